# Optimizing an MI355X kernel written in HIP

```python
import jax
import jax.numpy as jnp
from jax import lax
import numpy as np

D_MODEL = 2048
BATCH = 1
SEQ = 8192
DEPTH = 2

PLE_DIM = 256
RMS_EPS = 1e-6

MLSTM_HEADS = 4
MLSTM_HEAD_DIM = 256
MLSTM_W = MLSTM_HEADS * MLSTM_HEAD_DIM
MLSTM_CONV = 4
MLSTM_CHUNK = 64
GATE_SOFTCAP = 15.0

RWKV_HEADS = 8
RWKV_HEAD_DIM = 64
RWKV_W = RWKV_HEADS * RWKV_HEAD_DIM
DECAY_LORA = 96
AAA_LORA = 96
GATE_LORA = 256
RWKV_GN_EPS = 64e-5

S5_GROUP = 16
S5_GROUPS = 32
S5_W = S5_GROUP * S5_GROUPS
S5_STATE = 64

FFN_HIDDEN = ((8 * D_MODEL + 3 * 256 - 1) // (3 * 256)) * 256

M_IN = 4 * MLSTM_W + 2 * MLSTM_HEADS
RWKV_IN = 3 * RWKV_W + DECAY_LORA + AAA_LORA + GATE_LORA
N_BRANCH = 3
N_IN = M_IN + RWKV_IN + S5_W + N_BRANCH * D_MODEL
IN_SPLIT = (M_IN, M_IN + RWKV_IN, M_IN + RWKV_IN + S5_W)
RWKV_SPLIT = (RWKV_W, 2 * RWKV_W, 3 * RWKV_W, 3 * RWKV_W + DECAY_LORA, 3 * RWKV_W + DECAY_LORA + AAA_LORA)

kernel_name = 'hybrid_mlstm_rwkv7_s5_gated'


def _rmsnorm(x, g):
    xf = x.astype(jnp.float32)
    y = xf * lax.rsqrt(jnp.mean(xf * xf, axis=-1, keepdims=True) + RMS_EPS)
    return (y * g.astype(jnp.float32)).astype(x.dtype)


def _shift(x, n):
    return jnp.pad(x, ((0, 0), (n, 0), (0, 0)))[:, :x.shape[1]]


def _causal_dwconv(x, w):
    out = x * w[0]
    for j in range(1, w.shape[0]):
        out = out + w[j] * _shift(x, j)
    return out


def _token_shift(x, mu):
    return x + (_shift(x, 1) - x) * mu


def _softcap(z):
    return GATE_SOFTCAP * jnp.tanh(z / GATE_SOFTCAP)


def _mlstm(q, k, v, o, ig, fg, norm_g):
    B, T, _ = q.shape
    H, dh, L = MLSTM_HEADS, MLSTM_HEAD_DIM, MLSTM_CHUNK
    nc = T // L
    f32 = jnp.float32

    def to_chunks(z):
        return z.astype(f32).reshape(B, nc, L, H, dh).transpose(1, 0, 3, 2, 4)

    def gate_chunks(z):
        return z.reshape(B, nc, L, H).transpose(1, 0, 3, 2)

    qc = to_chunks(q) * (dh ** -0.5)
    kc = to_chunks(k)
    vc = to_chunks(v)
    ic = gate_chunks(_softcap(ig.astype(f32)))
    logf = jax.nn.log_sigmoid(_softcap(fg.astype(f32)))
    bc = jnp.cumsum(gate_chunks(logf), axis=-1)
    causal = jnp.tril(jnp.ones((L, L), dtype=bool))

    def step(carry, inp):
        C, n, m = carry
        qb, kb, vb, ib, bb = inp
        dmat = bb[..., :, None] - bb[..., None, :] + ib[..., None, :]
        dmat = jnp.where(causal, dmat, -jnp.inf)
        inter = bb + m[..., None]
        m_t = jnp.maximum(inter, jnp.max(dmat, axis=-1))
        s = jnp.einsum('bhtd,bhsd->bhts', qb, kb) * jnp.exp(dmat - m_t[..., None])
        inter_w = jnp.exp(inter - m_t)
        num = jnp.einsum('bhts,bhsd->bhtd', s, vb) + inter_w[..., None] * jnp.einsum('bhtk,bhvk->bhtv', qb, C)
        den = jnp.sum(s, axis=-1) + inter_w * jnp.einsum('bhtk,bhk->bht', qb, n)
        h = num / jnp.maximum(jnp.abs(den), jnp.exp(-m_t))[..., None]
        b_end = bb[..., -1]
        wlog = b_end[..., None] - bb + ib
        m_new = jnp.maximum(b_end + m, jnp.max(wlog, axis=-1))
        decay = jnp.exp(b_end + m - m_new)
        ws = jnp.exp(wlog - m_new[..., None])
        C_new = decay[..., None, None] * C + jnp.einsum('bhs,bhsv,bhsk->bhvk', ws, vb, kb)
        n_new = decay[..., None] * n + jnp.einsum('bhs,bhsk->bhk', ws, kb)
        return (C_new, n_new, m_new), h

    carry0 = (jnp.zeros((B, H, dh, dh), f32), jnp.zeros((B, H, dh), f32), jnp.zeros((B, H), f32))
    _, h = lax.scan(step, carry0, (qc, kc, vc, ic, bc))
    h = h.transpose(1, 0, 3, 2, 4).reshape(B, T, H, dh)
    h = h * lax.rsqrt(jnp.mean(h * h, axis=-1, keepdims=True) + RMS_EPS)
    h = h.reshape(B, T, MLSTM_W) * norm_g.astype(f32)
    return jax.nn.sigmoid(o.astype(f32)) * h


def _rwkv7(r, k, v, wl, al, gl, w0, w2, a0, a2, g2, k_k, k_a, r_k, ln_g, ln_b):
    B, T, _ = r.shape
    H, dh = RWKV_HEADS, RWKV_HEAD_DIM
    f32 = jnp.float32
    r, k, v = r.astype(f32), k.astype(f32), v.astype(f32)
    w = -jax.nn.softplus(-(w0 + jnp.tanh(wl.astype(f32)) @ w2)) - 0.5
    decay = jnp.exp(-jnp.exp(w))
    a = jax.nn.sigmoid(a0 + al.astype(f32) @ a2)
    g = jax.nn.sigmoid(gl.astype(f32)) @ g2
    kk = (k * k_k).reshape(B, T, H, dh)
    kk = kk / jnp.maximum(jnp.sqrt(jnp.sum(kk * kk, axis=-1, keepdims=True)), 1e-12)
    k = k * (1.0 + (a - 1.0) * k_a)

    def heads(z):
        return z.reshape(B, T, H, dh).transpose(1, 0, 2, 3)

    kk_t = kk.transpose(1, 0, 2, 3)

    def step(S, inp):
        r_t, w_t, k_t, v_t, kk_s, a_t = inp
        sa = jnp.einsum('bhvk,bhk->bhv', S, -kk_s)
        S = (S * w_t[:, :, None, :] + sa[..., None] * (kk_s * a_t)[:, :, None, :]
             + v_t[..., None] * k_t[:, :, None, :])
        return S, jnp.einsum('bhvk,bhk->bhv', S, r_t)

    S0 = jnp.zeros((B, H, dh, dh), f32)
    _, y = lax.scan(step, S0, (heads(r), heads(decay), heads(k), heads(v), kk_t, heads(a)))
    y = y.transpose(1, 0, 2, 3)
    mu = jnp.mean(y, axis=-1, keepdims=True)
    var = jnp.mean((y - mu) ** 2, axis=-1, keepdims=True)
    y = ((y - mu) * lax.rsqrt(var + RWKV_GN_EPS)).reshape(B, T, RWKV_W) * ln_g + ln_b
    bonus = jnp.sum((r * k * r_k).reshape(B, T, H, dh), axis=-1, keepdims=True) * v.reshape(B, T, H, dh)
    y = y + bonus.reshape(B, T, RWKV_W)
    return y * g


def _s5(u, a_re, a_im, log_dt, b_re, b_im, c_re, c_im, d, glu_w, glu_b):
    B, T, _ = u.shape
    G, P = S5_GROUPS, S5_GROUP
    uf = u.astype(jnp.float32).reshape(B, T, G, P)
    dt = jnp.exp(log_dt)[:, None]
    mag = jnp.exp(a_re * dt)
    ang = a_im * dt
    abar_re, abar_im = mag * jnp.cos(ang), mag * jnp.sin(ang)
    den = a_re * a_re + a_im * a_im
    nr, ni = abar_re - 1.0, abar_im
    coef_re = (nr * a_re + ni * a_im) / den
    coef_im = (ni * a_re - nr * a_im) / den
    bu_re = jnp.einsum('btgp,gnp->btgn', uf, b_re)
    bu_im = jnp.einsum('btgp,gnp->btgn', uf, b_im)
    x_re = coef_re * bu_re - coef_im * bu_im
    x_im = coef_re * bu_im + coef_im * bu_re
    ar = jnp.broadcast_to(abar_re, x_re.shape)
    ai = jnp.broadcast_to(abar_im, x_re.shape)

    def combine(e1, e2):
        a1r, a1i, b1r, b1i = e1
        a2r, a2i, b2r, b2i = e2
        return (a2r * a1r - a2i * a1i, a2r * a1i + a2i * a1r,
                a2r * b1r - a2i * b1i + b2r, a2r * b1i + a2i * b1r + b2i)

    _, _, s_re, s_im = lax.associative_scan(combine, (ar, ai, x_re, x_im), axis=1)
    y = (jnp.einsum('btgn,gpn->btgp', s_re, c_re) - jnp.einsum('btgn,gpn->btgp', s_im, c_im)
         + d.reshape(G, P) * uf)
    y = jax.nn.gelu(y.reshape(B, T, S5_W))
    return y * jax.nn.sigmoid(y @ glu_w + glu_b)


def setup_inputs(seed: int = 0) -> dict:
    key = jax.random.key(seed)
    ks = iter(jax.random.split(key, 48))
    L = DEPTH
    f32 = jnp.float32

    def nrm(shape, fan_in, scale=1.0):
        return jax.random.normal(next(ks), shape, f32) * (scale * fan_in ** -0.5)

    def gain(shape, center=1.0):
        return center + 0.02 * jax.random.normal(next(ks), shape, f32)

    def unif(shape, lo, hi):
        return jax.random.uniform(next(ks), shape, f32, minval=lo, maxval=hi)

    inputs = {
        'x': jax.random.normal(next(ks), (BATCH, SEQ, D_MODEL), f32),
        'p': jax.random.normal(next(ks), (DEPTH, BATCH, SEQ, PLE_DIM), f32),
        'norm_mix_g': gain((L, D_MODEL)),
        'w_in': nrm((L, D_MODEL, N_IN), D_MODEL),
        'mlstm_conv': nrm((L, MLSTM_CONV, 2 * MLSTM_W), MLSTM_CONV),
        'mlstm_ib': -2.0 + 0.5 * jax.random.normal(next(ks), (L, MLSTM_HEADS), f32),
        'mlstm_fb': unif((L, MLSTM_HEADS), 3.0, 6.0),
        'mlstm_norm_g': gain((L, MLSTM_W)),
        'rwkv_mu': unif((L, RWKV_IN), 0.0, 1.0),
        'rwkv_w0': unif((L, RWKV_W), -6.0, -1.0),
        'rwkv_w2': nrm((L, DECAY_LORA, RWKV_W), DECAY_LORA, 0.1),
        'rwkv_a0': 0.1 * jax.random.normal(next(ks), (L, RWKV_W), f32),
        'rwkv_a2': nrm((L, AAA_LORA, RWKV_W), AAA_LORA, 0.1),
        'rwkv_g2': nrm((L, GATE_LORA, RWKV_W), GATE_LORA),
        'rwkv_kk': gain((L, RWKV_W), 0.85),
        'rwkv_ka': gain((L, RWKV_W)),
        'rwkv_rk': 0.1 * jax.random.normal(next(ks), (L, RWKV_W), f32),
        'rwkv_ln_g': gain((L, RWKV_W)),
        'rwkv_ln_b': 0.01 * jax.random.normal(next(ks), (L, RWKV_W), f32),
        's5_a_re': -0.5 + 0.01 * jax.random.normal(next(ks), (L, S5_GROUPS, S5_STATE), f32),
        's5_a_im': (jnp.pi * jnp.arange(S5_STATE, dtype=f32)
                    + 0.01 * jax.random.normal(next(ks), (L, S5_GROUPS, S5_STATE), f32)),
        's5_log_dt': unif((L, S5_GROUPS), float(np.log(1e-3)), float(np.log(1e-1))),
        's5_b_re': nrm((L, S5_GROUPS, S5_STATE, S5_GROUP), 2 * S5_GROUP),
        's5_b_im': nrm((L, S5_GROUPS, S5_STATE, S5_GROUP), 2 * S5_GROUP),
        's5_c_re': nrm((L, S5_GROUPS, S5_GROUP, S5_STATE), 2 * S5_STATE),
        's5_c_im': nrm((L, S5_GROUPS, S5_GROUP, S5_STATE), 2 * S5_STATE),
        's5_d': jax.random.normal(next(ks), (L, S5_W), f32),
        's5_glu_w': nrm((L, S5_W, S5_W), S5_W),
        's5_glu_b': 0.01 * jax.random.normal(next(ks), (L, S5_W), f32),
        'w_up_m': nrm((L, MLSTM_W, D_MODEL), MLSTM_W),
        'w_up_r': nrm((L, RWKV_W, D_MODEL), RWKV_W),
        'w_up_s': nrm((L, S5_W, D_MODEL), S5_W),
        'w_out': nrm((L, D_MODEL, D_MODEL), D_MODEL),
        'norm_ffn_g': gain((L, D_MODEL)),
        'ffn_w_gate': nrm((L, D_MODEL, FFN_HIDDEN), D_MODEL),
        'ffn_w_up': nrm((L, D_MODEL, FFN_HIDDEN), D_MODEL),
        'ffn_w_down': nrm((L, FFN_HIDDEN, D_MODEL), FFN_HIDDEN),
        'norm_ple_g': gain((L, D_MODEL)),
        'ple_w_gate': nrm((L, D_MODEL, D_MODEL), D_MODEL),
        'ple_w_proj': nrm((L, PLE_DIM, D_MODEL), PLE_DIM),
        'final_norm_g': gain((D_MODEL,)),
    }
    return inputs


def reference(x, p, norm_mix_g, w_in, mlstm_conv, mlstm_ib, mlstm_fb, mlstm_norm_g,
              rwkv_mu, rwkv_w0, rwkv_w2, rwkv_a0, rwkv_a2, rwkv_g2, rwkv_kk, rwkv_ka, rwkv_rk,
              rwkv_ln_g, rwkv_ln_b, s5_a_re, s5_a_im, s5_log_dt, s5_b_re, s5_b_im, s5_c_re,
              s5_c_im, s5_d, s5_glu_w, s5_glu_b, w_up_m, w_up_r, w_up_s, w_out, norm_ffn_g,
              ffn_w_gate, ffn_w_up, ffn_w_down, norm_ple_g, ple_w_gate, ple_w_proj, final_norm_g):
    h = x
    dt = x.dtype
    for i in range(DEPTH):
        xn = _rmsnorm(h, norm_mix_g[i])
        z = xn @ w_in[i]
        zm, zr, zs, zg = jnp.split(z, IN_SPLIT, axis=-1)

        qk = jax.nn.silu(_causal_dwconv(zm[..., :2 * MLSTM_W], mlstm_conv[i]))
        q, k = jnp.split(qk, 2, axis=-1)
        v = zm[..., 2 * MLSTM_W:3 * MLSTM_W]
        o = zm[..., 3 * MLSTM_W:4 * MLSTM_W]
        ig = zm[..., 4 * MLSTM_W:4 * MLSTM_W + MLSTM_HEADS] + mlstm_ib[i]
        fg = zm[..., 4 * MLSTM_W + MLSTM_HEADS:] + mlstm_fb[i]
        y_m = _mlstm(q, k, v, o, ig, fg, mlstm_norm_g[i])

        zr = _token_shift(zr, rwkv_mu[i])
        r, kr, vr, wl, al, gl = jnp.split(zr, RWKV_SPLIT, axis=-1)
        y_r = _rwkv7(r, kr, vr, wl, al, gl, rwkv_w0[i], rwkv_w2[i], rwkv_a0[i], rwkv_a2[i],
                     rwkv_g2[i], rwkv_kk[i], rwkv_ka[i], rwkv_rk[i], rwkv_ln_g[i], rwkv_ln_b[i])

        y_s = _s5(zs, s5_a_re[i], s5_a_im[i], s5_log_dt[i], s5_b_re[i], s5_b_im[i],
                  s5_c_re[i], s5_c_im[i], s5_d[i], s5_glu_w[i], s5_glu_b[i])

        g_m, g_r, g_s = jnp.split(jax.nn.sigmoid(zg), N_BRANCH, axis=-1)
        mixed = (g_m * (y_m.astype(dt) @ w_up_m[i]) + g_r * (y_r.astype(dt) @ w_up_r[i])
                 + g_s * (y_s.astype(dt) @ w_up_s[i]))
        h = h + mixed @ w_out[i]

        hn = _rmsnorm(h, norm_ffn_g[i])
        h = h + (jax.nn.silu(hn @ ffn_w_gate[i]) * (hn @ ffn_w_up[i])) @ ffn_w_down[i]

        hp = _rmsnorm(h, norm_ple_g[i])
        h = h + (p[i] @ ple_w_proj[i]) * jax.nn.sigmoid(hp @ ple_w_gate[i])
    return _rmsnorm(h, final_norm_g)
```

```cpp
#include <hip/hip_runtime.h>
#include <hip/hip_cooperative_groups.h>
#include <cstdio>
#include <cstdint>
namespace cg = cooperative_groups;

#define LAS __attribute__((address_space(3)))
typedef unsigned short bh;
typedef short bf16x8 __attribute__((ext_vector_type(8)));
typedef float f32x4 __attribute__((ext_vector_type(4)));
typedef float f32x16 __attribute__((ext_vector_type(16)));
typedef unsigned u32x4 __attribute__((ext_vector_type(4)));
typedef unsigned u32x2 __attribute__((ext_vector_type(2)));

#ifndef SINGLE_LAUNCH
#define SINGLE_LAUNCH 1
#endif

constexpr int T = 8192, D = 2048, FH = 5632;
constexpr int NIN = 12744, NGATE = 6144, NF = 6600, ZF_LD = 6656, NINP = 12800;
constexpr int ZR0 = 4104, ZS0 = 6088;
constexpr int NCH = 128;

constexpr size_t AL(size_t x) { return (x + 255) & ~(size_t)255; }
constexpr size_t SZ_WIN = (size_t)NINP * D * 2, SZ_SQ = (size_t)D * D * 2, SZ_WGU = (size_t)2 * FH * D * 2, SZ_WD = (size_t)D * FH * 2;
constexpr size_t OFF_WIN = 0;
constexpr size_t OFF_WUP = OFF_WIN + SZ_WIN;
constexpr size_t OFF_WO = OFF_WUP + SZ_SQ;
constexpr size_t OFF_WGU = OFF_WO + SZ_SQ;
constexpr size_t OFF_WD = OFF_WGU + SZ_WGU;
constexpr size_t OFF_WPG = OFF_WD + SZ_WD;
constexpr size_t OFF_WPP = OFF_WPG + SZ_SQ;
constexpr size_t OFF_WGLU = OFF_WPP + (size_t)D * 256 * 2;
constexpr size_t OFF_WW2 = OFF_WGLU + (size_t)512 * 512 * 2;
constexpr size_t OFF_WA2 = OFF_WW2 + (size_t)512 * 256 * 2;
constexpr size_t OFF_WG2 = OFF_WA2 + (size_t)512 * 256 * 2;
constexpr size_t OFF_PBF = OFF_WG2 + (size_t)512 * 256 * 2;
constexpr size_t OFF_ABF = OFF_PBF + (size_t)2 * T * 256 * 2;
constexpr size_t OFF_YCAT = OFF_ABF + (size_t)T * D * 2;
constexpr size_t OFF_ZF = OFF_YCAT + (size_t)T * D * 2;
constexpr size_t OFF_ACT = OFF_ZF;
constexpr size_t OFF_MIX32 = OFF_ZF + (size_t)100663296;
constexpr size_t OFF_ZG = OFF_ZF + (size_t)T * ZF_LD * 4;
constexpr size_t SZ_R = (size_t)T * 512 * 4;
constexpr size_t OFF_RR = OFF_ZG + (size_t)T * NGATE * 2;
constexpr size_t OFF_RK = OFF_RR + SZ_R, OFF_RV = OFF_RK + SZ_R, OFF_RKK = OFF_RV + SZ_R, OFF_RW = OFF_RKK + SZ_R, OFF_RB = OFF_RW + SZ_R, OFF_RG = OFF_RB + SZ_R, OFF_RY = OFF_RG + SZ_R;
constexpr size_t OFF_LAW = OFF_RY + SZ_R;
constexpr size_t OFF_LAA = OFF_LAW + (size_t)T * 256 * 2, OFF_LAG = OFF_LAA + (size_t)T * 256 * 2;
constexpr size_t SZ_MB = (size_t)T * 1024 * 2;
constexpr size_t OFF_MQ = OFF_LAG + (size_t)T * 256 * 2, OFF_MK = OFF_MQ + SZ_MB, OFF_MKT = OFF_MK + SZ_MB, OFF_MVT = OFF_MKT + SZ_MB;
constexpr size_t OFF_MI = OFF_MVT + SZ_MB;
constexpr size_t OFF_MBB = OFF_MI + (size_t)4 * T * 4;
constexpr size_t OFF_MBEND = OFF_MBB + (size_t)4 * T * 4;
constexpr size_t OFF_MLOC = OFF_MBEND + 2048, OFF_MSTART = OFF_MLOC + 2048;
constexpr size_t OFF_DN = OFF_MSTART + 2048;
constexpr size_t OFF_NST = OFF_DN + (size_t)4 * NCH * 256 * 4;
constexpr size_t OFF_SEND = OFF_NST + (size_t)4 * NCH * 256 * 4;
constexpr size_t OFF_YS = OFF_SEND + (size_t)32 * NCH * 64 * 8;
constexpr size_t WS_TOTAL = OFF_YS + (size_t)T * 512 * 2;

struct Params { const float* in[41]; float* out; unsigned char* ws; };
#define KARG4 __attribute__((address_space(4)))
__device__ __forceinline__ const float* karg_in(int i) { const KARG4 char* ka = (const KARG4 char*)__builtin_amdgcn_kernarg_segment_ptr(); return *(const float* const volatile KARG4*)(ka + (size_t)i * 8); }
#define P_IN(i) karg_in(i)
#define P_OUT ((float*)karg_in(41))
#define P_WS ((unsigned char*)karg_in(42))

__device__ __forceinline__ int TIDX() { int t = threadIdx.x; asm volatile("" : "+v"(t)); return t; }
__device__ __forceinline__ int BIDX() { int t = blockIdx.x; asm volatile("" : "+s"(t)); return t; }
__device__ __forceinline__ int GDIM() { int t = gridDim.x; asm volatile("" : "+s"(t)); return t; }
__device__ __forceinline__ bh f2bf(float f) { unsigned u = __float_as_uint(f); u += 0x7fffu + ((u >> 16) & 1u); return (bh)(u >> 16); }
__device__ __forceinline__ float bf2f(bh h) { return __uint_as_float(((unsigned)h) << 16); }
__device__ __forceinline__ unsigned pk2(float lo, float hi) { return (unsigned)f2bf(lo) | ((unsigned)f2bf(hi) << 16); }
__device__ __forceinline__ float sigmoidf_(float x) { return 1.0f / (1.0f + __expf(-x)); }
__device__ __forceinline__ float wave_sum(float v) {
#pragma unroll
    for (int o = 32; o >= 1; o >>= 1) v += __shfl_xor(v, o);
    return v;
}
__device__ __forceinline__ float wave_max(float v) {
#pragma unroll
    for (int o = 32; o >= 1; o >>= 1) v = fmaxf(v, __shfl_xor(v, o));
    return v;
}
template <int CTRL> __device__ __forceinline__ float dpp_f(float x) {
    return __builtin_bit_cast(float, __builtin_amdgcn_update_dpp(0, __builtin_bit_cast(int, x), CTRL, 0xf, 0xf, true));
}
__device__ __forceinline__ float allreduce16(float x) {
    x += dpp_f<0xB1>(x); x += dpp_f<0x4E>(x); x += dpp_f<0x141>(x); x += dpp_f<0x140>(x);
    return x;
}
#define MFMA16(a, b, c) __builtin_amdgcn_mfma_f32_16x16x32_bf16(a, b, c, 0, 0, 0)
#define MFMA32(a, b, c) __builtin_amdgcn_mfma_f32_32x32x16_bf16(a, b, c, 0, 0, 0)

namespace pg8 {
constexpr int BM = 256, BK = 64, HALF = 128, HTB = HALF * BK * 2, STAGE_BYTES = 8 * HTB, NXCD = 8, WGM = 8;
__device__ __forceinline__ int lds_byte(int r, int c) { const int st = (r >> 4) * 2 + (c >> 5), rr = r & 15, cc = c & 31, ob = rr * 64 + cc * 2; return st * 1024 + (ob ^ (((ob >> 9) & 1) << 5)); }
__device__ __forceinline__ void stage_rc(int b, int& R, int& C) { const int st = b / 1024, sb = b % 1024, swz = sb ^ (((sb >> 9) & 1) << 5); R = (st >> 1) * 16 + swz / 64; C = (st & 1) * 32 + (swz % 64) / 2; }
__device__ __forceinline__ int perm32(int rho) { const int n = rho >> 4, i = rho & 15; return 8 * (i >> 2) + 4 * n + (i & 3); }
struct Unit { int pm, pn; };
struct Gemm { const bh* A; const bh* Bt; int M, N, K, lda, ldb, epi, perm; const void* p0; const void* p1; const void* p2; void* o0; void* o1; };
struct StaticOrder {
    int nM, nN, nwg, G, c;
    __device__ void init(int M, int N, int G_, int c_) { nM = M / BM; nN = N / BM; nwg = nM * nN; G = G_; c = c_; }
    __device__ bool next(int i, Unit& u) const {
        const long L = (long)i * G + c; if (L >= nwg) return false;
        int wgid = (int)L; { const int q = nwg / NXCD, r = nwg % NXCD, xcd = wgid % NXCD, off = wgid / NXCD; wgid = (xcd < r ? xcd * (q + 1) : r * (q + 1) + (xcd - r) * q) + off; }
        const int nig = WGM * nN, gid = wgid / nig, fm = gid * WGM, gsz = (nM - fm) < WGM ? (nM - fm) : WGM;
        u.pm = fm + ((wgid % nig) % gsz); u.pn = (wgid % nig) / gsz; return true;
    }
};
__device__ __forceinline__ unsigned cvt_pk_bf16(float lo, float hi) { unsigned r; asm volatile("v_cvt_pk_bf16_f32 %0, %1, %2" : "=v"(r) : "v"(lo), "v"(hi)); return r; }

__device__ __forceinline__ void epi_run(const Gemm& g, const f32x4 (&acc)[2][2][4][2], const Unit& u, int wr, int wc, int fr, int fq);
__device__ __forceinline__ void gemm_phase(LAS unsigned char* lds, const Gemm& g, const StaticOrder& S) {
    const int tid = TIDX(), wid = __builtin_amdgcn_readfirstlane(tid >> 6), lane = tid & 63, wr = wid >> 2, wc = wid & 3, fr = lane & 15, fq = lane >> 4;
    const int K = g.K, nt = K / BK;
    unsigned voffA[2], voffB[2];
#pragma unroll
    for (int i = 0; i < 2; ++i) { int R, C; stage_rc(tid * 16 + i * 8192, R, C); const int Rb = g.perm ? ((R & ~31) + perm32(R & 31)) : R;
        voffA[i] = (unsigned)(R * g.lda + C) * 2u; voffB[i] = (unsigned)(Rb * g.ldb + C) * 2u; }
    const size_t kstep = (size_t)(BK * 2);
    const size_t hstepA = (size_t)HALF * g.lda * 2, hstepB = (size_t)HALF * g.ldb * 2;
    const size_t tstepA = 2 * hstepA, tstepB = 2 * hstepB;
    const unsigned ldsw = (unsigned)wid * 1024u;
    const int aoff = lds_byte(wr * 64 + fr, fq * 8), boff = lds_byte(wc * 32 + fr, fq * 8);
#define PG8_SA(b, h) (((b) * 2 + (h)) * HTB)
#define PG8_SB(b, h) ((4 + (b) * 2 + (h)) * HTB)
#define PG8_STAGE(bufoff, gbase, voff) do { _Pragma("unroll") for (int _i = 0; _i < 2; ++_i) \
        __builtin_amdgcn_global_load_lds((const unsigned*)((const char*)(gbase) + (voff)[_i]), (LAS unsigned*)(lds + (bufoff) + ldsw + _i * 8192), 16, 0, 0); } while (0)
#define PG8_LDA(dst, b, h) do { _Pragma("unroll") for (int m = 0; m < 4; ++m) _Pragma("unroll") for (int k = 0; k < 2; ++k) dst[m][k] = *(const LAS bf16x8*)(lds + PG8_SA(b, h) + aoff + m * 2048 + k * 1024); } while (0)
#define PG8_LDB(dst, b, h) do { _Pragma("unroll") for (int n = 0; n < 2; ++n) _Pragma("unroll") for (int k = 0; k < 2; ++k) dst[n][k] = *(const LAS bf16x8*)(lds + PG8_SB(b, h) + boff + n * 2048 + k * 1024); } while (0)
#define PG8_MMA(ai, bj, At, Bt) do { __builtin_amdgcn_s_setprio(1); _Pragma("unroll") for (int m = 0; m < 4; ++m) _Pragma("unroll") for (int n = 0; n < 2; ++n) _Pragma("unroll") for (int k = 0; k < 2; ++k) \
        acc[ai][bj][m][n] = __builtin_amdgcn_mfma_f32_16x16x32_bf16(Bt[n][k], At[m][k], acc[ai][bj][m][n], 0, 0, 0); __builtin_amdgcn_s_setprio(0); } while (0)
#define PG8_WAIT_V(n) asm volatile("s_waitcnt vmcnt(" #n ")" ::: "memory")
#define PG8_WAIT_L(n) asm volatile("s_waitcnt lgkmcnt(" #n ")" ::: "memory")
#define PG8_BAR __builtin_amdgcn_s_barrier()
#define PG8_SCHED __builtin_amdgcn_sched_barrier(0)
    Unit cur, nxt; int ui = 0;
    if (!S.next(0, cur)) return;
    f32x4 acc[2][2][4][2];
#pragma unroll
    for (int a = 0; a < 2; ++a)
#pragma unroll
        for (int b = 0; b < 2; ++b)
#pragma unroll
            for (int m = 0; m < 4; ++m)
#pragma unroll
                for (int n = 0; n < 2; ++n) acc[a][b][m][n] = (f32x4){0.f, 0.f, 0.f, 0.f};
    bf16x8 At[4][2], B0[2][2], B1[2][2];
    const char* cA = (const char*)g.A + (size_t)cur.pm * tstepA; const char* cB = (const char*)g.Bt + (size_t)cur.pn * tstepB;
    PG8_STAGE(PG8_SB(0, 0), cB, voffB); PG8_STAGE(PG8_SA(0, 0), cA, voffA); PG8_STAGE(PG8_SB(0, 1), cB + hstepB, voffB); PG8_STAGE(PG8_SA(0, 1), cA + hstepA, voffA);
    if (wr == 1) PG8_BAR;
    PG8_WAIT_V(4); PG8_BAR;
    PG8_STAGE(PG8_SB(1, 0), cB + kstep, voffB); PG8_STAGE(PG8_SA(1, 0), cA + kstep, voffA); PG8_STAGE(PG8_SB(1, 1), cB + hstepB + kstep, voffB);
    PG8_WAIT_V(6); PG8_BAR;
    for (;;) {
        const bool has_next = S.next(ui + 1, nxt);
        const char* nA = has_next ? (const char*)g.A + (size_t)nxt.pm * tstepA : cA; const char* nB = has_next ? (const char*)g.Bt + (size_t)nxt.pn * tstepB : cB;
        for (int t = 0; t < nt; t += 2) {
            const bool last = (t == nt - 2);
            const char* a1 = cA + (size_t)(t + 1) * kstep;
            const char* a2 = last ? nA : cA + (size_t)(t + 2) * kstep; const char* b2 = last ? nB : cB + (size_t)(t + 2) * kstep;
            const char* a3 = a2 + kstep; const char* b3 = b2 + kstep;
            PG8_LDB(B0, 0, 0); PG8_SCHED; PG8_LDA(At, 0, 0); PG8_STAGE(PG8_SA(1, 1), a1 + hstepA, voffA);
            PG8_WAIT_L(8); PG8_BAR; PG8_WAIT_L(0); PG8_MMA(0, 0, At, B0); PG8_BAR; PG8_SCHED;
            PG8_LDB(B1, 0, 1); PG8_STAGE(PG8_SB(0, 0), b2, voffB);
            PG8_BAR; PG8_WAIT_L(0); PG8_MMA(0, 1, At, B1); PG8_BAR;
            PG8_LDA(At, 0, 1); PG8_STAGE(PG8_SA(0, 0), a2, voffA);
            PG8_BAR; PG8_WAIT_L(0); PG8_MMA(1, 0, At, B0); PG8_BAR; PG8_SCHED;
            PG8_STAGE(PG8_SB(0, 1), b2 + hstepB, voffB);
            PG8_WAIT_V(6); PG8_BAR; PG8_MMA(1, 1, At, B1); PG8_BAR;
            PG8_LDB(B0, 1, 0); PG8_SCHED; PG8_LDA(At, 1, 0); PG8_STAGE(PG8_SA(0, 1), a2 + hstepA, voffA);
            PG8_WAIT_L(8); PG8_BAR; PG8_WAIT_L(0); PG8_MMA(0, 0, At, B0); PG8_BAR; PG8_SCHED;
            PG8_LDB(B1, 1, 1); PG8_STAGE(PG8_SB(1, 0), b3, voffB);
            PG8_BAR; PG8_WAIT_L(0); PG8_MMA(0, 1, At, B1); PG8_BAR;
            PG8_LDA(At, 1, 1); PG8_STAGE(PG8_SA(1, 0), a3, voffA);
            PG8_BAR; PG8_WAIT_L(0); PG8_MMA(1, 0, At, B0); PG8_BAR; PG8_SCHED;
            PG8_STAGE(PG8_SB(1, 1), b3 + hstepB, voffB);
            PG8_WAIT_V(6); PG8_BAR; PG8_MMA(1, 1, At, B1); PG8_BAR;
        }
        epi_run(g, acc, cur, wr, wc, fr, fq);
        if (!has_next) break;
#pragma unroll
        for (int a = 0; a < 2; ++a)
#pragma unroll
            for (int b = 0; b < 2; ++b)
#pragma unroll
                for (int m = 0; m < 4; ++m)
#pragma unroll
                    for (int n = 0; n < 2; ++n) acc[a][b][m][n] = (f32x4){0.f, 0.f, 0.f, 0.f};
        cur = nxt; cA = nA; cB = nB; ++ui;
    }
    PG8_WAIT_V(0);
    if (wr == 0) PG8_BAR;
    PG8_BAR;
#undef PG8_SA
#undef PG8_SB
#undef PG8_STAGE
#undef PG8_LDA
#undef PG8_LDB
#undef PG8_MMA
#undef PG8_WAIT_V
#undef PG8_WAIT_L
#undef PG8_BAR
#undef PG8_SCHED
}
}
using pg8::Unit;
using pg8::cvt_pk_bf16;

#define EPI_FOR_NP(...) \
    _Pragma("unroll") for (int ai = 0; ai < 2; ++ai) _Pragma("unroll") for (int m = 0; m < 4; ++m) { const int row = u.pm * 256 + ai * 128 + wr * 64 + m * 16 + fr; \
    _Pragma("unroll") for (int bj = 0; bj < 2; ++bj) _Pragma("unroll") for (int n = 0; n < 2; ++n) { const int col = u.pn * 256 + bj * 128 + wc * 32 + n * 16 + 4 * fq; const f32x4 v = acc[ai][bj][m][n]; __VA_ARGS__ } }

typedef const f32x4 (&AccRef)[2][2][4][2];

struct EpiWin {
    static constexpr bool PERM = false;
    bh* zg; float* zf;
    __device__ __forceinline__ void operator()(AccRef acc, const Unit& u, int wr, int wc, int fr, int fq) const {
        if (u.pn < 24) {
            EPI_FOR_NP({ u32x2 w; w.x = cvt_pk_bf16(sigmoidf_(v[0]), sigmoidf_(v[1])); w.y = cvt_pk_bf16(sigmoidf_(v[2]), sigmoidf_(v[3])); *(u32x2*)(zg + (size_t)row * NGATE + col) = w; })
        } else {
            EPI_FOR_NP({ *(f32x4*)(zf + (size_t)row * ZF_LD + (col - NGATE)) = v; })
        }
    }
};
struct EpiLoraW {
    static constexpr bool PERM = false;
    const float* w0; float* rw;
    __device__ __forceinline__ void operator()(AccRef acc, const Unit& u, int wr, int wc, int fr, int fq) const {
        EPI_FOR_NP({ const f32x4 b = *(const f32x4*)(w0 + col); f32x4 o;
            _Pragma("unroll") for (int j = 0; j < 4; ++j) { const float x = -(b[j] + v[j]); const float sp = fmaxf(x, 0.f) + log1pf(__expf(-fabsf(x))); o[j] = __expf(-__expf(-sp - 0.5f)); }
            *(f32x4*)(rw + (size_t)row * 512 + col) = o; })
    }
};
struct EpiLoraA {
    static constexpr bool PERM = false;
    const float* a0; const float* ka; const float* rkk; float* rb; float* rk;
    __device__ __forceinline__ void operator()(AccRef acc, const Unit& u, int wr, int wc, int fr, int fq) const {
        EPI_FOR_NP({ const f32x4 b0 = *(const f32x4*)(a0 + col); const f32x4 kav = *(const f32x4*)(ka + col); const size_t o = (size_t)row * 512 + col;
            const f32x4 kkv = *(const f32x4*)(rkk + o); f32x4 kv = *(const f32x4*)(rk + o); f32x4 bo;
            _Pragma("unroll") for (int j = 0; j < 4; ++j) { const float a = sigmoidf_(b0[j] + v[j]); bo[j] = kkv[j] * a; kv[j] = kv[j] * (1.0f + (a - 1.0f) * kav[j]); }
            *(f32x4*)(rb + o) = bo; *(f32x4*)(rk + o) = kv; })
    }
};
struct EpiStoreF32 {
    static constexpr bool PERM = false;
    float* o; int ld;
    __device__ __forceinline__ void operator()(AccRef acc, const Unit& u, int wr, int wc, int fr, int fq) const {
        EPI_FOR_NP({ *(f32x4*)(o + (size_t)row * ld + col) = v; })
    }
};
struct EpiGlu {
    static constexpr bool PERM = false;
    const bh* ys; const float* gb; bh* ycat;
    __device__ __forceinline__ void operator()(AccRef acc, const Unit& u, int wr, int wc, int fr, int fq) const {
        EPI_FOR_NP({ const f32x4 b = *(const f32x4*)(gb + col); const u32x2 y2 = *(const u32x2*)(ys + (size_t)row * 512 + col);
            const float y0 = __uint_as_float(y2.x << 16), y1 = __uint_as_float(y2.x & 0xffff0000u), y2f = __uint_as_float(y2.y << 16), y3 = __uint_as_float(y2.y & 0xffff0000u);
            u32x2 w; w.x = cvt_pk_bf16(y0 * sigmoidf_(v[0] + b[0]), y1 * sigmoidf_(v[1] + b[1])); w.y = cvt_pk_bf16(y2f * sigmoidf_(v[2] + b[2]), y3 * sigmoidf_(v[3] + b[3]));
            *(u32x2*)(ycat + (size_t)row * D + 1536 + col) = w; })
    }
};
template <int MODE> struct EpiUp {
    static constexpr bool PERM = false;
    const bh* zg; float* mix; bh* mixed;
    __device__ __forceinline__ void operator()(AccRef acc, const Unit& u, int wr, int wc, int fr, int fq) const {
        EPI_FOR_NP({ const u32x2 g2 = *(const u32x2*)(zg + (size_t)row * NGATE + col);
            f32x4 g; g[0] = __uint_as_float(g2.x << 16); g[1] = __uint_as_float(g2.x & 0xffff0000u); g[2] = __uint_as_float(g2.y << 16); g[3] = __uint_as_float(g2.y & 0xffff0000u);
            f32x4 r = g * v; float* mp = mix + (size_t)row * D + col;
            if (MODE >= 1) r += *(const f32x4*)mp;
            if (MODE <= 1) *(f32x4*)mp = r;
            else { u32x2 w; w.x = cvt_pk_bf16(r[0], r[1]); w.y = cvt_pk_bf16(r[2], r[3]); *(u32x2*)(mixed + (size_t)row * D + col) = w; } })
    }
};
struct EpiRes {
    static constexpr bool PERM = false;
    float* h;
    __device__ __forceinline__ void operator()(AccRef acc, const Unit& u, int wr, int wc, int fr, int fq) const {
        EPI_FOR_NP({ float* hp = h + (size_t)row * D + col; *(f32x4*)hp = *(const f32x4*)hp + v; })
    }
};
struct EpiFfn {
    static constexpr bool PERM = true;
    bh* act;
    __device__ __forceinline__ void operator()(AccRef acc, const Unit& u, int wr, int wc, int fr, int fq) const {
#pragma unroll
        for (int ai = 0; ai < 2; ++ai)
#pragma unroll
            for (int m = 0; m < 4; ++m) { const int row = u.pm * 256 + ai * 128 + wr * 64 + m * 16 + fr; const int col = u.pn * 128 + wc * 32 + 8 * fq;
                float o[8];
#pragma unroll
                for (int n = 0; n < 2; ++n)
#pragma unroll
                    for (int j = 0; j < 4; ++j) { const float gte = acc[ai][0][m][n][j], up = acc[ai][1][m][n][j]; o[n * 4 + j] = gte * sigmoidf_(gte) * up; }
                u32x4 w; w.x = cvt_pk_bf16(o[0], o[1]); w.y = cvt_pk_bf16(o[2], o[3]); w.z = cvt_pk_bf16(o[4], o[5]); w.w = cvt_pk_bf16(o[6], o[7]);
                *(u32x4*)(act + (size_t)row * FH + col) = w; }
    }
};
struct EpiPle {
    static constexpr bool PERM = false;
    float* h; const float* tmp;
    __device__ __forceinline__ void operator()(AccRef acc, const Unit& u, int wr, int wc, int fr, int fq) const {
        EPI_FOR_NP({ float* hp = h + (size_t)row * D + col; const f32x4 tv = *(const f32x4*)(tmp + (size_t)row * D + col); f32x4 hv = *(const f32x4*)hp;
            _Pragma("unroll") for (int j = 0; j < 4; ++j) hv[j] += tv[j] * sigmoidf_(v[j]);
            *(f32x4*)hp = hv; })
    }
};

namespace pg8 {
__device__ __forceinline__ void epi_run(const Gemm& g, const f32x4 (&acc)[2][2][4][2], const Unit& u, int wr, int wc, int fr, int fq) {
    switch (g.epi) {
    case 0: { EpiWin E{(bh*)g.o0, (float*)g.o1}; E(acc, u, wr, wc, fr, fq); } break;
    case 1: { EpiLoraW E{(const float*)g.p0, (float*)g.o0}; E(acc, u, wr, wc, fr, fq); } break;
    case 2: { EpiLoraA E{(const float*)g.p0, (const float*)g.p1, (const float*)g.p2, (float*)g.o0, (float*)g.o1}; E(acc, u, wr, wc, fr, fq); } break;
    case 3: { EpiStoreF32 E{(float*)g.o0, g.N}; E(acc, u, wr, wc, fr, fq); } break;
    case 4: { EpiGlu E{(const bh*)g.p0, (const float*)g.p1, (bh*)g.o0}; E(acc, u, wr, wc, fr, fq); } break;
    case 5: { EpiUp<0> E{(const bh*)g.p0, (float*)g.o0, (bh*)g.o1}; E(acc, u, wr, wc, fr, fq); } break;
    case 6: { EpiUp<1> E{(const bh*)g.p0, (float*)g.o0, (bh*)g.o1}; E(acc, u, wr, wc, fr, fq); } break;
    case 7: { EpiUp<2> E{(const bh*)g.p0, (float*)g.o0, (bh*)g.o1}; E(acc, u, wr, wc, fr, fq); } break;
    case 8: { EpiRes E{(float*)g.o0}; E(acc, u, wr, wc, fr, fq); } break;
    case 9: { EpiFfn E{(bh*)g.o0}; E(acc, u, wr, wc, fr, fq); } break;
    default: { EpiPle E{(float*)g.o0, (const float*)g.p0}; E(acc, u, wr, wc, fr, fq); } break;
    }
}
}

__device__ __forceinline__ bool make_gemm(const Params& p, int L, int q, int i, pg8::Gemm& g) {
    unsigned char* ws = P_WS;
    g.M = T; g.perm = 0; g.p0 = nullptr; g.p1 = nullptr; g.p2 = nullptr; g.o0 = nullptr; g.o1 = nullptr;
    switch (q) {
    case 1: if (i > 0) return false;
        g.A = (const bh*)(ws + OFF_ABF); g.lda = D; g.Bt = (const bh*)(ws + OFF_WIN); g.ldb = D; g.N = NINP; g.K = D; g.epi = 0; g.o0 = ws + OFF_ZG; g.o1 = ws + OFF_ZF; return true;
    case 3: if (i > 2) return false;
        g.lda = 256; g.ldb = 256; g.N = 512; g.K = 256;
        if (i == 0) { g.A = (const bh*)(ws + OFF_LAW); g.Bt = (const bh*)(ws + OFF_WW2); g.epi = 1; g.p0 = P_IN(9) + L * 512; g.o0 = ws + OFF_RW; }
        else if (i == 1) { g.A = (const bh*)(ws + OFF_LAA); g.Bt = (const bh*)(ws + OFF_WA2); g.epi = 2; g.p0 = P_IN(11) + L * 512; g.p1 = P_IN(15) + L * 512; g.p2 = ws + OFF_RKK; g.o0 = ws + OFF_RB; g.o1 = ws + OFF_RK; }
        else { g.A = (const bh*)(ws + OFF_LAG); g.Bt = (const bh*)(ws + OFF_WG2); g.epi = 3; g.o0 = ws + OFF_RG; }
        return true;
    case 5: if (i > 0) return false;
        g.A = (const bh*)(ws + OFF_YS); g.lda = 512; g.Bt = (const bh*)(ws + OFF_WGLU); g.ldb = 512; g.N = 512; g.K = 512; g.epi = 4; g.p0 = ws + OFF_YS; g.p1 = P_IN(28) + L * 512; g.o0 = ws + OFF_YCAT; return true;
    case 6: if (i > 2) return false;
        { const int ko = (i == 0) ? 0 : (i == 1) ? 1024 : 1536;
          g.A = (const bh*)(ws + OFF_YCAT) + ko; g.lda = D; g.Bt = (const bh*)(ws + OFF_WUP) + ko; g.ldb = D; g.N = D; g.K = (i == 0) ? 1024 : 512; g.epi = 5 + i;
          g.p0 = (const bh*)(ws + OFF_ZG) + i * 2048; g.o0 = ws + OFF_MIX32; g.o1 = ws + OFF_ABF; }
        return true;
    case 7: if (i > 0) return false;
        g.A = (const bh*)(ws + OFF_ABF); g.lda = D; g.Bt = (const bh*)(ws + OFF_WO); g.ldb = D; g.N = D; g.K = D; g.epi = 8; g.o0 = P_OUT; return true;
    case 9: if (i > 0) return false;
        g.A = (const bh*)(ws + OFF_ABF); g.lda = D; g.Bt = (const bh*)(ws + OFF_WGU); g.ldb = D; g.N = 2 * FH; g.K = D; g.epi = 9; g.perm = 1; g.o0 = ws + OFF_ACT; return true;
    case 10: if (i > 0) return false;
        g.A = (const bh*)(ws + OFF_ACT); g.lda = FH; g.Bt = (const bh*)(ws + OFF_WD); g.ldb = FH; g.N = D; g.K = FH; g.epi = 8; g.o0 = P_OUT; return true;
    case 12: if (i > 1) return false;
        if (i == 0) { g.A = (const bh*)(ws + OFF_PBF) + (size_t)L * T * 256; g.lda = 256; g.Bt = (const bh*)(ws + OFF_WPP); g.ldb = 256; g.N = D; g.K = 256; g.epi = 3; g.o0 = ws + OFF_MIX32; }
        else { g.A = (const bh*)(ws + OFF_ABF); g.lda = D; g.Bt = (const bh*)(ws + OFF_WPG); g.ldb = D; g.N = D; g.K = D; g.epi = 10; g.o0 = P_OUT; g.p0 = ws + OFF_MIX32; }
        return true;
    default: return false;
    }
}

struct CJ { const float* src; int in_idx, src_ld, kv, n0, nv; long lstride; size_t dst; int dst_ld, r0, c0, npad, kpad, seg, segstride; };
constexpr int BIGSEG = 1 << 30;
__constant__ int JT_I[15][12] = {
    {3, NIN, 2048, NF, NGATE, D, 0, 0, NGATE, 2048, BIGSEG, 0},
    {3, NIN, 2048, 0, NF, D, NGATE, 0, 6656, 2048, BIGSEG, 0},
    {29, D, 1024, 0, D, D, 0, 0, D, 1024, BIGSEG, 0},
    {30, D, 512, 0, D, D, 0, 1024, D, 512, BIGSEG, 0},
    {31, D, 512, 0, D, D, 0, 1536, D, 512, BIGSEG, 0},
    {32, D, 2048, 0, D, D, 0, 0, D, 2048, BIGSEG, 0},
    {34, FH, 2048, 0, FH, D, 0, 0, FH, 2048, 128, 256},
    {35, FH, 2048, 0, FH, D, 128, 0, FH, 2048, 128, 256},
    {36, D, FH, 0, D, FH, 0, 0, D, FH, BIGSEG, 0},
    {38, D, 2048, 0, D, D, 0, 0, D, 2048, BIGSEG, 0},
    {39, D, 256, 0, D, 256, 0, 0, D, 256, BIGSEG, 0},
    {27, 512, 512, 0, 512, 512, 0, 0, 512, 512, BIGSEG, 0},
    {10, 512, 96, 0, 512, 256, 0, 0, 512, 256, BIGSEG, 0},
    {12, 512, 96, 0, 512, 256, 0, 0, 512, 256, BIGSEG, 0},
    {13, 512, 256, 0, 512, 256, 0, 0, 512, 256, BIGSEG, 0}};
__constant__ long JT_L[15][2] = {
    {(long)D * NIN, (long)OFF_WIN}, {(long)D * NIN, (long)OFF_WIN}, {(long)1024 * D, (long)OFF_WUP}, {(long)512 * D, (long)OFF_WUP}, {(long)512 * D, (long)OFF_WUP},
    {(long)D * D, (long)OFF_WO}, {(long)D * FH, (long)OFF_WGU}, {(long)D * FH, (long)OFF_WGU}, {(long)FH * D, (long)OFF_WD}, {(long)D * D, (long)OFF_WPG},
    {(long)256 * D, (long)OFF_WPP}, {(long)512 * 512, (long)OFF_WGLU}, {(long)96 * 512, (long)OFF_WW2}, {(long)96 * 512, (long)OFF_WA2}, {(long)256 * 512, (long)OFF_WG2}};
__device__ __forceinline__ void get_job(int j, CJ& J) {
    J.in_idx = JT_I[j][0]; J.src_ld = JT_I[j][1]; J.kv = JT_I[j][2]; J.n0 = JT_I[j][3]; J.nv = JT_I[j][4]; J.dst_ld = JT_I[j][5]; J.r0 = JT_I[j][6]; J.c0 = JT_I[j][7];
    J.npad = JT_I[j][8]; J.kpad = JT_I[j][9]; J.seg = JT_I[j][10]; J.segstride = JT_I[j][11]; J.lstride = JT_L[j][0]; J.dst = (size_t)JT_L[j][1];
}
__device__ __forceinline__ const float* in_by_idx(const Params& p, int i) { return P_IN(i); }
constexpr int NJOBS = 15;

__device__ __forceinline__ void conv_tile(const Params& p, int L, const CJ& J, int tile, LAS bh* sm) {
    const int tid = TIDX();
    const int nkt = J.kpad / 64; const int tn = tile / nkt, tk = tile % nkt;
    const float* src = J.src + (size_t)L * J.lstride;
    {   const int n = tid & 63, nl = tn * 64 + n; const bool nok = nl < J.nv;
#pragma unroll
        for (int i = 0; i < 8; ++i) { const int k = (tid >> 6) + 8 * i, kg = tk * 64 + k;
            float v = 0.f; if (nok && kg < J.kv) v = src[(size_t)kg * J.src_ld + J.n0 + nl];
            sm[k * 66 + n] = f2bf(v); } }
    __syncthreads();
    {   const int n = tid >> 3, k8 = (tid & 7) * 8, nl = tn * 64 + n;
        const int drow = J.r0 + (nl / J.seg) * J.segstride + (nl % J.seg);
        u32x4 w; unsigned t[4];
#pragma unroll
        for (int i = 0; i < 4; ++i) t[i] = (unsigned)sm[(k8 + 2 * i) * 66 + n] | ((unsigned)sm[(k8 + 2 * i + 1) * 66 + n] << 16);
        w.x = t[0]; w.y = t[1]; w.z = t[2]; w.w = t[3];
        *(u32x4*)((bh*)(P_WS + J.dst) + (size_t)drow * J.dst_ld + J.c0 + tk * 64 + k8) = w; }
    __syncthreads();
}

__device__ __forceinline__ void rms_row_bf16(const float* x, const float* g, bh* o, int lane) {
    f32x4 v[8]; float s = 0.f;
#pragma unroll
    for (int j = 0; j < 8; ++j) { v[j] = *(const f32x4*)(x + j * 256 + lane * 4); s += (v[j][0] * v[j][0] + v[j][1] * v[j][1]) + (v[j][2] * v[j][2] + v[j][3] * v[j][3]); }
    const float rstd = rsqrtf(wave_sum(s) * (1.0f / D) + 1e-6f);
#pragma unroll
    for (int j = 0; j < 8; ++j) { const f32x4 gg = *(const f32x4*)(g + j * 256 + lane * 4); u32x2 w; w.x = pk2(v[j][0] * rstd * gg[0], v[j][1] * rstd * gg[1]); w.y = pk2(v[j][2] * rstd * gg[2], v[j][3] * rstd * gg[3]);
        *(u32x2*)(o + j * 256 + lane * 4) = w; }
}
__device__ __forceinline__ void phase_rmsnorm(const Params& p, const float* g) {
    const int gw = BIDX() * 8 + (TIDX() >> 6), NGW = GDIM() * 8, lane = TIDX() & 63;
    bh* abf = (bh*)(P_WS + OFF_ABF);
    for (int r = gw; r < T; r += NGW) rms_row_bf16(P_OUT + (size_t)r * D, g, abf + (size_t)r * D, lane);
}

__device__ __forceinline__ void phase_conv(const Params& p, int L, LAS unsigned char* lds) {
    const int tid = TIDX();
    int base = 0;
    for (int j = 0; j < NJOBS; ++j) { CJ J; get_job(j, J); J.src = in_by_idx(p, J.in_idx); const int ntile = (J.npad / 64) * (J.kpad / 64);
        int first = BIDX() - (base % GDIM()); if (first < 0) first += GDIM();
        for (int t = first; t < ntile; t += GDIM()) conv_tile(p, L, J, t, (LAS bh*)lds);
        base += ntile; }
    { bh* w = (bh*)(P_WS + OFF_WIN) + (size_t)NIN * D; for (int i = BIDX() * 512 + tid; i < (NINP - NIN) * D / 8; i += GDIM() * 512) ((u32x4*)w)[i] = (u32x4){0u, 0u, 0u, 0u}; }
    const int gw = BIDX() * 8 + (tid >> 6), NGW = GDIM() * 8, lane = tid & 63;
    bh* abf = (bh*)(P_WS + OFF_ABF);
    if (L == 0) {
        const float* ps = P_IN(1); bh* pb = (bh*)(P_WS + OFF_PBF);
        for (size_t i = (size_t)BIDX() * 512 + tid; i < (size_t)2 * T * 256 / 4; i += (size_t)GDIM() * 512) { const f32x4 v = ((const f32x4*)ps)[i]; u32x2 w; w.x = pk2(v[0], v[1]); w.y = pk2(v[2], v[3]); ((u32x2*)pb)[i] = w; }
        const float* x = P_IN(0);
        for (int r = gw; r < T; r += NGW) {
#pragma unroll
            for (int j = 0; j < 8; ++j) *(f32x4*)(P_OUT + (size_t)r * D + j * 256 + lane * 4) = *(const f32x4*)(x + (size_t)r * D + j * 256 + lane * 4);
            rms_row_bf16(x + (size_t)r * D, P_IN(2), abf + (size_t)r * D, lane);
        }
    } else {
        for (int r = gw; r < T; r += NGW) rms_row_bf16(P_OUT + (size_t)r * D, P_IN(2) + (size_t)L * D, abf + (size_t)r * D, lane);
    }
}

struct S5C { float ar, ai; float br[16], bi[16]; };
__device__ __forceinline__ void s5_setup(const Params& p, int L, int g, int n, S5C& c) {
    const int gi = L * 32 + g;
    const float dt = __expf(P_IN(21)[gi]);
    const float are = P_IN(19)[gi * 64 + n], aim = P_IN(20)[gi * 64 + n];
    const float mag = __expf(are * dt), ang = aim * dt;
    float sn, cs;
    {
        const double a = (double)ang; const double k = rint(a * 0.15915494309189535); const float r = (float)(a - k * 6.283185307179586);
        sn = sinf(r); cs = cosf(r);
    }
    c.ar = mag * cs; c.ai = mag * sn;
    const float den = are * are + aim * aim, nr = c.ar - 1.0f, ni = c.ai;
    const float cr = (nr * are + ni * aim) / den, ci = (ni * are - nr * aim) / den;
    const float* bre = P_IN(22) + ((size_t)gi * 64 + n) * 16; const float* bim = P_IN(23) + ((size_t)gi * 64 + n) * 16;
#pragma unroll
    for (int q = 0; q < 4; ++q) { const f32x4 r4 = *(const f32x4*)(bre + q * 4), i4 = *(const f32x4*)(bim + q * 4);
#pragma unroll
        for (int j = 0; j < 4; ++j) { c.br[q * 4 + j] = cr * r4[j] - ci * i4[j]; c.bi[q * 4 + j] = cr * i4[j] + ci * r4[j]; } }
}
__device__ __forceinline__ void s5_step(const S5C& c, const float* urow, float& sr, float& si) {
    float xr = 0.f, xi = 0.f;
#pragma unroll
    for (int q = 0; q < 4; ++q) { const f32x4 u4 = *(const f32x4*)(urow + q * 4);
#pragma unroll
        for (int j = 0; j < 4; ++j) { xr = fmaf(u4[j], c.br[q * 4 + j], xr); xi = fmaf(u4[j], c.bi[q * 4 + j], xi); } }
    const float nr = c.ar * sr - c.ai * si + xr, ni = c.ar * si + c.ai * sr + xi;
    sr = nr; si = ni;
}

__device__ __forceinline__ void mlstm_prep(const Params& p, int L, int h, int c, LAS unsigned char* lds) {
    const int tid = TIDX(), t0 = c * 64;
    const float* zf = (const float*)(P_WS + OFF_ZF);
    LAS float* s_ws = (LAS float*)lds;
    if (tid < 64) {
        const int t = t0 + tid;
        float ig = zf[(size_t)t * ZF_LD + 4096 + h] + P_IN(5)[L * 4 + h];
        float fg = zf[(size_t)t * ZF_LD + 4100 + h] + P_IN(6)[L * 4 + h];
        ig = 15.0f * tanhf(ig * (1.0f / 15.0f)); fg = 15.0f * tanhf(fg * (1.0f / 15.0f));
        const float lf = fminf(fg, 0.f) - log1pf(__expf(-fabsf(fg)));
        float b = lf;
#pragma unroll
        for (int o = 1; o < 64; o <<= 1) { const float nb = __shfl_up(b, o); if (tid >= o) b += nb; }
        const float bend = __shfl(b, 63);
        const float wlog = bend - b + ig;
        const float mloc = wave_max(wlog);
        s_ws[tid] = __expf(wlog - mloc);
        ((float*)(P_WS + OFF_MI))[h * T + t] = ig; ((float*)(P_WS + OFF_MBB))[h * T + t] = b;
        if (tid == 0) { ((float*)(P_WS + OFF_MBEND))[h * NCH + c] = bend; ((float*)(P_WS + OFF_MLOC))[h * NCH + c] = mloc; }
    }
    __syncthreads();
    const int d = tid & 255, isk = tid >> 8;
    const int col = isk * 1024 + h * 256 + d;
    const float* cw = P_IN(4) + (size_t)L * 4 * 2048;
    const float w0 = cw[col], w1 = cw[2048 + col], w2 = cw[4096 + col], w3 = cw[6144 + col];
    float x1 = (t0 >= 1) ? zf[(size_t)(t0 - 1) * ZF_LD + col] : 0.f, x2 = (t0 >= 2) ? zf[(size_t)(t0 - 2) * ZF_LD + col] : 0.f, x3 = (t0 >= 3) ? zf[(size_t)(t0 - 3) * ZF_LD + col] : 0.f;
    bh* MQ = (bh*)(P_WS + OFF_MQ); bh* MK = (bh*)(P_WS + OFF_MK);
    bh* MT = (bh*)(P_WS + (isk ? OFF_MKT : OFF_MVT)) + ((size_t)(h * NCH + c) * 256 + d) * 64;
    float dnacc = 0.f;
    for (int s8 = 0; s8 < 8; ++s8) {
        unsigned pk[4];
#pragma unroll
        for (int j = 0; j < 8; ++j) { const int s = s8 * 8 + j, t = t0 + s;
            const float x0 = zf[(size_t)t * ZF_LD + col]; float y = w0 * x0 + w1 * x1 + w2 * x2 + w3 * x3; x3 = x2; x2 = x1; x1 = x0;
            y = y * sigmoidf_(y);
            unsigned short e;
            if (!isk) { MQ[(size_t)t * 1024 + h * 256 + d] = f2bf(y * 0.0625f); e = f2bf(zf[(size_t)t * ZF_LD + 2048 + h * 256 + d]); }
            else { MK[(size_t)t * 1024 + h * 256 + d] = f2bf(y); const float wk = y * s_ws[s]; e = f2bf(wk); dnacc += wk; }
            if (j & 1) pk[j >> 1] |= ((unsigned)e << 16); else pk[j >> 1] = e; }
        u32x4 w; w.x = pk[0]; w.y = pk[1]; w.z = pk[2]; w.w = pk[3];
        *(u32x4*)(MT + s8 * 8) = w;
    }
    if (isk) ((float*)(P_WS + OFF_DN))[(size_t)(h * NCH + c) * 256 + d] = dnacc;
    __syncthreads();
}

__device__ __forceinline__ void rwkv_prep_token(const Params& p, int L, int t, int lane) {
    const float* zf = (const float*)(P_WS + OFF_ZF);
    const float* z = zf + (size_t)t * ZF_LD + ZR0; const float* zp = z - ZF_LD; const bool hp = t > 0;
    const float* mu = P_IN(8) + (size_t)L * 1984;
    float* RR = (float*)(P_WS + OFF_RR); float* RK = (float*)(P_WS + OFF_RK); float* RV = (float*)(P_WS + OFF_RV); float* RKK = (float*)(P_WS + OFF_RKK);
    const float* kkw = P_IN(14) + L * 512;
#pragma unroll
    for (int i = 0; i < 8; ++i) { const int c = i * 64 + lane;
        { const float a = z[c], b = hp ? zp[c] : 0.f; RR[(size_t)t * 512 + c] = a + (b - a) * mu[c]; }
        { const float a = z[1024 + c], b = hp ? zp[1024 + c] : 0.f; RV[(size_t)t * 512 + c] = a + (b - a) * mu[1024 + c]; }
        { const float a = z[512 + c], b = hp ? zp[512 + c] : 0.f; const float k = a + (b - a) * mu[512 + c]; RK[(size_t)t * 512 + c] = k;
          const float kkv = k * kkw[c]; const float ss = wave_sum(kkv * kkv); RKK[(size_t)t * 512 + c] = kkv / fmaxf(sqrtf(ss), 1e-12f); } }
    bh* LAW = (bh*)(P_WS + OFF_LAW) + (size_t)t * 256; bh* LAA = (bh*)(P_WS + OFF_LAA) + (size_t)t * 256; bh* LAG = (bh*)(P_WS + OFF_LAG) + (size_t)t * 256;
#pragma unroll
    for (int i = 0; i < 4; ++i) { const int j = i * 64 + lane;
        float vw = 0.f, va = 0.f;
        if (j < 96) { { const int c = 1536 + j; const float a = z[c], b = hp ? zp[c] : 0.f; vw = tanhf(a + (b - a) * mu[c]); }
                      { const int c = 1632 + j; const float a = z[c], b = hp ? zp[c] : 0.f; va = a + (b - a) * mu[c]; } }
        LAW[j] = f2bf(vw); LAA[j] = f2bf(va);
        { const int c = 1728 + j; const float a = z[c], b = hp ? zp[c] : 0.f; LAG[j] = f2bf(sigmoidf_(a + (b - a) * mu[c])); } }
}

__device__ __forceinline__ void s5_pass_a(const Params& p, int L, int g, int c, int lane) {
    S5C k; s5_setup(p, L, g, lane, k);
    const float* zf = (const float*)(P_WS + OFF_ZF) + (size_t)(c * 64) * ZF_LD + ZS0 + g * 16;
    float sr = 0.f, si = 0.f;
    for (int s = 0; s < 64; ++s) s5_step(k, zf + (size_t)s * ZF_LD, sr, si);
    float* se = (float*)(P_WS + OFF_SEND) + ((size_t)(g * NCH + c) * 64 + lane) * 2;
    se[0] = sr; se[1] = si;
}

__device__ __forceinline__ void phase_prep(const Params& p, int L, LAS unsigned char* lds) {
    const int wid = TIDX() >> 6, lane = TIDX() & 63;
    for (int it = BIDX(); it < 2048; it += GDIM()) {
        if (it < 512) mlstm_prep(p, L, it >> 7, it & 127, lds);
        else if (it < 1536) rwkv_prep_token(p, L, (it - 512) * 8 + wid, lane);
        else { const int w = (it - 1536) * 8 + wid; s5_pass_a(p, L, w >> 7, w & 127, lane); }
    }
}

__device__ __forceinline__ void rwkv_scan(const Params& p, int rb, LAS unsigned char* lds) {
    const int tid = TIDX(), wid = __builtin_amdgcn_readfirstlane(tid >> 6), lane = tid & 63;
    const int hd = rb >> 2, rg = rb & 3;
    LAS float* buf = (LAS float*)lds;
    float* RY = (float*)(P_WS + OFF_RY);
    constexpr int NB = T / 16;
    if (wid >= 4) {
        const int lt = tid - 256;
        int so[6]; const float* sp[6];
#pragma unroll
        for (int i = 0; i < 6; ++i) { const int idx = lt + 256 * i, step = idx / 96, rem = idx % 96, a = rem >> 4, q = rem & 15;
            so[i] = (step * 6 + a) * 64 + q * 4;
            const int ai = (0x205314 >> (4 * a)) & 0xf;
            sp[i] = (const float*)(P_WS + OFF_RR + (size_t)ai * SZ_R) + (size_t)step * 512 + hd * 64 + q * 4; }
        f32x4 r[6];
#pragma unroll
        for (int i = 0; i < 6; ++i) r[i] = *(const f32x4*)(sp[i]);
#pragma unroll
        for (int i = 0; i < 6; ++i) *(LAS f32x4*)(buf + so[i]) = r[i];
#pragma unroll
        for (int i = 0; i < 6; ++i) r[i] = *(const f32x4*)(sp[i] + (size_t)16 * 512);
        __syncthreads();
        for (int ib = 0; ib < NB; ++ib) {
            if (ib + 1 < NB) {
#pragma unroll
                for (int i = 0; i < 6; ++i) *(LAS f32x4*)(buf + ((ib + 1) & 1) * 6144 + so[i]) = r[i];
            }
            if (ib + 2 < NB) {
#pragma unroll
                for (int i = 0; i < 6; ++i) r[i] = *(const f32x4*)(sp[i] + (size_t)(ib + 2) * 16 * 512);
            }
            __syncthreads();
        }
    } else {
        const int vrow = rg * 16 + wid * 4 + (lane >> 4), kq = lane & 15;
        f32x4 S = {0.f, 0.f, 0.f, 0.f};
        __syncthreads();
        for (int ib = 0; ib < NB; ++ib) {
            const LAS float* bb = buf + (ib & 1) * 6144;
            float ykeep = 0.f;
#pragma unroll
            for (int s = 0; s < 16; ++s) {
                const LAS float* q = bb + s * 384;
                const f32x4 w4 = *(const LAS f32x4*)(q + kq * 4), k4 = *(const LAS f32x4*)(q + 64 + kq * 4), kk4 = *(const LAS f32x4*)(q + 128 + kq * 4),
                            b4 = *(const LAS f32x4*)(q + 192 + kq * 4), r4 = *(const LAS f32x4*)(q + 256 + kq * 4);
                const float vv = q[320 + vrow];
                float pd = (S[0] * kk4[0] + S[1] * kk4[1]) + (S[2] * kk4[2] + S[3] * kk4[3]);
                const f32x4 pre = S * w4 + vv * k4;
                pd = allreduce16(pd);
                S = pre - pd * b4;
                float y = (S[0] * r4[0] + S[1] * r4[1]) + (S[2] * r4[2] + S[3] * r4[3]);
                y = allreduce16(y);
                ykeep = (kq == s) ? y : ykeep;
            }
            RY[(size_t)(ib * 16 + kq) * 512 + hd * 64 + vrow] = ykeep;
            __syncthreads();
        }
    }
}

__device__ __forceinline__ void mlstm_seq(const Params& p, int mb, LAS unsigned char* lds) {
    const int tid = TIDX(), wid = tid >> 6, lane = tid & 63;
    const int h = mb >> 2, jv = mb & 3;
    LAS bh* Cbf = (LAS bh*)lds;
    constexpr int CS = 264;
    for (int i = tid; i < 2 * 64 * CS / 2; i += 512) ((LAS unsigned*)Cbf)[i] = 0u;
    __syncthreads();
    const bh* MQ = (const bh*)(P_WS + OFF_MQ); const bh* MKT = (const bh*)(P_WS + OFF_MKT); const bh* MVT = (const bh*)(P_WS + OFF_MVT);
    float* MINTER = (float*)(P_WS + OFF_ABF);
    const float* MBEND = (const float*)(P_WS + OFF_MBEND); const float* MLOC = (const float*)(P_WS + OFF_MLOC);
    f32x16 ct0, ct1;
#pragma unroll
    for (int i = 0; i < 16; ++i) { ct0[i] = 0.f; ct1[i] = 0.f; }
    float m = 0.f;
    const int mt = wid >> 1, nt0 = (wid & 1) * 2;
    for (int c = 0; c < NCH; ++c) {
        const int t0 = c * 64, cur = c & 1;
        const float bend = MBEND[h * NCH + c], mloc = MLOC[h * NCH + c];
        const float mnew = fmaxf(bend + m, mloc), decay = __expf(bend + m - mnew), scale = __expf(mloc - mnew);
        f32x4 r0 = {0.f, 0.f, 0.f, 0.f}, r1 = {0.f, 0.f, 0.f, 0.f};
        const bh* qp = MQ + (size_t)(t0 + mt * 16 + (lane & 15)) * 1024 + h * 256 + (lane >> 4) * 8;
        const LAS bh* cb = Cbf + cur * 64 * CS + (nt0 * 16 + (lane & 15)) * CS + (lane >> 4) * 8;
#pragma unroll
        for (int ks = 0; ks < 8; ++ks) { const bf16x8 a = *(const bf16x8*)(qp + ks * 32);
            const bf16x8 b0 = *(const LAS bf16x8*)(cb + ks * 32), b1 = *(const LAS bf16x8*)(cb + 16 * CS + ks * 32);
            r0 = MFMA16(a, b0, r0); r1 = MFMA16(a, b1, r1); }
        {   float* o = MINTER + (size_t)(t0 + mt * 16 + (lane >> 4) * 4) * 1024 + h * 256 + jv * 64 + nt0 * 16 + (lane & 15);
#pragma unroll
            for (int r = 0; r < 4; ++r) { o[(size_t)r * 1024] = r0[r]; o[(size_t)r * 1024 + 16] = r1[r]; } }
        f32x16 d0, d1;
#pragma unroll
        for (int i = 0; i < 16; ++i) { d0[i] = 0.f; d1[i] = 0.f; }
        const bh* kp = MKT + ((size_t)(h * NCH + c) * 256 + wid * 32 + (lane & 31)) * 64 + (lane >> 5) * 8;
        const bh* vp = MVT + ((size_t)(h * NCH + c) * 256 + jv * 64 + (lane & 31)) * 64 + (lane >> 5) * 8;
#pragma unroll
        for (int ks = 0; ks < 4; ++ks) { const bf16x8 a = *(const bf16x8*)(kp + ks * 16);
            const bf16x8 b0 = *(const bf16x8*)(vp + ks * 16), b1 = *(const bf16x8*)(vp + 32 * 64 + ks * 16);
            d0 = MFMA32(a, b0, d0); d1 = MFMA32(a, b1, d1); }
#pragma unroll
        for (int i = 0; i < 16; ++i) { ct0[i] = decay * ct0[i] + scale * d0[i]; ct1[i] = decay * ct1[i] + scale * d1[i]; }
        m = mnew;
        {   LAS bh* o0 = Cbf + (cur ^ 1) * 64 * CS + (lane & 31) * CS + wid * 32 + 4 * (lane >> 5);
#pragma unroll
            for (int g = 0; g < 4; ++g) { u32x2 w0, w1; w0.x = pk2(ct0[4 * g], ct0[4 * g + 1]); w0.y = pk2(ct0[4 * g + 2], ct0[4 * g + 3]); w1.x = pk2(ct1[4 * g], ct1[4 * g + 1]); w1.y = pk2(ct1[4 * g + 2], ct1[4 * g + 3]);
                *(LAS u32x2*)(o0 + 8 * g) = w0; *(LAS u32x2*)(o0 + 32 * CS + 8 * g) = w1; } }
        __syncthreads();
    }
}

__device__ __forceinline__ void mlstm_nscan(const Params& p) {
    const float* MBEND = (const float*)(P_WS + OFF_MBEND); const float* MLOC = (const float*)(P_WS + OFF_MLOC);
    const float* DN = (const float*)(P_WS + OFF_DN); float* NST = (float*)(P_WS + OFF_NST); float* MSTART = (float*)(P_WS + OFF_MSTART);
    for (int idx = TIDX(); idx < 1024; idx += 512) { const int h = idx >> 8, d = idx & 255; float m = 0.f, n = 0.f;
        for (int c = 0; c < NCH; ++c) { if (d == 0) MSTART[h * NCH + c] = m; NST[(size_t)(h * NCH + c) * 256 + d] = n;
            const float bend = MBEND[h * NCH + c], mloc = MLOC[h * NCH + c]; const float mnew = fmaxf(bend + m, mloc);
            n = __expf(bend + m - mnew) * n + __expf(mloc - mnew) * DN[(size_t)(h * NCH + c) * 256 + d]; m = mnew; } }
}

__device__ __forceinline__ float gelu_tanh(float x) { const float u = 0.7978845608028654f * (x + 0.044715f * x * x * x); return 0.5f * x * (1.0f + tanhf(u)); }

__device__ __forceinline__ void s5_pass_c(const Params& p, int L, int g, int c, int lane, LAS bh* img) {
    S5C k; s5_setup(p, L, g, lane, k);
    float sr = 0.f, si = 0.f;
    {   float pr = k.ar, pi = k.ai;
#pragma unroll
        for (int i = 0; i < 6; ++i) { const float nr = pr * pr - pi * pi, ni = 2.f * pr * pi; pr = nr; pi = ni; }
        const float* se = (const float*)(P_WS + OFF_SEND) + ((size_t)(g * NCH) * 64 + lane) * 2;
        for (int cc = 0; cc < c; ++cc) { const float er = se[(size_t)cc * 128], ei = se[(size_t)cc * 128 + 1];
            const float nr = pr * sr - pi * si + er, ni = pr * si + pi * sr + ei; sr = nr; si = ni; } }
    const int gi = L * 32 + g;
    bf16x8 bfr[4];
    {   const int pp = lane & 15; const float* cre = P_IN(24) + ((size_t)gi * 16 + pp) * 64; const float* cim = P_IN(25) + ((size_t)gi * 16 + pp) * 64;
#pragma unroll
        for (int ks = 0; ks < 4; ++ks)
#pragma unroll
            for (int j = 0; j < 8; ++j) { const int n2 = ks * 32 + (lane >> 4) * 8 + j; const float v = (n2 < 64) ? cre[n2] : -cim[n2 - 64]; bfr[ks][j] = (short)f2bf(v); } }
    const float dco = P_IN(26)[L * 512 + g * 16 + (lane & 15)];
    const float* zf = (const float*)(P_WS + OFF_ZF) + (size_t)(c * 64) * ZF_LD + ZS0 + g * 16;
    bh* YS = (bh*)(P_WS + OFF_YS);
    for (int half = 0; half < 2; ++half) {
        for (int s = 0; s < 32; ++s) { s5_step(k, zf + (size_t)(half * 32 + s) * ZF_LD, sr, si); img[s * 136 + lane] = f2bf(sr); img[s * 136 + 64 + lane] = f2bf(si); }
        asm volatile("s_waitcnt lgkmcnt(0)" ::: "memory"); __builtin_amdgcn_wave_barrier();
#pragma unroll
        for (int mt = 0; mt < 2; ++mt) { f32x4 acc = {0.f, 0.f, 0.f, 0.f};
#pragma unroll
            for (int ks = 0; ks < 4; ++ks) { const bf16x8 a = *(const LAS bf16x8*)(img + (mt * 16 + (lane & 15)) * 136 + ks * 32 + (lane >> 4) * 8); acc = MFMA16(a, bfr[ks], acc); }
#pragma unroll
            for (int r = 0; r < 4; ++r) { const int tt = half * 32 + mt * 16 + (lane >> 4) * 4 + r; const float uv = zf[(size_t)tt * ZF_LD + (lane & 15)];
                YS[(size_t)(c * 64 + tt) * 512 + g * 16 + (lane & 15)] = f2bf(gelu_tanh(acc[r] + dco * uv)); } }
        asm volatile("s_waitcnt lgkmcnt(0)" ::: "memory"); __builtin_amdgcn_wave_barrier();
    }
}

__device__ __forceinline__ void phase_scan(const Params& p, int L, LAS unsigned char* lds) {
    const int b = BIDX();
    if (b < 32) rwkv_scan(p, b, lds);
    else if (b < 48) mlstm_seq(p, b - 32, lds);
    else if (b == 48) mlstm_nscan(p);
    else { const int wid = TIDX() >> 6, lane = TIDX() & 63; const int nw = (GDIM() - 49) * 8;
        for (int w = (b - 49) * 8 + wid; w < 32 * NCH; w += nw) s5_pass_c(p, L, w >> 7, w & 127, lane, (LAS bh*)lds + wid * (32 * 136)); }
}

__device__ __forceinline__ void mlstm_out(const Params& p, int L, int h, int c, LAS unsigned char* lds) {
    const int tid = TIDX(), wid = tid >> 6, lane = tid & 63, t0 = c * 64;
    LAS bh* Pl = (LAS bh*)lds;
    LAS float* s_b = (LAS float*)(lds + 9216); LAS float* s_a = s_b + 64; LAS float* s_mt = s_a + 64; LAS float* s_iw = s_mt + 64; LAS float* s_den = s_iw + 64; LAS float* s_qn = s_den + 64; LAS float* s_part = s_qn + 64;
    const bh* MQ = (const bh*)(P_WS + OFF_MQ); const bh* MK = (const bh*)(P_WS + OFF_MK); const bh* MVT = (const bh*)(P_WS + OFF_MVT);
    const float* MINTER = (const float*)(P_WS + OFF_ABF);
    const float m0 = ((const float*)(P_WS + OFF_MSTART))[h * NCH + c];
    if (tid < 64) { const float ig = ((const float*)(P_WS + OFF_MI))[h * T + t0 + tid], b = ((const float*)(P_WS + OFF_MBB))[h * T + t0 + tid];
        const float a = ig - b; float cm = a;
#pragma unroll
        for (int o = 1; o < 64; o <<= 1) { const float nb = __shfl_up(cm, o); if (tid >= o) cm = fmaxf(cm, nb); }
        const float mt = b + fmaxf(m0, cm);
        s_b[tid] = b; s_a[tid] = a; s_mt[tid] = mt; s_iw[tid] = __expf(b + m0 - mt); }
    __syncthreads();
    {
        const int mt = wid >> 1, nt0 = (wid & 1) * 2;
        f32x4 r0 = {0.f, 0.f, 0.f, 0.f}, r1 = {0.f, 0.f, 0.f, 0.f};
        const bh* qp = MQ + (size_t)(t0 + mt * 16 + (lane & 15)) * 1024 + h * 256 + (lane >> 4) * 8;
        const bh* kp = MK + (size_t)(t0 + nt0 * 16 + (lane & 15)) * 1024 + h * 256 + (lane >> 4) * 8;
#pragma unroll
        for (int ks = 0; ks < 8; ++ks) { const bf16x8 a = *(const bf16x8*)(qp + ks * 32); const bf16x8 b0 = *(const bf16x8*)(kp + ks * 32), b1 = *(const bf16x8*)(kp + (size_t)16 * 1024 + ks * 32);
            r0 = MFMA16(a, b0, r0); r1 = MFMA16(a, b1, r1); }
#pragma unroll
        for (int r = 0; r < 4; ++r) { const int t = mt * 16 + (lane >> 4) * 4 + r; const float bt = s_b[t] - s_mt[t];
            { const int s = nt0 * 16 + (lane & 15); const float pv = (s <= t) ? r0[r] * __expf(bt + s_a[s]) : 0.f; Pl[t * 72 + s] = f2bf(pv); }
            { const int s = nt0 * 16 + 16 + (lane & 15); const float pv = (s <= t) ? r1[r] * __expf(bt + s_a[s]) : 0.f; Pl[t * 72 + s] = f2bf(pv); } }
    }
    __syncthreads();
    if (tid < 64) { float s = 0.f;
#pragma unroll
        for (int q = 0; q < 8; ++q) { const u32x4 w = *(const LAS u32x4*)(Pl + tid * 72 + q * 8);
            s += __uint_as_float(w.x << 16) + __uint_as_float(w.x & 0xffff0000u) + __uint_as_float(w.y << 16) + __uint_as_float(w.y & 0xffff0000u)
               + __uint_as_float(w.z << 16) + __uint_as_float(w.z & 0xffff0000u) + __uint_as_float(w.w << 16) + __uint_as_float(w.w & 0xffff0000u); }
        s_den[tid] = s; }
    {
        const float* nst = (const float*)(P_WS + OFF_NST) + (size_t)(h * NCH + c) * 256 + lane * 4; const f32x4 nv = *(const f32x4*)nst;
#pragma unroll
        for (int i = 0; i < 8; ++i) { const int t = wid * 8 + i; const u32x2 q2 = *(const u32x2*)(MQ + (size_t)(t0 + t) * 1024 + h * 256 + lane * 4);
            float s = __uint_as_float(q2.x << 16) * nv[0] + __uint_as_float(q2.x & 0xffff0000u) * nv[1] + __uint_as_float(q2.y << 16) * nv[2] + __uint_as_float(q2.y & 0xffff0000u) * nv[3];
            s = wave_sum(s); if (lane == 0) s_qn[t] = s; } }
    f32x4 acc[4][2];
#pragma unroll
    for (int a = 0; a < 4; ++a) { acc[a][0] = (f32x4){0.f, 0.f, 0.f, 0.f}; acc[a][1] = (f32x4){0.f, 0.f, 0.f, 0.f}; }
    {   const bh* vp = MVT + ((size_t)(h * NCH + c) * 256 + wid * 32 + (lane & 15)) * 64 + (lane >> 4) * 8;
#pragma unroll
        for (int ks = 0; ks < 2; ++ks) { const bf16x8 b0 = *(const bf16x8*)(vp + ks * 32), b1 = *(const bf16x8*)(vp + 16 * 64 + ks * 32);
#pragma unroll
            for (int a = 0; a < 4; ++a) { const bf16x8 av = *(const LAS bf16x8*)(Pl + (a * 16 + (lane & 15)) * 72 + ks * 32 + (lane >> 4) * 8);
                acc[a][0] = MFMA16(av, b0, acc[a][0]); acc[a][1] = MFMA16(av, b1, acc[a][1]); } } }
    __syncthreads();
#pragma unroll
    for (int a = 0; a < 4; ++a)
#pragma unroll
        for (int r = 0; r < 4; ++r) { const int t = a * 16 + (lane >> 4) * 4 + r; const float iw = s_iw[t];
            const float den = s_den[t] + iw * s_qn[t]; const float dd = 1.0f / fmaxf(fabsf(den), __expf(-s_mt[t]));
            const float* mi = MINTER + (size_t)(t0 + t) * 1024 + h * 256 + wid * 32 + (lane & 15);
            const float h0 = (acc[a][0][r] + iw * mi[0]) * dd, h1 = (acc[a][1][r] + iw * mi[16]) * dd;
            acc[a][0][r] = h0; acc[a][1][r] = h1;
            float ss = h0 * h0 + h1 * h1;
            ss += __shfl_xor(ss, 1); ss += __shfl_xor(ss, 2); ss += __shfl_xor(ss, 4); ss += __shfl_xor(ss, 8);
            if ((lane & 15) == 0) s_part[wid * 64 + t] = ss; }
    __syncthreads();
    {   const float* zf = (const float*)(P_WS + OFF_ZF); const float* ng = P_IN(7) + L * 1024 + h * 256; bh* YC = (bh*)(P_WS + OFF_YCAT);
#pragma unroll
        for (int a = 0; a < 4; ++a)
#pragma unroll
            for (int r = 0; r < 4; ++r) { const int t = a * 16 + (lane >> 4) * 4 + r;
                float tot = 0.f;
#pragma unroll
                for (int w = 0; w < 8; ++w) tot += s_part[w * 64 + t];
                const float rstd = rsqrtf(tot * (1.0f / 256.0f) + 1e-6f);
                const int v0 = wid * 32 + (lane & 15);
                const float* op = zf + (size_t)(t0 + t) * ZF_LD + 3072 + h * 256 + v0;
                bh* yo = YC + (size_t)(t0 + t) * D + h * 256 + v0;
                yo[0] = f2bf(sigmoidf_(op[0]) * acc[a][0][r] * rstd * ng[v0]);
                yo[16] = f2bf(sigmoidf_(op[16]) * acc[a][1][r] * rstd * ng[v0 + 16]); } }
    __syncthreads();
}

__device__ __forceinline__ void rwkv_post_token(const Params& p, int L, int t, int lane) {
    const float* RY = (const float*)(P_WS + OFF_RY) + (size_t)t * 512; const float* RR = (const float*)(P_WS + OFF_RR) + (size_t)t * 512; const float* RK = (const float*)(P_WS + OFF_RK) + (size_t)t * 512;
    const float* RV = (const float*)(P_WS + OFF_RV) + (size_t)t * 512; const float* RG = (const float*)(P_WS + OFF_RG) + (size_t)t * 512;
    const float* rkw = P_IN(16) + L * 512; const float* lg = P_IN(17) + L * 512; const float* lb = P_IN(18) + L * 512;
    bh* yo = (bh*)(P_WS + OFF_YCAT) + (size_t)t * D + 1024;
#pragma unroll
    for (int i = 0; i < 8; ++i) { const int c = i * 64 + lane;
        const float y = RY[c]; const float mu = wave_sum(y) * (1.0f / 64.0f); const float dlt = y - mu; const float var = wave_sum(dlt * dlt) * (1.0f / 64.0f);
        const float yn = dlt * rsqrtf(var + 64e-5f) * lg[c] + lb[c];
        const float bon = wave_sum(RR[c] * RK[c] * rkw[c]) * RV[c];
        yo[c] = f2bf((yn + bon) * RG[c]); }
}

__device__ __forceinline__ void phase_post(const Params& p, int L, LAS unsigned char* lds) {
    const int wid = TIDX() >> 6, lane = TIDX() & 63;
    for (int it = BIDX(); it < 1536; it += GDIM()) {
        if (it < 512) mlstm_out(p, L, it >> 7, it & 127, lds);
        else rwkv_post_token(p, L, (it - 512) * 8 + wid, lane);
    }
    __syncthreads();
}

constexpr int NPHASE = 27;
__global__ void __launch_bounds__(512, 2) hybrid_fwd(Params p, int ph_lo, int ph_hi) {
    extern __shared__ __attribute__((aligned(16))) unsigned char smem_raw[];
    LAS unsigned char* lds = (LAS unsigned char*)smem_raw;
    cg::grid_group grid = cg::this_grid();
    for (int ph = ph_lo; ph < ph_hi; ++ph) {
        if (ph > ph_lo) grid.sync();
        if (ph == 26) {
            const int gw = BIDX() * 8 + (TIDX() >> 6), NGW = GDIM() * 8, lane = TIDX() & 63;
            for (int r = gw; r < T; r += NGW) { float* x = P_OUT + (size_t)r * D; f32x4 v[8]; float s = 0.f;
#pragma unroll
                for (int j = 0; j < 8; ++j) { v[j] = *(const f32x4*)(x + j * 256 + lane * 4); s += (v[j][0] * v[j][0] + v[j][1] * v[j][1]) + (v[j][2] * v[j][2] + v[j][3] * v[j][3]); }
                const float rstd = rsqrtf(wave_sum(s) * (1.0f / D) + 1e-6f);
#pragma unroll
                for (int j = 0; j < 8; ++j) { const f32x4 gg = *(const f32x4*)(P_IN(40) + j * 256 + lane * 4); *(f32x4*)(x + j * 256 + lane * 4) = v[j] * rstd * gg; } }
            continue;
        }
        const int L = ph / 13, q = ph % 13;
#ifdef ONLY_Q
        if (q != ONLY_Q) continue;
#endif
        switch (q) {
        case 0: phase_conv(p, L, lds); break;
        case 2: phase_prep(p, L, lds); break;
        case 4: phase_scan(p, L, lds); break;
        case 5: phase_post(p, L, lds); break;
        case 8: phase_rmsnorm(p, P_IN(33) + (size_t)L * D); break;
        case 11: phase_rmsnorm(p, P_IN(37) + (size_t)L * D); break;
        default: break;
        }
        for (int i = 0; i < 3; ++i) {
            pg8::Gemm g;
            if (!make_gemm(p, L, q, i, g)) break;
            pg8::StaticOrder S; S.init(T, g.N, GDIM(), BIDX());
            pg8::gemm_phase(lds, g, S);
        }
    }
}

extern "C" void kernel_launch(void* const* d_in, const int* in_sizes, int n_in, void* d_out, int out_size, void* d_ws, size_t ws_size, hipStream_t stream) {
    constexpr size_t kDynLds = 131072;
    static int grid_blocks = 0;
    if (!grid_blocks) {
        int dev = 0, cus = 0, per_cu = 0;
        (void)hipGetDevice(&dev);
        (void)hipDeviceGetAttribute(&cus, hipDeviceAttributeMultiprocessorCount, dev);
        (void)hipFuncSetAttribute((const void*)hybrid_fwd, hipFuncAttributeMaxDynamicSharedMemorySize, (int)kDynLds);
        (void)hipOccupancyMaxActiveBlocksPerMultiprocessor(&per_cu, hybrid_fwd, 512, kDynLds);
        if (per_cu > 1) per_cu = 1;
        grid_blocks = cus * per_cu;
        if (ws_size < WS_TOTAL) fprintf(stderr, "workspace too small: %zu < %zu\n", ws_size, (size_t)WS_TOTAL);
    }
    Params p{};
    for (int i = 0; i < 41; ++i) p.in[i] = (const float*)d_in[i];
    p.out = (float*)d_out; p.ws = (unsigned char*)d_ws;
#if SINGLE_LAUNCH
    int lo = 0, hi = NPHASE;
    void* args[] = {&p, &lo, &hi};
    hipError_t e = hipLaunchCooperativeKernel((const void*)hybrid_fwd, dim3(grid_blocks), dim3(512), args, kDynLds, stream);
    if (e != hipSuccess) fprintf(stderr, "cooperative launch failed: %s (grid %d)\n", hipGetErrorString(e), grid_blocks);
#else
    for (int ph = 0; ph < NPHASE; ++ph) {
        int lo = ph, hi = ph + 1;
        void* args[] = {&p, &lo, &hi};
        hipError_t e = hipLaunchCooperativeKernel((const void*)hybrid_fwd, dim3(grid_blocks), dim3(512), args, kDynLds, stream);
        if (e != hipSuccess) fprintf(stderr, "cooperative launch failed: %s (grid %d)\n", hipGetErrorString(e), grid_blocks);
    }
#endif
}
```

```cpp
#include <hip/hip_runtime.h>
#include <hip/hip_cooperative_groups.h>
#include <cstdio>
#include <cstdint>
namespace cg = cooperative_groups;

#define LAS __attribute__((address_space(3)))
typedef unsigned short bh;
typedef short bf16x8 __attribute__((ext_vector_type(8)));
typedef float f32x4 __attribute__((ext_vector_type(4)));
typedef float f32x16 __attribute__((ext_vector_type(16)));
typedef unsigned u32x4 __attribute__((ext_vector_type(4)));
typedef unsigned u32x2 __attribute__((ext_vector_type(2)));

#ifndef PROBE_REP_Q
#define PROBE_REP_Q (-1)
#endif
#ifndef SINGLE_LAUNCH
#define SINGLE_LAUNCH 1
#endif

constexpr int T = 8192, D = 2048, FH = 5632;
constexpr int NIN = 12744, NGATE = 6144, NF = 6600, ZF_LD = 6656, NINP = 12800;
constexpr int ZR0 = 4104, ZS0 = 6088;
constexpr int NCH = 128;

constexpr size_t AL(size_t x) { return (x + 255) & ~(size_t)255; }
constexpr size_t SZ_WIN = (size_t)NINP * D * 2, SZ_SQ = (size_t)D * D * 2, SZ_WGU = (size_t)2 * FH * D * 2, SZ_WD = (size_t)D * FH * 2;
constexpr size_t OFF_WIN = 0;
constexpr size_t OFF_WUP = OFF_WIN + SZ_WIN;
constexpr size_t OFF_WO = OFF_WUP + SZ_SQ;
constexpr size_t OFF_WGU = OFF_WO + SZ_SQ;
constexpr size_t OFF_WD = OFF_WGU + SZ_WGU;
constexpr size_t OFF_WPG = OFF_WD + SZ_WD;
constexpr size_t OFF_WPP = OFF_WPG + SZ_SQ;
constexpr size_t OFF_WGLU = OFF_WPP + (size_t)D * 256 * 2;
constexpr size_t OFF_WW2 = OFF_WGLU + (size_t)512 * 512 * 2;
constexpr size_t OFF_WA2 = OFF_WW2 + (size_t)512 * 256 * 2;
constexpr size_t OFF_WG2 = OFF_WA2 + (size_t)512 * 256 * 2;
constexpr size_t OFF_PBF = OFF_WG2 + (size_t)512 * 256 * 2;
constexpr size_t OFF_ABF = OFF_PBF + (size_t)2 * T * 256 * 2;
constexpr size_t OFF_YCAT = OFF_ABF + (size_t)T * D * 2;
constexpr size_t OFF_ZF = OFF_YCAT + (size_t)T * D * 2;
constexpr size_t OFF_ACT = OFF_ZF;
constexpr size_t OFF_MIX32 = OFF_ZF + (size_t)100663296;
constexpr size_t OFF_ZG = OFF_ZF + (size_t)T * ZF_LD * 4;
constexpr size_t SZ_R = (size_t)T * 512 * 4;
constexpr size_t OFF_RR = OFF_ZG + (size_t)T * NGATE * 2;
constexpr size_t OFF_RK = OFF_RR + SZ_R, OFF_RV = OFF_RK + SZ_R, OFF_RKK = OFF_RV + SZ_R, OFF_RW = OFF_RKK + SZ_R, OFF_RB = OFF_RW + SZ_R, OFF_RG = OFF_RB + SZ_R, OFF_RY = OFF_RG + SZ_R;
constexpr size_t OFF_LAW = OFF_RY + SZ_R;
constexpr size_t OFF_LAA = OFF_LAW + (size_t)T * 256 * 2, OFF_LAG = OFF_LAA + (size_t)T * 256 * 2;
constexpr size_t SZ_MB = (size_t)T * 1024 * 2;
constexpr size_t OFF_MQ = OFF_LAG + (size_t)T * 256 * 2, OFF_MK = OFF_MQ + SZ_MB, OFF_MKT = OFF_MK + SZ_MB, OFF_MVT = OFF_MKT + SZ_MB;
constexpr size_t OFF_MI = OFF_MVT + SZ_MB;
constexpr size_t OFF_MBB = OFF_MI + (size_t)4 * T * 4;
constexpr size_t OFF_MBEND = OFF_MBB + (size_t)4 * T * 4;
constexpr size_t OFF_MLOC = OFF_MBEND + 2048, OFF_MSTART = OFF_MLOC + 2048;
constexpr size_t OFF_DN = OFF_MSTART + 2048;
constexpr size_t OFF_NST = OFF_DN + (size_t)4 * NCH * 256 * 4;
constexpr size_t OFF_SEND = OFF_NST + (size_t)4 * NCH * 256 * 4;
constexpr size_t OFF_YS = OFF_SEND + (size_t)32 * NCH * 64 * 8;
constexpr size_t OFF_RZ = OFF_YS + (size_t)T * 512 * 2;
constexpr size_t OFF_RSEND = OFF_RZ + SZ_R;
constexpr size_t OFF_RPEND = OFF_RSEND + (size_t)8 * 4 * 4096 * 4;
constexpr size_t WS_TOTAL = OFF_RPEND + (size_t)8 * 4 * 4096 * 4;

struct Params { const float* in[41]; float* out; unsigned char* ws; };
#define KARG4 __attribute__((address_space(4)))
__device__ __forceinline__ const float* karg_in(int i) { const KARG4 char* ka = (const KARG4 char*)__builtin_amdgcn_kernarg_segment_ptr(); return *(const float* const volatile KARG4*)(ka + (size_t)i * 8); }
#define P_IN(i) karg_in(i)
#define P_OUT ((float*)karg_in(41))
#define P_WS ((unsigned char*)karg_in(42))

__device__ __forceinline__ int TIDX() { int t = threadIdx.x; asm volatile("" : "+v"(t)); return t; }
__device__ __forceinline__ int BIDX() { int t = blockIdx.x; asm volatile("" : "+s"(t)); return t; }
__device__ __forceinline__ int GDIM() { int t = gridDim.x; asm volatile("" : "+s"(t)); return t; }
__device__ __forceinline__ bh f2bf(float f) { unsigned u = __float_as_uint(f); u += 0x7fffu + ((u >> 16) & 1u); return (bh)(u >> 16); }
__device__ __forceinline__ float bf2f(bh h) { return __uint_as_float(((unsigned)h) << 16); }
__device__ __forceinline__ unsigned pk2(float lo, float hi) { return (unsigned)f2bf(lo) | ((unsigned)f2bf(hi) << 16); }
__device__ __forceinline__ float sigmoidf_(float x) { return 1.0f / (1.0f + __expf(-x)); }
__device__ __forceinline__ float wave_sum(float v) {
#pragma unroll
    for (int o = 32; o >= 1; o >>= 1) v += __shfl_xor(v, o);
    return v;
}
__device__ __forceinline__ float wave_max(float v) {
#pragma unroll
    for (int o = 32; o >= 1; o >>= 1) v = fmaxf(v, __shfl_xor(v, o));
    return v;
}
template <int CTRL> __device__ __forceinline__ float dpp_f(float x) {
    return __builtin_bit_cast(float, __builtin_amdgcn_update_dpp(0, __builtin_bit_cast(int, x), CTRL, 0xf, 0xf, true));
}
__device__ __forceinline__ float allreduce16(float x) {
    x += dpp_f<0xB1>(x); x += dpp_f<0x4E>(x); x += dpp_f<0x141>(x); x += dpp_f<0x140>(x);
    return x;
}
#define MFMA16(a, b, c) __builtin_amdgcn_mfma_f32_16x16x32_bf16(a, b, c, 0, 0, 0)
#define MFMA32(a, b, c) __builtin_amdgcn_mfma_f32_32x32x16_bf16(a, b, c, 0, 0, 0)

namespace pg8 {
constexpr int BM = 256, BK = 64, HALF = 128, HTB = HALF * BK * 2, STAGE_BYTES = 8 * HTB, NXCD = 8, WGM = 8;
__device__ __forceinline__ int lds_byte(int r, int c) { const int st = (r >> 4) * 2 + (c >> 5), rr = r & 15, cc = c & 31, ob = rr * 64 + cc * 2; return st * 1024 + (ob ^ (((ob >> 9) & 1) << 5)); }
__device__ __forceinline__ void stage_rc(int b, int& R, int& C) { const int st = b / 1024, sb = b % 1024, swz = sb ^ (((sb >> 9) & 1) << 5); R = (st >> 1) * 16 + swz / 64; C = (st & 1) * 32 + (swz % 64) / 2; }
__device__ __forceinline__ int perm32(int rho) { const int n = rho >> 4, i = rho & 15; return 8 * (i >> 2) + 4 * n + (i & 3); }
struct Unit { int pm, pn; };
struct Gemm { const bh* A; const bh* Bt; int M, N, K, lda, ldb, epi, perm; const void* p0; const void* p1; const void* p2; void* o0; void* o1; };
struct StaticOrder {
    int nM, nN, nwg, G, c;
    __device__ void init(int M, int N, int G_, int c_) { nM = M / BM; nN = N / BM; nwg = nM * nN; G = G_; c = c_; }
    __device__ bool next(int i, Unit& u) const {
        const long L = (long)i * G + c; if (L >= nwg) return false;
        int wgid = (int)L; { const int q = nwg / NXCD, r = nwg % NXCD, xcd = wgid % NXCD, off = wgid / NXCD; wgid = (xcd < r ? xcd * (q + 1) : r * (q + 1) + (xcd - r) * q) + off; }
        const int nig = WGM * nN, gid = wgid / nig, fm = gid * WGM, gsz = (nM - fm) < WGM ? (nM - fm) : WGM;
        u.pm = fm + ((wgid % nig) % gsz); u.pn = (wgid % nig) / gsz; return true;
    }
};
__device__ __forceinline__ unsigned cvt_pk_bf16(float lo, float hi) { unsigned r; asm volatile("v_cvt_pk_bf16_f32 %0, %1, %2" : "=v"(r) : "v"(lo), "v"(hi)); return r; }

__device__ __forceinline__ void epi_run(const Gemm& g, const f32x4 (&acc)[2][2][4][2], const Unit& u, int wr, int wc, int fr, int fq);
__device__ __forceinline__ void gemm_phase(LAS unsigned char* lds, const Gemm& g, const StaticOrder& S) {
    const int tid = TIDX(), wid = __builtin_amdgcn_readfirstlane(tid >> 6), lane = tid & 63, wr = wid >> 2, wc = wid & 3, fr = lane & 15, fq = lane >> 4;
    const int K = g.K, nt = K / BK;
    unsigned voffA[2], voffB[2];
#pragma unroll
    for (int i = 0; i < 2; ++i) { int R, C; stage_rc(tid * 16 + i * 8192, R, C); const int Rb = g.perm ? ((R & ~31) + perm32(R & 31)) : R;
        voffA[i] = (unsigned)(R * g.lda + C) * 2u; voffB[i] = (unsigned)(Rb * g.ldb + C) * 2u; }
    const size_t kstep = (size_t)(BK * 2);
    const size_t hstepA = (size_t)HALF * g.lda * 2, hstepB = (size_t)HALF * g.ldb * 2;
    const size_t tstepA = 2 * hstepA, tstepB = 2 * hstepB;
    const unsigned ldsw = (unsigned)wid * 1024u;
    const int aoff = lds_byte(wr * 64 + fr, fq * 8), boff = lds_byte(wc * 32 + fr, fq * 8);
#define PG8_SA(b, h) (((b) * 2 + (h)) * HTB)
#define PG8_SB(b, h) ((4 + (b) * 2 + (h)) * HTB)
#define PG8_STAGE(bufoff, gbase, voff) do { _Pragma("unroll") for (int _i = 0; _i < 2; ++_i) \
        __builtin_amdgcn_global_load_lds((const unsigned*)((const char*)(gbase) + (voff)[_i]), (LAS unsigned*)(lds + (bufoff) + ldsw + _i * 8192), 16, 0, 0); } while (0)
#define PG8_LDA(dst, b, h) do { _Pragma("unroll") for (int m = 0; m < 4; ++m) _Pragma("unroll") for (int k = 0; k < 2; ++k) dst[m][k] = *(const LAS bf16x8*)(lds + PG8_SA(b, h) + aoff + m * 2048 + k * 1024); } while (0)
#define PG8_LDB(dst, b, h) do { _Pragma("unroll") for (int n = 0; n < 2; ++n) _Pragma("unroll") for (int k = 0; k < 2; ++k) dst[n][k] = *(const LAS bf16x8*)(lds + PG8_SB(b, h) + boff + n * 2048 + k * 1024); } while (0)
#define PG8_MMA(ai, bj, At, Bt) do { __builtin_amdgcn_s_setprio(1); _Pragma("unroll") for (int m = 0; m < 4; ++m) _Pragma("unroll") for (int n = 0; n < 2; ++n) _Pragma("unroll") for (int k = 0; k < 2; ++k) \
        acc[ai][bj][m][n] = __builtin_amdgcn_mfma_f32_16x16x32_bf16(Bt[n][k], At[m][k], acc[ai][bj][m][n], 0, 0, 0); __builtin_amdgcn_s_setprio(0); } while (0)
#define PG8_WAIT_V(n) asm volatile("s_waitcnt vmcnt(" #n ")" ::: "memory")
#define PG8_WAIT_L(n) asm volatile("s_waitcnt lgkmcnt(" #n ")" ::: "memory")
#define PG8_BAR __builtin_amdgcn_s_barrier()
#define PG8_SCHED __builtin_amdgcn_sched_barrier(0)
    Unit cur, nxt; int ui = 0;
    if (!S.next(0, cur)) return;
    f32x4 acc[2][2][4][2];
#pragma unroll
    for (int a = 0; a < 2; ++a)
#pragma unroll
        for (int b = 0; b < 2; ++b)
#pragma unroll
            for (int m = 0; m < 4; ++m)
#pragma unroll
                for (int n = 0; n < 2; ++n) acc[a][b][m][n] = (f32x4){0.f, 0.f, 0.f, 0.f};
    bf16x8 At[4][2], B0[2][2], B1[2][2];
    const char* cA = (const char*)g.A + (size_t)cur.pm * tstepA; const char* cB = (const char*)g.Bt + (size_t)cur.pn * tstepB;
    PG8_STAGE(PG8_SB(0, 0), cB, voffB); PG8_STAGE(PG8_SA(0, 0), cA, voffA); PG8_STAGE(PG8_SB(0, 1), cB + hstepB, voffB); PG8_STAGE(PG8_SA(0, 1), cA + hstepA, voffA);
    if (wr == 1) PG8_BAR;
    PG8_WAIT_V(4); PG8_BAR;
    PG8_STAGE(PG8_SB(1, 0), cB + kstep, voffB); PG8_STAGE(PG8_SA(1, 0), cA + kstep, voffA); PG8_STAGE(PG8_SB(1, 1), cB + hstepB + kstep, voffB);
    PG8_WAIT_V(6); PG8_BAR;
    for (;;) {
        const bool has_next = S.next(ui + 1, nxt);
        const char* nA = has_next ? (const char*)g.A + (size_t)nxt.pm * tstepA : cA; const char* nB = has_next ? (const char*)g.Bt + (size_t)nxt.pn * tstepB : cB;
        for (int t = 0; t < nt; t += 2) {
            const bool last = (t == nt - 2);
            const char* a1 = cA + (size_t)(t + 1) * kstep;
            const char* a2 = last ? nA : cA + (size_t)(t + 2) * kstep; const char* b2 = last ? nB : cB + (size_t)(t + 2) * kstep;
            const char* a3 = a2 + kstep; const char* b3 = b2 + kstep;
            PG8_LDB(B0, 0, 0); PG8_SCHED; PG8_LDA(At, 0, 0); PG8_STAGE(PG8_SA(1, 1), a1 + hstepA, voffA);
            PG8_WAIT_L(8); PG8_BAR; PG8_WAIT_L(0); PG8_MMA(0, 0, At, B0); PG8_BAR; PG8_SCHED;
            PG8_LDB(B1, 0, 1); PG8_STAGE(PG8_SB(0, 0), b2, voffB);
            PG8_BAR; PG8_WAIT_L(0); PG8_MMA(0, 1, At, B1); PG8_BAR;
            PG8_LDA(At, 0, 1); PG8_STAGE(PG8_SA(0, 0), a2, voffA);
            PG8_BAR; PG8_WAIT_L(0); PG8_MMA(1, 0, At, B0); PG8_BAR; PG8_SCHED;
            PG8_STAGE(PG8_SB(0, 1), b2 + hstepB, voffB);
            PG8_WAIT_V(6); PG8_BAR; PG8_MMA(1, 1, At, B1); PG8_BAR;
            PG8_LDB(B0, 1, 0); PG8_SCHED; PG8_LDA(At, 1, 0); PG8_STAGE(PG8_SA(0, 1), a2 + hstepA, voffA);
            PG8_WAIT_L(8); PG8_BAR; PG8_WAIT_L(0); PG8_MMA(0, 0, At, B0); PG8_BAR; PG8_SCHED;
            PG8_LDB(B1, 1, 1); PG8_STAGE(PG8_SB(1, 0), b3, voffB);
            PG8_BAR; PG8_WAIT_L(0); PG8_MMA(0, 1, At, B1); PG8_BAR;
            PG8_LDA(At, 1, 1); PG8_STAGE(PG8_SA(1, 0), a3, voffA);
            PG8_BAR; PG8_WAIT_L(0); PG8_MMA(1, 0, At, B0); PG8_BAR; PG8_SCHED;
            PG8_STAGE(PG8_SB(1, 1), b3 + hstepB, voffB);
            PG8_WAIT_V(6); PG8_BAR; PG8_MMA(1, 1, At, B1); PG8_BAR;
        }
        epi_run(g, acc, cur, wr, wc, fr, fq);
        if (!has_next) break;
#pragma unroll
        for (int a = 0; a < 2; ++a)
#pragma unroll
            for (int b = 0; b < 2; ++b)
#pragma unroll
                for (int m = 0; m < 4; ++m)
#pragma unroll
                    for (int n = 0; n < 2; ++n) acc[a][b][m][n] = (f32x4){0.f, 0.f, 0.f, 0.f};
        cur = nxt; cA = nA; cB = nB; ++ui;
    }
    PG8_WAIT_V(0);
    if (wr == 0) PG8_BAR;
    PG8_BAR;
#undef PG8_SA
#undef PG8_SB
#undef PG8_STAGE
#undef PG8_LDA
#undef PG8_LDB
#undef PG8_MMA
#undef PG8_WAIT_V
#undef PG8_WAIT_L
#undef PG8_BAR
#undef PG8_SCHED
}
}
using pg8::Unit;
using pg8::cvt_pk_bf16;

#define EPI_FOR_NP(...) \
    _Pragma("unroll") for (int ai = 0; ai < 2; ++ai) _Pragma("unroll") for (int m = 0; m < 4; ++m) { const int row = u.pm * 256 + ai * 128 + wr * 64 + m * 16 + fr; \
    _Pragma("unroll") for (int bj = 0; bj < 2; ++bj) _Pragma("unroll") for (int n = 0; n < 2; ++n) { const int col = u.pn * 256 + bj * 128 + wc * 32 + n * 16 + 4 * fq; const f32x4 v = acc[ai][bj][m][n]; __VA_ARGS__ } }

typedef const f32x4 (&AccRef)[2][2][4][2];

struct EpiWin {
    static constexpr bool PERM = false;
    bh* zg; float* zf;
    __device__ __forceinline__ void operator()(AccRef acc, const Unit& u, int wr, int wc, int fr, int fq) const {
        if (u.pn < 24) {
            EPI_FOR_NP({ u32x2 w; w.x = cvt_pk_bf16(sigmoidf_(v[0]), sigmoidf_(v[1])); w.y = cvt_pk_bf16(sigmoidf_(v[2]), sigmoidf_(v[3])); *(u32x2*)(zg + (size_t)row * NGATE + col) = w; })
        } else {
            EPI_FOR_NP({ *(f32x4*)(zf + (size_t)row * ZF_LD + (col - NGATE)) = v; })
        }
    }
};
struct EpiLoraW {
    static constexpr bool PERM = false;
    const float* w0; float* rw;
    __device__ __forceinline__ void operator()(AccRef acc, const Unit& u, int wr, int wc, int fr, int fq) const {
        EPI_FOR_NP({ const f32x4 b = *(const f32x4*)(w0 + col); f32x4 o;
            _Pragma("unroll") for (int j = 0; j < 4; ++j) { const float x = -(b[j] + v[j]); const float sp = fmaxf(x, 0.f) + log1pf(__expf(-fabsf(x))); o[j] = __expf(-__expf(-sp - 0.5f)); }
            *(f32x4*)(rw + (size_t)row * 512 + col) = o; })
    }
};
struct EpiLoraA {
    static constexpr bool PERM = false;
    const float* a0; const float* ka; const float* rkk; float* rb; float* rk;
    __device__ __forceinline__ void operator()(AccRef acc, const Unit& u, int wr, int wc, int fr, int fq) const {
        EPI_FOR_NP({ const f32x4 b0 = *(const f32x4*)(a0 + col); const f32x4 kav = *(const f32x4*)(ka + col); const size_t o = (size_t)row * 512 + col;
            const f32x4 kkv = *(const f32x4*)(rkk + o); f32x4 kv = *(const f32x4*)(rk + o); f32x4 bo;
            _Pragma("unroll") for (int j = 0; j < 4; ++j) { const float a = sigmoidf_(b0[j] + v[j]); bo[j] = kkv[j] * a; kv[j] = kv[j] * (1.0f + (a - 1.0f) * kav[j]); }
            *(f32x4*)(rb + o) = bo; *(f32x4*)(rk + o) = kv; })
    }
};
struct EpiStoreF32 {
    static constexpr bool PERM = false;
    float* o; int ld;
    __device__ __forceinline__ void operator()(AccRef acc, const Unit& u, int wr, int wc, int fr, int fq) const {
        EPI_FOR_NP({ *(f32x4*)(o + (size_t)row * ld + col) = v; })
    }
};
struct EpiGlu {
    static constexpr bool PERM = false;
    const bh* ys; const float* gb; bh* ycat;
    __device__ __forceinline__ void operator()(AccRef acc, const Unit& u, int wr, int wc, int fr, int fq) const {
        EPI_FOR_NP({ const f32x4 b = *(const f32x4*)(gb + col); const u32x2 y2 = *(const u32x2*)(ys + (size_t)row * 512 + col);
            const float y0 = __uint_as_float(y2.x << 16), y1 = __uint_as_float(y2.x & 0xffff0000u), y2f = __uint_as_float(y2.y << 16), y3 = __uint_as_float(y2.y & 0xffff0000u);
            u32x2 w; w.x = cvt_pk_bf16(y0 * sigmoidf_(v[0] + b[0]), y1 * sigmoidf_(v[1] + b[1])); w.y = cvt_pk_bf16(y2f * sigmoidf_(v[2] + b[2]), y3 * sigmoidf_(v[3] + b[3]));
            *(u32x2*)(ycat + (size_t)row * D + 1536 + col) = w; })
    }
};
template <int MODE> struct EpiUp {
    static constexpr bool PERM = false;
    const bh* zg; float* mix; bh* mixed;
    __device__ __forceinline__ void operator()(AccRef acc, const Unit& u, int wr, int wc, int fr, int fq) const {
        EPI_FOR_NP({ const u32x2 g2 = *(const u32x2*)(zg + (size_t)row * NGATE + col);
            f32x4 g; g[0] = __uint_as_float(g2.x << 16); g[1] = __uint_as_float(g2.x & 0xffff0000u); g[2] = __uint_as_float(g2.y << 16); g[3] = __uint_as_float(g2.y & 0xffff0000u);
            f32x4 r = g * v; float* mp = mix + (size_t)row * D + col;
            if (MODE >= 1) r += *(const f32x4*)mp;
            if (MODE <= 1) *(f32x4*)mp = r;
            else { u32x2 w; w.x = cvt_pk_bf16(r[0], r[1]); w.y = cvt_pk_bf16(r[2], r[3]); *(u32x2*)(mixed + (size_t)row * D + col) = w; } })
    }
};
struct EpiRes {
    static constexpr bool PERM = false;
    float* h;
    __device__ __forceinline__ void operator()(AccRef acc, const Unit& u, int wr, int wc, int fr, int fq) const {
        EPI_FOR_NP({ float* hp = h + (size_t)row * D + col; *(f32x4*)hp = *(const f32x4*)hp + v; })
    }
};
struct EpiFfn {
    static constexpr bool PERM = true;
    bh* act;
    __device__ __forceinline__ void operator()(AccRef acc, const Unit& u, int wr, int wc, int fr, int fq) const {
#pragma unroll
        for (int ai = 0; ai < 2; ++ai)
#pragma unroll
            for (int m = 0; m < 4; ++m) { const int row = u.pm * 256 + ai * 128 + wr * 64 + m * 16 + fr; const int col = u.pn * 128 + wc * 32 + 8 * fq;
                float o[8];
#pragma unroll
                for (int n = 0; n < 2; ++n)
#pragma unroll
                    for (int j = 0; j < 4; ++j) { const float gte = acc[ai][0][m][n][j], up = acc[ai][1][m][n][j]; o[n * 4 + j] = gte * sigmoidf_(gte) * up; }
                u32x4 w; w.x = cvt_pk_bf16(o[0], o[1]); w.y = cvt_pk_bf16(o[2], o[3]); w.z = cvt_pk_bf16(o[4], o[5]); w.w = cvt_pk_bf16(o[6], o[7]);
                *(u32x4*)(act + (size_t)row * FH + col) = w; }
    }
};
struct EpiPle {
    static constexpr bool PERM = false;
    float* h; const float* tmp;
    __device__ __forceinline__ void operator()(AccRef acc, const Unit& u, int wr, int wc, int fr, int fq) const {
        EPI_FOR_NP({ float* hp = h + (size_t)row * D + col; const f32x4 tv = *(const f32x4*)(tmp + (size_t)row * D + col); f32x4 hv = *(const f32x4*)hp;
            _Pragma("unroll") for (int j = 0; j < 4; ++j) hv[j] += tv[j] * sigmoidf_(v[j]);
            *(f32x4*)hp = hv; })
    }
};

namespace pg8 {
__device__ __forceinline__ void epi_run(const Gemm& g, const f32x4 (&acc)[2][2][4][2], const Unit& u, int wr, int wc, int fr, int fq) {
    switch (g.epi) {
    case 0: { EpiWin E{(bh*)g.o0, (float*)g.o1}; E(acc, u, wr, wc, fr, fq); } break;
    case 1: { EpiLoraW E{(const float*)g.p0, (float*)g.o0}; E(acc, u, wr, wc, fr, fq); } break;
    case 2: { EpiLoraA E{(const float*)g.p0, (const float*)g.p1, (const float*)g.p2, (float*)g.o0, (float*)g.o1}; E(acc, u, wr, wc, fr, fq); } break;
    case 3: { EpiStoreF32 E{(float*)g.o0, g.N}; E(acc, u, wr, wc, fr, fq); } break;
    case 4: { EpiGlu E{(const bh*)g.p0, (const float*)g.p1, (bh*)g.o0}; E(acc, u, wr, wc, fr, fq); } break;
    case 5: { EpiUp<0> E{(const bh*)g.p0, (float*)g.o0, (bh*)g.o1}; E(acc, u, wr, wc, fr, fq); } break;
    case 6: { EpiUp<1> E{(const bh*)g.p0, (float*)g.o0, (bh*)g.o1}; E(acc, u, wr, wc, fr, fq); } break;
    case 7: { EpiUp<2> E{(const bh*)g.p0, (float*)g.o0, (bh*)g.o1}; E(acc, u, wr, wc, fr, fq); } break;
    case 8: { EpiRes E{(float*)g.o0}; E(acc, u, wr, wc, fr, fq); } break;
    case 9: { EpiFfn E{(bh*)g.o0}; E(acc, u, wr, wc, fr, fq); } break;
    default: { EpiPle E{(float*)g.o0, (const float*)g.p0}; E(acc, u, wr, wc, fr, fq); } break;
    }
}
}

__device__ __forceinline__ bool make_gemm(const Params& p, int L, int q, int i, pg8::Gemm& g) {
    unsigned char* ws = P_WS;
    g.M = T; g.perm = 0; g.p0 = nullptr; g.p1 = nullptr; g.p2 = nullptr; g.o0 = nullptr; g.o1 = nullptr;
    switch (q) {
    case 1: if (i > 0) return false;
        g.A = (const bh*)(ws + OFF_ABF); g.lda = D; g.Bt = (const bh*)(ws + OFF_WIN); g.ldb = D; g.N = NINP; g.K = D; g.epi = 0; g.o0 = ws + OFF_ZG; g.o1 = ws + OFF_ZF; return true;
    case 3: if (i > 2) return false;
        g.lda = 256; g.ldb = 256; g.N = 512; g.K = 256;
        if (i == 0) { g.A = (const bh*)(ws + OFF_LAW); g.Bt = (const bh*)(ws + OFF_WW2); g.epi = 1; g.p0 = P_IN(9) + L * 512; g.o0 = ws + OFF_RW; }
        else if (i == 1) { g.A = (const bh*)(ws + OFF_LAA); g.Bt = (const bh*)(ws + OFF_WA2); g.epi = 2; g.p0 = P_IN(11) + L * 512; g.p1 = P_IN(15) + L * 512; g.p2 = ws + OFF_RKK; g.o0 = ws + OFF_RB; g.o1 = ws + OFF_RK; }
        else { g.A = (const bh*)(ws + OFF_LAG); g.Bt = (const bh*)(ws + OFF_WG2); g.epi = 3; g.o0 = ws + OFF_RG; }
        return true;
    case 5: if (i > 0) return false;
        g.A = (const bh*)(ws + OFF_YS); g.lda = 512; g.Bt = (const bh*)(ws + OFF_WGLU); g.ldb = 512; g.N = 512; g.K = 512; g.epi = 4; g.p0 = ws + OFF_YS; g.p1 = P_IN(28) + L * 512; g.o0 = ws + OFF_YCAT; return true;
    case 6: if (i > 2) return false;
        { const int ko = (i == 0) ? 0 : (i == 1) ? 1024 : 1536;
          g.A = (const bh*)(ws + OFF_YCAT) + ko; g.lda = D; g.Bt = (const bh*)(ws + OFF_WUP) + ko; g.ldb = D; g.N = D; g.K = (i == 0) ? 1024 : 512; g.epi = 5 + i;
          g.p0 = (const bh*)(ws + OFF_ZG) + i * 2048; g.o0 = ws + OFF_MIX32; g.o1 = ws + OFF_ABF; }
        return true;
    case 7: if (i > 0) return false;
        g.A = (const bh*)(ws + OFF_ABF); g.lda = D; g.Bt = (const bh*)(ws + OFF_WO); g.ldb = D; g.N = D; g.K = D; g.epi = 8; g.o0 = P_OUT; return true;
    case 9: if (i > 0) return false;
        g.A = (const bh*)(ws + OFF_ABF); g.lda = D; g.Bt = (const bh*)(ws + OFF_WGU); g.ldb = D; g.N = 2 * FH; g.K = D; g.epi = 9; g.perm = 1; g.o0 = ws + OFF_ACT; return true;
    case 10: if (i > 0) return false;
        g.A = (const bh*)(ws + OFF_ACT); g.lda = FH; g.Bt = (const bh*)(ws + OFF_WD); g.ldb = FH; g.N = D; g.K = FH; g.epi = 8; g.o0 = P_OUT; return true;
    case 12: if (i > 1) return false;
        if (i == 0) { g.A = (const bh*)(ws + OFF_PBF) + (size_t)L * T * 256; g.lda = 256; g.Bt = (const bh*)(ws + OFF_WPP); g.ldb = 256; g.N = D; g.K = 256; g.epi = 3; g.o0 = ws + OFF_MIX32; }
        else { g.A = (const bh*)(ws + OFF_ABF); g.lda = D; g.Bt = (const bh*)(ws + OFF_WPG); g.ldb = D; g.N = D; g.K = D; g.epi = 10; g.o0 = P_OUT; g.p0 = ws + OFF_MIX32; }
        return true;
    default: return false;
    }
}

struct CJ { const float* src; int in_idx, src_ld, kv, n0, nv; long lstride; size_t dst; int dst_ld, r0, c0, npad, kpad, seg, segstride; };
constexpr int BIGSEG = 1 << 30;
__constant__ int JT_I[15][12] = {
    {3, NIN, 2048, NF, NGATE, D, 0, 0, NGATE, 2048, BIGSEG, 0},
    {3, NIN, 2048, 0, NF, D, NGATE, 0, 6656, 2048, BIGSEG, 0},
    {29, D, 1024, 0, D, D, 0, 0, D, 1024, BIGSEG, 0},
    {30, D, 512, 0, D, D, 0, 1024, D, 512, BIGSEG, 0},
    {31, D, 512, 0, D, D, 0, 1536, D, 512, BIGSEG, 0},
    {32, D, 2048, 0, D, D, 0, 0, D, 2048, BIGSEG, 0},
    {34, FH, 2048, 0, FH, D, 0, 0, FH, 2048, 128, 256},
    {35, FH, 2048, 0, FH, D, 128, 0, FH, 2048, 128, 256},
    {36, D, FH, 0, D, FH, 0, 0, D, FH, BIGSEG, 0},
    {38, D, 2048, 0, D, D, 0, 0, D, 2048, BIGSEG, 0},
    {39, D, 256, 0, D, 256, 0, 0, D, 256, BIGSEG, 0},
    {27, 512, 512, 0, 512, 512, 0, 0, 512, 512, BIGSEG, 0},
    {10, 512, 96, 0, 512, 256, 0, 0, 512, 256, BIGSEG, 0},
    {12, 512, 96, 0, 512, 256, 0, 0, 512, 256, BIGSEG, 0},
    {13, 512, 256, 0, 512, 256, 0, 0, 512, 256, BIGSEG, 0}};
__constant__ long JT_L[15][2] = {
    {(long)D * NIN, (long)OFF_WIN}, {(long)D * NIN, (long)OFF_WIN}, {(long)1024 * D, (long)OFF_WUP}, {(long)512 * D, (long)OFF_WUP}, {(long)512 * D, (long)OFF_WUP},
    {(long)D * D, (long)OFF_WO}, {(long)D * FH, (long)OFF_WGU}, {(long)D * FH, (long)OFF_WGU}, {(long)FH * D, (long)OFF_WD}, {(long)D * D, (long)OFF_WPG},
    {(long)256 * D, (long)OFF_WPP}, {(long)512 * 512, (long)OFF_WGLU}, {(long)96 * 512, (long)OFF_WW2}, {(long)96 * 512, (long)OFF_WA2}, {(long)256 * 512, (long)OFF_WG2}};
__device__ __forceinline__ void get_job(int j, CJ& J) {
    J.in_idx = JT_I[j][0]; J.src_ld = JT_I[j][1]; J.kv = JT_I[j][2]; J.n0 = JT_I[j][3]; J.nv = JT_I[j][4]; J.dst_ld = JT_I[j][5]; J.r0 = JT_I[j][6]; J.c0 = JT_I[j][7];
    J.npad = JT_I[j][8]; J.kpad = JT_I[j][9]; J.seg = JT_I[j][10]; J.segstride = JT_I[j][11]; J.lstride = JT_L[j][0]; J.dst = (size_t)JT_L[j][1];
}
__device__ __forceinline__ const float* in_by_idx(const Params& p, int i) { return P_IN(i); }
constexpr int NJOBS = 15;

__device__ __forceinline__ void conv_tile(int L, const CJ& J, int tile, int lane, bh* dstbase) {
    const int nkt = J.kpad / 64; const int tn = tile / nkt, tk = tile % nkt;
    const float* src = J.src + (size_t)L * J.lstride;
    const int cq = lane & 15, r = lane >> 4;
    const int nl = tn * 64 + cq * 4; const bool nok = nl < J.nv;
    const int k0 = tk * 64 + 16 * r;
    f32x4 v[16];
    const float* sp = src + (size_t)k0 * J.src_ld + J.n0 + nl;
#pragma unroll
    for (int i = 0; i < 16; ++i) { v[i] = (f32x4){0.f, 0.f, 0.f, 0.f}; if (nok && (k0 + i) < J.kv) v[i] = *(const f32x4*)(sp + (size_t)i * J.src_ld); }
#pragma unroll
    for (int j = 0; j < 4; ++j) { const int n = nl + j; const int drow = J.r0 + (n / J.seg) * J.segstride + (n % J.seg);
        u32x4 w0, w1;
        w0.x = cvt_pk_bf16(v[0][j], v[1][j]); w0.y = cvt_pk_bf16(v[2][j], v[3][j]); w0.z = cvt_pk_bf16(v[4][j], v[5][j]); w0.w = cvt_pk_bf16(v[6][j], v[7][j]);
        w1.x = cvt_pk_bf16(v[8][j], v[9][j]); w1.y = cvt_pk_bf16(v[10][j], v[11][j]); w1.z = cvt_pk_bf16(v[12][j], v[13][j]); w1.w = cvt_pk_bf16(v[14][j], v[15][j]);
        bh* d = dstbase + (size_t)drow * J.dst_ld + J.c0 + k0;
        *(u32x4*)d = w0; *(u32x4*)(d + 8) = w1; }
}

__device__ __forceinline__ void rms_row_bf16(const float* x, const float* g, bh* o, int lane) {
    f32x4 v[8]; float s = 0.f;
#pragma unroll
    for (int j = 0; j < 8; ++j) { v[j] = *(const f32x4*)(x + j * 256 + lane * 4); s += (v[j][0] * v[j][0] + v[j][1] * v[j][1]) + (v[j][2] * v[j][2] + v[j][3] * v[j][3]); }
    const float rstd = rsqrtf(wave_sum(s) * (1.0f / D) + 1e-6f);
#pragma unroll
    for (int j = 0; j < 8; ++j) { const f32x4 gg = *(const f32x4*)(g + j * 256 + lane * 4); u32x2 w; w.x = pk2(v[j][0] * rstd * gg[0], v[j][1] * rstd * gg[1]); w.y = pk2(v[j][2] * rstd * gg[2], v[j][3] * rstd * gg[3]);
        *(u32x2*)(o + j * 256 + lane * 4) = w; }
}
__device__ __forceinline__ void phase_rmsnorm(const Params& p, const float* g) {
    const int gw = BIDX() * 8 + (TIDX() >> 6), NGW = GDIM() * 8, lane = TIDX() & 63;
    bh* abf = (bh*)(P_WS + OFF_ABF);
    for (int r = gw; r < T; r += NGW) rms_row_bf16(P_OUT + (size_t)r * D, g, abf + (size_t)r * D, lane);
}

__device__ __forceinline__ void phase_conv(const Params& p, int L, LAS unsigned char* lds) {
    const int tid = TIDX();
    {   const int gw0 = BIDX() * 8 + (tid >> 6), NGW0 = GDIM() * 8, ln = tid & 63;
        int base = 0;
        for (int j = 0; j < NJOBS; ++j) { CJ J; get_job(j, J); J.src = in_by_idx(p, J.in_idx); const int ntile = (J.npad / 64) * (J.kpad / 64);
            int first = gw0 - (base % NGW0); if (first < 0) first += NGW0;
            bh* dstbase = (bh*)(P_WS + J.dst);
            for (int t = first; t < ntile; t += NGW0) conv_tile(L, J, t, ln, dstbase);
            base += ntile; } }
    { bh* w = (bh*)(P_WS + OFF_WIN) + (size_t)NIN * D; for (int i = BIDX() * 512 + tid; i < (NINP - NIN) * D / 8; i += GDIM() * 512) ((u32x4*)w)[i] = (u32x4){0u, 0u, 0u, 0u}; }
    const int gw = BIDX() * 8 + (tid >> 6), NGW = GDIM() * 8, lane = tid & 63;
    bh* abf = (bh*)(P_WS + OFF_ABF);
    if (L == 0) {
        const float* ps = P_IN(1); bh* pb = (bh*)(P_WS + OFF_PBF);
        for (size_t i = (size_t)BIDX() * 512 + tid; i < (size_t)2 * T * 256 / 4; i += (size_t)GDIM() * 512) { const f32x4 v = ((const f32x4*)ps)[i]; u32x2 w; w.x = pk2(v[0], v[1]); w.y = pk2(v[2], v[3]); ((u32x2*)pb)[i] = w; }
        const float* x = P_IN(0);
        for (int r = gw; r < T; r += NGW) {
#pragma unroll
            for (int j = 0; j < 8; ++j) *(f32x4*)(P_OUT + (size_t)r * D + j * 256 + lane * 4) = *(const f32x4*)(x + (size_t)r * D + j * 256 + lane * 4);
            rms_row_bf16(x + (size_t)r * D, P_IN(2), abf + (size_t)r * D, lane);
        }
    } else {
        for (int r = gw; r < T; r += NGW) rms_row_bf16(P_OUT + (size_t)r * D, P_IN(2) + (size_t)L * D, abf + (size_t)r * D, lane);
    }
}

struct S5C { float ar, ai; float br[16], bi[16]; };
__device__ __forceinline__ void s5_setup(const Params& p, int L, int g, int n, S5C& c) {
    const int gi = L * 32 + g;
    const float dt = __expf(P_IN(21)[gi]);
    const float are = P_IN(19)[gi * 64 + n], aim = P_IN(20)[gi * 64 + n];
    const float mag = __expf(are * dt), ang = aim * dt;
    float sn, cs;
    {
        const double a = (double)ang; const double k = rint(a * 0.15915494309189535); const float r = (float)(a - k * 6.283185307179586);
        sn = sinf(r); cs = cosf(r);
    }
    c.ar = mag * cs; c.ai = mag * sn;
    const float den = are * are + aim * aim, nr = c.ar - 1.0f, ni = c.ai;
    const float cr = (nr * are + ni * aim) / den, ci = (ni * are - nr * aim) / den;
    const float* bre = P_IN(22) + ((size_t)gi * 64 + n) * 16; const float* bim = P_IN(23) + ((size_t)gi * 64 + n) * 16;
#pragma unroll
    for (int q = 0; q < 4; ++q) { const f32x4 r4 = *(const f32x4*)(bre + q * 4), i4 = *(const f32x4*)(bim + q * 4);
#pragma unroll
        for (int j = 0; j < 4; ++j) { c.br[q * 4 + j] = cr * r4[j] - ci * i4[j]; c.bi[q * 4 + j] = cr * i4[j] + ci * r4[j]; } }
}
__device__ __forceinline__ void s5_step(const S5C& c, const LAS float* urow, float& sr, float& si) {
    float xr = 0.f, xi = 0.f;
#pragma unroll
    for (int q = 0; q < 4; ++q) { const f32x4 u4 = *(const LAS f32x4*)(urow + q * 4);
#pragma unroll
        for (int j = 0; j < 4; ++j) { xr = fmaf(u4[j], c.br[q * 4 + j], xr); xi = fmaf(u4[j], c.bi[q * 4 + j], xi); } }
    const float nr = c.ar * sr - c.ai * si + xr, ni = c.ar * si + c.ai * sr + xi;
    sr = nr; si = ni;
}
__device__ __forceinline__ void s5_stage_u(const float* zfc, LAS float* ul, int lane) {
    const float* src = zfc + (size_t)lane * ZF_LD;
    const f32x4 a = *(const f32x4*)src, b = *(const f32x4*)(src + 4), c = *(const f32x4*)(src + 8), d = *(const f32x4*)(src + 12);
    *(LAS f32x4*)(ul + lane * 16) = a; *(LAS f32x4*)(ul + lane * 16 + 4) = b; *(LAS f32x4*)(ul + lane * 16 + 8) = c; *(LAS f32x4*)(ul + lane * 16 + 12) = d;
    asm volatile("s_waitcnt lgkmcnt(0)" ::: "memory"); __builtin_amdgcn_wave_barrier();
}

__device__ __forceinline__ void mlstm_prep(const Params& p, int L, int h, int c, LAS unsigned char* lds) {
    const int tid = TIDX(), t0 = c * 64;
    const float* zf = (const float*)(P_WS + OFF_ZF);
    LAS float* s_ws = (LAS float*)lds;
    if (tid < 64) {
        const int t = t0 + tid;
        float ig = zf[(size_t)t * ZF_LD + 4096 + h] + P_IN(5)[L * 4 + h];
        float fg = zf[(size_t)t * ZF_LD + 4100 + h] + P_IN(6)[L * 4 + h];
        ig = 15.0f * tanhf(ig * (1.0f / 15.0f)); fg = 15.0f * tanhf(fg * (1.0f / 15.0f));
        const float lf = fminf(fg, 0.f) - log1pf(__expf(-fabsf(fg)));
        float b = lf;
#pragma unroll
        for (int o = 1; o < 64; o <<= 1) { const float nb = __shfl_up(b, o); if (tid >= o) b += nb; }
        const float bend = __shfl(b, 63);
        const float wlog = bend - b + ig;
        const float mloc = wave_max(wlog);
        s_ws[tid] = __expf(wlog - mloc);
        ((float*)(P_WS + OFF_MI))[h * T + t] = ig; ((float*)(P_WS + OFF_MBB))[h * T + t] = b;
        if (tid == 0) { ((float*)(P_WS + OFF_MBEND))[h * NCH + c] = bend; ((float*)(P_WS + OFF_MLOC))[h * NCH + c] = mloc; }
    }
    __syncthreads();
    const int d = tid & 255, isk = tid >> 8;
    const int col = isk * 1024 + h * 256 + d;
    const float* cw = P_IN(4) + (size_t)L * 4 * 2048;
    const float w0 = cw[col], w1 = cw[2048 + col], w2 = cw[4096 + col], w3 = cw[6144 + col];
    float x1 = (t0 >= 1) ? zf[(size_t)(t0 - 1) * ZF_LD + col] : 0.f, x2 = (t0 >= 2) ? zf[(size_t)(t0 - 2) * ZF_LD + col] : 0.f, x3 = (t0 >= 3) ? zf[(size_t)(t0 - 3) * ZF_LD + col] : 0.f;
    bh* MQ = (bh*)(P_WS + OFF_MQ); bh* MK = (bh*)(P_WS + OFF_MK);
    bh* MT = (bh*)(P_WS + (isk ? OFF_MKT : OFF_MVT)) + ((size_t)(h * NCH + c) * 256 + d) * 64;
    float dnacc = 0.f;
    for (int s8 = 0; s8 < 8; ++s8) {
        unsigned pk[4];
#pragma unroll
        for (int j = 0; j < 8; ++j) { const int s = s8 * 8 + j, t = t0 + s;
            const float x0 = zf[(size_t)t * ZF_LD + col]; float y = w0 * x0 + w1 * x1 + w2 * x2 + w3 * x3; x3 = x2; x2 = x1; x1 = x0;
            y = y * sigmoidf_(y);
            unsigned short e;
            if (!isk) { MQ[(size_t)t * 1024 + h * 256 + d] = f2bf(y * 0.0625f); e = f2bf(zf[(size_t)t * ZF_LD + 2048 + h * 256 + d]); }
            else { MK[(size_t)t * 1024 + h * 256 + d] = f2bf(y); const float wk = y * s_ws[s]; e = f2bf(wk); dnacc += wk; }
            if (j & 1) pk[j >> 1] |= ((unsigned)e << 16); else pk[j >> 1] = e; }
        u32x4 w; w.x = pk[0]; w.y = pk[1]; w.z = pk[2]; w.w = pk[3];
        *(u32x4*)(MT + s8 * 8) = w;
    }
    if (isk) ((float*)(P_WS + OFF_DN))[(size_t)(h * NCH + c) * 256 + d] = dnacc;
    __syncthreads();
}

__device__ __forceinline__ void rwkv_prep_token(const Params& p, int L, int t, int lane) {
    const float* zf = (const float*)(P_WS + OFF_ZF);
    const float* z = zf + (size_t)t * ZF_LD + ZR0; const float* zp = z - ZF_LD; const bool hp = t > 0;
    const float* mu = P_IN(8) + (size_t)L * 1984;
    float* RR = (float*)(P_WS + OFF_RR); float* RK = (float*)(P_WS + OFF_RK); float* RV = (float*)(P_WS + OFF_RV); float* RKK = (float*)(P_WS + OFF_RKK);
    const float* kkw = P_IN(14) + L * 512;
#pragma unroll
    for (int i = 0; i < 8; ++i) { const int c = i * 64 + lane;
        { const float a = z[c], b = hp ? zp[c] : 0.f; RR[(size_t)t * 512 + c] = a + (b - a) * mu[c]; }
        { const float a = z[1024 + c], b = hp ? zp[1024 + c] : 0.f; RV[(size_t)t * 512 + c] = a + (b - a) * mu[1024 + c]; }
        { const float a = z[512 + c], b = hp ? zp[512 + c] : 0.f; const float k = a + (b - a) * mu[512 + c]; RK[(size_t)t * 512 + c] = k;
          const float kkv = k * kkw[c]; const float ss = wave_sum(kkv * kkv); RKK[(size_t)t * 512 + c] = kkv / fmaxf(sqrtf(ss), 1e-12f); } }
    bh* LAW = (bh*)(P_WS + OFF_LAW) + (size_t)t * 256; bh* LAA = (bh*)(P_WS + OFF_LAA) + (size_t)t * 256; bh* LAG = (bh*)(P_WS + OFF_LAG) + (size_t)t * 256;
#pragma unroll
    for (int i = 0; i < 4; ++i) { const int j = i * 64 + lane;
        float vw = 0.f, va = 0.f;
        if (j < 96) { { const int c = 1536 + j; const float a = z[c], b = hp ? zp[c] : 0.f; vw = tanhf(a + (b - a) * mu[c]); }
                      { const int c = 1632 + j; const float a = z[c], b = hp ? zp[c] : 0.f; va = a + (b - a) * mu[c]; } }
        LAW[j] = f2bf(vw); LAA[j] = f2bf(va);
        { const int c = 1728 + j; const float a = z[c], b = hp ? zp[c] : 0.f; LAG[j] = f2bf(sigmoidf_(a + (b - a) * mu[c])); } }
}

__device__ __forceinline__ void s5_pass_a(const Params& p, int L, int g, int c, int lane, LAS float* ul) {
    const float* zf = (const float*)(P_WS + OFF_ZF) + (size_t)(c * 64) * ZF_LD + ZS0 + g * 16;
    s5_stage_u(zf, ul, lane);
    S5C k; s5_setup(p, L, g, lane, k);
    float sr = 0.f, si = 0.f;
#pragma unroll 8
    for (int s = 0; s < 64; ++s) s5_step(k, ul + s * 16, sr, si);
    asm volatile("s_waitcnt lgkmcnt(0)" ::: "memory"); __builtin_amdgcn_wave_barrier();
    float* se = (float*)(P_WS + OFF_SEND) + ((size_t)(g * NCH + c) * 64 + lane) * 2;
    se[0] = sr; se[1] = si;
}

__device__ __forceinline__ void phase_prep(const Params& p, int L, LAS unsigned char* lds) {
    const int wid = TIDX() >> 6, lane = TIDX() & 63;
    for (int it = BIDX(); it < 2048; it += GDIM()) {
        if (it < 512) mlstm_prep(p, L, it >> 7, it & 127, lds);
        else if (it < 1536) rwkv_prep_token(p, L, (it - 512) * 8 + wid, lane);
        else { const int w = (it - 1536) * 8 + wid; s5_pass_a(p, L, w >> 7, w & 127, lane, (LAS float*)lds + wid * 1024); }
    }
}

constexpr int RW_NS = 4, RW_LS = T / RW_NS, RW_NB = RW_LS / 16, RW_RING = 5, RW_SLOT = 16 * 384;
__device__ __forceinline__ void rwkv_scan(const Params& p, int b, LAS unsigned char* lds) {
    const int tid = TIDX(), wid = __builtin_amdgcn_readfirstlane(tid >> 6), lane = tid & 63;
    int j, h, rg;
    if (b < 32) { j = 0; h = b >> 2; rg = b & 3; } else { const int u = b - 32; j = 1 + (u >> 6); h = (u & 63) >> 3; rg = u & 7; }
    LAS float* ring = (LAS float*)lds;
    const int tbase = j * RW_LS;
    if (wid >= 4) {
        const int lw = wid - 4;
        const float* gp[6]; unsigned lo[6];
#pragma unroll
        for (int i = 0; i < 6; ++i) { const int ii = lw * 6 + i, rowidx = ii * 4 + (lane >> 4), step = rowidx / 6, a = rowidx % 6, q = lane & 15;
            const int ai = (0x205314 >> (4 * a)) & 0xf;
            gp[i] = (const float*)(P_WS + OFF_RR + (size_t)ai * SZ_R) + (size_t)(tbase + step) * 512 + h * 64 + q * 4;
            lo[i] = (unsigned)ii * 256u; }
#define RW_ISSUE(bi, sl) do { _Pragma("unroll") for (int _i = 0; _i < 6; ++_i) \
        __builtin_amdgcn_global_load_lds((const unsigned*)(gp[_i] + (size_t)(bi) * 16 * 512), (LAS unsigned*)(ring + (sl) * RW_SLOT + lo[_i]), 16, 0, 0); } while (0)
        RW_ISSUE(0, 0); RW_ISSUE(1, 1); RW_ISSUE(2, 2); RW_ISSUE(3, 3);
        asm volatile("s_waitcnt vmcnt(18)" ::: "memory"); __builtin_amdgcn_s_barrier();
        int sl = 4;
        for (int ib = 0; ib < RW_NB; ++ib) {
            if (ib + 4 < RW_NB) { RW_ISSUE(ib + 4, sl); asm volatile("s_waitcnt vmcnt(18)" ::: "memory"); }
            else asm volatile("s_waitcnt vmcnt(0)" ::: "memory");
            sl = (sl == RW_RING - 1) ? 0 : sl + 1;
            __builtin_amdgcn_s_barrier();
        }
#undef RW_ISSUE
    } else {
        const int rfull = rg * 16 + wid * 4 + (lane >> 4), kq = lane & 15;
        const bool isP = rfull >= 64; const int row = rfull & 63;
        f32x4 S;
#pragma unroll
        for (int e = 0; e < 4; ++e) S[e] = (isP && (kq * 4 + e == row)) ? 1.f : 0.f;
        float* OUT = (float*)(P_WS + (isP ? OFF_RZ : OFF_RY)) + (size_t)tbase * 512 + h * 64 + row;
        const float vmask = isP ? 0.f : 1.f;
        __builtin_amdgcn_s_barrier();
        int sl = 0;
        for (int ib = 0; ib < RW_NB; ++ib) {
            const LAS float* bb = ring + sl * RW_SLOT;
            float ykeep = 0.f;
#pragma unroll
            for (int s = 0; s < 16; ++s) {
                const LAS float* q = bb + s * 384;
                const f32x4 w4 = *(const LAS f32x4*)(q + kq * 4), k4 = *(const LAS f32x4*)(q + 64 + kq * 4), kk4 = *(const LAS f32x4*)(q + 128 + kq * 4),
                            b4 = *(const LAS f32x4*)(q + 192 + kq * 4), r4 = *(const LAS f32x4*)(q + 256 + kq * 4);
                const float vv = q[320 + row] * vmask;
                float pd = (S[0] * kk4[0] + S[1] * kk4[1]) + (S[2] * kk4[2] + S[3] * kk4[3]);
                const f32x4 pre = S * w4 + vv * k4;
                pd = allreduce16(pd);
                S = pre - pd * b4;
                float y = (S[0] * r4[0] + S[1] * r4[1]) + (S[2] * r4[2] + S[3] * r4[3]);
                y = allreduce16(y);
                ykeep = (kq == s) ? y : ykeep;
            }
            OUT[(size_t)(ib * 16 + kq) * 512] = ykeep;
            sl = (sl == RW_RING - 1) ? 0 : sl + 1;
            __builtin_amdgcn_s_barrier();
        }
        float* EN = (float*)(P_WS + (isP ? OFF_RPEND : OFF_RSEND)) + ((size_t)(h * 4 + j) * 64 + row) * 64 + kq * 4;
        *(f32x4*)EN = S;
    }
    __syncthreads();
}

__device__ __forceinline__ void mlstm_seq(const Params& p, int mb, LAS unsigned char* lds) {
    const int tid = TIDX(), wid = tid >> 6, lane = tid & 63;
    const int h = mb >> 3, jv = mb & 7;
    LAS bh* Cbf = (LAS bh*)lds;
    constexpr int CS = 264;
    for (int i = tid; i < 2 * 32 * CS / 2; i += 512) ((LAS unsigned*)Cbf)[i] = 0u;
    __syncthreads();
    const bh* MQ = (const bh*)(P_WS + OFF_MQ); const bh* MKT = (const bh*)(P_WS + OFF_MKT); const bh* MVT = (const bh*)(P_WS + OFF_MVT);
    float* MINTER = (float*)(P_WS + OFF_ABF);
    const float* MBEND = (const float*)(P_WS + OFF_MBEND); const float* MLOC = (const float*)(P_WS + OFF_MLOC);
    f32x16 ct;
#pragma unroll
    for (int i = 0; i < 16; ++i) ct[i] = 0.f;
    float m = 0.f;
    const int mt = wid >> 1, nt = wid & 1;
    const bh* qp = MQ + (size_t)(mt * 16 + (lane & 15)) * 1024 + h * 256 + (lane >> 4) * 8;
    const bh* kp = MKT + ((size_t)(h * NCH) * 256 + wid * 32 + (lane & 31)) * 64 + (lane >> 5) * 8;
    const bh* vp = MVT + ((size_t)(h * NCH) * 256 + jv * 32 + (lane & 31)) * 64 + (lane >> 5) * 8;
    bf16x8 qa[8], ka[4], va[4];
#pragma unroll
    for (int ks = 0; ks < 8; ++ks) qa[ks] = *(const bf16x8*)(qp + ks * 32);
#pragma unroll
    for (int ks = 0; ks < 4; ++ks) { ka[ks] = *(const bf16x8*)(kp + ks * 16); va[ks] = *(const bf16x8*)(vp + ks * 16); }
    float bend = MBEND[h * NCH], mloc = MLOC[h * NCH];
    for (int c = 0; c < NCH; ++c) {
        const int t0 = c * 64, cur = c & 1;
        bf16x8 qn[8], kn[4], vn[4]; float bendn = 0.f, mlocn = 0.f;
        const int cn = (c + 1 < NCH) ? c + 1 : c;
#pragma unroll
        for (int ks = 0; ks < 8; ++ks) qn[ks] = *(const bf16x8*)(qp + (size_t)cn * 64 * 1024 + ks * 32);
#pragma unroll
        for (int ks = 0; ks < 4; ++ks) { kn[ks] = *(const bf16x8*)(kp + (size_t)cn * 256 * 64 + ks * 16); vn[ks] = *(const bf16x8*)(vp + (size_t)cn * 256 * 64 + ks * 16); }
        bendn = MBEND[h * NCH + cn]; mlocn = MLOC[h * NCH + cn];
        const float mnew = fmaxf(bend + m, mloc), decay = __expf(bend + m - mnew), scale = __expf(mloc - mnew);
        f32x4 r0 = {0.f, 0.f, 0.f, 0.f};
        const LAS bh* cb = Cbf + cur * 32 * CS + (nt * 16 + (lane & 15)) * CS + (lane >> 4) * 8;
#pragma unroll
        for (int ks = 0; ks < 8; ++ks) { const bf16x8 b0 = *(const LAS bf16x8*)(cb + ks * 32); r0 = MFMA16(qa[ks], b0, r0); }
        {   float* o = MINTER + (size_t)(t0 + mt * 16 + (lane >> 4) * 4) * 1024 + h * 256 + jv * 32 + nt * 16 + (lane & 15);
#pragma unroll
            for (int r = 0; r < 4; ++r) o[(size_t)r * 1024] = r0[r]; }
        f32x16 d0;
#pragma unroll
        for (int i = 0; i < 16; ++i) d0[i] = 0.f;
#pragma unroll
        for (int ks = 0; ks < 4; ++ks) d0 = MFMA32(ka[ks], va[ks], d0);
#pragma unroll
        for (int i = 0; i < 16; ++i) ct[i] = decay * ct[i] + scale * d0[i];
        m = mnew;
        {   LAS bh* o0 = Cbf + (cur ^ 1) * 32 * CS + (lane & 31) * CS + wid * 32 + 4 * (lane >> 5);
#pragma unroll
            for (int g = 0; g < 4; ++g) { u32x2 w0; w0.x = pk2(ct[4 * g], ct[4 * g + 1]); w0.y = pk2(ct[4 * g + 2], ct[4 * g + 3]); *(LAS u32x2*)(o0 + 8 * g) = w0; } }
#pragma unroll
        for (int ks = 0; ks < 8; ++ks) qa[ks] = qn[ks];
#pragma unroll
        for (int ks = 0; ks < 4; ++ks) { ka[ks] = kn[ks]; va[ks] = vn[ks]; }
        bend = bendn; mloc = mlocn;
        __syncthreads();
    }
}

__device__ __forceinline__ void mlstm_nscan(const Params& p) {
    const float* MBEND = (const float*)(P_WS + OFF_MBEND); const float* MLOC = (const float*)(P_WS + OFF_MLOC);
    const float* DN = (const float*)(P_WS + OFF_DN); float* NST = (float*)(P_WS + OFF_NST); float* MSTART = (float*)(P_WS + OFF_MSTART);
    for (int idx = TIDX(); idx < 1024; idx += 512) { const int h = idx >> 8, d = idx & 255; float m = 0.f, n = 0.f;
#pragma unroll 8
        for (int c = 0; c < NCH; ++c) { if (d == 0) MSTART[h * NCH + c] = m; NST[(size_t)(h * NCH + c) * 256 + d] = n;
            const float bend = MBEND[h * NCH + c], mloc = MLOC[h * NCH + c]; const float mnew = fmaxf(bend + m, mloc);
            n = __expf(bend + m - mnew) * n + __expf(mloc - mnew) * DN[(size_t)(h * NCH + c) * 256 + d]; m = mnew; } }
}

__device__ __forceinline__ float gelu_tanh(float x) { const float u = 0.7978845608028654f * (x + 0.044715f * x * x * x); return 0.5f * x * (1.0f + tanhf(u)); }

__device__ __forceinline__ void s5_pass_c(const Params& p, int L, int g, int c, int lane, LAS bh* img, LAS float* ul) {
    const float* zf = (const float*)(P_WS + OFF_ZF) + (size_t)(c * 64) * ZF_LD + ZS0 + g * 16;
    s5_stage_u(zf, ul, lane);
    S5C k; s5_setup(p, L, g, lane, k);
    float sr = 0.f, si = 0.f;
    {   float pr = k.ar, pi = k.ai;
#pragma unroll
        for (int i = 0; i < 6; ++i) { const float nr = pr * pr - pi * pi, ni = 2.f * pr * pi; pr = nr; pi = ni; }
        const float* se = (const float*)(P_WS + OFF_SEND) + ((size_t)(g * NCH) * 64 + lane) * 2;
        int cc = 0;
        for (; cc + 8 <= c; cc += 8) { float er[8], ei[8];
#pragma unroll
            for (int j = 0; j < 8; ++j) { er[j] = se[(size_t)(cc + j) * 128]; ei[j] = se[(size_t)(cc + j) * 128 + 1]; }
#pragma unroll
            for (int j = 0; j < 8; ++j) { const float nr = pr * sr - pi * si + er[j], ni = pr * si + pi * sr + ei[j]; sr = nr; si = ni; } }
        for (; cc < c; ++cc) { const float er = se[(size_t)cc * 128], ei = se[(size_t)cc * 128 + 1];
            const float nr = pr * sr - pi * si + er, ni = pr * si + pi * sr + ei; sr = nr; si = ni; } }
    const int gi = L * 32 + g;
    bf16x8 bfr[4];
    {   const int pp = lane & 15; const float* cre = P_IN(24) + ((size_t)gi * 16 + pp) * 64; const float* cim = P_IN(25) + ((size_t)gi * 16 + pp) * 64;
#pragma unroll
        for (int ks = 0; ks < 4; ++ks)
#pragma unroll
            for (int j = 0; j < 8; ++j) { const int n2 = ks * 32 + (lane >> 4) * 8 + j; const float v = (n2 < 64) ? cre[n2] : -cim[n2 - 64]; bfr[ks][j] = (short)f2bf(v); } }
    const float dco = P_IN(26)[L * 512 + g * 16 + (lane & 15)];
    bh* YS = (bh*)(P_WS + OFF_YS);
    for (int half = 0; half < 2; ++half) {
#pragma unroll 8
        for (int s = 0; s < 32; ++s) { s5_step(k, ul + (half * 32 + s) * 16, sr, si); img[s * 136 + lane] = f2bf(sr); img[s * 136 + 64 + lane] = f2bf(si); }
        asm volatile("s_waitcnt lgkmcnt(0)" ::: "memory"); __builtin_amdgcn_wave_barrier();
#pragma unroll
        for (int mt = 0; mt < 2; ++mt) { f32x4 acc = {0.f, 0.f, 0.f, 0.f};
#pragma unroll
            for (int ks = 0; ks < 4; ++ks) { const bf16x8 a = *(const LAS bf16x8*)(img + (mt * 16 + (lane & 15)) * 136 + ks * 32 + (lane >> 4) * 8); acc = MFMA16(a, bfr[ks], acc); }
#pragma unroll
            for (int r = 0; r < 4; ++r) { const int tt = half * 32 + mt * 16 + (lane >> 4) * 4 + r; const float uv = ul[tt * 16 + (lane & 15)];
                YS[(size_t)(c * 64 + tt) * 512 + g * 16 + (lane & 15)] = f2bf(gelu_tanh(acc[r] + dco * uv)); } }
        asm volatile("s_waitcnt lgkmcnt(0)" ::: "memory"); __builtin_amdgcn_wave_barrier();
    }
}

__device__ __forceinline__ void phase_scan(const Params& p, int L, LAS unsigned char* lds) {
    const int b = BIDX();
    if (b < 224) rwkv_scan(p, b, lds);
    else mlstm_seq(p, b - 224, lds);
}
__device__ __forceinline__ void phase_s5c(const Params& p, int L, LAS unsigned char* lds) {
    const int b = BIDX(), wid = TIDX() >> 6, lane = TIDX() & 63;
    if (b == GDIM() - 1) mlstm_nscan(p);
    const int nw = GDIM() * 8;
    for (int w = b * 8 + wid; w < 32 * NCH; w += nw) s5_pass_c(p, L, w >> 7, w & 127, lane, (LAS bh*)lds + wid * (32 * 136), (LAS float*)(lds + 69632) + wid * 1024);
    __syncthreads();
}

__device__ __forceinline__ void mlstm_out(const Params& p, int L, int h, int c, LAS unsigned char* lds) {
    const int tid = TIDX(), wid = tid >> 6, lane = tid & 63, t0 = c * 64;
    LAS bh* Pl = (LAS bh*)lds;
    LAS float* s_b = (LAS float*)(lds + 9216); LAS float* s_a = s_b + 64; LAS float* s_mt = s_a + 64; LAS float* s_iw = s_mt + 64; LAS float* s_den = s_iw + 64; LAS float* s_qn = s_den + 64; LAS float* s_part = s_qn + 64;
    const bh* MQ = (const bh*)(P_WS + OFF_MQ); const bh* MK = (const bh*)(P_WS + OFF_MK); const bh* MVT = (const bh*)(P_WS + OFF_MVT);
    const float* MINTER = (const float*)(P_WS + OFF_ABF);
    const float m0 = ((const float*)(P_WS + OFF_MSTART))[h * NCH + c];
    if (tid < 64) { const float ig = ((const float*)(P_WS + OFF_MI))[h * T + t0 + tid], b = ((const float*)(P_WS + OFF_MBB))[h * T + t0 + tid];
        const float a = ig - b; float cm = a;
#pragma unroll
        for (int o = 1; o < 64; o <<= 1) { const float nb = __shfl_up(cm, o); if (tid >= o) cm = fmaxf(cm, nb); }
        const float mt = b + fmaxf(m0, cm);
        s_b[tid] = b; s_a[tid] = a; s_mt[tid] = mt; s_iw[tid] = __expf(b + m0 - mt); }
    __syncthreads();
    {
        const int mt = wid >> 1, nt0 = (wid & 1) * 2;
        f32x4 r0 = {0.f, 0.f, 0.f, 0.f}, r1 = {0.f, 0.f, 0.f, 0.f};
        const bh* qp = MQ + (size_t)(t0 + mt * 16 + (lane & 15)) * 1024 + h * 256 + (lane >> 4) * 8;
        const bh* kp = MK + (size_t)(t0 + nt0 * 16 + (lane & 15)) * 1024 + h * 256 + (lane >> 4) * 8;
#pragma unroll
        for (int ks = 0; ks < 8; ++ks) { const bf16x8 a = *(const bf16x8*)(qp + ks * 32); const bf16x8 b0 = *(const bf16x8*)(kp + ks * 32), b1 = *(const bf16x8*)(kp + (size_t)16 * 1024 + ks * 32);
            r0 = MFMA16(a, b0, r0); r1 = MFMA16(a, b1, r1); }
#pragma unroll
        for (int r = 0; r < 4; ++r) { const int t = mt * 16 + (lane >> 4) * 4 + r; const float bt = s_b[t] - s_mt[t];
            { const int s = nt0 * 16 + (lane & 15); const float pv = (s <= t) ? r0[r] * __expf(bt + s_a[s]) : 0.f; Pl[t * 72 + s] = f2bf(pv); }
            { const int s = nt0 * 16 + 16 + (lane & 15); const float pv = (s <= t) ? r1[r] * __expf(bt + s_a[s]) : 0.f; Pl[t * 72 + s] = f2bf(pv); } }
    }
    __syncthreads();
    if (tid < 64) { float s = 0.f;
#pragma unroll
        for (int q = 0; q < 8; ++q) { const u32x4 w = *(const LAS u32x4*)(Pl + tid * 72 + q * 8);
            s += __uint_as_float(w.x << 16) + __uint_as_float(w.x & 0xffff0000u) + __uint_as_float(w.y << 16) + __uint_as_float(w.y & 0xffff0000u)
               + __uint_as_float(w.z << 16) + __uint_as_float(w.z & 0xffff0000u) + __uint_as_float(w.w << 16) + __uint_as_float(w.w & 0xffff0000u); }
        s_den[tid] = s; }
    {
        const float* nst = (const float*)(P_WS + OFF_NST) + (size_t)(h * NCH + c) * 256 + lane * 4; const f32x4 nv = *(const f32x4*)nst;
#pragma unroll
        for (int i = 0; i < 8; ++i) { const int t = wid * 8 + i; const u32x2 q2 = *(const u32x2*)(MQ + (size_t)(t0 + t) * 1024 + h * 256 + lane * 4);
            float s = __uint_as_float(q2.x << 16) * nv[0] + __uint_as_float(q2.x & 0xffff0000u) * nv[1] + __uint_as_float(q2.y << 16) * nv[2] + __uint_as_float(q2.y & 0xffff0000u) * nv[3];
            s = wave_sum(s); if (lane == 0) s_qn[t] = s; } }
    f32x4 acc[4][2];
#pragma unroll
    for (int a = 0; a < 4; ++a) { acc[a][0] = (f32x4){0.f, 0.f, 0.f, 0.f}; acc[a][1] = (f32x4){0.f, 0.f, 0.f, 0.f}; }
    {   const bh* vp = MVT + ((size_t)(h * NCH + c) * 256 + wid * 32 + (lane & 15)) * 64 + (lane >> 4) * 8;
#pragma unroll
        for (int ks = 0; ks < 2; ++ks) { const bf16x8 b0 = *(const bf16x8*)(vp + ks * 32), b1 = *(const bf16x8*)(vp + 16 * 64 + ks * 32);
#pragma unroll
            for (int a = 0; a < 4; ++a) { const bf16x8 av = *(const LAS bf16x8*)(Pl + (a * 16 + (lane & 15)) * 72 + ks * 32 + (lane >> 4) * 8);
                acc[a][0] = MFMA16(av, b0, acc[a][0]); acc[a][1] = MFMA16(av, b1, acc[a][1]); } } }
    __syncthreads();
#pragma unroll
    for (int a = 0; a < 4; ++a)
#pragma unroll
        for (int r = 0; r < 4; ++r) { const int t = a * 16 + (lane >> 4) * 4 + r; const float iw = s_iw[t];
            const float den = s_den[t] + iw * s_qn[t]; const float dd = 1.0f / fmaxf(fabsf(den), __expf(-s_mt[t]));
            const float* mi = MINTER + (size_t)(t0 + t) * 1024 + h * 256 + wid * 32 + (lane & 15);
            const float h0 = (acc[a][0][r] + iw * mi[0]) * dd, h1 = (acc[a][1][r] + iw * mi[16]) * dd;
            acc[a][0][r] = h0; acc[a][1][r] = h1;
            float ss = h0 * h0 + h1 * h1;
            ss += __shfl_xor(ss, 1); ss += __shfl_xor(ss, 2); ss += __shfl_xor(ss, 4); ss += __shfl_xor(ss, 8);
            if ((lane & 15) == 0) s_part[wid * 64 + t] = ss; }
    __syncthreads();
    {   const float* zf = (const float*)(P_WS + OFF_ZF); const float* ng = P_IN(7) + L * 1024 + h * 256; bh* YC = (bh*)(P_WS + OFF_YCAT);
#pragma unroll
        for (int a = 0; a < 4; ++a)
#pragma unroll
            for (int r = 0; r < 4; ++r) { const int t = a * 16 + (lane >> 4) * 4 + r;
                float tot = 0.f;
#pragma unroll
                for (int w = 0; w < 8; ++w) tot += s_part[w * 64 + t];
                const float rstd = rsqrtf(tot * (1.0f / 256.0f) + 1e-6f);
                const int v0 = wid * 32 + (lane & 15);
                const float* op = zf + (size_t)(t0 + t) * ZF_LD + 3072 + h * 256 + v0;
                bh* yo = YC + (size_t)(t0 + t) * D + h * 256 + v0;
                yo[0] = f2bf(sigmoidf_(op[0]) * acc[a][0][r] * rstd * ng[v0]);
                yo[16] = f2bf(sigmoidf_(op[16]) * acc[a][1][r] * rstd * ng[v0 + 16]); } }
    __syncthreads();
}

__device__ __forceinline__ void rwkv_post(const Params& p, int L, int it, LAS unsigned char* lds) {
    const int tid = TIDX(), wid = tid >> 6, lane = tid & 63;
    const int h = it & 7, blk = it >> 3, j = blk >> 3;
    LAS float* bufA = (LAS float*)lds;
    LAS float* bufB = bufA + 64 * 65;
    LAS float* bufP = bufB + 64 * 65;
    const float* SE = (const float*)(P_WS + OFF_RSEND) + (size_t)(h * 4) * 4096; const float* PE = (const float*)(P_WS + OFF_RPEND) + (size_t)(h * 4) * 4096;
    LAS float* sst = bufA;
    if (j >= 1) {
        const int v = tid >> 3, k8 = (tid & 7) * 8;
        { const f32x4 a0 = *(const f32x4*)(SE + v * 64 + k8), a1 = *(const f32x4*)(SE + v * 64 + k8 + 4);
#pragma unroll
          for (int e = 0; e < 4; ++e) { bufA[v * 65 + k8 + e] = a0[e]; bufA[v * 65 + k8 + 4 + e] = a1[e]; } }
        for (int jj = 1; jj < j; ++jj) {
            { const f32x4 p0 = *(const f32x4*)(PE + (size_t)jj * 4096 + v * 64 + k8), p1 = *(const f32x4*)(PE + (size_t)jj * 4096 + v * 64 + k8 + 4);
              *(LAS f32x4*)(bufP + v * 64 + k8) = p0; *(LAS f32x4*)(bufP + v * 64 + k8 + 4) = p1; }
            __syncthreads();
            LAS float* src = (jj & 1) ? bufA : bufB; LAS float* dst = (jj & 1) ? bufB : bufA;
            f32x4 c0 = *(const f32x4*)(SE + (size_t)jj * 4096 + v * 64 + k8), c1 = *(const f32x4*)(SE + (size_t)jj * 4096 + v * 64 + k8 + 4);
#pragma unroll 8
            for (int i = 0; i < 64; ++i) { const float a = src[v * 65 + i]; const f32x4 p0 = *(const LAS f32x4*)(bufP + i * 64 + k8), p1 = *(const LAS f32x4*)(bufP + i * 64 + k8 + 4); c0 += a * p0; c1 += a * p1; }
#pragma unroll
            for (int e = 0; e < 4; ++e) { dst[v * 65 + k8 + e] = c0[e]; dst[v * 65 + k8 + 4 + e] = c1[e]; }
            __syncthreads();
            sst = dst;
        }
        __syncthreads();
    }
    float srow[64];
    if (j >= 1) {
#pragma unroll
        for (int i = 0; i < 64; ++i) srow[i] = sst[lane * 65 + i];
    } else {
#pragma unroll
        for (int i = 0; i < 64; ++i) srow[i] = 0.f;
    }
    const int c = h * 64 + lane;
    const float rkw = P_IN(16)[L * 512 + c], lg = P_IN(17)[L * 512 + c], lb = P_IN(18)[L * 512 + c];
    const float* RY = (const float*)(P_WS + OFF_RY); const float* RZ = (const float*)(P_WS + OFF_RZ); const float* RR = (const float*)(P_WS + OFF_RR); const float* RK = (const float*)(P_WS + OFF_RK);
    const float* RV = (const float*)(P_WS + OFF_RV); const float* RG = (const float*)(P_WS + OFF_RG); bh* YC = (bh*)(P_WS + OFF_YCAT);
    for (int i = 0; i < 32; ++i) { const int t = blk * 256 + wid * 32 + i; const size_t o = (size_t)t * 512 + c;
        float y = RY[o];
        if (j >= 1) { const float z = RZ[o]; float y2 = 0.f;
#pragma unroll
            for (int q = 0; q < 64; q += 2) { y = fmaf(srow[q], __builtin_bit_cast(float, __builtin_amdgcn_readlane(__builtin_bit_cast(int, z), q)), y);
                                              y2 = fmaf(srow[q + 1], __builtin_bit_cast(float, __builtin_amdgcn_readlane(__builtin_bit_cast(int, z), q + 1)), y2); }
            y += y2; }
        const float mu = wave_sum(y) * (1.0f / 64.0f); const float dlt = y - mu; const float var = wave_sum(dlt * dlt) * (1.0f / 64.0f);
        const float yn = dlt * rsqrtf(var + 64e-5f) * lg + lb;
        const float bon = wave_sum(RR[o] * RK[o] * rkw) * RV[o];
        YC[(size_t)t * D + 1024 + c] = f2bf((yn + bon) * RG[o]); }
    __syncthreads();
}

__device__ __forceinline__ void phase_post(const Params& p, int L, LAS unsigned char* lds) {
    for (int it = BIDX(); it < 768; it += GDIM()) {
        if (it < 512) mlstm_out(p, L, it >> 7, it & 127, lds);
        else rwkv_post(p, L, it - 512, lds);
    }
    __syncthreads();
}

constexpr int NPHASE = 27;
__global__ void __launch_bounds__(512, 2) hybrid_fwd(Params p, int ph_lo, int ph_hi, int rep_q) {
    extern __shared__ __attribute__((aligned(16))) unsigned char smem_raw[];
    LAS unsigned char* lds = (LAS unsigned char*)smem_raw;
    cg::grid_group grid = cg::this_grid();
    for (int ph = ph_lo; ph < ph_hi; ++ph) {
        if (ph > ph_lo) grid.sync();
        if (ph == 26) {
            const int gw = BIDX() * 8 + (TIDX() >> 6), NGW = GDIM() * 8, lane = TIDX() & 63;
            for (int r = gw; r < T; r += NGW) { float* x = P_OUT + (size_t)r * D; f32x4 v[8]; float s = 0.f;
#pragma unroll
                for (int j = 0; j < 8; ++j) { v[j] = *(const f32x4*)(x + j * 256 + lane * 4); s += (v[j][0] * v[j][0] + v[j][1] * v[j][1]) + (v[j][2] * v[j][2] + v[j][3] * v[j][3]); }
                const float rstd = rsqrtf(wave_sum(s) * (1.0f / D) + 1e-6f);
#pragma unroll
                for (int j = 0; j < 8; ++j) { const f32x4 gg = *(const f32x4*)(P_IN(40) + j * 256 + lane * 4); *(f32x4*)(x + j * 256 + lane * 4) = v[j] * rstd * gg; } }
            continue;
        }
        const int L = ph / 13, q = ph % 13;
#ifdef ONLY_Q
        if (q != ONLY_Q) continue;
#endif
        const int nrep = (q == rep_q) ? 2 : 1;
        for (int rep = 0; rep < nrep; ++rep) {
        if (rep) grid.sync();
        switch (q) {
        case 0: phase_conv(p, L, lds); break;
        case 2: phase_prep(p, L, lds); break;
        case 4: phase_scan(p, L, lds); break;
        case 5: phase_post(p, L, lds); break;
        case 8: phase_rmsnorm(p, P_IN(33) + (size_t)L * D); break;
        case 11: phase_rmsnorm(p, P_IN(37) + (size_t)L * D); break;
        default: break;
        }
        for (int i = 0; i < 3; ++i) {
            pg8::Gemm g;
            if (!make_gemm(p, L, q, i, g)) break;
            pg8::StaticOrder S; S.init(T, g.N, GDIM(), BIDX());
            pg8::gemm_phase(lds, g, S);
        }
        if (q == 3) phase_s5c(p, L, lds);
        }
    }
}

extern "C" void kernel_launch(void* const* d_in, const int* in_sizes, int n_in, void* d_out, int out_size, void* d_ws, size_t ws_size, hipStream_t stream) {
    constexpr size_t kDynLds = 131072;
    static int grid_blocks = 0;
    if (!grid_blocks) {
        int dev = 0, cus = 0, per_cu = 0;
        (void)hipGetDevice(&dev);
        (void)hipDeviceGetAttribute(&cus, hipDeviceAttributeMultiprocessorCount, dev);
        (void)hipFuncSetAttribute((const void*)hybrid_fwd, hipFuncAttributeMaxDynamicSharedMemorySize, (int)kDynLds);
        (void)hipOccupancyMaxActiveBlocksPerMultiprocessor(&per_cu, hybrid_fwd, 512, kDynLds);
        if (per_cu > 1) per_cu = 1;
        grid_blocks = cus * per_cu;
        if (ws_size < WS_TOTAL) fprintf(stderr, "workspace too small: %zu < %zu\n", ws_size, (size_t)WS_TOTAL);
    }
    Params p{};
    for (int i = 0; i < 41; ++i) p.in[i] = (const float*)d_in[i];
    p.out = (float*)d_out; p.ws = (unsigned char*)d_ws;
#if SINGLE_LAUNCH
    int lo = 0, hi = NPHASE, rq = PROBE_REP_Q;
    void* args[] = {&p, &lo, &hi, &rq};
    hipError_t e = hipLaunchCooperativeKernel((const void*)hybrid_fwd, dim3(grid_blocks), dim3(512), args, kDynLds, stream);
    if (e != hipSuccess) fprintf(stderr, "cooperative launch failed: %s (grid %d)\n", hipGetErrorString(e), grid_blocks);
#else
    for (int ph = 0; ph < NPHASE; ++ph) {
        int lo = ph, hi = ph + 1, rq = -1;
        void* args[] = {&p, &lo, &hi, &rq};
        hipError_t e = hipLaunchCooperativeKernel((const void*)hybrid_fwd, dim3(grid_blocks), dim3(512), args, kDynLds, stream);
        if (e != hipSuccess) fprintf(stderr, "cooperative launch failed: %s (grid %d)\n", hipGetErrorString(e), grid_blocks);
    }
#endif
}
```

```cpp
#include <hip/hip_runtime.h>
#include <hip/hip_cooperative_groups.h>
#include <cstdio>
#include <cstdint>
namespace cg = cooperative_groups;

#define LAS __attribute__((address_space(3)))
typedef unsigned short bh;
typedef short bf16x8 __attribute__((ext_vector_type(8)));
typedef float f32x4 __attribute__((ext_vector_type(4)));
typedef float f32x16 __attribute__((ext_vector_type(16)));
typedef unsigned u32x4 __attribute__((ext_vector_type(4)));
typedef unsigned u32x2 __attribute__((ext_vector_type(2)));

#ifndef PROBE_RW
#define PROBE_RW 1
#define PROBE_ML 1
#endif
#ifndef PROBE_REP_Q
#define PROBE_REP_Q (-1)
#endif
#ifndef SINGLE_LAUNCH
#define SINGLE_LAUNCH 1
#endif

constexpr int T = 8192, D = 2048, FH = 5632;
constexpr int NIN = 12744, NGATE = 6144, NF = 6600, ZF_LD = 6656, NINP = 12800;
constexpr int ZR0 = 4104, ZS0 = 6088;
constexpr int NCH = 128;

constexpr size_t AL(size_t x) { return (x + 255) & ~(size_t)255; }
constexpr size_t SZ_WIN = (size_t)NINP * D * 2, SZ_SQ = (size_t)D * D * 2, SZ_WGU = (size_t)2 * FH * D * 2, SZ_WD = (size_t)D * FH * 2;
constexpr size_t OFF_WIN = 0;
constexpr size_t OFF_WUP = OFF_WIN + SZ_WIN;
constexpr size_t OFF_WO = OFF_WUP + SZ_SQ;
constexpr size_t OFF_WGU = OFF_WO + SZ_SQ;
constexpr size_t OFF_WD = OFF_WGU + SZ_WGU;
constexpr size_t OFF_WPG = OFF_WD + SZ_WD;
constexpr size_t OFF_WPP = OFF_WPG + SZ_SQ;
constexpr size_t OFF_WGLU = OFF_WPP + (size_t)D * 256 * 2;
constexpr size_t OFF_WW2 = OFF_WGLU + (size_t)512 * 512 * 2;
constexpr size_t OFF_WA2 = OFF_WW2 + (size_t)512 * 256 * 2;
constexpr size_t OFF_WG2 = OFF_WA2 + (size_t)512 * 256 * 2;
constexpr size_t OFF_PBF = OFF_WG2 + (size_t)512 * 256 * 2;
constexpr size_t OFF_ABF = OFF_PBF + (size_t)2 * T * 256 * 2;
constexpr size_t OFF_YCAT = OFF_ABF + (size_t)T * D * 2;
constexpr size_t OFF_ZF = OFF_YCAT + (size_t)T * D * 2;
constexpr size_t OFF_ACT = OFF_ZF;
constexpr size_t OFF_MIX32 = OFF_ZF + (size_t)100663296;
constexpr size_t OFF_ZG = OFF_ZF + (size_t)T * ZF_LD * 4;
constexpr size_t SZ_R = (size_t)T * 512 * 4;
constexpr size_t OFF_RR = OFF_ZG + (size_t)T * NGATE * 2;
constexpr size_t OFF_RK = OFF_RR + SZ_R, OFF_RV = OFF_RK + SZ_R, OFF_RKK = OFF_RV + SZ_R, OFF_RW = OFF_RKK + SZ_R, OFF_RB = OFF_RW + SZ_R, OFF_RG = OFF_RB + SZ_R, OFF_RY = OFF_RG + SZ_R;
constexpr size_t OFF_LAW = OFF_RY + SZ_R;
constexpr size_t OFF_LAA = OFF_LAW + (size_t)T * 256 * 2, OFF_LAG = OFF_LAA + (size_t)T * 256 * 2;
constexpr size_t SZ_MB = (size_t)T * 1024 * 2;
constexpr size_t OFF_MQ = OFF_LAG + (size_t)T * 256 * 2, OFF_MK = OFF_MQ + SZ_MB, OFF_MKT = OFF_MK + SZ_MB, OFF_MVT = OFF_MKT + SZ_MB;
constexpr size_t OFF_MI = OFF_MVT + SZ_MB;
constexpr size_t OFF_MBB = OFF_MI + (size_t)4 * T * 4;
constexpr size_t OFF_MBEND = OFF_MBB + (size_t)4 * T * 4;
constexpr size_t OFF_MLOC = OFF_MBEND + 2048, OFF_MSTART = OFF_MLOC + 2048;
constexpr size_t OFF_DN = OFF_MSTART + 2048;
constexpr size_t OFF_NST = OFF_DN + (size_t)4 * NCH * 256 * 4;
constexpr size_t OFF_SEND = OFF_NST + (size_t)4 * NCH * 256 * 4;
constexpr size_t OFF_YS = OFF_SEND + (size_t)32 * NCH * 64 * 8;
constexpr size_t OFF_RZ = OFF_YS + (size_t)T * 512 * 2;
constexpr size_t OFF_RSEND = OFF_RZ + SZ_R;
constexpr size_t OFF_RPEND = OFF_RSEND + (size_t)8 * 4 * 4096 * 4;
constexpr size_t OFF_MINTER2 = OFF_RPEND + (size_t)8 * 4 * 4096 * 4;
constexpr size_t WS_TOTAL = OFF_MINTER2 + (size_t)T * 1024 * 4;

struct Params { const float* in[41]; float* out; unsigned char* ws; };
#define KARG4 __attribute__((address_space(4)))
__device__ __forceinline__ const float* karg_in(int i) { const KARG4 char* ka = (const KARG4 char*)__builtin_amdgcn_kernarg_segment_ptr(); return *(const float* const volatile KARG4*)(ka + (size_t)i * 8); }
#define P_IN(i) karg_in(i)
#define P_OUT ((float*)karg_in(41))
#define P_WS ((unsigned char*)karg_in(42))

__device__ __forceinline__ int TIDX() { int t = threadIdx.x; asm volatile("" : "+v"(t)); return t; }
__device__ __forceinline__ int BIDX() { int t = blockIdx.x; asm volatile("" : "+s"(t)); return t; }
__device__ __forceinline__ int GDIM() { int t = gridDim.x; asm volatile("" : "+s"(t)); return t; }
__device__ __forceinline__ bh f2bf(float f) { unsigned u = __float_as_uint(f); u += 0x7fffu + ((u >> 16) & 1u); return (bh)(u >> 16); }
__device__ __forceinline__ float bf2f(bh h) { return __uint_as_float(((unsigned)h) << 16); }
__device__ __forceinline__ unsigned pk2(float lo, float hi) { return (unsigned)f2bf(lo) | ((unsigned)f2bf(hi) << 16); }
__device__ __forceinline__ float sigmoidf_(float x) { return 1.0f / (1.0f + __expf(-x)); }
__device__ __forceinline__ float bperm_f(int srclane, float v) { return __builtin_bit_cast(float, __builtin_amdgcn_ds_bpermute(srclane << 2, __builtin_bit_cast(int, v))); }
__device__ __forceinline__ float wave_sum(float v) {
    const int lane = TIDX() & 63;
#pragma unroll
    for (int o = 32; o >= 1; o >>= 1) v += bperm_f(lane ^ o, v);
    return v;
}
__device__ __forceinline__ float wave_max(float v) {
    const int lane = TIDX() & 63;
#pragma unroll
    for (int o = 32; o >= 1; o >>= 1) v = fmaxf(v, bperm_f(lane ^ o, v));
    return v;
}
template <int CTRL> __device__ __forceinline__ float dpp_f(float x) {
    return __builtin_bit_cast(float, __builtin_amdgcn_update_dpp(0, __builtin_bit_cast(int, x), CTRL, 0xf, 0xf, true));
}
__device__ __forceinline__ float allreduce16(float x) {
    x += dpp_f<0xB1>(x); x += dpp_f<0x4E>(x); x += dpp_f<0x141>(x); x += dpp_f<0x140>(x);
    return x;
}
__device__ __forceinline__ float OZ() { float z = 0.f; asm volatile("" : "+v"(z)); return z; }
#define MFMA16(a, b, c) __builtin_amdgcn_mfma_f32_16x16x32_bf16(a, b, c, 0, 0, 0)
#define MFMA32(a, b, c) __builtin_amdgcn_mfma_f32_32x32x16_bf16(a, b, c, 0, 0, 0)

namespace pg8 {
constexpr int BM = 256, BK = 64, HALF = 128, HTB = HALF * BK * 2, STAGE_BYTES = 8 * HTB, NXCD = 8, WGM = 8;
__device__ __forceinline__ int lds_byte(int r, int c) { const int st = (r >> 4) * 2 + (c >> 5), rr = r & 15, cc = c & 31, ob = rr * 64 + cc * 2; return st * 1024 + (ob ^ (((ob >> 9) & 1) << 5)); }
__device__ __forceinline__ void stage_rc(int b, int& R, int& C) { const int st = b / 1024, sb = b % 1024, swz = sb ^ (((sb >> 9) & 1) << 5); R = (st >> 1) * 16 + swz / 64; C = (st & 1) * 32 + (swz % 64) / 2; }
__device__ __forceinline__ int perm32(int rho) { const int n = rho >> 4, i = rho & 15; return 8 * (i >> 2) + 4 * n + (i & 3); }
struct Unit { int pm, pn; };
struct Gemm { const bh* A; const bh* Bt; int M, N, K, lda, ldb, epi, perm, L; };
struct StaticOrder {
    int nM, nN, nwg, G, c;
    __device__ void init(int M, int N, int G_, int c_) { nM = M / BM; nN = N / BM; nwg = nM * nN; G = G_; c = c_; }
    __device__ bool next(int i, Unit& u) const {
        const long L = (long)i * G + c; if (L >= nwg) return false;
        int wgid = (int)L; { const int q = nwg / NXCD, r = nwg % NXCD, xcd = wgid % NXCD, off = wgid / NXCD; wgid = (xcd < r ? xcd * (q + 1) : r * (q + 1) + (xcd - r) * q) + off; }
        const int nig = WGM * nN, gid = wgid / nig, fm = gid * WGM, gsz = (nM - fm) < WGM ? (nM - fm) : WGM;
        u.pm = fm + ((wgid % nig) % gsz); u.pn = (wgid % nig) / gsz; return true;
    }
};
__device__ __forceinline__ unsigned cvt_pk_bf16(float lo, float hi) { unsigned r; asm volatile("v_cvt_pk_bf16_f32 %0, %1, %2" : "=v"(r) : "v"(lo), "v"(hi)); return r; }

__device__ __forceinline__ void epi_run(const Gemm& g, const f32x4 (&acc)[2][2][4][2], const Unit& u, int wr, int wc, int fr, int fq);
__device__ __forceinline__ void gemm_phase(LAS unsigned char* lds, const Gemm& g, const StaticOrder& S) {
    const int tid = TIDX(), wid = __builtin_amdgcn_readfirstlane(tid >> 6), lane = tid & 63, wr = wid >> 2, wc = wid & 3, fr = lane & 15, fq = lane >> 4;
    const int K = g.K, nt = K / BK;
    unsigned voffA[2], voffB[2];
#pragma unroll
    for (int i = 0; i < 2; ++i) { int R, C; stage_rc(tid * 16 + i * 8192, R, C); const int Rb = g.perm ? ((R & ~31) + perm32(R & 31)) : R;
        voffA[i] = (unsigned)(R * g.lda + C) * 2u; voffB[i] = (unsigned)(Rb * g.ldb + C) * 2u; }
    const size_t kstep = (size_t)(BK * 2);
    const size_t hstepA = (size_t)HALF * g.lda * 2, hstepB = (size_t)HALF * g.ldb * 2;
    const size_t tstepA = 2 * hstepA, tstepB = 2 * hstepB;
    const unsigned ldsw = (unsigned)wid * 1024u;
    const int aoff = lds_byte(wr * 64 + fr, fq * 8), boff = lds_byte(wc * 32 + fr, fq * 8);
#define PG8_SA(b, h) (((b) * 2 + (h)) * HTB)
#define PG8_SB(b, h) ((4 + (b) * 2 + (h)) * HTB)
#define PG8_STAGE(bufoff, gbase, voff) do { _Pragma("unroll") for (int _i = 0; _i < 2; ++_i) \
        __builtin_amdgcn_global_load_lds((const unsigned*)((const char*)(gbase) + (voff)[_i]), (LAS unsigned*)(lds + (bufoff) + ldsw + _i * 8192), 16, 0, 0); } while (0)
#define PG8_LDA(dst, b, h) do { _Pragma("unroll") for (int m = 0; m < 4; ++m) _Pragma("unroll") for (int k = 0; k < 2; ++k) dst[m][k] = *(const LAS bf16x8*)(lds + PG8_SA(b, h) + aoff + m * 2048 + k * 1024); } while (0)
#define PG8_LDB(dst, b, h) do { _Pragma("unroll") for (int n = 0; n < 2; ++n) _Pragma("unroll") for (int k = 0; k < 2; ++k) dst[n][k] = *(const LAS bf16x8*)(lds + PG8_SB(b, h) + boff + n * 2048 + k * 1024); } while (0)
#define PG8_MMA(ai, bj, At, Bt) do { __builtin_amdgcn_s_setprio(1); _Pragma("unroll") for (int m = 0; m < 4; ++m) _Pragma("unroll") for (int n = 0; n < 2; ++n) _Pragma("unroll") for (int k = 0; k < 2; ++k) \
        acc[ai][bj][m][n] = __builtin_amdgcn_mfma_f32_16x16x32_bf16(Bt[n][k], At[m][k], acc[ai][bj][m][n], 0, 0, 0); __builtin_amdgcn_s_setprio(0); } while (0)
#define PG8_WAIT_V(n) asm volatile("s_waitcnt vmcnt(" #n ")" ::: "memory")
#define PG8_WAIT_L(n) asm volatile("s_waitcnt lgkmcnt(" #n ")" ::: "memory")
#define PG8_BAR __builtin_amdgcn_s_barrier()
#define PG8_SCHED __builtin_amdgcn_sched_barrier(0)
    Unit cur, nxt; int ui = 0;
    if (!S.next(0, cur)) return;
    f32x4 acc[2][2][4][2];
    { const float z = OZ();
#pragma unroll
    for (int a = 0; a < 2; ++a)
#pragma unroll
        for (int b = 0; b < 2; ++b)
#pragma unroll
            for (int m = 0; m < 4; ++m)
#pragma unroll
                for (int n = 0; n < 2; ++n) acc[a][b][m][n] = (f32x4){z, z, z, z}; }
    bf16x8 At[4][2], B0[2][2], B1[2][2];
    const char* cA = (const char*)g.A + (size_t)cur.pm * tstepA; const char* cB = (const char*)g.Bt + (size_t)cur.pn * tstepB;
    PG8_STAGE(PG8_SB(0, 0), cB, voffB); PG8_STAGE(PG8_SA(0, 0), cA, voffA); PG8_STAGE(PG8_SB(0, 1), cB + hstepB, voffB); PG8_STAGE(PG8_SA(0, 1), cA + hstepA, voffA);
    if (wr == 1) PG8_BAR;
    PG8_WAIT_V(4); PG8_BAR;
    PG8_STAGE(PG8_SB(1, 0), cB + kstep, voffB); PG8_STAGE(PG8_SA(1, 0), cA + kstep, voffA); PG8_STAGE(PG8_SB(1, 1), cB + hstepB + kstep, voffB);
    PG8_WAIT_V(6); PG8_BAR;
    for (;;) {
        const bool has_next = S.next(ui + 1, nxt);
        const char* nA = has_next ? (const char*)g.A + (size_t)nxt.pm * tstepA : cA; const char* nB = has_next ? (const char*)g.Bt + (size_t)nxt.pn * tstepB : cB;
        for (int t = 0; t < nt; t += 2) {
            const bool last = (t == nt - 2);
            const char* a1 = cA + (size_t)(t + 1) * kstep;
            const char* a2 = last ? nA : cA + (size_t)(t + 2) * kstep; const char* b2 = last ? nB : cB + (size_t)(t + 2) * kstep;
            const char* a3 = a2 + kstep; const char* b3 = b2 + kstep;
            PG8_LDB(B0, 0, 0); PG8_SCHED; PG8_LDA(At, 0, 0); PG8_STAGE(PG8_SA(1, 1), a1 + hstepA, voffA);
            PG8_WAIT_L(8); PG8_BAR; PG8_WAIT_L(0); PG8_MMA(0, 0, At, B0); PG8_BAR; PG8_SCHED;
            PG8_LDB(B1, 0, 1); PG8_STAGE(PG8_SB(0, 0), b2, voffB);
            PG8_BAR; PG8_WAIT_L(0); PG8_MMA(0, 1, At, B1); PG8_BAR;
            PG8_LDA(At, 0, 1); PG8_STAGE(PG8_SA(0, 0), a2, voffA);
            PG8_BAR; PG8_WAIT_L(0); PG8_MMA(1, 0, At, B0); PG8_BAR; PG8_SCHED;
            PG8_STAGE(PG8_SB(0, 1), b2 + hstepB, voffB);
            PG8_WAIT_V(6); PG8_BAR; PG8_MMA(1, 1, At, B1); PG8_BAR;
            PG8_LDB(B0, 1, 0); PG8_SCHED; PG8_LDA(At, 1, 0); PG8_STAGE(PG8_SA(0, 1), a2 + hstepA, voffA);
            PG8_WAIT_L(8); PG8_BAR; PG8_WAIT_L(0); PG8_MMA(0, 0, At, B0); PG8_BAR; PG8_SCHED;
            PG8_LDB(B1, 1, 1); PG8_STAGE(PG8_SB(1, 0), b3, voffB);
            PG8_BAR; PG8_WAIT_L(0); PG8_MMA(0, 1, At, B1); PG8_BAR;
            PG8_LDA(At, 1, 1); PG8_STAGE(PG8_SA(1, 0), a3, voffA);
            PG8_BAR; PG8_WAIT_L(0); PG8_MMA(1, 0, At, B0); PG8_BAR; PG8_SCHED;
            PG8_STAGE(PG8_SB(1, 1), b3 + hstepB, voffB);
            PG8_WAIT_V(6); PG8_BAR; PG8_MMA(1, 1, At, B1); PG8_BAR;
        }
        epi_run(g, acc, cur, wr, wc, fr, fq);
        if (!has_next) break;
        { const float z = OZ();
#pragma unroll
        for (int a = 0; a < 2; ++a)
#pragma unroll
            for (int b = 0; b < 2; ++b)
#pragma unroll
                for (int m = 0; m < 4; ++m)
#pragma unroll
                    for (int n = 0; n < 2; ++n) acc[a][b][m][n] = (f32x4){z, z, z, z}; }
        cur = nxt; cA = nA; cB = nB; ++ui;
    }
    PG8_WAIT_V(0);
    if (wr == 0) PG8_BAR;
    PG8_BAR;
#undef PG8_SA
#undef PG8_SB
#undef PG8_STAGE
#undef PG8_LDA
#undef PG8_LDB
#undef PG8_MMA
#undef PG8_WAIT_V
#undef PG8_WAIT_L
#undef PG8_BAR
#undef PG8_SCHED
}
}
using pg8::Unit;
using pg8::cvt_pk_bf16;

#define EPI_FOR_NP(...) \
    _Pragma("unroll") for (int ai = 0; ai < 2; ++ai) _Pragma("unroll") for (int m = 0; m < 4; ++m) { const int row = u.pm * 256 + ai * 128 + wr * 64 + m * 16 + fr; \
    _Pragma("unroll") for (int bj = 0; bj < 2; ++bj) _Pragma("unroll") for (int n = 0; n < 2; ++n) { const int col = u.pn * 256 + bj * 128 + wc * 32 + n * 16 + 4 * fq; const f32x4 v = acc[ai][bj][m][n]; __VA_ARGS__ } }

typedef const f32x4 (&AccRef)[2][2][4][2];

struct EpiWin {
    static constexpr bool PERM = false;
    bh* zg; float* zf;
    __device__ __forceinline__ void operator()(AccRef acc, const Unit& u, int wr, int wc, int fr, int fq) const {
        if (u.pn < 24) {
            EPI_FOR_NP({ u32x2 w; w.x = cvt_pk_bf16(sigmoidf_(v[0]), sigmoidf_(v[1])); w.y = cvt_pk_bf16(sigmoidf_(v[2]), sigmoidf_(v[3])); *(u32x2*)(zg + (size_t)row * NGATE + col) = w; })
        } else {
            EPI_FOR_NP({ *(f32x4*)(zf + (size_t)row * ZF_LD + (col - NGATE)) = v; })
        }
    }
};
struct EpiLoraW {
    static constexpr bool PERM = false;
    const float* w0; float* rw;
    __device__ __forceinline__ void operator()(AccRef acc, const Unit& u, int wr, int wc, int fr, int fq) const {
        EPI_FOR_NP({ const f32x4 b = *(const f32x4*)(w0 + col); f32x4 o;
            _Pragma("unroll") for (int j = 0; j < 4; ++j) { const float x = -(b[j] + v[j]); const float sp = fmaxf(x, 0.f) + log1pf(__expf(-fabsf(x))); o[j] = __expf(-__expf(-sp - 0.5f)); }
            *(f32x4*)(rw + (size_t)row * 512 + col) = o; })
    }
};
struct EpiLoraA {
    static constexpr bool PERM = false;
    const float* a0; const float* ka; const float* rkk; float* rb; float* rk;
    __device__ __forceinline__ void operator()(AccRef acc, const Unit& u, int wr, int wc, int fr, int fq) const {
        EPI_FOR_NP({ const f32x4 b0 = *(const f32x4*)(a0 + col); const f32x4 kav = *(const f32x4*)(ka + col); const size_t o = (size_t)row * 512 + col;
            const f32x4 kkv = *(const f32x4*)(rkk + o); f32x4 kv = *(const f32x4*)(rk + o); f32x4 bo;
            _Pragma("unroll") for (int j = 0; j < 4; ++j) { const float a = sigmoidf_(b0[j] + v[j]); bo[j] = kkv[j] * a; kv[j] = kv[j] * (1.0f + (a - 1.0f) * kav[j]); }
            *(f32x4*)(rb + o) = bo; *(f32x4*)(rk + o) = kv; })
    }
};
struct EpiStoreF32 {
    static constexpr bool PERM = false;
    float* o; int ld;
    __device__ __forceinline__ void operator()(AccRef acc, const Unit& u, int wr, int wc, int fr, int fq) const {
        EPI_FOR_NP({ *(f32x4*)(o + (size_t)row * ld + col) = v; })
    }
};
struct EpiGlu {
    static constexpr bool PERM = false;
    const bh* ys; const float* gb; bh* ycat;
    __device__ __forceinline__ void operator()(AccRef acc, const Unit& u, int wr, int wc, int fr, int fq) const {
        EPI_FOR_NP({ const f32x4 b = *(const f32x4*)(gb + col); const u32x2 y2 = *(const u32x2*)(ys + (size_t)row * 512 + col);
            const float y0 = __uint_as_float(y2.x << 16), y1 = __uint_as_float(y2.x & 0xffff0000u), y2f = __uint_as_float(y2.y << 16), y3 = __uint_as_float(y2.y & 0xffff0000u);
            u32x2 w; w.x = cvt_pk_bf16(y0 * sigmoidf_(v[0] + b[0]), y1 * sigmoidf_(v[1] + b[1])); w.y = cvt_pk_bf16(y2f * sigmoidf_(v[2] + b[2]), y3 * sigmoidf_(v[3] + b[3]));
            *(u32x2*)(ycat + (size_t)row * D + 1536 + col) = w; })
    }
};
template <int MODE> struct EpiUp {
    static constexpr bool PERM = false;
    const bh* zg; float* mix; bh* mixed;
    __device__ __forceinline__ void operator()(AccRef acc, const Unit& u, int wr, int wc, int fr, int fq) const {
        EPI_FOR_NP({ const u32x2 g2 = *(const u32x2*)(zg + (size_t)row * NGATE + col);
            f32x4 g; g[0] = __uint_as_float(g2.x << 16); g[1] = __uint_as_float(g2.x & 0xffff0000u); g[2] = __uint_as_float(g2.y << 16); g[3] = __uint_as_float(g2.y & 0xffff0000u);
            f32x4 r = g * v; float* mp = mix + (size_t)row * D + col;
            if (MODE >= 1) r += *(const f32x4*)mp;
            if (MODE <= 1) *(f32x4*)mp = r;
            else { u32x2 w; w.x = cvt_pk_bf16(r[0], r[1]); w.y = cvt_pk_bf16(r[2], r[3]); *(u32x2*)(mixed + (size_t)row * D + col) = w; } })
    }
};
struct EpiRes {
    static constexpr bool PERM = false;
    float* h;
    __device__ __forceinline__ void operator()(AccRef acc, const Unit& u, int wr, int wc, int fr, int fq) const {
        EPI_FOR_NP({ float* hp = h + (size_t)row * D + col; *(f32x4*)hp = *(const f32x4*)hp + v; })
    }
};
struct EpiFfn {
    static constexpr bool PERM = true;
    bh* act;
    __device__ __forceinline__ void operator()(AccRef acc, const Unit& u, int wr, int wc, int fr, int fq) const {
#pragma unroll
        for (int ai = 0; ai < 2; ++ai)
#pragma unroll
            for (int m = 0; m < 4; ++m) { const int row = u.pm * 256 + ai * 128 + wr * 64 + m * 16 + fr; const int col = u.pn * 128 + wc * 32 + 8 * fq;
                float o[8];
#pragma unroll
                for (int n = 0; n < 2; ++n)
#pragma unroll
                    for (int j = 0; j < 4; ++j) { const float gte = acc[ai][0][m][n][j], up = acc[ai][1][m][n][j]; o[n * 4 + j] = gte * sigmoidf_(gte) * up; }
                u32x4 w; w.x = cvt_pk_bf16(o[0], o[1]); w.y = cvt_pk_bf16(o[2], o[3]); w.z = cvt_pk_bf16(o[4], o[5]); w.w = cvt_pk_bf16(o[6], o[7]);
                *(u32x4*)(act + (size_t)row * FH + col) = w; }
    }
};
struct EpiPle {
    static constexpr bool PERM = false;
    float* h; const float* tmp;
    __device__ __forceinline__ void operator()(AccRef acc, const Unit& u, int wr, int wc, int fr, int fq) const {
        EPI_FOR_NP({ float* hp = h + (size_t)row * D + col; const f32x4 tv = *(const f32x4*)(tmp + (size_t)row * D + col); f32x4 hv = *(const f32x4*)hp;
            _Pragma("unroll") for (int j = 0; j < 4; ++j) hv[j] += tv[j] * sigmoidf_(v[j]);
            *(f32x4*)hp = hv; })
    }
};

namespace pg8 {
__device__ __forceinline__ void epi_run(const Gemm& g, const f32x4 (&acc)[2][2][4][2], const Unit& u, int wr, int wc, int fr, int fq) {
    unsigned char* ws = P_WS; const int L = g.L;
    switch (g.epi) {
    case 0: { EpiWin E{(bh*)(ws + OFF_ZG), (float*)(ws + OFF_ZF)}; E(acc, u, wr, wc, fr, fq); } break;
    case 1: { EpiLoraW E{P_IN(9) + L * 512, (float*)(ws + OFF_RW)}; E(acc, u, wr, wc, fr, fq); } break;
    case 2: { EpiLoraA E{P_IN(11) + L * 512, P_IN(15) + L * 512, (const float*)(ws + OFF_RKK), (float*)(ws + OFF_RB), (float*)(ws + OFF_RK)}; E(acc, u, wr, wc, fr, fq); } break;
    case 3: { EpiStoreF32 E{(float*)(ws + (g.N == 512 ? OFF_RG : OFF_MIX32)), g.N}; E(acc, u, wr, wc, fr, fq); } break;
    case 4: { EpiGlu E{(const bh*)(ws + OFF_YS), P_IN(28) + L * 512, (bh*)(ws + OFF_YCAT)}; E(acc, u, wr, wc, fr, fq); } break;
    case 5: { EpiUp<0> E{(const bh*)(ws + OFF_ZG), (float*)(ws + OFF_MIX32), (bh*)(ws + OFF_ABF)}; E(acc, u, wr, wc, fr, fq); } break;
    case 6: { EpiUp<1> E{(const bh*)(ws + OFF_ZG) + 2048, (float*)(ws + OFF_MIX32), (bh*)(ws + OFF_ABF)}; E(acc, u, wr, wc, fr, fq); } break;
    case 7: { EpiUp<2> E{(const bh*)(ws + OFF_ZG) + 4096, (float*)(ws + OFF_MIX32), (bh*)(ws + OFF_ABF)}; E(acc, u, wr, wc, fr, fq); } break;
    case 8: { EpiRes E{P_OUT}; E(acc, u, wr, wc, fr, fq); } break;
    case 9: { EpiFfn E{(bh*)(ws + OFF_ACT)}; E(acc, u, wr, wc, fr, fq); } break;
    default: { EpiPle E{P_OUT, (const float*)(ws + OFF_MIX32)}; E(acc, u, wr, wc, fr, fq); } break;
    }
}
}

__device__ __forceinline__ bool make_gemm(const Params& p, int L, int q, int i, pg8::Gemm& g) {
    unsigned char* ws = P_WS;
    g.M = T; g.perm = 0; g.L = L;
    switch (q) {
    case 1: if (i > 0) return false;
        g.A = (const bh*)(ws + OFF_ABF); g.lda = D; g.Bt = (const bh*)(ws + OFF_WIN); g.ldb = D; g.N = NINP; g.K = D; g.epi = 0; return true;
    case 3: if (i > 2) return false;
        g.lda = 256; g.ldb = 256; g.N = 512; g.K = 256;
        if (i == 0) { g.A = (const bh*)(ws + OFF_LAW); g.Bt = (const bh*)(ws + OFF_WW2); g.epi = 1; }
        else if (i == 1) { g.A = (const bh*)(ws + OFF_LAA); g.Bt = (const bh*)(ws + OFF_WA2); g.epi = 2; }
        else { g.A = (const bh*)(ws + OFF_LAG); g.Bt = (const bh*)(ws + OFF_WG2); g.epi = 3; }
        return true;
    case 5: if (i > 0) return false;
        g.A = (const bh*)(ws + OFF_YS); g.lda = 512; g.Bt = (const bh*)(ws + OFF_WGLU); g.ldb = 512; g.N = 512; g.K = 512; g.epi = 4; return true;
    case 6: if (i > 2) return false;
        { const int ko = (i == 0) ? 0 : (i == 1) ? 1024 : 1536;
          g.A = (const bh*)(ws + OFF_YCAT) + ko; g.lda = D; g.Bt = (const bh*)(ws + OFF_WUP) + ko; g.ldb = D; g.N = D; g.K = (i == 0) ? 1024 : 512; g.epi = 5 + i;
          }
        return true;
    case 7: if (i > 0) return false;
        g.A = (const bh*)(ws + OFF_ABF); g.lda = D; g.Bt = (const bh*)(ws + OFF_WO); g.ldb = D; g.N = D; g.K = D; g.epi = 8; return true;
    case 9: if (i > 0) return false;
        g.A = (const bh*)(ws + OFF_ABF); g.lda = D; g.Bt = (const bh*)(ws + OFF_WGU); g.ldb = D; g.N = 2 * FH; g.K = D; g.epi = 9; g.perm = 1; return true;
    case 10: if (i > 0) return false;
        g.A = (const bh*)(ws + OFF_ACT); g.lda = FH; g.Bt = (const bh*)(ws + OFF_WD); g.ldb = FH; g.N = D; g.K = FH; g.epi = 8; return true;
    case 12: if (i > 1) return false;
        if (i == 0) { g.A = (const bh*)(ws + OFF_PBF) + (size_t)L * T * 256; g.lda = 256; g.Bt = (const bh*)(ws + OFF_WPP); g.ldb = 256; g.N = D; g.K = 256; g.epi = 3; }
        else { g.A = (const bh*)(ws + OFF_ABF); g.lda = D; g.Bt = (const bh*)(ws + OFF_WPG); g.ldb = D; g.N = D; g.K = D; g.epi = 10; }
        return true;
    default: return false;
    }
}

struct CJ { const float* src; int in_idx, src_ld, kv, n0, nv; long lstride; size_t dst; int dst_ld, r0, c0, npad, kpad, seg, segstride; };
constexpr int BIGSEG = 1 << 30;
__constant__ int JT_I[15][12] = {
    {3, NIN, 2048, NF, NGATE, D, 0, 0, NGATE, 2048, BIGSEG, 0},
    {3, NIN, 2048, 0, NF, D, NGATE, 0, 6656, 2048, BIGSEG, 0},
    {29, D, 1024, 0, D, D, 0, 0, D, 1024, BIGSEG, 0},
    {30, D, 512, 0, D, D, 0, 1024, D, 512, BIGSEG, 0},
    {31, D, 512, 0, D, D, 0, 1536, D, 512, BIGSEG, 0},
    {32, D, 2048, 0, D, D, 0, 0, D, 2048, BIGSEG, 0},
    {34, FH, 2048, 0, FH, D, 0, 0, FH, 2048, 128, 256},
    {35, FH, 2048, 0, FH, D, 128, 0, FH, 2048, 128, 256},
    {36, D, FH, 0, D, FH, 0, 0, D, FH, BIGSEG, 0},
    {38, D, 2048, 0, D, D, 0, 0, D, 2048, BIGSEG, 0},
    {39, D, 256, 0, D, 256, 0, 0, D, 256, BIGSEG, 0},
    {27, 512, 512, 0, 512, 512, 0, 0, 512, 512, BIGSEG, 0},
    {10, 512, 96, 0, 512, 256, 0, 0, 512, 256, BIGSEG, 0},
    {12, 512, 96, 0, 512, 256, 0, 0, 512, 256, BIGSEG, 0},
    {13, 512, 256, 0, 512, 256, 0, 0, 512, 256, BIGSEG, 0}};
__constant__ long JT_L[15][2] = {
    {(long)D * NIN, (long)OFF_WIN}, {(long)D * NIN, (long)OFF_WIN}, {(long)1024 * D, (long)OFF_WUP}, {(long)512 * D, (long)OFF_WUP}, {(long)512 * D, (long)OFF_WUP},
    {(long)D * D, (long)OFF_WO}, {(long)D * FH, (long)OFF_WGU}, {(long)D * FH, (long)OFF_WGU}, {(long)FH * D, (long)OFF_WD}, {(long)D * D, (long)OFF_WPG},
    {(long)256 * D, (long)OFF_WPP}, {(long)512 * 512, (long)OFF_WGLU}, {(long)96 * 512, (long)OFF_WW2}, {(long)96 * 512, (long)OFF_WA2}, {(long)256 * 512, (long)OFF_WG2}};
__device__ __forceinline__ void get_job(int j, CJ& J) {
    J.in_idx = JT_I[j][0]; J.src_ld = JT_I[j][1]; J.kv = JT_I[j][2]; J.n0 = JT_I[j][3]; J.nv = JT_I[j][4]; J.dst_ld = JT_I[j][5]; J.r0 = JT_I[j][6]; J.c0 = JT_I[j][7];
    J.npad = JT_I[j][8]; J.kpad = JT_I[j][9]; J.seg = JT_I[j][10]; J.segstride = JT_I[j][11]; J.lstride = JT_L[j][0]; J.dst = (size_t)JT_L[j][1];
}
__device__ __forceinline__ const float* in_by_idx(const Params& p, int i) { return P_IN(i); }
constexpr int NJOBS = 15;

__device__ __forceinline__ void conv_tile(int L, const CJ& J, int tile, int lane, bh* dstbase) {
    const int nkt = J.kpad / 64; const int tn = tile / nkt, tk = tile % nkt;
    const float* src = J.src + (size_t)L * J.lstride;
    const int cq = lane & 15, r = lane >> 4;
    const int nl = tn * 64 + cq * 4; const bool nok = nl < J.nv;
    const int k0 = tk * 64 + 16 * r;
    f32x4 v[16];
    const float* sp = src + (size_t)k0 * J.src_ld + J.n0 + nl;
    const float zc = OZ();
#pragma unroll
    for (int i = 0; i < 16; ++i) { v[i] = (f32x4){zc, zc, zc, zc}; if (nok && (k0 + i) < J.kv) v[i] = *(const f32x4*)(sp + (size_t)i * J.src_ld); }
#pragma unroll
    for (int j = 0; j < 4; ++j) { const int n = nl + j; const int drow = J.r0 + (n / J.seg) * J.segstride + (n % J.seg);
        u32x4 w0, w1;
        w0.x = cvt_pk_bf16(v[0][j], v[1][j]); w0.y = cvt_pk_bf16(v[2][j], v[3][j]); w0.z = cvt_pk_bf16(v[4][j], v[5][j]); w0.w = cvt_pk_bf16(v[6][j], v[7][j]);
        w1.x = cvt_pk_bf16(v[8][j], v[9][j]); w1.y = cvt_pk_bf16(v[10][j], v[11][j]); w1.z = cvt_pk_bf16(v[12][j], v[13][j]); w1.w = cvt_pk_bf16(v[14][j], v[15][j]);
        bh* d = dstbase + (size_t)drow * J.dst_ld + J.c0 + k0;
        *(u32x4*)d = w0; *(u32x4*)(d + 8) = w1; }
}

__device__ __forceinline__ void rms_row_bf16(const float* x, const float* g, bh* o, int lane) {
    f32x4 v[8]; float s = 0.f;
#pragma unroll
    for (int j = 0; j < 8; ++j) { v[j] = *(const f32x4*)(x + j * 256 + lane * 4); s += (v[j][0] * v[j][0] + v[j][1] * v[j][1]) + (v[j][2] * v[j][2] + v[j][3] * v[j][3]); }
    const float rstd = rsqrtf(wave_sum(s) * (1.0f / D) + 1e-6f);
#pragma unroll
    for (int j = 0; j < 8; ++j) { const f32x4 gg = *(const f32x4*)(g + j * 256 + lane * 4); u32x2 w; w.x = pk2(v[j][0] * rstd * gg[0], v[j][1] * rstd * gg[1]); w.y = pk2(v[j][2] * rstd * gg[2], v[j][3] * rstd * gg[3]);
        *(u32x2*)(o + j * 256 + lane * 4) = w; }
}
__device__ __forceinline__ void phase_rmsnorm(const Params& p, const float* g) {
    const int gw = BIDX() * 8 + (TIDX() >> 6), NGW = GDIM() * 8, lane = TIDX() & 63;
    bh* abf = (bh*)(P_WS + OFF_ABF);
    for (int r = gw; r < T; r += NGW) rms_row_bf16(P_OUT + (size_t)r * D, g, abf + (size_t)r * D, lane);
}

__device__ __forceinline__ void phase_conv(const Params& p, int L, LAS unsigned char* lds) {
    const int tid = TIDX();
    {   const int gw0 = BIDX() * 8 + (tid >> 6), NGW0 = GDIM() * 8, ln = tid & 63;
        int base = 0;
        for (int j = 0; j < NJOBS; ++j) { CJ J; get_job(j, J); J.src = in_by_idx(p, J.in_idx); const int ntile = (J.npad / 64) * (J.kpad / 64);
            int first = gw0 - (base % NGW0); if (first < 0) first += NGW0;
            bh* dstbase = (bh*)(P_WS + J.dst);
            for (int t = first; t < ntile; t += NGW0) conv_tile(L, J, t, ln, dstbase);
            base += ntile; } }
    const int gw = BIDX() * 8 + (tid >> 6), NGW = GDIM() * 8, lane = tid & 63;
    bh* abf = (bh*)(P_WS + OFF_ABF);
    if (L == 0) {
        const float* ps = P_IN(1); bh* pb = (bh*)(P_WS + OFF_PBF);
        for (size_t i = (size_t)BIDX() * 512 + tid; i < (size_t)2 * T * 256 / 4; i += (size_t)GDIM() * 512) { const f32x4 v = ((const f32x4*)ps)[i]; u32x2 w; w.x = pk2(v[0], v[1]); w.y = pk2(v[2], v[3]); ((u32x2*)pb)[i] = w; }
        const float* x = P_IN(0);
        for (int r = gw; r < T; r += NGW) {
#pragma unroll
            for (int j = 0; j < 8; ++j) *(f32x4*)(P_OUT + (size_t)r * D + j * 256 + lane * 4) = *(const f32x4*)(x + (size_t)r * D + j * 256 + lane * 4);
            rms_row_bf16(x + (size_t)r * D, P_IN(2), abf + (size_t)r * D, lane);
        }
    } else {
        for (int r = gw; r < T; r += NGW) rms_row_bf16(P_OUT + (size_t)r * D, P_IN(2) + (size_t)L * D, abf + (size_t)r * D, lane);
    }
}

struct S5C { float ar, ai; float br[16], bi[16]; };
__device__ __forceinline__ void s5_setup(const Params& p, int L, int g, int n, S5C& c) {
    const int gi = L * 32 + g;
    const float dt = __expf(P_IN(21)[gi]);
    const float are = P_IN(19)[gi * 64 + n], aim = P_IN(20)[gi * 64 + n];
    const float mag = __expf(are * dt), ang = aim * dt;
    float sn, cs;
    {
        const double a = (double)ang; const double k = rint(a * 0.15915494309189535); const float r = (float)(a - k * 6.283185307179586);
        sn = sinf(r); cs = cosf(r);
    }
    c.ar = mag * cs; c.ai = mag * sn;
    const float den = are * are + aim * aim, nr = c.ar - 1.0f, ni = c.ai;
    const float cr = (nr * are + ni * aim) / den, ci = (ni * are - nr * aim) / den;
    const float* bre = P_IN(22) + ((size_t)gi * 64 + n) * 16; const float* bim = P_IN(23) + ((size_t)gi * 64 + n) * 16;
#pragma unroll
    for (int q = 0; q < 4; ++q) { const f32x4 r4 = *(const f32x4*)(bre + q * 4), i4 = *(const f32x4*)(bim + q * 4);
#pragma unroll
        for (int j = 0; j < 4; ++j) { c.br[q * 4 + j] = cr * r4[j] - ci * i4[j]; c.bi[q * 4 + j] = cr * i4[j] + ci * r4[j]; } }
}
__device__ __forceinline__ void s5_step(const S5C& c, const LAS float* urow, float& sr, float& si) {
    float xr = 0.f, xi = 0.f;
#pragma unroll
    for (int q = 0; q < 4; ++q) { const f32x4 u4 = *(const LAS f32x4*)(urow + q * 4);
#pragma unroll
        for (int j = 0; j < 4; ++j) { xr = fmaf(u4[j], c.br[q * 4 + j], xr); xi = fmaf(u4[j], c.bi[q * 4 + j], xi); } }
    const float nr = c.ar * sr - c.ai * si + xr, ni = c.ar * si + c.ai * sr + xi;
    sr = nr; si = ni;
}
__device__ __forceinline__ void s5_stage_u(const float* zfc, LAS float* ul, int lane) {
    const float* src = zfc + (size_t)lane * ZF_LD;
    const f32x4 a = *(const f32x4*)src, b = *(const f32x4*)(src + 4), c = *(const f32x4*)(src + 8), d = *(const f32x4*)(src + 12);
    *(LAS f32x4*)(ul + lane * 16) = a; *(LAS f32x4*)(ul + lane * 16 + 4) = b; *(LAS f32x4*)(ul + lane * 16 + 8) = c; *(LAS f32x4*)(ul + lane * 16 + 12) = d;
    asm volatile("s_waitcnt lgkmcnt(0)" ::: "memory"); __builtin_amdgcn_wave_barrier();
}

__device__ __forceinline__ void mlstm_prep(const Params& p, int L, int h, int c, LAS unsigned char* lds) {
    const int tid = TIDX(), t0 = c * 64;
    const float* zf = (const float*)(P_WS + OFF_ZF);
    LAS float* s_ws = (LAS float*)lds;
    if (tid < 64) {
        const int t = t0 + tid;
        float ig = zf[(size_t)t * ZF_LD + 4096 + h] + P_IN(5)[L * 4 + h];
        float fg = zf[(size_t)t * ZF_LD + 4100 + h] + P_IN(6)[L * 4 + h];
        ig = 15.0f * tanhf(ig * (1.0f / 15.0f)); fg = 15.0f * tanhf(fg * (1.0f / 15.0f));
        const float lf = fminf(fg, 0.f) - log1pf(__expf(-fabsf(fg)));
        float b = lf;
#pragma unroll
        for (int o = 1; o < 64; o <<= 1) { const float nb = bperm_f((tid - o) & 63, b); if (tid >= o) b += nb; }
        const float bend = bperm_f(63, b);
        const float wlog = bend - b + ig;
        const float mloc = wave_max(wlog);
        s_ws[tid] = __expf(wlog - mloc);
        ((float*)(P_WS + OFF_MI))[h * T + t] = ig; ((float*)(P_WS + OFF_MBB))[h * T + t] = b;
        if (tid == 0) { ((float*)(P_WS + OFF_MBEND))[h * NCH + c] = bend; ((float*)(P_WS + OFF_MLOC))[h * NCH + c] = mloc; }
    }
    __syncthreads();
    const int d = tid & 255, isk = tid >> 8;
    const int col = isk * 1024 + h * 256 + d;
    const float* cw = P_IN(4) + (size_t)L * 4 * 2048;
    const float w0 = cw[col], w1 = cw[2048 + col], w2 = cw[4096 + col], w3 = cw[6144 + col];
    float x1 = (t0 >= 1) ? zf[(size_t)(t0 - 1) * ZF_LD + col] : 0.f, x2 = (t0 >= 2) ? zf[(size_t)(t0 - 2) * ZF_LD + col] : 0.f, x3 = (t0 >= 3) ? zf[(size_t)(t0 - 3) * ZF_LD + col] : 0.f;
    bh* MQ = (bh*)(P_WS + OFF_MQ); bh* MK = (bh*)(P_WS + OFF_MK);
    bh* MT = (bh*)(P_WS + (isk ? OFF_MKT : OFF_MVT)) + ((size_t)(h * NCH + c) * 256 + d) * 64;
    float dnacc = 0.f;
    for (int s8 = 0; s8 < 8; ++s8) {
        unsigned pk[4];
#pragma unroll
        for (int j = 0; j < 8; ++j) { const int s = s8 * 8 + j, t = t0 + s;
            const float x0 = zf[(size_t)t * ZF_LD + col]; float y = w0 * x0 + w1 * x1 + w2 * x2 + w3 * x3; x3 = x2; x2 = x1; x1 = x0;
            y = y * sigmoidf_(y);
            unsigned short e;
            if (!isk) { MQ[(size_t)t * 1024 + h * 256 + d] = f2bf(y * 0.0625f); e = f2bf(zf[(size_t)t * ZF_LD + 2048 + h * 256 + d]); }
            else { MK[(size_t)t * 1024 + h * 256 + d] = f2bf(y); const float wk = y * s_ws[s]; e = f2bf(wk); dnacc += wk; }
            if (j & 1) pk[j >> 1] |= ((unsigned)e << 16); else pk[j >> 1] = e; }
        u32x4 w; w.x = pk[0]; w.y = pk[1]; w.z = pk[2]; w.w = pk[3];
        *(u32x4*)(MT + s8 * 8) = w;
    }
    if (isk) ((float*)(P_WS + OFF_DN))[(size_t)(h * NCH + c) * 256 + d] = dnacc;
    __syncthreads();
}

__device__ __forceinline__ void rwkv_prep_token(const Params& p, int L, int t, int lane) {
    const float* zf = (const float*)(P_WS + OFF_ZF);
    const float* z = zf + (size_t)t * ZF_LD + ZR0; const float* zp = z - ZF_LD; const bool hp = t > 0;
    const float* mu = P_IN(8) + (size_t)L * 1984;
    float* RR = (float*)(P_WS + OFF_RR); float* RK = (float*)(P_WS + OFF_RK); float* RV = (float*)(P_WS + OFF_RV); float* RKK = (float*)(P_WS + OFF_RKK);
    const float* kkw = P_IN(14) + L * 512;
#pragma unroll
    for (int i = 0; i < 8; ++i) { const int c = i * 64 + lane;
        { const float a = z[c], b = hp ? zp[c] : 0.f; RR[(size_t)t * 512 + c] = a + (b - a) * mu[c]; }
        { const float a = z[1024 + c], b = hp ? zp[1024 + c] : 0.f; RV[(size_t)t * 512 + c] = a + (b - a) * mu[1024 + c]; }
        { const float a = z[512 + c], b = hp ? zp[512 + c] : 0.f; const float k = a + (b - a) * mu[512 + c]; RK[(size_t)t * 512 + c] = k;
          const float kkv = k * kkw[c]; const float ss = wave_sum(kkv * kkv); RKK[(size_t)t * 512 + c] = kkv / fmaxf(sqrtf(ss), 1e-12f); } }
    bh* LAW = (bh*)(P_WS + OFF_LAW) + (size_t)t * 256; bh* LAA = (bh*)(P_WS + OFF_LAA) + (size_t)t * 256; bh* LAG = (bh*)(P_WS + OFF_LAG) + (size_t)t * 256;
#pragma unroll
    for (int i = 0; i < 4; ++i) { const int j = i * 64 + lane;
        float vw = 0.f, va = 0.f;
        if (j < 96) { { const int c = 1536 + j; const float a = z[c], b = hp ? zp[c] : 0.f; vw = tanhf(a + (b - a) * mu[c]); }
                      { const int c = 1632 + j; const float a = z[c], b = hp ? zp[c] : 0.f; va = a + (b - a) * mu[c]; } }
        LAW[j] = f2bf(vw); LAA[j] = f2bf(va);
        { const int c = 1728 + j; const float a = z[c], b = hp ? zp[c] : 0.f; LAG[j] = f2bf(sigmoidf_(a + (b - a) * mu[c])); } }
}

__device__ __forceinline__ void s5_pass_a(const Params& p, int L, int g, int c, int lane, LAS float* ul) {
    const float* zf = (const float*)(P_WS + OFF_ZF) + (size_t)(c * 64) * ZF_LD + ZS0 + g * 16;
    s5_stage_u(zf, ul, lane);
    S5C k; s5_setup(p, L, g, lane, k);
    float sr = 0.f, si = 0.f;
#pragma unroll 8
    for (int s = 0; s < 64; ++s) s5_step(k, ul + s * 16, sr, si);
    asm volatile("s_waitcnt lgkmcnt(0)" ::: "memory"); __builtin_amdgcn_wave_barrier();
    float* se = (float*)(P_WS + OFF_SEND) + ((size_t)(g * NCH + c) * 64 + lane) * 2;
    se[0] = sr; se[1] = si;
}

__device__ __forceinline__ void phase_prep(const Params& p, int L, LAS unsigned char* lds) {
    const int wid = TIDX() >> 6, lane = TIDX() & 63;
    for (int it = BIDX(); it < 2048; it += GDIM()) {
        if (it < 512) mlstm_prep(p, L, it >> 7, it & 127, lds);
        else if (it < 1536) rwkv_prep_token(p, L, (it - 512) * 8 + wid, lane);
        else { const int w = (it - 1536) * 8 + wid; s5_pass_a(p, L, w >> 7, w & 127, lane, (LAS float*)lds + wid * 1024); }
    }
}

constexpr int RW_NS = 4, RW_LS = T / RW_NS, RW_NB = RW_LS / 16, RW_RING = 4, RW_SLOT = 16 * 384;
constexpr int RW_YOFF = RW_RING * RW_SLOT;
__device__ __forceinline__ void rwkv_scan(const Params& p, int b, LAS unsigned char* lds) {
    const int tid = TIDX(), wid = __builtin_amdgcn_readfirstlane(tid >> 6), lane = tid & 63;
    int j, h, rg;
    if (b < 32) { j = 0; h = b >> 2; rg = b & 3; } else { const int u = b - 32; j = 1 + (u >> 6); h = (u & 63) >> 3; rg = u & 7; }
    LAS float* ring = (LAS float*)lds;
    LAS float* ybuf = ring + RW_YOFF;
    const int tbase = j * RW_LS;
    const bool isP = rg >= 4;
    if (wid >= 4) {
        const int lw = wid - 4, lt = tid - 256;
        const float* gp[6]; unsigned lo[6];
#pragma unroll
        for (int i = 0; i < 6; ++i) { const int ii = lw * 6 + i, rowidx = ii * 4 + (lane >> 4), step = rowidx / 6, a = rowidx % 6, q = lane & 15;
            const int ai = (0x205314 >> (4 * a)) & 0xf;
            gp[i] = (const float*)(P_WS + OFF_RR + (size_t)ai * SZ_R) + (size_t)(tbase + step) * 512 + h * 64 + q * 4;
            lo[i] = (unsigned)ii * 256u; }
        float* OUT = (float*)(P_WS + (isP ? OFF_RZ : OFF_RY)) + (size_t)(tbase + (lt >> 4)) * 512 + h * 64 + (rg & 3) * 16 + (lt & 15);
#define RW_ISSUE(bi, sl) do { _Pragma("unroll") for (int _i = 0; _i < 6; ++_i) \
        __builtin_amdgcn_global_load_lds((const unsigned*)(gp[_i] + (size_t)(bi) * 16 * 512), (LAS unsigned*)(ring + (sl) * RW_SLOT + lo[_i]), 16, 0, 0); } while (0)
        RW_ISSUE(0, 0); RW_ISSUE(1, 1); RW_ISSUE(2, 2);
        asm volatile("s_waitcnt vmcnt(12)" ::: "memory"); __builtin_amdgcn_s_barrier();
        int sl = 3;
        for (int ib = 0; ib < RW_NB; ++ib) {
            if (ib + 3 < RW_NB) RW_ISSUE(ib + 3, sl);
            sl = (sl == RW_RING - 1) ? 0 : sl + 1;
            if (ib > 0) {
                const LAS float* yb = ybuf + ((ib - 1) & 1) * 4096 + lt * 16;
                const f32x4 a0 = *(const LAS f32x4*)yb, a1 = *(const LAS f32x4*)(yb + 4), a2 = *(const LAS f32x4*)(yb + 8), a3 = *(const LAS f32x4*)(yb + 12);
                const f32x4 sm = (a0 + a1) + (a2 + a3);
                OUT[(size_t)(ib - 1) * 16 * 512] = (sm[0] + sm[1]) + (sm[2] + sm[3]);
            }
            if (ib + 3 < RW_NB) asm volatile("s_waitcnt vmcnt(13)" ::: "memory");
            else asm volatile("s_waitcnt vmcnt(0)" ::: "memory");
            __builtin_amdgcn_s_barrier();
        }
        {   const LAS float* yb = ybuf + ((RW_NB - 1) & 1) * 4096 + lt * 16;
            const f32x4 a0 = *(const LAS f32x4*)yb, a1 = *(const LAS f32x4*)(yb + 4), a2 = *(const LAS f32x4*)(yb + 8), a3 = *(const LAS f32x4*)(yb + 12);
            const f32x4 sm = (a0 + a1) + (a2 + a3);
            OUT[(size_t)(RW_NB - 1) * 16 * 512] = (sm[0] + sm[1]) + (sm[2] + sm[3]); }
#undef RW_ISSUE
    } else {
        const int r16 = wid * 4 + (lane >> 4), kq = lane & 15, row = (rg & 3) * 16 + r16;
        f32x4 S;
#pragma unroll
        for (int e = 0; e < 4; ++e) S[e] = (isP && (kq * 4 + e == row)) ? 1.f : 0.f;
        const float vmask = isP ? 0.f : 1.f;
        __builtin_amdgcn_s_barrier();
        int sl = 0;
        for (int ib = 0; ib < RW_NB; ++ib) {
            const LAS float* bb = ring + sl * RW_SLOT;
            LAS float* yw = ybuf + (ib & 1) * 4096 + r16 * 16 + kq;
            f32x4 w4 = *(const LAS f32x4*)(bb + kq * 4), k4 = *(const LAS f32x4*)(bb + 64 + kq * 4), kk4 = *(const LAS f32x4*)(bb + 128 + kq * 4),
                  b4 = *(const LAS f32x4*)(bb + 192 + kq * 4), r4 = *(const LAS f32x4*)(bb + 256 + kq * 4);
            float vv = bb[320 + row];
#pragma unroll
            for (int s = 0; s < 16; ++s) {
                f32x4 w4n, k4n, kk4n, b4n, r4n; float vvn;
                if (s < 15) { const LAS float* q = bb + (s + 1) * 384;
                    w4n = *(const LAS f32x4*)(q + kq * 4); k4n = *(const LAS f32x4*)(q + 64 + kq * 4); kk4n = *(const LAS f32x4*)(q + 128 + kq * 4);
                    b4n = *(const LAS f32x4*)(q + 192 + kq * 4); r4n = *(const LAS f32x4*)(q + 256 + kq * 4); vvn = q[320 + row]; }
                __builtin_amdgcn_sched_barrier(0);
                float pd = (S[0] * kk4[0] + S[1] * kk4[1]) + (S[2] * kk4[2] + S[3] * kk4[3]);
                const f32x4 pre = S * w4 + (vv * vmask) * k4;
                pd = allreduce16(pd);
                S = pre - pd * b4;
                yw[s * 256] = (S[0] * r4[0] + S[1] * r4[1]) + (S[2] * r4[2] + S[3] * r4[3]);
                if (s < 15) { w4 = w4n; k4 = k4n; kk4 = kk4n; b4 = b4n; r4 = r4n; vv = vvn; }
            }
            sl = (sl == RW_RING - 1) ? 0 : sl + 1;
            asm volatile("s_waitcnt lgkmcnt(0)" ::: "memory");
            __builtin_amdgcn_s_barrier();
        }
        float* EN = (float*)(P_WS + (isP ? OFF_RPEND : OFF_RSEND)) + ((size_t)(h * 4 + j) * 64 + row) * 64 + kq * 4;
        *(f32x4*)EN = S;
    }
    __syncthreads();
}

struct MStage { bf16x8 q[4], k[4], v[4]; float bend, mloc; };
__device__ __forceinline__ void mstage_load(MStage& st, const bh* qp, const bh* kp, const bh* vp, const float* MBEND, const float* MLOC, int h, int c) {
#pragma unroll
    for (int ks = 0; ks < 4; ++ks) { st.q[ks] = *(const bf16x8*)(qp + (size_t)c * 64 * 1024 + ks * 32); st.k[ks] = *(const bf16x8*)(kp + (size_t)c * 256 * 64 + ks * 16); st.v[ks] = *(const bf16x8*)(vp + (size_t)c * 256 * 64 + ks * 16); }
    st.bend = MBEND[h * NCH + c]; st.mloc = MLOC[h * NCH + c];
}
__device__ __forceinline__ void mlstm_seq(const Params& p, int mb, LAS unsigned char* lds) {
    const int tid = TIDX(), wid = tid >> 6, lane = tid & 63;
    const int h = mb >> 3, jv = mb & 7;
    LAS bh* Cbf = (LAS bh*)lds;
    constexpr int CS = 264;
    for (int i = tid; i < 2 * 32 * CS / 2; i += 512) ((LAS unsigned*)Cbf)[i] = 0u;
    __syncthreads();
    const bh* MQ = (const bh*)(P_WS + OFF_MQ); const bh* MKT = (const bh*)(P_WS + OFF_MKT); const bh* MVT = (const bh*)(P_WS + OFF_MVT);
    const float* MBEND = (const float*)(P_WS + OFF_MBEND); const float* MLOC = (const float*)(P_WS + OFF_MLOC);
    f32x16 ct;
    { const float z = OZ();
#pragma unroll
    for (int i = 0; i < 16; ++i) ct[i] = z; }
    float m = 0.f;
    const int mt = wid >> 1, kh = wid & 1;
    float* MINTER = (float*)(P_WS + (kh ? OFF_MINTER2 : OFF_ABF));
    const bh* qp = MQ + (size_t)(mt * 16 + (lane & 15)) * 1024 + h * 256 + kh * 128 + (lane >> 4) * 8;
    const bh* kp = MKT + ((size_t)(h * NCH) * 256 + wid * 32 + (lane & 31)) * 64 + (lane >> 5) * 8;
    const bh* vp = MVT + ((size_t)(h * NCH) * 256 + jv * 32 + (lane & 31)) * 64 + (lane >> 5) * 8;
    MStage s0, s1, s2;
    mstage_load(s0, qp, kp, vp, MBEND, MLOC, h, 0);
    mstage_load(s1, qp, kp, vp, MBEND, MLOC, h, 1);
#define MSTEP(SC, SL, CIDX) do { const int c = (CIDX); const int t0 = c * 64, cur = c & 1; \
        mstage_load(SL, qp, kp, vp, MBEND, MLOC, h, (c + 2 < NCH) ? c + 2 : NCH - 1); \
        const float mnew = fmaxf(SC.bend + m, SC.mloc), decay = __expf(SC.bend + m - mnew), scale = __expf(SC.mloc - mnew); \
        f32x4 r0 = {0.f, 0.f, 0.f, 0.f}, r1 = {0.f, 0.f, 0.f, 0.f}; \
        const LAS bh* cb = Cbf + cur * 32 * CS + (lane & 15) * CS + kh * 128 + (lane >> 4) * 8; \
        _Pragma("unroll") for (int ks = 0; ks < 4; ++ks) { const bf16x8 b0 = *(const LAS bf16x8*)(cb + ks * 32), b1 = *(const LAS bf16x8*)(cb + 16 * CS + ks * 32); r0 = MFMA16(SC.q[ks], b0, r0); r1 = MFMA16(SC.q[ks], b1, r1); } \
        {   float* o = MINTER + (size_t)(t0 + mt * 16 + (lane >> 4) * 4) * 1024 + h * 256 + jv * 32 + (lane & 15); \
            asm volatile("global_store_dword %0, %2, off\n\tglobal_store_dword %1, %3, off\n\ts_nop 0" :: "v"(o), "v"(o + 1024), "v"(r0[0]), "v"(r0[1]) : "memory"); \
            asm volatile("global_store_dword %0, %2, off\n\tglobal_store_dword %1, %3, off\n\ts_nop 0" :: "v"(o + 2048), "v"(o + 3072), "v"(r0[2]), "v"(r0[3]) : "memory"); \
            asm volatile("global_store_dword %0, %2, off offset:64\n\tglobal_store_dword %1, %3, off offset:64\n\ts_nop 0" :: "v"(o), "v"(o + 1024), "v"(r1[0]), "v"(r1[1]) : "memory"); \
            asm volatile("global_store_dword %0, %2, off offset:64\n\tglobal_store_dword %1, %3, off offset:64\n\ts_nop 0" :: "v"(o + 2048), "v"(o + 3072), "v"(r1[2]), "v"(r1[3]) : "memory"); } \
        f32x16 d0; { const float z = OZ(); _Pragma("unroll") for (int i = 0; i < 16; ++i) d0[i] = z; } \
        _Pragma("unroll") for (int ks = 0; ks < 4; ++ks) d0 = MFMA32(SC.k[ks], SC.v[ks], d0); \
        _Pragma("unroll") for (int i = 0; i < 16; ++i) ct[i] = decay * ct[i] + scale * d0[i]; \
        m = mnew; \
        {   LAS bh* o0 = Cbf + (cur ^ 1) * 32 * CS + (lane & 31) * CS + wid * 32 + 4 * (lane >> 5); \
            _Pragma("unroll") for (int g = 0; g < 4; ++g) { u32x2 w0; w0.x = cvt_pk_bf16(ct[4 * g], ct[4 * g + 1]); w0.y = cvt_pk_bf16(ct[4 * g + 2], ct[4 * g + 3]); *(LAS u32x2*)(o0 + 8 * g) = w0; } } \
        asm volatile("s_waitcnt lgkmcnt(0)" ::: "memory"); __builtin_amdgcn_s_barrier(); asm volatile("" ::: "memory"); } while (0)
    for (int c3 = 0; c3 < 126; c3 += 3) { MSTEP(s0, s2, c3); MSTEP(s1, s0, c3 + 1); MSTEP(s2, s1, c3 + 2); }
    MSTEP(s0, s2, 126); MSTEP(s1, s0, 127);
#undef MSTEP
    asm volatile("s_waitcnt vmcnt(0)" ::: "memory");
    __syncthreads();
}

__device__ __forceinline__ void mlstm_nscan(const Params& p) {
    const float* MBEND = (const float*)(P_WS + OFF_MBEND); const float* MLOC = (const float*)(P_WS + OFF_MLOC);
    const float* DN = (const float*)(P_WS + OFF_DN); float* NST = (float*)(P_WS + OFF_NST); float* MSTART = (float*)(P_WS + OFF_MSTART);
    for (int idx = TIDX(); idx < 1024; idx += 512) { const int h = idx >> 8, d = idx & 255; float m = 0.f, n = 0.f;
#pragma unroll 8
        for (int c = 0; c < NCH; ++c) { if (d == 0) MSTART[h * NCH + c] = m; NST[(size_t)(h * NCH + c) * 256 + d] = n;
            const float bend = MBEND[h * NCH + c], mloc = MLOC[h * NCH + c]; const float mnew = fmaxf(bend + m, mloc);
            n = __expf(bend + m - mnew) * n + __expf(mloc - mnew) * DN[(size_t)(h * NCH + c) * 256 + d]; m = mnew; } }
}

__device__ __forceinline__ float gelu_tanh(float x) { const float u = 0.7978845608028654f * (x + 0.044715f * x * x * x); return 0.5f * x * (1.0f + tanhf(u)); }

__device__ __forceinline__ void s5_pass_c(const Params& p, int L, int g, int c, int lane, LAS bh* img, LAS float* ul) {
    const float* zf = (const float*)(P_WS + OFF_ZF) + (size_t)(c * 64) * ZF_LD + ZS0 + g * 16;
    s5_stage_u(zf, ul, lane);
    S5C k; s5_setup(p, L, g, lane, k);
    float sr = 0.f, si = 0.f;
    {   float pr = k.ar, pi = k.ai;
#pragma unroll
        for (int i = 0; i < 6; ++i) { const float nr = pr * pr - pi * pi, ni = 2.f * pr * pi; pr = nr; pi = ni; }
        const float* se = (const float*)(P_WS + OFF_SEND) + ((size_t)(g * NCH) * 64 + lane) * 2;
        int cc = 0;
        for (; cc + 8 <= c; cc += 8) { float er[8], ei[8];
#pragma unroll
            for (int j = 0; j < 8; ++j) { er[j] = se[(size_t)(cc + j) * 128]; ei[j] = se[(size_t)(cc + j) * 128 + 1]; }
#pragma unroll
            for (int j = 0; j < 8; ++j) { const float nr = pr * sr - pi * si + er[j], ni = pr * si + pi * sr + ei[j]; sr = nr; si = ni; } }
        for (; cc < c; ++cc) { const float er = se[(size_t)cc * 128], ei = se[(size_t)cc * 128 + 1];
            const float nr = pr * sr - pi * si + er, ni = pr * si + pi * sr + ei; sr = nr; si = ni; } }
    const int gi = L * 32 + g;
    bf16x8 bfr[4];
    {   const int pp = lane & 15; const float* cre = P_IN(24) + ((size_t)gi * 16 + pp) * 64; const float* cim = P_IN(25) + ((size_t)gi * 16 + pp) * 64;
#pragma unroll
        for (int ks = 0; ks < 4; ++ks)
#pragma unroll
            for (int j = 0; j < 8; ++j) { const int n2 = ks * 32 + (lane >> 4) * 8 + j; const float v = (n2 < 64) ? cre[n2] : -cim[n2 - 64]; bfr[ks][j] = (short)f2bf(v); } }
    const float dco = P_IN(26)[L * 512 + g * 16 + (lane & 15)];
    bh* YS = (bh*)(P_WS + OFF_YS);
    for (int half = 0; half < 2; ++half) {
#pragma unroll 8
        for (int s = 0; s < 32; ++s) { s5_step(k, ul + (half * 32 + s) * 16, sr, si); img[s * 136 + lane] = f2bf(sr); img[s * 136 + 64 + lane] = f2bf(si); }
        asm volatile("s_waitcnt lgkmcnt(0)" ::: "memory"); __builtin_amdgcn_wave_barrier();
#pragma unroll
        for (int mt = 0; mt < 2; ++mt) { f32x4 acc = {0.f, 0.f, 0.f, 0.f};
#pragma unroll
            for (int ks = 0; ks < 4; ++ks) { const bf16x8 a = *(const LAS bf16x8*)(img + (mt * 16 + (lane & 15)) * 136 + ks * 32 + (lane >> 4) * 8); acc = MFMA16(a, bfr[ks], acc); }
#pragma unroll
            for (int r = 0; r < 4; ++r) { const int tt = half * 32 + mt * 16 + (lane >> 4) * 4 + r; const float uv = ul[tt * 16 + (lane & 15)];
                YS[(size_t)(c * 64 + tt) * 512 + g * 16 + (lane & 15)] = f2bf(gelu_tanh(acc[r] + dco * uv)); } }
        asm volatile("s_waitcnt lgkmcnt(0)" ::: "memory"); __builtin_amdgcn_wave_barrier();
    }
}

__device__ __forceinline__ void phase_scan(const Params& p, int L, LAS unsigned char* lds) {
    const int b = BIDX();
    if (b < 224) { for (int rr = 0; rr < PROBE_RW; ++rr) rwkv_scan(p, b, lds); }
    else { for (int rr = 0; rr < PROBE_ML; ++rr) mlstm_seq(p, b - 224, lds); }
}
__device__ __forceinline__ void phase_s5c(const Params& p, int L, LAS unsigned char* lds) {
    const int b = BIDX(), wid = TIDX() >> 6, lane = TIDX() & 63;
    if (b == GDIM() - 1) mlstm_nscan(p);
    const int nw = GDIM() * 8;
    for (int w = b * 8 + wid; w < 32 * NCH; w += nw) s5_pass_c(p, L, w >> 7, w & 127, lane, (LAS bh*)lds + wid * (32 * 136), (LAS float*)(lds + 69632) + wid * 1024);
    __syncthreads();
}

__device__ __forceinline__ void mlstm_out(const Params& p, int L, int h, int c, LAS unsigned char* lds) {
    const int tid = TIDX(), wid = tid >> 6, lane = tid & 63, t0 = c * 64;
    LAS bh* Pl = (LAS bh*)lds;
    LAS float* s_b = (LAS float*)(lds + 9216); LAS float* s_a = s_b + 64; LAS float* s_mt = s_a + 64; LAS float* s_iw = s_mt + 64; LAS float* s_den = s_iw + 64; LAS float* s_qn = s_den + 64; LAS float* s_part = s_qn + 64;
    const bh* MQ = (const bh*)(P_WS + OFF_MQ); const bh* MK = (const bh*)(P_WS + OFF_MK); const bh* MVT = (const bh*)(P_WS + OFF_MVT);
    const float* MINTER = (const float*)(P_WS + OFF_ABF);
    const float m0 = ((const float*)(P_WS + OFF_MSTART))[h * NCH + c];
    if (tid < 64) { const float ig = ((const float*)(P_WS + OFF_MI))[h * T + t0 + tid], b = ((const float*)(P_WS + OFF_MBB))[h * T + t0 + tid];
        const float a = ig - b; float cm = a;
#pragma unroll
        for (int o = 1; o < 64; o <<= 1) { const float nb = bperm_f((tid - o) & 63, cm); if (tid >= o) cm = fmaxf(cm, nb); }
        const float mt = b + fmaxf(m0, cm);
        s_b[tid] = b; s_a[tid] = a; s_mt[tid] = mt; s_iw[tid] = __expf(b + m0 - mt); }
    __syncthreads();
    {
        const int mt = wid >> 1, nt0 = (wid & 1) * 2;
        f32x4 r0 = {0.f, 0.f, 0.f, 0.f}, r1 = {0.f, 0.f, 0.f, 0.f};
        const bh* qp = MQ + (size_t)(t0 + mt * 16 + (lane & 15)) * 1024 + h * 256 + (lane >> 4) * 8;
        const bh* kp = MK + (size_t)(t0 + nt0 * 16 + (lane & 15)) * 1024 + h * 256 + (lane >> 4) * 8;
#pragma unroll
        for (int ks = 0; ks < 8; ++ks) { const bf16x8 a = *(const bf16x8*)(qp + ks * 32); const bf16x8 b0 = *(const bf16x8*)(kp + ks * 32), b1 = *(const bf16x8*)(kp + (size_t)16 * 1024 + ks * 32);
            r0 = MFMA16(a, b0, r0); r1 = MFMA16(a, b1, r1); }
#pragma unroll
        for (int r = 0; r < 4; ++r) { const int t = mt * 16 + (lane >> 4) * 4 + r; const float bt = s_b[t] - s_mt[t];
            { const int s = nt0 * 16 + (lane & 15); const float pv = (s <= t) ? r0[r] * __expf(bt + s_a[s]) : 0.f; Pl[t * 72 + s] = f2bf(pv); }
            { const int s = nt0 * 16 + 16 + (lane & 15); const float pv = (s <= t) ? r1[r] * __expf(bt + s_a[s]) : 0.f; Pl[t * 72 + s] = f2bf(pv); } }
    }
    __syncthreads();
    if (tid < 64) { float s = 0.f;
#pragma unroll
        for (int q = 0; q < 8; ++q) { const u32x4 w = *(const LAS u32x4*)(Pl + tid * 72 + q * 8);
            s += __uint_as_float(w.x << 16) + __uint_as_float(w.x & 0xffff0000u) + __uint_as_float(w.y << 16) + __uint_as_float(w.y & 0xffff0000u)
               + __uint_as_float(w.z << 16) + __uint_as_float(w.z & 0xffff0000u) + __uint_as_float(w.w << 16) + __uint_as_float(w.w & 0xffff0000u); }
        s_den[tid] = s; }
    {
        const float* nst = (const float*)(P_WS + OFF_NST) + (size_t)(h * NCH + c) * 256 + lane * 4; const f32x4 nv = *(const f32x4*)nst;
#pragma unroll
        for (int i = 0; i < 8; ++i) { const int t = wid * 8 + i; const u32x2 q2 = *(const u32x2*)(MQ + (size_t)(t0 + t) * 1024 + h * 256 + lane * 4);
            float s = __uint_as_float(q2.x << 16) * nv[0] + __uint_as_float(q2.x & 0xffff0000u) * nv[1] + __uint_as_float(q2.y << 16) * nv[2] + __uint_as_float(q2.y & 0xffff0000u) * nv[3];
            s = wave_sum(s); if (lane == 0) s_qn[t] = s; } }
    f32x4 acc[4][2];
#pragma unroll
    for (int a = 0; a < 4; ++a) { const float z = OZ(); acc[a][0] = (f32x4){z, z, z, z}; acc[a][1] = (f32x4){z, z, z, z}; }
    {   const bh* vp = MVT + ((size_t)(h * NCH + c) * 256 + wid * 32 + (lane & 15)) * 64 + (lane >> 4) * 8;
#pragma unroll
        for (int ks = 0; ks < 2; ++ks) { const bf16x8 b0 = *(const bf16x8*)(vp + ks * 32), b1 = *(const bf16x8*)(vp + 16 * 64 + ks * 32);
#pragma unroll
            for (int a = 0; a < 4; ++a) { const bf16x8 av = *(const LAS bf16x8*)(Pl + (a * 16 + (lane & 15)) * 72 + ks * 32 + (lane >> 4) * 8);
                acc[a][0] = MFMA16(av, b0, acc[a][0]); acc[a][1] = MFMA16(av, b1, acc[a][1]); } } }
    __syncthreads();
#pragma unroll
    for (int a = 0; a < 4; ++a)
#pragma unroll
        for (int r = 0; r < 4; ++r) { const int t = a * 16 + (lane >> 4) * 4 + r; const float iw = s_iw[t];
            const float den = s_den[t] + iw * s_qn[t]; const float dd = 1.0f / fmaxf(fabsf(den), __expf(-s_mt[t]));
            const float* mi = MINTER + (size_t)(t0 + t) * 1024 + h * 256 + wid * 32 + (lane & 15);
            const float* mi2 = (const float*)(P_WS + OFF_MINTER2) + (size_t)(t0 + t) * 1024 + h * 256 + wid * 32 + (lane & 15);
            const float h0 = (acc[a][0][r] + iw * (mi[0] + mi2[0])) * dd, h1 = (acc[a][1][r] + iw * (mi[16] + mi2[16])) * dd;
            acc[a][0][r] = h0; acc[a][1][r] = h1;
            float ss = h0 * h0 + h1 * h1;
            ss = allreduce16(ss);
            if ((lane & 15) == 0) s_part[wid * 64 + t] = ss; }
    __syncthreads();
    {   const float* zf = (const float*)(P_WS + OFF_ZF); const float* ng = P_IN(7) + L * 1024 + h * 256; bh* YC = (bh*)(P_WS + OFF_YCAT);
#pragma unroll
        for (int a = 0; a < 4; ++a)
#pragma unroll
            for (int r = 0; r < 4; ++r) { const int t = a * 16 + (lane >> 4) * 4 + r;
                float tot = 0.f;
#pragma unroll
                for (int w = 0; w < 8; ++w) tot += s_part[w * 64 + t];
                const float rstd = rsqrtf(tot * (1.0f / 256.0f) + 1e-6f);
                const int v0 = wid * 32 + (lane & 15);
                const float* op = zf + (size_t)(t0 + t) * ZF_LD + 3072 + h * 256 + v0;
                bh* yo = YC + (size_t)(t0 + t) * D + h * 256 + v0;
                yo[0] = f2bf(sigmoidf_(op[0]) * acc[a][0][r] * rstd * ng[v0]);
                yo[16] = f2bf(sigmoidf_(op[16]) * acc[a][1][r] * rstd * ng[v0 + 16]); } }
    __syncthreads();
}

__device__ __forceinline__ void rwkv_post(const Params& p, int L, int it, LAS unsigned char* lds) {
    const int tid = TIDX(), wid = tid >> 6, lane = tid & 63;
    const int h = it & 7, blk = it >> 3, j = blk >> 3;
    LAS float* bufA = (LAS float*)lds;
    LAS float* bufB = bufA + 64 * 65;
    LAS float* bufP = bufB + 64 * 65;
    const float* SE = (const float*)(P_WS + OFF_RSEND) + (size_t)(h * 4) * 4096; const float* PE = (const float*)(P_WS + OFF_RPEND) + (size_t)(h * 4) * 4096;
    LAS float* sst = bufA;
    if (j >= 1) {
        const int v = tid >> 3, k8 = (tid & 7) * 8;
        { const f32x4 a0 = *(const f32x4*)(SE + v * 64 + k8), a1 = *(const f32x4*)(SE + v * 64 + k8 + 4);
#pragma unroll
          for (int e = 0; e < 4; ++e) { bufA[v * 65 + k8 + e] = a0[e]; bufA[v * 65 + k8 + 4 + e] = a1[e]; } }
        for (int jj = 1; jj < j; ++jj) {
            { const f32x4 p0 = *(const f32x4*)(PE + (size_t)jj * 4096 + v * 64 + k8), p1 = *(const f32x4*)(PE + (size_t)jj * 4096 + v * 64 + k8 + 4);
              *(LAS f32x4*)(bufP + v * 64 + k8) = p0; *(LAS f32x4*)(bufP + v * 64 + k8 + 4) = p1; }
            __syncthreads();
            LAS float* src = (jj & 1) ? bufA : bufB; LAS float* dst = (jj & 1) ? bufB : bufA;
            f32x4 c0 = *(const f32x4*)(SE + (size_t)jj * 4096 + v * 64 + k8), c1 = *(const f32x4*)(SE + (size_t)jj * 4096 + v * 64 + k8 + 4);
#pragma unroll 8
            for (int i = 0; i < 64; ++i) { const float a = src[v * 65 + i]; const f32x4 p0 = *(const LAS f32x4*)(bufP + i * 64 + k8), p1 = *(const LAS f32x4*)(bufP + i * 64 + k8 + 4); c0 += a * p0; c1 += a * p1; }
#pragma unroll
            for (int e = 0; e < 4; ++e) { dst[v * 65 + k8 + e] = c0[e]; dst[v * 65 + k8 + 4 + e] = c1[e]; }
            __syncthreads();
            sst = dst;
        }
        __syncthreads();
    }
    float srow[64];
    if (j >= 1) {
#pragma unroll
        for (int i = 0; i < 64; ++i) srow[i] = sst[lane * 65 + i];
    } else {
#pragma unroll
        for (int i = 0; i < 64; ++i) srow[i] = 0.f;
    }
    const int c = h * 64 + lane;
    const float rkw = P_IN(16)[L * 512 + c], lg = P_IN(17)[L * 512 + c], lb = P_IN(18)[L * 512 + c];
    const float* RY = (const float*)(P_WS + OFF_RY); const float* RZ = (const float*)(P_WS + OFF_RZ); const float* RR = (const float*)(P_WS + OFF_RR); const float* RK = (const float*)(P_WS + OFF_RK);
    const float* RV = (const float*)(P_WS + OFF_RV); const float* RG = (const float*)(P_WS + OFF_RG); bh* YC = (bh*)(P_WS + OFF_YCAT);
    for (int i = 0; i < 32; ++i) { const int t = blk * 256 + wid * 32 + i; const size_t o = (size_t)t * 512 + c;
        float y = RY[o];
        if (j >= 1) { const float z = RZ[o]; float y2 = 0.f;
#pragma unroll
            for (int q = 0; q < 64; q += 2) { y = fmaf(srow[q], __builtin_bit_cast(float, __builtin_amdgcn_readlane(__builtin_bit_cast(int, z), q)), y);
                                              y2 = fmaf(srow[q + 1], __builtin_bit_cast(float, __builtin_amdgcn_readlane(__builtin_bit_cast(int, z), q + 1)), y2); }
            y += y2; }
        const float mu = wave_sum(y) * (1.0f / 64.0f); const float dlt = y - mu; const float var = wave_sum(dlt * dlt) * (1.0f / 64.0f);
        const float yn = dlt * rsqrtf(var + 64e-5f) * lg + lb;
        const float bon = wave_sum(RR[o] * RK[o] * rkw) * RV[o];
        YC[(size_t)t * D + 1024 + c] = f2bf((yn + bon) * RG[o]); }
    __syncthreads();
}

__device__ __forceinline__ void phase_post(const Params& p, int L, LAS unsigned char* lds) {
    for (int it = BIDX(); it < 768; it += GDIM()) {
        if (it < 512) mlstm_out(p, L, it >> 7, it & 127, lds);
        else rwkv_post(p, L, it - 512, lds);
    }
    __syncthreads();
}

constexpr int NPHASE = 27;
__global__ void __launch_bounds__(512, 2) hybrid_fwd(Params p, int ph_lo, int ph_hi, int rep_q) {
    extern __shared__ __attribute__((aligned(16))) unsigned char smem_raw[];
    LAS unsigned char* lds = (LAS unsigned char*)smem_raw;
    cg::grid_group grid = cg::this_grid();
    for (int ph = ph_lo; ph < ph_hi; ++ph) {
        if (ph > ph_lo) grid.sync();
        if (ph == 26) {
            const int gw = BIDX() * 8 + (TIDX() >> 6), NGW = GDIM() * 8, lane = TIDX() & 63;
            for (int r = gw; r < T; r += NGW) { float* x = P_OUT + (size_t)r * D; f32x4 v[8]; float s = 0.f;
#pragma unroll
                for (int j = 0; j < 8; ++j) { v[j] = *(const f32x4*)(x + j * 256 + lane * 4); s += (v[j][0] * v[j][0] + v[j][1] * v[j][1]) + (v[j][2] * v[j][2] + v[j][3] * v[j][3]); }
                const float rstd = rsqrtf(wave_sum(s) * (1.0f / D) + 1e-6f);
#pragma unroll
                for (int j = 0; j < 8; ++j) { const f32x4 gg = *(const f32x4*)(P_IN(40) + j * 256 + lane * 4); *(f32x4*)(x + j * 256 + lane * 4) = v[j] * rstd * gg; } }
            continue;
        }
        const int L = ph / 13, q = ph % 13;
#ifdef ONLY_Q
        if (q != ONLY_Q) continue;
#endif
        const int nrep = (q == rep_q) ? 2 : 1;
        for (int rep = 0; rep < nrep; ++rep) {
        if (rep) grid.sync();
        switch (q) {
        case 0: phase_conv(p, L, lds); break;
        case 2: phase_prep(p, L, lds); break;
        case 4: phase_scan(p, L, lds); break;
        case 5: phase_post(p, L, lds); break;
        case 8: phase_rmsnorm(p, P_IN(33) + (size_t)L * D); break;
        case 11: phase_rmsnorm(p, P_IN(37) + (size_t)L * D); break;
        default: break;
        }
        for (int i = 0; i < 3; ++i) {
            pg8::Gemm g;
            if (!make_gemm(p, L, q, i, g)) break;
            pg8::StaticOrder S; S.init(T, g.N, GDIM(), BIDX());
            pg8::gemm_phase(lds, g, S);
        }
        if (q == 3) phase_s5c(p, L, lds);
        }
    }
}

extern "C" void kernel_launch(void* const* d_in, const int* in_sizes, int n_in, void* d_out, int out_size, void* d_ws, size_t ws_size, hipStream_t stream) {
    constexpr size_t kDynLds = 131072;
    static int grid_blocks = 0;
    if (!grid_blocks) {
        int dev = 0, cus = 0, per_cu = 0;
        (void)hipGetDevice(&dev);
        (void)hipDeviceGetAttribute(&cus, hipDeviceAttributeMultiprocessorCount, dev);
        (void)hipFuncSetAttribute((const void*)hybrid_fwd, hipFuncAttributeMaxDynamicSharedMemorySize, (int)kDynLds);
        (void)hipOccupancyMaxActiveBlocksPerMultiprocessor(&per_cu, hybrid_fwd, 512, kDynLds);
        if (per_cu > 1) per_cu = 1;
        grid_blocks = cus * per_cu;
        if (ws_size < WS_TOTAL) fprintf(stderr, "workspace too small: %zu < %zu\n", ws_size, (size_t)WS_TOTAL);
    }
    Params p{};
    for (int i = 0; i < 41; ++i) p.in[i] = (const float*)d_in[i];
    p.out = (float*)d_out; p.ws = (unsigned char*)d_ws;
#if SINGLE_LAUNCH
    int lo = 0, hi = NPHASE, rq = PROBE_REP_Q;
    void* args[] = {&p, &lo, &hi, &rq};
    hipError_t e = hipLaunchCooperativeKernel((const void*)hybrid_fwd, dim3(grid_blocks), dim3(512), args, kDynLds, stream);
    if (e != hipSuccess) fprintf(stderr, "cooperative launch failed: %s (grid %d)\n", hipGetErrorString(e), grid_blocks);
#else
    for (int ph = 0; ph < NPHASE; ++ph) {
        int lo = ph, hi = ph + 1, rq = -1;
        void* args[] = {&p, &lo, &hi, &rq};
        hipError_t e = hipLaunchCooperativeKernel((const void*)hybrid_fwd, dim3(grid_blocks), dim3(512), args, kDynLds, stream);
        if (e != hipSuccess) fprintf(stderr, "cooperative launch failed: %s (grid %d)\n", hipGetErrorString(e), grid_blocks);
    }
#endif
}
```

```cpp
#include <hip/hip_runtime.h>
#include <hip/hip_cooperative_groups.h>
#include <cstdio>
#include <cstdint>
namespace cg = cooperative_groups;

#define LAS __attribute__((address_space(3)))
typedef unsigned short bh;
typedef short bf16x8 __attribute__((ext_vector_type(8)));
typedef float f32x4 __attribute__((ext_vector_type(4)));
typedef float f32x16 __attribute__((ext_vector_type(16)));
typedef unsigned u32x4 __attribute__((ext_vector_type(4)));
typedef unsigned u32x2 __attribute__((ext_vector_type(2)));

#ifndef PROBE_RW
#define PROBE_RW 1
#define PROBE_ML 1
#endif
#ifndef PROBE_REP_Q
#define PROBE_REP_Q (-1)
#endif
#ifndef SINGLE_LAUNCH
#define SINGLE_LAUNCH 1
#endif

constexpr int T = 8192, D = 2048, FH = 5632;
constexpr int NIN = 12744, NGATE = 6144, NF = 6600, ZF_LD = 6656, NINP = 12800;
constexpr int ZR0 = 4104, ZS0 = 6088;
constexpr int NCH = 128;

constexpr size_t AL(size_t x) { return (x + 255) & ~(size_t)255; }
constexpr size_t SZ_WIN = (size_t)NINP * D * 2, SZ_SQ = (size_t)D * D * 2, SZ_WGU = (size_t)2 * FH * D * 2, SZ_WD = (size_t)D * FH * 2;
constexpr size_t OFF_WIN = 0;
constexpr size_t OFF_WUP = OFF_WIN + SZ_WIN;
constexpr size_t OFF_WO = OFF_WUP + SZ_SQ;
constexpr size_t OFF_WGU = OFF_WO + SZ_SQ;
constexpr size_t OFF_WD = OFF_WGU + SZ_WGU;
constexpr size_t OFF_WPG = OFF_WD + SZ_WD;
constexpr size_t OFF_WPP = OFF_WPG + SZ_SQ;
constexpr size_t OFF_WGLU = OFF_WPP + (size_t)D * 256 * 2;
constexpr size_t OFF_WW2 = OFF_WGLU + (size_t)512 * 512 * 2;
constexpr size_t OFF_WA2 = OFF_WW2 + (size_t)512 * 256 * 2;
constexpr size_t OFF_WG2 = OFF_WA2 + (size_t)512 * 256 * 2;
constexpr size_t OFF_PBF = OFF_WG2 + (size_t)512 * 256 * 2;
constexpr size_t OFF_ABF = OFF_PBF + (size_t)2 * T * 256 * 2;
constexpr size_t OFF_YCAT = OFF_ABF + (size_t)T * D * 2;
constexpr size_t OFF_ZF = OFF_YCAT + (size_t)T * D * 2;
constexpr size_t OFF_ACT = OFF_ZF;
constexpr size_t OFF_MIX32 = OFF_ZF + (size_t)100663296;
constexpr size_t OFF_ZG = OFF_ZF + (size_t)T * ZF_LD * 4;
constexpr size_t SZ_R = (size_t)T * 512 * 4;
constexpr size_t OFF_RR = OFF_ZG + (size_t)T * NGATE * 2;
constexpr size_t OFF_RK = OFF_RR + SZ_R, OFF_RV = OFF_RK + SZ_R, OFF_RKK = OFF_RV + SZ_R, OFF_RW = OFF_RKK + SZ_R, OFF_RB = OFF_RW + SZ_R, OFF_RG = OFF_RB + SZ_R, OFF_RY = OFF_RG + SZ_R;
constexpr size_t OFF_LAW = OFF_RY + SZ_R;
constexpr size_t OFF_LAA = OFF_LAW + (size_t)T * 256 * 2, OFF_LAG = OFF_LAA + (size_t)T * 256 * 2;
constexpr size_t SZ_MB = (size_t)T * 1024 * 2;
constexpr size_t OFF_MQ = OFF_LAG + (size_t)T * 256 * 2, OFF_MK = OFF_MQ + SZ_MB, OFF_MKT = OFF_MK + SZ_MB, OFF_MVT = OFF_MKT + SZ_MB;
constexpr size_t OFF_MI = OFF_MVT + SZ_MB;
constexpr size_t OFF_MBB = OFF_MI + (size_t)4 * T * 4;
constexpr size_t OFF_MBEND = OFF_MBB + (size_t)4 * T * 4;
constexpr size_t OFF_MLOC = OFF_MBEND + 2048, OFF_MSTART = OFF_MLOC + 2048;
constexpr size_t OFF_DN = OFF_MSTART + 2048;
constexpr size_t OFF_NST = OFF_DN + (size_t)4 * NCH * 256 * 4;
constexpr size_t OFF_SEND = OFF_NST + (size_t)4 * NCH * 256 * 4;
constexpr size_t OFF_YS = OFF_SEND + (size_t)32 * NCH * 64 * 8;
constexpr size_t OFF_RZ = OFF_YS + (size_t)T * 512 * 2;
constexpr size_t OFF_RSEND = OFF_RZ + SZ_R;
constexpr size_t OFF_RPEND = OFF_RSEND + (size_t)8 * 4 * 4096 * 4;
constexpr size_t OFF_MINTER2 = OFF_RPEND + (size_t)8 * 4 * 4096 * 4;
constexpr size_t WS_TOTAL = OFF_MINTER2 + (size_t)T * 1024 * 4;

struct Params { const float* in[41]; float* out; unsigned char* ws; };
#define KARG4 __attribute__((address_space(4)))
__device__ __forceinline__ const float* karg_in(int i) { const KARG4 char* ka = (const KARG4 char*)__builtin_amdgcn_kernarg_segment_ptr(); return *(const float* const volatile KARG4*)(ka + (size_t)i * 8); }
#define P_IN(i) karg_in(i)
#define P_OUT ((float*)karg_in(41))
#define P_WS ((unsigned char*)karg_in(42))

__device__ __forceinline__ int TIDX() { int t = threadIdx.x; asm volatile("" : "+v"(t)); return t; }
__device__ __forceinline__ int BIDX() { int t = blockIdx.x; asm volatile("" : "+s"(t)); return t; }
__device__ __forceinline__ int GDIM() { int t = gridDim.x; asm volatile("" : "+s"(t)); return t; }
__device__ __forceinline__ bh f2bf(float f) { unsigned u = __float_as_uint(f); u += 0x7fffu + ((u >> 16) & 1u); return (bh)(u >> 16); }
__device__ __forceinline__ float bf2f(bh h) { return __uint_as_float(((unsigned)h) << 16); }
__device__ __forceinline__ unsigned pk2(float lo, float hi) { return (unsigned)f2bf(lo) | ((unsigned)f2bf(hi) << 16); }
__device__ __forceinline__ float sigmoidf_(float x) { return 1.0f / (1.0f + __expf(-x)); }
__device__ __forceinline__ float bperm_f(int srclane, float v) { return __builtin_bit_cast(float, __builtin_amdgcn_ds_bpermute(srclane << 2, __builtin_bit_cast(int, v))); }
__device__ __forceinline__ float wave_sum(float v) {
    const int lane = TIDX() & 63;
#pragma unroll
    for (int o = 32; o >= 1; o >>= 1) v += bperm_f(lane ^ o, v);
    return v;
}
__device__ __forceinline__ float wave_max(float v) {
    const int lane = TIDX() & 63;
#pragma unroll
    for (int o = 32; o >= 1; o >>= 1) v = fmaxf(v, bperm_f(lane ^ o, v));
    return v;
}
template <int CTRL> __device__ __forceinline__ float dpp_f(float x) {
    return __builtin_bit_cast(float, __builtin_amdgcn_update_dpp(0, __builtin_bit_cast(int, x), CTRL, 0xf, 0xf, true));
}
__device__ __forceinline__ float allreduce16(float x) {
    x += dpp_f<0xB1>(x); x += dpp_f<0x4E>(x); x += dpp_f<0x141>(x); x += dpp_f<0x140>(x);
    return x;
}
__device__ __forceinline__ float OZ() { float z = 0.f; asm volatile("" : "+v"(z)); return z; }
#define MFMA16(a, b, c) __builtin_amdgcn_mfma_f32_16x16x32_bf16(a, b, c, 0, 0, 0)
#define MFMA32(a, b, c) __builtin_amdgcn_mfma_f32_32x32x16_bf16(a, b, c, 0, 0, 0)

namespace pg8 {
constexpr int BM = 256, BK = 64, HALF = 128, HTB = HALF * BK * 2, STAGE_BYTES = 8 * HTB, NXCD = 8, WGM = 8;
__device__ __forceinline__ int lds_byte(int r, int c) { const int st = (r >> 4) * 2 + (c >> 5), rr = r & 15, cc = c & 31, ob = rr * 64 + cc * 2; return st * 1024 + (ob ^ (((ob >> 9) & 1) << 5)); }
__device__ __forceinline__ void stage_rc(int b, int& R, int& C) { const int st = b / 1024, sb = b % 1024, swz = sb ^ (((sb >> 9) & 1) << 5); R = (st >> 1) * 16 + swz / 64; C = (st & 1) * 32 + (swz % 64) / 2; }
__device__ __forceinline__ int perm32(int rho) { const int n = rho >> 4, i = rho & 15; return 8 * (i >> 2) + 4 * n + (i & 3); }
struct Unit { int pm, pn; };
struct Gemm { const bh* A; const bh* Bt; int M, N, K, lda, ldb, epi, perm, L; };
struct StaticOrder {
    int nM, nN, nwg, G, c;
    __device__ void init(int M, int N, int G_, int c_) { nM = M / BM; nN = N / BM; nwg = nM * nN; G = G_; c = c_; }
    __device__ bool next(int i, Unit& u) const {
        const long L = (long)i * G + c; if (L >= nwg) return false;
        int wgid = (int)L; { const int q = nwg / NXCD, r = nwg % NXCD, xcd = wgid % NXCD, off = wgid / NXCD; wgid = (xcd < r ? xcd * (q + 1) : r * (q + 1) + (xcd - r) * q) + off; }
        const int nig = WGM * nN, gid = wgid / nig, fm = gid * WGM, gsz = (nM - fm) < WGM ? (nM - fm) : WGM;
        u.pm = fm + ((wgid % nig) % gsz); u.pn = (wgid % nig) / gsz; return true;
    }
};
__device__ __forceinline__ unsigned cvt_pk_bf16(float lo, float hi) { unsigned r; asm volatile("v_cvt_pk_bf16_f32 %0, %1, %2" : "=v"(r) : "v"(lo), "v"(hi)); return r; }

__device__ __forceinline__ void epi_run(const Gemm& g, const f32x4 (&acc)[2][2][4][2], const Unit& u, int wr, int wc, int fr, int fq);
__device__ __forceinline__ void up_rescale(f32x4 (&acc)[2][2][4][2], const Unit& u, int wr, int wc, int fr, int fq, int goff) {
    const bh* zg = (const bh*)(P_WS + OFF_ZG) + goff;
    asm volatile("" : "+v"(fr), "+v"(fq));
    const bh* zrow0 = zg + (size_t)(u.pm * 256 + wr * 64 + fr) * NGATE + u.pn * 256 + wc * 32 + 4 * fq;
#pragma unroll
    for (int ai = 0; ai < 2; ++ai)
#pragma unroll
        for (int m = 0; m < 4; ++m) { const bh* zr = zrow0 + (size_t)(ai * 128 + m * 16) * NGATE;
#pragma unroll
            for (int bj = 0; bj < 2; ++bj)
#pragma unroll
                for (int n = 0; n < 2; ++n) {
                    const u32x2 gp = *(const u32x2*)(zr + bj * 128 + n * 16), gn = *(const u32x2*)(zr + 2048 + bj * 128 + n * 16);
                    f32x4 r;
                    r[0] = __uint_as_float(gp.x << 16) * __builtin_amdgcn_rcpf(__uint_as_float(gn.x << 16)); r[1] = __uint_as_float(gp.x & 0xffff0000u) * __builtin_amdgcn_rcpf(__uint_as_float(gn.x & 0xffff0000u));
                    r[2] = __uint_as_float(gp.y << 16) * __builtin_amdgcn_rcpf(__uint_as_float(gn.y << 16)); r[3] = __uint_as_float(gp.y & 0xffff0000u) * __builtin_amdgcn_rcpf(__uint_as_float(gn.y & 0xffff0000u));
                    acc[ai][bj][m][n] *= r; }
            __builtin_amdgcn_sched_barrier(0); }
}
__device__ __forceinline__ void gemm_phase(LAS unsigned char* lds, const Gemm& g, const StaticOrder& S) {
    const int tid = TIDX(), wid = __builtin_amdgcn_readfirstlane(tid >> 6), lane = tid & 63, wr = wid >> 2, wc = wid & 3, fr = lane & 15, fq = lane >> 4;
    const int K = g.K, nt = K / BK;
    unsigned voffA[2], voffB[2];
#pragma unroll
    for (int i = 0; i < 2; ++i) { int R, C; stage_rc(tid * 16 + i * 8192, R, C); const int Rb = g.perm ? ((R & ~31) + perm32(R & 31)) : R;
        voffA[i] = (unsigned)(R * g.lda + C) * 2u; voffB[i] = (unsigned)(Rb * g.ldb + C) * 2u; }
    const size_t kstep = (size_t)(BK * 2);
    const size_t hstepA = (size_t)HALF * g.lda * 2, hstepB = (size_t)HALF * g.ldb * 2;
    const size_t tstepA = 2 * hstepA, tstepB = 2 * hstepB;
    const unsigned ldsw = (unsigned)wid * 1024u;
    const int aoff = lds_byte(wr * 64 + fr, fq * 8), boff = lds_byte(wc * 32 + fr, fq * 8);
#define PG8_SA(b, h) (((b) * 2 + (h)) * HTB)
#define PG8_SB(b, h) ((4 + (b) * 2 + (h)) * HTB)
#define PG8_STAGE(bufoff, gbase, voff) do { _Pragma("unroll") for (int _i = 0; _i < 2; ++_i) \
        __builtin_amdgcn_global_load_lds((const unsigned*)((const char*)(gbase) + (voff)[_i]), (LAS unsigned*)(lds + (bufoff) + ldsw + _i * 8192), 16, 0, 0); } while (0)
#define PG8_LDA(dst, b, h) do { _Pragma("unroll") for (int m = 0; m < 4; ++m) _Pragma("unroll") for (int k = 0; k < 2; ++k) dst[m][k] = *(const LAS bf16x8*)(lds + PG8_SA(b, h) + aoff + m * 2048 + k * 1024); } while (0)
#define PG8_LDB(dst, b, h) do { _Pragma("unroll") for (int n = 0; n < 2; ++n) _Pragma("unroll") for (int k = 0; k < 2; ++k) dst[n][k] = *(const LAS bf16x8*)(lds + PG8_SB(b, h) + boff + n * 2048 + k * 1024); } while (0)
#define PG8_MMA(ai, bj, At, Bt) do { __builtin_amdgcn_s_setprio(1); _Pragma("unroll") for (int m = 0; m < 4; ++m) _Pragma("unroll") for (int n = 0; n < 2; ++n) _Pragma("unroll") for (int k = 0; k < 2; ++k) \
        acc[ai][bj][m][n] = __builtin_amdgcn_mfma_f32_16x16x32_bf16(Bt[n][k], At[m][k], acc[ai][bj][m][n], 0, 0, 0); __builtin_amdgcn_s_setprio(0); } while (0)
#define PG8_WAIT_V(n) asm volatile("s_waitcnt vmcnt(" #n ")" ::: "memory")
#define PG8_WAIT_L(n) asm volatile("s_waitcnt lgkmcnt(" #n ")" ::: "memory")
#define PG8_BAR __builtin_amdgcn_s_barrier()
#define PG8_SCHED __builtin_amdgcn_sched_barrier(0)
    Unit cur, nxt; int ui = 0;
    if (!S.next(0, cur)) return;
    f32x4 acc[2][2][4][2];
    { const float z = OZ();
#pragma unroll
    for (int a = 0; a < 2; ++a)
#pragma unroll
        for (int b = 0; b < 2; ++b)
#pragma unroll
            for (int m = 0; m < 4; ++m)
#pragma unroll
                for (int n = 0; n < 2; ++n) acc[a][b][m][n] = (f32x4){z, z, z, z}; }
    bf16x8 At[4][2], B0[2][2], B1[2][2];
    const char* cA = (const char*)g.A + (size_t)cur.pm * tstepA; const char* cB = (const char*)g.Bt + (size_t)cur.pn * tstepB;
    PG8_STAGE(PG8_SB(0, 0), cB, voffB); PG8_STAGE(PG8_SA(0, 0), cA, voffA); PG8_STAGE(PG8_SB(0, 1), cB + hstepB, voffB); PG8_STAGE(PG8_SA(0, 1), cA + hstepA, voffA);
    if (wr == 1) PG8_BAR;
    PG8_WAIT_V(4); PG8_BAR;
    PG8_STAGE(PG8_SB(1, 0), cB + kstep, voffB); PG8_STAGE(PG8_SA(1, 0), cA + kstep, voffA); PG8_STAGE(PG8_SB(1, 1), cB + hstepB + kstep, voffB);
    PG8_WAIT_V(6); PG8_BAR;
    for (;;) {
        const bool has_next = S.next(ui + 1, nxt);
        const char* nA = has_next ? (const char*)g.A + (size_t)nxt.pm * tstepA : cA; const char* nB = has_next ? (const char*)g.Bt + (size_t)nxt.pn * tstepB : cB;
        for (int t = 0; t < nt; t += 2) {
            if (g.epi == 11 && (t == 16 || t == 24)) up_rescale(acc, cur, wr, wc, fr, fq, t == 16 ? 0 : 2048);
            const bool last = (t == nt - 2);
            const char* a1 = cA + (size_t)(t + 1) * kstep;
            const char* a2 = last ? nA : cA + (size_t)(t + 2) * kstep; const char* b2 = last ? nB : cB + (size_t)(t + 2) * kstep;
            const char* a3 = a2 + kstep; const char* b3 = b2 + kstep;
            PG8_LDB(B0, 0, 0); PG8_SCHED; PG8_LDA(At, 0, 0); PG8_STAGE(PG8_SA(1, 1), a1 + hstepA, voffA);
            PG8_WAIT_L(8); PG8_BAR; PG8_WAIT_L(0); PG8_MMA(0, 0, At, B0); PG8_BAR; PG8_SCHED;
            PG8_LDB(B1, 0, 1); PG8_STAGE(PG8_SB(0, 0), b2, voffB);
            PG8_BAR; PG8_WAIT_L(0); PG8_MMA(0, 1, At, B1); PG8_BAR;
            PG8_LDA(At, 0, 1); PG8_STAGE(PG8_SA(0, 0), a2, voffA);
            PG8_BAR; PG8_WAIT_L(0); PG8_MMA(1, 0, At, B0); PG8_BAR; PG8_SCHED;
            PG8_STAGE(PG8_SB(0, 1), b2 + hstepB, voffB);
            PG8_WAIT_V(6); PG8_BAR; PG8_MMA(1, 1, At, B1); PG8_BAR;
            PG8_LDB(B0, 1, 0); PG8_SCHED; PG8_LDA(At, 1, 0); PG8_STAGE(PG8_SA(0, 1), a2 + hstepA, voffA);
            PG8_WAIT_L(8); PG8_BAR; PG8_WAIT_L(0); PG8_MMA(0, 0, At, B0); PG8_BAR; PG8_SCHED;
            PG8_LDB(B1, 1, 1); PG8_STAGE(PG8_SB(1, 0), b3, voffB);
            PG8_BAR; PG8_WAIT_L(0); PG8_MMA(0, 1, At, B1); PG8_BAR;
            PG8_LDA(At, 1, 1); PG8_STAGE(PG8_SA(1, 0), a3, voffA);
            PG8_BAR; PG8_WAIT_L(0); PG8_MMA(1, 0, At, B0); PG8_BAR; PG8_SCHED;
            PG8_STAGE(PG8_SB(1, 1), b3 + hstepB, voffB);
            PG8_WAIT_V(6); PG8_BAR; PG8_MMA(1, 1, At, B1); PG8_BAR;
        }
        epi_run(g, acc, cur, wr, wc, fr, fq);
        if (!has_next) break;
        { const float z = OZ();
#pragma unroll
        for (int a = 0; a < 2; ++a)
#pragma unroll
            for (int b = 0; b < 2; ++b)
#pragma unroll
                for (int m = 0; m < 4; ++m)
#pragma unroll
                    for (int n = 0; n < 2; ++n) acc[a][b][m][n] = (f32x4){z, z, z, z}; }
        cur = nxt; cA = nA; cB = nB; ++ui;
    }
    PG8_WAIT_V(0);
    if (wr == 0) PG8_BAR;
    PG8_BAR;
#undef PG8_SA
#undef PG8_SB
#undef PG8_STAGE
#undef PG8_LDA
#undef PG8_LDB
#undef PG8_MMA
#undef PG8_WAIT_V
#undef PG8_WAIT_L
#undef PG8_BAR
#undef PG8_SCHED
}
}
using pg8::Unit;
using pg8::cvt_pk_bf16;

#define EPI_FOR_NP(...) \
    _Pragma("unroll") for (int ai = 0; ai < 2; ++ai) _Pragma("unroll") for (int m = 0; m < 4; ++m) { const int row = u.pm * 256 + ai * 128 + wr * 64 + m * 16 + fr; \
    _Pragma("unroll") for (int bj = 0; bj < 2; ++bj) _Pragma("unroll") for (int n = 0; n < 2; ++n) { const int col = u.pn * 256 + bj * 128 + wc * 32 + n * 16 + 4 * fq; const f32x4 v = acc[ai][bj][m][n]; __VA_ARGS__ } }

typedef const f32x4 (&AccRef)[2][2][4][2];

struct EpiWin {
    static constexpr bool PERM = false;
    bh* zg; float* zf;
    __device__ __forceinline__ void operator()(AccRef acc, const Unit& u, int wr, int wc, int fr, int fq) const {
        if (u.pn < 24) {
            EPI_FOR_NP({ u32x2 w; w.x = cvt_pk_bf16(fmaxf(sigmoidf_(v[0]), 1e-6f), fmaxf(sigmoidf_(v[1]), 1e-6f)); w.y = cvt_pk_bf16(fmaxf(sigmoidf_(v[2]), 1e-6f), fmaxf(sigmoidf_(v[3]), 1e-6f)); *(u32x2*)(zg + (size_t)row * NGATE + col) = w; })
        } else {
            EPI_FOR_NP({ *(f32x4*)(zf + (size_t)row * ZF_LD + (col - NGATE)) = v; })
        }
    }
};
struct EpiLoraW {
    static constexpr bool PERM = false;
    const float* w0; float* rw;
    __device__ __forceinline__ void operator()(AccRef acc, const Unit& u, int wr, int wc, int fr, int fq) const {
        EPI_FOR_NP({ const f32x4 b = *(const f32x4*)(w0 + col); f32x4 o;
            _Pragma("unroll") for (int j = 0; j < 4; ++j) { const float x = -(b[j] + v[j]); const float sp = fmaxf(x, 0.f) + log1pf(__expf(-fabsf(x))); o[j] = __expf(-__expf(-sp - 0.5f)); }
            *(f32x4*)(rw + (size_t)row * 512 + col) = o; })
    }
};
struct EpiLoraA {
    static constexpr bool PERM = false;
    const float* a0; const float* ka; const float* rkk; float* rb; float* rk;
    __device__ __forceinline__ void operator()(AccRef acc, const Unit& u, int wr, int wc, int fr, int fq) const {
        EPI_FOR_NP({ const f32x4 b0 = *(const f32x4*)(a0 + col); const f32x4 kav = *(const f32x4*)(ka + col); const size_t o = (size_t)row * 512 + col;
            const f32x4 kkv = *(const f32x4*)(rkk + o); f32x4 kv = *(const f32x4*)(rk + o); f32x4 bo;
            _Pragma("unroll") for (int j = 0; j < 4; ++j) { const float a = sigmoidf_(b0[j] + v[j]); bo[j] = kkv[j] * a; kv[j] = kv[j] * (1.0f + (a - 1.0f) * kav[j]); }
            *(f32x4*)(rb + o) = bo; *(f32x4*)(rk + o) = kv; })
    }
};
struct EpiStoreF32 {
    static constexpr bool PERM = false;
    float* o; int ld;
    __device__ __forceinline__ void operator()(AccRef acc, const Unit& u, int wr, int wc, int fr, int fq) const {
        EPI_FOR_NP({ *(f32x4*)(o + (size_t)row * ld + col) = v; })
    }
};
struct EpiGlu {
    static constexpr bool PERM = false;
    const bh* ys; const float* gb; bh* ycat;
    __device__ __forceinline__ void operator()(AccRef acc, const Unit& u, int wr, int wc, int fr, int fq) const {
        EPI_FOR_NP({ const f32x4 b = *(const f32x4*)(gb + col); const u32x2 y2 = *(const u32x2*)(ys + (size_t)row * 512 + col);
            const float y0 = __uint_as_float(y2.x << 16), y1 = __uint_as_float(y2.x & 0xffff0000u), y2f = __uint_as_float(y2.y << 16), y3 = __uint_as_float(y2.y & 0xffff0000u);
            u32x2 w; w.x = cvt_pk_bf16(y0 * sigmoidf_(v[0] + b[0]), y1 * sigmoidf_(v[1] + b[1])); w.y = cvt_pk_bf16(y2f * sigmoidf_(v[2] + b[2]), y3 * sigmoidf_(v[3] + b[3]));
            *(u32x2*)(ycat + (size_t)row * D + 1536 + col) = w; })
    }
};
template <int MODE> struct EpiUp {
    static constexpr bool PERM = false;
    const bh* zg; float* mix; bh* mixed;
    __device__ __forceinline__ void operator()(AccRef acc, const Unit& u, int wr, int wc, int fr, int fq) const {
        EPI_FOR_NP({ const u32x2 g2 = *(const u32x2*)(zg + (size_t)row * NGATE + col);
            f32x4 g; g[0] = __uint_as_float(g2.x << 16); g[1] = __uint_as_float(g2.x & 0xffff0000u); g[2] = __uint_as_float(g2.y << 16); g[3] = __uint_as_float(g2.y & 0xffff0000u);
            f32x4 r = g * v; float* mp = mix + (size_t)row * D + col;
            if (MODE >= 1) r += *(const f32x4*)mp;
            if (MODE <= 1) *(f32x4*)mp = r;
            else { u32x2 w; w.x = cvt_pk_bf16(r[0], r[1]); w.y = cvt_pk_bf16(r[2], r[3]); *(u32x2*)(mixed + (size_t)row * D + col) = w; } })
    }
};
struct EpiUpF {
    static constexpr bool PERM = false;
    const bh* zg; bh* mixed;
    __device__ __forceinline__ void operator()(AccRef acc, const Unit& u, int wr, int wc, int fr, int fq) const {
        EPI_FOR_NP({ const u32x2 g2 = *(const u32x2*)(zg + (size_t)row * NGATE + col);
            u32x2 w; w.x = cvt_pk_bf16(__uint_as_float(g2.x << 16) * v[0], __uint_as_float(g2.x & 0xffff0000u) * v[1]); w.y = cvt_pk_bf16(__uint_as_float(g2.y << 16) * v[2], __uint_as_float(g2.y & 0xffff0000u) * v[3]);
            *(u32x2*)(mixed + (size_t)row * D + col) = w; })
    }
};
struct EpiRes {
    static constexpr bool PERM = false;
    float* h;
    __device__ __forceinline__ void operator()(AccRef acc, const Unit& u, int wr, int wc, int fr, int fq) const {
        EPI_FOR_NP({ float* hp = h + (size_t)row * D + col; *(f32x4*)hp = *(const f32x4*)hp + v; })
    }
};
struct EpiFfn {
    static constexpr bool PERM = true;
    bh* act;
    __device__ __forceinline__ void operator()(AccRef acc, const Unit& u, int wr, int wc, int fr, int fq) const {
#pragma unroll
        for (int ai = 0; ai < 2; ++ai)
#pragma unroll
            for (int m = 0; m < 4; ++m) { const int row = u.pm * 256 + ai * 128 + wr * 64 + m * 16 + fr; const int col = u.pn * 128 + wc * 32 + 8 * fq;
                float o[8];
#pragma unroll
                for (int n = 0; n < 2; ++n)
#pragma unroll
                    for (int j = 0; j < 4; ++j) { const float gte = acc[ai][0][m][n][j], up = acc[ai][1][m][n][j]; o[n * 4 + j] = gte * sigmoidf_(gte) * up; }
                u32x4 w; w.x = cvt_pk_bf16(o[0], o[1]); w.y = cvt_pk_bf16(o[2], o[3]); w.z = cvt_pk_bf16(o[4], o[5]); w.w = cvt_pk_bf16(o[6], o[7]);
                *(u32x4*)(act + (size_t)row * FH + col) = w; }
    }
};
struct EpiPle {
    static constexpr bool PERM = false;
    float* h; const float* tmp;
    __device__ __forceinline__ void operator()(AccRef acc, const Unit& u, int wr, int wc, int fr, int fq) const {
        EPI_FOR_NP({ float* hp = h + (size_t)row * D + col; const f32x4 tv = *(const f32x4*)(tmp + (size_t)row * D + col); f32x4 hv = *(const f32x4*)hp;
            _Pragma("unroll") for (int j = 0; j < 4; ++j) hv[j] += tv[j] * sigmoidf_(v[j]);
            *(f32x4*)hp = hv; })
    }
};

namespace pg8 {
__device__ __forceinline__ void epi_run(const Gemm& g, const f32x4 (&acc)[2][2][4][2], const Unit& u, int wr, int wc, int fr, int fq) {
    unsigned char* ws = P_WS; const int L = g.L;
    switch (g.epi) {
    case 0: { EpiWin E{(bh*)(ws + OFF_ZG), (float*)(ws + OFF_ZF)}; E(acc, u, wr, wc, fr, fq); } break;
    case 1: { EpiLoraW E{P_IN(9) + L * 512, (float*)(ws + OFF_RW)}; E(acc, u, wr, wc, fr, fq); } break;
    case 2: { EpiLoraA E{P_IN(11) + L * 512, P_IN(15) + L * 512, (const float*)(ws + OFF_RKK), (float*)(ws + OFF_RB), (float*)(ws + OFF_RK)}; E(acc, u, wr, wc, fr, fq); } break;
    case 3: { EpiStoreF32 E{(float*)(ws + (g.N == 512 ? OFF_RG : OFF_MIX32)), g.N}; E(acc, u, wr, wc, fr, fq); } break;
    case 4: { EpiGlu E{(const bh*)(ws + OFF_YS), P_IN(28) + L * 512, (bh*)(ws + OFF_YCAT)}; E(acc, u, wr, wc, fr, fq); } break;
    case 5: { EpiUp<0> E{(const bh*)(ws + OFF_ZG), (float*)(ws + OFF_MIX32), (bh*)(ws + OFF_ABF)}; E(acc, u, wr, wc, fr, fq); } break;
    case 6: { EpiUp<1> E{(const bh*)(ws + OFF_ZG) + 2048, (float*)(ws + OFF_MIX32), (bh*)(ws + OFF_ABF)}; E(acc, u, wr, wc, fr, fq); } break;
    case 7: { EpiUp<2> E{(const bh*)(ws + OFF_ZG) + 4096, (float*)(ws + OFF_MIX32), (bh*)(ws + OFF_ABF)}; E(acc, u, wr, wc, fr, fq); } break;
    case 8: { EpiRes E{P_OUT}; E(acc, u, wr, wc, fr, fq); } break;
    case 9: { EpiFfn E{(bh*)(ws + OFF_ACT)}; E(acc, u, wr, wc, fr, fq); } break;
    case 11: { EpiUpF E{(const bh*)(ws + OFF_ZG) + 4096, (bh*)(ws + OFF_ABF)}; E(acc, u, wr, wc, fr, fq); } break;
    default: { EpiPle E{P_OUT, (const float*)(ws + OFF_MIX32)}; E(acc, u, wr, wc, fr, fq); } break;
    }
}
}

__device__ __forceinline__ bool make_gemm(const Params& p, int L, int q, int i, pg8::Gemm& g) {
    unsigned char* ws = P_WS;
    g.M = T; g.perm = 0; g.L = L;
    switch (q) {
    case 1: if (i > 0) return false;
        g.A = (const bh*)(ws + OFF_ABF); g.lda = D; g.Bt = (const bh*)(ws + OFF_WIN); g.ldb = D; g.N = NINP; g.K = D; g.epi = 0; return true;
    case 3: if (i > 2) return false;
        g.lda = 256; g.ldb = 256; g.N = 512; g.K = 256;
        if (i == 0) { g.A = (const bh*)(ws + OFF_LAW); g.Bt = (const bh*)(ws + OFF_WW2); g.epi = 1; }
        else if (i == 1) { g.A = (const bh*)(ws + OFF_LAA); g.Bt = (const bh*)(ws + OFF_WA2); g.epi = 2; }
        else { g.A = (const bh*)(ws + OFF_LAG); g.Bt = (const bh*)(ws + OFF_WG2); g.epi = 3; }
        return true;
    case 5: if (i > 0) return false;
        g.A = (const bh*)(ws + OFF_YS); g.lda = 512; g.Bt = (const bh*)(ws + OFF_WGLU); g.ldb = 512; g.N = 512; g.K = 512; g.epi = 4; return true;
    case 6: if (i > 0) return false;
        g.A = (const bh*)(ws + OFF_YCAT); g.lda = D; g.Bt = (const bh*)(ws + OFF_WUP); g.ldb = D; g.N = D; g.K = D; g.epi = 11; return true;
    case 7: if (i > 0) return false;
        g.A = (const bh*)(ws + OFF_ABF); g.lda = D; g.Bt = (const bh*)(ws + OFF_WO); g.ldb = D; g.N = D; g.K = D; g.epi = 8; return true;
    case 9: if (i > 0) return false;
        g.A = (const bh*)(ws + OFF_ABF); g.lda = D; g.Bt = (const bh*)(ws + OFF_WGU); g.ldb = D; g.N = 2 * FH; g.K = D; g.epi = 9; g.perm = 1; return true;
    case 10: if (i > 0) return false;
        g.A = (const bh*)(ws + OFF_ACT); g.lda = FH; g.Bt = (const bh*)(ws + OFF_WD); g.ldb = FH; g.N = D; g.K = FH; g.epi = 8; return true;
    case 12: if (i > 1) return false;
        if (i == 0) { g.A = (const bh*)(ws + OFF_PBF) + (size_t)L * T * 256; g.lda = 256; g.Bt = (const bh*)(ws + OFF_WPP); g.ldb = 256; g.N = D; g.K = 256; g.epi = 3; }
        else { g.A = (const bh*)(ws + OFF_ABF); g.lda = D; g.Bt = (const bh*)(ws + OFF_WPG); g.ldb = D; g.N = D; g.K = D; g.epi = 10; }
        return true;
    default: return false;
    }
}

struct CJ { const float* src; int in_idx, src_ld, kv, n0, nv; long lstride; size_t dst; int dst_ld, r0, c0, npad, kpad, seg, segstride; };
constexpr int BIGSEG = 1 << 30;
__constant__ int JT_I[15][12] = {
    {3, NIN, 2048, NF, NGATE, D, 0, 0, NGATE, 2048, BIGSEG, 0},
    {3, NIN, 2048, 0, NF, D, NGATE, 0, 6656, 2048, BIGSEG, 0},
    {29, D, 1024, 0, D, D, 0, 0, D, 1024, BIGSEG, 0},
    {30, D, 512, 0, D, D, 0, 1024, D, 512, BIGSEG, 0},
    {31, D, 512, 0, D, D, 0, 1536, D, 512, BIGSEG, 0},
    {32, D, 2048, 0, D, D, 0, 0, D, 2048, BIGSEG, 0},
    {34, FH, 2048, 0, FH, D, 0, 0, FH, 2048, 128, 256},
    {35, FH, 2048, 0, FH, D, 128, 0, FH, 2048, 128, 256},
    {36, D, FH, 0, D, FH, 0, 0, D, FH, BIGSEG, 0},
    {38, D, 2048, 0, D, D, 0, 0, D, 2048, BIGSEG, 0},
    {39, D, 256, 0, D, 256, 0, 0, D, 256, BIGSEG, 0},
    {27, 512, 512, 0, 512, 512, 0, 0, 512, 512, BIGSEG, 0},
    {10, 512, 96, 0, 512, 256, 0, 0, 512, 256, BIGSEG, 0},
    {12, 512, 96, 0, 512, 256, 0, 0, 512, 256, BIGSEG, 0},
    {13, 512, 256, 0, 512, 256, 0, 0, 512, 256, BIGSEG, 0}};
__constant__ long JT_L[15][2] = {
    {(long)D * NIN, (long)OFF_WIN}, {(long)D * NIN, (long)OFF_WIN}, {(long)1024 * D, (long)OFF_WUP}, {(long)512 * D, (long)OFF_WUP}, {(long)512 * D, (long)OFF_WUP},
    {(long)D * D, (long)OFF_WO}, {(long)D * FH, (long)OFF_WGU}, {(long)D * FH, (long)OFF_WGU}, {(long)FH * D, (long)OFF_WD}, {(long)D * D, (long)OFF_WPG},
    {(long)256 * D, (long)OFF_WPP}, {(long)512 * 512, (long)OFF_WGLU}, {(long)96 * 512, (long)OFF_WW2}, {(long)96 * 512, (long)OFF_WA2}, {(long)256 * 512, (long)OFF_WG2}};
__device__ __forceinline__ void get_job(int j, CJ& J) {
    J.in_idx = JT_I[j][0]; J.src_ld = JT_I[j][1]; J.kv = JT_I[j][2]; J.n0 = JT_I[j][3]; J.nv = JT_I[j][4]; J.dst_ld = JT_I[j][5]; J.r0 = JT_I[j][6]; J.c0 = JT_I[j][7];
    J.npad = JT_I[j][8]; J.kpad = JT_I[j][9]; J.seg = JT_I[j][10]; J.segstride = JT_I[j][11]; J.lstride = JT_L[j][0]; J.dst = (size_t)JT_L[j][1];
}
__device__ __forceinline__ const float* in_by_idx(const Params& p, int i) { return P_IN(i); }
constexpr int NJOBS = 15;

__device__ __forceinline__ void conv_tile(int L, const CJ& J, int tile, int lane, bh* dstbase) {
    const int nkt = J.kpad / 64; const int tn = tile / nkt, tk = tile % nkt;
    const float* src = J.src + (size_t)L * J.lstride;
    const int cq = lane & 15, r = lane >> 4;
    const int nl = tn * 64 + cq * 4; const bool nok = nl < J.nv;
    const int k0 = tk * 64 + 16 * r;
    f32x4 v[16];
    const float* sp = src + (size_t)k0 * J.src_ld + J.n0 + nl;
    const float zc = OZ();
#pragma unroll
    for (int i = 0; i < 16; ++i) { v[i] = (f32x4){zc, zc, zc, zc}; if (nok && (k0 + i) < J.kv) v[i] = *(const f32x4*)(sp + (size_t)i * J.src_ld); }
#pragma unroll
    for (int j = 0; j < 4; ++j) { const int n = nl + j; const int drow = J.r0 + (n / J.seg) * J.segstride + (n % J.seg);
        u32x4 w0, w1;
        w0.x = cvt_pk_bf16(v[0][j], v[1][j]); w0.y = cvt_pk_bf16(v[2][j], v[3][j]); w0.z = cvt_pk_bf16(v[4][j], v[5][j]); w0.w = cvt_pk_bf16(v[6][j], v[7][j]);
        w1.x = cvt_pk_bf16(v[8][j], v[9][j]); w1.y = cvt_pk_bf16(v[10][j], v[11][j]); w1.z = cvt_pk_bf16(v[12][j], v[13][j]); w1.w = cvt_pk_bf16(v[14][j], v[15][j]);
        bh* d = dstbase + (size_t)drow * J.dst_ld + J.c0 + k0;
        *(u32x4*)d = w0; *(u32x4*)(d + 8) = w1; }
}

__device__ __forceinline__ void rms_row_bf16(const float* x, const float* g, bh* o, int lane) {
    f32x4 v[8]; float s = 0.f;
#pragma unroll
    for (int j = 0; j < 8; ++j) { v[j] = *(const f32x4*)(x + j * 256 + lane * 4); s += (v[j][0] * v[j][0] + v[j][1] * v[j][1]) + (v[j][2] * v[j][2] + v[j][3] * v[j][3]); }
    const float rstd = rsqrtf(wave_sum(s) * (1.0f / D) + 1e-6f);
#pragma unroll
    for (int j = 0; j < 8; ++j) { const f32x4 gg = *(const f32x4*)(g + j * 256 + lane * 4); u32x2 w; w.x = pk2(v[j][0] * rstd * gg[0], v[j][1] * rstd * gg[1]); w.y = pk2(v[j][2] * rstd * gg[2], v[j][3] * rstd * gg[3]);
        *(u32x2*)(o + j * 256 + lane * 4) = w; }
}
__device__ __forceinline__ void phase_rmsnorm(const Params& p, const float* g) {
    const int gw = BIDX() * 8 + (TIDX() >> 6), NGW = GDIM() * 8, lane = TIDX() & 63;
    bh* abf = (bh*)(P_WS + OFF_ABF);
    for (int r = gw; r < T; r += NGW) rms_row_bf16(P_OUT + (size_t)r * D, g, abf + (size_t)r * D, lane);
}

__device__ __forceinline__ void phase_conv(const Params& p, int L, LAS unsigned char* lds) {
    const int tid = TIDX();
    {   const int gw0 = BIDX() * 8 + (tid >> 6), NGW0 = GDIM() * 8, ln = tid & 63;
        int base = 0;
        for (int j = 0; j < NJOBS; ++j) { CJ J; get_job(j, J); J.src = in_by_idx(p, J.in_idx); const int ntile = (J.npad / 64) * (J.kpad / 64);
            int first = gw0 - (base % NGW0); if (first < 0) first += NGW0;
            bh* dstbase = (bh*)(P_WS + J.dst);
            for (int t = first; t < ntile; t += NGW0) conv_tile(L, J, t, ln, dstbase);
            base += ntile; } }
    const int gw = BIDX() * 8 + (tid >> 6), NGW = GDIM() * 8, lane = tid & 63;
    bh* abf = (bh*)(P_WS + OFF_ABF);
    if (L == 0) {
        const float* ps = P_IN(1); bh* pb = (bh*)(P_WS + OFF_PBF);
        for (size_t i = (size_t)BIDX() * 512 + tid; i < (size_t)2 * T * 256 / 4; i += (size_t)GDIM() * 512) { const f32x4 v = ((const f32x4*)ps)[i]; u32x2 w; w.x = pk2(v[0], v[1]); w.y = pk2(v[2], v[3]); ((u32x2*)pb)[i] = w; }
        const float* x = P_IN(0);
        for (int r = gw; r < T; r += NGW) {
#pragma unroll
            for (int j = 0; j < 8; ++j) *(f32x4*)(P_OUT + (size_t)r * D + j * 256 + lane * 4) = *(const f32x4*)(x + (size_t)r * D + j * 256 + lane * 4);
            rms_row_bf16(x + (size_t)r * D, P_IN(2), abf + (size_t)r * D, lane);
        }
    } else {
        for (int r = gw; r < T; r += NGW) rms_row_bf16(P_OUT + (size_t)r * D, P_IN(2) + (size_t)L * D, abf + (size_t)r * D, lane);
    }
}

struct S5C { float ar, ai; float br[16], bi[16]; };
__device__ __forceinline__ void s5_setup(const Params& p, int L, int g, int n, S5C& c) {
    const int gi = L * 32 + g;
    const float dt = __expf(P_IN(21)[gi]);
    const float are = P_IN(19)[gi * 64 + n], aim = P_IN(20)[gi * 64 + n];
    const float mag = __expf(are * dt), ang = aim * dt;
    float sn, cs;
    {
        const double a = (double)ang; const double k = rint(a * 0.15915494309189535); const float r = (float)(a - k * 6.283185307179586);
        sn = sinf(r); cs = cosf(r);
    }
    c.ar = mag * cs; c.ai = mag * sn;
    const float den = are * are + aim * aim, nr = c.ar - 1.0f, ni = c.ai;
    const float cr = (nr * are + ni * aim) / den, ci = (ni * are - nr * aim) / den;
    const float* bre = P_IN(22) + ((size_t)gi * 64 + n) * 16; const float* bim = P_IN(23) + ((size_t)gi * 64 + n) * 16;
#pragma unroll
    for (int q = 0; q < 4; ++q) { const f32x4 r4 = *(const f32x4*)(bre + q * 4), i4 = *(const f32x4*)(bim + q * 4);
#pragma unroll
        for (int j = 0; j < 4; ++j) { c.br[q * 4 + j] = cr * r4[j] - ci * i4[j]; c.bi[q * 4 + j] = cr * i4[j] + ci * r4[j]; } }
}
__device__ __forceinline__ void s5_step(const S5C& c, const LAS float* urow, float& sr, float& si) {
    float xr = 0.f, xi = 0.f;
#pragma unroll
    for (int q = 0; q < 4; ++q) { const f32x4 u4 = *(const LAS f32x4*)(urow + q * 4);
#pragma unroll
        for (int j = 0; j < 4; ++j) { xr = fmaf(u4[j], c.br[q * 4 + j], xr); xi = fmaf(u4[j], c.bi[q * 4 + j], xi); } }
    const float nr = c.ar * sr - c.ai * si + xr, ni = c.ar * si + c.ai * sr + xi;
    sr = nr; si = ni;
}
__device__ __forceinline__ void s5_stage_u(const float* zfc, LAS float* ul, int lane) {
    const float* src = zfc + (size_t)lane * ZF_LD;
    const f32x4 a = *(const f32x4*)src, b = *(const f32x4*)(src + 4), c = *(const f32x4*)(src + 8), d = *(const f32x4*)(src + 12);
    *(LAS f32x4*)(ul + lane * 16) = a; *(LAS f32x4*)(ul + lane * 16 + 4) = b; *(LAS f32x4*)(ul + lane * 16 + 8) = c; *(LAS f32x4*)(ul + lane * 16 + 12) = d;
    asm volatile("s_waitcnt lgkmcnt(0)" ::: "memory"); __builtin_amdgcn_wave_barrier();
}

__device__ __forceinline__ void mlstm_prep(const Params& p, int L, int h, int c, LAS unsigned char* lds) {
    const int tid = TIDX(), t0 = c * 64;
    const float* zf = (const float*)(P_WS + OFF_ZF);
    LAS float* s_ws = (LAS float*)lds;
    if (tid < 64) {
        const int t = t0 + tid;
        float ig = zf[(size_t)t * ZF_LD + 4096 + h] + P_IN(5)[L * 4 + h];
        float fg = zf[(size_t)t * ZF_LD + 4100 + h] + P_IN(6)[L * 4 + h];
        ig = 15.0f * tanhf(ig * (1.0f / 15.0f)); fg = 15.0f * tanhf(fg * (1.0f / 15.0f));
        const float lf = fminf(fg, 0.f) - log1pf(__expf(-fabsf(fg)));
        float b = lf;
#pragma unroll
        for (int o = 1; o < 64; o <<= 1) { const float nb = bperm_f((tid - o) & 63, b); if (tid >= o) b += nb; }
        const float bend = bperm_f(63, b);
        const float wlog = bend - b + ig;
        const float mloc = wave_max(wlog);
        s_ws[tid] = __expf(wlog - mloc);
        ((float*)(P_WS + OFF_MI))[h * T + t] = ig; ((float*)(P_WS + OFF_MBB))[h * T + t] = b;
        if (tid == 0) { ((float*)(P_WS + OFF_MBEND))[h * NCH + c] = bend; ((float*)(P_WS + OFF_MLOC))[h * NCH + c] = mloc; }
    }
    __syncthreads();
    const int d = tid & 255, isk = tid >> 8;
    const int col = isk * 1024 + h * 256 + d;
    const float* cw = P_IN(4) + (size_t)L * 4 * 2048;
    const float w0 = cw[col], w1 = cw[2048 + col], w2 = cw[4096 + col], w3 = cw[6144 + col];
    float x1 = (t0 >= 1) ? zf[(size_t)(t0 - 1) * ZF_LD + col] : 0.f, x2 = (t0 >= 2) ? zf[(size_t)(t0 - 2) * ZF_LD + col] : 0.f, x3 = (t0 >= 3) ? zf[(size_t)(t0 - 3) * ZF_LD + col] : 0.f;
    bh* MQ = (bh*)(P_WS + OFF_MQ); bh* MK = (bh*)(P_WS + OFF_MK);
    bh* MT = (bh*)(P_WS + (isk ? OFF_MKT : OFF_MVT)) + ((size_t)(h * NCH + c) * 256 + d) * 64;
    float dnacc = 0.f;
    for (int s8 = 0; s8 < 8; ++s8) {
        unsigned pk[4];
#pragma unroll
        for (int j = 0; j < 8; ++j) { const int s = s8 * 8 + j, t = t0 + s;
            const float x0 = zf[(size_t)t * ZF_LD + col]; float y = w0 * x0 + w1 * x1 + w2 * x2 + w3 * x3; x3 = x2; x2 = x1; x1 = x0;
            y = y * sigmoidf_(y);
            unsigned short e;
            if (!isk) { MQ[(size_t)t * 1024 + h * 256 + d] = f2bf(y * 0.0625f); e = f2bf(zf[(size_t)t * ZF_LD + 2048 + h * 256 + d]); }
            else { MK[(size_t)t * 1024 + h * 256 + d] = f2bf(y); const float wk = y * s_ws[s]; e = f2bf(wk); dnacc += wk; }
            if (j & 1) pk[j >> 1] |= ((unsigned)e << 16); else pk[j >> 1] = e; }
        u32x4 w; w.x = pk[0]; w.y = pk[1]; w.z = pk[2]; w.w = pk[3];
        *(u32x4*)(MT + s8 * 8) = w;
    }
    if (isk) ((float*)(P_WS + OFF_DN))[(size_t)(h * NCH + c) * 256 + d] = dnacc;
    __syncthreads();
}

__device__ __forceinline__ void rwkv_prep_token(const Params& p, int L, int t, int lane) {
    const float* zf = (const float*)(P_WS + OFF_ZF);
    const float* z = zf + (size_t)t * ZF_LD + ZR0; const float* zp = z - ZF_LD; const bool hp = t > 0;
    const float* mu = P_IN(8) + (size_t)L * 1984;
    float* RR = (float*)(P_WS + OFF_RR); float* RK = (float*)(P_WS + OFF_RK); float* RV = (float*)(P_WS + OFF_RV); float* RKK = (float*)(P_WS + OFF_RKK);
    const float* kkw = P_IN(14) + L * 512;
#pragma unroll
    for (int i = 0; i < 8; ++i) { const int c = i * 64 + lane;
        { const float a = z[c], b = hp ? zp[c] : 0.f; RR[(size_t)t * 512 + c] = a + (b - a) * mu[c]; }
        { const float a = z[1024 + c], b = hp ? zp[1024 + c] : 0.f; RV[(size_t)t * 512 + c] = a + (b - a) * mu[1024 + c]; }
        { const float a = z[512 + c], b = hp ? zp[512 + c] : 0.f; const float k = a + (b - a) * mu[512 + c]; RK[(size_t)t * 512 + c] = k;
          const float kkv = k * kkw[c]; const float ss = wave_sum(kkv * kkv); RKK[(size_t)t * 512 + c] = kkv / fmaxf(sqrtf(ss), 1e-12f); } }
    bh* LAW = (bh*)(P_WS + OFF_LAW) + (size_t)t * 256; bh* LAA = (bh*)(P_WS + OFF_LAA) + (size_t)t * 256; bh* LAG = (bh*)(P_WS + OFF_LAG) + (size_t)t * 256;
#pragma unroll
    for (int i = 0; i < 4; ++i) { const int j = i * 64 + lane;
        float vw = 0.f, va = 0.f;
        if (j < 96) { { const int c = 1536 + j; const float a = z[c], b = hp ? zp[c] : 0.f; vw = tanhf(a + (b - a) * mu[c]); }
                      { const int c = 1632 + j; const float a = z[c], b = hp ? zp[c] : 0.f; va = a + (b - a) * mu[c]; } }
        LAW[j] = f2bf(vw); LAA[j] = f2bf(va);
        { const int c = 1728 + j; const float a = z[c], b = hp ? zp[c] : 0.f; LAG[j] = f2bf(sigmoidf_(a + (b - a) * mu[c])); } }
}

__device__ __forceinline__ void s5_pass_a(const Params& p, int L, int g, int c, int lane, LAS float* ul) {
    const float* zf = (const float*)(P_WS + OFF_ZF) + (size_t)(c * 64) * ZF_LD + ZS0 + g * 16;
    s5_stage_u(zf, ul, lane);
    S5C k; s5_setup(p, L, g, lane, k);
    float sr = 0.f, si = 0.f;
#pragma unroll 8
    for (int s = 0; s < 64; ++s) s5_step(k, ul + s * 16, sr, si);
    asm volatile("s_waitcnt lgkmcnt(0)" ::: "memory"); __builtin_amdgcn_wave_barrier();
    float* se = (float*)(P_WS + OFF_SEND) + ((size_t)(g * NCH + c) * 64 + lane) * 2;
    se[0] = sr; se[1] = si;
}

__device__ __forceinline__ void phase_prep(const Params& p, int L, LAS unsigned char* lds) {
    const int wid = TIDX() >> 6, lane = TIDX() & 63;
    for (int it = BIDX(); it < 2048; it += GDIM()) {
        if (it < 512) mlstm_prep(p, L, it >> 7, it & 127, lds);
        else if (it < 1536) rwkv_prep_token(p, L, (it - 512) * 8 + wid, lane);
        else { const int w = (it - 1536) * 8 + wid; s5_pass_a(p, L, w >> 7, w & 127, lane, (LAS float*)lds + wid * 1024); }
    }
}

constexpr int RW_NS = 4, RW_LS = T / RW_NS, RW_NB = RW_LS / 16, RW_RING = 4, RW_SLOT = 16 * 384;
constexpr int RW_YOFF = RW_RING * RW_SLOT;
__device__ __forceinline__ void rwkv_scan(const Params& p, int b, LAS unsigned char* lds) {
    const int tid = TIDX(), wid = __builtin_amdgcn_readfirstlane(tid >> 6), lane = tid & 63;
    int j, h, rg;
    if (b < 32) { j = 0; h = b >> 2; rg = b & 3; } else { const int u = b - 32; j = 1 + (u >> 6); h = (u & 63) >> 3; rg = u & 7; }
    LAS float* ring = (LAS float*)lds;
    LAS float* ybuf = ring + RW_YOFF;
    const int tbase = j * RW_LS;
    const bool isP = rg >= 4;
    if (wid >= 4) {
        const int lw = wid - 4, lt = tid - 256;
        const float* gp[6]; unsigned lo[6];
#pragma unroll
        for (int i = 0; i < 6; ++i) { const int ii = lw * 6 + i, rowidx = ii * 4 + (lane >> 4), step = rowidx / 6, a = rowidx % 6, q = lane & 15;
            const int ai = (0x205314 >> (4 * a)) & 0xf;
            gp[i] = (const float*)(P_WS + OFF_RR + (size_t)ai * SZ_R) + (size_t)(tbase + step) * 512 + h * 64 + q * 4;
            lo[i] = (unsigned)ii * 256u; }
        float* OUT = (float*)(P_WS + (isP ? OFF_RZ : OFF_RY)) + (size_t)(tbase + (lt >> 4)) * 512 + h * 64 + (rg & 3) * 16 + (lt & 15);
#define RW_ISSUE(bi, sl) do { _Pragma("unroll") for (int _i = 0; _i < 6; ++_i) \
        __builtin_amdgcn_global_load_lds((const unsigned*)(gp[_i] + (size_t)(bi) * 16 * 512), (LAS unsigned*)(ring + (sl) * RW_SLOT + lo[_i]), 16, 0, 0); } while (0)
        RW_ISSUE(0, 0); RW_ISSUE(1, 1); RW_ISSUE(2, 2);
        asm volatile("s_waitcnt vmcnt(12)" ::: "memory"); __builtin_amdgcn_s_barrier();
        int sl = 3;
        for (int ib = 0; ib < RW_NB; ++ib) {
            if (ib + 3 < RW_NB) RW_ISSUE(ib + 3, sl);
            sl = (sl == RW_RING - 1) ? 0 : sl + 1;
            if (ib > 0) {
                const LAS float* yb = ybuf + ((ib - 1) & 1) * 4096 + lt * 16;
                const f32x4 a0 = *(const LAS f32x4*)yb, a1 = *(const LAS f32x4*)(yb + 4), a2 = *(const LAS f32x4*)(yb + 8), a3 = *(const LAS f32x4*)(yb + 12);
                const f32x4 sm = (a0 + a1) + (a2 + a3);
                OUT[(size_t)(ib - 1) * 16 * 512] = (sm[0] + sm[1]) + (sm[2] + sm[3]);
            }
            if (ib + 3 < RW_NB) asm volatile("s_waitcnt vmcnt(13)" ::: "memory");
            else asm volatile("s_waitcnt vmcnt(0)" ::: "memory");
            __builtin_amdgcn_s_barrier();
        }
        {   const LAS float* yb = ybuf + ((RW_NB - 1) & 1) * 4096 + lt * 16;
            const f32x4 a0 = *(const LAS f32x4*)yb, a1 = *(const LAS f32x4*)(yb + 4), a2 = *(const LAS f32x4*)(yb + 8), a3 = *(const LAS f32x4*)(yb + 12);
            const f32x4 sm = (a0 + a1) + (a2 + a3);
            OUT[(size_t)(RW_NB - 1) * 16 * 512] = (sm[0] + sm[1]) + (sm[2] + sm[3]); }
#undef RW_ISSUE
    } else {
        const int r16 = wid * 4 + (lane >> 4), kq = lane & 15, row = (rg & 3) * 16 + r16;
        f32x4 S;
#pragma unroll
        for (int e = 0; e < 4; ++e) S[e] = (isP && (kq * 4 + e == row)) ? 1.f : 0.f;
        const float vmask = isP ? 0.f : 1.f;
        __builtin_amdgcn_s_barrier();
        int sl = 0;
        for (int ib = 0; ib < RW_NB; ++ib) {
            const LAS float* bb = ring + sl * RW_SLOT;
            LAS float* yw = ybuf + (ib & 1) * 4096 + r16 * 16 + kq;
            f32x4 w4 = *(const LAS f32x4*)(bb + kq * 4), k4 = *(const LAS f32x4*)(bb + 64 + kq * 4), kk4 = *(const LAS f32x4*)(bb + 128 + kq * 4),
                  b4 = *(const LAS f32x4*)(bb + 192 + kq * 4), r4 = *(const LAS f32x4*)(bb + 256 + kq * 4);
            float vv = bb[320 + row];
#pragma unroll
            for (int s = 0; s < 16; ++s) {
                f32x4 w4n, k4n, kk4n, b4n, r4n; float vvn;
                if (s < 15) { const LAS float* q = bb + (s + 1) * 384;
                    w4n = *(const LAS f32x4*)(q + kq * 4); k4n = *(const LAS f32x4*)(q + 64 + kq * 4); kk4n = *(const LAS f32x4*)(q + 128 + kq * 4);
                    b4n = *(const LAS f32x4*)(q + 192 + kq * 4); r4n = *(const LAS f32x4*)(q + 256 + kq * 4); vvn = q[320 + row]; }
                __builtin_amdgcn_sched_barrier(0);
                float pd = (S[0] * kk4[0] + S[1] * kk4[1]) + (S[2] * kk4[2] + S[3] * kk4[3]);
                const f32x4 pre = S * w4 + (vv * vmask) * k4;
                pd = allreduce16(pd);
                S = pre - pd * b4;
                yw[s * 256] = (S[0] * r4[0] + S[1] * r4[1]) + (S[2] * r4[2] + S[3] * r4[3]);
                if (s < 15) { w4 = w4n; k4 = k4n; kk4 = kk4n; b4 = b4n; r4 = r4n; vv = vvn; }
            }
            sl = (sl == RW_RING - 1) ? 0 : sl + 1;
            asm volatile("s_waitcnt lgkmcnt(0)" ::: "memory");
            __builtin_amdgcn_s_barrier();
        }
        float* EN = (float*)(P_WS + (isP ? OFF_RPEND : OFF_RSEND)) + ((size_t)(h * 4 + j) * 64 + row) * 64 + kq * 4;
        *(f32x4*)EN = S;
    }
    __syncthreads();
}

struct MStage { bf16x8 q[4], k[4], v[4]; float bend, mloc; };
__device__ __forceinline__ void mstage_load(MStage& st, const bh* qp, const bh* kp, const bh* vp, const float* MBEND, const float* MLOC, int h, int c) {
#pragma unroll
    for (int ks = 0; ks < 4; ++ks) { st.q[ks] = *(const bf16x8*)(qp + (size_t)c * 64 * 1024 + ks * 32); st.k[ks] = *(const bf16x8*)(kp + (size_t)c * 256 * 64 + ks * 16); st.v[ks] = *(const bf16x8*)(vp + (size_t)c * 256 * 64 + ks * 16); }
    st.bend = MBEND[h * NCH + c]; st.mloc = MLOC[h * NCH + c];
}
__device__ __forceinline__ void mlstm_seq(const Params& p, int mb, LAS unsigned char* lds) {
    const int tid = TIDX(), wid = tid >> 6, lane = tid & 63;
    const int h = mb >> 3, jv = mb & 7;
    LAS bh* Cbf = (LAS bh*)lds;
    constexpr int CS = 264;
    for (int i = tid; i < 2 * 32 * CS / 2; i += 512) ((LAS unsigned*)Cbf)[i] = 0u;
    __syncthreads();
    const bh* MQ = (const bh*)(P_WS + OFF_MQ); const bh* MKT = (const bh*)(P_WS + OFF_MKT); const bh* MVT = (const bh*)(P_WS + OFF_MVT);
    const float* MBEND = (const float*)(P_WS + OFF_MBEND); const float* MLOC = (const float*)(P_WS + OFF_MLOC);
    f32x16 ct;
    { const float z = OZ();
#pragma unroll
    for (int i = 0; i < 16; ++i) ct[i] = z; }
    float m = 0.f;
    const int mt = wid >> 1, kh = wid & 1;
    float* MINTER = (float*)(P_WS + OFF_ABF);
    LAS float* It = (LAS float*)(lds + 2 * 32 * 264 * 2);
    const bh* qp = MQ + (size_t)(mt * 16 + (lane & 15)) * 1024 + h * 256 + kh * 128 + (lane >> 4) * 8;
    const bh* kp = MKT + ((size_t)(h * NCH) * 256 + wid * 32 + (lane & 31)) * 64 + (lane >> 5) * 8;
    const bh* vp = MVT + ((size_t)(h * NCH) * 256 + jv * 32 + (lane & 31)) * 64 + (lane >> 5) * 8;
    MStage s0, s1, s2;
    mstage_load(s0, qp, kp, vp, MBEND, MLOC, h, 0);
    mstage_load(s1, qp, kp, vp, MBEND, MLOC, h, 1);
#define MSTEP(SC, SL, CIDX) do { const int c = (CIDX); const int t0 = c * 64, cur = c & 1; \
        mstage_load(SL, qp, kp, vp, MBEND, MLOC, h, (c + 2 < NCH) ? c + 2 : NCH - 1); \
        const float mnew = fmaxf(SC.bend + m, SC.mloc), decay = __expf(SC.bend + m - mnew), scale = __expf(SC.mloc - mnew); \
        f32x4 r0 = {0.f, 0.f, 0.f, 0.f}, r1 = {0.f, 0.f, 0.f, 0.f}; \
        const LAS bh* cb = Cbf + cur * 32 * CS + (lane & 15) * CS + kh * 128 + (lane >> 4) * 8; \
        _Pragma("unroll") for (int ks = 0; ks < 4; ++ks) { const bf16x8 b0 = *(const LAS bf16x8*)(cb + ks * 32), b1 = *(const LAS bf16x8*)(cb + 16 * CS + ks * 32); r0 = MFMA16(SC.q[ks], b0, r0); r1 = MFMA16(SC.q[ks], b1, r1); } \
        {     \
            if (c > 0) { const LAS float* ip = It + ((c - 1) & 1) * (2 * 64 * 36) + (tid >> 3) * 36 + (tid & 7) * 4; \
                const f32x4 sv = *(const LAS f32x4*)ip + *(const LAS f32x4*)(ip + 64 * 36); \
                float* o = MINTER + (size_t)(t0 - 64 + (tid >> 3)) * 1024 + h * 256 + jv * 32 + (tid & 7) * 4; \
                asm volatile("global_store_dwordx4 %0, %1, off\n\ts_nop 1" :: "v"(o), "v"(sv) : "memory"); } \
            LAS float* iw = It + cur * (2 * 64 * 36) + kh * (64 * 36) + (mt * 16 + (lane >> 4) * 4) * 36 + (lane & 15); \
            _Pragma("unroll") for (int r = 0; r < 4; ++r) { iw[r * 36] = r0[r]; iw[r * 36 + 16] = r1[r]; } } \
        f32x16 d0; { const float z = OZ(); _Pragma("unroll") for (int i = 0; i < 16; ++i) d0[i] = z; } \
        _Pragma("unroll") for (int ks = 0; ks < 4; ++ks) d0 = MFMA32(SC.k[ks], SC.v[ks], d0); \
        _Pragma("unroll") for (int i = 0; i < 16; ++i) ct[i] = decay * ct[i] + scale * d0[i]; \
        m = mnew; \
        {   LAS bh* o0 = Cbf + (cur ^ 1) * 32 * CS + (lane & 31) * CS + wid * 32 + 4 * (lane >> 5); \
            _Pragma("unroll") for (int g = 0; g < 4; ++g) { u32x2 w0; w0.x = cvt_pk_bf16(ct[4 * g], ct[4 * g + 1]); w0.y = cvt_pk_bf16(ct[4 * g + 2], ct[4 * g + 3]); *(LAS u32x2*)(o0 + 8 * g) = w0; } } \
        asm volatile("s_waitcnt lgkmcnt(0)" ::: "memory"); __builtin_amdgcn_s_barrier(); asm volatile("" ::: "memory"); } while (0)
    for (int c3 = 0; c3 < 126; c3 += 6) { MSTEP(s0, s2, c3); MSTEP(s1, s0, c3 + 1); MSTEP(s2, s1, c3 + 2); MSTEP(s0, s2, c3 + 3); MSTEP(s1, s0, c3 + 4); MSTEP(s2, s1, c3 + 5); }
    MSTEP(s0, s2, 126); MSTEP(s1, s0, 127);
#undef MSTEP
    {   const LAS float* ip = It + (127 & 1) * (2 * 64 * 36) + (tid >> 3) * 36 + (tid & 7) * 4;
        const f32x4 sv = *(const LAS f32x4*)ip + *(const LAS f32x4*)(ip + 64 * 36);
        *(f32x4*)(MINTER + (size_t)(127 * 64 + (tid >> 3)) * 1024 + h * 256 + jv * 32 + (tid & 7) * 4) = sv; }
    asm volatile("s_waitcnt vmcnt(0)" ::: "memory");
    __syncthreads();
}

__device__ __forceinline__ void mlstm_nscan(const Params& p) {
    const float* MBEND = (const float*)(P_WS + OFF_MBEND); const float* MLOC = (const float*)(P_WS + OFF_MLOC);
    const float* DN = (const float*)(P_WS + OFF_DN); float* NST = (float*)(P_WS + OFF_NST); float* MSTART = (float*)(P_WS + OFF_MSTART);
    for (int idx = TIDX(); idx < 1024; idx += 512) { const int h = idx >> 8, d = idx & 255; float m = 0.f, n = 0.f;
#pragma unroll 8
        for (int c = 0; c < NCH; ++c) { if (d == 0) MSTART[h * NCH + c] = m; NST[(size_t)(h * NCH + c) * 256 + d] = n;
            const float bend = MBEND[h * NCH + c], mloc = MLOC[h * NCH + c]; const float mnew = fmaxf(bend + m, mloc);
            n = __expf(bend + m - mnew) * n + __expf(mloc - mnew) * DN[(size_t)(h * NCH + c) * 256 + d]; m = mnew; } }
}

__device__ __forceinline__ float gelu_tanh(float x) { const float u = 0.7978845608028654f * (x + 0.044715f * x * x * x); return 0.5f * x * (1.0f + tanhf(u)); }

__device__ __forceinline__ void s5_pass_c(const Params& p, int L, int g, int c, int lane, LAS bh* img, LAS float* ul) {
    const float* zf = (const float*)(P_WS + OFF_ZF) + (size_t)(c * 64) * ZF_LD + ZS0 + g * 16;
    s5_stage_u(zf, ul, lane);
    S5C k; s5_setup(p, L, g, lane, k);
    float sr = 0.f, si = 0.f;
    {   float pr = k.ar, pi = k.ai;
#pragma unroll
        for (int i = 0; i < 6; ++i) { const float nr = pr * pr - pi * pi, ni = 2.f * pr * pi; pr = nr; pi = ni; }
        const float* se = (const float*)(P_WS + OFF_SEND) + ((size_t)(g * NCH) * 64 + lane) * 2;
        int cc = 0;
        for (; cc + 8 <= c; cc += 8) { float er[8], ei[8];
#pragma unroll
            for (int j = 0; j < 8; ++j) { er[j] = se[(size_t)(cc + j) * 128]; ei[j] = se[(size_t)(cc + j) * 128 + 1]; }
#pragma unroll
            for (int j = 0; j < 8; ++j) { const float nr = pr * sr - pi * si + er[j], ni = pr * si + pi * sr + ei[j]; sr = nr; si = ni; } }
        for (; cc < c; ++cc) { const float er = se[(size_t)cc * 128], ei = se[(size_t)cc * 128 + 1];
            const float nr = pr * sr - pi * si + er, ni = pr * si + pi * sr + ei; sr = nr; si = ni; } }
    const int gi = L * 32 + g;
    bf16x8 bfr[4];
    {   const int pp = lane & 15; const float* cre = P_IN(24) + ((size_t)gi * 16 + pp) * 64; const float* cim = P_IN(25) + ((size_t)gi * 16 + pp) * 64;
#pragma unroll
        for (int ks = 0; ks < 4; ++ks)
#pragma unroll
            for (int j = 0; j < 8; ++j) { const int n2 = ks * 32 + (lane >> 4) * 8 + j; const float v = (n2 < 64) ? cre[n2] : -cim[n2 - 64]; bfr[ks][j] = (short)f2bf(v); } }
    const float dco = P_IN(26)[L * 512 + g * 16 + (lane & 15)];
    bh* YS = (bh*)(P_WS + OFF_YS);
    for (int half = 0; half < 2; ++half) {
#pragma unroll 8
        for (int s = 0; s < 32; ++s) { s5_step(k, ul + (half * 32 + s) * 16, sr, si); img[s * 136 + lane] = f2bf(sr); img[s * 136 + 64 + lane] = f2bf(si); }
        asm volatile("s_waitcnt lgkmcnt(0)" ::: "memory"); __builtin_amdgcn_wave_barrier();
#pragma unroll
        for (int mt = 0; mt < 2; ++mt) { f32x4 acc = {0.f, 0.f, 0.f, 0.f};
#pragma unroll
            for (int ks = 0; ks < 4; ++ks) { const bf16x8 a = *(const LAS bf16x8*)(img + (mt * 16 + (lane & 15)) * 136 + ks * 32 + (lane >> 4) * 8); acc = MFMA16(a, bfr[ks], acc); }
#pragma unroll
            for (int r = 0; r < 4; ++r) { const int tt = half * 32 + mt * 16 + (lane >> 4) * 4 + r; const float uv = ul[tt * 16 + (lane & 15)];
                YS[(size_t)(c * 64 + tt) * 512 + g * 16 + (lane & 15)] = f2bf(gelu_tanh(acc[r] + dco * uv)); } }
        asm volatile("s_waitcnt lgkmcnt(0)" ::: "memory"); __builtin_amdgcn_wave_barrier();
    }
}

__device__ __forceinline__ void phase_scan(const Params& p, int L, LAS unsigned char* lds) {
    const int b = BIDX();
    if (b < 224) { for (int rr = 0; rr < PROBE_RW; ++rr) rwkv_scan(p, b, lds); }
    else { for (int rr = 0; rr < PROBE_ML; ++rr) mlstm_seq(p, b - 224, lds); }
}
__device__ __forceinline__ void phase_s5c(const Params& p, int L, LAS unsigned char* lds) {
    const int b = BIDX(), wid = TIDX() >> 6, lane = TIDX() & 63;
    if (b == GDIM() - 1) mlstm_nscan(p);
    const int nw = GDIM() * 8;
    for (int w = b * 8 + wid; w < 32 * NCH; w += nw) s5_pass_c(p, L, w >> 7, w & 127, lane, (LAS bh*)lds + wid * (32 * 136), (LAS float*)(lds + 69632) + wid * 1024);
    __syncthreads();
}

__device__ __forceinline__ void mlstm_out(const Params& p, int L, int h, int c, LAS unsigned char* lds) {
    const int tid = TIDX(), wid = tid >> 6, lane = tid & 63, t0 = c * 64;
    LAS bh* Pl = (LAS bh*)lds;
    LAS float* s_b = (LAS float*)(lds + 9216); LAS float* s_a = s_b + 64; LAS float* s_mt = s_a + 64; LAS float* s_iw = s_mt + 64; LAS float* s_den = s_iw + 64; LAS float* s_qn = s_den + 64; LAS float* s_part = s_qn + 64;
    const bh* MQ = (const bh*)(P_WS + OFF_MQ); const bh* MK = (const bh*)(P_WS + OFF_MK); const bh* MVT = (const bh*)(P_WS + OFF_MVT);
    const float* MINTER = (const float*)(P_WS + OFF_ABF);
    const float m0 = ((const float*)(P_WS + OFF_MSTART))[h * NCH + c];
    if (tid < 64) { const float ig = ((const float*)(P_WS + OFF_MI))[h * T + t0 + tid], b = ((const float*)(P_WS + OFF_MBB))[h * T + t0 + tid];
        const float a = ig - b; float cm = a;
#pragma unroll
        for (int o = 1; o < 64; o <<= 1) { const float nb = bperm_f((tid - o) & 63, cm); if (tid >= o) cm = fmaxf(cm, nb); }
        const float mt = b + fmaxf(m0, cm);
        s_b[tid] = b; s_a[tid] = a; s_mt[tid] = mt; s_iw[tid] = __expf(b + m0 - mt); }
    __syncthreads();
    {
        const int mt = wid >> 1, nt0 = (wid & 1) * 2;
        f32x4 r0 = {0.f, 0.f, 0.f, 0.f}, r1 = {0.f, 0.f, 0.f, 0.f};
        const bh* qp = MQ + (size_t)(t0 + mt * 16 + (lane & 15)) * 1024 + h * 256 + (lane >> 4) * 8;
        const bh* kp = MK + (size_t)(t0 + nt0 * 16 + (lane & 15)) * 1024 + h * 256 + (lane >> 4) * 8;
#pragma unroll
        for (int ks = 0; ks < 8; ++ks) { const bf16x8 a = *(const bf16x8*)(qp + ks * 32); const bf16x8 b0 = *(const bf16x8*)(kp + ks * 32), b1 = *(const bf16x8*)(kp + (size_t)16 * 1024 + ks * 32);
            r0 = MFMA16(a, b0, r0); r1 = MFMA16(a, b1, r1); }
#pragma unroll
        for (int r = 0; r < 4; ++r) { const int t = mt * 16 + (lane >> 4) * 4 + r; const float bt = s_b[t] - s_mt[t];
            { const int s = nt0 * 16 + (lane & 15); const float pv = (s <= t) ? r0[r] * __expf(bt + s_a[s]) : 0.f; Pl[t * 72 + s] = f2bf(pv); }
            { const int s = nt0 * 16 + 16 + (lane & 15); const float pv = (s <= t) ? r1[r] * __expf(bt + s_a[s]) : 0.f; Pl[t * 72 + s] = f2bf(pv); } }
    }
    __syncthreads();
    if (tid < 64) { float s = 0.f;
#pragma unroll
        for (int q = 0; q < 8; ++q) { const u32x4 w = *(const LAS u32x4*)(Pl + tid * 72 + q * 8);
            s += __uint_as_float(w.x << 16) + __uint_as_float(w.x & 0xffff0000u) + __uint_as_float(w.y << 16) + __uint_as_float(w.y & 0xffff0000u)
               + __uint_as_float(w.z << 16) + __uint_as_float(w.z & 0xffff0000u) + __uint_as_float(w.w << 16) + __uint_as_float(w.w & 0xffff0000u); }
        s_den[tid] = s; }
    {
        const float* nst = (const float*)(P_WS + OFF_NST) + (size_t)(h * NCH + c) * 256 + lane * 4; const f32x4 nv = *(const f32x4*)nst;
#pragma unroll
        for (int i = 0; i < 8; ++i) { const int t = wid * 8 + i; const u32x2 q2 = *(const u32x2*)(MQ + (size_t)(t0 + t) * 1024 + h * 256 + lane * 4);
            float s = __uint_as_float(q2.x << 16) * nv[0] + __uint_as_float(q2.x & 0xffff0000u) * nv[1] + __uint_as_float(q2.y << 16) * nv[2] + __uint_as_float(q2.y & 0xffff0000u) * nv[3];
            s = wave_sum(s); if (lane == 0) s_qn[t] = s; } }
    f32x4 acc[4][2];
#pragma unroll
    for (int a = 0; a < 4; ++a) { const float z = OZ(); acc[a][0] = (f32x4){z, z, z, z}; acc[a][1] = (f32x4){z, z, z, z}; }
    {   const bh* vp = MVT + ((size_t)(h * NCH + c) * 256 + wid * 32 + (lane & 15)) * 64 + (lane >> 4) * 8;
#pragma unroll
        for (int ks = 0; ks < 2; ++ks) { const bf16x8 b0 = *(const bf16x8*)(vp + ks * 32), b1 = *(const bf16x8*)(vp + 16 * 64 + ks * 32);
#pragma unroll
            for (int a = 0; a < 4; ++a) { const bf16x8 av = *(const LAS bf16x8*)(Pl + (a * 16 + (lane & 15)) * 72 + ks * 32 + (lane >> 4) * 8);
                acc[a][0] = MFMA16(av, b0, acc[a][0]); acc[a][1] = MFMA16(av, b1, acc[a][1]); } } }
    __syncthreads();
#pragma unroll
    for (int a = 0; a < 4; ++a)
#pragma unroll
        for (int r = 0; r < 4; ++r) { const int t = a * 16 + (lane >> 4) * 4 + r; const float iw = s_iw[t];
            const float den = s_den[t] + iw * s_qn[t]; const float dd = 1.0f / fmaxf(fabsf(den), __expf(-s_mt[t]));
            const float* mi = MINTER + (size_t)(t0 + t) * 1024 + h * 256 + wid * 32 + (lane & 15);
            const float h0 = (acc[a][0][r] + iw * mi[0]) * dd, h1 = (acc[a][1][r] + iw * mi[16]) * dd;
            acc[a][0][r] = h0; acc[a][1][r] = h1;
            float ss = h0 * h0 + h1 * h1;
            ss = allreduce16(ss);
            if ((lane & 15) == 0) s_part[wid * 64 + t] = ss; }
    __syncthreads();
    {   const float* zf = (const float*)(P_WS + OFF_ZF); const float* ng = P_IN(7) + L * 1024 + h * 256; bh* YC = (bh*)(P_WS + OFF_YCAT);
#pragma unroll
        for (int a = 0; a < 4; ++a)
#pragma unroll
            for (int r = 0; r < 4; ++r) { const int t = a * 16 + (lane >> 4) * 4 + r;
                float tot = 0.f;
#pragma unroll
                for (int w = 0; w < 8; ++w) tot += s_part[w * 64 + t];
                const float rstd = rsqrtf(tot * (1.0f / 256.0f) + 1e-6f);
                const int v0 = wid * 32 + (lane & 15);
                const float* op = zf + (size_t)(t0 + t) * ZF_LD + 3072 + h * 256 + v0;
                bh* yo = YC + (size_t)(t0 + t) * D + h * 256 + v0;
                yo[0] = f2bf(sigmoidf_(op[0]) * acc[a][0][r] * rstd * ng[v0]);
                yo[16] = f2bf(sigmoidf_(op[16]) * acc[a][1][r] * rstd * ng[v0 + 16]); } }
    __syncthreads();
}

__device__ __forceinline__ void rwkv_post(const Params& p, int L, int it, LAS unsigned char* lds) {
    const int tid = TIDX(), wid = tid >> 6, lane = tid & 63;
    const int h = it & 7, blk = it >> 3, j = blk >> 3;
    LAS float* bufA = (LAS float*)lds;
    LAS float* bufB = bufA + 64 * 65;
    LAS float* bufP = bufB + 64 * 65;
    const float* SE = (const float*)(P_WS + OFF_RSEND) + (size_t)(h * 4) * 4096; const float* PE = (const float*)(P_WS + OFF_RPEND) + (size_t)(h * 4) * 4096;
    LAS float* sst = bufA;
    if (j >= 1) {
        const int v = tid >> 3, k8 = (tid & 7) * 8;
        { const f32x4 a0 = *(const f32x4*)(SE + v * 64 + k8), a1 = *(const f32x4*)(SE + v * 64 + k8 + 4);
#pragma unroll
          for (int e = 0; e < 4; ++e) { bufA[v * 65 + k8 + e] = a0[e]; bufA[v * 65 + k8 + 4 + e] = a1[e]; } }
        for (int jj = 1; jj < j; ++jj) {
            { const f32x4 p0 = *(const f32x4*)(PE + (size_t)jj * 4096 + v * 64 + k8), p1 = *(const f32x4*)(PE + (size_t)jj * 4096 + v * 64 + k8 + 4);
              *(LAS f32x4*)(bufP + v * 64 + k8) = p0; *(LAS f32x4*)(bufP + v * 64 + k8 + 4) = p1; }
            __syncthreads();
            LAS float* src = (jj & 1) ? bufA : bufB; LAS float* dst = (jj & 1) ? bufB : bufA;
            f32x4 c0 = *(const f32x4*)(SE + (size_t)jj * 4096 + v * 64 + k8), c1 = *(const f32x4*)(SE + (size_t)jj * 4096 + v * 64 + k8 + 4);
#pragma unroll 8
            for (int i = 0; i < 64; ++i) { const float a = src[v * 65 + i]; const f32x4 p0 = *(const LAS f32x4*)(bufP + i * 64 + k8), p1 = *(const LAS f32x4*)(bufP + i * 64 + k8 + 4); c0 += a * p0; c1 += a * p1; }
#pragma unroll
            for (int e = 0; e < 4; ++e) { dst[v * 65 + k8 + e] = c0[e]; dst[v * 65 + k8 + 4 + e] = c1[e]; }
            __syncthreads();
            sst = dst;
        }
        __syncthreads();
    }
    float srow[64];
    if (j >= 1) {
#pragma unroll
        for (int i = 0; i < 64; ++i) srow[i] = sst[lane * 65 + i];
    } else {
#pragma unroll
        for (int i = 0; i < 64; ++i) srow[i] = 0.f;
    }
    const int c = h * 64 + lane;
    const float rkw = P_IN(16)[L * 512 + c], lg = P_IN(17)[L * 512 + c], lb = P_IN(18)[L * 512 + c];
    const float* RY = (const float*)(P_WS + OFF_RY); const float* RZ = (const float*)(P_WS + OFF_RZ); const float* RR = (const float*)(P_WS + OFF_RR); const float* RK = (const float*)(P_WS + OFF_RK);
    const float* RV = (const float*)(P_WS + OFF_RV); const float* RG = (const float*)(P_WS + OFF_RG); bh* YC = (bh*)(P_WS + OFF_YCAT);
    for (int i = 0; i < 32; ++i) { const int t = blk * 256 + wid * 32 + i; const size_t o = (size_t)t * 512 + c;
        float y = RY[o];
        if (j >= 1) { const float z = RZ[o]; float y2 = 0.f;
#pragma unroll
            for (int q = 0; q < 64; q += 2) { y = fmaf(srow[q], __builtin_bit_cast(float, __builtin_amdgcn_readlane(__builtin_bit_cast(int, z), q)), y);
                                              y2 = fmaf(srow[q + 1], __builtin_bit_cast(float, __builtin_amdgcn_readlane(__builtin_bit_cast(int, z), q + 1)), y2); }
            y += y2; }
        const float mu = wave_sum(y) * (1.0f / 64.0f); const float dlt = y - mu; const float var = wave_sum(dlt * dlt) * (1.0f / 64.0f);
        const float yn = dlt * rsqrtf(var + 64e-5f) * lg + lb;
        const float bon = wave_sum(RR[o] * RK[o] * rkw) * RV[o];
        YC[(size_t)t * D + 1024 + c] = f2bf((yn + bon) * RG[o]); }
    __syncthreads();
}

__device__ __forceinline__ void phase_post(const Params& p, int L, LAS unsigned char* lds) {
    for (int it = BIDX(); it < 768; it += GDIM()) {
        if (it < 512) mlstm_out(p, L, it >> 7, it & 127, lds);
        else rwkv_post(p, L, it - 512, lds);
    }
    __syncthreads();
}

constexpr int NPHASE = 27;
__global__ void __launch_bounds__(512, 2) hybrid_fwd(Params p, int ph_lo, int ph_hi, int rep_q) {
    extern __shared__ __attribute__((aligned(16))) unsigned char smem_raw[];
    LAS unsigned char* lds = (LAS unsigned char*)smem_raw;
    cg::grid_group grid = cg::this_grid();
    for (int ph = ph_lo; ph < ph_hi; ++ph) {
        if (ph > ph_lo) grid.sync();
        if (ph == 26) {
            const int gw = BIDX() * 8 + (TIDX() >> 6), NGW = GDIM() * 8, lane = TIDX() & 63;
            for (int r = gw; r < T; r += NGW) { float* x = P_OUT + (size_t)r * D; f32x4 v[8]; float s = 0.f;
#pragma unroll
                for (int j = 0; j < 8; ++j) { v[j] = *(const f32x4*)(x + j * 256 + lane * 4); s += (v[j][0] * v[j][0] + v[j][1] * v[j][1]) + (v[j][2] * v[j][2] + v[j][3] * v[j][3]); }
                const float rstd = rsqrtf(wave_sum(s) * (1.0f / D) + 1e-6f);
#pragma unroll
                for (int j = 0; j < 8; ++j) { const f32x4 gg = *(const f32x4*)(P_IN(40) + j * 256 + lane * 4); *(f32x4*)(x + j * 256 + lane * 4) = v[j] * rstd * gg; } }
            continue;
        }
        const int L = ph / 13, q = ph % 13;
#ifdef ONLY_Q
        if (q != ONLY_Q) continue;
#endif
        const int nrep = (q == rep_q) ? 2 : 1;
        for (int rep = 0; rep < nrep; ++rep) {
        if (rep) grid.sync();
        switch (q) {
        case 0: phase_conv(p, L, lds); break;
        case 2: phase_prep(p, L, lds); break;
        case 4: phase_scan(p, L, lds); break;
        case 5: phase_post(p, L, lds); break;
        case 8: phase_rmsnorm(p, P_IN(33) + (size_t)L * D); break;
        case 11: phase_rmsnorm(p, P_IN(37) + (size_t)L * D); break;
        default: break;
        }
        for (int i = 0; i < 3; ++i) {
            pg8::Gemm g;
            if (!make_gemm(p, L, q, i, g)) break;
            pg8::StaticOrder S; S.init(T, g.N, GDIM(), BIDX());
            pg8::gemm_phase(lds, g, S);
        }
        if (q == 3) phase_s5c(p, L, lds);
        }
    }
}

extern "C" void kernel_launch(void* const* d_in, const int* in_sizes, int n_in, void* d_out, int out_size, void* d_ws, size_t ws_size, hipStream_t stream) {
    constexpr size_t kDynLds = 131072;
    static int grid_blocks = 0;
    if (!grid_blocks) {
        int dev = 0, cus = 0, per_cu = 0;
        (void)hipGetDevice(&dev);
        (void)hipDeviceGetAttribute(&cus, hipDeviceAttributeMultiprocessorCount, dev);
        (void)hipFuncSetAttribute((const void*)hybrid_fwd, hipFuncAttributeMaxDynamicSharedMemorySize, (int)kDynLds);
        (void)hipOccupancyMaxActiveBlocksPerMultiprocessor(&per_cu, hybrid_fwd, 512, kDynLds);
        if (per_cu > 1) per_cu = 1;
        grid_blocks = cus * per_cu;
        if (ws_size < WS_TOTAL) fprintf(stderr, "workspace too small: %zu < %zu\n", ws_size, (size_t)WS_TOTAL);
    }
    Params p{};
    for (int i = 0; i < 41; ++i) p.in[i] = (const float*)d_in[i];
    p.out = (float*)d_out; p.ws = (unsigned char*)d_ws;
#if SINGLE_LAUNCH
    int lo = 0, hi = NPHASE, rq = PROBE_REP_Q;
    void* args[] = {&p, &lo, &hi, &rq};
    hipError_t e = hipLaunchCooperativeKernel((const void*)hybrid_fwd, dim3(grid_blocks), dim3(512), args, kDynLds, stream);
    if (e != hipSuccess) fprintf(stderr, "cooperative launch failed: %s (grid %d)\n", hipGetErrorString(e), grid_blocks);
#else
    for (int ph = 0; ph < NPHASE; ++ph) {
        int lo = ph, hi = ph + 1, rq = -1;
        void* args[] = {&p, &lo, &hi, &rq};
        hipError_t e = hipLaunchCooperativeKernel((const void*)hybrid_fwd, dim3(grid_blocks), dim3(512), args, kDynLds, stream);
        if (e != hipSuccess) fprintf(stderr, "cooperative launch failed: %s (grid %d)\n", hipGetErrorString(e), grid_blocks);
    }
#endif
}
```

```cpp
#include <hip/hip_runtime.h>
#include <hip/hip_cooperative_groups.h>
#include <cstdio>
#include <cstdint>
namespace cg = cooperative_groups;

#define LAS __attribute__((address_space(3)))
typedef unsigned short bh;
typedef short bf16x8 __attribute__((ext_vector_type(8)));
typedef float f32x4 __attribute__((ext_vector_type(4)));
typedef float f32x16 __attribute__((ext_vector_type(16)));
typedef unsigned u32x4 __attribute__((ext_vector_type(4)));
typedef unsigned u32x2 __attribute__((ext_vector_type(2)));

#ifndef PROBE_RW
#define PROBE_RW 1
#define PROBE_ML 1
#endif
#ifndef PROBE_REP_Q
#define PROBE_REP_Q (-1)
#endif
#ifndef SINGLE_LAUNCH
#define SINGLE_LAUNCH 1
#endif

constexpr int T = 8192, D = 2048, FH = 5632;
constexpr int NIN = 12744, NGATE = 6144, NF = 6600, ZF_LD = 6656, NINP = 12800;
constexpr int ZR0 = 4104, ZS0 = 6088;
constexpr int NCH = 128;

constexpr size_t AL(size_t x) { return (x + 255) & ~(size_t)255; }
constexpr size_t SZ_WIN = (size_t)NINP * D * 2, SZ_SQ = (size_t)D * D * 2, SZ_WGU = (size_t)2 * FH * D * 2, SZ_WD = (size_t)D * FH * 2;
constexpr size_t OFF_WIN = 0;
constexpr size_t OFF_WUP = OFF_WIN + SZ_WIN;
constexpr size_t OFF_WO = OFF_WUP + SZ_SQ;
constexpr size_t OFF_WGU = OFF_WO + SZ_SQ;
constexpr size_t OFF_WD = OFF_WGU + SZ_WGU;
constexpr size_t OFF_WPG = OFF_WD + SZ_WD;
constexpr size_t OFF_WPP = OFF_WPG + SZ_SQ;
constexpr size_t OFF_WGLU = OFF_WPP + (size_t)D * 256 * 2;
constexpr size_t OFF_WW2 = OFF_WGLU + (size_t)512 * 512 * 2;
constexpr size_t OFF_WA2 = OFF_WW2 + (size_t)512 * 256 * 2;
constexpr size_t OFF_WG2 = OFF_WA2 + (size_t)512 * 256 * 2;
constexpr size_t OFF_PBF = OFF_WG2 + (size_t)512 * 256 * 2;
constexpr size_t OFF_ABF = OFF_PBF + (size_t)2 * T * 256 * 2;
constexpr size_t OFF_YCAT = OFF_ABF + (size_t)T * D * 2;
constexpr size_t OFF_ZF = OFF_YCAT + (size_t)T * D * 2;
constexpr size_t OFF_ACT = OFF_ZF;
constexpr size_t OFF_MIX32 = OFF_ZF + (size_t)100663296;
constexpr size_t OFF_ZG = OFF_ZF + (size_t)T * ZF_LD * 4;
constexpr size_t SZ_R = (size_t)T * 512 * 4;
constexpr size_t OFF_RR = OFF_ZG + (size_t)T * NGATE * 2;
constexpr size_t OFF_RK = OFF_RR + SZ_R, OFF_RV = OFF_RK + SZ_R, OFF_RKK = OFF_RV + SZ_R, OFF_RW = OFF_RKK + SZ_R, OFF_RB = OFF_RW + SZ_R, OFF_RG = OFF_RB + SZ_R, OFF_RY = OFF_RG + SZ_R;
constexpr size_t OFF_LAW = OFF_RY + SZ_R;
constexpr size_t OFF_LAA = OFF_LAW + (size_t)T * 256 * 2, OFF_LAG = OFF_LAA + (size_t)T * 256 * 2;
constexpr size_t SZ_MB = (size_t)T * 1024 * 2;
constexpr size_t OFF_MQ = OFF_LAG + (size_t)T * 256 * 2, OFF_MK = OFF_MQ + SZ_MB, OFF_MKT = OFF_MK + SZ_MB, OFF_MVT = OFF_MKT + SZ_MB;
constexpr size_t OFF_MI = OFF_MVT + SZ_MB;
constexpr size_t OFF_MBB = OFF_MI + (size_t)4 * T * 4;
constexpr size_t OFF_MBEND = OFF_MBB + (size_t)4 * T * 4;
constexpr size_t OFF_MLOC = OFF_MBEND + 2048, OFF_MSTART = OFF_MLOC + 2048;
constexpr size_t OFF_DN = OFF_MSTART + 2048;
constexpr size_t OFF_NST = OFF_DN + (size_t)4 * NCH * 256 * 4;
constexpr size_t OFF_SEND = OFF_NST + (size_t)4 * NCH * 256 * 4;
constexpr size_t OFF_YS = OFF_SEND + (size_t)32 * NCH * 64 * 8;
constexpr size_t OFF_RZ = OFF_YS + (size_t)T * 512 * 2;
constexpr size_t OFF_RSEND = OFF_RZ + SZ_R;
constexpr size_t OFF_RPEND = OFF_RSEND + (size_t)8 * 4 * 4096 * 4;
constexpr size_t OFF_MINTER2 = OFF_RPEND + (size_t)8 * 4 * 4096 * 4;
constexpr size_t WS_TOTAL = OFF_MINTER2 + (size_t)T * 1024 * 4;

struct Params { const float* in[41]; float* out; unsigned char* ws; };
#define KARG4 __attribute__((address_space(4)))
__device__ __forceinline__ const float* karg_in(int i) { const KARG4 char* ka = (const KARG4 char*)__builtin_amdgcn_kernarg_segment_ptr(); return *(const float* const volatile KARG4*)(ka + (size_t)i * 8); }
#define P_IN(i) karg_in(i)
#define P_OUT ((float*)karg_in(41))
#define P_WS ((unsigned char*)karg_in(42))

__device__ __forceinline__ int TIDX() { int t = threadIdx.x; asm volatile("" : "+v"(t)); return t; }
__device__ __forceinline__ int BIDX() { int t = blockIdx.x; asm volatile("" : "+s"(t)); return t; }
__device__ __forceinline__ int GDIM() { int t = gridDim.x; asm volatile("" : "+s"(t)); return t; }
__device__ __forceinline__ bh f2bf(float f) { unsigned u = __float_as_uint(f); u += 0x7fffu + ((u >> 16) & 1u); return (bh)(u >> 16); }
__device__ __forceinline__ float bf2f(bh h) { return __uint_as_float(((unsigned)h) << 16); }
__device__ __forceinline__ unsigned pk2(float lo, float hi) { return (unsigned)f2bf(lo) | ((unsigned)f2bf(hi) << 16); }
__device__ __forceinline__ float sigmoidf_(float x) { return 1.0f / (1.0f + __expf(-x)); }
__device__ __forceinline__ float bperm_f(int srclane, float v) { return __builtin_bit_cast(float, __builtin_amdgcn_ds_bpermute(srclane << 2, __builtin_bit_cast(int, v))); }
__device__ __forceinline__ float wave_sum(float v) {
    const int lane = TIDX() & 63;
#pragma unroll
    for (int o = 32; o >= 1; o >>= 1) v += bperm_f(lane ^ o, v);
    return v;
}
__device__ __forceinline__ float wave_max(float v) {
    const int lane = TIDX() & 63;
#pragma unroll
    for (int o = 32; o >= 1; o >>= 1) v = fmaxf(v, bperm_f(lane ^ o, v));
    return v;
}
template <int CTRL> __device__ __forceinline__ float dpp_f(float x) {
    return __builtin_bit_cast(float, __builtin_amdgcn_update_dpp(0, __builtin_bit_cast(int, x), CTRL, 0xf, 0xf, true));
}
__device__ __forceinline__ float allreduce16(float x) {
    x += dpp_f<0xB1>(x); x += dpp_f<0x4E>(x); x += dpp_f<0x141>(x); x += dpp_f<0x140>(x);
    return x;
}
__device__ __forceinline__ float OZ() { float z = 0.f; asm volatile("" : "+v"(z)); return z; }
#define MFMA16(a, b, c) __builtin_amdgcn_mfma_f32_16x16x32_bf16(a, b, c, 0, 0, 0)
#define MFMA32(a, b, c) __builtin_amdgcn_mfma_f32_32x32x16_bf16(a, b, c, 0, 0, 0)

namespace pg8 {
constexpr int BM = 256, BK = 64, HALF = 128, HTB = HALF * BK * 2, STAGE_BYTES = 8 * HTB, NXCD = 8, WGM = 8;
__device__ __forceinline__ int lds_byte(int r, int c) { const int st = (r >> 4) * 2 + (c >> 5), rr = r & 15, cc = c & 31, ob = rr * 64 + cc * 2; return st * 1024 + (ob ^ (((ob >> 9) & 1) << 5)); }
__device__ __forceinline__ void stage_rc(int b, int& R, int& C) { const int st = b / 1024, sb = b % 1024, swz = sb ^ (((sb >> 9) & 1) << 5); R = (st >> 1) * 16 + swz / 64; C = (st & 1) * 32 + (swz % 64) / 2; }
__device__ __forceinline__ int perm32(int rho) { const int n = rho >> 4, i = rho & 15; return 8 * (i >> 2) + 4 * n + (i & 3); }
struct Unit { int pm, pn; };
struct Gemm { const bh* A; const bh* Bt; int M, N, K, lda, ldb, epi, perm, L; };
struct StaticOrder {
    int nM, nN, nwg, G, c;
    __device__ void init(int M, int N, int G_, int c_) { nM = M / BM; nN = N / BM; nwg = nM * nN; G = G_; c = c_; }
    __device__ bool next(int i, Unit& u) const {
        const long L = (long)i * G + c; if (L >= nwg) return false;
        int wgid = (int)L; { const int q = nwg / NXCD, r = nwg % NXCD, xcd = wgid % NXCD, off = wgid / NXCD; wgid = (xcd < r ? xcd * (q + 1) : r * (q + 1) + (xcd - r) * q) + off; }
        const int nig = WGM * nN, gid = wgid / nig, fm = gid * WGM, gsz = (nM - fm) < WGM ? (nM - fm) : WGM;
        u.pm = fm + ((wgid % nig) % gsz); u.pn = (wgid % nig) / gsz; return true;
    }
};
__device__ __forceinline__ unsigned cvt_pk_bf16(float lo, float hi) { unsigned r; asm volatile("v_cvt_pk_bf16_f32 %0, %1, %2" : "=v"(r) : "v"(lo), "v"(hi)); return r; }

__device__ __forceinline__ void epi_run(const Gemm& g, const f32x4 (&acc)[2][2][4][2], const Unit& u, int wr, int wc, int fr, int fq);
__device__ __forceinline__ void up_rescale(f32x4 (&acc)[2][2][4][2], const Unit& u, int wr, int wc, int fr, int fq, int goff) {
    const bh* zg = (const bh*)(P_WS + OFF_ZG) + goff;
    asm volatile("" : "+v"(fr), "+v"(fq));
    const bh* zrow0 = zg + (size_t)(u.pm * 256 + wr * 64 + fr) * NGATE + u.pn * 256 + wc * 32 + 4 * fq;
#pragma unroll
    for (int ai = 0; ai < 2; ++ai)
#pragma unroll
        for (int m = 0; m < 4; ++m) { const bh* zr = zrow0 + (size_t)(ai * 128 + m * 16) * NGATE;
#pragma unroll
            for (int bj = 0; bj < 2; ++bj)
#pragma unroll
                for (int n = 0; n < 2; ++n) {
                    const u32x2 gp = *(const u32x2*)(zr + bj * 128 + n * 16), gn = *(const u32x2*)(zr + 2048 + bj * 128 + n * 16);
                    f32x4 r;
                    r[0] = __uint_as_float(gp.x << 16) * __builtin_amdgcn_rcpf(__uint_as_float(gn.x << 16)); r[1] = __uint_as_float(gp.x & 0xffff0000u) * __builtin_amdgcn_rcpf(__uint_as_float(gn.x & 0xffff0000u));
                    r[2] = __uint_as_float(gp.y << 16) * __builtin_amdgcn_rcpf(__uint_as_float(gn.y << 16)); r[3] = __uint_as_float(gp.y & 0xffff0000u) * __builtin_amdgcn_rcpf(__uint_as_float(gn.y & 0xffff0000u));
                    acc[ai][bj][m][n] *= r; }
            __builtin_amdgcn_sched_barrier(0); }
}
__device__ __forceinline__ void gemm_phase(LAS unsigned char* lds, const Gemm& g, const StaticOrder& S) {
    const int tid = TIDX(), wid = __builtin_amdgcn_readfirstlane(tid >> 6), lane = tid & 63, wr = wid >> 2, wc = wid & 3, fr = lane & 15, fq = lane >> 4;
    const int K = g.K, nt = K / BK;
    unsigned voffA[2], voffB[2];
#pragma unroll
    for (int i = 0; i < 2; ++i) { int R, C; stage_rc(tid * 16 + i * 8192, R, C); const int Rb = g.perm ? ((R & ~31) + perm32(R & 31)) : R;
        voffA[i] = (unsigned)(R * g.lda + C) * 2u; voffB[i] = (unsigned)(Rb * g.ldb + C) * 2u; }
    const size_t kstep = (size_t)(BK * 2);
    const size_t hstepA = (size_t)HALF * g.lda * 2, hstepB = (size_t)HALF * g.ldb * 2;
    const size_t tstepA = 2 * hstepA, tstepB = 2 * hstepB;
    const unsigned ldsw = (unsigned)wid * 1024u;
    const int aoff = lds_byte(wr * 64 + fr, fq * 8), boff = lds_byte(wc * 32 + fr, fq * 8);
#define PG8_SA(b, h) (((b) * 2 + (h)) * HTB)
#define PG8_SB(b, h) ((4 + (b) * 2 + (h)) * HTB)
#define PG8_STAGE(bufoff, gbase, voff) do { _Pragma("unroll") for (int _i = 0; _i < 2; ++_i) \
        __builtin_amdgcn_global_load_lds((const unsigned*)((const char*)(gbase) + (voff)[_i]), (LAS unsigned*)(lds + (bufoff) + ldsw + _i * 8192), 16, 0, 0); } while (0)
#define PG8_LDA(dst, b, h) do { _Pragma("unroll") for (int m = 0; m < 4; ++m) _Pragma("unroll") for (int k = 0; k < 2; ++k) dst[m][k] = *(const LAS bf16x8*)(lds + PG8_SA(b, h) + aoff + m * 2048 + k * 1024); } while (0)
#define PG8_LDB(dst, b, h) do { _Pragma("unroll") for (int n = 0; n < 2; ++n) _Pragma("unroll") for (int k = 0; k < 2; ++k) dst[n][k] = *(const LAS bf16x8*)(lds + PG8_SB(b, h) + boff + n * 2048 + k * 1024); } while (0)
#define PG8_MMA(ai, bj, At, Bt) do { __builtin_amdgcn_s_setprio(1); _Pragma("unroll") for (int m = 0; m < 4; ++m) _Pragma("unroll") for (int n = 0; n < 2; ++n) _Pragma("unroll") for (int k = 0; k < 2; ++k) \
        acc[ai][bj][m][n] = __builtin_amdgcn_mfma_f32_16x16x32_bf16(Bt[n][k], At[m][k], acc[ai][bj][m][n], 0, 0, 0); __builtin_amdgcn_s_setprio(0); } while (0)
#define PG8_WAIT_V(n) asm volatile("s_waitcnt vmcnt(" #n ")" ::: "memory")
#define PG8_WAIT_L(n) asm volatile("s_waitcnt lgkmcnt(" #n ")" ::: "memory")
#define PG8_BAR __builtin_amdgcn_s_barrier()
#define PG8_SCHED __builtin_amdgcn_sched_barrier(0)
    Unit cur, nxt; int ui = 0;
    if (!S.next(0, cur)) return;
    f32x4 acc[2][2][4][2];
    { const float z = OZ();
#pragma unroll
    for (int a = 0; a < 2; ++a)
#pragma unroll
        for (int b = 0; b < 2; ++b)
#pragma unroll
            for (int m = 0; m < 4; ++m)
#pragma unroll
                for (int n = 0; n < 2; ++n) acc[a][b][m][n] = (f32x4){z, z, z, z}; }
    bf16x8 At[4][2], B0[2][2], B1[2][2];
    const char* cA = (const char*)g.A + (size_t)cur.pm * tstepA; const char* cB = (const char*)g.Bt + (size_t)cur.pn * tstepB;
    PG8_STAGE(PG8_SB(0, 0), cB, voffB); PG8_STAGE(PG8_SA(0, 0), cA, voffA); PG8_STAGE(PG8_SB(0, 1), cB + hstepB, voffB); PG8_STAGE(PG8_SA(0, 1), cA + hstepA, voffA);
    if (wr == 1) PG8_BAR;
    PG8_WAIT_V(4); PG8_BAR;
    PG8_STAGE(PG8_SB(1, 0), cB + kstep, voffB); PG8_STAGE(PG8_SA(1, 0), cA + kstep, voffA); PG8_STAGE(PG8_SB(1, 1), cB + hstepB + kstep, voffB);
    PG8_WAIT_V(6); PG8_BAR;
    for (;;) {
        const bool has_next = S.next(ui + 1, nxt);
        const char* nA = has_next ? (const char*)g.A + (size_t)nxt.pm * tstepA : cA; const char* nB = has_next ? (const char*)g.Bt + (size_t)nxt.pn * tstepB : cB;
        for (int t = 0; t < nt; t += 2) {
            if (g.epi == 11 && (t == 16 || t == 24)) up_rescale(acc, cur, wr, wc, fr, fq, t == 16 ? 0 : 2048);
            const bool last = (t == nt - 2);
            const char* a1 = cA + (size_t)(t + 1) * kstep;
            const char* a2 = last ? nA : cA + (size_t)(t + 2) * kstep; const char* b2 = last ? nB : cB + (size_t)(t + 2) * kstep;
            const char* a3 = a2 + kstep; const char* b3 = b2 + kstep;
            PG8_LDB(B0, 0, 0); PG8_SCHED; PG8_LDA(At, 0, 0); PG8_STAGE(PG8_SA(1, 1), a1 + hstepA, voffA);
            PG8_WAIT_L(8); PG8_BAR; PG8_WAIT_L(0); PG8_MMA(0, 0, At, B0); PG8_BAR; PG8_SCHED;
            PG8_LDB(B1, 0, 1); PG8_STAGE(PG8_SB(0, 0), b2, voffB);
            PG8_BAR; PG8_WAIT_L(0); PG8_MMA(0, 1, At, B1); PG8_BAR;
            PG8_LDA(At, 0, 1); PG8_STAGE(PG8_SA(0, 0), a2, voffA);
            PG8_BAR; PG8_WAIT_L(0); PG8_MMA(1, 0, At, B0); PG8_BAR; PG8_SCHED;
            PG8_STAGE(PG8_SB(0, 1), b2 + hstepB, voffB);
            PG8_WAIT_V(6); PG8_BAR; PG8_MMA(1, 1, At, B1); PG8_BAR;
            PG8_LDB(B0, 1, 0); PG8_SCHED; PG8_LDA(At, 1, 0); PG8_STAGE(PG8_SA(0, 1), a2 + hstepA, voffA);
            PG8_WAIT_L(8); PG8_BAR; PG8_WAIT_L(0); PG8_MMA(0, 0, At, B0); PG8_BAR; PG8_SCHED;
            PG8_LDB(B1, 1, 1); PG8_STAGE(PG8_SB(1, 0), b3, voffB);
            PG8_BAR; PG8_WAIT_L(0); PG8_MMA(0, 1, At, B1); PG8_BAR;
            PG8_LDA(At, 1, 1); PG8_STAGE(PG8_SA(1, 0), a3, voffA);
            PG8_BAR; PG8_WAIT_L(0); PG8_MMA(1, 0, At, B0); PG8_BAR; PG8_SCHED;
            PG8_STAGE(PG8_SB(1, 1), b3 + hstepB, voffB);
            PG8_WAIT_V(6); PG8_BAR; PG8_MMA(1, 1, At, B1); PG8_BAR;
        }
        epi_run(g, acc, cur, wr, wc, fr, fq);
        if (!has_next) break;
        { const float z = OZ();
#pragma unroll
        for (int a = 0; a < 2; ++a)
#pragma unroll
            for (int b = 0; b < 2; ++b)
#pragma unroll
                for (int m = 0; m < 4; ++m)
#pragma unroll
                    for (int n = 0; n < 2; ++n) acc[a][b][m][n] = (f32x4){z, z, z, z}; }
        cur = nxt; cA = nA; cB = nB; ++ui;
    }
    PG8_WAIT_V(0);
    if (wr == 0) PG8_BAR;
    PG8_BAR;
#undef PG8_SA
#undef PG8_SB
#undef PG8_STAGE
#undef PG8_LDA
#undef PG8_LDB
#undef PG8_MMA
#undef PG8_WAIT_V
#undef PG8_WAIT_L
#undef PG8_BAR
#undef PG8_SCHED
}
}
using pg8::Unit;
using pg8::cvt_pk_bf16;

#define EPI_FOR_NP(...) \
    _Pragma("unroll") for (int ai = 0; ai < 2; ++ai) _Pragma("unroll") for (int m = 0; m < 4; ++m) { const int row = u.pm * 256 + ai * 128 + wr * 64 + m * 16 + fr; \
    _Pragma("unroll") for (int bj = 0; bj < 2; ++bj) _Pragma("unroll") for (int n = 0; n < 2; ++n) { const int col = u.pn * 256 + bj * 128 + wc * 32 + n * 16 + 4 * fq; const f32x4 v = acc[ai][bj][m][n]; __VA_ARGS__ } }

typedef const f32x4 (&AccRef)[2][2][4][2];

struct EpiWin {
    static constexpr bool PERM = false;
    bh* zg; float* zf;
    __device__ __forceinline__ void operator()(AccRef acc, const Unit& u, int wr, int wc, int fr, int fq) const {
        if (u.pn < 24) {
            EPI_FOR_NP({ u32x2 w; w.x = cvt_pk_bf16(fmaxf(sigmoidf_(v[0]), 1e-6f), fmaxf(sigmoidf_(v[1]), 1e-6f)); w.y = cvt_pk_bf16(fmaxf(sigmoidf_(v[2]), 1e-6f), fmaxf(sigmoidf_(v[3]), 1e-6f)); *(u32x2*)(zg + (size_t)row * NGATE + col) = w; })
        } else {
            EPI_FOR_NP({ *(f32x4*)(zf + (size_t)row * ZF_LD + (col - NGATE)) = v; })
        }
    }
};
struct EpiLoraW {
    static constexpr bool PERM = false;
    const float* w0; float* rw;
    __device__ __forceinline__ void operator()(AccRef acc, const Unit& u, int wr, int wc, int fr, int fq) const {
        EPI_FOR_NP({ const f32x4 b = *(const f32x4*)(w0 + col); f32x4 o;
            _Pragma("unroll") for (int j = 0; j < 4; ++j) { const float x = -(b[j] + v[j]); const float sp = fmaxf(x, 0.f) + log1pf(__expf(-fabsf(x))); o[j] = __expf(-__expf(-sp - 0.5f)); }
            *(f32x4*)(rw + (size_t)row * 512 + col) = o; })
    }
};
struct EpiLoraA {
    static constexpr bool PERM = false;
    const float* a0; const float* ka; const float* rkk; float* rb; float* rk;
    __device__ __forceinline__ void operator()(AccRef acc, const Unit& u, int wr, int wc, int fr, int fq) const {
        EPI_FOR_NP({ const f32x4 b0 = *(const f32x4*)(a0 + col); const f32x4 kav = *(const f32x4*)(ka + col); const size_t o = (size_t)row * 512 + col;
            const f32x4 kkv = *(const f32x4*)(rkk + o); f32x4 kv = *(const f32x4*)(rk + o); f32x4 bo;
            _Pragma("unroll") for (int j = 0; j < 4; ++j) { const float a = sigmoidf_(b0[j] + v[j]); bo[j] = kkv[j] * a; kv[j] = kv[j] * (1.0f + (a - 1.0f) * kav[j]); }
            *(f32x4*)(rb + o) = bo; *(f32x4*)(rk + o) = kv; })
    }
};
struct EpiStoreF32 {
    static constexpr bool PERM = false;
    float* o; int ld;
    __device__ __forceinline__ void operator()(AccRef acc, const Unit& u, int wr, int wc, int fr, int fq) const {
        EPI_FOR_NP({ *(f32x4*)(o + (size_t)row * ld + col) = v; })
    }
};
struct EpiGlu {
    static constexpr bool PERM = false;
    const bh* ys; const float* gb; bh* ycat;
    __device__ __forceinline__ void operator()(AccRef acc, const Unit& u, int wr, int wc, int fr, int fq) const {
        EPI_FOR_NP({ const f32x4 b = *(const f32x4*)(gb + col); const u32x2 y2 = *(const u32x2*)(ys + (size_t)row * 512 + col);
            const float y0 = __uint_as_float(y2.x << 16), y1 = __uint_as_float(y2.x & 0xffff0000u), y2f = __uint_as_float(y2.y << 16), y3 = __uint_as_float(y2.y & 0xffff0000u);
            u32x2 w; w.x = cvt_pk_bf16(y0 * sigmoidf_(v[0] + b[0]), y1 * sigmoidf_(v[1] + b[1])); w.y = cvt_pk_bf16(y2f * sigmoidf_(v[2] + b[2]), y3 * sigmoidf_(v[3] + b[3]));
            *(u32x2*)(ycat + (size_t)row * D + 1536 + col) = w; })
    }
};
template <int MODE> struct EpiUp {
    static constexpr bool PERM = false;
    const bh* zg; float* mix; bh* mixed;
    __device__ __forceinline__ void operator()(AccRef acc, const Unit& u, int wr, int wc, int fr, int fq) const {
        EPI_FOR_NP({ const u32x2 g2 = *(const u32x2*)(zg + (size_t)row * NGATE + col);
            f32x4 g; g[0] = __uint_as_float(g2.x << 16); g[1] = __uint_as_float(g2.x & 0xffff0000u); g[2] = __uint_as_float(g2.y << 16); g[3] = __uint_as_float(g2.y & 0xffff0000u);
            f32x4 r = g * v; float* mp = mix + (size_t)row * D + col;
            if (MODE >= 1) r += *(const f32x4*)mp;
            if (MODE <= 1) *(f32x4*)mp = r;
            else { u32x2 w; w.x = cvt_pk_bf16(r[0], r[1]); w.y = cvt_pk_bf16(r[2], r[3]); *(u32x2*)(mixed + (size_t)row * D + col) = w; } })
    }
};
struct EpiUpF {
    static constexpr bool PERM = false;
    const bh* zg; bh* mixed;
    __device__ __forceinline__ void operator()(AccRef acc, const Unit& u, int wr, int wc, int fr, int fq) const {
        EPI_FOR_NP({ const u32x2 g2 = *(const u32x2*)(zg + (size_t)row * NGATE + col);
            u32x2 w; w.x = cvt_pk_bf16(__uint_as_float(g2.x << 16) * v[0], __uint_as_float(g2.x & 0xffff0000u) * v[1]); w.y = cvt_pk_bf16(__uint_as_float(g2.y << 16) * v[2], __uint_as_float(g2.y & 0xffff0000u) * v[3]);
            *(u32x2*)(mixed + (size_t)row * D + col) = w; })
    }
};
struct EpiRes {
    static constexpr bool PERM = false;
    float* h;
    __device__ __forceinline__ void operator()(AccRef acc, const Unit& u, int wr, int wc, int fr, int fq) const {
        EPI_FOR_NP({ float* hp = h + (size_t)row * D + col; *(f32x4*)hp = *(const f32x4*)hp + v; })
    }
};
struct EpiFfn {
    static constexpr bool PERM = true;
    bh* act;
    __device__ __forceinline__ void operator()(AccRef acc, const Unit& u, int wr, int wc, int fr, int fq) const {
#pragma unroll
        for (int ai = 0; ai < 2; ++ai)
#pragma unroll
            for (int m = 0; m < 4; ++m) { const int row = u.pm * 256 + ai * 128 + wr * 64 + m * 16 + fr; const int col = u.pn * 128 + wc * 32 + 8 * fq;
                float o[8];
#pragma unroll
                for (int n = 0; n < 2; ++n)
#pragma unroll
                    for (int j = 0; j < 4; ++j) { const float gte = acc[ai][0][m][n][j], up = acc[ai][1][m][n][j]; o[n * 4 + j] = gte * sigmoidf_(gte) * up; }
                u32x4 w; w.x = cvt_pk_bf16(o[0], o[1]); w.y = cvt_pk_bf16(o[2], o[3]); w.z = cvt_pk_bf16(o[4], o[5]); w.w = cvt_pk_bf16(o[6], o[7]);
                *(u32x4*)(act + (size_t)row * FH + col) = w; }
    }
};
struct EpiPle {
    static constexpr bool PERM = false;
    float* h; const float* tmp;
    __device__ __forceinline__ void operator()(AccRef acc, const Unit& u, int wr, int wc, int fr, int fq) const {
        EPI_FOR_NP({ float* hp = h + (size_t)row * D + col; const f32x4 tv = *(const f32x4*)(tmp + (size_t)row * D + col); f32x4 hv = *(const f32x4*)hp;
            _Pragma("unroll") for (int j = 0; j < 4; ++j) hv[j] += tv[j] * sigmoidf_(v[j]);
            *(f32x4*)hp = hv; })
    }
};

namespace pg8 {
__device__ __forceinline__ void epi_run(const Gemm& g, const f32x4 (&acc)[2][2][4][2], const Unit& u, int wr, int wc, int fr, int fq) {
    unsigned char* ws = P_WS; const int L = g.L;
    switch (g.epi) {
    case 0: { EpiWin E{(bh*)(ws + OFF_ZG), (float*)(ws + OFF_ZF)}; E(acc, u, wr, wc, fr, fq); } break;
    case 1: { EpiLoraW E{P_IN(9) + L * 512, (float*)(ws + OFF_RW)}; E(acc, u, wr, wc, fr, fq); } break;
    case 2: { EpiLoraA E{P_IN(11) + L * 512, P_IN(15) + L * 512, (const float*)(ws + OFF_RKK), (float*)(ws + OFF_RB), (float*)(ws + OFF_RK)}; E(acc, u, wr, wc, fr, fq); } break;
    case 3: { EpiStoreF32 E{(float*)(ws + (g.N == 512 ? OFF_RG : OFF_MIX32)), g.N}; E(acc, u, wr, wc, fr, fq); } break;
    case 4: { EpiGlu E{(const bh*)(ws + OFF_YS), P_IN(28) + L * 512, (bh*)(ws + OFF_YCAT)}; E(acc, u, wr, wc, fr, fq); } break;
    case 5: { EpiUp<0> E{(const bh*)(ws + OFF_ZG), (float*)(ws + OFF_MIX32), (bh*)(ws + OFF_ABF)}; E(acc, u, wr, wc, fr, fq); } break;
    case 6: { EpiUp<1> E{(const bh*)(ws + OFF_ZG) + 2048, (float*)(ws + OFF_MIX32), (bh*)(ws + OFF_ABF)}; E(acc, u, wr, wc, fr, fq); } break;
    case 7: { EpiUp<2> E{(const bh*)(ws + OFF_ZG) + 4096, (float*)(ws + OFF_MIX32), (bh*)(ws + OFF_ABF)}; E(acc, u, wr, wc, fr, fq); } break;
    case 8: { EpiRes E{P_OUT}; E(acc, u, wr, wc, fr, fq); } break;
    case 9: { EpiFfn E{(bh*)(ws + OFF_ACT)}; E(acc, u, wr, wc, fr, fq); } break;
    case 11: { EpiUpF E{(const bh*)(ws + OFF_ZG) + 4096, (bh*)(ws + OFF_ABF)}; E(acc, u, wr, wc, fr, fq); } break;
    default: { EpiPle E{P_OUT, (const float*)(ws + OFF_MIX32)}; E(acc, u, wr, wc, fr, fq); } break;
    }
}
}

__device__ __forceinline__ bool make_gemm(const Params& p, int L, int q, int i, pg8::Gemm& g) {
    unsigned char* ws = P_WS;
    g.M = T; g.perm = 0; g.L = L;
    switch (q) {
    case 1: if (i > 0) return false;
        g.A = (const bh*)(ws + OFF_ABF); g.lda = D; g.Bt = (const bh*)(ws + OFF_WIN); g.ldb = D; g.N = NINP; g.K = D; g.epi = 0; return true;
    case 3: if (i > 2) return false;
        g.lda = 256; g.ldb = 256; g.N = 512; g.K = 256;
        if (i == 0) { g.A = (const bh*)(ws + OFF_LAW); g.Bt = (const bh*)(ws + OFF_WW2); g.epi = 1; }
        else if (i == 1) { g.A = (const bh*)(ws + OFF_LAA); g.Bt = (const bh*)(ws + OFF_WA2); g.epi = 2; }
        else { g.A = (const bh*)(ws + OFF_LAG); g.Bt = (const bh*)(ws + OFF_WG2); g.epi = 3; }
        return true;
    case 5: if (i > 0) return false;
        g.A = (const bh*)(ws + OFF_YS); g.lda = 512; g.Bt = (const bh*)(ws + OFF_WGLU); g.ldb = 512; g.N = 512; g.K = 512; g.epi = 4; return true;
    case 6: if (i > 0) return false;
        g.A = (const bh*)(ws + OFF_YCAT); g.lda = D; g.Bt = (const bh*)(ws + OFF_WUP); g.ldb = D; g.N = D; g.K = D; g.epi = 11; return true;
    case 7: if (i > 0) return false;
        g.A = (const bh*)(ws + OFF_ABF); g.lda = D; g.Bt = (const bh*)(ws + OFF_WO); g.ldb = D; g.N = D; g.K = D; g.epi = 8; return true;
    case 9: if (i > 0) return false;
        g.A = (const bh*)(ws + OFF_ABF); g.lda = D; g.Bt = (const bh*)(ws + OFF_WGU); g.ldb = D; g.N = 2 * FH; g.K = D; g.epi = 9; g.perm = 1; return true;
    case 10: if (i > 0) return false;
        g.A = (const bh*)(ws + OFF_ACT); g.lda = FH; g.Bt = (const bh*)(ws + OFF_WD); g.ldb = FH; g.N = D; g.K = FH; g.epi = 8; return true;
    case 12: if (i > 1) return false;
        if (i == 0) { g.A = (const bh*)(ws + OFF_PBF) + (size_t)L * T * 256; g.lda = 256; g.Bt = (const bh*)(ws + OFF_WPP); g.ldb = 256; g.N = D; g.K = 256; g.epi = 3; }
        else { g.A = (const bh*)(ws + OFF_ABF); g.lda = D; g.Bt = (const bh*)(ws + OFF_WPG); g.ldb = D; g.N = D; g.K = D; g.epi = 10; }
        return true;
    default: return false;
    }
}

struct CJ { const float* src; int in_idx, src_ld, kv, n0, nv; long lstride; size_t dst; int dst_ld, r0, c0, npad, kpad, seg, segstride; };
constexpr int BIGSEG = 1 << 30;
__constant__ int JT_I[15][12] = {
    {3, NIN, 2048, NF, NGATE, D, 0, 0, NGATE, 2048, BIGSEG, 0},
    {3, NIN, 2048, 0, NF, D, NGATE, 0, 6656, 2048, BIGSEG, 0},
    {29, D, 1024, 0, D, D, 0, 0, D, 1024, BIGSEG, 0},
    {30, D, 512, 0, D, D, 0, 1024, D, 512, BIGSEG, 0},
    {31, D, 512, 0, D, D, 0, 1536, D, 512, BIGSEG, 0},
    {32, D, 2048, 0, D, D, 0, 0, D, 2048, BIGSEG, 0},
    {34, FH, 2048, 0, FH, D, 0, 0, FH, 2048, 128, 256},
    {35, FH, 2048, 0, FH, D, 128, 0, FH, 2048, 128, 256},
    {36, D, FH, 0, D, FH, 0, 0, D, FH, BIGSEG, 0},
    {38, D, 2048, 0, D, D, 0, 0, D, 2048, BIGSEG, 0},
    {39, D, 256, 0, D, 256, 0, 0, D, 256, BIGSEG, 0},
    {27, 512, 512, 0, 512, 512, 0, 0, 512, 512, BIGSEG, 0},
    {10, 512, 96, 0, 512, 256, 0, 0, 512, 256, BIGSEG, 0},
    {12, 512, 96, 0, 512, 256, 0, 0, 512, 256, BIGSEG, 0},
    {13, 512, 256, 0, 512, 256, 0, 0, 512, 256, BIGSEG, 0}};
__constant__ long JT_L[15][2] = {
    {(long)D * NIN, (long)OFF_WIN}, {(long)D * NIN, (long)OFF_WIN}, {(long)1024 * D, (long)OFF_WUP}, {(long)512 * D, (long)OFF_WUP}, {(long)512 * D, (long)OFF_WUP},
    {(long)D * D, (long)OFF_WO}, {(long)D * FH, (long)OFF_WGU}, {(long)D * FH, (long)OFF_WGU}, {(long)FH * D, (long)OFF_WD}, {(long)D * D, (long)OFF_WPG},
    {(long)256 * D, (long)OFF_WPP}, {(long)512 * 512, (long)OFF_WGLU}, {(long)96 * 512, (long)OFF_WW2}, {(long)96 * 512, (long)OFF_WA2}, {(long)256 * 512, (long)OFF_WG2}};
__device__ __forceinline__ void get_job(int j, CJ& J) {
    J.in_idx = JT_I[j][0]; J.src_ld = JT_I[j][1]; J.kv = JT_I[j][2]; J.n0 = JT_I[j][3]; J.nv = JT_I[j][4]; J.dst_ld = JT_I[j][5]; J.r0 = JT_I[j][6]; J.c0 = JT_I[j][7];
    J.npad = JT_I[j][8]; J.kpad = JT_I[j][9]; J.seg = JT_I[j][10]; J.segstride = JT_I[j][11]; J.lstride = JT_L[j][0]; J.dst = (size_t)JT_L[j][1];
}
__device__ __forceinline__ const float* in_by_idx(const Params& p, int i) { return P_IN(i); }
constexpr int NJOBS = 15;

__device__ __forceinline__ void conv_tile(int L, const CJ& J, int tile, int lane, bh* dstbase) {
    const int nkt = J.kpad / 64; const int tn = tile / nkt, tk = tile % nkt;
    const float* src = J.src + (size_t)L * J.lstride;
    const int cq = lane & 15, r = lane >> 4;
    const int nl = tn * 64 + cq * 4; const bool nok = nl < J.nv;
    const int k0 = tk * 64 + 16 * r;
    f32x4 v[16];
    const float* sp = src + (size_t)k0 * J.src_ld + J.n0 + nl;
    const float zc = OZ();
#pragma unroll
    for (int i = 0; i < 16; ++i) { v[i] = (f32x4){zc, zc, zc, zc}; if (nok && (k0 + i) < J.kv) v[i] = *(const f32x4*)(sp + (size_t)i * J.src_ld); }
#pragma unroll
    for (int j = 0; j < 4; ++j) { const int n = nl + j; const int drow = J.r0 + (n / J.seg) * J.segstride + (n % J.seg);
        u32x4 w0, w1;
        w0.x = cvt_pk_bf16(v[0][j], v[1][j]); w0.y = cvt_pk_bf16(v[2][j], v[3][j]); w0.z = cvt_pk_bf16(v[4][j], v[5][j]); w0.w = cvt_pk_bf16(v[6][j], v[7][j]);
        w1.x = cvt_pk_bf16(v[8][j], v[9][j]); w1.y = cvt_pk_bf16(v[10][j], v[11][j]); w1.z = cvt_pk_bf16(v[12][j], v[13][j]); w1.w = cvt_pk_bf16(v[14][j], v[15][j]);
        bh* d = dstbase + (size_t)drow * J.dst_ld + J.c0 + k0;
        *(u32x4*)d = w0; *(u32x4*)(d + 8) = w1; }
}

__device__ __forceinline__ void rms_row_bf16(const float* x, const float* g, bh* o, int lane) {
    f32x4 v[8]; float s = 0.f;
#pragma unroll
    for (int j = 0; j < 8; ++j) { v[j] = *(const f32x4*)(x + j * 256 + lane * 4); s += (v[j][0] * v[j][0] + v[j][1] * v[j][1]) + (v[j][2] * v[j][2] + v[j][3] * v[j][3]); }
    const float rstd = rsqrtf(wave_sum(s) * (1.0f / D) + 1e-6f);
#pragma unroll
    for (int j = 0; j < 8; ++j) { const f32x4 gg = *(const f32x4*)(g + j * 256 + lane * 4); u32x2 w; w.x = pk2(v[j][0] * rstd * gg[0], v[j][1] * rstd * gg[1]); w.y = pk2(v[j][2] * rstd * gg[2], v[j][3] * rstd * gg[3]);
        *(u32x2*)(o + j * 256 + lane * 4) = w; }
}
__device__ __forceinline__ void phase_rmsnorm(const Params& p, const float* g) {
    const int gw = BIDX() * 8 + (TIDX() >> 6), NGW = GDIM() * 8, lane = TIDX() & 63;
    bh* abf = (bh*)(P_WS + OFF_ABF);
    for (int r = gw; r < T; r += NGW) rms_row_bf16(P_OUT + (size_t)r * D, g, abf + (size_t)r * D, lane);
}

__device__ __forceinline__ void phase_conv(const Params& p, int L, LAS unsigned char* lds) {
    const int tid = TIDX();
    {   const int gw0 = BIDX() * 8 + (tid >> 6), NGW0 = GDIM() * 8, ln = tid & 63;
        int base = 0;
        for (int j = 0; j < NJOBS; ++j) { CJ J; get_job(j, J); J.src = in_by_idx(p, J.in_idx); const int ntile = (J.npad / 64) * (J.kpad / 64);
            int first = gw0 - (base % NGW0); if (first < 0) first += NGW0;
            bh* dstbase = (bh*)(P_WS + J.dst);
            for (int t = first; t < ntile; t += NGW0) conv_tile(L, J, t, ln, dstbase);
            base += ntile; } }
    const int gw = BIDX() * 8 + (tid >> 6), NGW = GDIM() * 8, lane = tid & 63;
    bh* abf = (bh*)(P_WS + OFF_ABF);
    if (L == 0) {
        const float* ps = P_IN(1); bh* pb = (bh*)(P_WS + OFF_PBF);
        for (size_t i = (size_t)BIDX() * 512 + tid; i < (size_t)2 * T * 256 / 4; i += (size_t)GDIM() * 512) { const f32x4 v = ((const f32x4*)ps)[i]; u32x2 w; w.x = pk2(v[0], v[1]); w.y = pk2(v[2], v[3]); ((u32x2*)pb)[i] = w; }
        const float* x = P_IN(0);
        for (int r = gw; r < T; r += NGW) {
#pragma unroll
            for (int j = 0; j < 8; ++j) *(f32x4*)(P_OUT + (size_t)r * D + j * 256 + lane * 4) = *(const f32x4*)(x + (size_t)r * D + j * 256 + lane * 4);
            rms_row_bf16(x + (size_t)r * D, P_IN(2), abf + (size_t)r * D, lane);
        }
    } else {
        for (int r = gw; r < T; r += NGW) rms_row_bf16(P_OUT + (size_t)r * D, P_IN(2) + (size_t)L * D, abf + (size_t)r * D, lane);
    }
}

struct S5C { float ar, ai; float br[16], bi[16]; };
__device__ __forceinline__ void s5_setup(const Params& p, int L, int g, int n, S5C& c) {
    const int gi = L * 32 + g;
    const float dt = __expf(P_IN(21)[gi]);
    const float are = P_IN(19)[gi * 64 + n], aim = P_IN(20)[gi * 64 + n];
    const float mag = __expf(are * dt), ang = aim * dt;
    float sn, cs;
    {
        const double a = (double)ang; const double k = rint(a * 0.15915494309189535); const float r = (float)(a - k * 6.283185307179586);
        sn = sinf(r); cs = cosf(r);
    }
    c.ar = mag * cs; c.ai = mag * sn;
    const float den = are * are + aim * aim, nr = c.ar - 1.0f, ni = c.ai;
    const float cr = (nr * are + ni * aim) / den, ci = (ni * are - nr * aim) / den;
    const float* bre = P_IN(22) + ((size_t)gi * 64 + n) * 16; const float* bim = P_IN(23) + ((size_t)gi * 64 + n) * 16;
#pragma unroll
    for (int q = 0; q < 4; ++q) { const f32x4 r4 = *(const f32x4*)(bre + q * 4), i4 = *(const f32x4*)(bim + q * 4);
#pragma unroll
        for (int j = 0; j < 4; ++j) { c.br[q * 4 + j] = cr * r4[j] - ci * i4[j]; c.bi[q * 4 + j] = cr * i4[j] + ci * r4[j]; } }
}
__device__ __forceinline__ void s5_step(const S5C& c, const LAS float* urow, float& sr, float& si) {
    float xr = 0.f, xi = 0.f;
#pragma unroll
    for (int q = 0; q < 4; ++q) { const f32x4 u4 = *(const LAS f32x4*)(urow + q * 4);
#pragma unroll
        for (int j = 0; j < 4; ++j) { xr = fmaf(u4[j], c.br[q * 4 + j], xr); xi = fmaf(u4[j], c.bi[q * 4 + j], xi); } }
    const float nr = c.ar * sr - c.ai * si + xr, ni = c.ar * si + c.ai * sr + xi;
    sr = nr; si = ni;
}
__device__ __forceinline__ void s5_stage_u(const float* zfc, LAS float* ul, int lane) {
    const float* src = zfc + (size_t)lane * ZF_LD;
    const f32x4 a = *(const f32x4*)src, b = *(const f32x4*)(src + 4), c = *(const f32x4*)(src + 8), d = *(const f32x4*)(src + 12);
    *(LAS f32x4*)(ul + lane * 16) = a; *(LAS f32x4*)(ul + lane * 16 + 4) = b; *(LAS f32x4*)(ul + lane * 16 + 8) = c; *(LAS f32x4*)(ul + lane * 16 + 12) = d;
    asm volatile("s_waitcnt lgkmcnt(0)" ::: "memory"); __builtin_amdgcn_wave_barrier();
}

__device__ __forceinline__ size_t fq_base(int h, int c, int mt, int ks8) { return ((((size_t)(h * NCH + c) * 4 + mt) * 8 + ks8) * 64) * 8; }
__device__ __forceinline__ size_t fq_off(int h, int t, int d) { const int s = t & 63; return fq_base(h, t >> 6, s >> 4, d >> 5) + ((s & 15) + 16 * ((d >> 3) & 3)) * 8 + (d & 7); }
__device__ __forceinline__ int ft_off(int row, int s8) { return ((((row >> 5) * 4 + (s8 >> 1)) * 64) + (row & 31) + 32 * (s8 & 1)) * 8; }

__device__ __forceinline__ void mlstm_prep(const Params& p, int L, int h, int c, LAS unsigned char* lds) {
    const int tid = TIDX(), t0 = c * 64;
    const float* zf = (const float*)(P_WS + OFF_ZF);
    LAS float* s_ws = (LAS float*)lds;
    if (tid < 64) {
        const int t = t0 + tid;
        float ig = zf[(size_t)t * ZF_LD + 4096 + h] + P_IN(5)[L * 4 + h];
        float fg = zf[(size_t)t * ZF_LD + 4100 + h] + P_IN(6)[L * 4 + h];
        ig = 15.0f * tanhf(ig * (1.0f / 15.0f)); fg = 15.0f * tanhf(fg * (1.0f / 15.0f));
        const float lf = fminf(fg, 0.f) - log1pf(__expf(-fabsf(fg)));
        float b = lf;
#pragma unroll
        for (int o = 1; o < 64; o <<= 1) { const float nb = bperm_f((tid - o) & 63, b); if (tid >= o) b += nb; }
        const float bend = bperm_f(63, b);
        const float wlog = bend - b + ig;
        const float mloc = wave_max(wlog);
        s_ws[tid] = __expf(wlog - mloc);
        ((float*)(P_WS + OFF_MI))[h * T + t] = ig; ((float*)(P_WS + OFF_MBB))[h * T + t] = b;
        if (tid == 0) { ((float*)(P_WS + OFF_MBEND))[h * NCH + c] = bend; ((float*)(P_WS + OFF_MLOC))[h * NCH + c] = mloc; }
    }
    __syncthreads();
    const int d = tid & 255, isk = tid >> 8;
    const int col = isk * 1024 + h * 256 + d;
    const float* cw = P_IN(4) + (size_t)L * 4 * 2048;
    const float w0 = cw[col], w1 = cw[2048 + col], w2 = cw[4096 + col], w3 = cw[6144 + col];
    float x1 = (t0 >= 1) ? zf[(size_t)(t0 - 1) * ZF_LD + col] : 0.f, x2 = (t0 >= 2) ? zf[(size_t)(t0 - 2) * ZF_LD + col] : 0.f, x3 = (t0 >= 3) ? zf[(size_t)(t0 - 3) * ZF_LD + col] : 0.f;
    bh* MQ = (bh*)(P_WS + OFF_MQ); bh* MK = (bh*)(P_WS + OFF_MK);
    bh* MT = (bh*)(P_WS + (isk ? OFF_MKT : OFF_MVT)) + (size_t)(h * NCH + c) * 16384;
    float dnacc = 0.f;
    for (int s8 = 0; s8 < 8; ++s8) {
        unsigned pk[4];
#pragma unroll
        for (int j = 0; j < 8; ++j) { const int s = s8 * 8 + j, t = t0 + s;
            const float x0 = zf[(size_t)t * ZF_LD + col]; float y = w0 * x0 + w1 * x1 + w2 * x2 + w3 * x3; x3 = x2; x2 = x1; x1 = x0;
            y = y * sigmoidf_(y);
            unsigned short e;
            if (!isk) { MQ[fq_off(h, t, d)] = f2bf(y * 0.0625f); e = f2bf(zf[(size_t)t * ZF_LD + 2048 + h * 256 + d]); }
            else { MK[fq_off(h, t, d)] = f2bf(y); const float wk = y * s_ws[s]; e = f2bf(wk); dnacc += wk; }
            if (j & 1) pk[j >> 1] |= ((unsigned)e << 16); else pk[j >> 1] = e; }
        u32x4 w; w.x = pk[0]; w.y = pk[1]; w.z = pk[2]; w.w = pk[3];
        *(u32x4*)(MT + ft_off(d, s8)) = w;
    }
    if (isk) ((float*)(P_WS + OFF_DN))[(size_t)(h * NCH + c) * 256 + d] = dnacc;
    __syncthreads();
}

__device__ __forceinline__ void rwkv_prep_token(const Params& p, int L, int t, int lane) {
    const float* zf = (const float*)(P_WS + OFF_ZF);
    const float* z = zf + (size_t)t * ZF_LD + ZR0; const float* zp = z - ZF_LD; const bool hp = t > 0;
    const float* mu = P_IN(8) + (size_t)L * 1984;
    float* RR = (float*)(P_WS + OFF_RR); float* RK = (float*)(P_WS + OFF_RK); float* RV = (float*)(P_WS + OFF_RV); float* RKK = (float*)(P_WS + OFF_RKK);
    const float* kkw = P_IN(14) + L * 512;
#pragma unroll
    for (int i = 0; i < 8; ++i) { const int c = i * 64 + lane;
        { const float a = z[c], b = hp ? zp[c] : 0.f; RR[(size_t)t * 512 + c] = a + (b - a) * mu[c]; }
        { const float a = z[1024 + c], b = hp ? zp[1024 + c] : 0.f; RV[(size_t)t * 512 + c] = a + (b - a) * mu[1024 + c]; }
        { const float a = z[512 + c], b = hp ? zp[512 + c] : 0.f; const float k = a + (b - a) * mu[512 + c]; RK[(size_t)t * 512 + c] = k;
          const float kkv = k * kkw[c]; const float ss = wave_sum(kkv * kkv); RKK[(size_t)t * 512 + c] = kkv / fmaxf(sqrtf(ss), 1e-12f); } }
    bh* LAW = (bh*)(P_WS + OFF_LAW) + (size_t)t * 256; bh* LAA = (bh*)(P_WS + OFF_LAA) + (size_t)t * 256; bh* LAG = (bh*)(P_WS + OFF_LAG) + (size_t)t * 256;
#pragma unroll
    for (int i = 0; i < 4; ++i) { const int j = i * 64 + lane;
        float vw = 0.f, va = 0.f;
        if (j < 96) { { const int c = 1536 + j; const float a = z[c], b = hp ? zp[c] : 0.f; vw = tanhf(a + (b - a) * mu[c]); }
                      { const int c = 1632 + j; const float a = z[c], b = hp ? zp[c] : 0.f; va = a + (b - a) * mu[c]; } }
        LAW[j] = f2bf(vw); LAA[j] = f2bf(va);
        { const int c = 1728 + j; const float a = z[c], b = hp ? zp[c] : 0.f; LAG[j] = f2bf(sigmoidf_(a + (b - a) * mu[c])); } }
}

__device__ __forceinline__ void s5_pass_a(const Params& p, int L, int g, int c, int lane, LAS float* ul) {
    const float* zf = (const float*)(P_WS + OFF_ZF) + (size_t)(c * 64) * ZF_LD + ZS0 + g * 16;
    s5_stage_u(zf, ul, lane);
    S5C k; s5_setup(p, L, g, lane, k);
    float sr = 0.f, si = 0.f;
#pragma unroll 8
    for (int s = 0; s < 64; ++s) s5_step(k, ul + s * 16, sr, si);
    asm volatile("s_waitcnt lgkmcnt(0)" ::: "memory"); __builtin_amdgcn_wave_barrier();
    float* se = (float*)(P_WS + OFF_SEND) + ((size_t)(g * NCH + c) * 64 + lane) * 2;
    se[0] = sr; se[1] = si;
}

__device__ __forceinline__ void phase_prep(const Params& p, int L, LAS unsigned char* lds) {
    const int wid = TIDX() >> 6, lane = TIDX() & 63;
    for (int it = BIDX(); it < 2048; it += GDIM()) {
        if (it < 512) mlstm_prep(p, L, it >> 7, it & 127, lds);
        else if (it < 1536) rwkv_prep_token(p, L, (it - 512) * 8 + wid, lane);
        else { const int w = (it - 1536) * 8 + wid; s5_pass_a(p, L, w >> 7, w & 127, lane, (LAS float*)lds + wid * 1024); }
    }
}

constexpr int RW_NS = 4, RW_LS = T / RW_NS, RW_NB = RW_LS / 16, RW_RING = 4, RW_SLOT = 16 * 384;
constexpr int RW_YOFF = RW_RING * RW_SLOT;
__device__ __forceinline__ void rwkv_scan(const Params& p, int b, LAS unsigned char* lds) {
    const int tid = TIDX(), wid = __builtin_amdgcn_readfirstlane(tid >> 6), lane = tid & 63;
    int j, h, rg;
    if (b < 32) { j = 0; h = b >> 2; rg = b & 3; } else { const int u = b - 32; j = 1 + (u >> 6); h = (u & 63) >> 3; rg = u & 7; }
    LAS float* ring = (LAS float*)lds;
    LAS float* ybuf = ring + RW_YOFF;
    const int tbase = j * RW_LS;
    const bool isP = rg >= 4;
    if (wid >= 4) {
        const int lw = wid - 4, lt = tid - 256;
        const float* gp[6]; unsigned lo[6];
#pragma unroll
        for (int i = 0; i < 6; ++i) { const int ii = lw * 6 + i, rowidx = ii * 4 + (lane >> 4), step = rowidx / 6, a = rowidx % 6, q = lane & 15;
            const int ai = (0x205314 >> (4 * a)) & 0xf;
            gp[i] = (const float*)(P_WS + OFF_RR + (size_t)ai * SZ_R) + (size_t)(tbase + step) * 512 + h * 64 + q * 4;
            lo[i] = (unsigned)ii * 256u; }
        float* OUT = (float*)(P_WS + (isP ? OFF_RZ : OFF_RY)) + (size_t)(tbase + (lt >> 4)) * 512 + h * 64 + (rg & 3) * 16 + (lt & 15);
#define RW_ISSUE(bi, sl) do { _Pragma("unroll") for (int _i = 0; _i < 6; ++_i) \
        __builtin_amdgcn_global_load_lds((const unsigned*)(gp[_i] + (size_t)(bi) * 16 * 512), (LAS unsigned*)(ring + (sl) * RW_SLOT + lo[_i]), 16, 0, 0); } while (0)
        RW_ISSUE(0, 0); RW_ISSUE(1, 1); RW_ISSUE(2, 2);
        asm volatile("s_waitcnt vmcnt(12)" ::: "memory"); __builtin_amdgcn_s_barrier();
        int sl = 3;
        for (int ib = 0; ib < RW_NB; ++ib) {
            if (ib + 3 < RW_NB) RW_ISSUE(ib + 3, sl);
            sl = (sl == RW_RING - 1) ? 0 : sl + 1;
            if (ib > 0) {
                const LAS float* yb = ybuf + ((ib - 1) & 1) * 4096 + lt * 16;
                const f32x4 a0 = *(const LAS f32x4*)yb, a1 = *(const LAS f32x4*)(yb + 4), a2 = *(const LAS f32x4*)(yb + 8), a3 = *(const LAS f32x4*)(yb + 12);
                const f32x4 sm = (a0 + a1) + (a2 + a3);
                OUT[(size_t)(ib - 1) * 16 * 512] = (sm[0] + sm[1]) + (sm[2] + sm[3]);
            }
            if (ib + 3 < RW_NB) asm volatile("s_waitcnt vmcnt(13)" ::: "memory");
            else asm volatile("s_waitcnt vmcnt(0)" ::: "memory");
            __builtin_amdgcn_s_barrier();
        }
        {   const LAS float* yb = ybuf + ((RW_NB - 1) & 1) * 4096 + lt * 16;
            const f32x4 a0 = *(const LAS f32x4*)yb, a1 = *(const LAS f32x4*)(yb + 4), a2 = *(const LAS f32x4*)(yb + 8), a3 = *(const LAS f32x4*)(yb + 12);
            const f32x4 sm = (a0 + a1) + (a2 + a3);
            OUT[(size_t)(RW_NB - 1) * 16 * 512] = (sm[0] + sm[1]) + (sm[2] + sm[3]); }
#undef RW_ISSUE
    } else {
        const int r16 = wid * 4 + (lane >> 4), kq = lane & 15, row = (rg & 3) * 16 + r16;
        f32x4 S;
#pragma unroll
        for (int e = 0; e < 4; ++e) S[e] = (isP && (kq * 4 + e == row)) ? 1.f : 0.f;
        const float vmask = isP ? 0.f : 1.f;
        __builtin_amdgcn_s_barrier();
        int sl = 0;
        for (int ib = 0; ib < RW_NB; ++ib) {
            const LAS float* bb = ring + sl * RW_SLOT;
            LAS float* yw = ybuf + (ib & 1) * 4096 + r16 * 16 + kq;
            f32x4 w4 = *(const LAS f32x4*)(bb + kq * 4), k4 = *(const LAS f32x4*)(bb + 64 + kq * 4), kk4 = *(const LAS f32x4*)(bb + 128 + kq * 4),
                  b4 = *(const LAS f32x4*)(bb + 192 + kq * 4), r4 = *(const LAS f32x4*)(bb + 256 + kq * 4);
            float vv = bb[320 + row];
#pragma unroll
            for (int s = 0; s < 16; ++s) {
                f32x4 w4n, k4n, kk4n, b4n, r4n; float vvn;
                if (s < 15) { const LAS float* q = bb + (s + 1) * 384;
                    w4n = *(const LAS f32x4*)(q + kq * 4); k4n = *(const LAS f32x4*)(q + 64 + kq * 4); kk4n = *(const LAS f32x4*)(q + 128 + kq * 4);
                    b4n = *(const LAS f32x4*)(q + 192 + kq * 4); r4n = *(const LAS f32x4*)(q + 256 + kq * 4); vvn = q[320 + row]; }
                __builtin_amdgcn_sched_barrier(0);
                float pd = (S[0] * kk4[0] + S[1] * kk4[1]) + (S[2] * kk4[2] + S[3] * kk4[3]);
                const f32x4 pre = S * w4 + (vv * vmask) * k4;
                pd = allreduce16(pd);
                S = pre - pd * b4;
                yw[s * 256] = (S[0] * r4[0] + S[1] * r4[1]) + (S[2] * r4[2] + S[3] * r4[3]);
                if (s < 15) { w4 = w4n; k4 = k4n; kk4 = kk4n; b4 = b4n; r4 = r4n; vv = vvn; }
            }
            sl = (sl == RW_RING - 1) ? 0 : sl + 1;
            asm volatile("s_waitcnt lgkmcnt(0)" ::: "memory");
            __builtin_amdgcn_s_barrier();
        }
        float* EN = (float*)(P_WS + (isP ? OFF_RPEND : OFF_RSEND)) + ((size_t)(h * 4 + j) * 64 + row) * 64 + kq * 4;
        *(f32x4*)EN = S;
    }
    __syncthreads();
}

struct MStage { bf16x8 q[4], k[4], v[4]; float bend, mloc; };
__device__ __forceinline__ void mstage_load(MStage& st, const bh* qp, const bh* kp, const bh* vp, const float* MBEND, const float* MLOC, int h, int c) {
#pragma unroll
    for (int ks = 0; ks < 4; ++ks) { st.q[ks] = *(const bf16x8*)(qp + (size_t)c * 16384 + ks * 512); st.k[ks] = *(const bf16x8*)(kp + (size_t)c * 16384 + ks * 512); st.v[ks] = *(const bf16x8*)(vp + (size_t)c * 16384 + ks * 512); }
    st.bend = MBEND[h * NCH + c]; st.mloc = MLOC[h * NCH + c];
}
__device__ __forceinline__ void mlstm_seq(const Params& p, int mb, LAS unsigned char* lds) {
    const int tid = TIDX(), wid = tid >> 6, lane = tid & 63;
    const int h = mb >> 3, jv = mb & 7;
    LAS bh* Cbf = (LAS bh*)lds;
    constexpr int CS = 264;
    for (int i = tid; i < 2 * 32 * CS / 2; i += 512) ((LAS unsigned*)Cbf)[i] = 0u;
    __syncthreads();
    const bh* MQ = (const bh*)(P_WS + OFF_MQ); const bh* MKT = (const bh*)(P_WS + OFF_MKT); const bh* MVT = (const bh*)(P_WS + OFF_MVT);
    const float* MBEND = (const float*)(P_WS + OFF_MBEND); const float* MLOC = (const float*)(P_WS + OFF_MLOC);
    f32x16 ct;
    { const float z = OZ();
#pragma unroll
    for (int i = 0; i < 16; ++i) ct[i] = z; }
    float m = 0.f;
    const int mt = wid >> 1, kh = wid & 1;
    float* MINTER = (float*)(P_WS + OFF_ABF);
    LAS float* It = (LAS float*)(lds + 2 * 32 * 264 * 2);
    const bh* qp = MQ + fq_base(h, 0, mt, kh * 4) + lane * 8;
    const bh* kp = MKT + (size_t)(h * NCH) * 16384 + (wid * 4 * 64 + lane) * 8;
    const bh* vp = MVT + (size_t)(h * NCH) * 16384 + (jv * 4 * 64 + lane) * 8;
    MStage s0, s1, s2;
    mstage_load(s0, qp, kp, vp, MBEND, MLOC, h, 0);
    mstage_load(s1, qp, kp, vp, MBEND, MLOC, h, 1);
#define MSTEP(SC, SL, CIDX) do { const int c = (CIDX); const int t0 = c * 64, cur = c & 1; \
        mstage_load(SL, qp, kp, vp, MBEND, MLOC, h, (c + 2 < NCH) ? c + 2 : NCH - 1); \
        const float mnew = fmaxf(SC.bend + m, SC.mloc), decay = __expf(SC.bend + m - mnew), scale = __expf(SC.mloc - mnew); \
        f32x4 r0 = {0.f, 0.f, 0.f, 0.f}, r1 = {0.f, 0.f, 0.f, 0.f}; \
        const LAS bh* cb = Cbf + cur * 32 * CS + (lane & 15) * CS + kh * 128 + (lane >> 4) * 8; \
        _Pragma("unroll") for (int ks = 0; ks < 4; ++ks) { const bf16x8 b0 = *(const LAS bf16x8*)(cb + ks * 32), b1 = *(const LAS bf16x8*)(cb + 16 * CS + ks * 32); r0 = MFMA16(SC.q[ks], b0, r0); r1 = MFMA16(SC.q[ks], b1, r1); } \
        {     \
            if (c > 0) { const LAS float* ip = It + ((c - 1) & 1) * (2 * 64 * 36) + (tid >> 3) * 36 + (tid & 7) * 4; \
                const f32x4 sv = *(const LAS f32x4*)ip + *(const LAS f32x4*)(ip + 64 * 36); \
                float* o = MINTER + (size_t)(t0 - 64 + (tid >> 3)) * 1024 + h * 256 + jv * 32 + (tid & 7) * 4; \
                asm volatile("global_store_dwordx4 %0, %1, off\n\ts_nop 1" :: "v"(o), "v"(sv) : "memory"); } \
            LAS float* iw = It + cur * (2 * 64 * 36) + kh * (64 * 36) + (mt * 16 + (lane >> 4) * 4) * 36 + (lane & 15); \
            _Pragma("unroll") for (int r = 0; r < 4; ++r) { iw[r * 36] = r0[r]; iw[r * 36 + 16] = r1[r]; } } \
        f32x16 d0; { const float z = OZ(); _Pragma("unroll") for (int i = 0; i < 16; ++i) d0[i] = z; } \
        _Pragma("unroll") for (int ks = 0; ks < 4; ++ks) d0 = MFMA32(SC.k[ks], SC.v[ks], d0); \
        _Pragma("unroll") for (int i = 0; i < 16; ++i) ct[i] = decay * ct[i] + scale * d0[i]; \
        m = mnew; \
        {   LAS bh* o0 = Cbf + (cur ^ 1) * 32 * CS + (lane & 31) * CS + wid * 32 + 4 * (lane >> 5); \
            _Pragma("unroll") for (int g = 0; g < 4; ++g) { u32x2 w0; w0.x = cvt_pk_bf16(ct[4 * g], ct[4 * g + 1]); w0.y = cvt_pk_bf16(ct[4 * g + 2], ct[4 * g + 3]); *(LAS u32x2*)(o0 + 8 * g) = w0; } } \
        asm volatile("s_waitcnt lgkmcnt(0)" ::: "memory"); __builtin_amdgcn_s_barrier(); asm volatile("" ::: "memory"); } while (0)
    for (int c3 = 0; c3 < 126; c3 += 6) { MSTEP(s0, s2, c3); MSTEP(s1, s0, c3 + 1); MSTEP(s2, s1, c3 + 2); MSTEP(s0, s2, c3 + 3); MSTEP(s1, s0, c3 + 4); MSTEP(s2, s1, c3 + 5); }
    MSTEP(s0, s2, 126); MSTEP(s1, s0, 127);
#undef MSTEP
    {   const LAS float* ip = It + (127 & 1) * (2 * 64 * 36) + (tid >> 3) * 36 + (tid & 7) * 4;
        const f32x4 sv = *(const LAS f32x4*)ip + *(const LAS f32x4*)(ip + 64 * 36);
        *(f32x4*)(MINTER + (size_t)(127 * 64 + (tid >> 3)) * 1024 + h * 256 + jv * 32 + (tid & 7) * 4) = sv; }
    asm volatile("s_waitcnt vmcnt(0)" ::: "memory");
    __syncthreads();
}

__device__ __forceinline__ void mlstm_nscan(const Params& p) {
    const float* MBEND = (const float*)(P_WS + OFF_MBEND); const float* MLOC = (const float*)(P_WS + OFF_MLOC);
    const float* DN = (const float*)(P_WS + OFF_DN); float* NST = (float*)(P_WS + OFF_NST); float* MSTART = (float*)(P_WS + OFF_MSTART);
    for (int idx = TIDX(); idx < 1024; idx += 512) { const int h = idx >> 8, d = idx & 255; float m = 0.f, n = 0.f;
#pragma unroll 8
        for (int c = 0; c < NCH; ++c) { if (d == 0) MSTART[h * NCH + c] = m; NST[(size_t)(h * NCH + c) * 256 + d] = n;
            const float bend = MBEND[h * NCH + c], mloc = MLOC[h * NCH + c]; const float mnew = fmaxf(bend + m, mloc);
            n = __expf(bend + m - mnew) * n + __expf(mloc - mnew) * DN[(size_t)(h * NCH + c) * 256 + d]; m = mnew; } }
}

__device__ __forceinline__ float gelu_tanh(float x) { const float u = 0.7978845608028654f * (x + 0.044715f * x * x * x); return 0.5f * x * (1.0f + tanhf(u)); }

__device__ __forceinline__ void s5_pass_c(const Params& p, int L, int g, int c, int lane, LAS bh* img, LAS float* ul) {
    const float* zf = (const float*)(P_WS + OFF_ZF) + (size_t)(c * 64) * ZF_LD + ZS0 + g * 16;
    s5_stage_u(zf, ul, lane);
    S5C k; s5_setup(p, L, g, lane, k);
    float sr = 0.f, si = 0.f;
    {   float pr = k.ar, pi = k.ai;
#pragma unroll
        for (int i = 0; i < 6; ++i) { const float nr = pr * pr - pi * pi, ni = 2.f * pr * pi; pr = nr; pi = ni; }
        const float* se = (const float*)(P_WS + OFF_SEND) + ((size_t)(g * NCH) * 64 + lane) * 2;
        int cc = 0;
        for (; cc + 8 <= c; cc += 8) { float er[8], ei[8];
#pragma unroll
            for (int j = 0; j < 8; ++j) { er[j] = se[(size_t)(cc + j) * 128]; ei[j] = se[(size_t)(cc + j) * 128 + 1]; }
#pragma unroll
            for (int j = 0; j < 8; ++j) { const float nr = pr * sr - pi * si + er[j], ni = pr * si + pi * sr + ei[j]; sr = nr; si = ni; } }
        for (; cc < c; ++cc) { const float er = se[(size_t)cc * 128], ei = se[(size_t)cc * 128 + 1];
            const float nr = pr * sr - pi * si + er, ni = pr * si + pi * sr + ei; sr = nr; si = ni; } }
    const int gi = L * 32 + g;
    bf16x8 bfr[4];
    {   const int pp = lane & 15; const float* cre = P_IN(24) + ((size_t)gi * 16 + pp) * 64; const float* cim = P_IN(25) + ((size_t)gi * 16 + pp) * 64;
#pragma unroll
        for (int ks = 0; ks < 4; ++ks)
#pragma unroll
            for (int j = 0; j < 8; ++j) { const int n2 = ks * 32 + (lane >> 4) * 8 + j; const float v = (n2 < 64) ? cre[n2] : -cim[n2 - 64]; bfr[ks][j] = (short)f2bf(v); } }
    const float dco = P_IN(26)[L * 512 + g * 16 + (lane & 15)];
    bh* YS = (bh*)(P_WS + OFF_YS);
    for (int half = 0; half < 2; ++half) {
#pragma unroll 8
        for (int s = 0; s < 32; ++s) { s5_step(k, ul + (half * 32 + s) * 16, sr, si); img[s * 136 + lane] = f2bf(sr); img[s * 136 + 64 + lane] = f2bf(si); }
        asm volatile("s_waitcnt lgkmcnt(0)" ::: "memory"); __builtin_amdgcn_wave_barrier();
#pragma unroll
        for (int mt = 0; mt < 2; ++mt) { f32x4 acc = {0.f, 0.f, 0.f, 0.f};
#pragma unroll
            for (int ks = 0; ks < 4; ++ks) { const bf16x8 a = *(const LAS bf16x8*)(img + (mt * 16 + (lane & 15)) * 136 + ks * 32 + (lane >> 4) * 8); acc = MFMA16(a, bfr[ks], acc); }
#pragma unroll
            for (int r = 0; r < 4; ++r) { const int tt = half * 32 + mt * 16 + (lane >> 4) * 4 + r; const float uv = ul[tt * 16 + (lane & 15)];
                YS[(size_t)(c * 64 + tt) * 512 + g * 16 + (lane & 15)] = f2bf(gelu_tanh(acc[r] + dco * uv)); } }
        asm volatile("s_waitcnt lgkmcnt(0)" ::: "memory"); __builtin_amdgcn_wave_barrier();
    }
}

__device__ __forceinline__ void phase_scan(const Params& p, int L, LAS unsigned char* lds) {
    const int b = BIDX();
    if (b < 224) { for (int rr = 0; rr < PROBE_RW; ++rr) rwkv_scan(p, b, lds); }
    else { for (int rr = 0; rr < PROBE_ML; ++rr) mlstm_seq(p, b - 224, lds); }
}
__device__ __forceinline__ void phase_s5c(const Params& p, int L, LAS unsigned char* lds) {
    const int b = BIDX(), wid = TIDX() >> 6, lane = TIDX() & 63;
    if (b == GDIM() - 1) mlstm_nscan(p);
    const int nw = GDIM() * 8;
    for (int w = b * 8 + wid; w < 32 * NCH; w += nw) s5_pass_c(p, L, w >> 7, w & 127, lane, (LAS bh*)lds + wid * (32 * 136), (LAS float*)(lds + 69632) + wid * 1024);
    __syncthreads();
}

__device__ __forceinline__ void mlstm_out(const Params& p, int L, int h, int c, LAS unsigned char* lds) {
    const int tid = TIDX(), wid = tid >> 6, lane = tid & 63, t0 = c * 64;
    LAS bh* Pl = (LAS bh*)lds;
    LAS float* s_b = (LAS float*)(lds + 9216); LAS float* s_a = s_b + 64; LAS float* s_mt = s_a + 64; LAS float* s_iw = s_mt + 64; LAS float* s_den = s_iw + 64; LAS float* s_qn = s_den + 64; LAS float* s_part = s_qn + 64;
    const bh* MQ = (const bh*)(P_WS + OFF_MQ); const bh* MK = (const bh*)(P_WS + OFF_MK); const bh* MVT = (const bh*)(P_WS + OFF_MVT);
    const float* MINTER = (const float*)(P_WS + OFF_ABF);
    const float m0 = ((const float*)(P_WS + OFF_MSTART))[h * NCH + c];
    if (tid < 64) { const float ig = ((const float*)(P_WS + OFF_MI))[h * T + t0 + tid], b = ((const float*)(P_WS + OFF_MBB))[h * T + t0 + tid];
        const float a = ig - b; float cm = a;
#pragma unroll
        for (int o = 1; o < 64; o <<= 1) { const float nb = bperm_f((tid - o) & 63, cm); if (tid >= o) cm = fmaxf(cm, nb); }
        const float mt = b + fmaxf(m0, cm);
        s_b[tid] = b; s_a[tid] = a; s_mt[tid] = mt; s_iw[tid] = __expf(b + m0 - mt); }
    __syncthreads();
    {
        const int mt = wid >> 1, nt0 = (wid & 1) * 2;
        f32x4 r0 = {0.f, 0.f, 0.f, 0.f}, r1 = {0.f, 0.f, 0.f, 0.f};
        const bh* qp = MQ + fq_base(h, c, mt, 0) + lane * 8;
        const bh* kp = MK + fq_base(h, c, nt0, 0) + lane * 8;
#pragma unroll
        for (int ks = 0; ks < 8; ++ks) { const bf16x8 a = *(const bf16x8*)(qp + ks * 512); const bf16x8 b0 = *(const bf16x8*)(kp + ks * 512), b1 = *(const bf16x8*)(kp + 8 * 512 + ks * 512);
            r0 = MFMA16(a, b0, r0); r1 = MFMA16(a, b1, r1); }
#pragma unroll
        for (int r = 0; r < 4; ++r) { const int t = mt * 16 + (lane >> 4) * 4 + r; const float bt = s_b[t] - s_mt[t];
            { const int s = nt0 * 16 + (lane & 15); const float pv = (s <= t) ? r0[r] * __expf(bt + s_a[s]) : 0.f; Pl[t * 72 + s] = f2bf(pv); }
            { const int s = nt0 * 16 + 16 + (lane & 15); const float pv = (s <= t) ? r1[r] * __expf(bt + s_a[s]) : 0.f; Pl[t * 72 + s] = f2bf(pv); } }
    }
    __syncthreads();
    if (tid < 64) { float s = 0.f;
#pragma unroll
        for (int q = 0; q < 8; ++q) { const u32x4 w = *(const LAS u32x4*)(Pl + tid * 72 + q * 8);
            s += __uint_as_float(w.x << 16) + __uint_as_float(w.x & 0xffff0000u) + __uint_as_float(w.y << 16) + __uint_as_float(w.y & 0xffff0000u)
               + __uint_as_float(w.z << 16) + __uint_as_float(w.z & 0xffff0000u) + __uint_as_float(w.w << 16) + __uint_as_float(w.w & 0xffff0000u); }
        s_den[tid] = s; }
    {
        const float* nst = (const float*)(P_WS + OFF_NST) + (size_t)(h * NCH + c) * 256 + lane * 4; const f32x4 nv = *(const f32x4*)nst;
#pragma unroll
        for (int i = 0; i < 8; ++i) { const int t = wid * 8 + i; const u32x2 q2 = *(const u32x2*)(MQ + fq_off(h, t0 + t, lane * 4));
            float s = __uint_as_float(q2.x << 16) * nv[0] + __uint_as_float(q2.x & 0xffff0000u) * nv[1] + __uint_as_float(q2.y << 16) * nv[2] + __uint_as_float(q2.y & 0xffff0000u) * nv[3];
            s = wave_sum(s); if (lane == 0) s_qn[t] = s; } }
    f32x4 acc[4][2];
#pragma unroll
    for (int a = 0; a < 4; ++a) { const float z = OZ(); acc[a][0] = (f32x4){z, z, z, z}; acc[a][1] = (f32x4){z, z, z, z}; }
    {   const bh* vp = MVT + (size_t)(h * NCH + c) * 16384;
#pragma unroll
        for (int ks = 0; ks < 2; ++ks) { const bf16x8 b0 = *(const bf16x8*)(vp + ft_off(wid * 32 + (lane & 15), ks * 4 + (lane >> 4))), b1 = *(const bf16x8*)(vp + ft_off(wid * 32 + 16 + (lane & 15), ks * 4 + (lane >> 4)));
#pragma unroll
            for (int a = 0; a < 4; ++a) { const bf16x8 av = *(const LAS bf16x8*)(Pl + (a * 16 + (lane & 15)) * 72 + ks * 32 + (lane >> 4) * 8);
                acc[a][0] = MFMA16(av, b0, acc[a][0]); acc[a][1] = MFMA16(av, b1, acc[a][1]); } } }
    __syncthreads();
#pragma unroll
    for (int a = 0; a < 4; ++a)
#pragma unroll
        for (int r = 0; r < 4; ++r) { const int t = a * 16 + (lane >> 4) * 4 + r; const float iw = s_iw[t];
            const float den = s_den[t] + iw * s_qn[t]; const float dd = 1.0f / fmaxf(fabsf(den), __expf(-s_mt[t]));
            const float* mi = MINTER + (size_t)(t0 + t) * 1024 + h * 256 + wid * 32 + (lane & 15);
            const float h0 = (acc[a][0][r] + iw * mi[0]) * dd, h1 = (acc[a][1][r] + iw * mi[16]) * dd;
            acc[a][0][r] = h0; acc[a][1][r] = h1;
            float ss = h0 * h0 + h1 * h1;
            ss = allreduce16(ss);
            if ((lane & 15) == 0) s_part[wid * 64 + t] = ss; }
    __syncthreads();
    {   const float* zf = (const float*)(P_WS + OFF_ZF); const float* ng = P_IN(7) + L * 1024 + h * 256; bh* YC = (bh*)(P_WS + OFF_YCAT);
#pragma unroll
        for (int a = 0; a < 4; ++a)
#pragma unroll
            for (int r = 0; r < 4; ++r) { const int t = a * 16 + (lane >> 4) * 4 + r;
                float tot = 0.f;
#pragma unroll
                for (int w = 0; w < 8; ++w) tot += s_part[w * 64 + t];
                const float rstd = rsqrtf(tot * (1.0f / 256.0f) + 1e-6f);
                const int v0 = wid * 32 + (lane & 15);
                const float* op = zf + (size_t)(t0 + t) * ZF_LD + 3072 + h * 256 + v0;
                bh* yo = YC + (size_t)(t0 + t) * D + h * 256 + v0;
                yo[0] = f2bf(sigmoidf_(op[0]) * acc[a][0][r] * rstd * ng[v0]);
                yo[16] = f2bf(sigmoidf_(op[16]) * acc[a][1][r] * rstd * ng[v0 + 16]); } }
    __syncthreads();
}

__device__ __forceinline__ void rwkv_post(const Params& p, int L, int it, LAS unsigned char* lds) {
    const int tid = TIDX(), wid = tid >> 6, lane = tid & 63;
    const int h = it & 7, blk = it >> 3, j = blk >> 3;
    LAS float* bufA = (LAS float*)lds;
    LAS float* bufB = bufA + 64 * 65;
    LAS float* bufP = bufB + 64 * 65;
    const float* SE = (const float*)(P_WS + OFF_RSEND) + (size_t)(h * 4) * 4096; const float* PE = (const float*)(P_WS + OFF_RPEND) + (size_t)(h * 4) * 4096;
    LAS float* sst = bufA;
    if (j >= 1) {
        const int v = tid >> 3, k8 = (tid & 7) * 8;
        { const f32x4 a0 = *(const f32x4*)(SE + v * 64 + k8), a1 = *(const f32x4*)(SE + v * 64 + k8 + 4);
#pragma unroll
          for (int e = 0; e < 4; ++e) { bufA[v * 65 + k8 + e] = a0[e]; bufA[v * 65 + k8 + 4 + e] = a1[e]; } }
        for (int jj = 1; jj < j; ++jj) {
            { const f32x4 p0 = *(const f32x4*)(PE + (size_t)jj * 4096 + v * 64 + k8), p1 = *(const f32x4*)(PE + (size_t)jj * 4096 + v * 64 + k8 + 4);
              *(LAS f32x4*)(bufP + v * 64 + k8) = p0; *(LAS f32x4*)(bufP + v * 64 + k8 + 4) = p1; }
            __syncthreads();
            LAS float* src = (jj & 1) ? bufA : bufB; LAS float* dst = (jj & 1) ? bufB : bufA;
            f32x4 c0 = *(const f32x4*)(SE + (size_t)jj * 4096 + v * 64 + k8), c1 = *(const f32x4*)(SE + (size_t)jj * 4096 + v * 64 + k8 + 4);
#pragma unroll 8
            for (int i = 0; i < 64; ++i) { const float a = src[v * 65 + i]; const f32x4 p0 = *(const LAS f32x4*)(bufP + i * 64 + k8), p1 = *(const LAS f32x4*)(bufP + i * 64 + k8 + 4); c0 += a * p0; c1 += a * p1; }
#pragma unroll
            for (int e = 0; e < 4; ++e) { dst[v * 65 + k8 + e] = c0[e]; dst[v * 65 + k8 + 4 + e] = c1[e]; }
            __syncthreads();
            sst = dst;
        }
        __syncthreads();
    }
    float srow[64];
    if (j >= 1) {
#pragma unroll
        for (int i = 0; i < 64; ++i) srow[i] = sst[lane * 65 + i];
    } else {
#pragma unroll
        for (int i = 0; i < 64; ++i) srow[i] = 0.f;
    }
    const int c = h * 64 + lane;
    const float rkw = P_IN(16)[L * 512 + c], lg = P_IN(17)[L * 512 + c], lb = P_IN(18)[L * 512 + c];
    const float* RY = (const float*)(P_WS + OFF_RY); const float* RZ = (const float*)(P_WS + OFF_RZ); const float* RR = (const float*)(P_WS + OFF_RR); const float* RK = (const float*)(P_WS + OFF_RK);
    const float* RV = (const float*)(P_WS + OFF_RV); const float* RG = (const float*)(P_WS + OFF_RG); bh* YC = (bh*)(P_WS + OFF_YCAT);
    for (int i = 0; i < 32; ++i) { const int t = blk * 256 + wid * 32 + i; const size_t o = (size_t)t * 512 + c;
        float y = RY[o];
        if (j >= 1) { const float z = RZ[o]; float y2 = 0.f;
#pragma unroll
            for (int q = 0; q < 64; q += 2) { y = fmaf(srow[q], __builtin_bit_cast(float, __builtin_amdgcn_readlane(__builtin_bit_cast(int, z), q)), y);
                                              y2 = fmaf(srow[q + 1], __builtin_bit_cast(float, __builtin_amdgcn_readlane(__builtin_bit_cast(int, z), q + 1)), y2); }
            y += y2; }
        const float mu = wave_sum(y) * (1.0f / 64.0f); const float dlt = y - mu; const float var = wave_sum(dlt * dlt) * (1.0f / 64.0f);
        const float yn = dlt * rsqrtf(var + 64e-5f) * lg + lb;
        const float bon = wave_sum(RR[o] * RK[o] * rkw) * RV[o];
        YC[(size_t)t * D + 1024 + c] = f2bf((yn + bon) * RG[o]); }
    __syncthreads();
}

__device__ __forceinline__ void phase_post(const Params& p, int L, LAS unsigned char* lds) {
    for (int it = BIDX(); it < 768; it += GDIM()) {
        if (it < 512) mlstm_out(p, L, it >> 7, it & 127, lds);
        else rwkv_post(p, L, it - 512, lds);
    }
    __syncthreads();
}

constexpr int NPHASE = 27;
__global__ void __launch_bounds__(512, 2) hybrid_fwd(Params p, int ph_lo, int ph_hi, int rep_q) {
    extern __shared__ __attribute__((aligned(16))) unsigned char smem_raw[];
    LAS unsigned char* lds = (LAS unsigned char*)smem_raw;
    cg::grid_group grid = cg::this_grid();
    for (int ph = ph_lo; ph < ph_hi; ++ph) {
        if (ph > ph_lo) grid.sync();
        if (ph == 26) {
            const int gw = BIDX() * 8 + (TIDX() >> 6), NGW = GDIM() * 8, lane = TIDX() & 63;
            for (int r = gw; r < T; r += NGW) { float* x = P_OUT + (size_t)r * D; f32x4 v[8]; float s = 0.f;
#pragma unroll
                for (int j = 0; j < 8; ++j) { v[j] = *(const f32x4*)(x + j * 256 + lane * 4); s += (v[j][0] * v[j][0] + v[j][1] * v[j][1]) + (v[j][2] * v[j][2] + v[j][3] * v[j][3]); }
                const float rstd = rsqrtf(wave_sum(s) * (1.0f / D) + 1e-6f);
#pragma unroll
                for (int j = 0; j < 8; ++j) { const f32x4 gg = *(const f32x4*)(P_IN(40) + j * 256 + lane * 4); *(f32x4*)(x + j * 256 + lane * 4) = v[j] * rstd * gg; } }
            continue;
        }
        const int L = ph / 13, q = ph % 13;
#ifdef ONLY_Q
        if (q != ONLY_Q) continue;
#endif
        const int nrep = (q == rep_q) ? 2 : 1;
        for (int rep = 0; rep < nrep; ++rep) {
        if (rep) grid.sync();
        switch (q) {
        case 0: phase_conv(p, L, lds); break;
        case 2: phase_prep(p, L, lds); break;
        case 4: phase_scan(p, L, lds); break;
        case 5: phase_post(p, L, lds); break;
        case 8: phase_rmsnorm(p, P_IN(33) + (size_t)L * D); break;
        case 11: phase_rmsnorm(p, P_IN(37) + (size_t)L * D); break;
        default: break;
        }
        for (int i = 0; i < 3; ++i) {
            pg8::Gemm g;
            if (!make_gemm(p, L, q, i, g)) break;
            pg8::StaticOrder S; S.init(T, g.N, GDIM(), BIDX());
            pg8::gemm_phase(lds, g, S);
        }
        if (q == 3) phase_s5c(p, L, lds);
        }
    }
}

extern "C" void kernel_launch(void* const* d_in, const int* in_sizes, int n_in, void* d_out, int out_size, void* d_ws, size_t ws_size, hipStream_t stream) {
    constexpr size_t kDynLds = 131072;
    static int grid_blocks = 0;
    if (!grid_blocks) {
        int dev = 0, cus = 0, per_cu = 0;
        (void)hipGetDevice(&dev);
        (void)hipDeviceGetAttribute(&cus, hipDeviceAttributeMultiprocessorCount, dev);
        (void)hipFuncSetAttribute((const void*)hybrid_fwd, hipFuncAttributeMaxDynamicSharedMemorySize, (int)kDynLds);
        (void)hipOccupancyMaxActiveBlocksPerMultiprocessor(&per_cu, hybrid_fwd, 512, kDynLds);
        if (per_cu > 1) per_cu = 1;
        grid_blocks = cus * per_cu;
        if (ws_size < WS_TOTAL) fprintf(stderr, "workspace too small: %zu < %zu\n", ws_size, (size_t)WS_TOTAL);
    }
    Params p{};
    for (int i = 0; i < 41; ++i) p.in[i] = (const float*)d_in[i];
    p.out = (float*)d_out; p.ws = (unsigned char*)d_ws;
#if SINGLE_LAUNCH
    int lo = 0, hi = NPHASE, rq = PROBE_REP_Q;
    void* args[] = {&p, &lo, &hi, &rq};
    hipError_t e = hipLaunchCooperativeKernel((const void*)hybrid_fwd, dim3(grid_blocks), dim3(512), args, kDynLds, stream);
    if (e != hipSuccess) fprintf(stderr, "cooperative launch failed: %s (grid %d)\n", hipGetErrorString(e), grid_blocks);
#else
    for (int ph = 0; ph < NPHASE; ++ph) {
        int lo = ph, hi = ph + 1, rq = -1;
        void* args[] = {&p, &lo, &hi, &rq};
        hipError_t e = hipLaunchCooperativeKernel((const void*)hybrid_fwd, dim3(grid_blocks), dim3(512), args, kDynLds, stream);
        if (e != hipSuccess) fprintf(stderr, "cooperative launch failed: %s (grid %d)\n", hipGetErrorString(e), grid_blocks);
    }
#endif
}
```

```cpp
#include <hip/hip_runtime.h>
#include <hip/hip_cooperative_groups.h>
#include <cstdio>
#include <cstdint>
namespace cg = cooperative_groups;

#define LAS __attribute__((address_space(3)))
typedef unsigned short bh;
typedef short bf16x8 __attribute__((ext_vector_type(8)));
typedef float f32x4 __attribute__((ext_vector_type(4)));
typedef float f32x16 __attribute__((ext_vector_type(16)));
typedef unsigned u32x4 __attribute__((ext_vector_type(4)));
typedef unsigned u32x2 __attribute__((ext_vector_type(2)));

#ifndef PROBE_RW
#define PROBE_RW 1
#define PROBE_ML 1
#endif
#ifndef PROBE_REP_Q
#define PROBE_REP_Q (-1)
#endif
#ifndef SINGLE_LAUNCH
#define SINGLE_LAUNCH 1
#endif

constexpr int T = 8192, D = 2048, FH = 5632;
constexpr int NIN = 12744, NGATE = 6144, NF = 6600, ZF_LD = 6656, NINP = 12800;
constexpr int ZR0 = 4104, ZS0 = 6088;
constexpr int NCH = 128;

constexpr size_t AL(size_t x) { return (x + 255) & ~(size_t)255; }
constexpr size_t SZ_WIN = (size_t)NINP * D * 2, SZ_SQ = (size_t)D * D * 2, SZ_WGU = (size_t)2 * FH * D * 2, SZ_WD = (size_t)D * FH * 2;
constexpr size_t OFF_WIN = 0;
constexpr size_t OFF_WUP = OFF_WIN + SZ_WIN;
constexpr size_t OFF_WO = OFF_WUP + SZ_SQ;
constexpr size_t OFF_WGU = OFF_WO + SZ_SQ;
constexpr size_t OFF_WD = OFF_WGU + SZ_WGU;
constexpr size_t OFF_WPG = OFF_WD + SZ_WD;
constexpr size_t OFF_WPP = OFF_WPG + SZ_SQ;
constexpr size_t OFF_WGLU = OFF_WPP + (size_t)D * 256 * 2;
constexpr size_t OFF_WW2 = OFF_WGLU + (size_t)512 * 512 * 2;
constexpr size_t OFF_WA2 = OFF_WW2 + (size_t)512 * 256 * 2;
constexpr size_t OFF_WG2 = OFF_WA2 + (size_t)512 * 256 * 2;
constexpr size_t OFF_PBF = OFF_WG2 + (size_t)512 * 256 * 2;
constexpr size_t OFF_ABF = OFF_PBF + (size_t)2 * T * 256 * 2;
constexpr size_t OFF_YCAT = OFF_ABF + (size_t)T * D * 2;
constexpr size_t OFF_ZF = OFF_YCAT + (size_t)T * D * 2;
constexpr size_t OFF_ACT = OFF_ZF;
constexpr size_t OFF_MIX32 = OFF_ZF + (size_t)100663296;
constexpr size_t OFF_ZG = OFF_ZF + (size_t)T * ZF_LD * 4;
constexpr size_t SZ_R = (size_t)T * 512 * 4;
constexpr size_t OFF_RR = OFF_ZG + (size_t)T * NGATE * 2;
constexpr size_t OFF_RK = OFF_RR + SZ_R, OFF_RV = OFF_RK + SZ_R, OFF_RKK = OFF_RV + SZ_R, OFF_RW = OFF_RKK + SZ_R, OFF_RB = OFF_RW + SZ_R, OFF_RG = OFF_RB + SZ_R, OFF_RY = OFF_RG + SZ_R;
constexpr size_t OFF_LAW = OFF_RY + SZ_R;
constexpr size_t OFF_LAA = OFF_LAW + (size_t)T * 256 * 2, OFF_LAG = OFF_LAA + (size_t)T * 256 * 2;
constexpr size_t SZ_MB = (size_t)T * 1024 * 2;
constexpr size_t OFF_MQ = OFF_LAG + (size_t)T * 256 * 2, OFF_MK = OFF_MQ + SZ_MB, OFF_MKT = OFF_MK + SZ_MB, OFF_MVT = OFF_MKT + SZ_MB;
constexpr size_t OFF_MI = OFF_MVT + SZ_MB;
constexpr size_t OFF_MBB = OFF_MI + (size_t)4 * T * 4;
constexpr size_t OFF_MBEND = OFF_MBB + (size_t)4 * T * 4;
constexpr size_t OFF_MLOC = OFF_MBEND + 2048, OFF_MSTART = OFF_MLOC + 2048;
constexpr size_t OFF_DN = OFF_MSTART + 2048;
constexpr size_t OFF_NST = OFF_DN + (size_t)4 * NCH * 256 * 4;
constexpr size_t OFF_SEND = OFF_NST + (size_t)4 * NCH * 256 * 4;
constexpr size_t OFF_YS = OFF_SEND + (size_t)32 * NCH * 64 * 8;
constexpr size_t OFF_RZ = OFF_YS + (size_t)T * 512 * 2;
constexpr size_t OFF_RSEND = OFF_RZ + SZ_R;
constexpr size_t OFF_RPEND = OFF_RSEND + (size_t)8 * 4 * 4096 * 4;
constexpr size_t OFF_MINTER2 = OFF_RPEND + (size_t)8 * 4 * 4096 * 4;
constexpr size_t OFF_BAR = OFF_MINTER2;
constexpr size_t WS_TOTAL = OFF_MINTER2 + (size_t)T * 1024 * 4;

struct Params { const float* in[41]; float* out; unsigned char* ws; };
#define KARG4 __attribute__((address_space(4)))
__device__ __forceinline__ const float* karg_in(int i) { const KARG4 char* ka = (const KARG4 char*)__builtin_amdgcn_kernarg_segment_ptr(); return *(const float* const volatile KARG4*)(ka + (size_t)i * 8); }
#define P_IN(i) karg_in(i)
#define P_OUT ((float*)karg_in(41))
#define P_WS ((unsigned char*)karg_in(42))

__device__ __forceinline__ int TIDX() { int t = threadIdx.x; asm volatile("" : "+v"(t)); return t; }
__device__ __forceinline__ int BIDX() { int t = blockIdx.x; asm volatile("" : "+s"(t)); return t; }
__device__ __forceinline__ int GDIM() { int t = gridDim.x; asm volatile("" : "+s"(t)); return t; }
__device__ __forceinline__ bh f2bf(float f) { unsigned u = __float_as_uint(f); u += 0x7fffu + ((u >> 16) & 1u); return (bh)(u >> 16); }
__device__ __forceinline__ float bf2f(bh h) { return __uint_as_float(((unsigned)h) << 16); }
__device__ __forceinline__ unsigned pk2(float lo, float hi) { return (unsigned)f2bf(lo) | ((unsigned)f2bf(hi) << 16); }
__device__ __forceinline__ float sigmoidf_(float x) { return 1.0f / (1.0f + __expf(-x)); }
__device__ __forceinline__ float bperm_f(int srclane, float v) { return __builtin_bit_cast(float, __builtin_amdgcn_ds_bpermute(srclane << 2, __builtin_bit_cast(int, v))); }
__device__ __forceinline__ float wave_sum(float v) {
    const int lane = TIDX() & 63;
#pragma unroll
    for (int o = 32; o >= 1; o >>= 1) v += bperm_f(lane ^ o, v);
    return v;
}
__device__ __forceinline__ float wave_max(float v) {
    const int lane = TIDX() & 63;
#pragma unroll
    for (int o = 32; o >= 1; o >>= 1) v = fmaxf(v, bperm_f(lane ^ o, v));
    return v;
}
template <int CTRL> __device__ __forceinline__ float dpp_f(float x) {
    return __builtin_bit_cast(float, __builtin_amdgcn_update_dpp(0, __builtin_bit_cast(int, x), CTRL, 0xf, 0xf, true));
}
__device__ __forceinline__ float allreduce16(float x) {
    x += dpp_f<0xB1>(x); x += dpp_f<0x4E>(x); x += dpp_f<0x141>(x); x += dpp_f<0x140>(x);
    return x;
}
__device__ __forceinline__ float OZ() { float z = 0.f; asm volatile("" : "+v"(z)); return z; }
#define MFMA16(a, b, c) __builtin_amdgcn_mfma_f32_16x16x32_bf16(a, b, c, 0, 0, 0)
#define MFMA32(a, b, c) __builtin_amdgcn_mfma_f32_32x32x16_bf16(a, b, c, 0, 0, 0)

namespace pg8 {
constexpr int BM = 256, BK = 64, HALF = 128, HTB = HALF * BK * 2, STAGE_BYTES = 8 * HTB, NXCD = 8, WGM = 8;
__device__ __forceinline__ int lds_byte(int r, int c) { const int st = (r >> 4) * 2 + (c >> 5), rr = r & 15, cc = c & 31, ob = rr * 64 + cc * 2; return st * 1024 + (ob ^ (((ob >> 9) & 1) << 5)); }
__device__ __forceinline__ void stage_rc(int b, int& R, int& C) { const int st = b / 1024, sb = b % 1024, swz = sb ^ (((sb >> 9) & 1) << 5); R = (st >> 1) * 16 + swz / 64; C = (st & 1) * 32 + (swz % 64) / 2; }
__device__ __forceinline__ int perm32(int rho) { const int n = rho >> 4, i = rho & 15; return 8 * (i >> 2) + 4 * n + (i & 3); }
struct Unit { int pm, pn; };
struct Gemm { const bh* A; const bh* Bt; int M, N, K, lda, ldb, epi, perm, L; };
struct StaticOrder {
    int nM, nN, nwg, G, c;
    __device__ void init(int M, int N, int G_, int c_) { nM = M / BM; nN = N / BM; nwg = nM * nN; G = G_; c = c_; }
    __device__ bool next(int i, Unit& u) const {
        const long L = (long)i * G + c; if (L >= nwg) return false;
        int wgid = (int)L; { const int q = nwg / NXCD, r = nwg % NXCD, xcd = wgid % NXCD, off = wgid / NXCD; wgid = (xcd < r ? xcd * (q + 1) : r * (q + 1) + (xcd - r) * q) + off; }
        const int nig = WGM * nN, gid = wgid / nig, fm = gid * WGM, gsz = (nM - fm) < WGM ? (nM - fm) : WGM;
        u.pm = fm + ((wgid % nig) % gsz); u.pn = (wgid % nig) / gsz; return true;
    }
};
__device__ __forceinline__ unsigned cvt_pk_bf16(float lo, float hi) { unsigned r; asm volatile("v_cvt_pk_bf16_f32 %0, %1, %2" : "=v"(r) : "v"(lo), "v"(hi)); return r; }

__device__ __forceinline__ void epi_run(const Gemm& g, const f32x4 (&acc)[2][2][4][2], const Unit& u, int wr, int wc, int fr, int fq);
__device__ __forceinline__ void up_rescale(f32x4 (&acc)[2][2][4][2], const Unit& u, int wr, int wc, int fr, int fq, int goff) {
    const bh* zg = (const bh*)(P_WS + OFF_ZG) + goff;
    asm volatile("" : "+v"(fr), "+v"(fq));
    const bh* zrow0 = zg + (size_t)(u.pm * 256 + wr * 64 + fr) * NGATE + u.pn * 256 + wc * 32 + 4 * fq;
#pragma unroll
    for (int ai = 0; ai < 2; ++ai)
#pragma unroll
        for (int m = 0; m < 4; ++m) { const bh* zr = zrow0 + (size_t)(ai * 128 + m * 16) * NGATE;
#pragma unroll
            for (int bj = 0; bj < 2; ++bj)
#pragma unroll
                for (int n = 0; n < 2; ++n) {
                    const u32x2 gp = *(const u32x2*)(zr + bj * 128 + n * 16), gn = *(const u32x2*)(zr + 2048 + bj * 128 + n * 16);
                    f32x4 r;
                    r[0] = __uint_as_float(gp.x << 16) * __builtin_amdgcn_rcpf(__uint_as_float(gn.x << 16)); r[1] = __uint_as_float(gp.x & 0xffff0000u) * __builtin_amdgcn_rcpf(__uint_as_float(gn.x & 0xffff0000u));
                    r[2] = __uint_as_float(gp.y << 16) * __builtin_amdgcn_rcpf(__uint_as_float(gn.y << 16)); r[3] = __uint_as_float(gp.y & 0xffff0000u) * __builtin_amdgcn_rcpf(__uint_as_float(gn.y & 0xffff0000u));
                    acc[ai][bj][m][n] *= r; }
            __builtin_amdgcn_sched_barrier(0); }
}
__device__ __forceinline__ void gemm_phase(LAS unsigned char* lds, const Gemm& g, const StaticOrder& S) {
    const int tid = TIDX(), wid = __builtin_amdgcn_readfirstlane(tid >> 6), lane = tid & 63, wr = wid >> 2, wc = wid & 3, fr = lane & 15, fq = lane >> 4;
    const int K = g.K, nt = K / BK;
    unsigned voffA[2], voffB[2];
#pragma unroll
    for (int i = 0; i < 2; ++i) { int R, C; stage_rc(tid * 16 + i * 8192, R, C); const int Rb = g.perm ? ((R & ~31) + perm32(R & 31)) : R;
        voffA[i] = (unsigned)(R * g.lda + C) * 2u; voffB[i] = (unsigned)(Rb * g.ldb + C) * 2u; }
    const size_t kstep = (size_t)(BK * 2);
    const size_t hstepA = (size_t)HALF * g.lda * 2, hstepB = (size_t)HALF * g.ldb * 2;
    const size_t tstepA = 2 * hstepA, tstepB = 2 * hstepB;
    const unsigned ldsw = (unsigned)wid * 1024u;
    const int aoff = lds_byte(wr * 64 + fr, fq * 8), boff = lds_byte(wc * 32 + fr, fq * 8);
#define PG8_SA(b, h) (((b) * 2 + (h)) * HTB)
#define PG8_SB(b, h) ((4 + (b) * 2 + (h)) * HTB)
#define PG8_STAGE(bufoff, gbase, voff) do { _Pragma("unroll") for (int _i = 0; _i < 2; ++_i) \
        __builtin_amdgcn_global_load_lds((const unsigned*)((const char*)(gbase) + (voff)[_i]), (LAS unsigned*)(lds + (bufoff) + ldsw + _i * 8192), 16, 0, 0); } while (0)
#define PG8_LDA(dst, b, h) do { _Pragma("unroll") for (int m = 0; m < 4; ++m) _Pragma("unroll") for (int k = 0; k < 2; ++k) dst[m][k] = *(const LAS bf16x8*)(lds + PG8_SA(b, h) + aoff + m * 2048 + k * 1024); } while (0)
#define PG8_LDB(dst, b, h) do { _Pragma("unroll") for (int n = 0; n < 2; ++n) _Pragma("unroll") for (int k = 0; k < 2; ++k) dst[n][k] = *(const LAS bf16x8*)(lds + PG8_SB(b, h) + boff + n * 2048 + k * 1024); } while (0)
#define PG8_MMA(ai, bj, At, Bt) do { __builtin_amdgcn_s_setprio(1); _Pragma("unroll") for (int m = 0; m < 4; ++m) _Pragma("unroll") for (int n = 0; n < 2; ++n) _Pragma("unroll") for (int k = 0; k < 2; ++k) \
        acc[ai][bj][m][n] = __builtin_amdgcn_mfma_f32_16x16x32_bf16(Bt[n][k], At[m][k], acc[ai][bj][m][n], 0, 0, 0); __builtin_amdgcn_s_setprio(0); } while (0)
#define PG8_WAIT_V(n) asm volatile("s_waitcnt vmcnt(" #n ")" ::: "memory")
#define PG8_WAIT_L(n) asm volatile("s_waitcnt lgkmcnt(" #n ")" ::: "memory")
#define PG8_BAR __builtin_amdgcn_s_barrier()
#define PG8_SCHED __builtin_amdgcn_sched_barrier(0)
    Unit cur, nxt; int ui = 0;
    if (!S.next(0, cur)) return;
    f32x4 acc[2][2][4][2];
    { const float z = OZ();
#pragma unroll
    for (int a = 0; a < 2; ++a)
#pragma unroll
        for (int b = 0; b < 2; ++b)
#pragma unroll
            for (int m = 0; m < 4; ++m)
#pragma unroll
                for (int n = 0; n < 2; ++n) acc[a][b][m][n] = (f32x4){z, z, z, z}; }
    bf16x8 At[4][2], B0[2][2], B1[2][2];
    const char* cA = (const char*)g.A + (size_t)cur.pm * tstepA; const char* cB = (const char*)g.Bt + (size_t)cur.pn * tstepB;
    PG8_STAGE(PG8_SB(0, 0), cB, voffB); PG8_STAGE(PG8_SA(0, 0), cA, voffA); PG8_STAGE(PG8_SB(0, 1), cB + hstepB, voffB); PG8_STAGE(PG8_SA(0, 1), cA + hstepA, voffA);
    if (wr == 1) PG8_BAR;
    PG8_WAIT_V(4); PG8_BAR;
    PG8_STAGE(PG8_SB(1, 0), cB + kstep, voffB); PG8_STAGE(PG8_SA(1, 0), cA + kstep, voffA); PG8_STAGE(PG8_SB(1, 1), cB + hstepB + kstep, voffB);
    PG8_WAIT_V(6); PG8_BAR;
    for (;;) {
        const bool has_next = S.next(ui + 1, nxt);
        const char* nA = has_next ? (const char*)g.A + (size_t)nxt.pm * tstepA : cA; const char* nB = has_next ? (const char*)g.Bt + (size_t)nxt.pn * tstepB : cB;
        for (int t = 0; t < nt; t += 2) {
            if (g.epi == 11 && (t == 16 || t == 24)) up_rescale(acc, cur, wr, wc, fr, fq, t == 16 ? 0 : 2048);
            const bool last = (t == nt - 2);
            const char* a1 = cA + (size_t)(t + 1) * kstep;
            const char* a2 = last ? nA : cA + (size_t)(t + 2) * kstep; const char* b2 = last ? nB : cB + (size_t)(t + 2) * kstep;
            const char* a3 = a2 + kstep; const char* b3 = b2 + kstep;
            PG8_LDB(B0, 0, 0); PG8_SCHED; PG8_LDA(At, 0, 0); PG8_STAGE(PG8_SA(1, 1), a1 + hstepA, voffA);
            PG8_WAIT_L(8); PG8_BAR; PG8_WAIT_L(0); PG8_MMA(0, 0, At, B0); PG8_BAR; PG8_SCHED;
            PG8_LDB(B1, 0, 1); PG8_STAGE(PG8_SB(0, 0), b2, voffB);
            PG8_BAR; PG8_WAIT_L(0); PG8_MMA(0, 1, At, B1); PG8_BAR;
            PG8_LDA(At, 0, 1); PG8_STAGE(PG8_SA(0, 0), a2, voffA);
            PG8_BAR; PG8_WAIT_L(0); PG8_MMA(1, 0, At, B0); PG8_BAR; PG8_SCHED;
            PG8_STAGE(PG8_SB(0, 1), b2 + hstepB, voffB);
            PG8_WAIT_V(6); PG8_BAR; PG8_MMA(1, 1, At, B1); PG8_BAR;
            PG8_LDB(B0, 1, 0); PG8_SCHED; PG8_LDA(At, 1, 0); PG8_STAGE(PG8_SA(0, 1), a2 + hstepA, voffA);
            PG8_WAIT_L(8); PG8_BAR; PG8_WAIT_L(0); PG8_MMA(0, 0, At, B0); PG8_BAR; PG8_SCHED;
            PG8_LDB(B1, 1, 1); PG8_STAGE(PG8_SB(1, 0), b3, voffB);
            PG8_BAR; PG8_WAIT_L(0); PG8_MMA(0, 1, At, B1); PG8_BAR;
            PG8_LDA(At, 1, 1); PG8_STAGE(PG8_SA(1, 0), a3, voffA);
            PG8_BAR; PG8_WAIT_L(0); PG8_MMA(1, 0, At, B0); PG8_BAR; PG8_SCHED;
            PG8_STAGE(PG8_SB(1, 1), b3 + hstepB, voffB);
            PG8_WAIT_V(6); PG8_BAR; PG8_MMA(1, 1, At, B1); PG8_BAR;
        }
        epi_run(g, acc, cur, wr, wc, fr, fq);
        if (!has_next) break;
        { const float z = OZ();
#pragma unroll
        for (int a = 0; a < 2; ++a)
#pragma unroll
            for (int b = 0; b < 2; ++b)
#pragma unroll
                for (int m = 0; m < 4; ++m)
#pragma unroll
                    for (int n = 0; n < 2; ++n) acc[a][b][m][n] = (f32x4){z, z, z, z}; }
        cur = nxt; cA = nA; cB = nB; ++ui;
    }
    PG8_WAIT_V(0);
    if (wr == 0) PG8_BAR;
    PG8_BAR;
#undef PG8_SA
#undef PG8_SB
#undef PG8_STAGE
#undef PG8_LDA
#undef PG8_LDB
#undef PG8_MMA
#undef PG8_WAIT_V
#undef PG8_WAIT_L
#undef PG8_BAR
#undef PG8_SCHED
}
}
using pg8::Unit;
using pg8::cvt_pk_bf16;

#define EPI_FOR_NP(...) \
    _Pragma("unroll") for (int ai = 0; ai < 2; ++ai) _Pragma("unroll") for (int m = 0; m < 4; ++m) { const int row = u.pm * 256 + ai * 128 + wr * 64 + m * 16 + fr; \
    _Pragma("unroll") for (int bj = 0; bj < 2; ++bj) _Pragma("unroll") for (int n = 0; n < 2; ++n) { const int col = u.pn * 256 + bj * 128 + wc * 32 + n * 16 + 4 * fq; const f32x4 v = acc[ai][bj][m][n]; __VA_ARGS__ } }

typedef const f32x4 (&AccRef)[2][2][4][2];

struct EpiWin {
    static constexpr bool PERM = false;
    bh* zg; float* zf;
    __device__ __forceinline__ void operator()(AccRef acc, const Unit& u, int wr, int wc, int fr, int fq) const {
        if (u.pn < 24) {
            EPI_FOR_NP({ u32x2 w; w.x = cvt_pk_bf16(fmaxf(sigmoidf_(v[0]), 1e-6f), fmaxf(sigmoidf_(v[1]), 1e-6f)); w.y = cvt_pk_bf16(fmaxf(sigmoidf_(v[2]), 1e-6f), fmaxf(sigmoidf_(v[3]), 1e-6f)); *(u32x2*)(zg + (size_t)row * NGATE + col) = w; })
        } else {
            EPI_FOR_NP({ *(f32x4*)(zf + (size_t)row * ZF_LD + (col - NGATE)) = v; })
        }
    }
};
struct EpiLoraW {
    static constexpr bool PERM = false;
    const float* w0; float* rw;
    __device__ __forceinline__ void operator()(AccRef acc, const Unit& u, int wr, int wc, int fr, int fq) const {
        EPI_FOR_NP({ const f32x4 b = *(const f32x4*)(w0 + col); f32x4 o;
            _Pragma("unroll") for (int j = 0; j < 4; ++j) { const float x = -(b[j] + v[j]); const float sp = fmaxf(x, 0.f) + log1pf(__expf(-fabsf(x))); o[j] = __expf(-__expf(-sp - 0.5f)); }
            *(f32x4*)(rw + (size_t)row * 512 + col) = o; })
    }
};
struct EpiLoraA {
    static constexpr bool PERM = false;
    const float* a0; const float* ka; const float* rkk; float* rb; float* rk;
    __device__ __forceinline__ void operator()(AccRef acc, const Unit& u, int wr, int wc, int fr, int fq) const {
        EPI_FOR_NP({ const f32x4 b0 = *(const f32x4*)(a0 + col); const f32x4 kav = *(const f32x4*)(ka + col); const size_t o = (size_t)row * 512 + col;
            const f32x4 kkv = *(const f32x4*)(rkk + o); f32x4 kv = *(const f32x4*)(rk + o); f32x4 bo;
            _Pragma("unroll") for (int j = 0; j < 4; ++j) { const float a = sigmoidf_(b0[j] + v[j]); bo[j] = kkv[j] * a; kv[j] = kv[j] * (1.0f + (a - 1.0f) * kav[j]); }
            *(f32x4*)(rb + o) = bo; *(f32x4*)(rk + o) = kv; })
    }
};
struct EpiStoreF32 {
    static constexpr bool PERM = false;
    float* o; int ld;
    __device__ __forceinline__ void operator()(AccRef acc, const Unit& u, int wr, int wc, int fr, int fq) const {
        EPI_FOR_NP({ *(f32x4*)(o + (size_t)row * ld + col) = v; })
    }
};
struct EpiGlu {
    static constexpr bool PERM = false;
    const bh* ys; const float* gb; bh* ycat;
    __device__ __forceinline__ void operator()(AccRef acc, const Unit& u, int wr, int wc, int fr, int fq) const {
        EPI_FOR_NP({ const f32x4 b = *(const f32x4*)(gb + col); const u32x2 y2 = *(const u32x2*)(ys + (size_t)row * 512 + col);
            const float y0 = __uint_as_float(y2.x << 16), y1 = __uint_as_float(y2.x & 0xffff0000u), y2f = __uint_as_float(y2.y << 16), y3 = __uint_as_float(y2.y & 0xffff0000u);
            u32x2 w; w.x = cvt_pk_bf16(y0 * sigmoidf_(v[0] + b[0]), y1 * sigmoidf_(v[1] + b[1])); w.y = cvt_pk_bf16(y2f * sigmoidf_(v[2] + b[2]), y3 * sigmoidf_(v[3] + b[3]));
            *(u32x2*)(ycat + (size_t)row * D + 1536 + col) = w; })
    }
};
template <int MODE> struct EpiUp {
    static constexpr bool PERM = false;
    const bh* zg; float* mix; bh* mixed;
    __device__ __forceinline__ void operator()(AccRef acc, const Unit& u, int wr, int wc, int fr, int fq) const {
        EPI_FOR_NP({ const u32x2 g2 = *(const u32x2*)(zg + (size_t)row * NGATE + col);
            f32x4 g; g[0] = __uint_as_float(g2.x << 16); g[1] = __uint_as_float(g2.x & 0xffff0000u); g[2] = __uint_as_float(g2.y << 16); g[3] = __uint_as_float(g2.y & 0xffff0000u);
            f32x4 r = g * v; float* mp = mix + (size_t)row * D + col;
            if (MODE >= 1) r += *(const f32x4*)mp;
            if (MODE <= 1) *(f32x4*)mp = r;
            else { u32x2 w; w.x = cvt_pk_bf16(r[0], r[1]); w.y = cvt_pk_bf16(r[2], r[3]); *(u32x2*)(mixed + (size_t)row * D + col) = w; } })
    }
};
struct EpiUpF {
    static constexpr bool PERM = false;
    const bh* zg; bh* mixed;
    __device__ __forceinline__ void operator()(AccRef acc, const Unit& u, int wr, int wc, int fr, int fq) const {
        EPI_FOR_NP({ const u32x2 g2 = *(const u32x2*)(zg + (size_t)row * NGATE + col);
            u32x2 w; w.x = cvt_pk_bf16(__uint_as_float(g2.x << 16) * v[0], __uint_as_float(g2.x & 0xffff0000u) * v[1]); w.y = cvt_pk_bf16(__uint_as_float(g2.y << 16) * v[2], __uint_as_float(g2.y & 0xffff0000u) * v[3]);
            *(u32x2*)(mixed + (size_t)row * D + col) = w; })
    }
};
struct EpiRes {
    static constexpr bool PERM = false;
    float* h;
    __device__ __forceinline__ void operator()(AccRef acc, const Unit& u, int wr, int wc, int fr, int fq) const {
        EPI_FOR_NP({ float* hp = h + (size_t)row * D + col; *(f32x4*)hp = *(const f32x4*)hp + v; })
    }
};
struct EpiFfn {
    static constexpr bool PERM = true;
    bh* act;
    __device__ __forceinline__ void operator()(AccRef acc, const Unit& u, int wr, int wc, int fr, int fq) const {
#pragma unroll
        for (int ai = 0; ai < 2; ++ai)
#pragma unroll
            for (int m = 0; m < 4; ++m) { const int row = u.pm * 256 + ai * 128 + wr * 64 + m * 16 + fr; const int col = u.pn * 128 + wc * 32 + 8 * fq;
                float o[8];
#pragma unroll
                for (int n = 0; n < 2; ++n)
#pragma unroll
                    for (int j = 0; j < 4; ++j) { const float gte = acc[ai][0][m][n][j], up = acc[ai][1][m][n][j]; o[n * 4 + j] = gte * sigmoidf_(gte) * up; }
                u32x4 w; w.x = cvt_pk_bf16(o[0], o[1]); w.y = cvt_pk_bf16(o[2], o[3]); w.z = cvt_pk_bf16(o[4], o[5]); w.w = cvt_pk_bf16(o[6], o[7]);
                *(u32x4*)(act + (size_t)row * FH + col) = w; }
    }
};
struct EpiPle {
    static constexpr bool PERM = false;
    float* h; const float* tmp;
    __device__ __forceinline__ void operator()(AccRef acc, const Unit& u, int wr, int wc, int fr, int fq) const {
        EPI_FOR_NP({ float* hp = h + (size_t)row * D + col; const f32x4 tv = *(const f32x4*)(tmp + (size_t)row * D + col); f32x4 hv = *(const f32x4*)hp;
            _Pragma("unroll") for (int j = 0; j < 4; ++j) hv[j] += tv[j] * sigmoidf_(v[j]);
            *(f32x4*)hp = hv; })
    }
};

namespace pg8 {
__device__ __forceinline__ void epi_run(const Gemm& g, const f32x4 (&acc)[2][2][4][2], const Unit& u, int wr, int wc, int fr, int fq) {
    unsigned char* ws = P_WS; const int L = g.L;
    switch (g.epi) {
    case 0: { EpiWin E{(bh*)(ws + OFF_ZG), (float*)(ws + OFF_ZF)}; E(acc, u, wr, wc, fr, fq); } break;
    case 1: { EpiLoraW E{P_IN(9) + L * 512, (float*)(ws + OFF_RW)}; E(acc, u, wr, wc, fr, fq); } break;
    case 2: { EpiLoraA E{P_IN(11) + L * 512, P_IN(15) + L * 512, (const float*)(ws + OFF_RKK), (float*)(ws + OFF_RB), (float*)(ws + OFF_RK)}; E(acc, u, wr, wc, fr, fq); } break;
    case 3: { EpiStoreF32 E{(float*)(ws + (g.N == 512 ? OFF_RG : OFF_MIX32)), g.N}; E(acc, u, wr, wc, fr, fq); } break;
    case 4: { EpiGlu E{(const bh*)(ws + OFF_YS), P_IN(28) + L * 512, (bh*)(ws + OFF_YCAT)}; E(acc, u, wr, wc, fr, fq); } break;
    case 5: { EpiUp<0> E{(const bh*)(ws + OFF_ZG), (float*)(ws + OFF_MIX32), (bh*)(ws + OFF_ABF)}; E(acc, u, wr, wc, fr, fq); } break;
    case 6: { EpiUp<1> E{(const bh*)(ws + OFF_ZG) + 2048, (float*)(ws + OFF_MIX32), (bh*)(ws + OFF_ABF)}; E(acc, u, wr, wc, fr, fq); } break;
    case 7: { EpiUp<2> E{(const bh*)(ws + OFF_ZG) + 4096, (float*)(ws + OFF_MIX32), (bh*)(ws + OFF_ABF)}; E(acc, u, wr, wc, fr, fq); } break;
    case 8: { EpiRes E{P_OUT}; E(acc, u, wr, wc, fr, fq); } break;
    case 9: { EpiFfn E{(bh*)(ws + OFF_ACT)}; E(acc, u, wr, wc, fr, fq); } break;
    case 11: { EpiUpF E{(const bh*)(ws + OFF_ZG) + 4096, (bh*)(ws + OFF_ABF)}; E(acc, u, wr, wc, fr, fq); } break;
    default: { EpiPle E{P_OUT, (const float*)(ws + OFF_MIX32)}; E(acc, u, wr, wc, fr, fq); } break;
    }
}
}

__device__ __forceinline__ bool make_gemm(const Params& p, int L, int q, int i, pg8::Gemm& g) {
    unsigned char* ws = P_WS;
    g.M = T; g.perm = 0; g.L = L;
    switch (q) {
    case 1: if (i > 0) return false;
        g.A = (const bh*)(ws + OFF_ABF); g.lda = D; g.Bt = (const bh*)(ws + OFF_WIN); g.ldb = D; g.N = NINP; g.K = D; g.epi = 0; return true;
    case 3: if (i > 2) return false;
        g.lda = 256; g.ldb = 256; g.N = 512; g.K = 256;
        if (i == 0) { g.A = (const bh*)(ws + OFF_LAW); g.Bt = (const bh*)(ws + OFF_WW2); g.epi = 1; }
        else if (i == 1) { g.A = (const bh*)(ws + OFF_LAA); g.Bt = (const bh*)(ws + OFF_WA2); g.epi = 2; }
        else { g.A = (const bh*)(ws + OFF_LAG); g.Bt = (const bh*)(ws + OFF_WG2); g.epi = 3; }
        return true;
    case 5: if (i > 0) return false;
        g.A = (const bh*)(ws + OFF_YS); g.lda = 512; g.Bt = (const bh*)(ws + OFF_WGLU); g.ldb = 512; g.N = 512; g.K = 512; g.epi = 4; return true;
    case 6: if (i > 0) return false;
        g.A = (const bh*)(ws + OFF_YCAT); g.lda = D; g.Bt = (const bh*)(ws + OFF_WUP); g.ldb = D; g.N = D; g.K = D; g.epi = 11; return true;
    case 7: if (i > 0) return false;
        g.A = (const bh*)(ws + OFF_ABF); g.lda = D; g.Bt = (const bh*)(ws + OFF_WO); g.ldb = D; g.N = D; g.K = D; g.epi = 8; return true;
    case 9: if (i > 0) return false;
        g.A = (const bh*)(ws + OFF_ABF); g.lda = D; g.Bt = (const bh*)(ws + OFF_WGU); g.ldb = D; g.N = 2 * FH; g.K = D; g.epi = 9; g.perm = 1; return true;
    case 10: if (i > 0) return false;
        g.A = (const bh*)(ws + OFF_ACT); g.lda = FH; g.Bt = (const bh*)(ws + OFF_WD); g.ldb = FH; g.N = D; g.K = FH; g.epi = 8; return true;
    case 12: if (i > 1) return false;
        if (i == 0) { g.A = (const bh*)(ws + OFF_PBF) + (size_t)L * T * 256; g.lda = 256; g.Bt = (const bh*)(ws + OFF_WPP); g.ldb = 256; g.N = D; g.K = 256; g.epi = 3; }
        else { g.A = (const bh*)(ws + OFF_ABF); g.lda = D; g.Bt = (const bh*)(ws + OFF_WPG); g.ldb = D; g.N = D; g.K = D; g.epi = 10; }
        return true;
    default: return false;
    }
}

struct CJ { const float* src; int in_idx, src_ld, kv, n0, nv; long lstride; size_t dst; int dst_ld, r0, c0, npad, kpad, seg, segstride; };
constexpr int BIGSEG = 1 << 30;
__constant__ int JT_I[15][12] = {
    {3, NIN, 2048, NF, NGATE, D, 0, 0, NGATE, 2048, BIGSEG, 0},
    {3, NIN, 2048, 0, NF, D, NGATE, 0, 6656, 2048, BIGSEG, 0},
    {29, D, 1024, 0, D, D, 0, 0, D, 1024, BIGSEG, 0},
    {30, D, 512, 0, D, D, 0, 1024, D, 512, BIGSEG, 0},
    {31, D, 512, 0, D, D, 0, 1536, D, 512, BIGSEG, 0},
    {32, D, 2048, 0, D, D, 0, 0, D, 2048, BIGSEG, 0},
    {34, FH, 2048, 0, FH, D, 0, 0, FH, 2048, 128, 256},
    {35, FH, 2048, 0, FH, D, 128, 0, FH, 2048, 128, 256},
    {36, D, FH, 0, D, FH, 0, 0, D, FH, BIGSEG, 0},
    {38, D, 2048, 0, D, D, 0, 0, D, 2048, BIGSEG, 0},
    {39, D, 256, 0, D, 256, 0, 0, D, 256, BIGSEG, 0},
    {27, 512, 512, 0, 512, 512, 0, 0, 512, 512, BIGSEG, 0},
    {10, 512, 96, 0, 512, 256, 0, 0, 512, 256, BIGSEG, 0},
    {12, 512, 96, 0, 512, 256, 0, 0, 512, 256, BIGSEG, 0},
    {13, 512, 256, 0, 512, 256, 0, 0, 512, 256, BIGSEG, 0}};
__constant__ long JT_L[15][2] = {
    {(long)D * NIN, (long)OFF_WIN}, {(long)D * NIN, (long)OFF_WIN}, {(long)1024 * D, (long)OFF_WUP}, {(long)512 * D, (long)OFF_WUP}, {(long)512 * D, (long)OFF_WUP},
    {(long)D * D, (long)OFF_WO}, {(long)D * FH, (long)OFF_WGU}, {(long)D * FH, (long)OFF_WGU}, {(long)FH * D, (long)OFF_WD}, {(long)D * D, (long)OFF_WPG},
    {(long)256 * D, (long)OFF_WPP}, {(long)512 * 512, (long)OFF_WGLU}, {(long)96 * 512, (long)OFF_WW2}, {(long)96 * 512, (long)OFF_WA2}, {(long)256 * 512, (long)OFF_WG2}};
__device__ __forceinline__ void get_job(int j, CJ& J) {
    J.in_idx = JT_I[j][0]; J.src_ld = JT_I[j][1]; J.kv = JT_I[j][2]; J.n0 = JT_I[j][3]; J.nv = JT_I[j][4]; J.dst_ld = JT_I[j][5]; J.r0 = JT_I[j][6]; J.c0 = JT_I[j][7];
    J.npad = JT_I[j][8]; J.kpad = JT_I[j][9]; J.seg = JT_I[j][10]; J.segstride = JT_I[j][11]; J.lstride = JT_L[j][0]; J.dst = (size_t)JT_L[j][1];
}
__device__ __forceinline__ const float* in_by_idx(const Params& p, int i) { return P_IN(i); }
constexpr int NJOBS = 15;

__device__ __forceinline__ void conv_tile(int L, const CJ& J, int tile, int lane, bh* dstbase) {
    const int nkt = J.kpad / 64; const int tn = tile / nkt, tk = tile % nkt;
    const float* src = J.src + (size_t)L * J.lstride;
    const int cq = lane & 15, r = lane >> 4;
    const int nl = tn * 64 + cq * 4; const bool nok = nl < J.nv;
    const int k0 = tk * 64 + 16 * r;
    f32x4 v[16];
    const float* sp = src + (size_t)k0 * J.src_ld + J.n0 + nl;
    const float zc = OZ();
#pragma unroll
    for (int i = 0; i < 16; ++i) { v[i] = (f32x4){zc, zc, zc, zc}; if (nok && (k0 + i) < J.kv) v[i] = *(const f32x4*)(sp + (size_t)i * J.src_ld); }
#pragma unroll
    for (int j = 0; j < 4; ++j) { const int n = nl + j; const int drow = J.r0 + (n / J.seg) * J.segstride + (n % J.seg);
        u32x4 w0, w1;
        w0.x = cvt_pk_bf16(v[0][j], v[1][j]); w0.y = cvt_pk_bf16(v[2][j], v[3][j]); w0.z = cvt_pk_bf16(v[4][j], v[5][j]); w0.w = cvt_pk_bf16(v[6][j], v[7][j]);
        w1.x = cvt_pk_bf16(v[8][j], v[9][j]); w1.y = cvt_pk_bf16(v[10][j], v[11][j]); w1.z = cvt_pk_bf16(v[12][j], v[13][j]); w1.w = cvt_pk_bf16(v[14][j], v[15][j]);
        bh* d = dstbase + (size_t)drow * J.dst_ld + J.c0 + k0;
        *(u32x4*)d = w0; *(u32x4*)(d + 8) = w1; }
}

__device__ __forceinline__ void rms_row_bf16(const float* x, const float* g, bh* o, int lane) {
    f32x4 v[8]; float s = 0.f;
#pragma unroll
    for (int j = 0; j < 8; ++j) { v[j] = *(const f32x4*)(x + j * 256 + lane * 4); s += (v[j][0] * v[j][0] + v[j][1] * v[j][1]) + (v[j][2] * v[j][2] + v[j][3] * v[j][3]); }
    const float rstd = rsqrtf(wave_sum(s) * (1.0f / D) + 1e-6f);
#pragma unroll
    for (int j = 0; j < 8; ++j) { const f32x4 gg = *(const f32x4*)(g + j * 256 + lane * 4); u32x2 w; w.x = pk2(v[j][0] * rstd * gg[0], v[j][1] * rstd * gg[1]); w.y = pk2(v[j][2] * rstd * gg[2], v[j][3] * rstd * gg[3]);
        *(u32x2*)(o + j * 256 + lane * 4) = w; }
}
__device__ __forceinline__ void phase_rmsnorm(const Params& p, const float* g) {
    const int gw = BIDX() * 8 + (TIDX() >> 6), NGW = GDIM() * 8, lane = TIDX() & 63;
    bh* abf = (bh*)(P_WS + OFF_ABF);
    for (int r = gw; r < T; r += NGW) rms_row_bf16(P_OUT + (size_t)r * D, g, abf + (size_t)r * D, lane);
}

__device__ __forceinline__ void phase_conv(const Params& p, int L, LAS unsigned char* lds) {
    const int tid = TIDX();
    {   const int gw0 = BIDX() * 8 + (tid >> 6), NGW0 = GDIM() * 8, ln = tid & 63;
        int base = 0;
        for (int j = 0; j < NJOBS; ++j) { CJ J; get_job(j, J); J.src = in_by_idx(p, J.in_idx); const int ntile = (J.npad / 64) * (J.kpad / 64);
            int first = gw0 - (base % NGW0); if (first < 0) first += NGW0;
            bh* dstbase = (bh*)(P_WS + J.dst);
            for (int t = first; t < ntile; t += NGW0) conv_tile(L, J, t, ln, dstbase);
            base += ntile; } }
    const int gw = BIDX() * 8 + (tid >> 6), NGW = GDIM() * 8, lane = tid & 63;
    bh* abf = (bh*)(P_WS + OFF_ABF);
    if (L == 0) {
        const float* ps = P_IN(1); bh* pb = (bh*)(P_WS + OFF_PBF);
        for (size_t i = (size_t)BIDX() * 512 + tid; i < (size_t)2 * T * 256 / 4; i += (size_t)GDIM() * 512) { const f32x4 v = ((const f32x4*)ps)[i]; u32x2 w; w.x = pk2(v[0], v[1]); w.y = pk2(v[2], v[3]); ((u32x2*)pb)[i] = w; }
        const float* x = P_IN(0);
        for (int r = gw; r < T; r += NGW) {
#pragma unroll
            for (int j = 0; j < 8; ++j) *(f32x4*)(P_OUT + (size_t)r * D + j * 256 + lane * 4) = *(const f32x4*)(x + (size_t)r * D + j * 256 + lane * 4);
            rms_row_bf16(x + (size_t)r * D, P_IN(2), abf + (size_t)r * D, lane);
        }
    } else {
        for (int r = gw; r < T; r += NGW) rms_row_bf16(P_OUT + (size_t)r * D, P_IN(2) + (size_t)L * D, abf + (size_t)r * D, lane);
    }
}

struct S5C { float ar, ai; float br[16], bi[16]; };
__device__ __forceinline__ void s5_setup(const Params& p, int L, int g, int n, S5C& c) {
    const int gi = L * 32 + g;
    const float dt = __expf(P_IN(21)[gi]);
    const float are = P_IN(19)[gi * 64 + n], aim = P_IN(20)[gi * 64 + n];
    const float mag = __expf(are * dt), ang = aim * dt;
    float sn, cs;
    {
        const double a = (double)ang; const double k = rint(a * 0.15915494309189535); const float r = (float)(a - k * 6.283185307179586);
        sn = sinf(r); cs = cosf(r);
    }
    c.ar = mag * cs; c.ai = mag * sn;
    const float den = are * are + aim * aim, nr = c.ar - 1.0f, ni = c.ai;
    const float cr = (nr * are + ni * aim) / den, ci = (ni * are - nr * aim) / den;
    const float* bre = P_IN(22) + ((size_t)gi * 64 + n) * 16; const float* bim = P_IN(23) + ((size_t)gi * 64 + n) * 16;
#pragma unroll
    for (int q = 0; q < 4; ++q) { const f32x4 r4 = *(const f32x4*)(bre + q * 4), i4 = *(const f32x4*)(bim + q * 4);
#pragma unroll
        for (int j = 0; j < 4; ++j) { c.br[q * 4 + j] = cr * r4[j] - ci * i4[j]; c.bi[q * 4 + j] = cr * i4[j] + ci * r4[j]; } }
}
__device__ __forceinline__ void s5_step(const S5C& c, const LAS float* urow, float& sr, float& si) {
    float xr = 0.f, xi = 0.f;
#pragma unroll
    for (int q = 0; q < 4; ++q) { const f32x4 u4 = *(const LAS f32x4*)(urow + q * 4);
#pragma unroll
        for (int j = 0; j < 4; ++j) { xr = fmaf(u4[j], c.br[q * 4 + j], xr); xi = fmaf(u4[j], c.bi[q * 4 + j], xi); } }
    const float nr = c.ar * sr - c.ai * si + xr, ni = c.ar * si + c.ai * sr + xi;
    sr = nr; si = ni;
}
__device__ __forceinline__ void s5_stage_u(const float* zfc, LAS float* ul, int lane) {
    const float* src = zfc + (size_t)lane * ZF_LD;
    const f32x4 a = *(const f32x4*)src, b = *(const f32x4*)(src + 4), c = *(const f32x4*)(src + 8), d = *(const f32x4*)(src + 12);
    *(LAS f32x4*)(ul + lane * 16) = a; *(LAS f32x4*)(ul + lane * 16 + 4) = b; *(LAS f32x4*)(ul + lane * 16 + 8) = c; *(LAS f32x4*)(ul + lane * 16 + 12) = d;
    asm volatile("s_waitcnt lgkmcnt(0)" ::: "memory"); __builtin_amdgcn_wave_barrier();
}

__device__ __forceinline__ size_t fq_base(int h, int c, int mt, int ks8) { return ((((size_t)(h * NCH + c) * 4 + mt) * 8 + ks8) * 64) * 8; }
__device__ __forceinline__ size_t fq_off(int h, int t, int d) { const int s = t & 63; return fq_base(h, t >> 6, s >> 4, d >> 5) + ((s & 15) + 16 * ((d >> 3) & 3)) * 8 + (d & 7); }
__device__ __forceinline__ int ft_off(int row, int s8) { return ((((row >> 5) * 4 + (s8 >> 1)) * 64) + (row & 31) + 32 * (s8 & 1)) * 8; }

__device__ __forceinline__ void mlstm_prep(const Params& p, int L, int h, int c, LAS unsigned char* lds) {
    const int tid = TIDX(), t0 = c * 64;
    const float* zf = (const float*)(P_WS + OFF_ZF);
    LAS float* s_ws = (LAS float*)lds;
    if (tid < 64) {
        const int t = t0 + tid;
        float ig = zf[(size_t)t * ZF_LD + 4096 + h] + P_IN(5)[L * 4 + h];
        float fg = zf[(size_t)t * ZF_LD + 4100 + h] + P_IN(6)[L * 4 + h];
        ig = 15.0f * tanhf(ig * (1.0f / 15.0f)); fg = 15.0f * tanhf(fg * (1.0f / 15.0f));
        const float lf = fminf(fg, 0.f) - log1pf(__expf(-fabsf(fg)));
        float b = lf;
#pragma unroll
        for (int o = 1; o < 64; o <<= 1) { const float nb = bperm_f((tid - o) & 63, b); if (tid >= o) b += nb; }
        const float bend = bperm_f(63, b);
        const float wlog = bend - b + ig;
        const float mloc = wave_max(wlog);
        s_ws[tid] = __expf(wlog - mloc);
        ((float*)(P_WS + OFF_MI))[h * T + t] = ig; ((float*)(P_WS + OFF_MBB))[h * T + t] = b;
        if (tid == 0) { ((float*)(P_WS + OFF_MBEND))[h * NCH + c] = bend; ((float*)(P_WS + OFF_MLOC))[h * NCH + c] = mloc; }
    }
    __syncthreads();
    const int d = tid & 255, isk = tid >> 8;
    const int col = isk * 1024 + h * 256 + d;
    const float* cw = P_IN(4) + (size_t)L * 4 * 2048;
    const float w0 = cw[col], w1 = cw[2048 + col], w2 = cw[4096 + col], w3 = cw[6144 + col];
    float x1 = (t0 >= 1) ? zf[(size_t)(t0 - 1) * ZF_LD + col] : 0.f, x2 = (t0 >= 2) ? zf[(size_t)(t0 - 2) * ZF_LD + col] : 0.f, x3 = (t0 >= 3) ? zf[(size_t)(t0 - 3) * ZF_LD + col] : 0.f;
    bh* MQ = (bh*)(P_WS + OFF_MQ); bh* MK = (bh*)(P_WS + OFF_MK);
    bh* MT = (bh*)(P_WS + (isk ? OFF_MKT : OFF_MVT)) + (size_t)(h * NCH + c) * 16384;
    float dnacc = 0.f;
    for (int s8 = 0; s8 < 8; ++s8) {
        unsigned pk[4];
#pragma unroll
        for (int j = 0; j < 8; ++j) { const int s = s8 * 8 + j, t = t0 + s;
            const float x0 = zf[(size_t)t * ZF_LD + col]; float y = w0 * x0 + w1 * x1 + w2 * x2 + w3 * x3; x3 = x2; x2 = x1; x1 = x0;
            y = y * sigmoidf_(y);
            unsigned short e;
            if (!isk) { MQ[fq_off(h, t, d)] = f2bf(y * 0.0625f); e = f2bf(zf[(size_t)t * ZF_LD + 2048 + h * 256 + d]); }
            else { MK[fq_off(h, t, d)] = f2bf(y); const float wk = y * s_ws[s]; e = f2bf(wk); dnacc += wk; }
            if (j & 1) pk[j >> 1] |= ((unsigned)e << 16); else pk[j >> 1] = e; }
        u32x4 w; w.x = pk[0]; w.y = pk[1]; w.z = pk[2]; w.w = pk[3];
        *(u32x4*)(MT + ft_off(d, s8)) = w;
    }
    if (isk) ((float*)(P_WS + OFF_DN))[(size_t)(h * NCH + c) * 256 + d] = dnacc;
    __syncthreads();
}

__device__ __forceinline__ void rwkv_prep_token(const Params& p, int L, int t, int lane) {
    const float* zf = (const float*)(P_WS + OFF_ZF);
    const float* z = zf + (size_t)t * ZF_LD + ZR0; const float* zp = z - ZF_LD; const bool hp = t > 0;
    const float* mu = P_IN(8) + (size_t)L * 1984;
    float* RR = (float*)(P_WS + OFF_RR); float* RK = (float*)(P_WS + OFF_RK); float* RV = (float*)(P_WS + OFF_RV); float* RKK = (float*)(P_WS + OFF_RKK);
    const float* kkw = P_IN(14) + L * 512;
#pragma unroll
    for (int i = 0; i < 8; ++i) { const int c = i * 64 + lane;
        { const float a = z[c], b = hp ? zp[c] : 0.f; RR[(size_t)t * 512 + c] = a + (b - a) * mu[c]; }
        { const float a = z[1024 + c], b = hp ? zp[1024 + c] : 0.f; RV[(size_t)t * 512 + c] = a + (b - a) * mu[1024 + c]; }
        { const float a = z[512 + c], b = hp ? zp[512 + c] : 0.f; const float k = a + (b - a) * mu[512 + c]; RK[(size_t)t * 512 + c] = k;
          const float kkv = k * kkw[c]; const float ss = wave_sum(kkv * kkv); RKK[(size_t)t * 512 + c] = kkv / fmaxf(sqrtf(ss), 1e-12f); } }
    bh* LAW = (bh*)(P_WS + OFF_LAW) + (size_t)t * 256; bh* LAA = (bh*)(P_WS + OFF_LAA) + (size_t)t * 256; bh* LAG = (bh*)(P_WS + OFF_LAG) + (size_t)t * 256;
#pragma unroll
    for (int i = 0; i < 4; ++i) { const int j = i * 64 + lane;
        float vw = 0.f, va = 0.f;
        if (j < 96) { { const int c = 1536 + j; const float a = z[c], b = hp ? zp[c] : 0.f; vw = tanhf(a + (b - a) * mu[c]); }
                      { const int c = 1632 + j; const float a = z[c], b = hp ? zp[c] : 0.f; va = a + (b - a) * mu[c]; } }
        LAW[j] = f2bf(vw); LAA[j] = f2bf(va);
        { const int c = 1728 + j; const float a = z[c], b = hp ? zp[c] : 0.f; LAG[j] = f2bf(sigmoidf_(a + (b - a) * mu[c])); } }
}

__device__ __forceinline__ void s5_pass_a(const Params& p, int L, int g, int c, int lane, LAS float* ul) {
    const float* zf = (const float*)(P_WS + OFF_ZF) + (size_t)(c * 64) * ZF_LD + ZS0 + g * 16;
    s5_stage_u(zf, ul, lane);
    S5C k; s5_setup(p, L, g, lane, k);
    float sr = 0.f, si = 0.f;
#pragma unroll 8
    for (int s = 0; s < 64; ++s) s5_step(k, ul + s * 16, sr, si);
    asm volatile("s_waitcnt lgkmcnt(0)" ::: "memory"); __builtin_amdgcn_wave_barrier();
    float* se = (float*)(P_WS + OFF_SEND) + ((size_t)(g * NCH + c) * 64 + lane) * 2;
    se[0] = sr; se[1] = si;
}

__device__ __forceinline__ void phase_prep(const Params& p, int L, LAS unsigned char* lds) {
    const int wid = TIDX() >> 6, lane = TIDX() & 63;
    for (int it = BIDX(); it < 2048; it += GDIM()) {
        if (it < 512) mlstm_prep(p, L, it >> 7, it & 127, lds);
        else if (it < 1536) rwkv_prep_token(p, L, (it - 512) * 8 + wid, lane);
        else { const int w = (it - 1536) * 8 + wid; s5_pass_a(p, L, w >> 7, w & 127, lane, (LAS float*)lds + wid * 1024); }
    }
}

constexpr int RW_NS = 4, RW_LS = T / RW_NS, RW_NB = RW_LS / 16, RW_RING = 4, RW_SLOT = 16 * 384;
constexpr int RW_YOFF = RW_RING * RW_SLOT;
__device__ __forceinline__ void rwkv_scan(const Params& p, int b, LAS unsigned char* lds) {
    const int tid = TIDX(), wid = __builtin_amdgcn_readfirstlane(tid >> 6), lane = tid & 63;
    int j, h, rg;
    if (b < 32) { j = 0; h = b >> 2; rg = b & 3; } else { const int u = b - 32; j = 1 + (u >> 6); h = (u & 63) >> 3; rg = u & 7; }
    LAS float* ring = (LAS float*)lds;
    LAS float* ybuf = ring + RW_YOFF;
    const int tbase = j * RW_LS;
    const bool isP = rg >= 4;
    if (wid >= 4) {
        const int lw = wid - 4, lt = tid - 256;
        const float* gp[6]; unsigned lo[6];
#pragma unroll
        for (int i = 0; i < 6; ++i) { const int ii = lw * 6 + i, rowidx = ii * 4 + (lane >> 4), step = rowidx / 6, a = rowidx % 6, q = lane & 15;
            const int ai = (0x205314 >> (4 * a)) & 0xf;
            gp[i] = (const float*)(P_WS + OFF_RR + (size_t)ai * SZ_R) + (size_t)(tbase + step) * 512 + h * 64 + q * 4;
            lo[i] = (unsigned)ii * 256u; }
        float* OUT = (float*)(P_WS + (isP ? OFF_RZ : OFF_RY)) + (size_t)(tbase + (lt >> 4)) * 512 + h * 64 + (rg & 3) * 16 + (lt & 15);
#define RW_ISSUE(bi, sl) do { _Pragma("unroll") for (int _i = 0; _i < 6; ++_i) \
        __builtin_amdgcn_global_load_lds((const unsigned*)(gp[_i] + (size_t)(bi) * 16 * 512), (LAS unsigned*)(ring + (sl) * RW_SLOT + lo[_i]), 16, 0, 0); } while (0)
        RW_ISSUE(0, 0); RW_ISSUE(1, 1); RW_ISSUE(2, 2);
        asm volatile("s_waitcnt vmcnt(12)" ::: "memory"); __builtin_amdgcn_s_barrier();
        int sl = 3;
        for (int ib = 0; ib < RW_NB; ++ib) {
            if (ib + 3 < RW_NB) RW_ISSUE(ib + 3, sl);
            sl = (sl == RW_RING - 1) ? 0 : sl + 1;
            if (ib > 0) {
                const LAS float* yb = ybuf + ((ib - 1) & 1) * 4096 + lt * 16;
                const f32x4 a0 = *(const LAS f32x4*)yb, a1 = *(const LAS f32x4*)(yb + 4), a2 = *(const LAS f32x4*)(yb + 8), a3 = *(const LAS f32x4*)(yb + 12);
                const f32x4 sm = (a0 + a1) + (a2 + a3);
                OUT[(size_t)(ib - 1) * 16 * 512] = (sm[0] + sm[1]) + (sm[2] + sm[3]);
            }
            if (ib + 3 < RW_NB) asm volatile("s_waitcnt vmcnt(13)" ::: "memory");
            else asm volatile("s_waitcnt vmcnt(0)" ::: "memory");
            __builtin_amdgcn_s_barrier();
        }
        {   const LAS float* yb = ybuf + ((RW_NB - 1) & 1) * 4096 + lt * 16;
            const f32x4 a0 = *(const LAS f32x4*)yb, a1 = *(const LAS f32x4*)(yb + 4), a2 = *(const LAS f32x4*)(yb + 8), a3 = *(const LAS f32x4*)(yb + 12);
            const f32x4 sm = (a0 + a1) + (a2 + a3);
            OUT[(size_t)(RW_NB - 1) * 16 * 512] = (sm[0] + sm[1]) + (sm[2] + sm[3]); }
#undef RW_ISSUE
    } else {
        const int r16 = wid * 4 + (lane >> 4), kq = lane & 15, row = (rg & 3) * 16 + r16;
        f32x4 S;
#pragma unroll
        for (int e = 0; e < 4; ++e) S[e] = (isP && (kq * 4 + e == row)) ? 1.f : 0.f;
        const float vmask = isP ? 0.f : 1.f;
        __builtin_amdgcn_s_barrier();
        int sl = 0;
        for (int ib = 0; ib < RW_NB; ++ib) {
            const LAS float* bb = ring + sl * RW_SLOT;
            LAS float* yw = ybuf + (ib & 1) * 4096 + r16 * 16 + kq;
            f32x4 w4 = *(const LAS f32x4*)(bb + kq * 4), k4 = *(const LAS f32x4*)(bb + 64 + kq * 4), kk4 = *(const LAS f32x4*)(bb + 128 + kq * 4),
                  b4 = *(const LAS f32x4*)(bb + 192 + kq * 4), r4 = *(const LAS f32x4*)(bb + 256 + kq * 4);
            float vv = bb[320 + row];
#pragma unroll
            for (int s = 0; s < 16; ++s) {
                f32x4 w4n, k4n, kk4n, b4n, r4n; float vvn;
                if (s < 15) { const LAS float* q = bb + (s + 1) * 384;
                    w4n = *(const LAS f32x4*)(q + kq * 4); k4n = *(const LAS f32x4*)(q + 64 + kq * 4); kk4n = *(const LAS f32x4*)(q + 128 + kq * 4);
                    b4n = *(const LAS f32x4*)(q + 192 + kq * 4); r4n = *(const LAS f32x4*)(q + 256 + kq * 4); vvn = q[320 + row]; }
                __builtin_amdgcn_sched_barrier(0);
                float pd = (S[0] * kk4[0] + S[1] * kk4[1]) + (S[2] * kk4[2] + S[3] * kk4[3]);
                const f32x4 pre = S * w4 + (vv * vmask) * k4;
                pd = allreduce16(pd);
                S = pre - pd * b4;
                yw[s * 256] = (S[0] * r4[0] + S[1] * r4[1]) + (S[2] * r4[2] + S[3] * r4[3]);
                if (s < 15) { w4 = w4n; k4 = k4n; kk4 = kk4n; b4 = b4n; r4 = r4n; vv = vvn; }
            }
            sl = (sl == RW_RING - 1) ? 0 : sl + 1;
            asm volatile("s_waitcnt lgkmcnt(0)" ::: "memory");
            __builtin_amdgcn_s_barrier();
        }
        float* EN = (float*)(P_WS + (isP ? OFF_RPEND : OFF_RSEND)) + ((size_t)(h * 4 + j) * 64 + row) * 64 + kq * 4;
        *(f32x4*)EN = S;
    }
    __syncthreads();
}

struct MStage { bf16x8 q[4], k[4], v[4]; float bend, mloc; };
__device__ __forceinline__ void mstage_load(MStage& st, const bh* qp, const bh* kp, const bh* vp, const float* MBEND, const float* MLOC, int h, int c) {
#pragma unroll
    for (int ks = 0; ks < 4; ++ks) { st.q[ks] = *(const bf16x8*)(qp + (size_t)c * 16384 + ks * 512); st.k[ks] = *(const bf16x8*)(kp + (size_t)c * 16384 + ks * 512); st.v[ks] = *(const bf16x8*)(vp + (size_t)c * 16384 + ks * 512); }
    st.bend = MBEND[h * NCH + c]; st.mloc = MLOC[h * NCH + c];
}
__device__ __forceinline__ void mlstm_seq(const Params& p, int mb, LAS unsigned char* lds) {
    const int tid = TIDX(), wid = tid >> 6, lane = tid & 63;
    const int h = mb >> 3, jv = mb & 7;
    LAS bh* Cbf = (LAS bh*)lds;
    constexpr int CS = 264;
    for (int i = tid; i < 2 * 32 * CS / 2; i += 512) ((LAS unsigned*)Cbf)[i] = 0u;
    __syncthreads();
    const bh* MQ = (const bh*)(P_WS + OFF_MQ); const bh* MKT = (const bh*)(P_WS + OFF_MKT); const bh* MVT = (const bh*)(P_WS + OFF_MVT);
    const float* MBEND = (const float*)(P_WS + OFF_MBEND); const float* MLOC = (const float*)(P_WS + OFF_MLOC);
    f32x16 ct;
    { const float z = OZ();
#pragma unroll
    for (int i = 0; i < 16; ++i) ct[i] = z; }
    float m = 0.f;
    const int mt = wid >> 1, kh = wid & 1;
    float* MINTER = (float*)(P_WS + OFF_ABF);
    LAS float* It = (LAS float*)(lds + 2 * 32 * 264 * 2);
    const bh* qp = MQ + fq_base(h, 0, mt, kh * 4) + lane * 8;
    const bh* kp = MKT + (size_t)(h * NCH) * 16384 + (wid * 4 * 64 + lane) * 8;
    const bh* vp = MVT + (size_t)(h * NCH) * 16384 + (jv * 4 * 64 + lane) * 8;
    MStage s0, s1, s2;
    mstage_load(s0, qp, kp, vp, MBEND, MLOC, h, 0);
    mstage_load(s1, qp, kp, vp, MBEND, MLOC, h, 1);
#define MSTEP(SC, SL, CIDX) do { const int c = (CIDX); const int t0 = c * 64, cur = c & 1; \
        mstage_load(SL, qp, kp, vp, MBEND, MLOC, h, (c + 2 < NCH) ? c + 2 : NCH - 1); \
        const float mnew = fmaxf(SC.bend + m, SC.mloc), decay = __expf(SC.bend + m - mnew), scale = __expf(SC.mloc - mnew); \
        f32x4 r0 = {0.f, 0.f, 0.f, 0.f}, r1 = {0.f, 0.f, 0.f, 0.f}; \
        const LAS bh* cb = Cbf + cur * 32 * CS + (lane & 15) * CS + kh * 128 + (lane >> 4) * 8; \
        _Pragma("unroll") for (int ks = 0; ks < 4; ++ks) { const bf16x8 b0 = *(const LAS bf16x8*)(cb + ks * 32), b1 = *(const LAS bf16x8*)(cb + 16 * CS + ks * 32); r0 = MFMA16(SC.q[ks], b0, r0); r1 = MFMA16(SC.q[ks], b1, r1); } \
        {     \
            if (c > 0) { const LAS float* ip = It + ((c - 1) & 1) * (2 * 64 * 36) + (tid >> 3) * 36 + (tid & 7) * 4; \
                const f32x4 sv = *(const LAS f32x4*)ip + *(const LAS f32x4*)(ip + 64 * 36); \
                float* o = MINTER + (size_t)(t0 - 64 + (tid >> 3)) * 1024 + h * 256 + jv * 32 + (tid & 7) * 4; \
                asm volatile("global_store_dwordx4 %0, %1, off\n\ts_nop 1" :: "v"(o), "v"(sv) : "memory"); } \
            LAS float* iw = It + cur * (2 * 64 * 36) + kh * (64 * 36) + (mt * 16 + (lane >> 4) * 4) * 36 + (lane & 15); \
            _Pragma("unroll") for (int r = 0; r < 4; ++r) { iw[r * 36] = r0[r]; iw[r * 36 + 16] = r1[r]; } } \
        f32x16 d0; { const float z = OZ(); _Pragma("unroll") for (int i = 0; i < 16; ++i) d0[i] = z; } \
        _Pragma("unroll") for (int ks = 0; ks < 4; ++ks) d0 = MFMA32(SC.k[ks], SC.v[ks], d0); \
        _Pragma("unroll") for (int i = 0; i < 16; ++i) ct[i] = decay * ct[i] + scale * d0[i]; \
        m = mnew; \
        {   LAS bh* o0 = Cbf + (cur ^ 1) * 32 * CS + (lane & 31) * CS + wid * 32 + 4 * (lane >> 5); \
            _Pragma("unroll") for (int g = 0; g < 4; ++g) { u32x2 w0; w0.x = cvt_pk_bf16(ct[4 * g], ct[4 * g + 1]); w0.y = cvt_pk_bf16(ct[4 * g + 2], ct[4 * g + 3]); *(LAS u32x2*)(o0 + 8 * g) = w0; } } \
        asm volatile("s_waitcnt lgkmcnt(0)" ::: "memory"); __builtin_amdgcn_s_barrier(); asm volatile("" ::: "memory"); } while (0)
    for (int c3 = 0; c3 < 126; c3 += 6) { MSTEP(s0, s2, c3); MSTEP(s1, s0, c3 + 1); MSTEP(s2, s1, c3 + 2); MSTEP(s0, s2, c3 + 3); MSTEP(s1, s0, c3 + 4); MSTEP(s2, s1, c3 + 5); }
    MSTEP(s0, s2, 126); MSTEP(s1, s0, 127);
#undef MSTEP
    {   const LAS float* ip = It + (127 & 1) * (2 * 64 * 36) + (tid >> 3) * 36 + (tid & 7) * 4;
        const f32x4 sv = *(const LAS f32x4*)ip + *(const LAS f32x4*)(ip + 64 * 36);
        *(f32x4*)(MINTER + (size_t)(127 * 64 + (tid >> 3)) * 1024 + h * 256 + jv * 32 + (tid & 7) * 4) = sv; }
    asm volatile("s_waitcnt vmcnt(0)" ::: "memory");
    __syncthreads();
}

__device__ __forceinline__ void mlstm_nscan(const Params& p) {
    const float* MBEND = (const float*)(P_WS + OFF_MBEND); const float* MLOC = (const float*)(P_WS + OFF_MLOC);
    const float* DN = (const float*)(P_WS + OFF_DN); float* NST = (float*)(P_WS + OFF_NST); float* MSTART = (float*)(P_WS + OFF_MSTART);
    for (int idx = TIDX(); idx < 1024; idx += 512) { const int h = idx >> 8, d = idx & 255; float m = 0.f, n = 0.f;
#pragma unroll 8
        for (int c = 0; c < NCH; ++c) { if (d == 0) MSTART[h * NCH + c] = m; NST[(size_t)(h * NCH + c) * 256 + d] = n;
            const float bend = MBEND[h * NCH + c], mloc = MLOC[h * NCH + c]; const float mnew = fmaxf(bend + m, mloc);
            n = __expf(bend + m - mnew) * n + __expf(mloc - mnew) * DN[(size_t)(h * NCH + c) * 256 + d]; m = mnew; } }
}

__device__ __forceinline__ float gelu_tanh(float x) { const float u = 0.7978845608028654f * (x + 0.044715f * x * x * x); return 0.5f * x * (1.0f + tanhf(u)); }

__device__ __forceinline__ void s5_pass_c(const Params& p, int L, int g, int c, int lane, LAS bh* img, LAS float* ul) {
    const float* zf = (const float*)(P_WS + OFF_ZF) + (size_t)(c * 64) * ZF_LD + ZS0 + g * 16;
    s5_stage_u(zf, ul, lane);
    S5C k; s5_setup(p, L, g, lane, k);
    float sr = 0.f, si = 0.f;
    {   float pr = k.ar, pi = k.ai;
#pragma unroll
        for (int i = 0; i < 6; ++i) { const float nr = pr * pr - pi * pi, ni = 2.f * pr * pi; pr = nr; pi = ni; }
        const float* se = (const float*)(P_WS + OFF_SEND) + ((size_t)(g * NCH) * 64 + lane) * 2;
        int cc = 0;
        for (; cc + 8 <= c; cc += 8) { float er[8], ei[8];
#pragma unroll
            for (int j = 0; j < 8; ++j) { er[j] = se[(size_t)(cc + j) * 128]; ei[j] = se[(size_t)(cc + j) * 128 + 1]; }
#pragma unroll
            for (int j = 0; j < 8; ++j) { const float nr = pr * sr - pi * si + er[j], ni = pr * si + pi * sr + ei[j]; sr = nr; si = ni; } }
        for (; cc < c; ++cc) { const float er = se[(size_t)cc * 128], ei = se[(size_t)cc * 128 + 1];
            const float nr = pr * sr - pi * si + er, ni = pr * si + pi * sr + ei; sr = nr; si = ni; } }
    const int gi = L * 32 + g;
    bf16x8 bfr[4];
    {   const int pp = lane & 15; const float* cre = P_IN(24) + ((size_t)gi * 16 + pp) * 64; const float* cim = P_IN(25) + ((size_t)gi * 16 + pp) * 64;
#pragma unroll
        for (int ks = 0; ks < 4; ++ks)
#pragma unroll
            for (int j = 0; j < 8; ++j) { const int n2 = ks * 32 + (lane >> 4) * 8 + j; const float v = (n2 < 64) ? cre[n2] : -cim[n2 - 64]; bfr[ks][j] = (short)f2bf(v); } }
    const float dco = P_IN(26)[L * 512 + g * 16 + (lane & 15)];
    bh* YS = (bh*)(P_WS + OFF_YS);
    for (int half = 0; half < 2; ++half) {
#pragma unroll 8
        for (int s = 0; s < 32; ++s) { s5_step(k, ul + (half * 32 + s) * 16, sr, si); img[s * 136 + lane] = f2bf(sr); img[s * 136 + 64 + lane] = f2bf(si); }
        asm volatile("s_waitcnt lgkmcnt(0)" ::: "memory"); __builtin_amdgcn_wave_barrier();
#pragma unroll
        for (int mt = 0; mt < 2; ++mt) { f32x4 acc = {0.f, 0.f, 0.f, 0.f};
#pragma unroll
            for (int ks = 0; ks < 4; ++ks) { const bf16x8 a = *(const LAS bf16x8*)(img + (mt * 16 + (lane & 15)) * 136 + ks * 32 + (lane >> 4) * 8); acc = MFMA16(a, bfr[ks], acc); }
#pragma unroll
            for (int r = 0; r < 4; ++r) { const int tt = half * 32 + mt * 16 + (lane >> 4) * 4 + r; const float uv = ul[tt * 16 + (lane & 15)];
                YS[(size_t)(c * 64 + tt) * 512 + g * 16 + (lane & 15)] = f2bf(gelu_tanh(acc[r] + dco * uv)); } }
        asm volatile("s_waitcnt lgkmcnt(0)" ::: "memory"); __builtin_amdgcn_wave_barrier();
    }
}

__device__ __forceinline__ void phase_scan(const Params& p, int L, LAS unsigned char* lds) {
    const int b = BIDX();
    if (b < 224) { for (int rr = 0; rr < PROBE_RW; ++rr) rwkv_scan(p, b, lds); }
    else { for (int rr = 0; rr < PROBE_ML; ++rr) mlstm_seq(p, b - 224, lds); }
}
__device__ __forceinline__ void phase_s5c(const Params& p, int L, LAS unsigned char* lds) {
    const int b = BIDX(), wid = TIDX() >> 6, lane = TIDX() & 63;
    if (b == GDIM() - 1) mlstm_nscan(p);
    const int nw = GDIM() * 8;
    for (int w = b * 8 + wid; w < 32 * NCH; w += nw) s5_pass_c(p, L, w >> 7, w & 127, lane, (LAS bh*)lds + wid * (32 * 136), (LAS float*)(lds + 69632) + wid * 1024);
    __syncthreads();
}

__device__ __forceinline__ void mlstm_out(const Params& p, int L, int h, int c, LAS unsigned char* lds) {
    const int tid = TIDX(), wid = tid >> 6, lane = tid & 63, t0 = c * 64;
    LAS bh* Pl = (LAS bh*)lds;
    LAS float* s_b = (LAS float*)(lds + 9216); LAS float* s_a = s_b + 64; LAS float* s_mt = s_a + 64; LAS float* s_iw = s_mt + 64; LAS float* s_den = s_iw + 64; LAS float* s_qn = s_den + 64; LAS float* s_part = s_qn + 64;
    const bh* MQ = (const bh*)(P_WS + OFF_MQ); const bh* MK = (const bh*)(P_WS + OFF_MK); const bh* MVT = (const bh*)(P_WS + OFF_MVT);
    const float* MINTER = (const float*)(P_WS + OFF_ABF);
    const float m0 = ((const float*)(P_WS + OFF_MSTART))[h * NCH + c];
    if (tid < 64) { const float ig = ((const float*)(P_WS + OFF_MI))[h * T + t0 + tid], b = ((const float*)(P_WS + OFF_MBB))[h * T + t0 + tid];
        const float a = ig - b; float cm = a;
#pragma unroll
        for (int o = 1; o < 64; o <<= 1) { const float nb = bperm_f((tid - o) & 63, cm); if (tid >= o) cm = fmaxf(cm, nb); }
        const float mt = b + fmaxf(m0, cm);
        s_b[tid] = b; s_a[tid] = a; s_mt[tid] = mt; s_iw[tid] = __expf(b + m0 - mt); }
    __syncthreads();
    {
        const int mt = wid >> 1, nt0 = (wid & 1) * 2;
        f32x4 r0 = {0.f, 0.f, 0.f, 0.f}, r1 = {0.f, 0.f, 0.f, 0.f};
        const bh* qp = MQ + fq_base(h, c, mt, 0) + lane * 8;
        const bh* kp = MK + fq_base(h, c, nt0, 0) + lane * 8;
#pragma unroll
        for (int ks = 0; ks < 8; ++ks) { const bf16x8 a = *(const bf16x8*)(qp + ks * 512); const bf16x8 b0 = *(const bf16x8*)(kp + ks * 512), b1 = *(const bf16x8*)(kp + 8 * 512 + ks * 512);
            r0 = MFMA16(a, b0, r0); r1 = MFMA16(a, b1, r1); }
#pragma unroll
        for (int r = 0; r < 4; ++r) { const int t = mt * 16 + (lane >> 4) * 4 + r; const float bt = s_b[t] - s_mt[t];
            { const int s = nt0 * 16 + (lane & 15); const float pv = (s <= t) ? r0[r] * __expf(bt + s_a[s]) : 0.f; Pl[t * 72 + s] = f2bf(pv); }
            { const int s = nt0 * 16 + 16 + (lane & 15); const float pv = (s <= t) ? r1[r] * __expf(bt + s_a[s]) : 0.f; Pl[t * 72 + s] = f2bf(pv); } }
    }
    __syncthreads();
    if (tid < 64) { float s = 0.f;
#pragma unroll
        for (int q = 0; q < 8; ++q) { const u32x4 w = *(const LAS u32x4*)(Pl + tid * 72 + q * 8);
            s += __uint_as_float(w.x << 16) + __uint_as_float(w.x & 0xffff0000u) + __uint_as_float(w.y << 16) + __uint_as_float(w.y & 0xffff0000u)
               + __uint_as_float(w.z << 16) + __uint_as_float(w.z & 0xffff0000u) + __uint_as_float(w.w << 16) + __uint_as_float(w.w & 0xffff0000u); }
        s_den[tid] = s; }
    {
        const float* nst = (const float*)(P_WS + OFF_NST) + (size_t)(h * NCH + c) * 256 + lane * 4; const f32x4 nv = *(const f32x4*)nst;
#pragma unroll
        for (int i = 0; i < 8; ++i) { const int t = wid * 8 + i; const u32x2 q2 = *(const u32x2*)(MQ + fq_off(h, t0 + t, lane * 4));
            float s = __uint_as_float(q2.x << 16) * nv[0] + __uint_as_float(q2.x & 0xffff0000u) * nv[1] + __uint_as_float(q2.y << 16) * nv[2] + __uint_as_float(q2.y & 0xffff0000u) * nv[3];
            s = wave_sum(s); if (lane == 0) s_qn[t] = s; } }
    f32x4 acc[4][2];
#pragma unroll
    for (int a = 0; a < 4; ++a) { const float z = OZ(); acc[a][0] = (f32x4){z, z, z, z}; acc[a][1] = (f32x4){z, z, z, z}; }
    {   const bh* vp = MVT + (size_t)(h * NCH + c) * 16384;
#pragma unroll
        for (int ks = 0; ks < 2; ++ks) { const bf16x8 b0 = *(const bf16x8*)(vp + ft_off(wid * 32 + (lane & 15), ks * 4 + (lane >> 4))), b1 = *(const bf16x8*)(vp + ft_off(wid * 32 + 16 + (lane & 15), ks * 4 + (lane >> 4)));
#pragma unroll
            for (int a = 0; a < 4; ++a) { const bf16x8 av = *(const LAS bf16x8*)(Pl + (a * 16 + (lane & 15)) * 72 + ks * 32 + (lane >> 4) * 8);
                acc[a][0] = MFMA16(av, b0, acc[a][0]); acc[a][1] = MFMA16(av, b1, acc[a][1]); } } }
    __syncthreads();
#pragma unroll
    for (int a = 0; a < 4; ++a)
#pragma unroll
        for (int r = 0; r < 4; ++r) { const int t = a * 16 + (lane >> 4) * 4 + r; const float iw = s_iw[t];
            const float den = s_den[t] + iw * s_qn[t]; const float dd = 1.0f / fmaxf(fabsf(den), __expf(-s_mt[t]));
            const float* mi = MINTER + (size_t)(t0 + t) * 1024 + h * 256 + wid * 32 + (lane & 15);
            const float h0 = (acc[a][0][r] + iw * mi[0]) * dd, h1 = (acc[a][1][r] + iw * mi[16]) * dd;
            acc[a][0][r] = h0; acc[a][1][r] = h1;
            float ss = h0 * h0 + h1 * h1;
            ss = allreduce16(ss);
            if ((lane & 15) == 0) s_part[wid * 64 + t] = ss; }
    __syncthreads();
    {   const float* zf = (const float*)(P_WS + OFF_ZF); const float* ng = P_IN(7) + L * 1024 + h * 256; bh* YC = (bh*)(P_WS + OFF_YCAT);
#pragma unroll
        for (int a = 0; a < 4; ++a)
#pragma unroll
            for (int r = 0; r < 4; ++r) { const int t = a * 16 + (lane >> 4) * 4 + r;
                float tot = 0.f;
#pragma unroll
                for (int w = 0; w < 8; ++w) tot += s_part[w * 64 + t];
                const float rstd = rsqrtf(tot * (1.0f / 256.0f) + 1e-6f);
                const int v0 = wid * 32 + (lane & 15);
                const float* op = zf + (size_t)(t0 + t) * ZF_LD + 3072 + h * 256 + v0;
                bh* yo = YC + (size_t)(t0 + t) * D + h * 256 + v0;
                yo[0] = f2bf(sigmoidf_(op[0]) * acc[a][0][r] * rstd * ng[v0]);
                yo[16] = f2bf(sigmoidf_(op[16]) * acc[a][1][r] * rstd * ng[v0 + 16]); } }
    __syncthreads();
}

__device__ __forceinline__ void rwkv_post(const Params& p, int L, int it, LAS unsigned char* lds) {
    const int tid = TIDX(), wid = tid >> 6, lane = tid & 63;
    const int h = it & 7, blk = it >> 3, j = blk >> 3;
    LAS float* bufA = (LAS float*)lds;
    LAS float* bufB = bufA + 64 * 65;
    LAS float* bufP = bufB + 64 * 65;
    const float* SE = (const float*)(P_WS + OFF_RSEND) + (size_t)(h * 4) * 4096; const float* PE = (const float*)(P_WS + OFF_RPEND) + (size_t)(h * 4) * 4096;
    LAS float* sst = bufA;
    if (j >= 1) {
        const int v = tid >> 3, k8 = (tid & 7) * 8;
        { const f32x4 a0 = *(const f32x4*)(SE + v * 64 + k8), a1 = *(const f32x4*)(SE + v * 64 + k8 + 4);
#pragma unroll
          for (int e = 0; e < 4; ++e) { bufA[v * 65 + k8 + e] = a0[e]; bufA[v * 65 + k8 + 4 + e] = a1[e]; } }
        for (int jj = 1; jj < j; ++jj) {
            { const f32x4 p0 = *(const f32x4*)(PE + (size_t)jj * 4096 + v * 64 + k8), p1 = *(const f32x4*)(PE + (size_t)jj * 4096 + v * 64 + k8 + 4);
              *(LAS f32x4*)(bufP + v * 64 + k8) = p0; *(LAS f32x4*)(bufP + v * 64 + k8 + 4) = p1; }
            __syncthreads();
            LAS float* src = (jj & 1) ? bufA : bufB; LAS float* dst = (jj & 1) ? bufB : bufA;
            f32x4 c0 = *(const f32x4*)(SE + (size_t)jj * 4096 + v * 64 + k8), c1 = *(const f32x4*)(SE + (size_t)jj * 4096 + v * 64 + k8 + 4);
#pragma unroll 8
            for (int i = 0; i < 64; ++i) { const float a = src[v * 65 + i]; const f32x4 p0 = *(const LAS f32x4*)(bufP + i * 64 + k8), p1 = *(const LAS f32x4*)(bufP + i * 64 + k8 + 4); c0 += a * p0; c1 += a * p1; }
#pragma unroll
            for (int e = 0; e < 4; ++e) { dst[v * 65 + k8 + e] = c0[e]; dst[v * 65 + k8 + 4 + e] = c1[e]; }
            __syncthreads();
            sst = dst;
        }
        __syncthreads();
    }
    float srow[64];
    if (j >= 1) {
#pragma unroll
        for (int i = 0; i < 64; ++i) srow[i] = sst[lane * 65 + i];
    } else {
#pragma unroll
        for (int i = 0; i < 64; ++i) srow[i] = 0.f;
    }
    const int c = h * 64 + lane;
    const float rkw = P_IN(16)[L * 512 + c], lg = P_IN(17)[L * 512 + c], lb = P_IN(18)[L * 512 + c];
    const float* RY = (const float*)(P_WS + OFF_RY); const float* RZ = (const float*)(P_WS + OFF_RZ); const float* RR = (const float*)(P_WS + OFF_RR); const float* RK = (const float*)(P_WS + OFF_RK);
    const float* RV = (const float*)(P_WS + OFF_RV); const float* RG = (const float*)(P_WS + OFF_RG); bh* YC = (bh*)(P_WS + OFF_YCAT);
    for (int i = 0; i < 32; ++i) { const int t = blk * 256 + wid * 32 + i; const size_t o = (size_t)t * 512 + c;
        float y = RY[o];
        if (j >= 1) { const float z = RZ[o]; float y2 = 0.f;
#pragma unroll
            for (int q = 0; q < 64; q += 2) { y = fmaf(srow[q], __builtin_bit_cast(float, __builtin_amdgcn_readlane(__builtin_bit_cast(int, z), q)), y);
                                              y2 = fmaf(srow[q + 1], __builtin_bit_cast(float, __builtin_amdgcn_readlane(__builtin_bit_cast(int, z), q + 1)), y2); }
            y += y2; }
        const float mu = wave_sum(y) * (1.0f / 64.0f); const float dlt = y - mu; const float var = wave_sum(dlt * dlt) * (1.0f / 64.0f);
        const float yn = dlt * rsqrtf(var + 64e-5f) * lg + lb;
        const float bon = wave_sum(RR[o] * RK[o] * rkw) * RV[o];
        YC[(size_t)t * D + 1024 + c] = f2bf((yn + bon) * RG[o]); }
    __syncthreads();
}

__device__ __forceinline__ void phase_post(const Params& p, int L, LAS unsigned char* lds) {
    for (int it = BIDX(); it < 768; it += GDIM()) {
        if (it < 512) mlstm_out(p, L, it >> 7, it & 127, lds);
        else rwkv_post(p, L, it - 512, lds);
    }
    __syncthreads();
}

#define XB_TMO      128
#define XB_XCNT(j)  (256  + 64 * (j))
#define XB_XSUB(j)  (1280 + 64 * (j))
#define XB_XGEN(j)  (2304 + 64 * (j))
#define XB_TOP      3328
#define XB_TOPGEN   3392
#define XCD_BAR_WORDS 3456
#define XB_SPIN_CAP (1u << 18)

__device__ __forceinline__ unsigned xb_ld(unsigned* p)              { return __hip_atomic_load(p, __ATOMIC_RELAXED, __HIP_MEMORY_SCOPE_AGENT); }
__device__ __forceinline__ unsigned xb_add(unsigned* p, unsigned v) { return __hip_atomic_fetch_add(p, v, __ATOMIC_RELAXED, __HIP_MEMORY_SCOPE_AGENT); }
__device__ __forceinline__ unsigned xb_xcc_id() { return (unsigned)__builtin_amdgcn_s_getreg((3 << 11) | 20) & 0xFu; }
#define XB_SPIN(cond, bar) do { unsigned _sp = 0; while (cond) { __builtin_amdgcn_s_sleep(1); \
    if ((++_sp & 255u) == 0u) { if (xb_ld(&(bar)[XB_TMO])) break; if (_sp > XB_SPIN_CAP) { atomicAdd(&(bar)[XB_TMO], 1u); break; } } } } while (0)

struct XcdBarrier {
    unsigned* bar; unsigned x;
    volatile LAS unsigned* st;
};

__device__ __forceinline__ XcdBarrier xcd_barrier_post(unsigned* bar, volatile LAS unsigned* st) {
    XcdBarrier b; b.bar = bar; b.x = xb_xcc_id(); b.st = st;
    if (threadIdx.x == 0) (void)xb_add(&bar[XB_XCNT(b.x)], 1u);
    return b;
}
__device__ __forceinline__ void xcd_barrier_complete(unsigned* bar, unsigned x, unsigned& nloc, unsigned& nx) {
    const unsigned G = gridDim.x * gridDim.y * gridDim.z;
    unsigned sum, cnt, mine, sp = 0u;
    for (;;) {
        sum = 0u; cnt = 0u; mine = 0u;
#pragma unroll
        for (unsigned j = 0; j < 16; ++j) { const unsigned c = xb_ld(&bar[XB_XCNT(j)]); sum += c; cnt += (c > 0u) ? 1u : 0u; mine = (j == x) ? c : mine; }
        if (sum == G) break;
        __builtin_amdgcn_s_sleep(1);
        if ((++sp & 255u) == 0u) { if (xb_ld(&bar[XB_TMO])) break; if (sp > XB_SPIN_CAP) { atomicAdd(&bar[XB_TMO], 1u); break; } }
    }
    nloc = mine > 0u ? mine : 1u; nx = cnt > 0u ? cnt : 1u;
}

__device__ __forceinline__ void xcd_barrier(const XcdBarrier& b) {
    asm volatile("s_waitcnt vmcnt(0)" ::: "memory");
    __syncthreads();
    if (threadIdx.x == 0) {
        unsigned* bar = b.bar;
        __builtin_amdgcn_s_waitcnt(0);
        unsigned nloc = b.st[0], nx = b.st[1];
        if (nloc == 0u) { xcd_barrier_complete(bar, b.x, nloc, nx); b.st[0] = nloc; b.st[1] = nx; }
        const unsigned old = xb_add(&bar[XB_XSUB(b.x)], 1u);
        const unsigned gen = old / nloc;
        if (old + 1u == (gen + 1u) * nloc) {
            __builtin_amdgcn_fence(__ATOMIC_RELEASE, "agent");
            asm volatile("s_waitcnt vmcnt(0)" ::: "memory");
            const unsigned og = xb_add(&bar[XB_TOP], 1u);
            const unsigned tg = og / nx;
            if (og + 1u == (tg + 1u) * nx) xb_add(&bar[XB_TOPGEN], 1u);
            else XB_SPIN(xb_ld(&bar[XB_TOPGEN]) == tg, bar);
            __builtin_amdgcn_fence(__ATOMIC_ACQUIRE, "agent");
            xb_add(&bar[XB_XGEN(b.x)], 1u);
            asm volatile("s_waitcnt vmcnt(0)" ::: "memory");
        } else {
            XB_SPIN(xb_ld(&bar[XB_XGEN(b.x)]) == gen, bar);
            __builtin_amdgcn_fence(__ATOMIC_ACQUIRE, "agent");
            asm volatile("s_waitcnt vmcnt(0)" ::: "memory");
        }
    }
    __syncthreads();
}


constexpr int NPHASE = 27;
__global__ void __launch_bounds__(512, 2) hybrid_fwd(Params p, int ph_lo, int ph_hi, int rep_q) {
    extern __shared__ __attribute__((aligned(16))) unsigned char smem_raw[];
    LAS unsigned char* lds = (LAS unsigned char*)smem_raw;
    cg::grid_group grid = cg::this_grid();
    volatile LAS unsigned* xst = (volatile LAS unsigned*)(lds + 131072);
    if (threadIdx.x < 2) xst[threadIdx.x] = 0u;
    __syncthreads();
    { XcdBarrier b0 = xcd_barrier_post((unsigned*)(P_WS + OFF_BAR), xst); (void)b0; }
    for (int ph = ph_lo; ph < ph_hi; ++ph) {
        if (ph == ph_lo + 1) grid.sync();
        else if (ph > ph_lo) { XcdBarrier xb; xb.bar = (unsigned*)(P_WS + OFF_BAR); xb.x = xb_xcc_id(); xb.st = xst; xcd_barrier(xb); }
        if (ph == 26) {
            const int gw = BIDX() * 8 + (TIDX() >> 6), NGW = GDIM() * 8, lane = TIDX() & 63;
            for (int r = gw; r < T; r += NGW) { float* x = P_OUT + (size_t)r * D; f32x4 v[8]; float s = 0.f;
#pragma unroll
                for (int j = 0; j < 8; ++j) { v[j] = *(const f32x4*)(x + j * 256 + lane * 4); s += (v[j][0] * v[j][0] + v[j][1] * v[j][1]) + (v[j][2] * v[j][2] + v[j][3] * v[j][3]); }
                const float rstd = rsqrtf(wave_sum(s) * (1.0f / D) + 1e-6f);
#pragma unroll
                for (int j = 0; j < 8; ++j) { const f32x4 gg = *(const f32x4*)(P_IN(40) + j * 256 + lane * 4); *(f32x4*)(x + j * 256 + lane * 4) = v[j] * rstd * gg; } }
            continue;
        }
        const int L = ph / 13, q = ph % 13;
#ifdef ONLY_Q
        if (q != ONLY_Q) continue;
#endif
        const int nrep = (q == rep_q) ? 2 : 1;
        for (int rep = 0; rep < nrep; ++rep) {
        if (rep) grid.sync();
        switch (q) {
        case 0: phase_conv(p, L, lds); break;
        case 2: phase_prep(p, L, lds); break;
        case 4: phase_scan(p, L, lds); break;
        case 5: phase_post(p, L, lds); break;
        case 8: phase_rmsnorm(p, P_IN(33) + (size_t)L * D); break;
        case 11: phase_rmsnorm(p, P_IN(37) + (size_t)L * D); break;
        default: break;
        }
        for (int i = 0; i < 3; ++i) {
            pg8::Gemm g;
            if (!make_gemm(p, L, q, i, g)) break;
            pg8::StaticOrder S; S.init(T, g.N, GDIM(), BIDX());
            pg8::gemm_phase(lds, g, S);
        }
        if (q == 3) phase_s5c(p, L, lds);
        }
    }
}

extern "C" void kernel_launch(void* const* d_in, const int* in_sizes, int n_in, void* d_out, int out_size, void* d_ws, size_t ws_size, hipStream_t stream) {
    constexpr size_t kDynLds = 131072 + 64;
    static int grid_blocks = 0;
    if (!grid_blocks) {
        int dev = 0, cus = 0, per_cu = 0;
        (void)hipGetDevice(&dev);
        (void)hipDeviceGetAttribute(&cus, hipDeviceAttributeMultiprocessorCount, dev);
        (void)hipFuncSetAttribute((const void*)hybrid_fwd, hipFuncAttributeMaxDynamicSharedMemorySize, (int)kDynLds);
        (void)hipOccupancyMaxActiveBlocksPerMultiprocessor(&per_cu, hybrid_fwd, 512, kDynLds);
        if (per_cu > 1) per_cu = 1;
        grid_blocks = cus * per_cu;
        if (ws_size < WS_TOTAL) fprintf(stderr, "workspace too small: %zu < %zu\n", ws_size, (size_t)WS_TOTAL);
    }
    Params p{};
    for (int i = 0; i < 41; ++i) p.in[i] = (const float*)d_in[i];
    p.out = (float*)d_out; p.ws = (unsigned char*)d_ws;
    (void)hipMemsetAsync((char*)d_ws + OFF_BAR, 0, XCD_BAR_WORDS * 4, stream);
#if SINGLE_LAUNCH
    int lo = 0, hi = NPHASE, rq = PROBE_REP_Q;
    void* args[] = {&p, &lo, &hi, &rq};
    hipError_t e = hipLaunchCooperativeKernel((const void*)hybrid_fwd, dim3(grid_blocks), dim3(512), args, kDynLds, stream);
    if (e != hipSuccess) fprintf(stderr, "cooperative launch failed: %s (grid %d)\n", hipGetErrorString(e), grid_blocks);
#else
    for (int ph = 0; ph < NPHASE; ++ph) {
        int lo = ph, hi = ph + 1, rq = -1;
        void* args[] = {&p, &lo, &hi, &rq};
        hipError_t e = hipLaunchCooperativeKernel((const void*)hybrid_fwd, dim3(grid_blocks), dim3(512), args, kDynLds, stream);
        if (e != hipSuccess) fprintf(stderr, "cooperative launch failed: %s (grid %d)\n", hipGetErrorString(e), grid_blocks);
    }
#endif
}
```

```cpp
#include <hip/hip_runtime.h>
#include <hip/hip_cooperative_groups.h>
#include <cstdio>
#include <cstdint>
namespace cg = cooperative_groups;

#define LAS __attribute__((address_space(3)))
typedef unsigned short bh;
typedef short bf16x8 __attribute__((ext_vector_type(8)));
typedef float f32x4 __attribute__((ext_vector_type(4)));
typedef float f32x16 __attribute__((ext_vector_type(16)));
typedef unsigned u32x4 __attribute__((ext_vector_type(4)));
typedef unsigned u32x2 __attribute__((ext_vector_type(2)));

#ifndef PROBE_RW
#define PROBE_RW 1
#define PROBE_ML 1
#endif
#ifndef PROBE_REP_Q
#define PROBE_REP_Q (-1)
#endif
#ifndef SINGLE_LAUNCH
#define SINGLE_LAUNCH 1
#endif

constexpr int T = 8192, D = 2048, FH = 5632;
constexpr int NIN = 12744, NGATE = 6144, NF = 6600, ZF_LD = 6656, NINP = 12800;
constexpr int ZR0 = 4104, ZS0 = 6088;
constexpr int NCH = 128;

constexpr size_t AL(size_t x) { return (x + 255) & ~(size_t)255; }
constexpr size_t SZ_WIN = (size_t)NINP * D * 2, SZ_SQ = (size_t)D * D * 2, SZ_WGU = (size_t)2 * FH * D * 2, SZ_WD = (size_t)D * FH * 2;
constexpr size_t OFF_WIN = 0;
constexpr size_t OFF_WUP = OFF_WIN + SZ_WIN;
constexpr size_t OFF_WO = OFF_WUP + SZ_SQ;
constexpr size_t OFF_WGU = OFF_WO + SZ_SQ;
constexpr size_t OFF_WD = OFF_WGU + SZ_WGU;
constexpr size_t OFF_WPG = OFF_WD + SZ_WD;
constexpr size_t OFF_WPP = OFF_WPG + SZ_SQ;
constexpr size_t OFF_WGLU = OFF_WPP + (size_t)D * 256 * 2;
constexpr size_t OFF_WW2 = OFF_WGLU + (size_t)512 * 512 * 2;
constexpr size_t OFF_WA2 = OFF_WW2 + (size_t)512 * 256 * 2;
constexpr size_t OFF_WG2 = OFF_WA2 + (size_t)512 * 256 * 2;
constexpr size_t OFF_PBF = OFF_WG2 + (size_t)512 * 256 * 2;
constexpr size_t OFF_ABF = OFF_PBF + (size_t)2 * T * 256 * 2;
constexpr size_t OFF_YCAT = OFF_ABF + (size_t)T * D * 2;
constexpr size_t OFF_ZF = OFF_YCAT + (size_t)T * D * 2;
constexpr size_t OFF_ACT = OFF_ZF;
constexpr size_t OFF_MIX32 = OFF_ZF + (size_t)100663296;
constexpr size_t OFF_ZG = OFF_ZF + (size_t)T * ZF_LD * 4;
constexpr size_t SZ_R = (size_t)T * 512 * 4;
constexpr size_t OFF_RR = OFF_ZG + (size_t)T * NGATE * 2;
constexpr size_t OFF_RK = OFF_RR + SZ_R, OFF_RV = OFF_RK + SZ_R, OFF_RKK = OFF_RV + SZ_R, OFF_RW = OFF_RKK + SZ_R, OFF_RB = OFF_RW + SZ_R, OFF_RG = OFF_RB + SZ_R, OFF_RY = OFF_RG + SZ_R;
constexpr size_t OFF_LAW = OFF_RY + SZ_R;
constexpr size_t OFF_LAA = OFF_LAW + (size_t)T * 256 * 2, OFF_LAG = OFF_LAA + (size_t)T * 256 * 2;
constexpr size_t SZ_MB = (size_t)T * 1024 * 2;
constexpr size_t OFF_MQ = OFF_LAG + (size_t)T * 256 * 2, OFF_MK = OFF_MQ + SZ_MB, OFF_MKT = OFF_MK + SZ_MB, OFF_MVT = OFF_MKT + SZ_MB;
constexpr size_t OFF_MI = OFF_MVT + SZ_MB;
constexpr size_t OFF_MBB = OFF_MI + (size_t)4 * T * 4;
constexpr size_t OFF_MBEND = OFF_MBB + (size_t)4 * T * 4;
constexpr size_t OFF_MLOC = OFF_MBEND + 2048, OFF_MSTART = OFF_MLOC + 2048;
constexpr size_t OFF_DN = OFF_MSTART + 2048;
constexpr size_t OFF_NST = OFF_DN + (size_t)4 * NCH * 256 * 4;
constexpr size_t OFF_SEND = OFF_NST + (size_t)4 * NCH * 256 * 4;
constexpr size_t OFF_YS = OFF_SEND + (size_t)32 * NCH * 64 * 8;
constexpr size_t OFF_RZ = OFF_YS + (size_t)T * 512 * 2;
constexpr size_t OFF_RSEND = OFF_RZ + SZ_R;
constexpr size_t OFF_RPEND = OFF_RSEND + (size_t)8 * 4 * 4096 * 4;
constexpr size_t OFF_MINTER2 = OFF_RPEND + (size_t)8 * 4 * 4096 * 4;
constexpr size_t OFF_BAR = OFF_MINTER2;
constexpr size_t WS_TOTAL = OFF_MINTER2 + (size_t)T * 1024 * 4;

struct Params { const float* in[41]; float* out; unsigned char* ws; };
#define KARG4 __attribute__((address_space(4)))
__device__ __forceinline__ const float* karg_in(int i) { const KARG4 char* ka = (const KARG4 char*)__builtin_amdgcn_kernarg_segment_ptr(); return *(const float* const volatile KARG4*)(ka + (size_t)i * 8); }
#define P_IN(i) karg_in(i)
#define P_OUT ((float*)karg_in(41))
#define P_WS ((unsigned char*)karg_in(42))

__device__ __forceinline__ int TIDX() { int t = threadIdx.x; asm volatile("" : "+v"(t)); return t; }
__device__ __forceinline__ int BIDX() { int t = blockIdx.x; asm volatile("" : "+s"(t)); return t; }
__device__ __forceinline__ int GDIM() { int t = gridDim.x; asm volatile("" : "+s"(t)); return t; }
__device__ __forceinline__ bh f2bf(float f) { unsigned u = __float_as_uint(f); u += 0x7fffu + ((u >> 16) & 1u); return (bh)(u >> 16); }
__device__ __forceinline__ float bf2f(bh h) { return __uint_as_float(((unsigned)h) << 16); }
__device__ __forceinline__ unsigned pk2(float lo, float hi) { return (unsigned)f2bf(lo) | ((unsigned)f2bf(hi) << 16); }
__device__ __forceinline__ float sigmoidf_(float x) { return 1.0f / (1.0f + __expf(-x)); }
__device__ __forceinline__ float bperm_f(int srclane, float v) { return __builtin_bit_cast(float, __builtin_amdgcn_ds_bpermute(srclane << 2, __builtin_bit_cast(int, v))); }
template <int CTRL> __device__ __forceinline__ float dpp_f(float x) {
    return __builtin_bit_cast(float, __builtin_amdgcn_update_dpp(0, __builtin_bit_cast(int, x), CTRL, 0xf, 0xf, true));
}
__device__ __forceinline__ float allreduce16(float x) {
    x += dpp_f<0xB1>(x); x += dpp_f<0x4E>(x); x += dpp_f<0x141>(x); x += dpp_f<0x140>(x);
    return x;
}
__device__ __forceinline__ float rl_f(float v, int l) { return __builtin_bit_cast(float, __builtin_amdgcn_readlane(__builtin_bit_cast(int, v), l)); }
__device__ __forceinline__ float wave_sum(float v) {
    v = allreduce16(v);
    return (rl_f(v, 0) + rl_f(v, 16)) + (rl_f(v, 32) + rl_f(v, 48));
}
__device__ __forceinline__ float wave_max(float v) {
    v = fmaxf(v, dpp_f<0xB1>(v)); v = fmaxf(v, dpp_f<0x4E>(v)); v = fmaxf(v, dpp_f<0x141>(v)); v = fmaxf(v, dpp_f<0x140>(v));
    return fmaxf(fmaxf(rl_f(v, 0), rl_f(v, 16)), fmaxf(rl_f(v, 32), rl_f(v, 48)));
}
__device__ __forceinline__ float OZ() { float z = 0.f; asm volatile("" : "+v"(z)); return z; }
#define MFMA16(a, b, c) __builtin_amdgcn_mfma_f32_16x16x32_bf16(a, b, c, 0, 0, 0)
#define MFMA32(a, b, c) __builtin_amdgcn_mfma_f32_32x32x16_bf16(a, b, c, 0, 0, 0)

namespace pg8 {
constexpr int BM = 256, BK = 64, HALF = 128, HTB = HALF * BK * 2, STAGE_BYTES = 8 * HTB, NXCD = 8, WGM = 8;
__device__ __forceinline__ int lds_byte(int r, int c) { const int st = (r >> 4) * 2 + (c >> 5), rr = r & 15, cc = c & 31, ob = rr * 64 + cc * 2; return st * 1024 + (ob ^ (((ob >> 9) & 1) << 5)); }
__device__ __forceinline__ void stage_rc(int b, int& R, int& C) { const int st = b / 1024, sb = b % 1024, swz = sb ^ (((sb >> 9) & 1) << 5); R = (st >> 1) * 16 + swz / 64; C = (st & 1) * 32 + (swz % 64) / 2; }
__device__ __forceinline__ int perm32(int rho) { const int n = rho >> 4, i = rho & 15; return 8 * (i >> 2) + 4 * n + (i & 3); }
struct Unit { int pm, pn; };
struct Gemm { const bh* A; const bh* Bt; int M, N, K, lda, ldb, epi, perm, L; };
struct StaticOrder {
    int nM, nN, nwg, G, c;
    __device__ void init(int M, int N, int G_, int c_) { nM = M / BM; nN = N / BM; nwg = nM * nN; G = G_; c = c_; }
    __device__ bool next(int i, Unit& u) const {
        const long L = (long)i * G + c; if (L >= nwg) return false;
        int wgid = (int)L; { const int q = nwg / NXCD, r = nwg % NXCD, xcd = wgid % NXCD, off = wgid / NXCD; wgid = (xcd < r ? xcd * (q + 1) : r * (q + 1) + (xcd - r) * q) + off; }
        const int nig = WGM * nN, gid = wgid / nig, fm = gid * WGM, gsz = (nM - fm) < WGM ? (nM - fm) : WGM;
        u.pm = fm + ((wgid % nig) % gsz); u.pn = (wgid % nig) / gsz; return true;
    }
};
__device__ __forceinline__ unsigned cvt_pk_bf16(float lo, float hi) { unsigned r; asm volatile("v_cvt_pk_bf16_f32 %0, %1, %2" : "=v"(r) : "v"(lo), "v"(hi)); return r; }

__device__ __forceinline__ void epi_run(const Gemm& g, const f32x4 (&acc)[2][2][4][2], const Unit& u, int wr, int wc, int fr, int fq);
__device__ __forceinline__ void up_rescale(f32x4 (&acc)[2][2][4][2], const Unit& u, int wr, int wc, int fr, int fq, int goff) {
    const bh* zg = (const bh*)(P_WS + OFF_ZG) + goff;
    asm volatile("" : "+v"(fr), "+v"(fq));
    const bh* zrow0 = zg + (size_t)(u.pm * 256 + wr * 64 + fr) * NGATE + u.pn * 256 + wc * 32 + 4 * fq;
#pragma unroll
    for (int ai = 0; ai < 2; ++ai)
#pragma unroll
        for (int m = 0; m < 4; ++m) { const bh* zr = zrow0 + (size_t)(ai * 128 + m * 16) * NGATE;
#pragma unroll
            for (int bj = 0; bj < 2; ++bj)
#pragma unroll
                for (int n = 0; n < 2; ++n) {
                    const u32x2 gp = *(const u32x2*)(zr + bj * 128 + n * 16), gn = *(const u32x2*)(zr + 2048 + bj * 128 + n * 16);
                    f32x4 r;
                    r[0] = __uint_as_float(gp.x << 16) * __builtin_amdgcn_rcpf(__uint_as_float(gn.x << 16)); r[1] = __uint_as_float(gp.x & 0xffff0000u) * __builtin_amdgcn_rcpf(__uint_as_float(gn.x & 0xffff0000u));
                    r[2] = __uint_as_float(gp.y << 16) * __builtin_amdgcn_rcpf(__uint_as_float(gn.y << 16)); r[3] = __uint_as_float(gp.y & 0xffff0000u) * __builtin_amdgcn_rcpf(__uint_as_float(gn.y & 0xffff0000u));
                    acc[ai][bj][m][n] *= r; }
            __builtin_amdgcn_sched_barrier(0); }
}
__device__ __forceinline__ void gemm_phase(LAS unsigned char* lds, const Gemm& g, const StaticOrder& S) {
    const int tid = TIDX(), wid = __builtin_amdgcn_readfirstlane(tid >> 6), lane = tid & 63, wr = wid >> 2, wc = wid & 3, fr = lane & 15, fq = lane >> 4;
    const int K = g.K, nt = K / BK;
    unsigned voffA[2], voffB[2];
#pragma unroll
    for (int i = 0; i < 2; ++i) { int R, C; stage_rc(tid * 16 + i * 8192, R, C); const int Rb = g.perm ? ((R & ~31) + perm32(R & 31)) : R;
        voffA[i] = (unsigned)(R * g.lda + C) * 2u; voffB[i] = (unsigned)(Rb * g.ldb + C) * 2u; }
    const size_t kstep = (size_t)(BK * 2);
    const size_t hstepA = (size_t)HALF * g.lda * 2, hstepB = (size_t)HALF * g.ldb * 2;
    const size_t tstepA = 2 * hstepA, tstepB = 2 * hstepB;
    const unsigned ldsw = (unsigned)wid * 1024u;
    const int aoff = lds_byte(wr * 64 + fr, fq * 8), boff = lds_byte(wc * 32 + fr, fq * 8);
#define PG8_SA(b, h) (((b) * 2 + (h)) * HTB)
#define PG8_SB(b, h) ((4 + (b) * 2 + (h)) * HTB)
#define PG8_STAGE(bufoff, gbase, voff) do { _Pragma("unroll") for (int _i = 0; _i < 2; ++_i) \
        __builtin_amdgcn_global_load_lds((const unsigned*)((const char*)(gbase) + (voff)[_i]), (LAS unsigned*)(lds + (bufoff) + ldsw + _i * 8192), 16, 0, 0); } while (0)
#define PG8_LDA(dst, b, h) do { _Pragma("unroll") for (int m = 0; m < 4; ++m) _Pragma("unroll") for (int k = 0; k < 2; ++k) dst[m][k] = *(const LAS bf16x8*)(lds + PG8_SA(b, h) + aoff + m * 2048 + k * 1024); } while (0)
#define PG8_LDB(dst, b, h) do { _Pragma("unroll") for (int n = 0; n < 2; ++n) _Pragma("unroll") for (int k = 0; k < 2; ++k) dst[n][k] = *(const LAS bf16x8*)(lds + PG8_SB(b, h) + boff + n * 2048 + k * 1024); } while (0)
#define PG8_MMA(ai, bj, At, Bt) do { __builtin_amdgcn_s_setprio(1); _Pragma("unroll") for (int m = 0; m < 4; ++m) _Pragma("unroll") for (int n = 0; n < 2; ++n) _Pragma("unroll") for (int k = 0; k < 2; ++k) \
        acc[ai][bj][m][n] = __builtin_amdgcn_mfma_f32_16x16x32_bf16(Bt[n][k], At[m][k], acc[ai][bj][m][n], 0, 0, 0); __builtin_amdgcn_s_setprio(0); } while (0)
#define PG8_WAIT_V(n) asm volatile("s_waitcnt vmcnt(" #n ")" ::: "memory")
#define PG8_WAIT_L(n) asm volatile("s_waitcnt lgkmcnt(" #n ")" ::: "memory")
#define PG8_BAR __builtin_amdgcn_s_barrier()
#define PG8_SCHED __builtin_amdgcn_sched_barrier(0)
    Unit cur, nxt; int ui = 0;
    if (!S.next(0, cur)) return;
    f32x4 acc[2][2][4][2];
    { const float z = OZ();
#pragma unroll
    for (int a = 0; a < 2; ++a)
#pragma unroll
        for (int b = 0; b < 2; ++b)
#pragma unroll
            for (int m = 0; m < 4; ++m)
#pragma unroll
                for (int n = 0; n < 2; ++n) acc[a][b][m][n] = (f32x4){z, z, z, z}; }
    bf16x8 At[4][2], B0[2][2], B1[2][2];
    const char* cA = (const char*)g.A + (size_t)cur.pm * tstepA; const char* cB = (const char*)g.Bt + (size_t)cur.pn * tstepB;
    PG8_STAGE(PG8_SB(0, 0), cB, voffB); PG8_STAGE(PG8_SA(0, 0), cA, voffA); PG8_STAGE(PG8_SB(0, 1), cB + hstepB, voffB); PG8_STAGE(PG8_SA(0, 1), cA + hstepA, voffA);
    if (wr == 1) PG8_BAR;
    PG8_WAIT_V(4); PG8_BAR;
    PG8_STAGE(PG8_SB(1, 0), cB + kstep, voffB); PG8_STAGE(PG8_SA(1, 0), cA + kstep, voffA); PG8_STAGE(PG8_SB(1, 1), cB + hstepB + kstep, voffB);
    PG8_WAIT_V(6); PG8_BAR;
    for (;;) {
        const bool has_next = S.next(ui + 1, nxt);
        const char* nA = has_next ? (const char*)g.A + (size_t)nxt.pm * tstepA : cA; const char* nB = has_next ? (const char*)g.Bt + (size_t)nxt.pn * tstepB : cB;
        for (int t = 0; t < nt; t += 2) {
            if (g.epi == 11 && (t == 16 || t == 24)) up_rescale(acc, cur, wr, wc, fr, fq, t == 16 ? 0 : 2048);
            const bool last = (t == nt - 2);
            const char* a1 = cA + (size_t)(t + 1) * kstep;
            const char* a2 = last ? nA : cA + (size_t)(t + 2) * kstep; const char* b2 = last ? nB : cB + (size_t)(t + 2) * kstep;
            const char* a3 = a2 + kstep; const char* b3 = b2 + kstep;
            PG8_LDB(B0, 0, 0); PG8_SCHED; PG8_LDA(At, 0, 0); PG8_STAGE(PG8_SA(1, 1), a1 + hstepA, voffA);
            PG8_WAIT_L(8); PG8_BAR; PG8_WAIT_L(0); PG8_MMA(0, 0, At, B0); PG8_BAR; PG8_SCHED;
            PG8_LDB(B1, 0, 1); PG8_STAGE(PG8_SB(0, 0), b2, voffB);
            PG8_BAR; PG8_WAIT_L(0); PG8_MMA(0, 1, At, B1); PG8_BAR;
            PG8_LDA(At, 0, 1); PG8_STAGE(PG8_SA(0, 0), a2, voffA);
            PG8_BAR; PG8_WAIT_L(0); PG8_MMA(1, 0, At, B0); PG8_BAR; PG8_SCHED;
            PG8_STAGE(PG8_SB(0, 1), b2 + hstepB, voffB);
            PG8_WAIT_V(6); PG8_BAR; PG8_MMA(1, 1, At, B1); PG8_BAR;
            PG8_LDB(B0, 1, 0); PG8_SCHED; PG8_LDA(At, 1, 0); PG8_STAGE(PG8_SA(0, 1), a2 + hstepA, voffA);
            PG8_WAIT_L(8); PG8_BAR; PG8_WAIT_L(0); PG8_MMA(0, 0, At, B0); PG8_BAR; PG8_SCHED;
            PG8_LDB(B1, 1, 1); PG8_STAGE(PG8_SB(1, 0), b3, voffB);
            PG8_BAR; PG8_WAIT_L(0); PG8_MMA(0, 1, At, B1); PG8_BAR;
            PG8_LDA(At, 1, 1); PG8_STAGE(PG8_SA(1, 0), a3, voffA);
            PG8_BAR; PG8_WAIT_L(0); PG8_MMA(1, 0, At, B0); PG8_BAR; PG8_SCHED;
            PG8_STAGE(PG8_SB(1, 1), b3 + hstepB, voffB);
            PG8_WAIT_V(6); PG8_BAR; PG8_MMA(1, 1, At, B1); PG8_BAR;
        }
        epi_run(g, acc, cur, wr, wc, fr, fq);
        if (!has_next) break;
        { const float z = OZ();
#pragma unroll
        for (int a = 0; a < 2; ++a)
#pragma unroll
            for (int b = 0; b < 2; ++b)
#pragma unroll
                for (int m = 0; m < 4; ++m)
#pragma unroll
                    for (int n = 0; n < 2; ++n) acc[a][b][m][n] = (f32x4){z, z, z, z}; }
        cur = nxt; cA = nA; cB = nB; ++ui;
    }
    PG8_WAIT_V(0);
    if (wr == 0) PG8_BAR;
    PG8_BAR;
#undef PG8_SA
#undef PG8_SB
#undef PG8_STAGE
#undef PG8_LDA
#undef PG8_LDB
#undef PG8_MMA
#undef PG8_WAIT_V
#undef PG8_WAIT_L
#undef PG8_BAR
#undef PG8_SCHED
}
}
using pg8::Unit;
using pg8::cvt_pk_bf16;

#define EPI_FOR_NP(...) \
    _Pragma("unroll") for (int ai = 0; ai < 2; ++ai) _Pragma("unroll") for (int m = 0; m < 4; ++m) { const int row = u.pm * 256 + ai * 128 + wr * 64 + m * 16 + fr; \
    _Pragma("unroll") for (int bj = 0; bj < 2; ++bj) _Pragma("unroll") for (int n = 0; n < 2; ++n) { const int col = u.pn * 256 + bj * 128 + wc * 32 + n * 16 + 4 * fq; const f32x4 v = acc[ai][bj][m][n]; __VA_ARGS__ } }

typedef const f32x4 (&AccRef)[2][2][4][2];

struct EpiWin {
    static constexpr bool PERM = false;
    bh* zg; float* zf;
    __device__ __forceinline__ void operator()(AccRef acc, const Unit& u, int wr, int wc, int fr, int fq) const {
        if (u.pn < 24) {
            EPI_FOR_NP({ u32x2 w; w.x = cvt_pk_bf16(fmaxf(sigmoidf_(v[0]), 1e-6f), fmaxf(sigmoidf_(v[1]), 1e-6f)); w.y = cvt_pk_bf16(fmaxf(sigmoidf_(v[2]), 1e-6f), fmaxf(sigmoidf_(v[3]), 1e-6f)); *(u32x2*)(zg + (size_t)row * NGATE + col) = w; })
        } else {
            EPI_FOR_NP({ *(f32x4*)(zf + (size_t)row * ZF_LD + (col - NGATE)) = v; })
        }
    }
};
struct EpiLoraW {
    static constexpr bool PERM = false;
    const float* w0; float* rw;
    __device__ __forceinline__ void operator()(AccRef acc, const Unit& u, int wr, int wc, int fr, int fq) const {
        EPI_FOR_NP({ const f32x4 b = *(const f32x4*)(w0 + col); f32x4 o;
            _Pragma("unroll") for (int j = 0; j < 4; ++j) { const float x = -(b[j] + v[j]); const float sp = fmaxf(x, 0.f) + log1pf(__expf(-fabsf(x))); o[j] = __expf(-__expf(-sp - 0.5f)); }
            *(f32x4*)(rw + (size_t)row * 512 + col) = o; })
    }
};
struct EpiLoraA {
    static constexpr bool PERM = false;
    const float* a0; const float* ka; const float* rkk; float* rb; float* rk;
    __device__ __forceinline__ void operator()(AccRef acc, const Unit& u, int wr, int wc, int fr, int fq) const {
        EPI_FOR_NP({ const f32x4 b0 = *(const f32x4*)(a0 + col); const f32x4 kav = *(const f32x4*)(ka + col); const size_t o = (size_t)row * 512 + col;
            const f32x4 kkv = *(const f32x4*)(rkk + o); f32x4 kv = *(const f32x4*)(rk + o); f32x4 bo;
            _Pragma("unroll") for (int j = 0; j < 4; ++j) { const float a = sigmoidf_(b0[j] + v[j]); bo[j] = kkv[j] * a; kv[j] = kv[j] * (1.0f + (a - 1.0f) * kav[j]); }
            *(f32x4*)(rb + o) = bo; *(f32x4*)(rk + o) = kv; })
    }
};
struct EpiStoreF32 {
    static constexpr bool PERM = false;
    float* o; int ld;
    __device__ __forceinline__ void operator()(AccRef acc, const Unit& u, int wr, int wc, int fr, int fq) const {
        EPI_FOR_NP({ *(f32x4*)(o + (size_t)row * ld + col) = v; })
    }
};
struct EpiGlu {
    static constexpr bool PERM = false;
    const bh* ys; const float* gb; bh* ycat;
    __device__ __forceinline__ void operator()(AccRef acc, const Unit& u, int wr, int wc, int fr, int fq) const {
        EPI_FOR_NP({ const f32x4 b = *(const f32x4*)(gb + col); const u32x2 y2 = *(const u32x2*)(ys + (size_t)row * 512 + col);
            const float y0 = __uint_as_float(y2.x << 16), y1 = __uint_as_float(y2.x & 0xffff0000u), y2f = __uint_as_float(y2.y << 16), y3 = __uint_as_float(y2.y & 0xffff0000u);
            u32x2 w; w.x = cvt_pk_bf16(y0 * sigmoidf_(v[0] + b[0]), y1 * sigmoidf_(v[1] + b[1])); w.y = cvt_pk_bf16(y2f * sigmoidf_(v[2] + b[2]), y3 * sigmoidf_(v[3] + b[3]));
            *(u32x2*)(ycat + (size_t)row * D + 1536 + col) = w; })
    }
};
template <int MODE> struct EpiUp {
    static constexpr bool PERM = false;
    const bh* zg; float* mix; bh* mixed;
    __device__ __forceinline__ void operator()(AccRef acc, const Unit& u, int wr, int wc, int fr, int fq) const {
        EPI_FOR_NP({ const u32x2 g2 = *(const u32x2*)(zg + (size_t)row * NGATE + col);
            f32x4 g; g[0] = __uint_as_float(g2.x << 16); g[1] = __uint_as_float(g2.x & 0xffff0000u); g[2] = __uint_as_float(g2.y << 16); g[3] = __uint_as_float(g2.y & 0xffff0000u);
            f32x4 r = g * v; float* mp = mix + (size_t)row * D + col;
            if (MODE >= 1) r += *(const f32x4*)mp;
            if (MODE <= 1) *(f32x4*)mp = r;
            else { u32x2 w; w.x = cvt_pk_bf16(r[0], r[1]); w.y = cvt_pk_bf16(r[2], r[3]); *(u32x2*)(mixed + (size_t)row * D + col) = w; } })
    }
};
struct EpiUpF {
    static constexpr bool PERM = false;
    const bh* zg; bh* mixed;
    __device__ __forceinline__ void operator()(AccRef acc, const Unit& u, int wr, int wc, int fr, int fq) const {
        EPI_FOR_NP({ const u32x2 g2 = *(const u32x2*)(zg + (size_t)row * NGATE + col);
            u32x2 w; w.x = cvt_pk_bf16(__uint_as_float(g2.x << 16) * v[0], __uint_as_float(g2.x & 0xffff0000u) * v[1]); w.y = cvt_pk_bf16(__uint_as_float(g2.y << 16) * v[2], __uint_as_float(g2.y & 0xffff0000u) * v[3]);
            *(u32x2*)(mixed + (size_t)row * D + col) = w; })
    }
};
struct EpiRes {
    static constexpr bool PERM = false;
    float* h;
    __device__ __forceinline__ void operator()(AccRef acc, const Unit& u, int wr, int wc, int fr, int fq) const {
        EPI_FOR_NP({ float* hp = h + (size_t)row * D + col; *(f32x4*)hp = *(const f32x4*)hp + v; })
    }
};
struct EpiFfn {
    static constexpr bool PERM = true;
    bh* act;
    __device__ __forceinline__ void operator()(AccRef acc, const Unit& u, int wr, int wc, int fr, int fq) const {
#pragma unroll
        for (int ai = 0; ai < 2; ++ai)
#pragma unroll
            for (int m = 0; m < 4; ++m) { const int row = u.pm * 256 + ai * 128 + wr * 64 + m * 16 + fr; const int col = u.pn * 128 + wc * 32 + 8 * fq;
                float o[8];
#pragma unroll
                for (int n = 0; n < 2; ++n)
#pragma unroll
                    for (int j = 0; j < 4; ++j) { const float gte = acc[ai][0][m][n][j], up = acc[ai][1][m][n][j]; o[n * 4 + j] = gte * sigmoidf_(gte) * up; }
                u32x4 w; w.x = cvt_pk_bf16(o[0], o[1]); w.y = cvt_pk_bf16(o[2], o[3]); w.z = cvt_pk_bf16(o[4], o[5]); w.w = cvt_pk_bf16(o[6], o[7]);
                *(u32x4*)(act + (size_t)row * FH + col) = w; }
    }
};
struct EpiPle {
    static constexpr bool PERM = false;
    float* h; const float* tmp;
    __device__ __forceinline__ void operator()(AccRef acc, const Unit& u, int wr, int wc, int fr, int fq) const {
        EPI_FOR_NP({ float* hp = h + (size_t)row * D + col; const f32x4 tv = *(const f32x4*)(tmp + (size_t)row * D + col); f32x4 hv = *(const f32x4*)hp;
            _Pragma("unroll") for (int j = 0; j < 4; ++j) hv[j] += tv[j] * sigmoidf_(v[j]);
            *(f32x4*)hp = hv; })
    }
};

namespace pg8 {
__device__ __forceinline__ void epi_run(const Gemm& g, const f32x4 (&acc)[2][2][4][2], const Unit& u, int wr, int wc, int fr, int fq) {
    unsigned char* ws = P_WS; const int L = g.L;
    switch (g.epi) {
    case 0: { EpiWin E{(bh*)(ws + OFF_ZG), (float*)(ws + OFF_ZF)}; E(acc, u, wr, wc, fr, fq); } break;
    case 1: { EpiLoraW E{P_IN(9) + L * 512, (float*)(ws + OFF_RW)}; E(acc, u, wr, wc, fr, fq); } break;
    case 2: { EpiLoraA E{P_IN(11) + L * 512, P_IN(15) + L * 512, (const float*)(ws + OFF_RKK), (float*)(ws + OFF_RB), (float*)(ws + OFF_RK)}; E(acc, u, wr, wc, fr, fq); } break;
    case 3: { EpiStoreF32 E{(float*)(ws + (g.N == 512 ? OFF_RG : OFF_MIX32)), g.N}; E(acc, u, wr, wc, fr, fq); } break;
    case 4: { EpiGlu E{(const bh*)(ws + OFF_YS), P_IN(28) + L * 512, (bh*)(ws + OFF_YCAT)}; E(acc, u, wr, wc, fr, fq); } break;
    case 5: { EpiUp<0> E{(const bh*)(ws + OFF_ZG), (float*)(ws + OFF_MIX32), (bh*)(ws + OFF_ABF)}; E(acc, u, wr, wc, fr, fq); } break;
    case 6: { EpiUp<1> E{(const bh*)(ws + OFF_ZG) + 2048, (float*)(ws + OFF_MIX32), (bh*)(ws + OFF_ABF)}; E(acc, u, wr, wc, fr, fq); } break;
    case 7: { EpiUp<2> E{(const bh*)(ws + OFF_ZG) + 4096, (float*)(ws + OFF_MIX32), (bh*)(ws + OFF_ABF)}; E(acc, u, wr, wc, fr, fq); } break;
    case 8: { EpiRes E{P_OUT}; E(acc, u, wr, wc, fr, fq); } break;
    case 9: { EpiFfn E{(bh*)(ws + OFF_ACT)}; E(acc, u, wr, wc, fr, fq); } break;
    case 11: { EpiUpF E{(const bh*)(ws + OFF_ZG) + 4096, (bh*)(ws + OFF_ABF)}; E(acc, u, wr, wc, fr, fq); } break;
    default: { EpiPle E{P_OUT, (const float*)(ws + OFF_MIX32)}; E(acc, u, wr, wc, fr, fq); } break;
    }
}
}

__device__ __forceinline__ bool make_gemm(const Params& p, int L, int q, int i, pg8::Gemm& g) {
    unsigned char* ws = P_WS;
    g.M = T; g.perm = 0; g.L = L;
    switch (q) {
    case 1: if (i > 0) return false;
        g.A = (const bh*)(ws + OFF_ABF); g.lda = D; g.Bt = (const bh*)(ws + OFF_WIN); g.ldb = D; g.N = NINP; g.K = D; g.epi = 0; return true;
    case 3: if (i > 2) return false;
        g.lda = 256; g.ldb = 256; g.N = 512; g.K = 256;
        if (i == 0) { g.A = (const bh*)(ws + OFF_LAW); g.Bt = (const bh*)(ws + OFF_WW2); g.epi = 1; }
        else if (i == 1) { g.A = (const bh*)(ws + OFF_LAA); g.Bt = (const bh*)(ws + OFF_WA2); g.epi = 2; }
        else { g.A = (const bh*)(ws + OFF_LAG); g.Bt = (const bh*)(ws + OFF_WG2); g.epi = 3; }
        return true;
    case 5: if (i > 0) return false;
        g.A = (const bh*)(ws + OFF_YS); g.lda = 512; g.Bt = (const bh*)(ws + OFF_WGLU); g.ldb = 512; g.N = 512; g.K = 512; g.epi = 4; return true;
    case 6: if (i > 0) return false;
        g.A = (const bh*)(ws + OFF_YCAT); g.lda = D; g.Bt = (const bh*)(ws + OFF_WUP); g.ldb = D; g.N = D; g.K = D; g.epi = 11; return true;
    case 7: if (i > 0) return false;
        g.A = (const bh*)(ws + OFF_ABF); g.lda = D; g.Bt = (const bh*)(ws + OFF_WO); g.ldb = D; g.N = D; g.K = D; g.epi = 8; return true;
    case 9: if (i > 0) return false;
        g.A = (const bh*)(ws + OFF_ABF); g.lda = D; g.Bt = (const bh*)(ws + OFF_WGU); g.ldb = D; g.N = 2 * FH; g.K = D; g.epi = 9; g.perm = 1; return true;
    case 10: if (i > 0) return false;
        g.A = (const bh*)(ws + OFF_ACT); g.lda = FH; g.Bt = (const bh*)(ws + OFF_WD); g.ldb = FH; g.N = D; g.K = FH; g.epi = 8; return true;
    case 12: if (i > 1) return false;
        if (i == 0) { g.A = (const bh*)(ws + OFF_PBF) + (size_t)L * T * 256; g.lda = 256; g.Bt = (const bh*)(ws + OFF_WPP); g.ldb = 256; g.N = D; g.K = 256; g.epi = 3; }
        else { g.A = (const bh*)(ws + OFF_ABF); g.lda = D; g.Bt = (const bh*)(ws + OFF_WPG); g.ldb = D; g.N = D; g.K = D; g.epi = 10; }
        return true;
    default: return false;
    }
}

struct CJ { const float* src; int in_idx, src_ld, kv, n0, nv; long lstride; size_t dst; int dst_ld, r0, c0, npad, kpad, seg, segstride; };
constexpr int BIGSEG = 1 << 30;
__constant__ int JT_I[15][12] = {
    {3, NIN, 2048, NF, NGATE, D, 0, 0, NGATE, 2048, BIGSEG, 0},
    {3, NIN, 2048, 0, NF, D, NGATE, 0, 6656, 2048, BIGSEG, 0},
    {29, D, 1024, 0, D, D, 0, 0, D, 1024, BIGSEG, 0},
    {30, D, 512, 0, D, D, 0, 1024, D, 512, BIGSEG, 0},
    {31, D, 512, 0, D, D, 0, 1536, D, 512, BIGSEG, 0},
    {32, D, 2048, 0, D, D, 0, 0, D, 2048, BIGSEG, 0},
    {34, FH, 2048, 0, FH, D, 0, 0, FH, 2048, 128, 256},
    {35, FH, 2048, 0, FH, D, 128, 0, FH, 2048, 128, 256},
    {36, D, FH, 0, D, FH, 0, 0, D, FH, BIGSEG, 0},
    {38, D, 2048, 0, D, D, 0, 0, D, 2048, BIGSEG, 0},
    {39, D, 256, 0, D, 256, 0, 0, D, 256, BIGSEG, 0},
    {27, 512, 512, 0, 512, 512, 0, 0, 512, 512, BIGSEG, 0},
    {10, 512, 96, 0, 512, 256, 0, 0, 512, 256, BIGSEG, 0},
    {12, 512, 96, 0, 512, 256, 0, 0, 512, 256, BIGSEG, 0},
    {13, 512, 256, 0, 512, 256, 0, 0, 512, 256, BIGSEG, 0}};
__constant__ long JT_L[15][2] = {
    {(long)D * NIN, (long)OFF_WIN}, {(long)D * NIN, (long)OFF_WIN}, {(long)1024 * D, (long)OFF_WUP}, {(long)512 * D, (long)OFF_WUP}, {(long)512 * D, (long)OFF_WUP},
    {(long)D * D, (long)OFF_WO}, {(long)D * FH, (long)OFF_WGU}, {(long)D * FH, (long)OFF_WGU}, {(long)FH * D, (long)OFF_WD}, {(long)D * D, (long)OFF_WPG},
    {(long)256 * D, (long)OFF_WPP}, {(long)512 * 512, (long)OFF_WGLU}, {(long)96 * 512, (long)OFF_WW2}, {(long)96 * 512, (long)OFF_WA2}, {(long)256 * 512, (long)OFF_WG2}};
__device__ __forceinline__ void get_job(int j, CJ& J) {
    J.in_idx = JT_I[j][0]; J.src_ld = JT_I[j][1]; J.kv = JT_I[j][2]; J.n0 = JT_I[j][3]; J.nv = JT_I[j][4]; J.dst_ld = JT_I[j][5]; J.r0 = JT_I[j][6]; J.c0 = JT_I[j][7];
    J.npad = JT_I[j][8]; J.kpad = JT_I[j][9]; J.seg = JT_I[j][10]; J.segstride = JT_I[j][11]; J.lstride = JT_L[j][0]; J.dst = (size_t)JT_L[j][1];
}
__device__ __forceinline__ const float* in_by_idx(const Params& p, int i) { return P_IN(i); }
constexpr int NJOBS = 15;

__device__ __forceinline__ void conv_tile(int L, const CJ& J, int tile, int lane, bh* dstbase) {
    const int nkt = J.kpad / 64; const int tn = tile / nkt, tk = tile % nkt;
    const float* src = J.src + (size_t)L * J.lstride;
    const int cq = lane & 15, r = lane >> 4;
    const int nl = tn * 64 + cq * 4; const bool nok = nl < J.nv;
    const int k0 = tk * 64 + 16 * r;
    f32x4 v[16];
    const float* sp = src + (size_t)k0 * J.src_ld + J.n0 + nl;
    const float zc = OZ();
#pragma unroll
    for (int i = 0; i < 16; ++i) { v[i] = (f32x4){zc, zc, zc, zc}; if (nok && (k0 + i) < J.kv) v[i] = *(const f32x4*)(sp + (size_t)i * J.src_ld); }
#pragma unroll
    for (int j = 0; j < 4; ++j) { const int n = nl + j; const int drow = J.r0 + (n / J.seg) * J.segstride + (n % J.seg);
        u32x4 w0, w1;
        w0.x = cvt_pk_bf16(v[0][j], v[1][j]); w0.y = cvt_pk_bf16(v[2][j], v[3][j]); w0.z = cvt_pk_bf16(v[4][j], v[5][j]); w0.w = cvt_pk_bf16(v[6][j], v[7][j]);
        w1.x = cvt_pk_bf16(v[8][j], v[9][j]); w1.y = cvt_pk_bf16(v[10][j], v[11][j]); w1.z = cvt_pk_bf16(v[12][j], v[13][j]); w1.w = cvt_pk_bf16(v[14][j], v[15][j]);
        bh* d = dstbase + (size_t)drow * J.dst_ld + J.c0 + k0;
        *(u32x4*)d = w0; *(u32x4*)(d + 8) = w1; }
}

__device__ __forceinline__ void rms_row_bf16(const float* x, const float* g, bh* o, int lane) {
    f32x4 v[8]; float s = 0.f;
#pragma unroll
    for (int j = 0; j < 8; ++j) { v[j] = *(const f32x4*)(x + j * 256 + lane * 4); s += (v[j][0] * v[j][0] + v[j][1] * v[j][1]) + (v[j][2] * v[j][2] + v[j][3] * v[j][3]); }
    const float rstd = rsqrtf(wave_sum(s) * (1.0f / D) + 1e-6f);
#pragma unroll
    for (int j = 0; j < 8; ++j) { const f32x4 gg = *(const f32x4*)(g + j * 256 + lane * 4); u32x2 w; w.x = pk2(v[j][0] * rstd * gg[0], v[j][1] * rstd * gg[1]); w.y = pk2(v[j][2] * rstd * gg[2], v[j][3] * rstd * gg[3]);
        *(u32x2*)(o + j * 256 + lane * 4) = w; }
}
__device__ __forceinline__ void phase_rmsnorm(const Params& p, const float* g) {
    const int gw = BIDX() * 8 + (TIDX() >> 6), NGW = GDIM() * 8, lane = TIDX() & 63;
    bh* abf = (bh*)(P_WS + OFF_ABF);
    for (int r = gw; r < T; r += NGW) rms_row_bf16(P_OUT + (size_t)r * D, g, abf + (size_t)r * D, lane);
}

__device__ __forceinline__ void phase_conv(const Params& p, int L, LAS unsigned char* lds) {
    const int tid = TIDX();
    {   const int gw0 = BIDX() * 8 + (tid >> 6), NGW0 = GDIM() * 8, ln = tid & 63;
        int base = 0;
        for (int j = 0; j < NJOBS; ++j) { CJ J; get_job(j, J); J.src = in_by_idx(p, J.in_idx); const int ntile = (J.npad / 64) * (J.kpad / 64);
            int first = gw0 - (base % NGW0); if (first < 0) first += NGW0;
            bh* dstbase = (bh*)(P_WS + J.dst);
            for (int t = first; t < ntile; t += NGW0) conv_tile(L, J, t, ln, dstbase);
            base += ntile; } }
    const int gw = BIDX() * 8 + (tid >> 6), NGW = GDIM() * 8, lane = tid & 63;
    bh* abf = (bh*)(P_WS + OFF_ABF);
    if (L == 0) {
        const float* ps = P_IN(1); bh* pb = (bh*)(P_WS + OFF_PBF);
        for (size_t i = (size_t)BIDX() * 512 + tid; i < (size_t)2 * T * 256 / 4; i += (size_t)GDIM() * 512) { const f32x4 v = ((const f32x4*)ps)[i]; u32x2 w; w.x = pk2(v[0], v[1]); w.y = pk2(v[2], v[3]); ((u32x2*)pb)[i] = w; }
        const float* x = P_IN(0);
        for (int r = gw; r < T; r += NGW) {
#pragma unroll
            for (int j = 0; j < 8; ++j) *(f32x4*)(P_OUT + (size_t)r * D + j * 256 + lane * 4) = *(const f32x4*)(x + (size_t)r * D + j * 256 + lane * 4);
            rms_row_bf16(x + (size_t)r * D, P_IN(2), abf + (size_t)r * D, lane);
        }
    } else {
        for (int r = gw; r < T; r += NGW) rms_row_bf16(P_OUT + (size_t)r * D, P_IN(2) + (size_t)L * D, abf + (size_t)r * D, lane);
    }
}

struct S5C { float ar, ai; float br[16], bi[16]; };
__device__ __forceinline__ void s5_setup(const Params& p, int L, int g, int n, S5C& c) {
    const int gi = L * 32 + g;
    const float dt = __expf(P_IN(21)[gi]);
    const float are = P_IN(19)[gi * 64 + n], aim = P_IN(20)[gi * 64 + n];
    const float mag = __expf(are * dt), ang = aim * dt;
    float sn, cs;
    {
        const double a = (double)ang; const double k = rint(a * 0.15915494309189535); const float r = (float)(a - k * 6.283185307179586);
        sn = sinf(r); cs = cosf(r);
    }
    c.ar = mag * cs; c.ai = mag * sn;
    const float den = are * are + aim * aim, nr = c.ar - 1.0f, ni = c.ai;
    const float cr = (nr * are + ni * aim) / den, ci = (ni * are - nr * aim) / den;
    const float* bre = P_IN(22) + ((size_t)gi * 64 + n) * 16; const float* bim = P_IN(23) + ((size_t)gi * 64 + n) * 16;
#pragma unroll
    for (int q = 0; q < 4; ++q) { const f32x4 r4 = *(const f32x4*)(bre + q * 4), i4 = *(const f32x4*)(bim + q * 4);
#pragma unroll
        for (int j = 0; j < 4; ++j) { c.br[q * 4 + j] = cr * r4[j] - ci * i4[j]; c.bi[q * 4 + j] = cr * i4[j] + ci * r4[j]; } }
}
__device__ __forceinline__ void s5_step(const S5C& c, const LAS float* urow, float& sr, float& si) {
    float xr = 0.f, xi = 0.f;
#pragma unroll
    for (int q = 0; q < 4; ++q) { const f32x4 u4 = *(const LAS f32x4*)(urow + q * 4);
#pragma unroll
        for (int j = 0; j < 4; ++j) { xr = fmaf(u4[j], c.br[q * 4 + j], xr); xi = fmaf(u4[j], c.bi[q * 4 + j], xi); } }
    const float nr = c.ar * sr - c.ai * si + xr, ni = c.ar * si + c.ai * sr + xi;
    sr = nr; si = ni;
}
__device__ __forceinline__ void s5_stage_u(const float* zfc, LAS float* ul, int lane) {
    const float* src = zfc + (size_t)lane * ZF_LD;
    const f32x4 a = *(const f32x4*)src, b = *(const f32x4*)(src + 4), c = *(const f32x4*)(src + 8), d = *(const f32x4*)(src + 12);
    *(LAS f32x4*)(ul + lane * 16) = a; *(LAS f32x4*)(ul + lane * 16 + 4) = b; *(LAS f32x4*)(ul + lane * 16 + 8) = c; *(LAS f32x4*)(ul + lane * 16 + 12) = d;
    asm volatile("s_waitcnt lgkmcnt(0)" ::: "memory"); __builtin_amdgcn_wave_barrier();
}

__device__ __forceinline__ size_t fq_base(int h, int c, int mt, int ks8) { return ((((size_t)(h * NCH + c) * 4 + mt) * 8 + ks8) * 64) * 8; }
__device__ __forceinline__ size_t fq_off(int h, int t, int d) { const int s = t & 63; return fq_base(h, t >> 6, s >> 4, d >> 5) + ((s & 15) + 16 * ((d >> 3) & 3)) * 8 + (d & 7); }
__device__ __forceinline__ int ft_off(int row, int s8) { return ((((row >> 5) * 4 + (s8 >> 1)) * 64) + (row & 31) + 32 * (s8 & 1)) * 8; }

__device__ __forceinline__ void mlstm_prep(const Params& p, int L, int h, int c, LAS unsigned char* lds) {
    const int tid = TIDX(), t0 = c * 64;
    const float* zf = (const float*)(P_WS + OFF_ZF);
    LAS float* s_ws = (LAS float*)lds;
    if (tid < 64) {
        const int t = t0 + tid;
        float ig = zf[(size_t)t * ZF_LD + 4096 + h] + P_IN(5)[L * 4 + h];
        float fg = zf[(size_t)t * ZF_LD + 4100 + h] + P_IN(6)[L * 4 + h];
        ig = 15.0f * tanhf(ig * (1.0f / 15.0f)); fg = 15.0f * tanhf(fg * (1.0f / 15.0f));
        const float lf = fminf(fg, 0.f) - log1pf(__expf(-fabsf(fg)));
        float b = lf;
#pragma unroll
        for (int o = 1; o < 64; o <<= 1) { const float nb = bperm_f((tid - o) & 63, b); if (tid >= o) b += nb; }
        const float bend = bperm_f(63, b);
        const float wlog = bend - b + ig;
        const float mloc = wave_max(wlog);
        s_ws[tid] = __expf(wlog - mloc);
        ((float*)(P_WS + OFF_MI))[h * T + t] = ig; ((float*)(P_WS + OFF_MBB))[h * T + t] = b;
        if (tid == 0) { ((float*)(P_WS + OFF_MBEND))[h * NCH + c] = bend; ((float*)(P_WS + OFF_MLOC))[h * NCH + c] = mloc; }
    }
    __syncthreads();
    const int d = tid & 255, isk = tid >> 8;
    const int col = isk * 1024 + h * 256 + d;
    const float* cw = P_IN(4) + (size_t)L * 4 * 2048;
    const float w0 = cw[col], w1 = cw[2048 + col], w2 = cw[4096 + col], w3 = cw[6144 + col];
    float x1 = (t0 >= 1) ? zf[(size_t)(t0 - 1) * ZF_LD + col] : 0.f, x2 = (t0 >= 2) ? zf[(size_t)(t0 - 2) * ZF_LD + col] : 0.f, x3 = (t0 >= 3) ? zf[(size_t)(t0 - 3) * ZF_LD + col] : 0.f;
    bh* MQ = (bh*)(P_WS + OFF_MQ); bh* MK = (bh*)(P_WS + OFF_MK);
    bh* MT = (bh*)(P_WS + (isk ? OFF_MKT : OFF_MVT)) + (size_t)(h * NCH + c) * 16384;
    LAS bh* sQK = (LAS bh*)(lds + 1024);
    float dnacc = 0.f;
    for (int s8 = 0; s8 < 8; ++s8) {
        unsigned pk[4];
#pragma unroll
        for (int j = 0; j < 8; ++j) { const int s = s8 * 8 + j, t = t0 + s;
            const float x0 = zf[(size_t)t * ZF_LD + col]; float y = w0 * x0 + w1 * x1 + w2 * x2 + w3 * x3; x3 = x2; x2 = x1; x1 = x0;
            y = y * sigmoidf_(y);
            unsigned short e;
            if (!isk) { sQK[s * 264 + d] = f2bf(y * 0.0625f); e = f2bf(zf[(size_t)t * ZF_LD + 2048 + h * 256 + d]); }
            else { sQK[64 * 264 + s * 264 + d] = f2bf(y); const float wk = y * s_ws[s]; e = f2bf(wk); dnacc += wk; }
            if (j & 1) pk[j >> 1] |= ((unsigned)e << 16); else pk[j >> 1] = e; }
        u32x4 w; w.x = pk[0]; w.y = pk[1]; w.z = pk[2]; w.w = pk[3];
        *(u32x4*)(MT + ft_off(d, s8)) = w;
    }
    if (isk) ((float*)(P_WS + OFF_DN))[(size_t)(h * NCH + c) * 256 + d] = dnacc;
    __syncthreads();
#pragma unroll
    for (int i = 0; i < 8; ++i) { const int pid = i * 512 + tid, tens = pid >> 11, rem = pid & 2047, mt = rem >> 9, ks8 = (rem >> 6) & 7, lp = rem & 63;
        const u32x4 w = *(const LAS u32x4*)(sQK + tens * (64 * 264) + (mt * 16 + (lp & 15)) * 264 + ks8 * 32 + (lp >> 4) * 8);
        *(u32x4*)((tens ? MK : MQ) + fq_base(h, c, mt, ks8) + lp * 8) = w; }
    __syncthreads();
}

__device__ __forceinline__ void rwkv_prep_token(const Params& p, int L, int t, int lane) {
    const float* zf = (const float*)(P_WS + OFF_ZF);
    const float* z = zf + (size_t)t * ZF_LD + ZR0; const float* zp = z - ZF_LD; const bool hp = t > 0;
    const float* mu = P_IN(8) + (size_t)L * 1984;
    float* RR = (float*)(P_WS + OFF_RR); float* RK = (float*)(P_WS + OFF_RK); float* RV = (float*)(P_WS + OFF_RV); float* RKK = (float*)(P_WS + OFF_RKK);
    const float* kkw = P_IN(14) + L * 512;
#pragma unroll
    for (int i = 0; i < 8; ++i) { const int c = i * 64 + lane;
        { const float a = z[c], b = hp ? zp[c] : 0.f; RR[(size_t)t * 512 + c] = a + (b - a) * mu[c]; }
        { const float a = z[1024 + c], b = hp ? zp[1024 + c] : 0.f; RV[(size_t)t * 512 + c] = a + (b - a) * mu[1024 + c]; }
        { const float a = z[512 + c], b = hp ? zp[512 + c] : 0.f; const float k = a + (b - a) * mu[512 + c]; RK[(size_t)t * 512 + c] = k;
          const float kkv = k * kkw[c]; const float ss = wave_sum(kkv * kkv); RKK[(size_t)t * 512 + c] = kkv / fmaxf(sqrtf(ss), 1e-12f); } }
    bh* LAW = (bh*)(P_WS + OFF_LAW) + (size_t)t * 256; bh* LAA = (bh*)(P_WS + OFF_LAA) + (size_t)t * 256; bh* LAG = (bh*)(P_WS + OFF_LAG) + (size_t)t * 256;
#pragma unroll
    for (int i = 0; i < 4; ++i) { const int j = i * 64 + lane;
        float vw = 0.f, va = 0.f;
        if (j < 96) { { const int c = 1536 + j; const float a = z[c], b = hp ? zp[c] : 0.f; vw = tanhf(a + (b - a) * mu[c]); }
                      { const int c = 1632 + j; const float a = z[c], b = hp ? zp[c] : 0.f; va = a + (b - a) * mu[c]; } }
        LAW[j] = f2bf(vw); LAA[j] = f2bf(va);
        { const int c = 1728 + j; const float a = z[c], b = hp ? zp[c] : 0.f; LAG[j] = f2bf(sigmoidf_(a + (b - a) * mu[c])); } }
}

__device__ __forceinline__ void s5_pass_a(const Params& p, int L, int g, int c, int lane, LAS float* ul) {
    const float* zf = (const float*)(P_WS + OFF_ZF) + (size_t)(c * 64) * ZF_LD + ZS0 + g * 16;
    s5_stage_u(zf, ul, lane);
    S5C k; s5_setup(p, L, g, lane, k);
    float sr = 0.f, si = 0.f;
#pragma unroll 8
    for (int s = 0; s < 64; ++s) s5_step(k, ul + s * 16, sr, si);
    asm volatile("s_waitcnt lgkmcnt(0)" ::: "memory"); __builtin_amdgcn_wave_barrier();
    float* se = (float*)(P_WS + OFF_SEND) + ((size_t)(g * NCH + c) * 64 + lane) * 2;
    se[0] = sr; se[1] = si;
}

__device__ __forceinline__ void phase_prep(const Params& p, int L, LAS unsigned char* lds) {
    const int wid = TIDX() >> 6, lane = TIDX() & 63;
    for (int it = BIDX(); it < 2048; it += GDIM()) {
        if (it < 512) mlstm_prep(p, L, it >> 7, it & 127, lds);
        else if (it < 1536) rwkv_prep_token(p, L, (it - 512) * 8 + wid, lane);
        else { const int w = (it - 1536) * 8 + wid; s5_pass_a(p, L, w >> 7, w & 127, lane, (LAS float*)lds + wid * 1024); }
    }
}

constexpr int RW_NS = 4, RW_LS = T / RW_NS, RW_NB = RW_LS / 16, RW_RING = 4, RW_SLOT = 16 * 384;
constexpr int RW_YOFF = RW_RING * RW_SLOT;
__device__ __forceinline__ void rwkv_scan(const Params& p, int b, LAS unsigned char* lds) {
    const int tid = TIDX(), wid = __builtin_amdgcn_readfirstlane(tid >> 6), lane = tid & 63;
    int j, h, rg;
    if (b < 32) { j = 0; h = b >> 2; rg = b & 3; } else { const int u = b - 32; j = 1 + (u >> 6); h = (u & 63) >> 3; rg = u & 7; }
    LAS float* ring = (LAS float*)lds;
    LAS float* ybuf = ring + RW_YOFF;
    const int tbase = j * RW_LS;
    const bool isP = rg >= 4;
    if (wid >= 4) {
        const int lw = wid - 4, lt = tid - 256;
        const float* gp[6]; unsigned lo[6];
#pragma unroll
        for (int i = 0; i < 6; ++i) { const int ii = lw * 6 + i, rowidx = ii * 4 + (lane >> 4), step = rowidx / 6, a = rowidx % 6, q = lane & 15;
            const int ai = (0x205314 >> (4 * a)) & 0xf;
            gp[i] = (const float*)(P_WS + OFF_RR + (size_t)ai * SZ_R) + (size_t)(tbase + step) * 512 + h * 64 + q * 4;
            lo[i] = (unsigned)ii * 256u; }
        float* OUT = (float*)(P_WS + (isP ? OFF_RZ : OFF_RY)) + (size_t)(tbase + (lt >> 4)) * 512 + h * 64 + (rg & 3) * 16 + (lt & 15);
#define RW_ISSUE(bi, sl) do { _Pragma("unroll") for (int _i = 0; _i < 6; ++_i) \
        __builtin_amdgcn_global_load_lds((const unsigned*)(gp[_i] + (size_t)(bi) * 16 * 512), (LAS unsigned*)(ring + (sl) * RW_SLOT + lo[_i]), 16, 0, 0); } while (0)
        RW_ISSUE(0, 0); RW_ISSUE(1, 1); RW_ISSUE(2, 2);
        asm volatile("s_waitcnt vmcnt(12)" ::: "memory"); __builtin_amdgcn_s_barrier();
        int sl = 3;
        for (int ib = 0; ib < RW_NB; ++ib) {
            if (ib + 3 < RW_NB) RW_ISSUE(ib + 3, sl);
            sl = (sl == RW_RING - 1) ? 0 : sl + 1;
            if (ib > 0) {
                const LAS float* yb = ybuf + ((ib - 1) & 1) * 4096 + lt * 16;
                const f32x4 a0 = *(const LAS f32x4*)yb, a1 = *(const LAS f32x4*)(yb + 4), a2 = *(const LAS f32x4*)(yb + 8), a3 = *(const LAS f32x4*)(yb + 12);
                const f32x4 sm = (a0 + a1) + (a2 + a3);
                OUT[(size_t)(ib - 1) * 16 * 512] = (sm[0] + sm[1]) + (sm[2] + sm[3]);
            }
            if (ib + 3 < RW_NB) asm volatile("s_waitcnt vmcnt(13)" ::: "memory");
            else asm volatile("s_waitcnt vmcnt(0)" ::: "memory");
            __builtin_amdgcn_s_barrier();
        }
        {   const LAS float* yb = ybuf + ((RW_NB - 1) & 1) * 4096 + lt * 16;
            const f32x4 a0 = *(const LAS f32x4*)yb, a1 = *(const LAS f32x4*)(yb + 4), a2 = *(const LAS f32x4*)(yb + 8), a3 = *(const LAS f32x4*)(yb + 12);
            const f32x4 sm = (a0 + a1) + (a2 + a3);
            OUT[(size_t)(RW_NB - 1) * 16 * 512] = (sm[0] + sm[1]) + (sm[2] + sm[3]); }
#undef RW_ISSUE
    } else {
        const int r16 = wid * 4 + (lane >> 4), kq = lane & 15, row = (rg & 3) * 16 + r16;
        f32x4 S;
#pragma unroll
        for (int e = 0; e < 4; ++e) S[e] = (isP && (kq * 4 + e == row)) ? 1.f : 0.f;
        const float vmask = isP ? 0.f : 1.f;
        __builtin_amdgcn_s_barrier();
        int sl = 0;
        for (int ib = 0; ib < RW_NB; ++ib) {
            const LAS float* bb = ring + sl * RW_SLOT;
            LAS float* yw = ybuf + (ib & 1) * 4096 + r16 * 16 + kq;
            f32x4 w4 = *(const LAS f32x4*)(bb + kq * 4), k4 = *(const LAS f32x4*)(bb + 64 + kq * 4), kk4 = *(const LAS f32x4*)(bb + 128 + kq * 4),
                  b4 = *(const LAS f32x4*)(bb + 192 + kq * 4), r4 = *(const LAS f32x4*)(bb + 256 + kq * 4);
            float vv = bb[320 + row];
#pragma unroll
            for (int s = 0; s < 16; ++s) {
                f32x4 w4n, k4n, kk4n, b4n, r4n; float vvn;
                if (s < 15) { const LAS float* q = bb + (s + 1) * 384;
                    w4n = *(const LAS f32x4*)(q + kq * 4); k4n = *(const LAS f32x4*)(q + 64 + kq * 4); kk4n = *(const LAS f32x4*)(q + 128 + kq * 4);
                    b4n = *(const LAS f32x4*)(q + 192 + kq * 4); r4n = *(const LAS f32x4*)(q + 256 + kq * 4); vvn = q[320 + row]; }
                __builtin_amdgcn_sched_barrier(0);
                float pd = (S[0] * kk4[0] + S[1] * kk4[1]) + (S[2] * kk4[2] + S[3] * kk4[3]);
                const f32x4 pre = S * w4 + (vv * vmask) * k4;
                pd = allreduce16(pd);
                S = pre - pd * b4;
                yw[s * 256] = (S[0] * r4[0] + S[1] * r4[1]) + (S[2] * r4[2] + S[3] * r4[3]);
                if (s < 15) { w4 = w4n; k4 = k4n; kk4 = kk4n; b4 = b4n; r4 = r4n; vv = vvn; }
            }
            sl = (sl == RW_RING - 1) ? 0 : sl + 1;
            asm volatile("s_waitcnt lgkmcnt(0)" ::: "memory");
            __builtin_amdgcn_s_barrier();
        }
        float* EN = (float*)(P_WS + (isP ? OFF_RPEND : OFF_RSEND)) + ((size_t)(h * 4 + j) * 64 + row) * 64 + kq * 4;
        *(f32x4*)EN = S;
    }
    __syncthreads();
}

struct MStage { bf16x8 q[4], k[4], v[4]; float bend, mloc; };
__device__ __forceinline__ void mstage_load(MStage& st, const bh* qp, const bh* kp, const bh* vp, const float* MBEND, const float* MLOC, int h, int c) {
#pragma unroll
    for (int ks = 0; ks < 4; ++ks) { st.q[ks] = *(const bf16x8*)(qp + (size_t)c * 16384 + ks * 512); st.k[ks] = *(const bf16x8*)(kp + (size_t)c * 16384 + ks * 512); st.v[ks] = *(const bf16x8*)(vp + (size_t)c * 16384 + ks * 512); }
    st.bend = MBEND[h * NCH + c]; st.mloc = MLOC[h * NCH + c];
}
__device__ __forceinline__ void mlstm_seq(const Params& p, int mb, LAS unsigned char* lds) {
    const int tid = TIDX(), wid = tid >> 6, lane = tid & 63;
    const int h = mb >> 3, jv = mb & 7;
    LAS bh* Cbf = (LAS bh*)lds;
    constexpr int CS = 264;
    for (int i = tid; i < 2 * 32 * CS / 2; i += 512) ((LAS unsigned*)Cbf)[i] = 0u;
    __syncthreads();
    const bh* MQ = (const bh*)(P_WS + OFF_MQ); const bh* MKT = (const bh*)(P_WS + OFF_MKT); const bh* MVT = (const bh*)(P_WS + OFF_MVT);
    const float* MBEND = (const float*)(P_WS + OFF_MBEND); const float* MLOC = (const float*)(P_WS + OFF_MLOC);
    f32x16 ct;
    { const float z = OZ();
#pragma unroll
    for (int i = 0; i < 16; ++i) ct[i] = z; }
    float m = 0.f;
    const int mt = wid >> 1, kh = wid & 1;
    float* MINTER = (float*)(P_WS + OFF_ABF);
    LAS float* It = (LAS float*)(lds + 2 * 32 * 264 * 2);
    const bh* qp = MQ + fq_base(h, 0, mt, kh * 4) + lane * 8;
    const bh* kp = MKT + (size_t)(h * NCH) * 16384 + (wid * 4 * 64 + lane) * 8;
    const bh* vp = MVT + (size_t)(h * NCH) * 16384 + (jv * 4 * 64 + lane) * 8;
    MStage s0, s1, s2;
    mstage_load(s0, qp, kp, vp, MBEND, MLOC, h, 0);
    mstage_load(s1, qp, kp, vp, MBEND, MLOC, h, 1);
#define MSTEP(SC, SL, CIDX) do { const int c = (CIDX); const int t0 = c * 64, cur = c & 1; \
        mstage_load(SL, qp, kp, vp, MBEND, MLOC, h, (c + 2 < NCH) ? c + 2 : NCH - 1); \
        const float mnew = fmaxf(SC.bend + m, SC.mloc), decay = __expf(SC.bend + m - mnew), scale = __expf(SC.mloc - mnew); \
        f32x4 r0 = {0.f, 0.f, 0.f, 0.f}, r1 = {0.f, 0.f, 0.f, 0.f}; \
        const LAS bh* cb = Cbf + cur * 32 * CS + (lane & 15) * CS + kh * 128 + (lane >> 4) * 8; \
        _Pragma("unroll") for (int ks = 0; ks < 4; ++ks) { const bf16x8 b0 = *(const LAS bf16x8*)(cb + ks * 32), b1 = *(const LAS bf16x8*)(cb + 16 * CS + ks * 32); r0 = MFMA16(SC.q[ks], b0, r0); r1 = MFMA16(SC.q[ks], b1, r1); } \
        {     \
            if (c > 0) { const LAS float* ip = It + ((c - 1) & 1) * (2 * 64 * 36) + (tid >> 3) * 36 + (tid & 7) * 4; \
                const f32x4 sv = *(const LAS f32x4*)ip + *(const LAS f32x4*)(ip + 64 * 36); \
                float* o = MINTER + (size_t)(t0 - 64 + (tid >> 3)) * 1024 + h * 256 + jv * 32 + (tid & 7) * 4; \
                asm volatile("global_store_dwordx4 %0, %1, off\n\ts_nop 1" :: "v"(o), "v"(sv) : "memory"); } \
            LAS float* iw = It + cur * (2 * 64 * 36) + kh * (64 * 36) + (mt * 16 + (lane >> 4) * 4) * 36 + (lane & 15); \
            _Pragma("unroll") for (int r = 0; r < 4; ++r) { iw[r * 36] = r0[r]; iw[r * 36 + 16] = r1[r]; } } \
        f32x16 d0; { const float z = OZ(); _Pragma("unroll") for (int i = 0; i < 16; ++i) d0[i] = z; } \
        _Pragma("unroll") for (int ks = 0; ks < 4; ++ks) d0 = MFMA32(SC.k[ks], SC.v[ks], d0); \
        _Pragma("unroll") for (int i = 0; i < 16; ++i) ct[i] = decay * ct[i] + scale * d0[i]; \
        m = mnew; \
        {   LAS bh* o0 = Cbf + (cur ^ 1) * 32 * CS + (lane & 31) * CS + wid * 32 + 4 * (lane >> 5); \
            _Pragma("unroll") for (int g = 0; g < 4; ++g) { u32x2 w0; w0.x = cvt_pk_bf16(ct[4 * g], ct[4 * g + 1]); w0.y = cvt_pk_bf16(ct[4 * g + 2], ct[4 * g + 3]); *(LAS u32x2*)(o0 + 8 * g) = w0; } } \
        asm volatile("s_waitcnt lgkmcnt(0)" ::: "memory"); __builtin_amdgcn_s_barrier(); asm volatile("" ::: "memory"); } while (0)
    for (int c3 = 0; c3 < 126; c3 += 6) { MSTEP(s0, s2, c3); MSTEP(s1, s0, c3 + 1); MSTEP(s2, s1, c3 + 2); MSTEP(s0, s2, c3 + 3); MSTEP(s1, s0, c3 + 4); MSTEP(s2, s1, c3 + 5); }
    MSTEP(s0, s2, 126); MSTEP(s1, s0, 127);
#undef MSTEP
    {   const LAS float* ip = It + (127 & 1) * (2 * 64 * 36) + (tid >> 3) * 36 + (tid & 7) * 4;
        const f32x4 sv = *(const LAS f32x4*)ip + *(const LAS f32x4*)(ip + 64 * 36);
        *(f32x4*)(MINTER + (size_t)(127 * 64 + (tid >> 3)) * 1024 + h * 256 + jv * 32 + (tid & 7) * 4) = sv; }
    asm volatile("s_waitcnt vmcnt(0)" ::: "memory");
    __syncthreads();
}

__device__ __forceinline__ void mlstm_nscan(const Params& p) {
    const float* MBEND = (const float*)(P_WS + OFF_MBEND); const float* MLOC = (const float*)(P_WS + OFF_MLOC);
    const float* DN = (const float*)(P_WS + OFF_DN); float* NST = (float*)(P_WS + OFF_NST); float* MSTART = (float*)(P_WS + OFF_MSTART);
    for (int idx = TIDX(); idx < 1024; idx += 512) { const int h = idx >> 8, d = idx & 255; float m = 0.f, n = 0.f;
#pragma unroll 8
        for (int c = 0; c < NCH; ++c) { if (d == 0) MSTART[h * NCH + c] = m; NST[(size_t)(h * NCH + c) * 256 + d] = n;
            const float bend = MBEND[h * NCH + c], mloc = MLOC[h * NCH + c]; const float mnew = fmaxf(bend + m, mloc);
            n = __expf(bend + m - mnew) * n + __expf(mloc - mnew) * DN[(size_t)(h * NCH + c) * 256 + d]; m = mnew; } }
}

__device__ __forceinline__ float gelu_tanh(float x) { const float u = 0.7978845608028654f * (x + 0.044715f * x * x * x); return 0.5f * x * (1.0f + tanhf(u)); }

__device__ __forceinline__ void s5_pass_c(const Params& p, int L, int g, int c, int lane, LAS bh* img, LAS float* ul) {
    const float* zf = (const float*)(P_WS + OFF_ZF) + (size_t)(c * 64) * ZF_LD + ZS0 + g * 16;
    s5_stage_u(zf, ul, lane);
    S5C k; s5_setup(p, L, g, lane, k);
    float sr = 0.f, si = 0.f;
    {   float pr = k.ar, pi = k.ai;
#pragma unroll
        for (int i = 0; i < 6; ++i) { const float nr = pr * pr - pi * pi, ni = 2.f * pr * pi; pr = nr; pi = ni; }
        const float* se = (const float*)(P_WS + OFF_SEND) + ((size_t)(g * NCH) * 64 + lane) * 2;
        int cc = 0;
        for (; cc + 8 <= c; cc += 8) { float er[8], ei[8];
#pragma unroll
            for (int j = 0; j < 8; ++j) { er[j] = se[(size_t)(cc + j) * 128]; ei[j] = se[(size_t)(cc + j) * 128 + 1]; }
#pragma unroll
            for (int j = 0; j < 8; ++j) { const float nr = pr * sr - pi * si + er[j], ni = pr * si + pi * sr + ei[j]; sr = nr; si = ni; } }
        for (; cc < c; ++cc) { const float er = se[(size_t)cc * 128], ei = se[(size_t)cc * 128 + 1];
            const float nr = pr * sr - pi * si + er, ni = pr * si + pi * sr + ei; sr = nr; si = ni; } }
    const int gi = L * 32 + g;
    bf16x8 bfr[4];
    {   const int pp = lane & 15; const float* cre = P_IN(24) + ((size_t)gi * 16 + pp) * 64; const float* cim = P_IN(25) + ((size_t)gi * 16 + pp) * 64;
#pragma unroll
        for (int ks = 0; ks < 4; ++ks)
#pragma unroll
            for (int j = 0; j < 8; ++j) { const int n2 = ks * 32 + (lane >> 4) * 8 + j; const float v = (n2 < 64) ? cre[n2] : -cim[n2 - 64]; bfr[ks][j] = (short)f2bf(v); } }
    const float dco = P_IN(26)[L * 512 + g * 16 + (lane & 15)];
    bh* YS = (bh*)(P_WS + OFF_YS);
    for (int half = 0; half < 2; ++half) {
#pragma unroll 8
        for (int s = 0; s < 32; ++s) { s5_step(k, ul + (half * 32 + s) * 16, sr, si); img[s * 136 + lane] = f2bf(sr); img[s * 136 + 64 + lane] = f2bf(si); }
        asm volatile("s_waitcnt lgkmcnt(0)" ::: "memory"); __builtin_amdgcn_wave_barrier();
#pragma unroll
        for (int mt = 0; mt < 2; ++mt) { f32x4 acc = {0.f, 0.f, 0.f, 0.f};
#pragma unroll
            for (int ks = 0; ks < 4; ++ks) { const bf16x8 a = *(const LAS bf16x8*)(img + (mt * 16 + (lane & 15)) * 136 + ks * 32 + (lane >> 4) * 8); acc = MFMA16(a, bfr[ks], acc); }
#pragma unroll
            for (int r = 0; r < 4; ++r) { const int tt = half * 32 + mt * 16 + (lane >> 4) * 4 + r; const float uv = ul[tt * 16 + (lane & 15)];
                YS[(size_t)(c * 64 + tt) * 512 + g * 16 + (lane & 15)] = f2bf(gelu_tanh(acc[r] + dco * uv)); } }
        asm volatile("s_waitcnt lgkmcnt(0)" ::: "memory"); __builtin_amdgcn_wave_barrier();
    }
}

__device__ __forceinline__ void phase_scan(const Params& p, int L, LAS unsigned char* lds) {
    const int b = BIDX();
    if (b < 224) { for (int rr = 0; rr < PROBE_RW; ++rr) rwkv_scan(p, b, lds); }
    else { for (int rr = 0; rr < PROBE_ML; ++rr) mlstm_seq(p, b - 224, lds); }
}
__device__ __forceinline__ void phase_s5c(const Params& p, int L, LAS unsigned char* lds) {
    const int b = BIDX(), wid = TIDX() >> 6, lane = TIDX() & 63;
    if (b == GDIM() - 1) mlstm_nscan(p);
    const int nw = GDIM() * 8;
    for (int w = b * 8 + wid; w < 32 * NCH; w += nw) s5_pass_c(p, L, w >> 7, w & 127, lane, (LAS bh*)lds + wid * (32 * 136), (LAS float*)(lds + 69632) + wid * 1024);
    __syncthreads();
}

__device__ __forceinline__ void mlstm_out(const Params& p, int L, int h, int c, LAS unsigned char* lds) {
    const int tid = TIDX(), wid = tid >> 6, lane = tid & 63, t0 = c * 64;
    LAS bh* Pl = (LAS bh*)lds;
    LAS float* s_b = (LAS float*)(lds + 9216); LAS float* s_a = s_b + 64; LAS float* s_mt = s_a + 64; LAS float* s_iw = s_mt + 64; LAS float* s_den = s_iw + 64; LAS float* s_qn = s_den + 64; LAS float* s_part = s_qn + 64;
    const bh* MQ = (const bh*)(P_WS + OFF_MQ); const bh* MK = (const bh*)(P_WS + OFF_MK); const bh* MVT = (const bh*)(P_WS + OFF_MVT);
    const float* MINTER = (const float*)(P_WS + OFF_ABF);
    const float m0 = ((const float*)(P_WS + OFF_MSTART))[h * NCH + c];
    if (tid < 64) { const float ig = ((const float*)(P_WS + OFF_MI))[h * T + t0 + tid], b = ((const float*)(P_WS + OFF_MBB))[h * T + t0 + tid];
        const float a = ig - b; float cm = a;
#pragma unroll
        for (int o = 1; o < 64; o <<= 1) { const float nb = bperm_f((tid - o) & 63, cm); if (tid >= o) cm = fmaxf(cm, nb); }
        const float mt = b + fmaxf(m0, cm);
        s_b[tid] = b; s_a[tid] = a; s_mt[tid] = mt; s_iw[tid] = __expf(b + m0 - mt); }
    __syncthreads();
    {
        const int mt = wid >> 1, nt0 = (wid & 1) * 2;
        f32x4 r0 = {0.f, 0.f, 0.f, 0.f}, r1 = {0.f, 0.f, 0.f, 0.f};
        const bh* qp = MQ + fq_base(h, c, mt, 0) + lane * 8;
        const bh* kp = MK + fq_base(h, c, nt0, 0) + lane * 8;
#pragma unroll
        for (int ks = 0; ks < 8; ++ks) { const bf16x8 a = *(const bf16x8*)(qp + ks * 512); const bf16x8 b0 = *(const bf16x8*)(kp + ks * 512), b1 = *(const bf16x8*)(kp + 8 * 512 + ks * 512);
            r0 = MFMA16(a, b0, r0); r1 = MFMA16(a, b1, r1); }
#pragma unroll
        for (int r = 0; r < 4; ++r) { const int t = mt * 16 + (lane >> 4) * 4 + r; const float bt = s_b[t] - s_mt[t];
            { const int s = nt0 * 16 + (lane & 15); const float pv = (s <= t) ? r0[r] * __expf(bt + s_a[s]) : 0.f; Pl[t * 72 + s] = f2bf(pv); }
            { const int s = nt0 * 16 + 16 + (lane & 15); const float pv = (s <= t) ? r1[r] * __expf(bt + s_a[s]) : 0.f; Pl[t * 72 + s] = f2bf(pv); } }
    }
    __syncthreads();
    if (tid < 64) { float s = 0.f;
#pragma unroll
        for (int q = 0; q < 8; ++q) { const u32x4 w = *(const LAS u32x4*)(Pl + tid * 72 + q * 8);
            s += __uint_as_float(w.x << 16) + __uint_as_float(w.x & 0xffff0000u) + __uint_as_float(w.y << 16) + __uint_as_float(w.y & 0xffff0000u)
               + __uint_as_float(w.z << 16) + __uint_as_float(w.z & 0xffff0000u) + __uint_as_float(w.w << 16) + __uint_as_float(w.w & 0xffff0000u); }
        s_den[tid] = s; }
    {
        const float* nst = (const float*)(P_WS + OFF_NST) + (size_t)(h * NCH + c) * 256 + lane * 4; const f32x4 nv = *(const f32x4*)nst;
#pragma unroll
        for (int i = 0; i < 8; ++i) { const int t = wid * 8 + i; const u32x2 q2 = *(const u32x2*)(MQ + fq_off(h, t0 + t, lane * 4));
            float s = __uint_as_float(q2.x << 16) * nv[0] + __uint_as_float(q2.x & 0xffff0000u) * nv[1] + __uint_as_float(q2.y << 16) * nv[2] + __uint_as_float(q2.y & 0xffff0000u) * nv[3];
            s = wave_sum(s); if (lane == 0) s_qn[t] = s; } }
    f32x4 acc[4][2];
#pragma unroll
    for (int a = 0; a < 4; ++a) { const float z = OZ(); acc[a][0] = (f32x4){z, z, z, z}; acc[a][1] = (f32x4){z, z, z, z}; }
    {   const bh* vp = MVT + (size_t)(h * NCH + c) * 16384;
#pragma unroll
        for (int ks = 0; ks < 2; ++ks) { const bf16x8 b0 = *(const bf16x8*)(vp + ft_off(wid * 32 + (lane & 15), ks * 4 + (lane >> 4))), b1 = *(const bf16x8*)(vp + ft_off(wid * 32 + 16 + (lane & 15), ks * 4 + (lane >> 4)));
#pragma unroll
            for (int a = 0; a < 4; ++a) { const bf16x8 av = *(const LAS bf16x8*)(Pl + (a * 16 + (lane & 15)) * 72 + ks * 32 + (lane >> 4) * 8);
                acc[a][0] = MFMA16(av, b0, acc[a][0]); acc[a][1] = MFMA16(av, b1, acc[a][1]); } } }
    __syncthreads();
#pragma unroll
    for (int a = 0; a < 4; ++a)
#pragma unroll
        for (int r = 0; r < 4; ++r) { const int t = a * 16 + (lane >> 4) * 4 + r; const float iw = s_iw[t];
            const float den = s_den[t] + iw * s_qn[t]; const float dd = 1.0f / fmaxf(fabsf(den), __expf(-s_mt[t]));
            const float* mi = MINTER + (size_t)(t0 + t) * 1024 + h * 256 + wid * 32 + (lane & 15);
            const float h0 = (acc[a][0][r] + iw * mi[0]) * dd, h1 = (acc[a][1][r] + iw * mi[16]) * dd;
            acc[a][0][r] = h0; acc[a][1][r] = h1;
            float ss = h0 * h0 + h1 * h1;
            ss = allreduce16(ss);
            if ((lane & 15) == 0) s_part[wid * 64 + t] = ss; }
    __syncthreads();
    {   const float* zf = (const float*)(P_WS + OFF_ZF); const float* ng = P_IN(7) + L * 1024 + h * 256; bh* YC = (bh*)(P_WS + OFF_YCAT);
#pragma unroll
        for (int a = 0; a < 4; ++a)
#pragma unroll
            for (int r = 0; r < 4; ++r) { const int t = a * 16 + (lane >> 4) * 4 + r;
                float tot = 0.f;
#pragma unroll
                for (int w = 0; w < 8; ++w) tot += s_part[w * 64 + t];
                const float rstd = rsqrtf(tot * (1.0f / 256.0f) + 1e-6f);
                const int v0 = wid * 32 + (lane & 15);
                const float* op = zf + (size_t)(t0 + t) * ZF_LD + 3072 + h * 256 + v0;
                bh* yo = YC + (size_t)(t0 + t) * D + h * 256 + v0;
                yo[0] = f2bf(sigmoidf_(op[0]) * acc[a][0][r] * rstd * ng[v0]);
                yo[16] = f2bf(sigmoidf_(op[16]) * acc[a][1][r] * rstd * ng[v0 + 16]); } }
    __syncthreads();
}

__device__ __forceinline__ void rwkv_post(const Params& p, int L, int it, LAS unsigned char* lds) {
    const int tid = TIDX(), wid = tid >> 6, lane = tid & 63;
    const int h = it & 7, blk = it >> 3, j = blk >> 3;
    LAS float* bufA = (LAS float*)lds;
    LAS float* bufB = bufA + 64 * 65;
    LAS float* bufP = bufB + 64 * 65;
    const float* SE = (const float*)(P_WS + OFF_RSEND) + (size_t)(h * 4) * 4096; const float* PE = (const float*)(P_WS + OFF_RPEND) + (size_t)(h * 4) * 4096;
    LAS float* sst = bufA;
    if (j >= 1) {
        const int v = tid >> 3, k8 = (tid & 7) * 8;
        { const f32x4 a0 = *(const f32x4*)(SE + v * 64 + k8), a1 = *(const f32x4*)(SE + v * 64 + k8 + 4);
#pragma unroll
          for (int e = 0; e < 4; ++e) { bufA[v * 65 + k8 + e] = a0[e]; bufA[v * 65 + k8 + 4 + e] = a1[e]; } }
        for (int jj = 1; jj < j; ++jj) {
            { const f32x4 p0 = *(const f32x4*)(PE + (size_t)jj * 4096 + v * 64 + k8), p1 = *(const f32x4*)(PE + (size_t)jj * 4096 + v * 64 + k8 + 4);
              *(LAS f32x4*)(bufP + v * 64 + k8) = p0; *(LAS f32x4*)(bufP + v * 64 + k8 + 4) = p1; }
            __syncthreads();
            LAS float* src = (jj & 1) ? bufA : bufB; LAS float* dst = (jj & 1) ? bufB : bufA;
            f32x4 c0 = *(const f32x4*)(SE + (size_t)jj * 4096 + v * 64 + k8), c1 = *(const f32x4*)(SE + (size_t)jj * 4096 + v * 64 + k8 + 4);
#pragma unroll 8
            for (int i = 0; i < 64; ++i) { const float a = src[v * 65 + i]; const f32x4 p0 = *(const LAS f32x4*)(bufP + i * 64 + k8), p1 = *(const LAS f32x4*)(bufP + i * 64 + k8 + 4); c0 += a * p0; c1 += a * p1; }
#pragma unroll
            for (int e = 0; e < 4; ++e) { dst[v * 65 + k8 + e] = c0[e]; dst[v * 65 + k8 + 4 + e] = c1[e]; }
            __syncthreads();
            sst = dst;
        }
        __syncthreads();
    }
    float srow[64];
    if (j >= 1) {
#pragma unroll
        for (int i = 0; i < 64; ++i) srow[i] = sst[lane * 65 + i];
    } else {
#pragma unroll
        for (int i = 0; i < 64; ++i) srow[i] = 0.f;
    }
    const int c = h * 64 + lane;
    const float rkw = P_IN(16)[L * 512 + c], lg = P_IN(17)[L * 512 + c], lb = P_IN(18)[L * 512 + c];
    const float* RY = (const float*)(P_WS + OFF_RY); const float* RZ = (const float*)(P_WS + OFF_RZ); const float* RR = (const float*)(P_WS + OFF_RR); const float* RK = (const float*)(P_WS + OFF_RK);
    const float* RV = (const float*)(P_WS + OFF_RV); const float* RG = (const float*)(P_WS + OFF_RG); bh* YC = (bh*)(P_WS + OFF_YCAT);
    for (int i = 0; i < 32; ++i) { const int t = blk * 256 + wid * 32 + i; const size_t o = (size_t)t * 512 + c;
        float y = RY[o];
        if (j >= 1) { const float z = RZ[o]; float y2 = 0.f;
#pragma unroll
            for (int q = 0; q < 64; q += 2) { y = fmaf(srow[q], __builtin_bit_cast(float, __builtin_amdgcn_readlane(__builtin_bit_cast(int, z), q)), y);
                                              y2 = fmaf(srow[q + 1], __builtin_bit_cast(float, __builtin_amdgcn_readlane(__builtin_bit_cast(int, z), q + 1)), y2); }
            y += y2; }
        const float mu = wave_sum(y) * (1.0f / 64.0f); const float dlt = y - mu; const float var = wave_sum(dlt * dlt) * (1.0f / 64.0f);
        const float yn = dlt * rsqrtf(var + 64e-5f) * lg + lb;
        const float bon = wave_sum(RR[o] * RK[o] * rkw) * RV[o];
        YC[(size_t)t * D + 1024 + c] = f2bf((yn + bon) * RG[o]); }
    __syncthreads();
}

__device__ __forceinline__ void phase_post(const Params& p, int L, LAS unsigned char* lds) {
    for (int it = BIDX(); it < 768; it += GDIM()) {
        if (it < 512) mlstm_out(p, L, it >> 7, it & 127, lds);
        else rwkv_post(p, L, it - 512, lds);
    }
    __syncthreads();
}

#define XB_TMO      128
#define XB_XCNT(j)  (256  + 64 * (j))
#define XB_XSUB(j)  (1280 + 64 * (j))
#define XB_XGEN(j)  (2304 + 64 * (j))
#define XB_TOP      3328
#define XB_TOPGEN   3392
#define XCD_BAR_WORDS 3456
#define XB_SPIN_CAP (1u << 18)

__device__ __forceinline__ unsigned xb_ld(unsigned* p)              { return __hip_atomic_load(p, __ATOMIC_RELAXED, __HIP_MEMORY_SCOPE_AGENT); }
__device__ __forceinline__ unsigned xb_add(unsigned* p, unsigned v) { return __hip_atomic_fetch_add(p, v, __ATOMIC_RELAXED, __HIP_MEMORY_SCOPE_AGENT); }
__device__ __forceinline__ unsigned xb_xcc_id() { return (unsigned)__builtin_amdgcn_s_getreg((3 << 11) | 20) & 0xFu; }
#define XB_SPIN(cond, bar) do { unsigned _sp = 0; while (cond) { __builtin_amdgcn_s_sleep(1); \
    if ((++_sp & 255u) == 0u) { if (xb_ld(&(bar)[XB_TMO])) break; if (_sp > XB_SPIN_CAP) { atomicAdd(&(bar)[XB_TMO], 1u); break; } } } } while (0)

struct XcdBarrier {
    unsigned* bar; unsigned x;
    volatile LAS unsigned* st;
};

__device__ __forceinline__ XcdBarrier xcd_barrier_post(unsigned* bar, volatile LAS unsigned* st) {
    XcdBarrier b; b.bar = bar; b.x = xb_xcc_id(); b.st = st;
    if (threadIdx.x == 0) (void)xb_add(&bar[XB_XCNT(b.x)], 1u);
    return b;
}
__device__ __forceinline__ void xcd_barrier_complete(unsigned* bar, unsigned x, unsigned& nloc, unsigned& nx) {
    const unsigned G = gridDim.x * gridDim.y * gridDim.z;
    unsigned sum, cnt, mine, sp = 0u;
    for (;;) {
        sum = 0u; cnt = 0u; mine = 0u;
#pragma unroll
        for (unsigned j = 0; j < 16; ++j) { const unsigned c = xb_ld(&bar[XB_XCNT(j)]); sum += c; cnt += (c > 0u) ? 1u : 0u; mine = (j == x) ? c : mine; }
        if (sum == G) break;
        __builtin_amdgcn_s_sleep(1);
        if ((++sp & 255u) == 0u) { if (xb_ld(&bar[XB_TMO])) break; if (sp > XB_SPIN_CAP) { atomicAdd(&bar[XB_TMO], 1u); break; } }
    }
    nloc = mine > 0u ? mine : 1u; nx = cnt > 0u ? cnt : 1u;
}

__device__ __forceinline__ void xcd_barrier(const XcdBarrier& b) {
    asm volatile("s_waitcnt vmcnt(0)" ::: "memory");
    __syncthreads();
    if (threadIdx.x == 0) {
        unsigned* bar = b.bar;
        __builtin_amdgcn_s_waitcnt(0);
        unsigned nloc = b.st[0], nx = b.st[1];
        if (nloc == 0u) { xcd_barrier_complete(bar, b.x, nloc, nx); b.st[0] = nloc; b.st[1] = nx; }
        const unsigned old = xb_add(&bar[XB_XSUB(b.x)], 1u);
        const unsigned gen = old / nloc;
        if (old + 1u == (gen + 1u) * nloc) {
            __builtin_amdgcn_fence(__ATOMIC_RELEASE, "agent");
            asm volatile("s_waitcnt vmcnt(0)" ::: "memory");
            const unsigned og = xb_add(&bar[XB_TOP], 1u);
            const unsigned tg = og / nx;
            if (og + 1u == (tg + 1u) * nx) xb_add(&bar[XB_TOPGEN], 1u);
            else XB_SPIN(xb_ld(&bar[XB_TOPGEN]) == tg, bar);
            __builtin_amdgcn_fence(__ATOMIC_ACQUIRE, "agent");
            xb_add(&bar[XB_XGEN(b.x)], 1u);
            asm volatile("s_waitcnt vmcnt(0)" ::: "memory");
        } else {
            XB_SPIN(xb_ld(&bar[XB_XGEN(b.x)]) == gen, bar);
            __builtin_amdgcn_fence(__ATOMIC_ACQUIRE, "agent");
            asm volatile("s_waitcnt vmcnt(0)" ::: "memory");
        }
    }
    __syncthreads();
}


constexpr int NPHASE = 27;
__global__ void __launch_bounds__(512, 2) hybrid_fwd(Params p, int ph_lo, int ph_hi, int rep_q) {
    extern __shared__ __attribute__((aligned(16))) unsigned char smem_raw[];
    LAS unsigned char* lds = (LAS unsigned char*)smem_raw;
    cg::grid_group grid = cg::this_grid();
    volatile LAS unsigned* xst = (volatile LAS unsigned*)(lds + 131072);
    if (threadIdx.x < 2) xst[threadIdx.x] = 0u;
    __syncthreads();
    { XcdBarrier b0 = xcd_barrier_post((unsigned*)(P_WS + OFF_BAR), xst); (void)b0; }
    for (int ph = ph_lo; ph < ph_hi; ++ph) {
        if (ph == ph_lo + 1) grid.sync();
        else if (ph > ph_lo) { XcdBarrier xb; xb.bar = (unsigned*)(P_WS + OFF_BAR); xb.x = xb_xcc_id(); xb.st = xst; xcd_barrier(xb); }
        if (ph == 26) {
            const int gw = BIDX() * 8 + (TIDX() >> 6), NGW = GDIM() * 8, lane = TIDX() & 63;
            for (int r = gw; r < T; r += NGW) { float* x = P_OUT + (size_t)r * D; f32x4 v[8]; float s = 0.f;
#pragma unroll
                for (int j = 0; j < 8; ++j) { v[j] = *(const f32x4*)(x + j * 256 + lane * 4); s += (v[j][0] * v[j][0] + v[j][1] * v[j][1]) + (v[j][2] * v[j][2] + v[j][3] * v[j][3]); }
                const float rstd = rsqrtf(wave_sum(s) * (1.0f / D) + 1e-6f);
#pragma unroll
                for (int j = 0; j < 8; ++j) { const f32x4 gg = *(const f32x4*)(P_IN(40) + j * 256 + lane * 4); *(f32x4*)(x + j * 256 + lane * 4) = v[j] * rstd * gg; } }
            continue;
        }
        const int L = ph / 13, q = ph % 13;
#ifdef ONLY_Q
        if (q != ONLY_Q) continue;
#endif
        const int nrep = (q == rep_q) ? 2 : 1;
        for (int rep = 0; rep < nrep; ++rep) {
        if (rep) grid.sync();
        switch (q) {
        case 0: phase_conv(p, L, lds); break;
        case 2: phase_prep(p, L, lds); break;
        case 4: phase_scan(p, L, lds); break;
        case 5: phase_post(p, L, lds); break;
        case 8: phase_rmsnorm(p, P_IN(33) + (size_t)L * D); break;
        case 11: phase_rmsnorm(p, P_IN(37) + (size_t)L * D); break;
        default: break;
        }
        for (int i = 0; i < 3; ++i) {
            pg8::Gemm g;
            if (!make_gemm(p, L, q, i, g)) break;
            pg8::StaticOrder S; S.init(T, g.N, GDIM(), BIDX());
            pg8::gemm_phase(lds, g, S);
        }
        if (q == 3) phase_s5c(p, L, lds);
        }
    }
}

extern "C" void kernel_launch(void* const* d_in, const int* in_sizes, int n_in, void* d_out, int out_size, void* d_ws, size_t ws_size, hipStream_t stream) {
    constexpr size_t kDynLds = 131072 + 64;
    static int grid_blocks = 0;
    if (!grid_blocks) {
        int dev = 0, cus = 0, per_cu = 0;
        (void)hipGetDevice(&dev);
        (void)hipDeviceGetAttribute(&cus, hipDeviceAttributeMultiprocessorCount, dev);
        (void)hipFuncSetAttribute((const void*)hybrid_fwd, hipFuncAttributeMaxDynamicSharedMemorySize, (int)kDynLds);
        (void)hipOccupancyMaxActiveBlocksPerMultiprocessor(&per_cu, hybrid_fwd, 512, kDynLds);
        if (per_cu > 1) per_cu = 1;
        grid_blocks = cus * per_cu;
        if (ws_size < WS_TOTAL) fprintf(stderr, "workspace too small: %zu < %zu\n", ws_size, (size_t)WS_TOTAL);
    }
    Params p{};
    for (int i = 0; i < 41; ++i) p.in[i] = (const float*)d_in[i];
    p.out = (float*)d_out; p.ws = (unsigned char*)d_ws;
    (void)hipMemsetAsync((char*)d_ws + OFF_BAR, 0, XCD_BAR_WORDS * 4, stream);
#if SINGLE_LAUNCH
    int lo = 0, hi = NPHASE, rq = PROBE_REP_Q;
    void* args[] = {&p, &lo, &hi, &rq};
    hipError_t e = hipLaunchCooperativeKernel((const void*)hybrid_fwd, dim3(grid_blocks), dim3(512), args, kDynLds, stream);
    if (e != hipSuccess) fprintf(stderr, "cooperative launch failed: %s (grid %d)\n", hipGetErrorString(e), grid_blocks);
#else
    for (int ph = 0; ph < NPHASE; ++ph) {
        int lo = ph, hi = ph + 1, rq = -1;
        void* args[] = {&p, &lo, &hi, &rq};
        hipError_t e = hipLaunchCooperativeKernel((const void*)hybrid_fwd, dim3(grid_blocks), dim3(512), args, kDynLds, stream);
        if (e != hipSuccess) fprintf(stderr, "cooperative launch failed: %s (grid %d)\n", hipGetErrorString(e), grid_blocks);
    }
#endif
}
```

```cpp
#include <hip/hip_runtime.h>
#include <hip/hip_cooperative_groups.h>
#include <cstdio>
#include <cstdint>
namespace cg = cooperative_groups;

#define LAS __attribute__((address_space(3)))
typedef unsigned short bh;
typedef short bf16x8 __attribute__((ext_vector_type(8)));
typedef float f32x4 __attribute__((ext_vector_type(4)));
typedef float f32x16 __attribute__((ext_vector_type(16)));
typedef unsigned u32x4 __attribute__((ext_vector_type(4)));
typedef unsigned u32x2 __attribute__((ext_vector_type(2)));

#ifndef PROBE_RW
#define PROBE_RW 1
#define PROBE_ML 1
#endif
#ifndef PROBE_REP_Q
#define PROBE_REP_Q (-1)
#endif
#ifndef SINGLE_LAUNCH
#define SINGLE_LAUNCH 1
#endif

constexpr int T = 8192, D = 2048, FH = 5632;
constexpr int NIN = 12744, NGATE = 6144, NF = 6600, ZF_LD = 6656, NINP = 12800;
constexpr int ZR0 = 4104, ZS0 = 6088;
constexpr int NCH = 128;

constexpr size_t AL(size_t x) { return (x + 255) & ~(size_t)255; }
constexpr size_t SZ_WIN = (size_t)NINP * D * 2, SZ_SQ = (size_t)D * D * 2, SZ_WGU = (size_t)2 * FH * D * 2, SZ_WD = (size_t)D * FH * 2;
constexpr size_t OFF_WIN = 0;
constexpr size_t OFF_WUP = OFF_WIN + SZ_WIN;
constexpr size_t OFF_WO = OFF_WUP + SZ_SQ;
constexpr size_t OFF_WGU = OFF_WO + SZ_SQ;
constexpr size_t OFF_WD = OFF_WGU + SZ_WGU;
constexpr size_t OFF_WPG = OFF_WD + SZ_WD;
constexpr size_t OFF_WPP = OFF_WPG + SZ_SQ;
constexpr size_t OFF_WGLU = OFF_WPP + (size_t)D * 256 * 2;
constexpr size_t OFF_WW2 = OFF_WGLU + (size_t)512 * 512 * 2;
constexpr size_t OFF_WA2 = OFF_WW2 + (size_t)512 * 256 * 2;
constexpr size_t OFF_WG2 = OFF_WA2 + (size_t)512 * 256 * 2;
constexpr size_t OFF_PBF = OFF_WG2 + (size_t)512 * 256 * 2;
constexpr size_t OFF_ABF = OFF_PBF + (size_t)2 * T * 256 * 2;
constexpr size_t OFF_YCAT = OFF_ABF + (size_t)T * D * 2;
constexpr size_t OFF_ZF = OFF_YCAT + (size_t)T * D * 2;
constexpr size_t OFF_ACT = OFF_ZF;
constexpr size_t OFF_MIX32 = OFF_ZF + (size_t)100663296;
constexpr size_t OFF_ZG = OFF_ZF + (size_t)T * ZF_LD * 4;
constexpr size_t SZ_R = (size_t)T * 512 * 4;
constexpr size_t OFF_RR = OFF_ZG + (size_t)T * NGATE * 2;
constexpr size_t OFF_RK = OFF_RR + SZ_R, OFF_RV = OFF_RK + SZ_R, OFF_RKK = OFF_RV + SZ_R, OFF_RW = OFF_RKK + SZ_R, OFF_RB = OFF_RW + SZ_R, OFF_RG = OFF_RB + SZ_R, OFF_RY = OFF_RG + SZ_R;
constexpr size_t OFF_LAW = OFF_RY + SZ_R;
constexpr size_t OFF_LAA = OFF_LAW + (size_t)T * 256 * 2, OFF_LAG = OFF_LAA + (size_t)T * 256 * 2;
constexpr size_t SZ_MB = (size_t)T * 1024 * 2;
constexpr size_t OFF_MQ = OFF_LAG + (size_t)T * 256 * 2, OFF_MK = OFF_MQ + SZ_MB, OFF_MKT = OFF_MK + SZ_MB, OFF_MVT = OFF_MKT + SZ_MB;
constexpr size_t OFF_MI = OFF_MVT + SZ_MB;
constexpr size_t OFF_MBB = OFF_MI + (size_t)4 * T * 4;
constexpr size_t OFF_MBEND = OFF_MBB + (size_t)4 * T * 4;
constexpr size_t OFF_MLOC = OFF_MBEND + 2048, OFF_MSTART = OFF_MLOC + 2048;
constexpr size_t OFF_DN = OFF_MSTART + 2048;
constexpr size_t OFF_NST = OFF_DN + (size_t)4 * NCH * 256 * 4;
constexpr size_t OFF_SEND = OFF_NST + (size_t)4 * NCH * 256 * 4;
constexpr size_t OFF_YS = OFF_SEND + (size_t)32 * NCH * 64 * 8;
constexpr size_t OFF_RZ = OFF_YS + (size_t)T * 512 * 2;
constexpr size_t OFF_RSEND = OFF_RZ + SZ_R;
constexpr size_t OFF_RPEND = OFF_RSEND + (size_t)8 * 4 * 4096 * 4;
constexpr size_t OFF_MINTER2 = OFF_RPEND + (size_t)8 * 4 * 4096 * 4;
constexpr size_t OFF_BAR = OFF_MINTER2;
constexpr size_t WS_TOTAL = OFF_MINTER2 + (size_t)T * 1024 * 4;

struct Params { const float* in[41]; float* out; unsigned char* ws; };
#define KARG4 __attribute__((address_space(4)))
__device__ __forceinline__ const float* karg_in(int i) { const KARG4 char* ka = (const KARG4 char*)__builtin_amdgcn_kernarg_segment_ptr(); return *(const float* const volatile KARG4*)(ka + (size_t)i * 8); }
#define P_IN(i) karg_in(i)
#define P_OUT ((float*)karg_in(41))
#define P_WS ((unsigned char*)karg_in(42))

__device__ __forceinline__ int TIDX() { int t = threadIdx.x; asm volatile("" : "+v"(t)); return t; }
__device__ __forceinline__ int BIDX() { int t = blockIdx.x; asm volatile("" : "+s"(t)); return t; }
__device__ __forceinline__ int GDIM() { int t = gridDim.x; asm volatile("" : "+s"(t)); return t; }
__device__ __forceinline__ bh f2bf(float f) { unsigned u = __float_as_uint(f); u += 0x7fffu + ((u >> 16) & 1u); return (bh)(u >> 16); }
__device__ __forceinline__ float bf2f(bh h) { return __uint_as_float(((unsigned)h) << 16); }
__device__ __forceinline__ unsigned pk2(float lo, float hi) { return (unsigned)f2bf(lo) | ((unsigned)f2bf(hi) << 16); }
__device__ __forceinline__ float sigmoidf_(float x) { return 1.0f / (1.0f + __expf(-x)); }
__device__ __forceinline__ float bperm_f(int srclane, float v) { return __builtin_bit_cast(float, __builtin_amdgcn_ds_bpermute(srclane << 2, __builtin_bit_cast(int, v))); }
template <int CTRL> __device__ __forceinline__ float dpp_f(float x) {
    return __builtin_bit_cast(float, __builtin_amdgcn_update_dpp(0, __builtin_bit_cast(int, x), CTRL, 0xf, 0xf, true));
}
__device__ __forceinline__ float allreduce16(float x) {
    x += dpp_f<0xB1>(x); x += dpp_f<0x4E>(x); x += dpp_f<0x141>(x); x += dpp_f<0x140>(x);
    return x;
}
__device__ __forceinline__ float rl_f(float v, int l) { return __builtin_bit_cast(float, __builtin_amdgcn_readlane(__builtin_bit_cast(int, v), l)); }
__device__ __forceinline__ float wave_sum(float v) {
    v = allreduce16(v);
    return (rl_f(v, 0) + rl_f(v, 16)) + (rl_f(v, 32) + rl_f(v, 48));
}
__device__ __forceinline__ float wave_max(float v) {
    v = fmaxf(v, dpp_f<0xB1>(v)); v = fmaxf(v, dpp_f<0x4E>(v)); v = fmaxf(v, dpp_f<0x141>(v)); v = fmaxf(v, dpp_f<0x140>(v));
    return fmaxf(fmaxf(rl_f(v, 0), rl_f(v, 16)), fmaxf(rl_f(v, 32), rl_f(v, 48)));
}
__device__ __forceinline__ float OZ() { float z = 0.f; asm volatile("" : "+v"(z)); return z; }
#define MFMA16(a, b, c) __builtin_amdgcn_mfma_f32_16x16x32_bf16(a, b, c, 0, 0, 0)
#define MFMA32(a, b, c) __builtin_amdgcn_mfma_f32_32x32x16_bf16(a, b, c, 0, 0, 0)

namespace pg8 {
constexpr int BM = 256, BK = 64, HALF = 128, HTB = HALF * BK * 2, STAGE_BYTES = 8 * HTB, NXCD = 8, WGM = 8;
__device__ __forceinline__ int lds_byte(int r, int c) { const int st = (r >> 4) * 2 + (c >> 5), rr = r & 15, cc = c & 31, ob = rr * 64 + cc * 2; return st * 1024 + (ob ^ (((ob >> 9) & 1) << 5)); }
__device__ __forceinline__ void stage_rc(int b, int& R, int& C) { const int st = b / 1024, sb = b % 1024, swz = sb ^ (((sb >> 9) & 1) << 5); R = (st >> 1) * 16 + swz / 64; C = (st & 1) * 32 + (swz % 64) / 2; }
__device__ __forceinline__ int perm32(int rho) { const int n = rho >> 4, i = rho & 15; return 8 * (i >> 2) + 4 * n + (i & 3); }
struct Unit { int pm, pn; };
struct Gemm { const bh* A; const bh* Bt; int M, N, K, lda, ldb, epi, perm, L; };
struct StaticOrder {
    int nM, nN, nwg, G, c;
    __device__ void init(int M, int N, int G_, int c_) { nM = M / BM; nN = N / BM; nwg = nM * nN; G = G_; c = c_; }
    __device__ bool next(int i, Unit& u) const {
        const long L = (long)i * G + c; if (L >= nwg) return false;
        int wgid = (int)L; { const int q = nwg / NXCD, r = nwg % NXCD, xcd = wgid % NXCD, off = wgid / NXCD; wgid = (xcd < r ? xcd * (q + 1) : r * (q + 1) + (xcd - r) * q) + off; }
        const int nig = WGM * nN, gid = wgid / nig, fm = gid * WGM, gsz = (nM - fm) < WGM ? (nM - fm) : WGM;
        u.pm = fm + ((wgid % nig) % gsz); u.pn = (wgid % nig) / gsz; return true;
    }
};
__device__ __forceinline__ unsigned cvt_pk_bf16(float lo, float hi) { unsigned r; asm volatile("v_cvt_pk_bf16_f32 %0, %1, %2" : "=v"(r) : "v"(lo), "v"(hi)); return r; }

__device__ __forceinline__ void epi_run(const Gemm& g, const f32x4 (&acc)[2][2][4][2], const Unit& u, int wr, int wc, int fr, int fq);
__device__ __forceinline__ void up_rescale(f32x4 (&acc)[2][2][4][2], const Unit& u, int wr, int wc, int fr, int fq, int goff) {
    const bh* zg = (const bh*)(P_WS + OFF_ZG) + goff;
    asm volatile("" : "+v"(fr), "+v"(fq));
    const bh* zrow0 = zg + (size_t)(u.pm * 256 + wr * 64 + fr) * NGATE + u.pn * 256 + wc * 32 + 4 * fq;
#pragma unroll
    for (int ai = 0; ai < 2; ++ai)
#pragma unroll
        for (int m = 0; m < 4; ++m) { const bh* zr = zrow0 + (size_t)(ai * 128 + m * 16) * NGATE;
#pragma unroll
            for (int bj = 0; bj < 2; ++bj)
#pragma unroll
                for (int n = 0; n < 2; ++n) {
                    const u32x2 gp = *(const u32x2*)(zr + bj * 128 + n * 16), gn = *(const u32x2*)(zr + 2048 + bj * 128 + n * 16);
                    f32x4 r;
                    r[0] = __uint_as_float(gp.x << 16) * __builtin_amdgcn_rcpf(__uint_as_float(gn.x << 16)); r[1] = __uint_as_float(gp.x & 0xffff0000u) * __builtin_amdgcn_rcpf(__uint_as_float(gn.x & 0xffff0000u));
                    r[2] = __uint_as_float(gp.y << 16) * __builtin_amdgcn_rcpf(__uint_as_float(gn.y << 16)); r[3] = __uint_as_float(gp.y & 0xffff0000u) * __builtin_amdgcn_rcpf(__uint_as_float(gn.y & 0xffff0000u));
                    acc[ai][bj][m][n] *= r; }
            __builtin_amdgcn_sched_barrier(0); }
}
__device__ __forceinline__ void gemm_phase(LAS unsigned char* lds, const Gemm& g, const StaticOrder& S) {
    const int tid = TIDX(), wid = __builtin_amdgcn_readfirstlane(tid >> 6), lane = tid & 63, wr = wid >> 2, wc = wid & 3, fr = lane & 15, fq = lane >> 4;
    const int K = g.K, nt = K / BK;
    unsigned voffA[2], voffB[2];
#pragma unroll
    for (int i = 0; i < 2; ++i) { int R, C; stage_rc(tid * 16 + i * 8192, R, C); const int Rb = g.perm ? ((R & ~31) + perm32(R & 31)) : R;
        voffA[i] = (unsigned)(R * g.lda + C) * 2u; voffB[i] = (unsigned)(Rb * g.ldb + C) * 2u; }
    const size_t kstep = (size_t)(BK * 2);
    const size_t hstepA = (size_t)HALF * g.lda * 2, hstepB = (size_t)HALF * g.ldb * 2;
    const size_t tstepA = 2 * hstepA, tstepB = 2 * hstepB;
    const unsigned ldsw = (unsigned)wid * 1024u;
    const int aoff = lds_byte(wr * 64 + fr, fq * 8), boff = lds_byte(wc * 32 + fr, fq * 8);
#define PG8_SA(b, h) (((b) * 2 + (h)) * HTB)
#define PG8_SB(b, h) ((4 + (b) * 2 + (h)) * HTB)
#define PG8_STAGE(bufoff, gbase, voff) do { _Pragma("unroll") for (int _i = 0; _i < 2; ++_i) \
        __builtin_amdgcn_global_load_lds((const unsigned*)((const char*)(gbase) + (voff)[_i]), (LAS unsigned*)(lds + (bufoff) + ldsw + _i * 8192), 16, 0, 0); } while (0)
#define PG8_LDA(dst, b, h) do { _Pragma("unroll") for (int m = 0; m < 4; ++m) _Pragma("unroll") for (int k = 0; k < 2; ++k) dst[m][k] = *(const LAS bf16x8*)(lds + PG8_SA(b, h) + aoff + m * 2048 + k * 1024); } while (0)
#define PG8_LDB(dst, b, h) do { _Pragma("unroll") for (int n = 0; n < 2; ++n) _Pragma("unroll") for (int k = 0; k < 2; ++k) dst[n][k] = *(const LAS bf16x8*)(lds + PG8_SB(b, h) + boff + n * 2048 + k * 1024); } while (0)
#define PG8_MMA(ai, bj, At, Bt) do { __builtin_amdgcn_s_setprio(1); _Pragma("unroll") for (int m = 0; m < 4; ++m) _Pragma("unroll") for (int n = 0; n < 2; ++n) _Pragma("unroll") for (int k = 0; k < 2; ++k) \
        acc[ai][bj][m][n] = __builtin_amdgcn_mfma_f32_16x16x32_bf16(Bt[n][k], At[m][k], acc[ai][bj][m][n], 0, 0, 0); __builtin_amdgcn_s_setprio(0); } while (0)
#define PG8_WAIT_V(n) asm volatile("s_waitcnt vmcnt(" #n ")" ::: "memory")
#define PG8_WAIT_L(n) asm volatile("s_waitcnt lgkmcnt(" #n ")" ::: "memory")
#define PG8_BAR __builtin_amdgcn_s_barrier()
#define PG8_SCHED __builtin_amdgcn_sched_barrier(0)
    Unit cur, nxt; int ui = 0;
    if (!S.next(0, cur)) return;
    f32x4 acc[2][2][4][2];
    { const float z = OZ();
#pragma unroll
    for (int a = 0; a < 2; ++a)
#pragma unroll
        for (int b = 0; b < 2; ++b)
#pragma unroll
            for (int m = 0; m < 4; ++m)
#pragma unroll
                for (int n = 0; n < 2; ++n) acc[a][b][m][n] = (f32x4){z, z, z, z}; }
    bf16x8 At[4][2], B0[2][2], B1[2][2];
    const char* cA = (const char*)g.A + (size_t)cur.pm * tstepA; const char* cB = (const char*)g.Bt + (size_t)cur.pn * tstepB;
    PG8_STAGE(PG8_SB(0, 0), cB, voffB); PG8_STAGE(PG8_SA(0, 0), cA, voffA); PG8_STAGE(PG8_SB(0, 1), cB + hstepB, voffB); PG8_STAGE(PG8_SA(0, 1), cA + hstepA, voffA);
    if (wr == 1) PG8_BAR;
    PG8_WAIT_V(4); PG8_BAR;
    PG8_STAGE(PG8_SB(1, 0), cB + kstep, voffB); PG8_STAGE(PG8_SA(1, 0), cA + kstep, voffA); PG8_STAGE(PG8_SB(1, 1), cB + hstepB + kstep, voffB);
    PG8_WAIT_V(6); PG8_BAR;
    for (;;) {
        const bool has_next = S.next(ui + 1, nxt);
        const char* nA = has_next ? (const char*)g.A + (size_t)nxt.pm * tstepA : cA; const char* nB = has_next ? (const char*)g.Bt + (size_t)nxt.pn * tstepB : cB;
        for (int t = 0; t < nt; t += 2) {
            if (g.epi == 11 && (t == 16 || t == 24)) up_rescale(acc, cur, wr, wc, fr, fq, t == 16 ? 0 : 2048);
            const bool last = (t == nt - 2);
            const char* a1 = cA + (size_t)(t + 1) * kstep;
            const char* a2 = last ? nA : cA + (size_t)(t + 2) * kstep; const char* b2 = last ? nB : cB + (size_t)(t + 2) * kstep;
            const char* a3 = a2 + kstep; const char* b3 = b2 + kstep;
            PG8_LDB(B0, 0, 0); PG8_SCHED; PG8_LDA(At, 0, 0); PG8_STAGE(PG8_SA(1, 1), a1 + hstepA, voffA);
            PG8_WAIT_L(8); PG8_BAR; PG8_WAIT_L(0); PG8_MMA(0, 0, At, B0); PG8_BAR; PG8_SCHED;
            PG8_LDB(B1, 0, 1); PG8_STAGE(PG8_SB(0, 0), b2, voffB);
            PG8_BAR; PG8_WAIT_L(0); PG8_MMA(0, 1, At, B1); PG8_BAR;
            PG8_LDA(At, 0, 1); PG8_STAGE(PG8_SA(0, 0), a2, voffA);
            PG8_BAR; PG8_WAIT_L(0); PG8_MMA(1, 0, At, B0); PG8_BAR; PG8_SCHED;
            PG8_STAGE(PG8_SB(0, 1), b2 + hstepB, voffB);
            PG8_WAIT_V(6); PG8_BAR; PG8_MMA(1, 1, At, B1); PG8_BAR;
            PG8_LDB(B0, 1, 0); PG8_SCHED; PG8_LDA(At, 1, 0); PG8_STAGE(PG8_SA(0, 1), a2 + hstepA, voffA);
            PG8_WAIT_L(8); PG8_BAR; PG8_WAIT_L(0); PG8_MMA(0, 0, At, B0); PG8_BAR; PG8_SCHED;
            PG8_LDB(B1, 1, 1); PG8_STAGE(PG8_SB(1, 0), b3, voffB);
            PG8_BAR; PG8_WAIT_L(0); PG8_MMA(0, 1, At, B1); PG8_BAR;
            PG8_LDA(At, 1, 1); PG8_STAGE(PG8_SA(1, 0), a3, voffA);
            PG8_BAR; PG8_WAIT_L(0); PG8_MMA(1, 0, At, B0); PG8_BAR; PG8_SCHED;
            PG8_STAGE(PG8_SB(1, 1), b3 + hstepB, voffB);
            PG8_WAIT_V(6); PG8_BAR; PG8_MMA(1, 1, At, B1); PG8_BAR;
        }
        epi_run(g, acc, cur, wr, wc, fr, fq);
        if (!has_next) break;
        { const float z = OZ();
#pragma unroll
        for (int a = 0; a < 2; ++a)
#pragma unroll
            for (int b = 0; b < 2; ++b)
#pragma unroll
                for (int m = 0; m < 4; ++m)
#pragma unroll
                    for (int n = 0; n < 2; ++n) acc[a][b][m][n] = (f32x4){z, z, z, z}; }
        cur = nxt; cA = nA; cB = nB; ++ui;
    }
    PG8_WAIT_V(0);
    if (wr == 0) PG8_BAR;
    PG8_BAR;
#undef PG8_SA
#undef PG8_SB
#undef PG8_STAGE
#undef PG8_LDA
#undef PG8_LDB
#undef PG8_MMA
#undef PG8_WAIT_V
#undef PG8_WAIT_L
#undef PG8_BAR
#undef PG8_SCHED
}
}
using pg8::Unit;
using pg8::cvt_pk_bf16;

#define EPI_FOR_NP(...) \
    _Pragma("unroll") for (int ai = 0; ai < 2; ++ai) _Pragma("unroll") for (int m = 0; m < 4; ++m) { const int row = u.pm * 256 + ai * 128 + wr * 64 + m * 16 + fr; \
    _Pragma("unroll") for (int bj = 0; bj < 2; ++bj) _Pragma("unroll") for (int n = 0; n < 2; ++n) { const int col = u.pn * 256 + bj * 128 + wc * 32 + n * 16 + 4 * fq; const f32x4 v = acc[ai][bj][m][n]; __VA_ARGS__ } }

typedef const f32x4 (&AccRef)[2][2][4][2];

struct EpiWin {
    static constexpr bool PERM = false;
    bh* zg; float* zf;
    __device__ __forceinline__ void operator()(AccRef acc, const Unit& u, int wr, int wc, int fr, int fq) const {
        if (u.pn < 24) {
            EPI_FOR_NP({ u32x2 w; w.x = cvt_pk_bf16(fmaxf(sigmoidf_(v[0]), 1e-6f), fmaxf(sigmoidf_(v[1]), 1e-6f)); w.y = cvt_pk_bf16(fmaxf(sigmoidf_(v[2]), 1e-6f), fmaxf(sigmoidf_(v[3]), 1e-6f)); *(u32x2*)(zg + (size_t)row * NGATE + col) = w; })
        } else {
            EPI_FOR_NP({ *(f32x4*)(zf + (size_t)row * ZF_LD + (col - NGATE)) = v; })
        }
    }
};
struct EpiLoraW {
    static constexpr bool PERM = false;
    const float* w0; float* rw;
    __device__ __forceinline__ void operator()(AccRef acc, const Unit& u, int wr, int wc, int fr, int fq) const {
        EPI_FOR_NP({ const f32x4 b = *(const f32x4*)(w0 + col); f32x4 o;
            _Pragma("unroll") for (int j = 0; j < 4; ++j) { const float x = -(b[j] + v[j]); const float sp = fmaxf(x, 0.f) + log1pf(__expf(-fabsf(x))); o[j] = __expf(-__expf(-sp - 0.5f)); }
            *(f32x4*)(rw + (size_t)row * 512 + col) = o; })
    }
};
struct EpiLoraA {
    static constexpr bool PERM = false;
    const float* a0; const float* ka; const float* rkk; float* rb; float* rk;
    __device__ __forceinline__ void operator()(AccRef acc, const Unit& u, int wr, int wc, int fr, int fq) const {
        EPI_FOR_NP({ const f32x4 b0 = *(const f32x4*)(a0 + col); const f32x4 kav = *(const f32x4*)(ka + col); const size_t o = (size_t)row * 512 + col;
            const f32x4 kkv = *(const f32x4*)(rkk + o); f32x4 kv = *(const f32x4*)(rk + o); f32x4 bo;
            _Pragma("unroll") for (int j = 0; j < 4; ++j) { const float a = sigmoidf_(b0[j] + v[j]); bo[j] = -(kkv[j] * a); kv[j] = kv[j] * (1.0f + (a - 1.0f) * kav[j]); }
            *(f32x4*)(rb + o) = bo; *(f32x4*)(rk + o) = kv; })
    }
};
struct EpiStoreF32 {
    static constexpr bool PERM = false;
    float* o; int ld;
    __device__ __forceinline__ void operator()(AccRef acc, const Unit& u, int wr, int wc, int fr, int fq) const {
        EPI_FOR_NP({ *(f32x4*)(o + (size_t)row * ld + col) = v; })
    }
};
struct EpiGlu {
    static constexpr bool PERM = false;
    const bh* ys; const float* gb; bh* ycat;
    __device__ __forceinline__ void operator()(AccRef acc, const Unit& u, int wr, int wc, int fr, int fq) const {
        EPI_FOR_NP({ const f32x4 b = *(const f32x4*)(gb + col); const u32x2 y2 = *(const u32x2*)(ys + (size_t)row * 512 + col);
            const float y0 = __uint_as_float(y2.x << 16), y1 = __uint_as_float(y2.x & 0xffff0000u), y2f = __uint_as_float(y2.y << 16), y3 = __uint_as_float(y2.y & 0xffff0000u);
            u32x2 w; w.x = cvt_pk_bf16(y0 * sigmoidf_(v[0] + b[0]), y1 * sigmoidf_(v[1] + b[1])); w.y = cvt_pk_bf16(y2f * sigmoidf_(v[2] + b[2]), y3 * sigmoidf_(v[3] + b[3]));
            *(u32x2*)(ycat + (size_t)row * D + 1536 + col) = w; })
    }
};
template <int MODE> struct EpiUp {
    static constexpr bool PERM = false;
    const bh* zg; float* mix; bh* mixed;
    __device__ __forceinline__ void operator()(AccRef acc, const Unit& u, int wr, int wc, int fr, int fq) const {
        EPI_FOR_NP({ const u32x2 g2 = *(const u32x2*)(zg + (size_t)row * NGATE + col);
            f32x4 g; g[0] = __uint_as_float(g2.x << 16); g[1] = __uint_as_float(g2.x & 0xffff0000u); g[2] = __uint_as_float(g2.y << 16); g[3] = __uint_as_float(g2.y & 0xffff0000u);
            f32x4 r = g * v; float* mp = mix + (size_t)row * D + col;
            if (MODE >= 1) r += *(const f32x4*)mp;
            if (MODE <= 1) *(f32x4*)mp = r;
            else { u32x2 w; w.x = cvt_pk_bf16(r[0], r[1]); w.y = cvt_pk_bf16(r[2], r[3]); *(u32x2*)(mixed + (size_t)row * D + col) = w; } })
    }
};
struct EpiUpF {
    static constexpr bool PERM = false;
    const bh* zg; bh* mixed;
    __device__ __forceinline__ void operator()(AccRef acc, const Unit& u, int wr, int wc, int fr, int fq) const {
        EPI_FOR_NP({ const u32x2 g2 = *(const u32x2*)(zg + (size_t)row * NGATE + col);
            u32x2 w; w.x = cvt_pk_bf16(__uint_as_float(g2.x << 16) * v[0], __uint_as_float(g2.x & 0xffff0000u) * v[1]); w.y = cvt_pk_bf16(__uint_as_float(g2.y << 16) * v[2], __uint_as_float(g2.y & 0xffff0000u) * v[3]);
            *(u32x2*)(mixed + (size_t)row * D + col) = w; })
    }
};
struct EpiRes {
    static constexpr bool PERM = false;
    float* h;
    __device__ __forceinline__ void operator()(AccRef acc, const Unit& u, int wr, int wc, int fr, int fq) const {
        EPI_FOR_NP({ float* hp = h + (size_t)row * D + col; *(f32x4*)hp = *(const f32x4*)hp + v; })
    }
};
struct EpiFfn {
    static constexpr bool PERM = true;
    bh* act;
    __device__ __forceinline__ void operator()(AccRef acc, const Unit& u, int wr, int wc, int fr, int fq) const {
#pragma unroll
        for (int ai = 0; ai < 2; ++ai)
#pragma unroll
            for (int m = 0; m < 4; ++m) { const int row = u.pm * 256 + ai * 128 + wr * 64 + m * 16 + fr; const int col = u.pn * 128 + wc * 32 + 8 * fq;
                float o[8];
#pragma unroll
                for (int n = 0; n < 2; ++n)
#pragma unroll
                    for (int j = 0; j < 4; ++j) { const float gte = acc[ai][0][m][n][j], up = acc[ai][1][m][n][j]; o[n * 4 + j] = gte * sigmoidf_(gte) * up; }
                u32x4 w; w.x = cvt_pk_bf16(o[0], o[1]); w.y = cvt_pk_bf16(o[2], o[3]); w.z = cvt_pk_bf16(o[4], o[5]); w.w = cvt_pk_bf16(o[6], o[7]);
                *(u32x4*)(act + (size_t)row * FH + col) = w; }
    }
};
struct EpiPle {
    static constexpr bool PERM = false;
    float* h; const float* tmp;
    __device__ __forceinline__ void operator()(AccRef acc, const Unit& u, int wr, int wc, int fr, int fq) const {
        EPI_FOR_NP({ float* hp = h + (size_t)row * D + col; const f32x4 tv = *(const f32x4*)(tmp + (size_t)row * D + col); f32x4 hv = *(const f32x4*)hp;
            _Pragma("unroll") for (int j = 0; j < 4; ++j) hv[j] += tv[j] * sigmoidf_(v[j]);
            *(f32x4*)hp = hv; })
    }
};

namespace pg8 {
__device__ __forceinline__ void epi_run(const Gemm& g, const f32x4 (&acc)[2][2][4][2], const Unit& u, int wr, int wc, int fr, int fq) {
    unsigned char* ws = P_WS; const int L = g.L;
    switch (g.epi) {
    case 0: { EpiWin E{(bh*)(ws + OFF_ZG), (float*)(ws + OFF_ZF)}; E(acc, u, wr, wc, fr, fq); } break;
    case 1: { EpiLoraW E{P_IN(9) + L * 512, (float*)(ws + OFF_RW)}; E(acc, u, wr, wc, fr, fq); } break;
    case 2: { EpiLoraA E{P_IN(11) + L * 512, P_IN(15) + L * 512, (const float*)(ws + OFF_RKK), (float*)(ws + OFF_RB), (float*)(ws + OFF_RK)}; E(acc, u, wr, wc, fr, fq); } break;
    case 3: { EpiStoreF32 E{(float*)(ws + (g.N == 512 ? OFF_RG : OFF_MIX32)), g.N}; E(acc, u, wr, wc, fr, fq); } break;
    case 4: { EpiGlu E{(const bh*)(ws + OFF_YS), P_IN(28) + L * 512, (bh*)(ws + OFF_YCAT)}; E(acc, u, wr, wc, fr, fq); } break;
    case 5: { EpiUp<0> E{(const bh*)(ws + OFF_ZG), (float*)(ws + OFF_MIX32), (bh*)(ws + OFF_ABF)}; E(acc, u, wr, wc, fr, fq); } break;
    case 6: { EpiUp<1> E{(const bh*)(ws + OFF_ZG) + 2048, (float*)(ws + OFF_MIX32), (bh*)(ws + OFF_ABF)}; E(acc, u, wr, wc, fr, fq); } break;
    case 7: { EpiUp<2> E{(const bh*)(ws + OFF_ZG) + 4096, (float*)(ws + OFF_MIX32), (bh*)(ws + OFF_ABF)}; E(acc, u, wr, wc, fr, fq); } break;
    case 8: { EpiRes E{P_OUT}; E(acc, u, wr, wc, fr, fq); } break;
    case 9: { EpiFfn E{(bh*)(ws + OFF_ACT)}; E(acc, u, wr, wc, fr, fq); } break;
    case 11: { EpiUpF E{(const bh*)(ws + OFF_ZG) + 4096, (bh*)(ws + OFF_ABF)}; E(acc, u, wr, wc, fr, fq); } break;
    default: { EpiPle E{P_OUT, (const float*)(ws + OFF_MIX32)}; E(acc, u, wr, wc, fr, fq); } break;
    }
}
}

__device__ __forceinline__ bool make_gemm(const Params& p, int L, int q, int i, pg8::Gemm& g) {
    unsigned char* ws = P_WS;
    g.M = T; g.perm = 0; g.L = L;
    switch (q) {
    case 1: if (i > 0) return false;
        g.A = (const bh*)(ws + OFF_ABF); g.lda = D; g.Bt = (const bh*)(ws + OFF_WIN); g.ldb = D; g.N = NINP; g.K = D; g.epi = 0; return true;
    case 3: if (i > 2) return false;
        g.lda = 256; g.ldb = 256; g.N = 512; g.K = 256;
        if (i == 0) { g.A = (const bh*)(ws + OFF_LAW); g.Bt = (const bh*)(ws + OFF_WW2); g.epi = 1; }
        else if (i == 1) { g.A = (const bh*)(ws + OFF_LAA); g.Bt = (const bh*)(ws + OFF_WA2); g.epi = 2; }
        else { g.A = (const bh*)(ws + OFF_LAG); g.Bt = (const bh*)(ws + OFF_WG2); g.epi = 3; }
        return true;
    case 5: if (i > 0) return false;
        g.A = (const bh*)(ws + OFF_YS); g.lda = 512; g.Bt = (const bh*)(ws + OFF_WGLU); g.ldb = 512; g.N = 512; g.K = 512; g.epi = 4; return true;
    case 6: if (i > 0) return false;
        g.A = (const bh*)(ws + OFF_YCAT); g.lda = D; g.Bt = (const bh*)(ws + OFF_WUP); g.ldb = D; g.N = D; g.K = D; g.epi = 11; return true;
    case 7: if (i > 0) return false;
        g.A = (const bh*)(ws + OFF_ABF); g.lda = D; g.Bt = (const bh*)(ws + OFF_WO); g.ldb = D; g.N = D; g.K = D; g.epi = 8; return true;
    case 9: if (i > 0) return false;
        g.A = (const bh*)(ws + OFF_ABF); g.lda = D; g.Bt = (const bh*)(ws + OFF_WGU); g.ldb = D; g.N = 2 * FH; g.K = D; g.epi = 9; g.perm = 1; return true;
    case 10: if (i > 0) return false;
        g.A = (const bh*)(ws + OFF_ACT); g.lda = FH; g.Bt = (const bh*)(ws + OFF_WD); g.ldb = FH; g.N = D; g.K = FH; g.epi = 8; return true;
    case 12: if (i > 1) return false;
        if (i == 0) { g.A = (const bh*)(ws + OFF_PBF) + (size_t)L * T * 256; g.lda = 256; g.Bt = (const bh*)(ws + OFF_WPP); g.ldb = 256; g.N = D; g.K = 256; g.epi = 3; }
        else { g.A = (const bh*)(ws + OFF_ABF); g.lda = D; g.Bt = (const bh*)(ws + OFF_WPG); g.ldb = D; g.N = D; g.K = D; g.epi = 10; }
        return true;
    default: return false;
    }
}

struct CJ { const float* src; int in_idx, src_ld, kv, n0, nv; long lstride; size_t dst; int dst_ld, r0, c0, npad, kpad, seg, segstride; };
constexpr int BIGSEG = 1 << 30;
__constant__ int JT_I[15][12] = {
    {3, NIN, 2048, NF, NGATE, D, 0, 0, NGATE, 2048, BIGSEG, 0},
    {3, NIN, 2048, 0, NF, D, NGATE, 0, 6656, 2048, BIGSEG, 0},
    {29, D, 1024, 0, D, D, 0, 0, D, 1024, BIGSEG, 0},
    {30, D, 512, 0, D, D, 0, 1024, D, 512, BIGSEG, 0},
    {31, D, 512, 0, D, D, 0, 1536, D, 512, BIGSEG, 0},
    {32, D, 2048, 0, D, D, 0, 0, D, 2048, BIGSEG, 0},
    {34, FH, 2048, 0, FH, D, 0, 0, FH, 2048, 128, 256},
    {35, FH, 2048, 0, FH, D, 128, 0, FH, 2048, 128, 256},
    {36, D, FH, 0, D, FH, 0, 0, D, FH, BIGSEG, 0},
    {38, D, 2048, 0, D, D, 0, 0, D, 2048, BIGSEG, 0},
    {39, D, 256, 0, D, 256, 0, 0, D, 256, BIGSEG, 0},
    {27, 512, 512, 0, 512, 512, 0, 0, 512, 512, BIGSEG, 0},
    {10, 512, 96, 0, 512, 256, 0, 0, 512, 256, BIGSEG, 0},
    {12, 512, 96, 0, 512, 256, 0, 0, 512, 256, BIGSEG, 0},
    {13, 512, 256, 0, 512, 256, 0, 0, 512, 256, BIGSEG, 0}};
__constant__ long JT_L[15][2] = {
    {(long)D * NIN, (long)OFF_WIN}, {(long)D * NIN, (long)OFF_WIN}, {(long)1024 * D, (long)OFF_WUP}, {(long)512 * D, (long)OFF_WUP}, {(long)512 * D, (long)OFF_WUP},
    {(long)D * D, (long)OFF_WO}, {(long)D * FH, (long)OFF_WGU}, {(long)D * FH, (long)OFF_WGU}, {(long)FH * D, (long)OFF_WD}, {(long)D * D, (long)OFF_WPG},
    {(long)256 * D, (long)OFF_WPP}, {(long)512 * 512, (long)OFF_WGLU}, {(long)96 * 512, (long)OFF_WW2}, {(long)96 * 512, (long)OFF_WA2}, {(long)256 * 512, (long)OFF_WG2}};
__device__ __forceinline__ void get_job(int j, CJ& J) {
    J.in_idx = JT_I[j][0]; J.src_ld = JT_I[j][1]; J.kv = JT_I[j][2]; J.n0 = JT_I[j][3]; J.nv = JT_I[j][4]; J.dst_ld = JT_I[j][5]; J.r0 = JT_I[j][6]; J.c0 = JT_I[j][7];
    J.npad = JT_I[j][8]; J.kpad = JT_I[j][9]; J.seg = JT_I[j][10]; J.segstride = JT_I[j][11]; J.lstride = JT_L[j][0]; J.dst = (size_t)JT_L[j][1];
}
__device__ __forceinline__ const float* in_by_idx(const Params& p, int i) { return P_IN(i); }
constexpr int NJOBS = 15;

__device__ __forceinline__ void conv_tile(int L, const CJ& J, int tile, int lane, bh* dstbase) {
    const int nkt = J.kpad / 64; const int tn = tile / nkt, tk = tile % nkt;
    const float* src = J.src + (size_t)L * J.lstride;
    const int cq = lane & 15, r = lane >> 4;
    const int nl = tn * 64 + cq * 4; const bool nok = nl < J.nv;
    const int k0 = tk * 64 + 16 * r;
    f32x4 v[16];
    const float* sp = src + (size_t)k0 * J.src_ld + J.n0 + nl;
    const float zc = OZ();
#pragma unroll
    for (int i = 0; i < 16; ++i) { v[i] = (f32x4){zc, zc, zc, zc}; if (nok && (k0 + i) < J.kv) v[i] = *(const f32x4*)(sp + (size_t)i * J.src_ld); }
#pragma unroll
    for (int j = 0; j < 4; ++j) { const int n = nl + j; const int drow = J.r0 + (n / J.seg) * J.segstride + (n % J.seg);
        u32x4 w0, w1;
        w0.x = cvt_pk_bf16(v[0][j], v[1][j]); w0.y = cvt_pk_bf16(v[2][j], v[3][j]); w0.z = cvt_pk_bf16(v[4][j], v[5][j]); w0.w = cvt_pk_bf16(v[6][j], v[7][j]);
        w1.x = cvt_pk_bf16(v[8][j], v[9][j]); w1.y = cvt_pk_bf16(v[10][j], v[11][j]); w1.z = cvt_pk_bf16(v[12][j], v[13][j]); w1.w = cvt_pk_bf16(v[14][j], v[15][j]);
        bh* d = dstbase + (size_t)drow * J.dst_ld + J.c0 + k0;
        *(u32x4*)d = w0; *(u32x4*)(d + 8) = w1; }
}

__device__ __forceinline__ void rms_row_bf16(const float* x, const float* g, bh* o, int lane) {
    f32x4 v[8]; float s = 0.f;
#pragma unroll
    for (int j = 0; j < 8; ++j) { v[j] = *(const f32x4*)(x + j * 256 + lane * 4); s += (v[j][0] * v[j][0] + v[j][1] * v[j][1]) + (v[j][2] * v[j][2] + v[j][3] * v[j][3]); }
    const float rstd = rsqrtf(wave_sum(s) * (1.0f / D) + 1e-6f);
#pragma unroll
    for (int j = 0; j < 8; ++j) { const f32x4 gg = *(const f32x4*)(g + j * 256 + lane * 4); u32x2 w; w.x = pk2(v[j][0] * rstd * gg[0], v[j][1] * rstd * gg[1]); w.y = pk2(v[j][2] * rstd * gg[2], v[j][3] * rstd * gg[3]);
        *(u32x2*)(o + j * 256 + lane * 4) = w; }
}
__device__ __forceinline__ void phase_rmsnorm(const Params& p, const float* g) {
    const int gw = BIDX() * 8 + (TIDX() >> 6), NGW = GDIM() * 8, lane = TIDX() & 63;
    bh* abf = (bh*)(P_WS + OFF_ABF);
    for (int r = gw; r < T; r += NGW) rms_row_bf16(P_OUT + (size_t)r * D, g, abf + (size_t)r * D, lane);
}

__device__ __forceinline__ void phase_conv(const Params& p, int L, LAS unsigned char* lds) {
    const int tid = TIDX();
    {   const int gw0 = BIDX() * 8 + (tid >> 6), NGW0 = GDIM() * 8, ln = tid & 63;
        int base = 0;
        for (int j = 0; j < NJOBS; ++j) { CJ J; get_job(j, J); J.src = in_by_idx(p, J.in_idx); const int ntile = (J.npad / 64) * (J.kpad / 64);
            int first = gw0 - (base % NGW0); if (first < 0) first += NGW0;
            bh* dstbase = (bh*)(P_WS + J.dst);
            for (int t = first; t < ntile; t += NGW0) conv_tile(L, J, t, ln, dstbase);
            base += ntile; } }
    const int gw = BIDX() * 8 + (tid >> 6), NGW = GDIM() * 8, lane = tid & 63;
    bh* abf = (bh*)(P_WS + OFF_ABF);
    if (L == 0) {
        const float* ps = P_IN(1); bh* pb = (bh*)(P_WS + OFF_PBF);
        for (size_t i = (size_t)BIDX() * 512 + tid; i < (size_t)2 * T * 256 / 4; i += (size_t)GDIM() * 512) { const f32x4 v = ((const f32x4*)ps)[i]; u32x2 w; w.x = pk2(v[0], v[1]); w.y = pk2(v[2], v[3]); ((u32x2*)pb)[i] = w; }
        const float* x = P_IN(0);
        for (int r = gw; r < T; r += NGW) {
#pragma unroll
            for (int j = 0; j < 8; ++j) *(f32x4*)(P_OUT + (size_t)r * D + j * 256 + lane * 4) = *(const f32x4*)(x + (size_t)r * D + j * 256 + lane * 4);
            rms_row_bf16(x + (size_t)r * D, P_IN(2), abf + (size_t)r * D, lane);
        }
    } else {
        for (int r = gw; r < T; r += NGW) rms_row_bf16(P_OUT + (size_t)r * D, P_IN(2) + (size_t)L * D, abf + (size_t)r * D, lane);
    }
}

struct S5C { float ar, ai; float br[16], bi[16]; };
__device__ __forceinline__ void s5_setup(const Params& p, int L, int g, int n, S5C& c) {
    const int gi = L * 32 + g;
    const float dt = __expf(P_IN(21)[gi]);
    const float are = P_IN(19)[gi * 64 + n], aim = P_IN(20)[gi * 64 + n];
    const float mag = __expf(are * dt), ang = aim * dt;
    float sn, cs;
    {
        const double a = (double)ang; const double k = rint(a * 0.15915494309189535); const float r = (float)(a - k * 6.283185307179586);
        sn = sinf(r); cs = cosf(r);
    }
    c.ar = mag * cs; c.ai = mag * sn;
    const float den = are * are + aim * aim, nr = c.ar - 1.0f, ni = c.ai;
    const float cr = (nr * are + ni * aim) / den, ci = (ni * are - nr * aim) / den;
    const float* bre = P_IN(22) + ((size_t)gi * 64 + n) * 16; const float* bim = P_IN(23) + ((size_t)gi * 64 + n) * 16;
#pragma unroll
    for (int q = 0; q < 4; ++q) { const f32x4 r4 = *(const f32x4*)(bre + q * 4), i4 = *(const f32x4*)(bim + q * 4);
#pragma unroll
        for (int j = 0; j < 4; ++j) { c.br[q * 4 + j] = cr * r4[j] - ci * i4[j]; c.bi[q * 4 + j] = cr * i4[j] + ci * r4[j]; } }
}
__device__ __forceinline__ void s5_step(const S5C& c, const LAS float* urow, float& sr, float& si) {
    float xr = 0.f, xi = 0.f;
#pragma unroll
    for (int q = 0; q < 4; ++q) { const f32x4 u4 = *(const LAS f32x4*)(urow + q * 4);
#pragma unroll
        for (int j = 0; j < 4; ++j) { xr = fmaf(u4[j], c.br[q * 4 + j], xr); xi = fmaf(u4[j], c.bi[q * 4 + j], xi); } }
    const float nr = c.ar * sr - c.ai * si + xr, ni = c.ar * si + c.ai * sr + xi;
    sr = nr; si = ni;
}
__device__ __forceinline__ void s5_stage_u(const float* zfc, LAS float* ul, int lane) {
    const float* src = zfc + (size_t)lane * ZF_LD;
    const f32x4 a = *(const f32x4*)src, b = *(const f32x4*)(src + 4), c = *(const f32x4*)(src + 8), d = *(const f32x4*)(src + 12);
    *(LAS f32x4*)(ul + lane * 16) = a; *(LAS f32x4*)(ul + lane * 16 + 4) = b; *(LAS f32x4*)(ul + lane * 16 + 8) = c; *(LAS f32x4*)(ul + lane * 16 + 12) = d;
    asm volatile("s_waitcnt lgkmcnt(0)" ::: "memory"); __builtin_amdgcn_wave_barrier();
}

__device__ __forceinline__ size_t fq_base(int h, int c, int mt, int ks8) { return ((((size_t)(h * NCH + c) * 4 + mt) * 8 + ks8) * 64) * 8; }
__device__ __forceinline__ size_t fq_off(int h, int t, int d) { const int s = t & 63; return fq_base(h, t >> 6, s >> 4, d >> 5) + ((s & 15) + 16 * ((d >> 3) & 3)) * 8 + (d & 7); }
__device__ __forceinline__ int ft_off(int row, int s8) { return ((((row >> 5) * 4 + (s8 >> 1)) * 64) + (row & 31) + 32 * (s8 & 1)) * 8; }

__device__ __forceinline__ void mlstm_prep(const Params& p, int L, int h, int c, LAS unsigned char* lds) {
    const int tid = TIDX(), t0 = c * 64;
    const float* zf = (const float*)(P_WS + OFF_ZF);
    LAS float* s_ws = (LAS float*)lds;
    if (tid < 64) {
        const int t = t0 + tid;
        float ig = zf[(size_t)t * ZF_LD + 4096 + h] + P_IN(5)[L * 4 + h];
        float fg = zf[(size_t)t * ZF_LD + 4100 + h] + P_IN(6)[L * 4 + h];
        ig = 15.0f * tanhf(ig * (1.0f / 15.0f)); fg = 15.0f * tanhf(fg * (1.0f / 15.0f));
        const float lf = fminf(fg, 0.f) - log1pf(__expf(-fabsf(fg)));
        float b = lf;
#pragma unroll
        for (int o = 1; o < 64; o <<= 1) { const float nb = bperm_f((tid - o) & 63, b); if (tid >= o) b += nb; }
        const float bend = bperm_f(63, b);
        const float wlog = bend - b + ig;
        const float mloc = wave_max(wlog);
        s_ws[tid] = __expf(wlog - mloc);
        ((float*)(P_WS + OFF_MI))[h * T + t] = ig; ((float*)(P_WS + OFF_MBB))[h * T + t] = b;
        if (tid == 0) { ((float*)(P_WS + OFF_MBEND))[h * NCH + c] = bend; ((float*)(P_WS + OFF_MLOC))[h * NCH + c] = mloc; }
    }
    __syncthreads();
    const int d = tid & 255, isk = tid >> 8;
    const int col = isk * 1024 + h * 256 + d;
    const float* cw = P_IN(4) + (size_t)L * 4 * 2048;
    const float w0 = cw[col], w1 = cw[2048 + col], w2 = cw[4096 + col], w3 = cw[6144 + col];
    float x1 = (t0 >= 1) ? zf[(size_t)(t0 - 1) * ZF_LD + col] : 0.f, x2 = (t0 >= 2) ? zf[(size_t)(t0 - 2) * ZF_LD + col] : 0.f, x3 = (t0 >= 3) ? zf[(size_t)(t0 - 3) * ZF_LD + col] : 0.f;
    bh* MQ = (bh*)(P_WS + OFF_MQ); bh* MK = (bh*)(P_WS + OFF_MK);
    bh* MT = (bh*)(P_WS + (isk ? OFF_MKT : OFF_MVT)) + (size_t)(h * NCH + c) * 16384;
    LAS bh* sQK = (LAS bh*)(lds + 1024);
    float dnacc = 0.f;
    for (int s8 = 0; s8 < 8; ++s8) {
        unsigned pk[4];
#pragma unroll
        for (int j = 0; j < 8; ++j) { const int s = s8 * 8 + j, t = t0 + s;
            const float x0 = zf[(size_t)t * ZF_LD + col]; float y = w0 * x0 + w1 * x1 + w2 * x2 + w3 * x3; x3 = x2; x2 = x1; x1 = x0;
            y = y * sigmoidf_(y);
            unsigned short e;
            if (!isk) { sQK[s * 264 + d] = f2bf(y * 0.0625f); e = f2bf(zf[(size_t)t * ZF_LD + 2048 + h * 256 + d]); }
            else { sQK[64 * 264 + s * 264 + d] = f2bf(y); const float wk = y * s_ws[s]; e = f2bf(wk); dnacc += wk; }
            if (j & 1) pk[j >> 1] |= ((unsigned)e << 16); else pk[j >> 1] = e; }
        u32x4 w; w.x = pk[0]; w.y = pk[1]; w.z = pk[2]; w.w = pk[3];
        *(u32x4*)(MT + ft_off(d, s8)) = w;
    }
    if (isk) ((float*)(P_WS + OFF_DN))[(size_t)(h * NCH + c) * 256 + d] = dnacc;
    __syncthreads();
#pragma unroll
    for (int i = 0; i < 8; ++i) { const int pid = i * 512 + tid, tens = pid >> 11, rem = pid & 2047, mt = rem >> 9, ks8 = (rem >> 6) & 7, lp = rem & 63;
        const u32x4 w = *(const LAS u32x4*)(sQK + tens * (64 * 264) + (mt * 16 + (lp & 15)) * 264 + ks8 * 32 + (lp >> 4) * 8);
        *(u32x4*)((tens ? MK : MQ) + fq_base(h, c, mt, ks8) + lp * 8) = w; }
    __syncthreads();
}

__device__ __forceinline__ void rwkv_prep_token(const Params& p, int L, int t, int lane) {
    const float* zf = (const float*)(P_WS + OFF_ZF);
    const float* z = zf + (size_t)t * ZF_LD + ZR0; const float* zp = z - ZF_LD; const bool hp = t > 0;
    const float* mu = P_IN(8) + (size_t)L * 1984;
    float* RR = (float*)(P_WS + OFF_RR); float* RK = (float*)(P_WS + OFF_RK); float* RV = (float*)(P_WS + OFF_RV); float* RKK = (float*)(P_WS + OFF_RKK);
    const float* kkw = P_IN(14) + L * 512;
#pragma unroll
    for (int i = 0; i < 8; ++i) { const int c = i * 64 + lane;
        { const float a = z[c], b = hp ? zp[c] : 0.f; RR[(size_t)t * 512 + c] = a + (b - a) * mu[c]; }
        { const float a = z[1024 + c], b = hp ? zp[1024 + c] : 0.f; RV[(size_t)t * 512 + c] = a + (b - a) * mu[1024 + c]; }
        { const float a = z[512 + c], b = hp ? zp[512 + c] : 0.f; const float k = a + (b - a) * mu[512 + c]; RK[(size_t)t * 512 + c] = k;
          const float kkv = k * kkw[c]; const float ss = wave_sum(kkv * kkv); RKK[(size_t)t * 512 + c] = kkv / fmaxf(sqrtf(ss), 1e-12f); } }
    bh* LAW = (bh*)(P_WS + OFF_LAW) + (size_t)t * 256; bh* LAA = (bh*)(P_WS + OFF_LAA) + (size_t)t * 256; bh* LAG = (bh*)(P_WS + OFF_LAG) + (size_t)t * 256;
#pragma unroll
    for (int i = 0; i < 4; ++i) { const int j = i * 64 + lane;
        float vw = 0.f, va = 0.f;
        if (j < 96) { { const int c = 1536 + j; const float a = z[c], b = hp ? zp[c] : 0.f; vw = tanhf(a + (b - a) * mu[c]); }
                      { const int c = 1632 + j; const float a = z[c], b = hp ? zp[c] : 0.f; va = a + (b - a) * mu[c]; } }
        LAW[j] = f2bf(vw); LAA[j] = f2bf(va);
        { const int c = 1728 + j; const float a = z[c], b = hp ? zp[c] : 0.f; LAG[j] = f2bf(sigmoidf_(a + (b - a) * mu[c])); } }
}

__device__ __forceinline__ void s5_pass_a(const Params& p, int L, int g, int c, int lane, LAS float* ul) {
    const float* zf = (const float*)(P_WS + OFF_ZF) + (size_t)(c * 64) * ZF_LD + ZS0 + g * 16;
    s5_stage_u(zf, ul, lane);
    S5C k; s5_setup(p, L, g, lane, k);
    float sr = 0.f, si = 0.f;
#pragma unroll 8
    for (int s = 0; s < 64; ++s) s5_step(k, ul + s * 16, sr, si);
    asm volatile("s_waitcnt lgkmcnt(0)" ::: "memory"); __builtin_amdgcn_wave_barrier();
    float* se = (float*)(P_WS + OFF_SEND) + ((size_t)(g * NCH + c) * 64 + lane) * 2;
    se[0] = sr; se[1] = si;
}

__device__ __forceinline__ void phase_prep(const Params& p, int L, LAS unsigned char* lds) {
    const int wid = TIDX() >> 6, lane = TIDX() & 63;
    for (int it = BIDX(); it < 2048; it += GDIM()) {
        if (it < 512) mlstm_prep(p, L, it >> 7, it & 127, lds);
        else if (it < 1536) rwkv_prep_token(p, L, (it - 512) * 8 + wid, lane);
        else { const int w = (it - 1536) * 8 + wid; s5_pass_a(p, L, w >> 7, w & 127, lane, (LAS float*)lds + wid * 1024); }
    }
}

constexpr int RW_NS = 4, RW_LS = T / RW_NS, RW_NB = RW_LS / 16, RW_RING = 4, RW_SLOT = 16 * 384;
constexpr int RW_YOFF = RW_RING * RW_SLOT;
__device__ __forceinline__ void rwkv_scan(const Params& p, int b, LAS unsigned char* lds) {
    const int tid = TIDX(), wid = __builtin_amdgcn_readfirstlane(tid >> 6), lane = tid & 63;
    int j, h, rg;
    if (b < 32) { j = 0; h = b >> 2; rg = b & 3; } else { const int u = b - 32; j = 1 + (u >> 6); h = (u & 63) >> 3; rg = u & 7; }
    LAS float* ring = (LAS float*)lds;
    LAS float* ybuf = ring + RW_YOFF;
    const int tbase = j * RW_LS;
    const bool isP = rg >= 4;
    if (wid >= 4) {
        const int lw = wid - 4, lt = tid - 256;
        const float* gp[6]; unsigned lo[6];
#pragma unroll
        for (int i = 0; i < 6; ++i) { const int ii = lw * 6 + i, rowidx = ii * 4 + (lane >> 4), step = rowidx / 6, a = rowidx % 6, q = lane & 15;
            const int ai = (0x205314 >> (4 * a)) & 0xf;
            gp[i] = (const float*)(P_WS + OFF_RR + (size_t)ai * SZ_R) + (size_t)(tbase + step) * 512 + h * 64 + q * 4;
            lo[i] = (unsigned)ii * 256u; }
        float* OUT = (float*)(P_WS + (isP ? OFF_RZ : OFF_RY)) + (size_t)(tbase + (lt >> 4)) * 512 + h * 64 + (rg & 3) * 16 + (lt & 15);
#define RW_ISSUE(bi, sl) do { _Pragma("unroll") for (int _i = 0; _i < 6; ++_i) \
        __builtin_amdgcn_global_load_lds((const unsigned*)(gp[_i] + (size_t)(bi) * 16 * 512), (LAS unsigned*)(ring + (sl) * RW_SLOT + lo[_i]), 16, 0, 0); } while (0)
        RW_ISSUE(0, 0); RW_ISSUE(1, 1); RW_ISSUE(2, 2);
        asm volatile("s_waitcnt vmcnt(12)" ::: "memory"); __builtin_amdgcn_s_barrier();
        int sl = 3;
        for (int ib = 0; ib < RW_NB; ++ib) {
            if (ib + 3 < RW_NB) RW_ISSUE(ib + 3, sl);
            sl = (sl == RW_RING - 1) ? 0 : sl + 1;
            if (ib > 0) {
                const LAS float* yb = ybuf + ((ib - 1) & 1) * 4096 + lt * 16;
                const f32x4 a0 = *(const LAS f32x4*)yb, a1 = *(const LAS f32x4*)(yb + 4), a2 = *(const LAS f32x4*)(yb + 8), a3 = *(const LAS f32x4*)(yb + 12);
                const f32x4 sm = (a0 + a1) + (a2 + a3);
                OUT[(size_t)(ib - 1) * 16 * 512] = (sm[0] + sm[1]) + (sm[2] + sm[3]);
            }
            if (ib + 3 < RW_NB) asm volatile("s_waitcnt vmcnt(13)" ::: "memory");
            else asm volatile("s_waitcnt vmcnt(0)" ::: "memory");
            __builtin_amdgcn_s_barrier();
        }
        {   const LAS float* yb = ybuf + ((RW_NB - 1) & 1) * 4096 + lt * 16;
            const f32x4 a0 = *(const LAS f32x4*)yb, a1 = *(const LAS f32x4*)(yb + 4), a2 = *(const LAS f32x4*)(yb + 8), a3 = *(const LAS f32x4*)(yb + 12);
            const f32x4 sm = (a0 + a1) + (a2 + a3);
            OUT[(size_t)(RW_NB - 1) * 16 * 512] = (sm[0] + sm[1]) + (sm[2] + sm[3]); }
#undef RW_ISSUE
    } else {
        const int r16 = wid * 4 + (lane >> 4), kq = lane & 15, row = (rg & 3) * 16 + r16;
        f32x4 S;
#pragma unroll
        for (int e = 0; e < 4; ++e) S[e] = (isP && (kq * 4 + e == row)) ? 1.f : 0.f;
        const float vmask = isP ? 0.f : 1.f;
        __builtin_amdgcn_s_barrier();
        int sl = 0;
        for (int ib = 0; ib < RW_NB; ++ib) {
            const LAS float* bb = ring + sl * RW_SLOT;
            LAS float* yw = ybuf + (ib & 1) * 4096 + r16 * 16 + kq;
            f32x4 w4 = *(const LAS f32x4*)(bb + kq * 4), k4 = *(const LAS f32x4*)(bb + 64 + kq * 4), kk4 = *(const LAS f32x4*)(bb + 128 + kq * 4),
                  b4 = *(const LAS f32x4*)(bb + 192 + kq * 4), r4 = *(const LAS f32x4*)(bb + 256 + kq * 4);
            float vv = bb[320 + row];
#pragma unroll
            for (int s = 0; s < 16; ++s) {
                f32x4 w4n, k4n, kk4n, b4n, r4n; float vvn;
                if (s < 15) { const LAS float* q = bb + (s + 1) * 384;
                    w4n = *(const LAS f32x4*)(q + kq * 4); k4n = *(const LAS f32x4*)(q + 64 + kq * 4); kk4n = *(const LAS f32x4*)(q + 128 + kq * 4);
                    b4n = *(const LAS f32x4*)(q + 192 + kq * 4); r4n = *(const LAS f32x4*)(q + 256 + kq * 4); vvn = q[320 + row]; }
                __builtin_amdgcn_sched_barrier(0);
                float pd = fmaf(S[0], kk4[0], fmaf(S[1], kk4[1], fmaf(S[2], kk4[2], S[3] * kk4[3])));
                const f32x4 pre = S * w4 + (vv * vmask) * k4;
                pd = allreduce16(pd);
                S = pre + pd * b4;
                yw[s * 256] = fmaf(S[0], r4[0], fmaf(S[1], r4[1], fmaf(S[2], r4[2], S[3] * r4[3])));
                if (s < 15) { w4 = w4n; k4 = k4n; kk4 = kk4n; b4 = b4n; r4 = r4n; vv = vvn; }
            }
            sl = (sl == RW_RING - 1) ? 0 : sl + 1;
            asm volatile("s_waitcnt lgkmcnt(0)" ::: "memory");
            __builtin_amdgcn_s_barrier();
        }
        float* EN = (float*)(P_WS + (isP ? OFF_RPEND : OFF_RSEND)) + ((size_t)(h * 4 + j) * 64 + row) * 64 + kq * 4;
        *(f32x4*)EN = S;
    }
    __syncthreads();
}

struct MStage { bf16x8 q[4], k[4], v[4]; float bend, mloc; };
__device__ __forceinline__ void mstage_load(MStage& st, const bh* qp, const bh* kp, const bh* vp, const float* MBEND, const float* MLOC, int h, int c) {
#pragma unroll
    for (int ks = 0; ks < 4; ++ks) { st.q[ks] = *(const bf16x8*)(qp + (size_t)c * 16384 + ks * 512); st.k[ks] = *(const bf16x8*)(kp + (size_t)c * 16384 + ks * 512); st.v[ks] = *(const bf16x8*)(vp + (size_t)c * 16384 + ks * 512); }
    st.bend = MBEND[h * NCH + c]; st.mloc = MLOC[h * NCH + c];
}
__device__ __forceinline__ void mlstm_seq(const Params& p, int mb, LAS unsigned char* lds) {
    const int tid = TIDX(), wid = tid >> 6, lane = tid & 63;
    const int h = mb >> 3, jv = mb & 7;
    LAS bh* Cbf = (LAS bh*)lds;
    constexpr int CS = 264;
    for (int i = tid; i < 2 * 32 * CS / 2; i += 512) ((LAS unsigned*)Cbf)[i] = 0u;
    __syncthreads();
    const bh* MQ = (const bh*)(P_WS + OFF_MQ); const bh* MKT = (const bh*)(P_WS + OFF_MKT); const bh* MVT = (const bh*)(P_WS + OFF_MVT);
    const float* MBEND = (const float*)(P_WS + OFF_MBEND); const float* MLOC = (const float*)(P_WS + OFF_MLOC);
    f32x16 ct;
    { const float z = OZ();
#pragma unroll
    for (int i = 0; i < 16; ++i) ct[i] = z; }
    float m = 0.f;
    const int mt = wid >> 1, kh = wid & 1;
    float* MINTER = (float*)(P_WS + OFF_ABF);
    LAS float* It = (LAS float*)(lds + 2 * 32 * 264 * 2);
    const bh* qp = MQ + fq_base(h, 0, mt, kh * 4) + lane * 8;
    const bh* kp = MKT + (size_t)(h * NCH) * 16384 + (wid * 4 * 64 + lane) * 8;
    const bh* vp = MVT + (size_t)(h * NCH) * 16384 + (jv * 4 * 64 + lane) * 8;
    MStage s0, s1, s2;
    mstage_load(s0, qp, kp, vp, MBEND, MLOC, h, 0);
    mstage_load(s1, qp, kp, vp, MBEND, MLOC, h, 1);
#define MSTEP(SC, SL, CIDX) do { const int c = (CIDX); const int t0 = c * 64, cur = c & 1; \
        mstage_load(SL, qp, kp, vp, MBEND, MLOC, h, (c + 2 < NCH) ? c + 2 : NCH - 1); \
        const float mnew = fmaxf(SC.bend + m, SC.mloc), decay = __expf(SC.bend + m - mnew), scale = __expf(SC.mloc - mnew); \
        f32x4 r0 = {0.f, 0.f, 0.f, 0.f}, r1 = {0.f, 0.f, 0.f, 0.f}; \
        const LAS bh* cb = Cbf + cur * 32 * CS + (lane & 15) * CS + kh * 128 + (lane >> 4) * 8; \
        _Pragma("unroll") for (int ks = 0; ks < 4; ++ks) { const bf16x8 b0 = *(const LAS bf16x8*)(cb + ks * 32), b1 = *(const LAS bf16x8*)(cb + 16 * CS + ks * 32); r0 = MFMA16(SC.q[ks], b0, r0); r1 = MFMA16(SC.q[ks], b1, r1); } \
        {     \
            if (c > 0) { const LAS float* ip = It + ((c - 1) & 1) * (2 * 64 * 36) + (tid >> 3) * 36 + (tid & 7) * 4; \
                const f32x4 sv = *(const LAS f32x4*)ip + *(const LAS f32x4*)(ip + 64 * 36); \
                float* o = MINTER + (size_t)(t0 - 64 + (tid >> 3)) * 1024 + h * 256 + jv * 32 + (tid & 7) * 4; \
                asm volatile("global_store_dwordx4 %0, %1, off\n\ts_nop 1" :: "v"(o), "v"(sv) : "memory"); } \
            LAS float* iw = It + cur * (2 * 64 * 36) + kh * (64 * 36) + (mt * 16 + (lane >> 4) * 4) * 36 + (lane & 15); \
            _Pragma("unroll") for (int r = 0; r < 4; ++r) { iw[r * 36] = r0[r]; iw[r * 36 + 16] = r1[r]; } } \
        f32x16 d0; { const float z = OZ(); _Pragma("unroll") for (int i = 0; i < 16; ++i) d0[i] = z; } \
        _Pragma("unroll") for (int ks = 0; ks < 4; ++ks) d0 = MFMA32(SC.k[ks], SC.v[ks], d0); \
        _Pragma("unroll") for (int i = 0; i < 16; ++i) ct[i] = decay * ct[i] + scale * d0[i]; \
        m = mnew; \
        {   LAS bh* o0 = Cbf + (cur ^ 1) * 32 * CS + (lane & 31) * CS + wid * 32 + 4 * (lane >> 5); \
            _Pragma("unroll") for (int g = 0; g < 4; ++g) { u32x2 w0; w0.x = cvt_pk_bf16(ct[4 * g], ct[4 * g + 1]); w0.y = cvt_pk_bf16(ct[4 * g + 2], ct[4 * g + 3]); *(LAS u32x2*)(o0 + 8 * g) = w0; } } \
        asm volatile("s_waitcnt lgkmcnt(0)" ::: "memory"); __builtin_amdgcn_s_barrier(); asm volatile("" ::: "memory"); } while (0)
    for (int c3 = 0; c3 < 126; c3 += 6) { MSTEP(s0, s2, c3); MSTEP(s1, s0, c3 + 1); MSTEP(s2, s1, c3 + 2); MSTEP(s0, s2, c3 + 3); MSTEP(s1, s0, c3 + 4); MSTEP(s2, s1, c3 + 5); }
    MSTEP(s0, s2, 126); MSTEP(s1, s0, 127);
#undef MSTEP
    {   const LAS float* ip = It + (127 & 1) * (2 * 64 * 36) + (tid >> 3) * 36 + (tid & 7) * 4;
        const f32x4 sv = *(const LAS f32x4*)ip + *(const LAS f32x4*)(ip + 64 * 36);
        *(f32x4*)(MINTER + (size_t)(127 * 64 + (tid >> 3)) * 1024 + h * 256 + jv * 32 + (tid & 7) * 4) = sv; }
    asm volatile("s_waitcnt vmcnt(0)" ::: "memory");
    __syncthreads();
}

__device__ __forceinline__ void mlstm_nscan(const Params& p) {
    const float* MBEND = (const float*)(P_WS + OFF_MBEND); const float* MLOC = (const float*)(P_WS + OFF_MLOC);
    const float* DN = (const float*)(P_WS + OFF_DN); float* NST = (float*)(P_WS + OFF_NST); float* MSTART = (float*)(P_WS + OFF_MSTART);
    for (int idx = TIDX(); idx < 1024; idx += 512) { const int h = idx >> 8, d = idx & 255; float m = 0.f, n = 0.f;
#pragma unroll 8
        for (int c = 0; c < NCH; ++c) { if (d == 0) MSTART[h * NCH + c] = m; NST[(size_t)(h * NCH + c) * 256 + d] = n;
            const float bend = MBEND[h * NCH + c], mloc = MLOC[h * NCH + c]; const float mnew = fmaxf(bend + m, mloc);
            n = __expf(bend + m - mnew) * n + __expf(mloc - mnew) * DN[(size_t)(h * NCH + c) * 256 + d]; m = mnew; } }
}

__device__ __forceinline__ float gelu_tanh(float x) { const float u = 0.7978845608028654f * (x + 0.044715f * x * x * x); return 0.5f * x * (1.0f + tanhf(u)); }

__device__ __forceinline__ void s5_pass_c(const Params& p, int L, int g, int c, int lane, LAS bh* img, LAS float* ul) {
    const float* zf = (const float*)(P_WS + OFF_ZF) + (size_t)(c * 64) * ZF_LD + ZS0 + g * 16;
    s5_stage_u(zf, ul, lane);
    S5C k; s5_setup(p, L, g, lane, k);
    float sr = 0.f, si = 0.f;
    {   float pr = k.ar, pi = k.ai;
#pragma unroll
        for (int i = 0; i < 6; ++i) { const float nr = pr * pr - pi * pi, ni = 2.f * pr * pi; pr = nr; pi = ni; }
        const float* se = (const float*)(P_WS + OFF_SEND) + ((size_t)(g * NCH) * 64 + lane) * 2;
        int cc = 0;
        for (; cc + 8 <= c; cc += 8) { float er[8], ei[8];
#pragma unroll
            for (int j = 0; j < 8; ++j) { er[j] = se[(size_t)(cc + j) * 128]; ei[j] = se[(size_t)(cc + j) * 128 + 1]; }
#pragma unroll
            for (int j = 0; j < 8; ++j) { const float nr = pr * sr - pi * si + er[j], ni = pr * si + pi * sr + ei[j]; sr = nr; si = ni; } }
        for (; cc < c; ++cc) { const float er = se[(size_t)cc * 128], ei = se[(size_t)cc * 128 + 1];
            const float nr = pr * sr - pi * si + er, ni = pr * si + pi * sr + ei; sr = nr; si = ni; } }
    const int gi = L * 32 + g;
    bf16x8 bfr[4];
    {   const int pp = lane & 15; const float* cre = P_IN(24) + ((size_t)gi * 16 + pp) * 64; const float* cim = P_IN(25) + ((size_t)gi * 16 + pp) * 64;
#pragma unroll
        for (int ks = 0; ks < 4; ++ks)
#pragma unroll
            for (int j = 0; j < 8; ++j) { const int n2 = ks * 32 + (lane >> 4) * 8 + j; const float v = (n2 < 64) ? cre[n2] : -cim[n2 - 64]; bfr[ks][j] = (short)f2bf(v); } }
    const float dco = P_IN(26)[L * 512 + g * 16 + (lane & 15)];
    bh* YS = (bh*)(P_WS + OFF_YS);
    for (int half = 0; half < 2; ++half) {
#pragma unroll 8
        for (int s = 0; s < 32; ++s) { s5_step(k, ul + (half * 32 + s) * 16, sr, si); img[s * 136 + lane] = f2bf(sr); img[s * 136 + 64 + lane] = f2bf(si); }
        asm volatile("s_waitcnt lgkmcnt(0)" ::: "memory"); __builtin_amdgcn_wave_barrier();
#pragma unroll
        for (int mt = 0; mt < 2; ++mt) { f32x4 acc = {0.f, 0.f, 0.f, 0.f};
#pragma unroll
            for (int ks = 0; ks < 4; ++ks) { const bf16x8 a = *(const LAS bf16x8*)(img + (mt * 16 + (lane & 15)) * 136 + ks * 32 + (lane >> 4) * 8); acc = MFMA16(a, bfr[ks], acc); }
#pragma unroll
            for (int r = 0; r < 4; ++r) { const int tt = half * 32 + mt * 16 + (lane >> 4) * 4 + r; const float uv = ul[tt * 16 + (lane & 15)];
                YS[(size_t)(c * 64 + tt) * 512 + g * 16 + (lane & 15)] = f2bf(gelu_tanh(acc[r] + dco * uv)); } }
        asm volatile("s_waitcnt lgkmcnt(0)" ::: "memory"); __builtin_amdgcn_wave_barrier();
    }
}

__device__ __forceinline__ void phase_scan(const Params& p, int L, LAS unsigned char* lds) {
    const int b = BIDX();
    if (b < 224) { for (int rr = 0; rr < PROBE_RW; ++rr) rwkv_scan(p, b, lds); }
    else { for (int rr = 0; rr < PROBE_ML; ++rr) mlstm_seq(p, b - 224, lds); }
}
__device__ __forceinline__ void phase_s5c(const Params& p, int L, LAS unsigned char* lds) {
    const int b = BIDX(), wid = TIDX() >> 6, lane = TIDX() & 63;
    if (b == GDIM() - 1) mlstm_nscan(p);
    const int nw = GDIM() * 8;
    for (int w = b * 8 + wid; w < 32 * NCH; w += nw) s5_pass_c(p, L, w >> 7, w & 127, lane, (LAS bh*)lds + wid * (32 * 136), (LAS float*)(lds + 69632) + wid * 1024);
    __syncthreads();
}

__device__ __forceinline__ void mlstm_out(const Params& p, int L, int h, int c, LAS unsigned char* lds) {
    const int tid = TIDX(), wid = tid >> 6, lane = tid & 63, t0 = c * 64;
    LAS bh* Pl = (LAS bh*)lds;
    LAS float* s_b = (LAS float*)(lds + 9216); LAS float* s_a = s_b + 64; LAS float* s_mt = s_a + 64; LAS float* s_iw = s_mt + 64; LAS float* s_den = s_iw + 64; LAS float* s_qn = s_den + 64; LAS float* s_part = s_qn + 64;
    const bh* MQ = (const bh*)(P_WS + OFF_MQ); const bh* MK = (const bh*)(P_WS + OFF_MK); const bh* MVT = (const bh*)(P_WS + OFF_MVT);
    const float* MINTER = (const float*)(P_WS + OFF_ABF);
    const float m0 = ((const float*)(P_WS + OFF_MSTART))[h * NCH + c];
    if (tid < 64) { const float ig = ((const float*)(P_WS + OFF_MI))[h * T + t0 + tid], b = ((const float*)(P_WS + OFF_MBB))[h * T + t0 + tid];
        const float a = ig - b; float cm = a;
#pragma unroll
        for (int o = 1; o < 64; o <<= 1) { const float nb = bperm_f((tid - o) & 63, cm); if (tid >= o) cm = fmaxf(cm, nb); }
        const float mt = b + fmaxf(m0, cm);
        s_b[tid] = b; s_a[tid] = a; s_mt[tid] = mt; s_iw[tid] = __expf(b + m0 - mt); }
    __syncthreads();
    {
        const int mt = wid >> 1, nt0 = (wid & 1) * 2;
        f32x4 r0 = {0.f, 0.f, 0.f, 0.f}, r1 = {0.f, 0.f, 0.f, 0.f};
        const bh* qp = MQ + fq_base(h, c, mt, 0) + lane * 8;
        const bh* kp = MK + fq_base(h, c, nt0, 0) + lane * 8;
#pragma unroll
        for (int ks = 0; ks < 8; ++ks) { const bf16x8 a = *(const bf16x8*)(qp + ks * 512); const bf16x8 b0 = *(const bf16x8*)(kp + ks * 512), b1 = *(const bf16x8*)(kp + 8 * 512 + ks * 512);
            r0 = MFMA16(a, b0, r0); r1 = MFMA16(a, b1, r1); }
#pragma unroll
        for (int r = 0; r < 4; ++r) { const int t = mt * 16 + (lane >> 4) * 4 + r; const float bt = s_b[t] - s_mt[t];
            { const int s = nt0 * 16 + (lane & 15); const float pv = (s <= t) ? r0[r] * __expf(bt + s_a[s]) : 0.f; Pl[t * 72 + s] = f2bf(pv); }
            { const int s = nt0 * 16 + 16 + (lane & 15); const float pv = (s <= t) ? r1[r] * __expf(bt + s_a[s]) : 0.f; Pl[t * 72 + s] = f2bf(pv); } }
    }
    __syncthreads();
    if (tid < 64) { float s = 0.f;
#pragma unroll
        for (int q = 0; q < 8; ++q) { const u32x4 w = *(const LAS u32x4*)(Pl + tid * 72 + q * 8);
            s += __uint_as_float(w.x << 16) + __uint_as_float(w.x & 0xffff0000u) + __uint_as_float(w.y << 16) + __uint_as_float(w.y & 0xffff0000u)
               + __uint_as_float(w.z << 16) + __uint_as_float(w.z & 0xffff0000u) + __uint_as_float(w.w << 16) + __uint_as_float(w.w & 0xffff0000u); }
        s_den[tid] = s; }
    {
        const float* nst = (const float*)(P_WS + OFF_NST) + (size_t)(h * NCH + c) * 256 + lane * 4; const f32x4 nv = *(const f32x4*)nst;
#pragma unroll
        for (int i = 0; i < 8; ++i) { const int t = wid * 8 + i; const u32x2 q2 = *(const u32x2*)(MQ + fq_off(h, t0 + t, lane * 4));
            float s = __uint_as_float(q2.x << 16) * nv[0] + __uint_as_float(q2.x & 0xffff0000u) * nv[1] + __uint_as_float(q2.y << 16) * nv[2] + __uint_as_float(q2.y & 0xffff0000u) * nv[3];
            s = wave_sum(s); if (lane == 0) s_qn[t] = s; } }
    f32x4 acc[4][2];
#pragma unroll
    for (int a = 0; a < 4; ++a) { const float z = OZ(); acc[a][0] = (f32x4){z, z, z, z}; acc[a][1] = (f32x4){z, z, z, z}; }
    {   const bh* vp = MVT + (size_t)(h * NCH + c) * 16384;
#pragma unroll
        for (int ks = 0; ks < 2; ++ks) { const bf16x8 b0 = *(const bf16x8*)(vp + ft_off(wid * 32 + (lane & 15), ks * 4 + (lane >> 4))), b1 = *(const bf16x8*)(vp + ft_off(wid * 32 + 16 + (lane & 15), ks * 4 + (lane >> 4)));
#pragma unroll
            for (int a = 0; a < 4; ++a) { const bf16x8 av = *(const LAS bf16x8*)(Pl + (a * 16 + (lane & 15)) * 72 + ks * 32 + (lane >> 4) * 8);
                acc[a][0] = MFMA16(av, b0, acc[a][0]); acc[a][1] = MFMA16(av, b1, acc[a][1]); } } }
    __syncthreads();
#pragma unroll
    for (int a = 0; a < 4; ++a)
#pragma unroll
        for (int r = 0; r < 4; ++r) { const int t = a * 16 + (lane >> 4) * 4 + r; const float iw = s_iw[t];
            const float den = s_den[t] + iw * s_qn[t]; const float dd = 1.0f / fmaxf(fabsf(den), __expf(-s_mt[t]));
            const float* mi = MINTER + (size_t)(t0 + t) * 1024 + h * 256 + wid * 32 + (lane & 15);
            const float h0 = (acc[a][0][r] + iw * mi[0]) * dd, h1 = (acc[a][1][r] + iw * mi[16]) * dd;
            acc[a][0][r] = h0; acc[a][1][r] = h1;
            float ss = h0 * h0 + h1 * h1;
            ss = allreduce16(ss);
            if ((lane & 15) == 0) s_part[wid * 64 + t] = ss; }
    __syncthreads();
    {   const float* zf = (const float*)(P_WS + OFF_ZF); const float* ng = P_IN(7) + L * 1024 + h * 256; bh* YC = (bh*)(P_WS + OFF_YCAT);
#pragma unroll
        for (int a = 0; a < 4; ++a)
#pragma unroll
            for (int r = 0; r < 4; ++r) { const int t = a * 16 + (lane >> 4) * 4 + r;
                float tot = 0.f;
#pragma unroll
                for (int w = 0; w < 8; ++w) tot += s_part[w * 64 + t];
                const float rstd = rsqrtf(tot * (1.0f / 256.0f) + 1e-6f);
                const int v0 = wid * 32 + (lane & 15);
                const float* op = zf + (size_t)(t0 + t) * ZF_LD + 3072 + h * 256 + v0;
                bh* yo = YC + (size_t)(t0 + t) * D + h * 256 + v0;
                yo[0] = f2bf(sigmoidf_(op[0]) * acc[a][0][r] * rstd * ng[v0]);
                yo[16] = f2bf(sigmoidf_(op[16]) * acc[a][1][r] * rstd * ng[v0 + 16]); } }
    __syncthreads();
}

__device__ __forceinline__ void rwkv_post(const Params& p, int L, int it, LAS unsigned char* lds) {
    const int tid = TIDX(), wid = tid >> 6, lane = tid & 63;
    const int h = it & 7, blk = it >> 3, j = blk >> 3;
    LAS float* bufA = (LAS float*)lds;
    LAS float* bufB = bufA + 64 * 65;
    LAS float* bufP = bufB + 64 * 65;
    const float* SE = (const float*)(P_WS + OFF_RSEND) + (size_t)(h * 4) * 4096; const float* PE = (const float*)(P_WS + OFF_RPEND) + (size_t)(h * 4) * 4096;
    LAS float* sst = bufA;
    if (j >= 1) {
        const int v = tid >> 3, k8 = (tid & 7) * 8;
        { const f32x4 a0 = *(const f32x4*)(SE + v * 64 + k8), a1 = *(const f32x4*)(SE + v * 64 + k8 + 4);
#pragma unroll
          for (int e = 0; e < 4; ++e) { bufA[v * 65 + k8 + e] = a0[e]; bufA[v * 65 + k8 + 4 + e] = a1[e]; } }
        for (int jj = 1; jj < j; ++jj) {
            { const f32x4 p0 = *(const f32x4*)(PE + (size_t)jj * 4096 + v * 64 + k8), p1 = *(const f32x4*)(PE + (size_t)jj * 4096 + v * 64 + k8 + 4);
              *(LAS f32x4*)(bufP + v * 64 + k8) = p0; *(LAS f32x4*)(bufP + v * 64 + k8 + 4) = p1; }
            __syncthreads();
            LAS float* src = (jj & 1) ? bufA : bufB; LAS float* dst = (jj & 1) ? bufB : bufA;
            f32x4 c0 = *(const f32x4*)(SE + (size_t)jj * 4096 + v * 64 + k8), c1 = *(const f32x4*)(SE + (size_t)jj * 4096 + v * 64 + k8 + 4);
#pragma unroll 8
            for (int i = 0; i < 64; ++i) { const float a = src[v * 65 + i]; const f32x4 p0 = *(const LAS f32x4*)(bufP + i * 64 + k8), p1 = *(const LAS f32x4*)(bufP + i * 64 + k8 + 4); c0 += a * p0; c1 += a * p1; }
#pragma unroll
            for (int e = 0; e < 4; ++e) { dst[v * 65 + k8 + e] = c0[e]; dst[v * 65 + k8 + 4 + e] = c1[e]; }
            __syncthreads();
            sst = dst;
        }
        __syncthreads();
    }
    float srow[64];
    if (j >= 1) {
#pragma unroll
        for (int i = 0; i < 64; ++i) srow[i] = sst[lane * 65 + i];
    } else {
#pragma unroll
        for (int i = 0; i < 64; ++i) srow[i] = 0.f;
    }
    const int c = h * 64 + lane;
    const float rkw = P_IN(16)[L * 512 + c], lg = P_IN(17)[L * 512 + c], lb = P_IN(18)[L * 512 + c];
    const float* RY = (const float*)(P_WS + OFF_RY); const float* RZ = (const float*)(P_WS + OFF_RZ); const float* RR = (const float*)(P_WS + OFF_RR); const float* RK = (const float*)(P_WS + OFF_RK);
    const float* RV = (const float*)(P_WS + OFF_RV); const float* RG = (const float*)(P_WS + OFF_RG); bh* YC = (bh*)(P_WS + OFF_YCAT);
    for (int i = 0; i < 32; ++i) { const int t = blk * 256 + wid * 32 + i; const size_t o = (size_t)t * 512 + c;
        float y = RY[o];
        if (j >= 1) { const float z = RZ[o]; float y2 = 0.f;
#pragma unroll
            for (int q = 0; q < 64; q += 2) { y = fmaf(srow[q], __builtin_bit_cast(float, __builtin_amdgcn_readlane(__builtin_bit_cast(int, z), q)), y);
                                              y2 = fmaf(srow[q + 1], __builtin_bit_cast(float, __builtin_amdgcn_readlane(__builtin_bit_cast(int, z), q + 1)), y2); }
            y += y2; }
        const float mu = wave_sum(y) * (1.0f / 64.0f); const float dlt = y - mu; const float var = wave_sum(dlt * dlt) * (1.0f / 64.0f);
        const float yn = dlt * rsqrtf(var + 64e-5f) * lg + lb;
        const float bon = wave_sum(RR[o] * RK[o] * rkw) * RV[o];
        YC[(size_t)t * D + 1024 + c] = f2bf((yn + bon) * RG[o]); }
    __syncthreads();
}

__device__ __forceinline__ void phase_post(const Params& p, int L, LAS unsigned char* lds) {
    for (int it = BIDX(); it < 768; it += GDIM()) {
        if (it < 512) mlstm_out(p, L, it >> 7, it & 127, lds);
        else rwkv_post(p, L, it - 512, lds);
    }
    __syncthreads();
}

#define XB_TMO      128
#define XB_XCNT(j)  (256  + 64 * (j))
#define XB_XSUB(j)  (1280 + 64 * (j))
#define XB_XGEN(j)  (2304 + 64 * (j))
#define XB_TOP      3328
#define XB_TOPGEN   3392
#define XCD_BAR_WORDS 3456
#define XB_SPIN_CAP (1u << 18)

__device__ __forceinline__ unsigned xb_ld(unsigned* p)              { return __hip_atomic_load(p, __ATOMIC_RELAXED, __HIP_MEMORY_SCOPE_AGENT); }
__device__ __forceinline__ unsigned xb_add(unsigned* p, unsigned v) { return __hip_atomic_fetch_add(p, v, __ATOMIC_RELAXED, __HIP_MEMORY_SCOPE_AGENT); }
__device__ __forceinline__ unsigned xb_xcc_id() { return (unsigned)__builtin_amdgcn_s_getreg((3 << 11) | 20) & 0xFu; }
#define XB_SPIN(cond, bar) do { unsigned _sp = 0; while (cond) { __builtin_amdgcn_s_sleep(1); \
    if ((++_sp & 255u) == 0u) { if (xb_ld(&(bar)[XB_TMO])) break; if (_sp > XB_SPIN_CAP) { atomicAdd(&(bar)[XB_TMO], 1u); break; } } } } while (0)

struct XcdBarrier {
    unsigned* bar; unsigned x;
    volatile LAS unsigned* st;
};

__device__ __forceinline__ XcdBarrier xcd_barrier_post(unsigned* bar, volatile LAS unsigned* st) {
    XcdBarrier b; b.bar = bar; b.x = xb_xcc_id(); b.st = st;
    if (threadIdx.x == 0) (void)xb_add(&bar[XB_XCNT(b.x)], 1u);
    return b;
}
__device__ __forceinline__ void xcd_barrier_complete(unsigned* bar, unsigned x, unsigned& nloc, unsigned& nx) {
    const unsigned G = gridDim.x * gridDim.y * gridDim.z;
    unsigned sum, cnt, mine, sp = 0u;
    for (;;) {
        sum = 0u; cnt = 0u; mine = 0u;
#pragma unroll
        for (unsigned j = 0; j < 16; ++j) { const unsigned c = xb_ld(&bar[XB_XCNT(j)]); sum += c; cnt += (c > 0u) ? 1u : 0u; mine = (j == x) ? c : mine; }
        if (sum == G) break;
        __builtin_amdgcn_s_sleep(1);
        if ((++sp & 255u) == 0u) { if (xb_ld(&bar[XB_TMO])) break; if (sp > XB_SPIN_CAP) { atomicAdd(&bar[XB_TMO], 1u); break; } }
    }
    nloc = mine > 0u ? mine : 1u; nx = cnt > 0u ? cnt : 1u;
}

__device__ __forceinline__ void xcd_barrier(const XcdBarrier& b) {
    asm volatile("s_waitcnt vmcnt(0)" ::: "memory");
    __syncthreads();
    if (threadIdx.x == 0) {
        unsigned* bar = b.bar;
        __builtin_amdgcn_s_waitcnt(0);
        unsigned nloc = b.st[0], nx = b.st[1];
        if (nloc == 0u) { xcd_barrier_complete(bar, b.x, nloc, nx); b.st[0] = nloc; b.st[1] = nx; }
        const unsigned old = xb_add(&bar[XB_XSUB(b.x)], 1u);
        const unsigned gen = old / nloc;
        if (old + 1u == (gen + 1u) * nloc) {
            __builtin_amdgcn_fence(__ATOMIC_RELEASE, "agent");
            asm volatile("s_waitcnt vmcnt(0)" ::: "memory");
            const unsigned og = xb_add(&bar[XB_TOP], 1u);
            const unsigned tg = og / nx;
            if (og + 1u == (tg + 1u) * nx) xb_add(&bar[XB_TOPGEN], 1u);
            else XB_SPIN(xb_ld(&bar[XB_TOPGEN]) == tg, bar);
            __builtin_amdgcn_fence(__ATOMIC_ACQUIRE, "agent");
            xb_add(&bar[XB_XGEN(b.x)], 1u);
            asm volatile("s_waitcnt vmcnt(0)" ::: "memory");
        } else {
            XB_SPIN(xb_ld(&bar[XB_XGEN(b.x)]) == gen, bar);
            __builtin_amdgcn_fence(__ATOMIC_ACQUIRE, "agent");
            asm volatile("s_waitcnt vmcnt(0)" ::: "memory");
        }
    }
    __syncthreads();
}


constexpr int NPHASE = 27;
__global__ void __launch_bounds__(512, 2) hybrid_fwd(Params p, int ph_lo, int ph_hi, int rep_q) {
    extern __shared__ __attribute__((aligned(16))) unsigned char smem_raw[];
    LAS unsigned char* lds = (LAS unsigned char*)smem_raw;
    cg::grid_group grid = cg::this_grid();
    volatile LAS unsigned* xst = (volatile LAS unsigned*)(lds + 131072);
    if (threadIdx.x < 2) xst[threadIdx.x] = 0u;
    __syncthreads();
    { XcdBarrier b0 = xcd_barrier_post((unsigned*)(P_WS + OFF_BAR), xst); (void)b0; }
    for (int ph = ph_lo; ph < ph_hi; ++ph) {
        if (ph == ph_lo + 1) grid.sync();
        else if (ph > ph_lo) { XcdBarrier xb; xb.bar = (unsigned*)(P_WS + OFF_BAR); xb.x = xb_xcc_id(); xb.st = xst; xcd_barrier(xb); }
        if (ph == 26) {
            const int gw = BIDX() * 8 + (TIDX() >> 6), NGW = GDIM() * 8, lane = TIDX() & 63;
            for (int r = gw; r < T; r += NGW) { float* x = P_OUT + (size_t)r * D; f32x4 v[8]; float s = 0.f;
#pragma unroll
                for (int j = 0; j < 8; ++j) { v[j] = *(const f32x4*)(x + j * 256 + lane * 4); s += (v[j][0] * v[j][0] + v[j][1] * v[j][1]) + (v[j][2] * v[j][2] + v[j][3] * v[j][3]); }
                const float rstd = rsqrtf(wave_sum(s) * (1.0f / D) + 1e-6f);
#pragma unroll
                for (int j = 0; j < 8; ++j) { const f32x4 gg = *(const f32x4*)(P_IN(40) + j * 256 + lane * 4); *(f32x4*)(x + j * 256 + lane * 4) = v[j] * rstd * gg; } }
            continue;
        }
        const int L = ph / 13, q = ph % 13;
#ifdef ONLY_Q
        if (q != ONLY_Q) continue;
#endif
        const int nrep = (q == rep_q) ? 2 : 1;
        for (int rep = 0; rep < nrep; ++rep) {
        if (rep) grid.sync();
        switch (q) {
        case 0: phase_conv(p, L, lds); break;
        case 2: phase_prep(p, L, lds); break;
        case 4: phase_scan(p, L, lds); break;
        case 5: phase_post(p, L, lds); break;
        case 8: phase_rmsnorm(p, P_IN(33) + (size_t)L * D); break;
        case 11: phase_rmsnorm(p, P_IN(37) + (size_t)L * D); break;
        default: break;
        }
        for (int i = 0; i < 3; ++i) {
            pg8::Gemm g;
            if (!make_gemm(p, L, q, i, g)) break;
            pg8::StaticOrder S; S.init(T, g.N, GDIM(), BIDX());
            pg8::gemm_phase(lds, g, S);
        }
        if (q == 3) phase_s5c(p, L, lds);
        }
    }
}

extern "C" void kernel_launch(void* const* d_in, const int* in_sizes, int n_in, void* d_out, int out_size, void* d_ws, size_t ws_size, hipStream_t stream) {
    constexpr size_t kDynLds = 131072 + 64;
    static int grid_blocks = 0;
    if (!grid_blocks) {
        int dev = 0, cus = 0, per_cu = 0;
        (void)hipGetDevice(&dev);
        (void)hipDeviceGetAttribute(&cus, hipDeviceAttributeMultiprocessorCount, dev);
        (void)hipFuncSetAttribute((const void*)hybrid_fwd, hipFuncAttributeMaxDynamicSharedMemorySize, (int)kDynLds);
        (void)hipOccupancyMaxActiveBlocksPerMultiprocessor(&per_cu, hybrid_fwd, 512, kDynLds);
        if (per_cu > 1) per_cu = 1;
        grid_blocks = cus * per_cu;
        if (ws_size < WS_TOTAL) fprintf(stderr, "workspace too small: %zu < %zu\n", ws_size, (size_t)WS_TOTAL);
    }
    Params p{};
    for (int i = 0; i < 41; ++i) p.in[i] = (const float*)d_in[i];
    p.out = (float*)d_out; p.ws = (unsigned char*)d_ws;
    (void)hipMemsetAsync((char*)d_ws + OFF_BAR, 0, XCD_BAR_WORDS * 4, stream);
#if SINGLE_LAUNCH
    int lo = 0, hi = NPHASE, rq = PROBE_REP_Q;
    void* args[] = {&p, &lo, &hi, &rq};
    hipError_t e = hipLaunchCooperativeKernel((const void*)hybrid_fwd, dim3(grid_blocks), dim3(512), args, kDynLds, stream);
    if (e != hipSuccess) fprintf(stderr, "cooperative launch failed: %s (grid %d)\n", hipGetErrorString(e), grid_blocks);
#else
    for (int ph = 0; ph < NPHASE; ++ph) {
        int lo = ph, hi = ph + 1, rq = -1;
        void* args[] = {&p, &lo, &hi, &rq};
        hipError_t e = hipLaunchCooperativeKernel((const void*)hybrid_fwd, dim3(grid_blocks), dim3(512), args, kDynLds, stream);
        if (e != hipSuccess) fprintf(stderr, "cooperative launch failed: %s (grid %d)\n", hipGetErrorString(e), grid_blocks);
    }
#endif
}
```

```cpp
#include <hip/hip_runtime.h>
#include <hip/hip_cooperative_groups.h>
#include <cstdio>
#include <cstdint>
namespace cg = cooperative_groups;

#define LAS __attribute__((address_space(3)))
typedef unsigned short bh;
typedef short bf16x8 __attribute__((ext_vector_type(8)));
typedef float f32x4 __attribute__((ext_vector_type(4)));
typedef float f32x16 __attribute__((ext_vector_type(16)));
typedef unsigned u32x4 __attribute__((ext_vector_type(4)));
typedef unsigned u32x2 __attribute__((ext_vector_type(2)));

#ifndef PROBE_RW
#define PROBE_RW 1
#define PROBE_ML 1
#endif
#ifndef PROBE_REP_Q
#define PROBE_REP_Q (-1)
#endif
#ifndef SINGLE_LAUNCH
#define SINGLE_LAUNCH 1
#endif

constexpr int T = 8192, D = 2048, FH = 5632;
constexpr int NIN = 12744, NGATE = 6144, NF = 6600, ZF_LD = 6656, NINP = 12800;
constexpr int ZR0 = 4104, ZS0 = 6088;
constexpr int NCH = 128;

constexpr size_t AL(size_t x) { return (x + 255) & ~(size_t)255; }
constexpr size_t SZ_WIN = (size_t)NINP * D * 2, SZ_SQ = (size_t)D * D * 2, SZ_WGU = (size_t)2 * FH * D * 2, SZ_WD = (size_t)D * FH * 2;
constexpr size_t OFF_WIN = 0;
constexpr size_t OFF_WUP = OFF_WIN + SZ_WIN;
constexpr size_t OFF_WO = OFF_WUP + SZ_SQ;
constexpr size_t OFF_WGU = OFF_WO + SZ_SQ;
constexpr size_t OFF_WD = OFF_WGU + SZ_WGU;
constexpr size_t OFF_WPG = OFF_WD + SZ_WD;
constexpr size_t OFF_WPP = OFF_WPG + SZ_SQ;
constexpr size_t OFF_WGLU = OFF_WPP + (size_t)D * 256 * 2;
constexpr size_t OFF_WW2 = OFF_WGLU + (size_t)512 * 512 * 2;
constexpr size_t OFF_WA2 = OFF_WW2 + (size_t)512 * 256 * 2;
constexpr size_t OFF_WG2 = OFF_WA2 + (size_t)512 * 256 * 2;
constexpr size_t OFF_PBF = OFF_WG2 + (size_t)512 * 256 * 2;
constexpr size_t OFF_ABF = OFF_PBF + (size_t)2 * T * 256 * 2;
constexpr size_t OFF_YCAT = OFF_ABF + (size_t)T * D * 2;
constexpr size_t OFF_ZF = OFF_YCAT + (size_t)T * D * 2;
constexpr size_t OFF_ACT = OFF_ZF;
constexpr size_t OFF_MIX32 = OFF_ZF + (size_t)100663296;
constexpr size_t OFF_ZG = OFF_ZF + (size_t)T * ZF_LD * 4;
constexpr size_t SZ_R = (size_t)T * 512 * 4;
constexpr size_t OFF_RR = OFF_ZG + (size_t)T * NGATE * 2;
constexpr size_t OFF_RK = OFF_RR + SZ_R, OFF_RV = OFF_RK + SZ_R, OFF_RKK = OFF_RV + SZ_R, OFF_RW = OFF_RKK + SZ_R, OFF_RB = OFF_RW + SZ_R, OFF_RG = OFF_RB + SZ_R, OFF_RY = OFF_RG + SZ_R;
constexpr size_t OFF_LAW = OFF_RY + SZ_R;
constexpr size_t OFF_LAA = OFF_LAW + (size_t)T * 256 * 2, OFF_LAG = OFF_LAA + (size_t)T * 256 * 2;
constexpr size_t SZ_MB = (size_t)T * 1024 * 2;
constexpr size_t OFF_MQ = OFF_LAG + (size_t)T * 256 * 2, OFF_MK = OFF_MQ + SZ_MB, OFF_MKT = OFF_MK + SZ_MB, OFF_MVT = OFF_MKT + SZ_MB;
constexpr size_t OFF_MI = OFF_MVT + SZ_MB;
constexpr size_t OFF_MBB = OFF_MI + (size_t)4 * T * 4;
constexpr size_t OFF_MBEND = OFF_MBB + (size_t)4 * T * 4;
constexpr size_t OFF_MLOC = OFF_MBEND + 2048, OFF_MSTART = OFF_MLOC + 2048;
constexpr size_t OFF_DN = OFF_MSTART + 2048;
constexpr size_t OFF_NST = OFF_DN + (size_t)4 * NCH * 256 * 4;
constexpr size_t OFF_SEND = OFF_NST + (size_t)4 * NCH * 256 * 4;
constexpr size_t OFF_YS = OFF_SEND + (size_t)32 * NCH * 64 * 8;
constexpr size_t OFF_RZ = OFF_YS + (size_t)T * 512 * 2;
constexpr size_t OFF_RSEND = OFF_RZ + SZ_R;
constexpr size_t OFF_RPEND = OFF_RSEND + (size_t)8 * 4 * 4096 * 4;
constexpr size_t OFF_MINTER2 = OFF_RPEND + (size_t)8 * 4 * 4096 * 4;
constexpr size_t OFF_BAR = OFF_MINTER2;
constexpr size_t WS_TOTAL = OFF_MINTER2 + (size_t)T * 1024 * 4;

struct Params { const float* in[41]; float* out; unsigned char* ws; };
#define KARG4 __attribute__((address_space(4)))
__device__ __forceinline__ const float* karg_in(int i) { const KARG4 char* ka = (const KARG4 char*)__builtin_amdgcn_kernarg_segment_ptr(); return *(const float* const volatile KARG4*)(ka + (size_t)i * 8); }
#define P_IN(i) karg_in(i)
#define P_OUT ((float*)karg_in(41))
#define P_WS ((unsigned char*)karg_in(42))

__device__ __forceinline__ int TIDX() { int t = threadIdx.x; asm volatile("" : "+v"(t)); return t; }
__device__ __forceinline__ int BIDX() { int t = blockIdx.x; asm volatile("" : "+s"(t)); return t; }
__device__ __forceinline__ int GDIM() { int t = gridDim.x; asm volatile("" : "+s"(t)); return t; }
__device__ __forceinline__ bh f2bf(float f) { unsigned u = __float_as_uint(f); u += 0x7fffu + ((u >> 16) & 1u); return (bh)(u >> 16); }
__device__ __forceinline__ float bf2f(bh h) { return __uint_as_float(((unsigned)h) << 16); }
__device__ __forceinline__ unsigned pk2(float lo, float hi) { return (unsigned)f2bf(lo) | ((unsigned)f2bf(hi) << 16); }
__device__ __forceinline__ float sigmoidf_(float x) { return 1.0f / (1.0f + __expf(-x)); }
__device__ __forceinline__ float bperm_f(int srclane, float v) { return __builtin_bit_cast(float, __builtin_amdgcn_ds_bpermute(srclane << 2, __builtin_bit_cast(int, v))); }
template <int CTRL> __device__ __forceinline__ float dpp_f(float x) {
    return __builtin_bit_cast(float, __builtin_amdgcn_update_dpp(0, __builtin_bit_cast(int, x), CTRL, 0xf, 0xf, true));
}
__device__ __forceinline__ float allreduce16(float x) {
    x += dpp_f<0xB1>(x); x += dpp_f<0x4E>(x); x += dpp_f<0x141>(x); x += dpp_f<0x140>(x);
    return x;
}
__device__ __forceinline__ float rl_f(float v, int l) { return __builtin_bit_cast(float, __builtin_amdgcn_readlane(__builtin_bit_cast(int, v), l)); }
__device__ __forceinline__ float wave_sum(float v) {
    v = allreduce16(v);
    return (rl_f(v, 0) + rl_f(v, 16)) + (rl_f(v, 32) + rl_f(v, 48));
}
__device__ __forceinline__ float wave_max(float v) {
    v = fmaxf(v, dpp_f<0xB1>(v)); v = fmaxf(v, dpp_f<0x4E>(v)); v = fmaxf(v, dpp_f<0x141>(v)); v = fmaxf(v, dpp_f<0x140>(v));
    return fmaxf(fmaxf(rl_f(v, 0), rl_f(v, 16)), fmaxf(rl_f(v, 32), rl_f(v, 48)));
}
__device__ __forceinline__ float OZ() { float z = 0.f; asm volatile("" : "+v"(z)); return z; }
#define MFMA16(a, b, c) __builtin_amdgcn_mfma_f32_16x16x32_bf16(a, b, c, 0, 0, 0)
#define MFMA32(a, b, c) __builtin_amdgcn_mfma_f32_32x32x16_bf16(a, b, c, 0, 0, 0)

namespace pg8 {
constexpr int BM = 256, BK = 64, HALF = 128, HTB = HALF * BK * 2, STAGE_BYTES = 8 * HTB, NXCD = 8, WGM = 8;
__device__ __forceinline__ int lds_byte(int r, int c) { const int st = (r >> 4) * 2 + (c >> 5), rr = r & 15, cc = c & 31, ob = rr * 64 + cc * 2; return st * 1024 + (ob ^ (((ob >> 9) & 1) << 5)); }
__device__ __forceinline__ void stage_rc(int b, int& R, int& C) { const int st = b / 1024, sb = b % 1024, swz = sb ^ (((sb >> 9) & 1) << 5); R = (st >> 1) * 16 + swz / 64; C = (st & 1) * 32 + (swz % 64) / 2; }
__device__ __forceinline__ int perm32(int rho) { const int n = rho >> 4, i = rho & 15; return 8 * (i >> 2) + 4 * n + (i & 3); }
struct Unit { int pm, pn; };
struct Gemm { const bh* A; const bh* Bt; int M, N, K, lda, ldb, epi, perm, L; };
struct StaticOrder {
    int nM, nN, nwg, G, c;
    __device__ void init(int M, int N, int G_, int c_) { nM = M / BM; nN = N / BM; nwg = nM * nN; G = G_; c = c_; }
    __device__ bool next(int i, Unit& u) const {
        const long L = (long)i * G + c; if (L >= nwg) return false;
        int wgid = (int)L; { const int q = nwg / NXCD, r = nwg % NXCD, xcd = wgid % NXCD, off = wgid / NXCD; wgid = (xcd < r ? xcd * (q + 1) : r * (q + 1) + (xcd - r) * q) + off; }
        const int nig = WGM * nN, gid = wgid / nig, fm = gid * WGM, gsz = (nM - fm) < WGM ? (nM - fm) : WGM;
        u.pm = fm + ((wgid % nig) % gsz); u.pn = (wgid % nig) / gsz; return true;
    }
};
__device__ __forceinline__ unsigned cvt_pk_bf16(float lo, float hi) { unsigned r; asm volatile("v_cvt_pk_bf16_f32 %0, %1, %2" : "=v"(r) : "v"(lo), "v"(hi)); return r; }

__device__ __forceinline__ void epi_run(const Gemm& g, const f32x4 (&acc)[2][2][4][2], const Unit& u, int wr, int wc, int fr, int fq);
__device__ __forceinline__ void up_rescale(f32x4 (&acc)[2][2][4][2], const Unit& u, int wr, int wc, int fr, int fq, int goff) {
    const bh* zg = (const bh*)(P_WS + OFF_ZG) + goff;
    asm volatile("" : "+v"(fr), "+v"(fq));
    const bh* zrow0 = zg + (size_t)(u.pm * 256 + wr * 64 + fr) * NGATE + u.pn * 256 + wc * 32 + 4 * fq;
#pragma unroll
    for (int ai = 0; ai < 2; ++ai)
#pragma unroll
        for (int mp = 0; mp < 2; ++mp) {
            u32x2 gp[8], gn[8];
#pragma unroll
            for (int mm = 0; mm < 2; ++mm) { const bh* zr = zrow0 + (size_t)(ai * 128 + (mp * 2 + mm) * 16) * NGATE;
#pragma unroll
                for (int bj = 0; bj < 2; ++bj)
#pragma unroll
                    for (int n = 0; n < 2; ++n) { gp[mm * 4 + bj * 2 + n] = *(const u32x2*)(zr + bj * 128 + n * 16); gn[mm * 4 + bj * 2 + n] = *(const u32x2*)(zr + 2048 + bj * 128 + n * 16); } }
            __builtin_amdgcn_sched_barrier(0);
#pragma unroll
            for (int mm = 0; mm < 2; ++mm)
#pragma unroll
                for (int bj = 0; bj < 2; ++bj)
#pragma unroll
                    for (int n = 0; n < 2; ++n) { const u32x2 p = gp[mm * 4 + bj * 2 + n], q = gn[mm * 4 + bj * 2 + n];
                        f32x4 r;
                        r[0] = __uint_as_float(p.x << 16) * __builtin_amdgcn_rcpf(__uint_as_float(q.x << 16)); r[1] = __uint_as_float(p.x & 0xffff0000u) * __builtin_amdgcn_rcpf(__uint_as_float(q.x & 0xffff0000u));
                        r[2] = __uint_as_float(p.y << 16) * __builtin_amdgcn_rcpf(__uint_as_float(q.y << 16)); r[3] = __uint_as_float(p.y & 0xffff0000u) * __builtin_amdgcn_rcpf(__uint_as_float(q.y & 0xffff0000u));
                        acc[ai][bj][mp * 2 + mm][n] *= r; }
            __builtin_amdgcn_sched_barrier(0); }
}
__device__ __forceinline__ void gemm_phase(LAS unsigned char* lds, const Gemm& g, const StaticOrder& S) {
    const int tid = TIDX(), wid = __builtin_amdgcn_readfirstlane(tid >> 6), lane = tid & 63, wr = wid >> 2, wc = wid & 3, fr = lane & 15, fq = lane >> 4;
    const int K = g.K, nt = K / BK;
    unsigned voffA[2], voffB[2];
#pragma unroll
    for (int i = 0; i < 2; ++i) { int R, C; stage_rc(tid * 16 + i * 8192, R, C); const int Rb = g.perm ? ((R & ~31) + perm32(R & 31)) : R;
        voffA[i] = (unsigned)(R * g.lda + C) * 2u; voffB[i] = (unsigned)(Rb * g.ldb + C) * 2u; }
    const size_t kstep = (size_t)(BK * 2);
    const size_t hstepA = (size_t)HALF * g.lda * 2, hstepB = (size_t)HALF * g.ldb * 2;
    const size_t tstepA = 2 * hstepA, tstepB = 2 * hstepB;
    const unsigned ldsw = (unsigned)wid * 1024u;
    const int aoff = lds_byte(wr * 64 + fr, fq * 8), boff = lds_byte(wc * 32 + fr, fq * 8);
#define PG8_SA(b, h) (((b) * 2 + (h)) * HTB)
#define PG8_SB(b, h) ((4 + (b) * 2 + (h)) * HTB)
#define PG8_STAGE(bufoff, gbase, voff) do { _Pragma("unroll") for (int _i = 0; _i < 2; ++_i) \
        __builtin_amdgcn_global_load_lds((const unsigned*)((const char*)(gbase) + (voff)[_i]), (LAS unsigned*)(lds + (bufoff) + ldsw + _i * 8192), 16, 0, 0); } while (0)
#define PG8_LDA(dst, b, h) do { _Pragma("unroll") for (int m = 0; m < 4; ++m) _Pragma("unroll") for (int k = 0; k < 2; ++k) dst[m][k] = *(const LAS bf16x8*)(lds + PG8_SA(b, h) + aoff + m * 2048 + k * 1024); } while (0)
#define PG8_LDB(dst, b, h) do { _Pragma("unroll") for (int n = 0; n < 2; ++n) _Pragma("unroll") for (int k = 0; k < 2; ++k) dst[n][k] = *(const LAS bf16x8*)(lds + PG8_SB(b, h) + boff + n * 2048 + k * 1024); } while (0)
#define PG8_MMA(ai, bj, At, Bt) do { __builtin_amdgcn_s_setprio(1); _Pragma("unroll") for (int m = 0; m < 4; ++m) _Pragma("unroll") for (int n = 0; n < 2; ++n) _Pragma("unroll") for (int k = 0; k < 2; ++k) \
        acc[ai][bj][m][n] = __builtin_amdgcn_mfma_f32_16x16x32_bf16(Bt[n][k], At[m][k], acc[ai][bj][m][n], 0, 0, 0); __builtin_amdgcn_s_setprio(0); } while (0)
#define PG8_WAIT_V(n) asm volatile("s_waitcnt vmcnt(" #n ")" ::: "memory")
#define PG8_WAIT_L(n) asm volatile("s_waitcnt lgkmcnt(" #n ")" ::: "memory")
#define PG8_BAR __builtin_amdgcn_s_barrier()
#define PG8_SCHED __builtin_amdgcn_sched_barrier(0)
    Unit cur, nxt; int ui = 0;
    if (!S.next(0, cur)) return;
    f32x4 acc[2][2][4][2];
    { const float z = OZ();
#pragma unroll
    for (int a = 0; a < 2; ++a)
#pragma unroll
        for (int b = 0; b < 2; ++b)
#pragma unroll
            for (int m = 0; m < 4; ++m)
#pragma unroll
                for (int n = 0; n < 2; ++n) acc[a][b][m][n] = (f32x4){z, z, z, z}; }
    bf16x8 At[4][2], B0[2][2], B1[2][2];
    const char* cA = (const char*)g.A + (size_t)cur.pm * tstepA; const char* cB = (const char*)g.Bt + (size_t)cur.pn * tstepB;
    PG8_STAGE(PG8_SB(0, 0), cB, voffB); PG8_STAGE(PG8_SA(0, 0), cA, voffA); PG8_STAGE(PG8_SB(0, 1), cB + hstepB, voffB); PG8_STAGE(PG8_SA(0, 1), cA + hstepA, voffA);
    if (wr == 1) PG8_BAR;
    PG8_WAIT_V(4); PG8_BAR;
    PG8_STAGE(PG8_SB(1, 0), cB + kstep, voffB); PG8_STAGE(PG8_SA(1, 0), cA + kstep, voffA); PG8_STAGE(PG8_SB(1, 1), cB + hstepB + kstep, voffB);
    PG8_WAIT_V(6); PG8_BAR;
    for (;;) {
        const bool has_next = S.next(ui + 1, nxt);
        const char* nA = has_next ? (const char*)g.A + (size_t)nxt.pm * tstepA : cA; const char* nB = has_next ? (const char*)g.Bt + (size_t)nxt.pn * tstepB : cB;
        for (int t = 0; t < nt; t += 2) {
            if (g.epi == 11 && (t == 16 || t == 24)) up_rescale(acc, cur, wr, wc, fr, fq, t == 16 ? 0 : 2048);
            const bool last = (t == nt - 2);
            const char* a1 = cA + (size_t)(t + 1) * kstep;
            const char* a2 = last ? nA : cA + (size_t)(t + 2) * kstep; const char* b2 = last ? nB : cB + (size_t)(t + 2) * kstep;
            const char* a3 = a2 + kstep; const char* b3 = b2 + kstep;
            PG8_LDB(B0, 0, 0); PG8_SCHED; PG8_LDA(At, 0, 0); PG8_STAGE(PG8_SA(1, 1), a1 + hstepA, voffA);
            PG8_WAIT_L(8); PG8_BAR; PG8_WAIT_L(0); PG8_MMA(0, 0, At, B0); PG8_BAR; PG8_SCHED;
            PG8_LDB(B1, 0, 1); PG8_STAGE(PG8_SB(0, 0), b2, voffB);
            PG8_BAR; PG8_WAIT_L(0); PG8_MMA(0, 1, At, B1); PG8_BAR;
            PG8_LDA(At, 0, 1); PG8_STAGE(PG8_SA(0, 0), a2, voffA);
            PG8_BAR; PG8_WAIT_L(0); PG8_MMA(1, 0, At, B0); PG8_BAR; PG8_SCHED;
            PG8_STAGE(PG8_SB(0, 1), b2 + hstepB, voffB);
            PG8_WAIT_V(6); PG8_BAR; PG8_MMA(1, 1, At, B1); PG8_BAR;
            PG8_LDB(B0, 1, 0); PG8_SCHED; PG8_LDA(At, 1, 0); PG8_STAGE(PG8_SA(0, 1), a2 + hstepA, voffA);
            PG8_WAIT_L(8); PG8_BAR; PG8_WAIT_L(0); PG8_MMA(0, 0, At, B0); PG8_BAR; PG8_SCHED;
            PG8_LDB(B1, 1, 1); PG8_STAGE(PG8_SB(1, 0), b3, voffB);
            PG8_BAR; PG8_WAIT_L(0); PG8_MMA(0, 1, At, B1); PG8_BAR;
            PG8_LDA(At, 1, 1); PG8_STAGE(PG8_SA(1, 0), a3, voffA);
            PG8_BAR; PG8_WAIT_L(0); PG8_MMA(1, 0, At, B0); PG8_BAR; PG8_SCHED;
            PG8_STAGE(PG8_SB(1, 1), b3 + hstepB, voffB);
            PG8_WAIT_V(6); PG8_BAR; PG8_MMA(1, 1, At, B1); PG8_BAR;
        }
        epi_run(g, acc, cur, wr, wc, fr, fq);
        if (!has_next) break;
        { const float z = OZ();
#pragma unroll
        for (int a = 0; a < 2; ++a)
#pragma unroll
            for (int b = 0; b < 2; ++b)
#pragma unroll
                for (int m = 0; m < 4; ++m)
#pragma unroll
                    for (int n = 0; n < 2; ++n) acc[a][b][m][n] = (f32x4){z, z, z, z}; }
        cur = nxt; cA = nA; cB = nB; ++ui;
    }
    PG8_WAIT_V(0);
    if (wr == 0) PG8_BAR;
    PG8_BAR;
#undef PG8_SA
#undef PG8_SB
#undef PG8_STAGE
#undef PG8_LDA
#undef PG8_LDB
#undef PG8_MMA
#undef PG8_WAIT_V
#undef PG8_WAIT_L
#undef PG8_BAR
#undef PG8_SCHED
}
}
using pg8::Unit;
using pg8::cvt_pk_bf16;

#define EPI_FOR_NP(...) \
    _Pragma("unroll") for (int ai = 0; ai < 2; ++ai) _Pragma("unroll") for (int m = 0; m < 4; ++m) { const int row = u.pm * 256 + ai * 128 + wr * 64 + m * 16 + fr; \
    _Pragma("unroll") for (int bj = 0; bj < 2; ++bj) _Pragma("unroll") for (int n = 0; n < 2; ++n) { const int col = u.pn * 256 + bj * 128 + wc * 32 + n * 16 + 4 * fq; const f32x4 v = acc[ai][bj][m][n]; __VA_ARGS__ } }

typedef const f32x4 (&AccRef)[2][2][4][2];

struct EpiWin {
    static constexpr bool PERM = false;
    bh* zg; float* zf;
    __device__ __forceinline__ void operator()(AccRef acc, const Unit& u, int wr, int wc, int fr, int fq) const {
        if (u.pn < 24) {
            EPI_FOR_NP({ u32x2 w; w.x = cvt_pk_bf16(fmaxf(sigmoidf_(v[0]), 1e-6f), fmaxf(sigmoidf_(v[1]), 1e-6f)); w.y = cvt_pk_bf16(fmaxf(sigmoidf_(v[2]), 1e-6f), fmaxf(sigmoidf_(v[3]), 1e-6f)); *(u32x2*)(zg + (size_t)row * NGATE + col) = w; })
        } else {
            EPI_FOR_NP({ *(f32x4*)(zf + (size_t)row * ZF_LD + (col - NGATE)) = v; })
        }
    }
};
struct EpiLoraW {
    static constexpr bool PERM = false;
    const float* w0; float* rw;
    __device__ __forceinline__ void operator()(AccRef acc, const Unit& u, int wr, int wc, int fr, int fq) const {
        EPI_FOR_NP({ const f32x4 b = *(const f32x4*)(w0 + col); f32x4 o;
            _Pragma("unroll") for (int j = 0; j < 4; ++j) { const float x = -(b[j] + v[j]); const float sp = fmaxf(x, 0.f) + log1pf(__expf(-fabsf(x))); o[j] = __expf(-__expf(-sp - 0.5f)); }
            *(f32x4*)(rw + (size_t)row * 512 + col) = o; })
    }
};
struct EpiLoraA {
    static constexpr bool PERM = false;
    const float* a0; const float* ka; const float* rkk; float* rb; float* rk;
    __device__ __forceinline__ void operator()(AccRef acc, const Unit& u, int wr, int wc, int fr, int fq) const {
        EPI_FOR_NP({ const f32x4 b0 = *(const f32x4*)(a0 + col); const f32x4 kav = *(const f32x4*)(ka + col); const size_t o = (size_t)row * 512 + col;
            const f32x4 kkv = *(const f32x4*)(rkk + o); f32x4 kv = *(const f32x4*)(rk + o); f32x4 bo;
            _Pragma("unroll") for (int j = 0; j < 4; ++j) { const float a = sigmoidf_(b0[j] + v[j]); bo[j] = -(kkv[j] * a); kv[j] = kv[j] * (1.0f + (a - 1.0f) * kav[j]); }
            *(f32x4*)(rb + o) = bo; *(f32x4*)(rk + o) = kv; })
    }
};
struct EpiStoreF32 {
    static constexpr bool PERM = false;
    float* o; int ld;
    __device__ __forceinline__ void operator()(AccRef acc, const Unit& u, int wr, int wc, int fr, int fq) const {
        EPI_FOR_NP({ *(f32x4*)(o + (size_t)row * ld + col) = v; })
    }
};
struct EpiGlu {
    static constexpr bool PERM = false;
    const bh* ys; const float* gb; bh* ycat;
    __device__ __forceinline__ void operator()(AccRef acc, const Unit& u, int wr, int wc, int fr, int fq) const {
        EPI_FOR_NP({ const f32x4 b = *(const f32x4*)(gb + col); const u32x2 y2 = *(const u32x2*)(ys + (size_t)row * 512 + col);
            const float y0 = __uint_as_float(y2.x << 16), y1 = __uint_as_float(y2.x & 0xffff0000u), y2f = __uint_as_float(y2.y << 16), y3 = __uint_as_float(y2.y & 0xffff0000u);
            u32x2 w; w.x = cvt_pk_bf16(y0 * sigmoidf_(v[0] + b[0]), y1 * sigmoidf_(v[1] + b[1])); w.y = cvt_pk_bf16(y2f * sigmoidf_(v[2] + b[2]), y3 * sigmoidf_(v[3] + b[3]));
            *(u32x2*)(ycat + (size_t)row * D + 1536 + col) = w; })
    }
};
template <int MODE> struct EpiUp {
    static constexpr bool PERM = false;
    const bh* zg; float* mix; bh* mixed;
    __device__ __forceinline__ void operator()(AccRef acc, const Unit& u, int wr, int wc, int fr, int fq) const {
        EPI_FOR_NP({ const u32x2 g2 = *(const u32x2*)(zg + (size_t)row * NGATE + col);
            f32x4 g; g[0] = __uint_as_float(g2.x << 16); g[1] = __uint_as_float(g2.x & 0xffff0000u); g[2] = __uint_as_float(g2.y << 16); g[3] = __uint_as_float(g2.y & 0xffff0000u);
            f32x4 r = g * v; float* mp = mix + (size_t)row * D + col;
            if (MODE >= 1) r += *(const f32x4*)mp;
            if (MODE <= 1) *(f32x4*)mp = r;
            else { u32x2 w; w.x = cvt_pk_bf16(r[0], r[1]); w.y = cvt_pk_bf16(r[2], r[3]); *(u32x2*)(mixed + (size_t)row * D + col) = w; } })
    }
};
struct EpiUpF {
    static constexpr bool PERM = false;
    const bh* zg; bh* mixed;
    __device__ __forceinline__ void operator()(AccRef acc, const Unit& u, int wr, int wc, int fr, int fq) const {
#pragma unroll
        for (int ai = 0; ai < 2; ++ai) { u32x2 gg[16];
#pragma unroll
            for (int m = 0; m < 4; ++m)
#pragma unroll
                for (int bj = 0; bj < 2; ++bj)
#pragma unroll
                    for (int n = 0; n < 2; ++n) gg[m * 4 + bj * 2 + n] = *(const u32x2*)(zg + (size_t)(u.pm * 256 + ai * 128 + wr * 64 + m * 16 + fr) * NGATE + u.pn * 256 + bj * 128 + wc * 32 + n * 16 + 4 * fq);
            __builtin_amdgcn_sched_barrier(0);
#pragma unroll
            for (int m = 0; m < 4; ++m)
#pragma unroll
                for (int bj = 0; bj < 2; ++bj)
#pragma unroll
                    for (int n = 0; n < 2; ++n) { const u32x2 g2 = gg[m * 4 + bj * 2 + n]; const f32x4 v = acc[ai][bj][m][n];
                        u32x2 w; w.x = cvt_pk_bf16(__uint_as_float(g2.x << 16) * v[0], __uint_as_float(g2.x & 0xffff0000u) * v[1]); w.y = cvt_pk_bf16(__uint_as_float(g2.y << 16) * v[2], __uint_as_float(g2.y & 0xffff0000u) * v[3]);
                        *(u32x2*)(mixed + (size_t)(u.pm * 256 + ai * 128 + wr * 64 + m * 16 + fr) * D + u.pn * 256 + bj * 128 + wc * 32 + n * 16 + 4 * fq) = w; }
            __builtin_amdgcn_sched_barrier(0); }
    }
};
struct EpiRes {
    static constexpr bool PERM = false;
    float* h;
    __device__ __forceinline__ void operator()(AccRef acc, const Unit& u, int wr, int wc, int fr, int fq) const {
#pragma unroll
        for (int ai = 0; ai < 2; ++ai)
#pragma unroll
            for (int mp = 0; mp < 2; ++mp) { f32x4 hv[8];
#pragma unroll
                for (int mm = 0; mm < 2; ++mm)
#pragma unroll
                    for (int bj = 0; bj < 2; ++bj)
#pragma unroll
                        for (int n = 0; n < 2; ++n) hv[mm * 4 + bj * 2 + n] = *(const f32x4*)(h + (size_t)(u.pm * 256 + ai * 128 + wr * 64 + (mp * 2 + mm) * 16 + fr) * D + u.pn * 256 + bj * 128 + wc * 32 + n * 16 + 4 * fq);
                __builtin_amdgcn_sched_barrier(0);
#pragma unroll
                for (int mm = 0; mm < 2; ++mm)
#pragma unroll
                    for (int bj = 0; bj < 2; ++bj)
#pragma unroll
                        for (int n = 0; n < 2; ++n) *(f32x4*)(h + (size_t)(u.pm * 256 + ai * 128 + wr * 64 + (mp * 2 + mm) * 16 + fr) * D + u.pn * 256 + bj * 128 + wc * 32 + n * 16 + 4 * fq) = hv[mm * 4 + bj * 2 + n] + acc[ai][bj][mp * 2 + mm][n];
                __builtin_amdgcn_sched_barrier(0); }
    }
};
struct EpiFfn {
    static constexpr bool PERM = true;
    bh* act;
    __device__ __forceinline__ void operator()(AccRef acc, const Unit& u, int wr, int wc, int fr, int fq) const {
#pragma unroll
        for (int ai = 0; ai < 2; ++ai)
#pragma unroll
            for (int m = 0; m < 4; ++m) { const int row = u.pm * 256 + ai * 128 + wr * 64 + m * 16 + fr; const int col = u.pn * 128 + wc * 32 + 8 * fq;
                float o[8];
#pragma unroll
                for (int n = 0; n < 2; ++n)
#pragma unroll
                    for (int j = 0; j < 4; ++j) { const float gte = acc[ai][0][m][n][j], up = acc[ai][1][m][n][j]; o[n * 4 + j] = gte * sigmoidf_(gte) * up; }
                u32x4 w; w.x = cvt_pk_bf16(o[0], o[1]); w.y = cvt_pk_bf16(o[2], o[3]); w.z = cvt_pk_bf16(o[4], o[5]); w.w = cvt_pk_bf16(o[6], o[7]);
                *(u32x4*)(act + (size_t)row * FH + col) = w; }
    }
};
struct EpiPle {
    static constexpr bool PERM = false;
    float* h; const float* tmp;
    __device__ __forceinline__ void operator()(AccRef acc, const Unit& u, int wr, int wc, int fr, int fq) const {
#pragma unroll
        for (int ai = 0; ai < 2; ++ai)
#pragma unroll
            for (int mp = 0; mp < 2; ++mp) { f32x4 hv[8], tv[8];
#pragma unroll
                for (int mm = 0; mm < 2; ++mm)
#pragma unroll
                    for (int bj = 0; bj < 2; ++bj)
#pragma unroll
                        for (int n = 0; n < 2; ++n) { const size_t o = (size_t)(u.pm * 256 + ai * 128 + wr * 64 + (mp * 2 + mm) * 16 + fr) * D + u.pn * 256 + bj * 128 + wc * 32 + n * 16 + 4 * fq;
                            hv[mm * 4 + bj * 2 + n] = *(const f32x4*)(h + o); tv[mm * 4 + bj * 2 + n] = *(const f32x4*)(tmp + o); }
                __builtin_amdgcn_sched_barrier(0);
#pragma unroll
                for (int mm = 0; mm < 2; ++mm)
#pragma unroll
                    for (int bj = 0; bj < 2; ++bj)
#pragma unroll
                        for (int n = 0; n < 2; ++n) { const size_t o = (size_t)(u.pm * 256 + ai * 128 + wr * 64 + (mp * 2 + mm) * 16 + fr) * D + u.pn * 256 + bj * 128 + wc * 32 + n * 16 + 4 * fq;
                            f32x4 r = hv[mm * 4 + bj * 2 + n]; const f32x4 v = acc[ai][bj][mp * 2 + mm][n]; const f32x4 t4 = tv[mm * 4 + bj * 2 + n];
                            _Pragma("unroll") for (int j = 0; j < 4; ++j) r[j] += t4[j] * sigmoidf_(v[j]);
                            *(f32x4*)(h + o) = r; }
                __builtin_amdgcn_sched_barrier(0); }
    }
};

namespace pg8 {
__device__ __forceinline__ void epi_run(const Gemm& g, const f32x4 (&acc)[2][2][4][2], const Unit& u, int wr, int wc, int fr, int fq) {
    unsigned char* ws = P_WS; const int L = g.L;
    switch (g.epi) {
    case 0: { EpiWin E{(bh*)(ws + OFF_ZG), (float*)(ws + OFF_ZF)}; E(acc, u, wr, wc, fr, fq); } break;
    case 1: { EpiLoraW E{P_IN(9) + L * 512, (float*)(ws + OFF_RW)}; E(acc, u, wr, wc, fr, fq); } break;
    case 2: { EpiLoraA E{P_IN(11) + L * 512, P_IN(15) + L * 512, (const float*)(ws + OFF_RKK), (float*)(ws + OFF_RB), (float*)(ws + OFF_RK)}; E(acc, u, wr, wc, fr, fq); } break;
    case 3: { EpiStoreF32 E{(float*)(ws + (g.N == 512 ? OFF_RG : OFF_MIX32)), g.N}; E(acc, u, wr, wc, fr, fq); } break;
    case 4: { EpiGlu E{(const bh*)(ws + OFF_YS), P_IN(28) + L * 512, (bh*)(ws + OFF_YCAT)}; E(acc, u, wr, wc, fr, fq); } break;
    case 5: { EpiUp<0> E{(const bh*)(ws + OFF_ZG), (float*)(ws + OFF_MIX32), (bh*)(ws + OFF_ABF)}; E(acc, u, wr, wc, fr, fq); } break;
    case 6: { EpiUp<1> E{(const bh*)(ws + OFF_ZG) + 2048, (float*)(ws + OFF_MIX32), (bh*)(ws + OFF_ABF)}; E(acc, u, wr, wc, fr, fq); } break;
    case 7: { EpiUp<2> E{(const bh*)(ws + OFF_ZG) + 4096, (float*)(ws + OFF_MIX32), (bh*)(ws + OFF_ABF)}; E(acc, u, wr, wc, fr, fq); } break;
    case 8: { EpiRes E{P_OUT}; E(acc, u, wr, wc, fr, fq); } break;
    case 9: { EpiFfn E{(bh*)(ws + OFF_ACT)}; E(acc, u, wr, wc, fr, fq); } break;
    case 11: { EpiUpF E{(const bh*)(ws + OFF_ZG) + 4096, (bh*)(ws + OFF_ABF)}; E(acc, u, wr, wc, fr, fq); } break;
    default: { EpiPle E{P_OUT, (const float*)(ws + OFF_MIX32)}; E(acc, u, wr, wc, fr, fq); } break;
    }
}
}

__device__ __forceinline__ bool make_gemm(const Params& p, int L, int q, int i, pg8::Gemm& g) {
    unsigned char* ws = P_WS;
    g.M = T; g.perm = 0; g.L = L;
    switch (q) {
    case 1: if (i > 0) return false;
        g.A = (const bh*)(ws + OFF_ABF); g.lda = D; g.Bt = (const bh*)(ws + OFF_WIN); g.ldb = D; g.N = NINP; g.K = D; g.epi = 0; return true;
    case 3: if (i > 2) return false;
        g.lda = 256; g.ldb = 256; g.N = 512; g.K = 256;
        if (i == 0) { g.A = (const bh*)(ws + OFF_LAW); g.Bt = (const bh*)(ws + OFF_WW2); g.epi = 1; }
        else if (i == 1) { g.A = (const bh*)(ws + OFF_LAA); g.Bt = (const bh*)(ws + OFF_WA2); g.epi = 2; }
        else { g.A = (const bh*)(ws + OFF_LAG); g.Bt = (const bh*)(ws + OFF_WG2); g.epi = 3; }
        return true;
    case 5: if (i > 0) return false;
        g.A = (const bh*)(ws + OFF_YS); g.lda = 512; g.Bt = (const bh*)(ws + OFF_WGLU); g.ldb = 512; g.N = 512; g.K = 512; g.epi = 4; return true;
    case 6: if (i > 0) return false;
        g.A = (const bh*)(ws + OFF_YCAT); g.lda = D; g.Bt = (const bh*)(ws + OFF_WUP); g.ldb = D; g.N = D; g.K = D; g.epi = 11; return true;
    case 7: if (i > 0) return false;
        g.A = (const bh*)(ws + OFF_ABF); g.lda = D; g.Bt = (const bh*)(ws + OFF_WO); g.ldb = D; g.N = D; g.K = D; g.epi = 8; return true;
    case 9: if (i > 0) return false;
        g.A = (const bh*)(ws + OFF_ABF); g.lda = D; g.Bt = (const bh*)(ws + OFF_WGU); g.ldb = D; g.N = 2 * FH; g.K = D; g.epi = 9; g.perm = 1; return true;
    case 10: if (i > 0) return false;
        g.A = (const bh*)(ws + OFF_ACT); g.lda = FH; g.Bt = (const bh*)(ws + OFF_WD); g.ldb = FH; g.N = D; g.K = FH; g.epi = 8; return true;
    case 12: if (i > 1) return false;
        if (i == 0) { g.A = (const bh*)(ws + OFF_PBF) + (size_t)L * T * 256; g.lda = 256; g.Bt = (const bh*)(ws + OFF_WPP); g.ldb = 256; g.N = D; g.K = 256; g.epi = 3; }
        else { g.A = (const bh*)(ws + OFF_ABF); g.lda = D; g.Bt = (const bh*)(ws + OFF_WPG); g.ldb = D; g.N = D; g.K = D; g.epi = 10; }
        return true;
    default: return false;
    }
}

struct CJ { const float* src; int in_idx, src_ld, kv, n0, nv; long lstride; size_t dst; int dst_ld, r0, c0, npad, kpad, seg, segstride; };
constexpr int BIGSEG = 1 << 30;
__constant__ int JT_I[15][12] = {
    {3, NIN, 2048, NF, NGATE, D, 0, 0, NGATE, 2048, BIGSEG, 0},
    {3, NIN, 2048, 0, NF, D, NGATE, 0, 6656, 2048, BIGSEG, 0},
    {29, D, 1024, 0, D, D, 0, 0, D, 1024, BIGSEG, 0},
    {30, D, 512, 0, D, D, 0, 1024, D, 512, BIGSEG, 0},
    {31, D, 512, 0, D, D, 0, 1536, D, 512, BIGSEG, 0},
    {32, D, 2048, 0, D, D, 0, 0, D, 2048, BIGSEG, 0},
    {34, FH, 2048, 0, FH, D, 0, 0, FH, 2048, 128, 256},
    {35, FH, 2048, 0, FH, D, 128, 0, FH, 2048, 128, 256},
    {36, D, FH, 0, D, FH, 0, 0, D, FH, BIGSEG, 0},
    {38, D, 2048, 0, D, D, 0, 0, D, 2048, BIGSEG, 0},
    {39, D, 256, 0, D, 256, 0, 0, D, 256, BIGSEG, 0},
    {27, 512, 512, 0, 512, 512, 0, 0, 512, 512, BIGSEG, 0},
    {10, 512, 96, 0, 512, 256, 0, 0, 512, 256, BIGSEG, 0},
    {12, 512, 96, 0, 512, 256, 0, 0, 512, 256, BIGSEG, 0},
    {13, 512, 256, 0, 512, 256, 0, 0, 512, 256, BIGSEG, 0}};
__constant__ long JT_L[15][2] = {
    {(long)D * NIN, (long)OFF_WIN}, {(long)D * NIN, (long)OFF_WIN}, {(long)1024 * D, (long)OFF_WUP}, {(long)512 * D, (long)OFF_WUP}, {(long)512 * D, (long)OFF_WUP},
    {(long)D * D, (long)OFF_WO}, {(long)D * FH, (long)OFF_WGU}, {(long)D * FH, (long)OFF_WGU}, {(long)FH * D, (long)OFF_WD}, {(long)D * D, (long)OFF_WPG},
    {(long)256 * D, (long)OFF_WPP}, {(long)512 * 512, (long)OFF_WGLU}, {(long)96 * 512, (long)OFF_WW2}, {(long)96 * 512, (long)OFF_WA2}, {(long)256 * 512, (long)OFF_WG2}};
__device__ __forceinline__ void get_job(int j, CJ& J) {
    J.in_idx = JT_I[j][0]; J.src_ld = JT_I[j][1]; J.kv = JT_I[j][2]; J.n0 = JT_I[j][3]; J.nv = JT_I[j][4]; J.dst_ld = JT_I[j][5]; J.r0 = JT_I[j][6]; J.c0 = JT_I[j][7];
    J.npad = JT_I[j][8]; J.kpad = JT_I[j][9]; J.seg = JT_I[j][10]; J.segstride = JT_I[j][11]; J.lstride = JT_L[j][0]; J.dst = (size_t)JT_L[j][1];
}
__device__ __forceinline__ const float* in_by_idx(const Params& p, int i) { return P_IN(i); }
constexpr int NJOBS = 15;

__device__ __forceinline__ void conv_tile(int L, const CJ& J, int tile, int lane, bh* dstbase) {
    const int nkt = J.kpad / 64; const int tn = tile / nkt, tk = tile % nkt;
    const float* src = J.src + (size_t)L * J.lstride;
    const int cq = lane & 15, r = lane >> 4;
    const int nl = tn * 64 + cq * 4; const bool nok = nl < J.nv;
    const int k0 = tk * 64 + 16 * r;
    f32x4 v[16];
    const float* sp = src + (size_t)k0 * J.src_ld + J.n0 + nl;
    const float zc = OZ();
#pragma unroll
    for (int i = 0; i < 16; ++i) { v[i] = (f32x4){zc, zc, zc, zc}; if (nok && (k0 + i) < J.kv) v[i] = *(const f32x4*)(sp + (size_t)i * J.src_ld); }
#pragma unroll
    for (int j = 0; j < 4; ++j) { const int n = nl + j; const int drow = J.r0 + (n / J.seg) * J.segstride + (n % J.seg);
        u32x4 w0, w1;
        w0.x = cvt_pk_bf16(v[0][j], v[1][j]); w0.y = cvt_pk_bf16(v[2][j], v[3][j]); w0.z = cvt_pk_bf16(v[4][j], v[5][j]); w0.w = cvt_pk_bf16(v[6][j], v[7][j]);
        w1.x = cvt_pk_bf16(v[8][j], v[9][j]); w1.y = cvt_pk_bf16(v[10][j], v[11][j]); w1.z = cvt_pk_bf16(v[12][j], v[13][j]); w1.w = cvt_pk_bf16(v[14][j], v[15][j]);
        bh* d = dstbase + (size_t)drow * J.dst_ld + J.c0 + k0;
        *(u32x4*)d = w0; *(u32x4*)(d + 8) = w1; }
}

__device__ __forceinline__ void rms_row_bf16(const float* x, const float* g, bh* o, int lane) {
    f32x4 v[8]; float s = 0.f;
#pragma unroll
    for (int j = 0; j < 8; ++j) { v[j] = *(const f32x4*)(x + j * 256 + lane * 4); s += (v[j][0] * v[j][0] + v[j][1] * v[j][1]) + (v[j][2] * v[j][2] + v[j][3] * v[j][3]); }
    const float rstd = rsqrtf(wave_sum(s) * (1.0f / D) + 1e-6f);
#pragma unroll
    for (int j = 0; j < 8; ++j) { const f32x4 gg = *(const f32x4*)(g + j * 256 + lane * 4); u32x2 w; w.x = pk2(v[j][0] * rstd * gg[0], v[j][1] * rstd * gg[1]); w.y = pk2(v[j][2] * rstd * gg[2], v[j][3] * rstd * gg[3]);
        *(u32x2*)(o + j * 256 + lane * 4) = w; }
}
__device__ __forceinline__ void phase_rmsnorm(const Params& p, const float* g) {
    const int gw = BIDX() * 8 + (TIDX() >> 6), NGW = GDIM() * 8, lane = TIDX() & 63;
    bh* abf = (bh*)(P_WS + OFF_ABF);
    for (int r = gw; r < T; r += NGW) rms_row_bf16(P_OUT + (size_t)r * D, g, abf + (size_t)r * D, lane);
}

__device__ __forceinline__ void phase_conv(const Params& p, int L, LAS unsigned char* lds) {
    const int tid = TIDX();
    {   const int gw0 = BIDX() * 8 + (tid >> 6), NGW0 = GDIM() * 8, ln = tid & 63;
        int base = 0;
        for (int j = 0; j < NJOBS; ++j) { CJ J; get_job(j, J); J.src = in_by_idx(p, J.in_idx); const int ntile = (J.npad / 64) * (J.kpad / 64);
            int first = gw0 - (base % NGW0); if (first < 0) first += NGW0;
            bh* dstbase = (bh*)(P_WS + J.dst);
            for (int t = first; t < ntile; t += NGW0) conv_tile(L, J, t, ln, dstbase);
            base += ntile; } }
    const int gw = BIDX() * 8 + (tid >> 6), NGW = GDIM() * 8, lane = tid & 63;
    bh* abf = (bh*)(P_WS + OFF_ABF);
    if (L == 0) {
        const float* ps = P_IN(1); bh* pb = (bh*)(P_WS + OFF_PBF);
        for (size_t i = (size_t)BIDX() * 512 + tid; i < (size_t)2 * T * 256 / 4; i += (size_t)GDIM() * 512) { const f32x4 v = ((const f32x4*)ps)[i]; u32x2 w; w.x = pk2(v[0], v[1]); w.y = pk2(v[2], v[3]); ((u32x2*)pb)[i] = w; }
        const float* x = P_IN(0);
        for (int r = gw; r < T; r += NGW) {
#pragma unroll
            for (int j = 0; j < 8; ++j) *(f32x4*)(P_OUT + (size_t)r * D + j * 256 + lane * 4) = *(const f32x4*)(x + (size_t)r * D + j * 256 + lane * 4);
            rms_row_bf16(x + (size_t)r * D, P_IN(2), abf + (size_t)r * D, lane);
        }
    } else {
        for (int r = gw; r < T; r += NGW) rms_row_bf16(P_OUT + (size_t)r * D, P_IN(2) + (size_t)L * D, abf + (size_t)r * D, lane);
    }
}

struct S5C { float ar, ai; float br[16], bi[16]; };
__device__ __forceinline__ void s5_setup(const Params& p, int L, int g, int n, S5C& c) {
    const int gi = L * 32 + g;
    const float dt = __expf(P_IN(21)[gi]);
    const float are = P_IN(19)[gi * 64 + n], aim = P_IN(20)[gi * 64 + n];
    const float mag = __expf(are * dt), ang = aim * dt;
    float sn, cs;
    {
        const double a = (double)ang; const double k = rint(a * 0.15915494309189535); const float r = (float)(a - k * 6.283185307179586);
        sn = sinf(r); cs = cosf(r);
    }
    c.ar = mag * cs; c.ai = mag * sn;
    const float den = are * are + aim * aim, nr = c.ar - 1.0f, ni = c.ai;
    const float cr = (nr * are + ni * aim) / den, ci = (ni * are - nr * aim) / den;
    const float* bre = P_IN(22) + ((size_t)gi * 64 + n) * 16; const float* bim = P_IN(23) + ((size_t)gi * 64 + n) * 16;
#pragma unroll
    for (int q = 0; q < 4; ++q) { const f32x4 r4 = *(const f32x4*)(bre + q * 4), i4 = *(const f32x4*)(bim + q * 4);
#pragma unroll
        for (int j = 0; j < 4; ++j) { c.br[q * 4 + j] = cr * r4[j] - ci * i4[j]; c.bi[q * 4 + j] = cr * i4[j] + ci * r4[j]; } }
}
__device__ __forceinline__ void s5_step(const S5C& c, const LAS float* urow, float& sr, float& si) {
    float xr = 0.f, xi = 0.f;
#pragma unroll
    for (int q = 0; q < 4; ++q) { const f32x4 u4 = *(const LAS f32x4*)(urow + q * 4);
#pragma unroll
        for (int j = 0; j < 4; ++j) { xr = fmaf(u4[j], c.br[q * 4 + j], xr); xi = fmaf(u4[j], c.bi[q * 4 + j], xi); } }
    const float nr = c.ar * sr - c.ai * si + xr, ni = c.ar * si + c.ai * sr + xi;
    sr = nr; si = ni;
}
__device__ __forceinline__ void s5_stage_u(const float* zfc, LAS float* ul, int lane) {
    const float* src = zfc + (size_t)lane * ZF_LD;
    const f32x4 a = *(const f32x4*)src, b = *(const f32x4*)(src + 4), c = *(const f32x4*)(src + 8), d = *(const f32x4*)(src + 12);
    *(LAS f32x4*)(ul + lane * 16) = a; *(LAS f32x4*)(ul + lane * 16 + 4) = b; *(LAS f32x4*)(ul + lane * 16 + 8) = c; *(LAS f32x4*)(ul + lane * 16 + 12) = d;
    asm volatile("s_waitcnt lgkmcnt(0)" ::: "memory"); __builtin_amdgcn_wave_barrier();
}

__device__ __forceinline__ size_t fq_base(int h, int c, int mt, int ks8) { return ((((size_t)(h * NCH + c) * 4 + mt) * 8 + ks8) * 64) * 8; }
__device__ __forceinline__ size_t fq_off(int h, int t, int d) { const int s = t & 63; return fq_base(h, t >> 6, s >> 4, d >> 5) + ((s & 15) + 16 * ((d >> 3) & 3)) * 8 + (d & 7); }
__device__ __forceinline__ int ft_off(int row, int s8) { return ((((row >> 5) * 4 + (s8 >> 1)) * 64) + (row & 31) + 32 * (s8 & 1)) * 8; }

__device__ __forceinline__ void mlstm_prep(const Params& p, int L, int h, int c, LAS unsigned char* lds) {
    const int tid = TIDX(), t0 = c * 64;
    const float* zf = (const float*)(P_WS + OFF_ZF);
    LAS float* s_ws = (LAS float*)lds;
    if (tid < 64) {
        const int t = t0 + tid;
        float ig = zf[(size_t)t * ZF_LD + 4096 + h] + P_IN(5)[L * 4 + h];
        float fg = zf[(size_t)t * ZF_LD + 4100 + h] + P_IN(6)[L * 4 + h];
        ig = 15.0f * tanhf(ig * (1.0f / 15.0f)); fg = 15.0f * tanhf(fg * (1.0f / 15.0f));
        const float lf = fminf(fg, 0.f) - log1pf(__expf(-fabsf(fg)));
        float b = lf;
#pragma unroll
        for (int o = 1; o < 64; o <<= 1) { const float nb = bperm_f((tid - o) & 63, b); if (tid >= o) b += nb; }
        const float bend = bperm_f(63, b);
        const float wlog = bend - b + ig;
        const float mloc = wave_max(wlog);
        s_ws[tid] = __expf(wlog - mloc);
        ((float*)(P_WS + OFF_MI))[h * T + t] = ig; ((float*)(P_WS + OFF_MBB))[h * T + t] = b;
        if (tid == 0) { ((float*)(P_WS + OFF_MBEND))[h * NCH + c] = bend; ((float*)(P_WS + OFF_MLOC))[h * NCH + c] = mloc; }
    }
    __syncthreads();
    const int d = tid & 255, isk = tid >> 8;
    const int col = isk * 1024 + h * 256 + d;
    const float* cw = P_IN(4) + (size_t)L * 4 * 2048;
    const float w0 = cw[col], w1 = cw[2048 + col], w2 = cw[4096 + col], w3 = cw[6144 + col];
    float x1 = (t0 >= 1) ? zf[(size_t)(t0 - 1) * ZF_LD + col] : 0.f, x2 = (t0 >= 2) ? zf[(size_t)(t0 - 2) * ZF_LD + col] : 0.f, x3 = (t0 >= 3) ? zf[(size_t)(t0 - 3) * ZF_LD + col] : 0.f;
    bh* MQ = (bh*)(P_WS + OFF_MQ); bh* MK = (bh*)(P_WS + OFF_MK);
    bh* MT = (bh*)(P_WS + (isk ? OFF_MKT : OFF_MVT)) + (size_t)(h * NCH + c) * 16384;
    LAS bh* sQK = (LAS bh*)(lds + 1024);
    float dnacc = 0.f;
    for (int s8 = 0; s8 < 8; ++s8) {
        unsigned pk[4];
#pragma unroll
        for (int j = 0; j < 8; ++j) { const int s = s8 * 8 + j, t = t0 + s;
            const float x0 = zf[(size_t)t * ZF_LD + col]; float y = w0 * x0 + w1 * x1 + w2 * x2 + w3 * x3; x3 = x2; x2 = x1; x1 = x0;
            y = y * sigmoidf_(y);
            unsigned short e;
            if (!isk) { sQK[s * 264 + d] = f2bf(y * 0.0625f); e = f2bf(zf[(size_t)t * ZF_LD + 2048 + h * 256 + d]); }
            else { sQK[64 * 264 + s * 264 + d] = f2bf(y); const float wk = y * s_ws[s]; e = f2bf(wk); dnacc += wk; }
            if (j & 1) pk[j >> 1] |= ((unsigned)e << 16); else pk[j >> 1] = e; }
        u32x4 w; w.x = pk[0]; w.y = pk[1]; w.z = pk[2]; w.w = pk[3];
        *(u32x4*)(MT + ft_off(d, s8)) = w;
    }
    if (isk) ((float*)(P_WS + OFF_DN))[(size_t)(h * NCH + c) * 256 + d] = dnacc;
    __syncthreads();
#pragma unroll
    for (int i = 0; i < 8; ++i) { const int pid = i * 512 + tid, tens = pid >> 11, rem = pid & 2047, mt = rem >> 9, ks8 = (rem >> 6) & 7, lp = rem & 63;
        const u32x4 w = *(const LAS u32x4*)(sQK + tens * (64 * 264) + (mt * 16 + (lp & 15)) * 264 + ks8 * 32 + (lp >> 4) * 8);
        *(u32x4*)((tens ? MK : MQ) + fq_base(h, c, mt, ks8) + lp * 8) = w; }
    __syncthreads();
}

__device__ __forceinline__ void rwkv_prep_token(const Params& p, int L, int t, int lane) {
    const float* zf = (const float*)(P_WS + OFF_ZF);
    const float* z = zf + (size_t)t * ZF_LD + ZR0; const float* zp = z - ZF_LD; const bool hp = t > 0;
    const float* mu = P_IN(8) + (size_t)L * 1984;
    float* RR = (float*)(P_WS + OFF_RR); float* RK = (float*)(P_WS + OFF_RK); float* RV = (float*)(P_WS + OFF_RV); float* RKK = (float*)(P_WS + OFF_RKK);
    const float* kkw = P_IN(14) + L * 512;
#pragma unroll
    for (int i = 0; i < 8; ++i) { const int c = i * 64 + lane;
        { const float a = z[c], b = hp ? zp[c] : 0.f; RR[(size_t)t * 512 + c] = a + (b - a) * mu[c]; }
        { const float a = z[1024 + c], b = hp ? zp[1024 + c] : 0.f; RV[(size_t)t * 512 + c] = a + (b - a) * mu[1024 + c]; }
        { const float a = z[512 + c], b = hp ? zp[512 + c] : 0.f; const float k = a + (b - a) * mu[512 + c]; RK[(size_t)t * 512 + c] = k;
          const float kkv = k * kkw[c]; const float ss = wave_sum(kkv * kkv); RKK[(size_t)t * 512 + c] = kkv / fmaxf(sqrtf(ss), 1e-12f); } }
    bh* LAW = (bh*)(P_WS + OFF_LAW) + (size_t)t * 256; bh* LAA = (bh*)(P_WS + OFF_LAA) + (size_t)t * 256; bh* LAG = (bh*)(P_WS + OFF_LAG) + (size_t)t * 256;
#pragma unroll
    for (int i = 0; i < 4; ++i) { const int j = i * 64 + lane;
        float vw = 0.f, va = 0.f;
        if (j < 96) { { const int c = 1536 + j; const float a = z[c], b = hp ? zp[c] : 0.f; vw = tanhf(a + (b - a) * mu[c]); }
                      { const int c = 1632 + j; const float a = z[c], b = hp ? zp[c] : 0.f; va = a + (b - a) * mu[c]; } }
        LAW[j] = f2bf(vw); LAA[j] = f2bf(va);
        { const int c = 1728 + j; const float a = z[c], b = hp ? zp[c] : 0.f; LAG[j] = f2bf(sigmoidf_(a + (b - a) * mu[c])); } }
}

__device__ __forceinline__ void s5_pass_a(const Params& p, int L, int g, int c, int lane, LAS float* ul) {
    const float* zf = (const float*)(P_WS + OFF_ZF) + (size_t)(c * 64) * ZF_LD + ZS0 + g * 16;
    s5_stage_u(zf, ul, lane);
    S5C k; s5_setup(p, L, g, lane, k);
    float sr = 0.f, si = 0.f;
#pragma unroll 8
    for (int s = 0; s < 64; ++s) s5_step(k, ul + s * 16, sr, si);
    asm volatile("s_waitcnt lgkmcnt(0)" ::: "memory"); __builtin_amdgcn_wave_barrier();
    float* se = (float*)(P_WS + OFF_SEND) + ((size_t)(g * NCH + c) * 64 + lane) * 2;
    se[0] = sr; se[1] = si;
}

__device__ __forceinline__ void phase_prep(const Params& p, int L, LAS unsigned char* lds) {
    const int wid = TIDX() >> 6, lane = TIDX() & 63;
    for (int it = BIDX(); it < 2048; it += GDIM()) {
        if (it < 512) mlstm_prep(p, L, it >> 7, it & 127, lds);
        else if (it < 1536) rwkv_prep_token(p, L, (it - 512) * 8 + wid, lane);
        else { const int w = (it - 1536) * 8 + wid; s5_pass_a(p, L, w >> 7, w & 127, lane, (LAS float*)lds + wid * 1024); }
    }
}

constexpr int RW_NS = 4, RW_LS = T / RW_NS, RW_NB = RW_LS / 16, RW_RING = 4, RW_SLOT = 16 * 384;
constexpr int RW_YOFF = RW_RING * RW_SLOT;
__device__ __forceinline__ void rwkv_scan(const Params& p, int b, LAS unsigned char* lds) {
    const int tid = TIDX(), wid = __builtin_amdgcn_readfirstlane(tid >> 6), lane = tid & 63;
    int j, h, rg;
    if (b < 32) { j = 0; h = b >> 2; rg = b & 3; } else { const int u = b - 32; j = 1 + (u >> 6); h = (u & 63) >> 3; rg = u & 7; }
    LAS float* ring = (LAS float*)lds;
    LAS float* ybuf = ring + RW_YOFF;
    const int tbase = j * RW_LS;
    const bool isP = rg >= 4;
    if (wid >= 4) {
        const int lw = wid - 4, lt = tid - 256;
        const float* gp[6]; unsigned lo[6];
#pragma unroll
        for (int i = 0; i < 6; ++i) { const int ii = lw * 6 + i, rowidx = ii * 4 + (lane >> 4), step = rowidx / 6, a = rowidx % 6, q = lane & 15;
            const int ai = (0x205314 >> (4 * a)) & 0xf;
            gp[i] = (const float*)(P_WS + OFF_RR + (size_t)ai * SZ_R) + (size_t)(tbase + step) * 512 + h * 64 + q * 4;
            lo[i] = (unsigned)ii * 256u; }
        float* OUT = (float*)(P_WS + (isP ? OFF_RZ : OFF_RY)) + (size_t)(tbase + (lt >> 4)) * 512 + h * 64 + (rg & 3) * 16 + (lt & 15);
#define RW_ISSUE(bi, sl) do { _Pragma("unroll") for (int _i = 0; _i < 6; ++_i) \
        __builtin_amdgcn_global_load_lds((const unsigned*)(gp[_i] + (size_t)(bi) * 16 * 512), (LAS unsigned*)(ring + (sl) * RW_SLOT + lo[_i]), 16, 0, 0); } while (0)
        RW_ISSUE(0, 0); RW_ISSUE(1, 1); RW_ISSUE(2, 2);
        asm volatile("s_waitcnt vmcnt(12)" ::: "memory"); __builtin_amdgcn_s_barrier();
        int sl = 3;
        for (int ib = 0; ib < RW_NB; ++ib) {
            if (ib + 3 < RW_NB) RW_ISSUE(ib + 3, sl);
            sl = (sl == RW_RING - 1) ? 0 : sl + 1;
            if (ib > 0) {
                const LAS float* yb = ybuf + ((ib - 1) & 1) * 4096 + lt * 16;
                const f32x4 a0 = *(const LAS f32x4*)yb, a1 = *(const LAS f32x4*)(yb + 4), a2 = *(const LAS f32x4*)(yb + 8), a3 = *(const LAS f32x4*)(yb + 12);
                const f32x4 sm = (a0 + a1) + (a2 + a3);
                OUT[(size_t)(ib - 1) * 16 * 512] = (sm[0] + sm[1]) + (sm[2] + sm[3]);
            }
            if (ib + 3 < RW_NB) asm volatile("s_waitcnt vmcnt(13)" ::: "memory");
            else asm volatile("s_waitcnt vmcnt(0)" ::: "memory");
            __builtin_amdgcn_s_barrier();
        }
        {   const LAS float* yb = ybuf + ((RW_NB - 1) & 1) * 4096 + lt * 16;
            const f32x4 a0 = *(const LAS f32x4*)yb, a1 = *(const LAS f32x4*)(yb + 4), a2 = *(const LAS f32x4*)(yb + 8), a3 = *(const LAS f32x4*)(yb + 12);
            const f32x4 sm = (a0 + a1) + (a2 + a3);
            OUT[(size_t)(RW_NB - 1) * 16 * 512] = (sm[0] + sm[1]) + (sm[2] + sm[3]); }
#undef RW_ISSUE
    } else {
        const int r16 = wid * 4 + (lane >> 4), kq = lane & 15, row = (rg & 3) * 16 + r16;
        f32x4 S;
#pragma unroll
        for (int e = 0; e < 4; ++e) S[e] = (isP && (kq * 4 + e == row)) ? 1.f : 0.f;
        const float vmask = isP ? 0.f : 1.f;
        __builtin_amdgcn_s_barrier();
        int sl = 0;
        for (int ib = 0; ib < RW_NB; ++ib) {
            const LAS float* bb = ring + sl * RW_SLOT;
            LAS float* yw = ybuf + (ib & 1) * 4096 + r16 * 16 + kq;
            f32x4 w4 = *(const LAS f32x4*)(bb + kq * 4), k4 = *(const LAS f32x4*)(bb + 64 + kq * 4), kk4 = *(const LAS f32x4*)(bb + 128 + kq * 4),
                  b4 = *(const LAS f32x4*)(bb + 192 + kq * 4), r4 = *(const LAS f32x4*)(bb + 256 + kq * 4);
            float vv = bb[320 + row];
#pragma unroll
            for (int s = 0; s < 16; ++s) {
                f32x4 w4n, k4n, kk4n, b4n, r4n; float vvn;
                if (s < 15) { const LAS float* q = bb + (s + 1) * 384;
                    w4n = *(const LAS f32x4*)(q + kq * 4); k4n = *(const LAS f32x4*)(q + 64 + kq * 4); kk4n = *(const LAS f32x4*)(q + 128 + kq * 4);
                    b4n = *(const LAS f32x4*)(q + 192 + kq * 4); r4n = *(const LAS f32x4*)(q + 256 + kq * 4); vvn = q[320 + row]; }
                __builtin_amdgcn_sched_barrier(0);
                float pd = fmaf(S[0], kk4[0], fmaf(S[1], kk4[1], fmaf(S[2], kk4[2], S[3] * kk4[3])));
                const f32x4 pre = S * w4 + (vv * vmask) * k4;
                pd = allreduce16(pd);
                S = pre + pd * b4;
                yw[s * 256] = fmaf(S[0], r4[0], fmaf(S[1], r4[1], fmaf(S[2], r4[2], S[3] * r4[3])));
                if (s < 15) { w4 = w4n; k4 = k4n; kk4 = kk4n; b4 = b4n; r4 = r4n; vv = vvn; }
            }
            sl = (sl == RW_RING - 1) ? 0 : sl + 1;
            asm volatile("s_waitcnt lgkmcnt(0)" ::: "memory");
            __builtin_amdgcn_s_barrier();
        }
        float* EN = (float*)(P_WS + (isP ? OFF_RPEND : OFF_RSEND)) + ((size_t)(h * 4 + j) * 64 + row) * 64 + kq * 4;
        *(f32x4*)EN = S;
    }
    __syncthreads();
}

struct MStage { bf16x8 q[4], k[4], v[4]; float bend, mloc; };
__device__ __forceinline__ void mstage_load(MStage& st, const bh* qp, const bh* kp, const bh* vp, const float* MBEND, const float* MLOC, int h, int c) {
#pragma unroll
    for (int ks = 0; ks < 4; ++ks) { st.q[ks] = *(const bf16x8*)(qp + (size_t)c * 16384 + ks * 512); st.k[ks] = *(const bf16x8*)(kp + (size_t)c * 16384 + ks * 512); st.v[ks] = *(const bf16x8*)(vp + (size_t)c * 16384 + ks * 512); }
    st.bend = MBEND[h * NCH + c]; st.mloc = MLOC[h * NCH + c];
}
__device__ __forceinline__ void mlstm_seq(const Params& p, int mb, LAS unsigned char* lds) {
    const int tid = TIDX(), wid = tid >> 6, lane = tid & 63;
    const int h = mb >> 3, jv = mb & 7;
    LAS bh* Cbf = (LAS bh*)lds;
    constexpr int CS = 264;
    for (int i = tid; i < 2 * 32 * CS / 2; i += 512) ((LAS unsigned*)Cbf)[i] = 0u;
    __syncthreads();
    const bh* MQ = (const bh*)(P_WS + OFF_MQ); const bh* MKT = (const bh*)(P_WS + OFF_MKT); const bh* MVT = (const bh*)(P_WS + OFF_MVT);
    const float* MBEND = (const float*)(P_WS + OFF_MBEND); const float* MLOC = (const float*)(P_WS + OFF_MLOC);
    f32x16 ct;
    { const float z = OZ();
#pragma unroll
    for (int i = 0; i < 16; ++i) ct[i] = z; }
    float m = 0.f;
    const int mt = wid >> 1, kh = wid & 1;
    float* MINTER = (float*)(P_WS + OFF_ABF);
    LAS float* It = (LAS float*)(lds + 2 * 32 * 264 * 2);
    const bh* qp = MQ + fq_base(h, 0, mt, kh * 4) + lane * 8;
    const bh* kp = MKT + (size_t)(h * NCH) * 16384 + (wid * 4 * 64 + lane) * 8;
    const bh* vp = MVT + (size_t)(h * NCH) * 16384 + (jv * 4 * 64 + lane) * 8;
    MStage s0, s1, s2;
    mstage_load(s0, qp, kp, vp, MBEND, MLOC, h, 0);
    mstage_load(s1, qp, kp, vp, MBEND, MLOC, h, 1);
#define MSTEP(SC, SL, CIDX) do { const int c = (CIDX); const int t0 = c * 64, cur = c & 1; \
        mstage_load(SL, qp, kp, vp, MBEND, MLOC, h, (c + 2 < NCH) ? c + 2 : NCH - 1); \
        const float mnew = fmaxf(SC.bend + m, SC.mloc), decay = __expf(SC.bend + m - mnew), scale = __expf(SC.mloc - mnew); \
        f32x4 r0 = {0.f, 0.f, 0.f, 0.f}, r1 = {0.f, 0.f, 0.f, 0.f}; \
        const LAS bh* cb = Cbf + cur * 32 * CS + (lane & 15) * CS + kh * 128 + (lane >> 4) * 8; \
        _Pragma("unroll") for (int ks = 0; ks < 4; ++ks) { const bf16x8 b0 = *(const LAS bf16x8*)(cb + ks * 32), b1 = *(const LAS bf16x8*)(cb + 16 * CS + ks * 32); r0 = MFMA16(SC.q[ks], b0, r0); r1 = MFMA16(SC.q[ks], b1, r1); } \
        {     \
            if (c > 0) { const LAS float* ip = It + ((c - 1) & 1) * (2 * 64 * 36) + (tid >> 3) * 36 + (tid & 7) * 4; \
                const f32x4 sv = *(const LAS f32x4*)ip + *(const LAS f32x4*)(ip + 64 * 36); \
                float* o = MINTER + (size_t)(t0 - 64 + (tid >> 3)) * 1024 + h * 256 + jv * 32 + (tid & 7) * 4; \
                asm volatile("global_store_dwordx4 %0, %1, off\n\ts_nop 1" :: "v"(o), "v"(sv) : "memory"); } \
            LAS float* iw = It + cur * (2 * 64 * 36) + kh * (64 * 36) + (mt * 16 + (lane >> 4) * 4) * 36 + (lane & 15); \
            _Pragma("unroll") for (int r = 0; r < 4; ++r) { iw[r * 36] = r0[r]; iw[r * 36 + 16] = r1[r]; } } \
        f32x16 d0; { const float z = OZ(); _Pragma("unroll") for (int i = 0; i < 16; ++i) d0[i] = z; } \
        _Pragma("unroll") for (int ks = 0; ks < 4; ++ks) d0 = MFMA32(SC.k[ks], SC.v[ks], d0); \
        _Pragma("unroll") for (int i = 0; i < 16; ++i) ct[i] = decay * ct[i] + scale * d0[i]; \
        m = mnew; \
        {   LAS bh* o0 = Cbf + (cur ^ 1) * 32 * CS + (lane & 31) * CS + wid * 32 + 4 * (lane >> 5); \
            _Pragma("unroll") for (int g = 0; g < 4; ++g) { u32x2 w0; w0.x = cvt_pk_bf16(ct[4 * g], ct[4 * g + 1]); w0.y = cvt_pk_bf16(ct[4 * g + 2], ct[4 * g + 3]); *(LAS u32x2*)(o0 + 8 * g) = w0; } } \
        asm volatile("s_waitcnt lgkmcnt(0)" ::: "memory"); __builtin_amdgcn_s_barrier(); asm volatile("" ::: "memory"); } while (0)
    for (int c3 = 0; c3 < 126; c3 += 6) { MSTEP(s0, s2, c3); MSTEP(s1, s0, c3 + 1); MSTEP(s2, s1, c3 + 2); MSTEP(s0, s2, c3 + 3); MSTEP(s1, s0, c3 + 4); MSTEP(s2, s1, c3 + 5); }
    MSTEP(s0, s2, 126); MSTEP(s1, s0, 127);
#undef MSTEP
    {   const LAS float* ip = It + (127 & 1) * (2 * 64 * 36) + (tid >> 3) * 36 + (tid & 7) * 4;
        const f32x4 sv = *(const LAS f32x4*)ip + *(const LAS f32x4*)(ip + 64 * 36);
        *(f32x4*)(MINTER + (size_t)(127 * 64 + (tid >> 3)) * 1024 + h * 256 + jv * 32 + (tid & 7) * 4) = sv; }
    asm volatile("s_waitcnt vmcnt(0)" ::: "memory");
    __syncthreads();
}

__device__ __forceinline__ void mlstm_nscan(const Params& p) {
    const float* MBEND = (const float*)(P_WS + OFF_MBEND); const float* MLOC = (const float*)(P_WS + OFF_MLOC);
    const float* DN = (const float*)(P_WS + OFF_DN); float* NST = (float*)(P_WS + OFF_NST); float* MSTART = (float*)(P_WS + OFF_MSTART);
    for (int idx = TIDX(); idx < 1024; idx += 512) { const int h = idx >> 8, d = idx & 255; float m = 0.f, n = 0.f;
#pragma unroll 8
        for (int c = 0; c < NCH; ++c) { if (d == 0) MSTART[h * NCH + c] = m; NST[(size_t)(h * NCH + c) * 256 + d] = n;
            const float bend = MBEND[h * NCH + c], mloc = MLOC[h * NCH + c]; const float mnew = fmaxf(bend + m, mloc);
            n = __expf(bend + m - mnew) * n + __expf(mloc - mnew) * DN[(size_t)(h * NCH + c) * 256 + d]; m = mnew; } }
}

__device__ __forceinline__ float gelu_tanh(float x) { const float u = 0.7978845608028654f * (x + 0.044715f * x * x * x); return 0.5f * x * (1.0f + tanhf(u)); }

__device__ __forceinline__ void s5_pass_c(const Params& p, int L, int g, int c, int lane, LAS bh* img, LAS float* ul) {
    const float* zf = (const float*)(P_WS + OFF_ZF) + (size_t)(c * 64) * ZF_LD + ZS0 + g * 16;
    s5_stage_u(zf, ul, lane);
    S5C k; s5_setup(p, L, g, lane, k);
    float sr = 0.f, si = 0.f;
    {   float pr = k.ar, pi = k.ai;
#pragma unroll
        for (int i = 0; i < 6; ++i) { const float nr = pr * pr - pi * pi, ni = 2.f * pr * pi; pr = nr; pi = ni; }
        const float* se = (const float*)(P_WS + OFF_SEND) + ((size_t)(g * NCH) * 64 + lane) * 2;
        int cc = 0;
        for (; cc + 8 <= c; cc += 8) { float er[8], ei[8];
#pragma unroll
            for (int j = 0; j < 8; ++j) { er[j] = se[(size_t)(cc + j) * 128]; ei[j] = se[(size_t)(cc + j) * 128 + 1]; }
#pragma unroll
            for (int j = 0; j < 8; ++j) { const float nr = pr * sr - pi * si + er[j], ni = pr * si + pi * sr + ei[j]; sr = nr; si = ni; } }
        for (; cc < c; ++cc) { const float er = se[(size_t)cc * 128], ei = se[(size_t)cc * 128 + 1];
            const float nr = pr * sr - pi * si + er, ni = pr * si + pi * sr + ei; sr = nr; si = ni; } }
    const int gi = L * 32 + g;
    bf16x8 bfr[4];
    {   const int pp = lane & 15; const float* cre = P_IN(24) + ((size_t)gi * 16 + pp) * 64; const float* cim = P_IN(25) + ((size_t)gi * 16 + pp) * 64;
#pragma unroll
        for (int ks = 0; ks < 4; ++ks)
#pragma unroll
            for (int j = 0; j < 8; ++j) { const int n2 = ks * 32 + (lane >> 4) * 8 + j; const float v = (n2 < 64) ? cre[n2] : -cim[n2 - 64]; bfr[ks][j] = (short)f2bf(v); } }
    const float dco = P_IN(26)[L * 512 + g * 16 + (lane & 15)];
    bh* YS = (bh*)(P_WS + OFF_YS);
    for (int half = 0; half < 2; ++half) {
#pragma unroll 8
        for (int s = 0; s < 32; ++s) { s5_step(k, ul + (half * 32 + s) * 16, sr, si); img[s * 136 + lane] = f2bf(sr); img[s * 136 + 64 + lane] = f2bf(si); }
        asm volatile("s_waitcnt lgkmcnt(0)" ::: "memory"); __builtin_amdgcn_wave_barrier();
#pragma unroll
        for (int mt = 0; mt < 2; ++mt) { f32x4 acc = {0.f, 0.f, 0.f, 0.f};
#pragma unroll
            for (int ks = 0; ks < 4; ++ks) { const bf16x8 a = *(const LAS bf16x8*)(img + (mt * 16 + (lane & 15)) * 136 + ks * 32 + (lane >> 4) * 8); acc = MFMA16(a, bfr[ks], acc); }
#pragma unroll
            for (int r = 0; r < 4; ++r) { const int tt = half * 32 + mt * 16 + (lane >> 4) * 4 + r; const float uv = ul[tt * 16 + (lane & 15)];
                YS[(size_t)(c * 64 + tt) * 512 + g * 16 + (lane & 15)] = f2bf(gelu_tanh(acc[r] + dco * uv)); } }
        asm volatile("s_waitcnt lgkmcnt(0)" ::: "memory"); __builtin_amdgcn_wave_barrier();
    }
}

__device__ __forceinline__ void phase_scan(const Params& p, int L, LAS unsigned char* lds) {
    const int b = BIDX();
    if (b < 224) { for (int rr = 0; rr < PROBE_RW; ++rr) rwkv_scan(p, b, lds); }
    else { for (int rr = 0; rr < PROBE_ML; ++rr) mlstm_seq(p, b - 224, lds); }
}
__device__ __forceinline__ void phase_s5c(const Params& p, int L, LAS unsigned char* lds) {
    const int b = BIDX(), wid = TIDX() >> 6, lane = TIDX() & 63;
    if (b == GDIM() - 1) mlstm_nscan(p);
    const int nw = GDIM() * 8;
    for (int w = b * 8 + wid; w < 32 * NCH; w += nw) s5_pass_c(p, L, w >> 7, w & 127, lane, (LAS bh*)lds + wid * (32 * 136), (LAS float*)(lds + 69632) + wid * 1024);
    __syncthreads();
}

__device__ __forceinline__ void mlstm_out(const Params& p, int L, int h, int c, LAS unsigned char* lds) {
    const int tid = TIDX(), wid = tid >> 6, lane = tid & 63, t0 = c * 64;
    LAS bh* Pl = (LAS bh*)lds;
    LAS float* s_b = (LAS float*)(lds + 9216); LAS float* s_a = s_b + 64; LAS float* s_mt = s_a + 64; LAS float* s_iw = s_mt + 64; LAS float* s_den = s_iw + 64; LAS float* s_qn = s_den + 64; LAS float* s_part = s_qn + 64;
    const bh* MQ = (const bh*)(P_WS + OFF_MQ); const bh* MK = (const bh*)(P_WS + OFF_MK); const bh* MVT = (const bh*)(P_WS + OFF_MVT);
    const float* MINTER = (const float*)(P_WS + OFF_ABF);
    const float m0 = ((const float*)(P_WS + OFF_MSTART))[h * NCH + c];
    if (tid < 64) { const float ig = ((const float*)(P_WS + OFF_MI))[h * T + t0 + tid], b = ((const float*)(P_WS + OFF_MBB))[h * T + t0 + tid];
        const float a = ig - b; float cm = a;
#pragma unroll
        for (int o = 1; o < 64; o <<= 1) { const float nb = bperm_f((tid - o) & 63, cm); if (tid >= o) cm = fmaxf(cm, nb); }
        const float mt = b + fmaxf(m0, cm);
        s_b[tid] = b; s_a[tid] = a; s_mt[tid] = mt; s_iw[tid] = __expf(b + m0 - mt); }
    __syncthreads();
    {
        const int mt = wid >> 1, nt0 = (wid & 1) * 2;
        f32x4 r0 = {0.f, 0.f, 0.f, 0.f}, r1 = {0.f, 0.f, 0.f, 0.f};
        const bh* qp = MQ + fq_base(h, c, mt, 0) + lane * 8;
        const bh* kp = MK + fq_base(h, c, nt0, 0) + lane * 8;
#pragma unroll
        for (int ks = 0; ks < 8; ++ks) { const bf16x8 a = *(const bf16x8*)(qp + ks * 512); const bf16x8 b0 = *(const bf16x8*)(kp + ks * 512), b1 = *(const bf16x8*)(kp + 8 * 512 + ks * 512);
            r0 = MFMA16(a, b0, r0); r1 = MFMA16(a, b1, r1); }
#pragma unroll
        for (int r = 0; r < 4; ++r) { const int t = mt * 16 + (lane >> 4) * 4 + r; const float bt = s_b[t] - s_mt[t];
            { const int s = nt0 * 16 + (lane & 15); const float pv = (s <= t) ? r0[r] * __expf(bt + s_a[s]) : 0.f; Pl[t * 72 + s] = f2bf(pv); }
            { const int s = nt0 * 16 + 16 + (lane & 15); const float pv = (s <= t) ? r1[r] * __expf(bt + s_a[s]) : 0.f; Pl[t * 72 + s] = f2bf(pv); } }
    }
    __syncthreads();
    if (tid < 64) { float s = 0.f;
#pragma unroll
        for (int q = 0; q < 8; ++q) { const u32x4 w = *(const LAS u32x4*)(Pl + tid * 72 + q * 8);
            s += __uint_as_float(w.x << 16) + __uint_as_float(w.x & 0xffff0000u) + __uint_as_float(w.y << 16) + __uint_as_float(w.y & 0xffff0000u)
               + __uint_as_float(w.z << 16) + __uint_as_float(w.z & 0xffff0000u) + __uint_as_float(w.w << 16) + __uint_as_float(w.w & 0xffff0000u); }
        s_den[tid] = s; }
    {
        const float* nst = (const float*)(P_WS + OFF_NST) + (size_t)(h * NCH + c) * 256 + lane * 4; const f32x4 nv = *(const f32x4*)nst;
#pragma unroll
        for (int i = 0; i < 8; ++i) { const int t = wid * 8 + i; const u32x2 q2 = *(const u32x2*)(MQ + fq_off(h, t0 + t, lane * 4));
            float s = __uint_as_float(q2.x << 16) * nv[0] + __uint_as_float(q2.x & 0xffff0000u) * nv[1] + __uint_as_float(q2.y << 16) * nv[2] + __uint_as_float(q2.y & 0xffff0000u) * nv[3];
            s = wave_sum(s); if (lane == 0) s_qn[t] = s; } }
    f32x4 acc[4][2];
#pragma unroll
    for (int a = 0; a < 4; ++a) { const float z = OZ(); acc[a][0] = (f32x4){z, z, z, z}; acc[a][1] = (f32x4){z, z, z, z}; }
    {   const bh* vp = MVT + (size_t)(h * NCH + c) * 16384;
#pragma unroll
        for (int ks = 0; ks < 2; ++ks) { const bf16x8 b0 = *(const bf16x8*)(vp + ft_off(wid * 32 + (lane & 15), ks * 4 + (lane >> 4))), b1 = *(const bf16x8*)(vp + ft_off(wid * 32 + 16 + (lane & 15), ks * 4 + (lane >> 4)));
#pragma unroll
            for (int a = 0; a < 4; ++a) { const bf16x8 av = *(const LAS bf16x8*)(Pl + (a * 16 + (lane & 15)) * 72 + ks * 32 + (lane >> 4) * 8);
                acc[a][0] = MFMA16(av, b0, acc[a][0]); acc[a][1] = MFMA16(av, b1, acc[a][1]); } } }
    __syncthreads();
#pragma unroll
    for (int a = 0; a < 4; ++a)
#pragma unroll
        for (int r = 0; r < 4; ++r) { const int t = a * 16 + (lane >> 4) * 4 + r; const float iw = s_iw[t];
            const float den = s_den[t] + iw * s_qn[t]; const float dd = 1.0f / fmaxf(fabsf(den), __expf(-s_mt[t]));
            const float* mi = MINTER + (size_t)(t0 + t) * 1024 + h * 256 + wid * 32 + (lane & 15);
            const float h0 = (acc[a][0][r] + iw * mi[0]) * dd, h1 = (acc[a][1][r] + iw * mi[16]) * dd;
            acc[a][0][r] = h0; acc[a][1][r] = h1;
            float ss = h0 * h0 + h1 * h1;
            ss = allreduce16(ss);
            if ((lane & 15) == 0) s_part[wid * 64 + t] = ss; }
    __syncthreads();
    {   const float* zf = (const float*)(P_WS + OFF_ZF); const float* ng = P_IN(7) + L * 1024 + h * 256; bh* YC = (bh*)(P_WS + OFF_YCAT);
#pragma unroll
        for (int a = 0; a < 4; ++a)
#pragma unroll
            for (int r = 0; r < 4; ++r) { const int t = a * 16 + (lane >> 4) * 4 + r;
                float tot = 0.f;
#pragma unroll
                for (int w = 0; w < 8; ++w) tot += s_part[w * 64 + t];
                const float rstd = rsqrtf(tot * (1.0f / 256.0f) + 1e-6f);
                const int v0 = wid * 32 + (lane & 15);
                const float* op = zf + (size_t)(t0 + t) * ZF_LD + 3072 + h * 256 + v0;
                bh* yo = YC + (size_t)(t0 + t) * D + h * 256 + v0;
                yo[0] = f2bf(sigmoidf_(op[0]) * acc[a][0][r] * rstd * ng[v0]);
                yo[16] = f2bf(sigmoidf_(op[16]) * acc[a][1][r] * rstd * ng[v0 + 16]); } }
    __syncthreads();
}

__device__ __forceinline__ void rwkv_post(const Params& p, int L, int it, LAS unsigned char* lds) {
    const int tid = TIDX(), wid = tid >> 6, lane = tid & 63;
    const int h = it & 7, blk = it >> 3, j = blk >> 3;
    LAS float* bufA = (LAS float*)lds;
    LAS float* bufB = bufA + 64 * 65;
    LAS float* bufP = bufB + 64 * 65;
    const float* SE = (const float*)(P_WS + OFF_RSEND) + (size_t)(h * 4) * 4096; const float* PE = (const float*)(P_WS + OFF_RPEND) + (size_t)(h * 4) * 4096;
    LAS float* sst = bufA;
    if (j >= 1) {
        const int v = tid >> 3, k8 = (tid & 7) * 8;
        { const f32x4 a0 = *(const f32x4*)(SE + v * 64 + k8), a1 = *(const f32x4*)(SE + v * 64 + k8 + 4);
#pragma unroll
          for (int e = 0; e < 4; ++e) { bufA[v * 65 + k8 + e] = a0[e]; bufA[v * 65 + k8 + 4 + e] = a1[e]; } }
        for (int jj = 1; jj < j; ++jj) {
            { const f32x4 p0 = *(const f32x4*)(PE + (size_t)jj * 4096 + v * 64 + k8), p1 = *(const f32x4*)(PE + (size_t)jj * 4096 + v * 64 + k8 + 4);
              *(LAS f32x4*)(bufP + v * 64 + k8) = p0; *(LAS f32x4*)(bufP + v * 64 + k8 + 4) = p1; }
            __syncthreads();
            LAS float* src = (jj & 1) ? bufA : bufB; LAS float* dst = (jj & 1) ? bufB : bufA;
            f32x4 c0 = *(const f32x4*)(SE + (size_t)jj * 4096 + v * 64 + k8), c1 = *(const f32x4*)(SE + (size_t)jj * 4096 + v * 64 + k8 + 4);
#pragma unroll 8
            for (int i = 0; i < 64; ++i) { const float a = src[v * 65 + i]; const f32x4 p0 = *(const LAS f32x4*)(bufP + i * 64 + k8), p1 = *(const LAS f32x4*)(bufP + i * 64 + k8 + 4); c0 += a * p0; c1 += a * p1; }
#pragma unroll
            for (int e = 0; e < 4; ++e) { dst[v * 65 + k8 + e] = c0[e]; dst[v * 65 + k8 + 4 + e] = c1[e]; }
            __syncthreads();
            sst = dst;
        }
        __syncthreads();
    }
    float srow[64];
    if (j >= 1) {
#pragma unroll
        for (int i = 0; i < 64; ++i) srow[i] = sst[lane * 65 + i];
    } else {
#pragma unroll
        for (int i = 0; i < 64; ++i) srow[i] = 0.f;
    }
    const int c = h * 64 + lane;
    const float rkw = P_IN(16)[L * 512 + c], lg = P_IN(17)[L * 512 + c], lb = P_IN(18)[L * 512 + c];
    const float* RY = (const float*)(P_WS + OFF_RY); const float* RZ = (const float*)(P_WS + OFF_RZ); const float* RR = (const float*)(P_WS + OFF_RR); const float* RK = (const float*)(P_WS + OFF_RK);
    const float* RV = (const float*)(P_WS + OFF_RV); const float* RG = (const float*)(P_WS + OFF_RG); bh* YC = (bh*)(P_WS + OFF_YCAT);
    for (int i = 0; i < 32; ++i) { const int t = blk * 256 + wid * 32 + i; const size_t o = (size_t)t * 512 + c;
        float y = RY[o];
        if (j >= 1) { const float z = RZ[o]; float y2 = 0.f;
#pragma unroll
            for (int q = 0; q < 64; q += 2) { y = fmaf(srow[q], __builtin_bit_cast(float, __builtin_amdgcn_readlane(__builtin_bit_cast(int, z), q)), y);
                                              y2 = fmaf(srow[q + 1], __builtin_bit_cast(float, __builtin_amdgcn_readlane(__builtin_bit_cast(int, z), q + 1)), y2); }
            y += y2; }
        const float mu = wave_sum(y) * (1.0f / 64.0f); const float dlt = y - mu; const float var = wave_sum(dlt * dlt) * (1.0f / 64.0f);
        const float yn = dlt * rsqrtf(var + 64e-5f) * lg + lb;
        const float bon = wave_sum(RR[o] * RK[o] * rkw) * RV[o];
        YC[(size_t)t * D + 1024 + c] = f2bf((yn + bon) * RG[o]); }
    __syncthreads();
}

__device__ __forceinline__ void phase_post(const Params& p, int L, LAS unsigned char* lds) {
    for (int it = BIDX(); it < 768; it += GDIM()) {
        if (it < 512) mlstm_out(p, L, it >> 7, it & 127, lds);
        else rwkv_post(p, L, it - 512, lds);
    }
    __syncthreads();
}

#define XB_TMO      128
#define XB_XCNT(j)  (256  + 64 * (j))
#define XB_XSUB(j)  (1280 + 64 * (j))
#define XB_XGEN(j)  (2304 + 64 * (j))
#define XB_TOP      3328
#define XB_TOPGEN   3392
#define XCD_BAR_WORDS 3456
#define XB_SPIN_CAP (1u << 18)

__device__ __forceinline__ unsigned xb_ld(unsigned* p)              { return __hip_atomic_load(p, __ATOMIC_RELAXED, __HIP_MEMORY_SCOPE_AGENT); }
__device__ __forceinline__ unsigned xb_add(unsigned* p, unsigned v) { return __hip_atomic_fetch_add(p, v, __ATOMIC_RELAXED, __HIP_MEMORY_SCOPE_AGENT); }
__device__ __forceinline__ unsigned xb_xcc_id() { return (unsigned)__builtin_amdgcn_s_getreg((3 << 11) | 20) & 0xFu; }
#define XB_SPIN(cond, bar) do { unsigned _sp = 0; while (cond) { __builtin_amdgcn_s_sleep(1); \
    if ((++_sp & 255u) == 0u) { if (xb_ld(&(bar)[XB_TMO])) break; if (_sp > XB_SPIN_CAP) { atomicAdd(&(bar)[XB_TMO], 1u); break; } } } } while (0)

struct XcdBarrier {
    unsigned* bar; unsigned x;
    volatile LAS unsigned* st;
};

__device__ __forceinline__ XcdBarrier xcd_barrier_post(unsigned* bar, volatile LAS unsigned* st) {
    XcdBarrier b; b.bar = bar; b.x = xb_xcc_id(); b.st = st;
    if (threadIdx.x == 0) (void)xb_add(&bar[XB_XCNT(b.x)], 1u);
    return b;
}
__device__ __forceinline__ void xcd_barrier_complete(unsigned* bar, unsigned x, unsigned& nloc, unsigned& nx) {
    const unsigned G = gridDim.x * gridDim.y * gridDim.z;
    unsigned sum, cnt, mine, sp = 0u;
    for (;;) {
        sum = 0u; cnt = 0u; mine = 0u;
#pragma unroll
        for (unsigned j = 0; j < 16; ++j) { const unsigned c = xb_ld(&bar[XB_XCNT(j)]); sum += c; cnt += (c > 0u) ? 1u : 0u; mine = (j == x) ? c : mine; }
        if (sum == G) break;
        __builtin_amdgcn_s_sleep(1);
        if ((++sp & 255u) == 0u) { if (xb_ld(&bar[XB_TMO])) break; if (sp > XB_SPIN_CAP) { atomicAdd(&bar[XB_TMO], 1u); break; } }
    }
    nloc = mine > 0u ? mine : 1u; nx = cnt > 0u ? cnt : 1u;
}

__device__ __forceinline__ void xcd_barrier(const XcdBarrier& b) {
    asm volatile("s_waitcnt vmcnt(0)" ::: "memory");
    __syncthreads();
    if (threadIdx.x == 0) {
        unsigned* bar = b.bar;
        __builtin_amdgcn_s_waitcnt(0);
        unsigned nloc = b.st[0], nx = b.st[1];
        if (nloc == 0u) { xcd_barrier_complete(bar, b.x, nloc, nx); b.st[0] = nloc; b.st[1] = nx; }
        const unsigned old = xb_add(&bar[XB_XSUB(b.x)], 1u);
        const unsigned gen = old / nloc;
        if (old + 1u == (gen + 1u) * nloc) {
            __builtin_amdgcn_fence(__ATOMIC_RELEASE, "agent");
            asm volatile("s_waitcnt vmcnt(0)" ::: "memory");
            const unsigned og = xb_add(&bar[XB_TOP], 1u);
            const unsigned tg = og / nx;
            if (og + 1u == (tg + 1u) * nx) xb_add(&bar[XB_TOPGEN], 1u);
            else XB_SPIN(xb_ld(&bar[XB_TOPGEN]) == tg, bar);
            __builtin_amdgcn_fence(__ATOMIC_ACQUIRE, "agent");
            xb_add(&bar[XB_XGEN(b.x)], 1u);
            asm volatile("s_waitcnt vmcnt(0)" ::: "memory");
        } else {
            XB_SPIN(xb_ld(&bar[XB_XGEN(b.x)]) == gen, bar);
            __builtin_amdgcn_fence(__ATOMIC_ACQUIRE, "agent");
            asm volatile("s_waitcnt vmcnt(0)" ::: "memory");
        }
    }
    __syncthreads();
}


constexpr int NPHASE = 27;
__global__ void __launch_bounds__(512, 2) hybrid_fwd(Params p, int ph_lo, int ph_hi, int rep_q) {
    extern __shared__ __attribute__((aligned(16))) unsigned char smem_raw[];
    LAS unsigned char* lds = (LAS unsigned char*)smem_raw;
    cg::grid_group grid = cg::this_grid();
    volatile LAS unsigned* xst = (volatile LAS unsigned*)(lds + 131072);
    if (threadIdx.x < 2) xst[threadIdx.x] = 0u;
    __syncthreads();
    { XcdBarrier b0 = xcd_barrier_post((unsigned*)(P_WS + OFF_BAR), xst); (void)b0; }
    for (int ph = ph_lo; ph < ph_hi; ++ph) {
        if (ph == ph_lo + 1) grid.sync();
        else if (ph > ph_lo) { XcdBarrier xb; xb.bar = (unsigned*)(P_WS + OFF_BAR); xb.x = xb_xcc_id(); xb.st = xst; xcd_barrier(xb); }
        if (ph == 26) {
            const int gw = BIDX() * 8 + (TIDX() >> 6), NGW = GDIM() * 8, lane = TIDX() & 63;
            for (int r = gw; r < T; r += NGW) { float* x = P_OUT + (size_t)r * D; f32x4 v[8]; float s = 0.f;
#pragma unroll
                for (int j = 0; j < 8; ++j) { v[j] = *(const f32x4*)(x + j * 256 + lane * 4); s += (v[j][0] * v[j][0] + v[j][1] * v[j][1]) + (v[j][2] * v[j][2] + v[j][3] * v[j][3]); }
                const float rstd = rsqrtf(wave_sum(s) * (1.0f / D) + 1e-6f);
#pragma unroll
                for (int j = 0; j < 8; ++j) { const f32x4 gg = *(const f32x4*)(P_IN(40) + j * 256 + lane * 4); *(f32x4*)(x + j * 256 + lane * 4) = v[j] * rstd * gg; } }
            continue;
        }
        const int L = ph / 13, q = ph % 13;
#ifdef ONLY_Q
        if (q != ONLY_Q) continue;
#endif
        const int nrep = (q == rep_q) ? 2 : 1;
        for (int rep = 0; rep < nrep; ++rep) {
        if (rep) grid.sync();
        switch (q) {
        case 0: phase_conv(p, L, lds); break;
        case 2: phase_prep(p, L, lds); break;
        case 4: phase_scan(p, L, lds); break;
        case 5: phase_post(p, L, lds); break;
        case 8: phase_rmsnorm(p, P_IN(33) + (size_t)L * D); break;
        case 11: phase_rmsnorm(p, P_IN(37) + (size_t)L * D); break;
        default: break;
        }
        for (int i = 0; i < 3; ++i) {
            pg8::Gemm g;
            if (!make_gemm(p, L, q, i, g)) break;
            pg8::StaticOrder S; S.init(T, g.N, GDIM(), BIDX());
            pg8::gemm_phase(lds, g, S);
        }
        if (q == 3) phase_s5c(p, L, lds);
        }
    }
}

extern "C" void kernel_launch(void* const* d_in, const int* in_sizes, int n_in, void* d_out, int out_size, void* d_ws, size_t ws_size, hipStream_t stream) {
    constexpr size_t kDynLds = 131072 + 64;
    static int grid_blocks = 0;
    if (!grid_blocks) {
        int dev = 0, cus = 0, per_cu = 0;
        (void)hipGetDevice(&dev);
        (void)hipDeviceGetAttribute(&cus, hipDeviceAttributeMultiprocessorCount, dev);
        (void)hipFuncSetAttribute((const void*)hybrid_fwd, hipFuncAttributeMaxDynamicSharedMemorySize, (int)kDynLds);
        (void)hipOccupancyMaxActiveBlocksPerMultiprocessor(&per_cu, hybrid_fwd, 512, kDynLds);
        if (per_cu > 1) per_cu = 1;
        grid_blocks = cus * per_cu;
        if (ws_size < WS_TOTAL) fprintf(stderr, "workspace too small: %zu < %zu\n", ws_size, (size_t)WS_TOTAL);
    }
    Params p{};
    for (int i = 0; i < 41; ++i) p.in[i] = (const float*)d_in[i];
    p.out = (float*)d_out; p.ws = (unsigned char*)d_ws;
    (void)hipMemsetAsync((char*)d_ws + OFF_BAR, 0, XCD_BAR_WORDS * 4, stream);
#if SINGLE_LAUNCH
    int lo = 0, hi = NPHASE, rq = PROBE_REP_Q;
    void* args[] = {&p, &lo, &hi, &rq};
    hipError_t e = hipLaunchCooperativeKernel((const void*)hybrid_fwd, dim3(grid_blocks), dim3(512), args, kDynLds, stream);
    if (e != hipSuccess) fprintf(stderr, "cooperative launch failed: %s (grid %d)\n", hipGetErrorString(e), grid_blocks);
#else
    for (int ph = 0; ph < NPHASE; ++ph) {
        int lo = ph, hi = ph + 1, rq = -1;
        void* args[] = {&p, &lo, &hi, &rq};
        hipError_t e = hipLaunchCooperativeKernel((const void*)hybrid_fwd, dim3(grid_blocks), dim3(512), args, kDynLds, stream);
        if (e != hipSuccess) fprintf(stderr, "cooperative launch failed: %s (grid %d)\n", hipGetErrorString(e), grid_blocks);
    }
#endif
}
```

```cpp
#include <hip/hip_runtime.h>
#include <hip/hip_cooperative_groups.h>
#include <cstdio>
#include <cstdint>
namespace cg = cooperative_groups;

#define LAS __attribute__((address_space(3)))
typedef unsigned short bh;
typedef short bf16x8 __attribute__((ext_vector_type(8)));
typedef float f32x4 __attribute__((ext_vector_type(4)));
typedef float f32x16 __attribute__((ext_vector_type(16)));
typedef unsigned u32x4 __attribute__((ext_vector_type(4)));
typedef unsigned u32x2 __attribute__((ext_vector_type(2)));

#ifndef PROBE_RW
#define PROBE_RW 1
#define PROBE_ML 1
#endif
#ifndef PROBE_REP_Q
#define PROBE_REP_Q (-1)
#endif
#ifndef SINGLE_LAUNCH
#define SINGLE_LAUNCH 1
#endif

constexpr int T = 8192, D = 2048, FH = 5632;
constexpr int NIN = 12744, NGATE = 6144, NF = 6600, ZF_LD = 6656, NINP = 12800;
constexpr int ZR0 = 4104, ZS0 = 6088;
constexpr int NCH = 128;

constexpr size_t AL(size_t x) { return (x + 255) & ~(size_t)255; }
constexpr size_t SZ_WIN = (size_t)NINP * D * 2, SZ_SQ = (size_t)D * D * 2, SZ_WGU = (size_t)2 * FH * D * 2, SZ_WD = (size_t)D * FH * 2;
constexpr size_t OFF_WIN = 0;
constexpr size_t OFF_WUP = OFF_WIN + SZ_WIN;
constexpr size_t OFF_WO = OFF_WUP + SZ_SQ;
constexpr size_t OFF_WGU = OFF_WO + SZ_SQ;
constexpr size_t OFF_WD = OFF_WGU + SZ_WGU;
constexpr size_t OFF_WPG = OFF_WD + SZ_WD;
constexpr size_t OFF_WPP = OFF_WPG + SZ_SQ;
constexpr size_t OFF_WGLU = OFF_WPP + (size_t)D * 256 * 2;
constexpr size_t OFF_WW2 = OFF_WGLU + (size_t)512 * 512 * 2;
constexpr size_t OFF_WA2 = OFF_WW2 + (size_t)512 * 256 * 2;
constexpr size_t OFF_WG2 = OFF_WA2 + (size_t)512 * 256 * 2;
constexpr size_t OFF_PBF = OFF_WG2 + (size_t)512 * 256 * 2;
constexpr size_t OFF_ABF = OFF_PBF + (size_t)2 * T * 256 * 2;
constexpr size_t OFF_YCAT = OFF_ABF + (size_t)T * D * 2;
constexpr size_t OFF_ZF = OFF_YCAT + (size_t)T * D * 2;
constexpr size_t OFF_ACT = OFF_ZF;
constexpr size_t OFF_MIX32 = OFF_ZF + (size_t)100663296;
constexpr size_t OFF_ZG = OFF_ZF + (size_t)T * ZF_LD * 4;
constexpr size_t SZ_R = (size_t)T * 512 * 4;
constexpr size_t OFF_RR = OFF_ZG + (size_t)T * NGATE * 2;
constexpr size_t OFF_RK = OFF_RR + SZ_R, OFF_RV = OFF_RK + SZ_R, OFF_RKK = OFF_RV + SZ_R, OFF_RW = OFF_RKK + SZ_R, OFF_RB = OFF_RW + SZ_R, OFF_RG = OFF_RB + SZ_R, OFF_RY = OFF_RG + SZ_R;
constexpr size_t OFF_LAW = OFF_RY + SZ_R;
constexpr size_t OFF_LAA = OFF_LAW + (size_t)T * 256 * 2, OFF_LAG = OFF_LAA + (size_t)T * 256 * 2;
constexpr size_t SZ_MB = (size_t)T * 1024 * 2;
constexpr size_t OFF_MQ = OFF_LAG + (size_t)T * 256 * 2, OFF_MK = OFF_MQ + SZ_MB, OFF_MKT = OFF_MK + SZ_MB, OFF_MVT = OFF_MKT + SZ_MB;
constexpr size_t OFF_MI = OFF_MVT + SZ_MB;
constexpr size_t OFF_MBB = OFF_MI + (size_t)4 * T * 4;
constexpr size_t OFF_MBEND = OFF_MBB + (size_t)4 * T * 4;
constexpr size_t OFF_MLOC = OFF_MBEND + 2048, OFF_MSTART = OFF_MLOC + 2048;
constexpr size_t OFF_DN = OFF_MSTART + 2048;
constexpr size_t OFF_NST = OFF_DN + (size_t)4 * NCH * 256 * 4;
constexpr size_t OFF_SEND = OFF_NST + (size_t)4 * NCH * 256 * 4;
constexpr size_t OFF_YS = OFF_SEND + (size_t)32 * NCH * 64 * 8;
constexpr size_t OFF_RZ = OFF_YS + (size_t)T * 512 * 2;
constexpr size_t OFF_RSEND = OFF_RZ + SZ_R;
constexpr size_t OFF_RPEND = OFF_RSEND + (size_t)8 * 4 * 4096 * 4;
constexpr size_t OFF_MINTER2 = OFF_RPEND + (size_t)8 * 4 * 4096 * 4;
constexpr size_t OFF_BAR = OFF_MINTER2;
constexpr size_t WS_TOTAL = OFF_MINTER2 + (size_t)T * 1024 * 4;

struct Params { const float* in[41]; float* out; unsigned char* ws; };
#define KARG4 __attribute__((address_space(4)))
__device__ __forceinline__ const float* karg_in(int i) { const KARG4 char* ka = (const KARG4 char*)__builtin_amdgcn_kernarg_segment_ptr(); return *(const float* const volatile KARG4*)(ka + (size_t)i * 8); }
#define P_IN(i) karg_in(i)
#define P_OUT ((float*)karg_in(41))
#define P_WS ((unsigned char*)karg_in(42))

__device__ __forceinline__ int TIDX() { int t = threadIdx.x; asm volatile("" : "+v"(t)); return t; }
__device__ __forceinline__ int BIDX() { int t = blockIdx.x; asm volatile("" : "+s"(t)); return t; }
__device__ __forceinline__ int GDIM() { int t = gridDim.x; asm volatile("" : "+s"(t)); return t; }
__device__ __forceinline__ bh f2bf(float f) { unsigned u = __float_as_uint(f); u += 0x7fffu + ((u >> 16) & 1u); return (bh)(u >> 16); }
__device__ __forceinline__ float bf2f(bh h) { return __uint_as_float(((unsigned)h) << 16); }
__device__ __forceinline__ unsigned pk2(float lo, float hi) { return (unsigned)f2bf(lo) | ((unsigned)f2bf(hi) << 16); }
__device__ __forceinline__ float sigmoidf_(float x) { return 1.0f / (1.0f + __expf(-x)); }
__device__ __forceinline__ float bperm_f(int srclane, float v) { return __builtin_bit_cast(float, __builtin_amdgcn_ds_bpermute(srclane << 2, __builtin_bit_cast(int, v))); }
template <int CTRL> __device__ __forceinline__ float dpp_f(float x) {
    return __builtin_bit_cast(float, __builtin_amdgcn_update_dpp(0, __builtin_bit_cast(int, x), CTRL, 0xf, 0xf, true));
}
__device__ __forceinline__ float allreduce16(float x) {
    x += dpp_f<0xB1>(x); x += dpp_f<0x4E>(x); x += dpp_f<0x141>(x); x += dpp_f<0x140>(x);
    return x;
}
__device__ __forceinline__ float rl_f(float v, int l) { return __builtin_bit_cast(float, __builtin_amdgcn_readlane(__builtin_bit_cast(int, v), l)); }
__device__ __forceinline__ float wave_sum(float v) {
    v = allreduce16(v);
    return (rl_f(v, 0) + rl_f(v, 16)) + (rl_f(v, 32) + rl_f(v, 48));
}
__device__ __forceinline__ float wave_max(float v) {
    v = fmaxf(v, dpp_f<0xB1>(v)); v = fmaxf(v, dpp_f<0x4E>(v)); v = fmaxf(v, dpp_f<0x141>(v)); v = fmaxf(v, dpp_f<0x140>(v));
    return fmaxf(fmaxf(rl_f(v, 0), rl_f(v, 16)), fmaxf(rl_f(v, 32), rl_f(v, 48)));
}
__device__ __forceinline__ float OZ() { float z = 0.f; asm volatile("" : "+v"(z)); return z; }
#define MFMA16(a, b, c) __builtin_amdgcn_mfma_f32_16x16x32_bf16(a, b, c, 0, 0, 0)
#define MFMA32(a, b, c) __builtin_amdgcn_mfma_f32_32x32x16_bf16(a, b, c, 0, 0, 0)

namespace pg8 {
constexpr int BM = 256, BK = 64, HALF = 128, HTB = HALF * BK * 2, STAGE_BYTES = 8 * HTB, NXCD = 8, WGM = 8;
__device__ __forceinline__ int lds_byte(int r, int c) { const int st = (r >> 4) * 2 + (c >> 5), rr = r & 15, cc = c & 31, ob = rr * 64 + cc * 2; return st * 1024 + (ob ^ (((ob >> 9) & 1) << 5)); }
__device__ __forceinline__ void stage_rc(int b, int& R, int& C) { const int st = b / 1024, sb = b % 1024, swz = sb ^ (((sb >> 9) & 1) << 5); R = (st >> 1) * 16 + swz / 64; C = (st & 1) * 32 + (swz % 64) / 2; }
__device__ __forceinline__ int perm32(int rho) { const int n = rho >> 4, i = rho & 15; return 8 * (i >> 2) + 4 * n + (i & 3); }
struct Unit { int pm, pn; };
struct Gemm { const bh* A; const bh* Bt; int M, N, K, lda, ldb, epi, perm, L; };
struct StaticOrder {
    int nM, nN, nwg, G, c;
    __device__ void init(int M, int N, int G_, int c_) { nM = M / BM; nN = N / BM; nwg = nM * nN; G = G_; c = c_; }
    __device__ bool next(int i, Unit& u) const {
        const long L = (long)i * G + c; if (c < 0 || L >= nwg) return false;
        int wgid = (int)L; { const int q = nwg / NXCD, r = nwg % NXCD, xcd = wgid % NXCD, off = wgid / NXCD; wgid = (xcd < r ? xcd * (q + 1) : r * (q + 1) + (xcd - r) * q) + off; }
        const int nig = WGM * nN, gid = wgid / nig, fm = gid * WGM, gsz = (nM - fm) < WGM ? (nM - fm) : WGM;
        u.pm = fm + ((wgid % nig) % gsz); u.pn = (wgid % nig) / gsz; return true;
    }
};
__device__ __forceinline__ unsigned cvt_pk_bf16(float lo, float hi) { unsigned r; asm volatile("v_cvt_pk_bf16_f32 %0, %1, %2" : "=v"(r) : "v"(lo), "v"(hi)); return r; }

__device__ __forceinline__ void epi_run(const Gemm& g, const f32x4 (&acc)[2][2][4][2], const Unit& u, int wr, int wc, int fr, int fq);
__device__ __forceinline__ void up_rescale(f32x4 (&acc)[2][2][4][2], const Unit& u, int wr, int wc, int fr, int fq, int goff) {
    const bh* zg = (const bh*)(P_WS + OFF_ZG) + goff;
    asm volatile("" : "+v"(fr), "+v"(fq));
    const bh* zrow0 = zg + (size_t)(u.pm * 256 + wr * 64 + fr) * NGATE + u.pn * 256 + wc * 32 + 4 * fq;
#pragma unroll
    for (int ai = 0; ai < 2; ++ai)
#pragma unroll
        for (int mp = 0; mp < 2; ++mp) {
            u32x2 gp[8], gn[8];
#pragma unroll
            for (int mm = 0; mm < 2; ++mm) { const bh* zr = zrow0 + (size_t)(ai * 128 + (mp * 2 + mm) * 16) * NGATE;
#pragma unroll
                for (int bj = 0; bj < 2; ++bj)
#pragma unroll
                    for (int n = 0; n < 2; ++n) { gp[mm * 4 + bj * 2 + n] = *(const u32x2*)(zr + bj * 128 + n * 16); gn[mm * 4 + bj * 2 + n] = *(const u32x2*)(zr + 2048 + bj * 128 + n * 16); } }
            __builtin_amdgcn_sched_barrier(0);
#pragma unroll
            for (int mm = 0; mm < 2; ++mm)
#pragma unroll
                for (int bj = 0; bj < 2; ++bj)
#pragma unroll
                    for (int n = 0; n < 2; ++n) { const u32x2 p = gp[mm * 4 + bj * 2 + n], q = gn[mm * 4 + bj * 2 + n];
                        f32x4 r;
                        r[0] = __uint_as_float(p.x << 16) * __builtin_amdgcn_rcpf(__uint_as_float(q.x << 16)); r[1] = __uint_as_float(p.x & 0xffff0000u) * __builtin_amdgcn_rcpf(__uint_as_float(q.x & 0xffff0000u));
                        r[2] = __uint_as_float(p.y << 16) * __builtin_amdgcn_rcpf(__uint_as_float(q.y << 16)); r[3] = __uint_as_float(p.y & 0xffff0000u) * __builtin_amdgcn_rcpf(__uint_as_float(q.y & 0xffff0000u));
                        acc[ai][bj][mp * 2 + mm][n] *= r; }
            __builtin_amdgcn_sched_barrier(0); }
}
__device__ __forceinline__ void gemm_phase(LAS unsigned char* lds, const Gemm& g, const StaticOrder& S) {
    const int tid = TIDX(), wid = __builtin_amdgcn_readfirstlane(tid >> 6), lane = tid & 63, wr = wid >> 2, wc = wid & 3, fr = lane & 15, fq = lane >> 4;
    const int K = g.K, nt = K / BK;
    unsigned voffA[2], voffB[2];
#pragma unroll
    for (int i = 0; i < 2; ++i) { int R, C; stage_rc(tid * 16 + i * 8192, R, C); const int Rb = g.perm ? ((R & ~31) + perm32(R & 31)) : R;
        voffA[i] = (unsigned)(R * g.lda + C) * 2u; voffB[i] = (unsigned)(Rb * g.ldb + C) * 2u; }
    const size_t kstep = (size_t)(BK * 2);
    const size_t hstepA = (size_t)HALF * g.lda * 2, hstepB = (size_t)HALF * g.ldb * 2;
    const size_t tstepA = 2 * hstepA, tstepB = 2 * hstepB;
    const unsigned ldsw = (unsigned)wid * 1024u;
    const int aoff = lds_byte(wr * 64 + fr, fq * 8), boff = lds_byte(wc * 32 + fr, fq * 8);
#define PG8_SA(b, h) (((b) * 2 + (h)) * HTB)
#define PG8_SB(b, h) ((4 + (b) * 2 + (h)) * HTB)
#define PG8_STAGE(bufoff, gbase, voff) do { _Pragma("unroll") for (int _i = 0; _i < 2; ++_i) \
        __builtin_amdgcn_global_load_lds((const unsigned*)((const char*)(gbase) + (voff)[_i]), (LAS unsigned*)(lds + (bufoff) + ldsw + _i * 8192), 16, 0, 0); } while (0)
#define PG8_LDA(dst, b, h) do { _Pragma("unroll") for (int m = 0; m < 4; ++m) _Pragma("unroll") for (int k = 0; k < 2; ++k) dst[m][k] = *(const LAS bf16x8*)(lds + PG8_SA(b, h) + aoff + m * 2048 + k * 1024); } while (0)
#define PG8_LDB(dst, b, h) do { _Pragma("unroll") for (int n = 0; n < 2; ++n) _Pragma("unroll") for (int k = 0; k < 2; ++k) dst[n][k] = *(const LAS bf16x8*)(lds + PG8_SB(b, h) + boff + n * 2048 + k * 1024); } while (0)
#define PG8_MMA(ai, bj, At, Bt) do { __builtin_amdgcn_s_setprio(1); _Pragma("unroll") for (int m = 0; m < 4; ++m) _Pragma("unroll") for (int n = 0; n < 2; ++n) _Pragma("unroll") for (int k = 0; k < 2; ++k) \
        acc[ai][bj][m][n] = __builtin_amdgcn_mfma_f32_16x16x32_bf16(Bt[n][k], At[m][k], acc[ai][bj][m][n], 0, 0, 0); __builtin_amdgcn_s_setprio(0); } while (0)
#define PG8_WAIT_V(n) asm volatile("s_waitcnt vmcnt(" #n ")" ::: "memory")
#define PG8_WAIT_L(n) asm volatile("s_waitcnt lgkmcnt(" #n ")" ::: "memory")
#define PG8_BAR __builtin_amdgcn_s_barrier()
#define PG8_SCHED __builtin_amdgcn_sched_barrier(0)
    Unit cur, nxt; int ui = 0;
    if (!S.next(0, cur)) return;
    f32x4 acc[2][2][4][2];
    { const float z = OZ();
#pragma unroll
    for (int a = 0; a < 2; ++a)
#pragma unroll
        for (int b = 0; b < 2; ++b)
#pragma unroll
            for (int m = 0; m < 4; ++m)
#pragma unroll
                for (int n = 0; n < 2; ++n) acc[a][b][m][n] = (f32x4){z, z, z, z}; }
    bf16x8 At[4][2], B0[2][2], B1[2][2];
    const char* cA = (const char*)g.A + (size_t)cur.pm * tstepA; const char* cB = (const char*)g.Bt + (size_t)cur.pn * tstepB;
    PG8_STAGE(PG8_SB(0, 0), cB, voffB); PG8_STAGE(PG8_SA(0, 0), cA, voffA); PG8_STAGE(PG8_SB(0, 1), cB + hstepB, voffB); PG8_STAGE(PG8_SA(0, 1), cA + hstepA, voffA);
    if (wr == 1) PG8_BAR;
    PG8_WAIT_V(4); PG8_BAR;
    PG8_STAGE(PG8_SB(1, 0), cB + kstep, voffB); PG8_STAGE(PG8_SA(1, 0), cA + kstep, voffA); PG8_STAGE(PG8_SB(1, 1), cB + hstepB + kstep, voffB);
    PG8_WAIT_V(6); PG8_BAR;
    for (;;) {
        const bool has_next = S.next(ui + 1, nxt);
        const char* nA = has_next ? (const char*)g.A + (size_t)nxt.pm * tstepA : cA; const char* nB = has_next ? (const char*)g.Bt + (size_t)nxt.pn * tstepB : cB;
        for (int t = 0; t < nt; t += 2) {
            if (g.epi == 11 && (t == 16 || t == 24)) up_rescale(acc, cur, wr, wc, fr, fq, t == 16 ? 0 : 2048);
            const bool last = (t == nt - 2);
            const char* a1 = cA + (size_t)(t + 1) * kstep;
            const char* a2 = last ? nA : cA + (size_t)(t + 2) * kstep; const char* b2 = last ? nB : cB + (size_t)(t + 2) * kstep;
            const char* a3 = a2 + kstep; const char* b3 = b2 + kstep;
            PG8_LDB(B0, 0, 0); PG8_SCHED; PG8_LDA(At, 0, 0); PG8_STAGE(PG8_SA(1, 1), a1 + hstepA, voffA);
            PG8_WAIT_L(8); PG8_BAR; PG8_WAIT_L(0); PG8_MMA(0, 0, At, B0); PG8_BAR; PG8_SCHED;
            PG8_LDB(B1, 0, 1); PG8_STAGE(PG8_SB(0, 0), b2, voffB);
            PG8_BAR; PG8_WAIT_L(0); PG8_MMA(0, 1, At, B1); PG8_BAR;
            PG8_LDA(At, 0, 1); PG8_STAGE(PG8_SA(0, 0), a2, voffA);
            PG8_BAR; PG8_WAIT_L(0); PG8_MMA(1, 0, At, B0); PG8_BAR; PG8_SCHED;
            PG8_STAGE(PG8_SB(0, 1), b2 + hstepB, voffB);
            PG8_WAIT_V(6); PG8_BAR; PG8_MMA(1, 1, At, B1); PG8_BAR;
            PG8_LDB(B0, 1, 0); PG8_SCHED; PG8_LDA(At, 1, 0); PG8_STAGE(PG8_SA(0, 1), a2 + hstepA, voffA);
            PG8_WAIT_L(8); PG8_BAR; PG8_WAIT_L(0); PG8_MMA(0, 0, At, B0); PG8_BAR; PG8_SCHED;
            PG8_LDB(B1, 1, 1); PG8_STAGE(PG8_SB(1, 0), b3, voffB);
            PG8_BAR; PG8_WAIT_L(0); PG8_MMA(0, 1, At, B1); PG8_BAR;
            PG8_LDA(At, 1, 1); PG8_STAGE(PG8_SA(1, 0), a3, voffA);
            PG8_BAR; PG8_WAIT_L(0); PG8_MMA(1, 0, At, B0); PG8_BAR; PG8_SCHED;
            PG8_STAGE(PG8_SB(1, 1), b3 + hstepB, voffB);
            PG8_WAIT_V(6); PG8_BAR; PG8_MMA(1, 1, At, B1); PG8_BAR;
        }
        epi_run(g, acc, cur, wr, wc, fr, fq);
        if (!has_next) break;
        { const float z = OZ();
#pragma unroll
        for (int a = 0; a < 2; ++a)
#pragma unroll
            for (int b = 0; b < 2; ++b)
#pragma unroll
                for (int m = 0; m < 4; ++m)
#pragma unroll
                    for (int n = 0; n < 2; ++n) acc[a][b][m][n] = (f32x4){z, z, z, z}; }
        cur = nxt; cA = nA; cB = nB; ++ui;
    }
    PG8_WAIT_V(0);
    if (wr == 0) PG8_BAR;
    PG8_BAR;
#undef PG8_SA
#undef PG8_SB
#undef PG8_STAGE
#undef PG8_LDA
#undef PG8_LDB
#undef PG8_MMA
#undef PG8_WAIT_V
#undef PG8_WAIT_L
#undef PG8_BAR
#undef PG8_SCHED
}
}
using pg8::Unit;
using pg8::cvt_pk_bf16;

#define EPI_FOR_NP(...) \
    _Pragma("unroll") for (int ai = 0; ai < 2; ++ai) _Pragma("unroll") for (int m = 0; m < 4; ++m) { const int row = u.pm * 256 + ai * 128 + wr * 64 + m * 16 + fr; \
    _Pragma("unroll") for (int bj = 0; bj < 2; ++bj) _Pragma("unroll") for (int n = 0; n < 2; ++n) { const int col = u.pn * 256 + bj * 128 + wc * 32 + n * 16 + 4 * fq; const f32x4 v = acc[ai][bj][m][n]; __VA_ARGS__ } }

typedef const f32x4 (&AccRef)[2][2][4][2];
#define EPI_GRP8(...) \
    _Pragma("unroll") for (int mm = 0; mm < 2; ++mm) _Pragma("unroll") for (int bj = 0; bj < 2; ++bj) _Pragma("unroll") for (int n = 0; n < 2; ++n) { \
        const int idx = mm * 4 + bj * 2 + n; const int row = u.pm * 256 + ai * 128 + wr * 64 + (mp * 2 + mm) * 16 + fr; const int col = u.pn * 256 + bj * 128 + wc * 32 + n * 16 + 4 * fq; \
        const f32x4 v = acc[ai][bj][mp * 2 + mm][n]; (void)idx; (void)row; (void)col; (void)v; __VA_ARGS__ }
#define EPI_GROUPS _Pragma("unroll") for (int ai = 0; ai < 2; ++ai) _Pragma("unroll") for (int mp = 0; mp < 2; ++mp)

struct EpiWin {
    static constexpr bool PERM = false;
    bh* zg; float* zf;
    __device__ __forceinline__ void operator()(AccRef acc, const Unit& u, int wr, int wc, int fr, int fq) const {
        if (u.pn < 24) {
            EPI_FOR_NP({ u32x2 w; w.x = cvt_pk_bf16(fmaxf(sigmoidf_(v[0]), 1e-6f), fmaxf(sigmoidf_(v[1]), 1e-6f)); w.y = cvt_pk_bf16(fmaxf(sigmoidf_(v[2]), 1e-6f), fmaxf(sigmoidf_(v[3]), 1e-6f)); *(u32x2*)(zg + (size_t)row * NGATE + col) = w; })
        } else {
            EPI_FOR_NP({ *(f32x4*)(zf + (size_t)row * ZF_LD + (col - NGATE)) = v; })
        }
    }
};
struct EpiLoraW {
    static constexpr bool PERM = false;
    const float* w0; float* rw;
    __device__ __forceinline__ void operator()(AccRef acc, const Unit& u, int wr, int wc, int fr, int fq) const {
        f32x4 bb[2][2];
#pragma unroll
        for (int bj = 0; bj < 2; ++bj)
#pragma unroll
            for (int n = 0; n < 2; ++n) bb[bj][n] = *(const f32x4*)(w0 + u.pn * 256 + bj * 128 + wc * 32 + n * 16 + 4 * fq);
        __builtin_amdgcn_sched_barrier(0);
        EPI_FOR_NP({ const f32x4 b = bb[bj][n]; f32x4 o;
            _Pragma("unroll") for (int j = 0; j < 4; ++j) { const float x = -(b[j] + v[j]); const float sp = fmaxf(x, 0.f) + log1pf(__expf(-fabsf(x))); o[j] = __expf(-__expf(-sp - 0.5f)); }
            *(f32x4*)(rw + (size_t)row * 512 + col) = o; })
    }
};
struct EpiLoraA {
    static constexpr bool PERM = false;
    const float* a0; const float* ka; const float* rkk; float* rb; float* rk;
    __device__ __forceinline__ void operator()(AccRef acc, const Unit& u, int wr, int wc, int fr, int fq) const {
        f32x4 b0s[2][2], kas[2][2];
#pragma unroll
        for (int bj = 0; bj < 2; ++bj)
#pragma unroll
            for (int n = 0; n < 2; ++n) { const int c0 = u.pn * 256 + bj * 128 + wc * 32 + n * 16 + 4 * fq; b0s[bj][n] = *(const f32x4*)(a0 + c0); kas[bj][n] = *(const f32x4*)(ka + c0); }
#pragma unroll
        for (int ai = 0; ai < 2; ++ai)
#pragma unroll
            for (int m = 0; m < 4; ++m) { const int row = u.pm * 256 + ai * 128 + wr * 64 + m * 16 + fr; f32x4 kkq[4], kq[4];
#pragma unroll
                for (int bj = 0; bj < 2; ++bj)
#pragma unroll
                    for (int n = 0; n < 2; ++n) { const size_t o = (size_t)row * 512 + u.pn * 256 + bj * 128 + wc * 32 + n * 16 + 4 * fq; kkq[bj * 2 + n] = *(const f32x4*)(rkk + o); kq[bj * 2 + n] = *(const f32x4*)(rk + o); }
                __builtin_amdgcn_sched_barrier(0);
#pragma unroll
                for (int bj = 0; bj < 2; ++bj)
#pragma unroll
                    for (int n = 0; n < 2; ++n) { const size_t o = (size_t)row * 512 + u.pn * 256 + bj * 128 + wc * 32 + n * 16 + 4 * fq;
                        const f32x4 v = acc[ai][bj][m][n]; const f32x4 b0 = b0s[bj][n]; const f32x4 kav = kas[bj][n]; const f32x4 kkv = kkq[bj * 2 + n]; f32x4 kv = kq[bj * 2 + n]; f32x4 bo;
                        _Pragma("unroll") for (int j = 0; j < 4; ++j) { const float a = sigmoidf_(b0[j] + v[j]); bo[j] = -(kkv[j] * a); kv[j] = kv[j] * (1.0f + (a - 1.0f) * kav[j]); }
                        *(f32x4*)(rb + o) = bo; *(f32x4*)(rk + o) = kv; }
                __builtin_amdgcn_sched_barrier(0); }
    }
};
struct EpiStoreF32 {
    static constexpr bool PERM = false;
    float* o; int ld;
    __device__ __forceinline__ void operator()(AccRef acc, const Unit& u, int wr, int wc, int fr, int fq) const {
        EPI_FOR_NP({ *(f32x4*)(o + (size_t)row * ld + col) = v; })
    }
};
struct EpiGlu {
    static constexpr bool PERM = false;
    const bh* ys; const float* gb; bh* ycat;
    __device__ __forceinline__ void operator()(AccRef acc, const Unit& u, int wr, int wc, int fr, int fq) const {
        f32x4 gbs[2][2];
#pragma unroll
        for (int bj = 0; bj < 2; ++bj)
#pragma unroll
            for (int n = 0; n < 2; ++n) gbs[bj][n] = *(const f32x4*)(gb + u.pn * 256 + bj * 128 + wc * 32 + n * 16 + 4 * fq);
        EPI_GROUPS { u32x2 yq[8];
            EPI_GRP8({ yq[idx] = *(const u32x2*)(ys + (size_t)row * 512 + col); })
            __builtin_amdgcn_sched_barrier(0);
            EPI_GRP8({ const f32x4 b = gbs[bj][n]; const u32x2 y2 = yq[idx];
                const float y0 = __uint_as_float(y2.x << 16), y1 = __uint_as_float(y2.x & 0xffff0000u), y2f = __uint_as_float(y2.y << 16), y3 = __uint_as_float(y2.y & 0xffff0000u);
                u32x2 w; w.x = cvt_pk_bf16(y0 * sigmoidf_(v[0] + b[0]), y1 * sigmoidf_(v[1] + b[1])); w.y = cvt_pk_bf16(y2f * sigmoidf_(v[2] + b[2]), y3 * sigmoidf_(v[3] + b[3]));
                *(u32x2*)(ycat + (size_t)row * D + 1536 + col) = w; })
            __builtin_amdgcn_sched_barrier(0); }
    }
};
template <int MODE> struct EpiUp {
    static constexpr bool PERM = false;
    const bh* zg; float* mix; bh* mixed;
    __device__ __forceinline__ void operator()(AccRef acc, const Unit& u, int wr, int wc, int fr, int fq) const {
        EPI_FOR_NP({ const u32x2 g2 = *(const u32x2*)(zg + (size_t)row * NGATE + col);
            f32x4 g; g[0] = __uint_as_float(g2.x << 16); g[1] = __uint_as_float(g2.x & 0xffff0000u); g[2] = __uint_as_float(g2.y << 16); g[3] = __uint_as_float(g2.y & 0xffff0000u);
            f32x4 r = g * v; float* mp = mix + (size_t)row * D + col;
            if (MODE >= 1) r += *(const f32x4*)mp;
            if (MODE <= 1) *(f32x4*)mp = r;
            else { u32x2 w; w.x = cvt_pk_bf16(r[0], r[1]); w.y = cvt_pk_bf16(r[2], r[3]); *(u32x2*)(mixed + (size_t)row * D + col) = w; } })
    }
};
struct EpiUpF {
    static constexpr bool PERM = false;
    const bh* zg; bh* mixed;
    __device__ __forceinline__ void operator()(AccRef acc, const Unit& u, int wr, int wc, int fr, int fq) const {
#pragma unroll
        for (int ai = 0; ai < 2; ++ai) { u32x2 gg[16];
#pragma unroll
            for (int m = 0; m < 4; ++m)
#pragma unroll
                for (int bj = 0; bj < 2; ++bj)
#pragma unroll
                    for (int n = 0; n < 2; ++n) gg[m * 4 + bj * 2 + n] = *(const u32x2*)(zg + (size_t)(u.pm * 256 + ai * 128 + wr * 64 + m * 16 + fr) * NGATE + u.pn * 256 + bj * 128 + wc * 32 + n * 16 + 4 * fq);
            __builtin_amdgcn_sched_barrier(0);
#pragma unroll
            for (int m = 0; m < 4; ++m)
#pragma unroll
                for (int bj = 0; bj < 2; ++bj)
#pragma unroll
                    for (int n = 0; n < 2; ++n) { const u32x2 g2 = gg[m * 4 + bj * 2 + n]; const f32x4 v = acc[ai][bj][m][n];
                        u32x2 w; w.x = cvt_pk_bf16(__uint_as_float(g2.x << 16) * v[0], __uint_as_float(g2.x & 0xffff0000u) * v[1]); w.y = cvt_pk_bf16(__uint_as_float(g2.y << 16) * v[2], __uint_as_float(g2.y & 0xffff0000u) * v[3]);
                        *(u32x2*)(mixed + (size_t)(u.pm * 256 + ai * 128 + wr * 64 + m * 16 + fr) * D + u.pn * 256 + bj * 128 + wc * 32 + n * 16 + 4 * fq) = w; }
            __builtin_amdgcn_sched_barrier(0); }
    }
};
struct EpiRes {
    static constexpr bool PERM = false;
    float* h;
    __device__ __forceinline__ void operator()(AccRef acc, const Unit& u, int wr, int wc, int fr, int fq) const {
#pragma unroll
        for (int ai = 0; ai < 2; ++ai)
#pragma unroll
            for (int mp = 0; mp < 2; ++mp) { f32x4 hv[8];
#pragma unroll
                for (int mm = 0; mm < 2; ++mm)
#pragma unroll
                    for (int bj = 0; bj < 2; ++bj)
#pragma unroll
                        for (int n = 0; n < 2; ++n) hv[mm * 4 + bj * 2 + n] = *(const f32x4*)(h + (size_t)(u.pm * 256 + ai * 128 + wr * 64 + (mp * 2 + mm) * 16 + fr) * D + u.pn * 256 + bj * 128 + wc * 32 + n * 16 + 4 * fq);
                __builtin_amdgcn_sched_barrier(0);
#pragma unroll
                for (int mm = 0; mm < 2; ++mm)
#pragma unroll
                    for (int bj = 0; bj < 2; ++bj)
#pragma unroll
                        for (int n = 0; n < 2; ++n) *(f32x4*)(h + (size_t)(u.pm * 256 + ai * 128 + wr * 64 + (mp * 2 + mm) * 16 + fr) * D + u.pn * 256 + bj * 128 + wc * 32 + n * 16 + 4 * fq) = hv[mm * 4 + bj * 2 + n] + acc[ai][bj][mp * 2 + mm][n];
                __builtin_amdgcn_sched_barrier(0); }
    }
};
struct EpiFfn {
    static constexpr bool PERM = true;
    bh* act;
    __device__ __forceinline__ void operator()(AccRef acc, const Unit& u, int wr, int wc, int fr, int fq) const {
#pragma unroll
        for (int ai = 0; ai < 2; ++ai)
#pragma unroll
            for (int m = 0; m < 4; ++m) { const int row = u.pm * 256 + ai * 128 + wr * 64 + m * 16 + fr; const int col = u.pn * 128 + wc * 32 + 8 * fq;
                float o[8];
#pragma unroll
                for (int n = 0; n < 2; ++n)
#pragma unroll
                    for (int j = 0; j < 4; ++j) { const float gte = acc[ai][0][m][n][j], up = acc[ai][1][m][n][j]; o[n * 4 + j] = gte * sigmoidf_(gte) * up; }
                u32x4 w; w.x = cvt_pk_bf16(o[0], o[1]); w.y = cvt_pk_bf16(o[2], o[3]); w.z = cvt_pk_bf16(o[4], o[5]); w.w = cvt_pk_bf16(o[6], o[7]);
                *(u32x4*)(act + (size_t)row * FH + col) = w; }
    }
};
struct EpiPle {
    static constexpr bool PERM = false;
    float* h; const float* tmp;
    __device__ __forceinline__ void operator()(AccRef acc, const Unit& u, int wr, int wc, int fr, int fq) const {
#pragma unroll
        for (int ai = 0; ai < 2; ++ai)
#pragma unroll
            for (int mp = 0; mp < 2; ++mp) { f32x4 hv[8], tv[8];
#pragma unroll
                for (int mm = 0; mm < 2; ++mm)
#pragma unroll
                    for (int bj = 0; bj < 2; ++bj)
#pragma unroll
                        for (int n = 0; n < 2; ++n) { const size_t o = (size_t)(u.pm * 256 + ai * 128 + wr * 64 + (mp * 2 + mm) * 16 + fr) * D + u.pn * 256 + bj * 128 + wc * 32 + n * 16 + 4 * fq;
                            hv[mm * 4 + bj * 2 + n] = *(const f32x4*)(h + o); tv[mm * 4 + bj * 2 + n] = *(const f32x4*)(tmp + o); }
                __builtin_amdgcn_sched_barrier(0);
#pragma unroll
                for (int mm = 0; mm < 2; ++mm)
#pragma unroll
                    for (int bj = 0; bj < 2; ++bj)
#pragma unroll
                        for (int n = 0; n < 2; ++n) { const size_t o = (size_t)(u.pm * 256 + ai * 128 + wr * 64 + (mp * 2 + mm) * 16 + fr) * D + u.pn * 256 + bj * 128 + wc * 32 + n * 16 + 4 * fq;
                            f32x4 r = hv[mm * 4 + bj * 2 + n]; const f32x4 v = acc[ai][bj][mp * 2 + mm][n]; const f32x4 t4 = tv[mm * 4 + bj * 2 + n];
                            _Pragma("unroll") for (int j = 0; j < 4; ++j) r[j] += t4[j] * sigmoidf_(v[j]);
                            *(f32x4*)(h + o) = r; }
                __builtin_amdgcn_sched_barrier(0); }
    }
};

namespace pg8 {
__device__ __forceinline__ void epi_run(const Gemm& g, const f32x4 (&acc)[2][2][4][2], const Unit& u, int wr, int wc, int fr, int fq) {
    unsigned char* ws = P_WS; const int L = g.L;
    switch (g.epi) {
    case 0: { EpiWin E{(bh*)(ws + OFF_ZG), (float*)(ws + OFF_ZF)}; E(acc, u, wr, wc, fr, fq); } break;
    case 1: { EpiLoraW E{P_IN(9) + L * 512, (float*)(ws + OFF_RW)}; E(acc, u, wr, wc, fr, fq); } break;
    case 2: { EpiLoraA E{P_IN(11) + L * 512, P_IN(15) + L * 512, (const float*)(ws + OFF_RKK), (float*)(ws + OFF_RB), (float*)(ws + OFF_RK)}; E(acc, u, wr, wc, fr, fq); } break;
    case 3: { EpiStoreF32 E{(float*)(ws + (g.N == 512 ? OFF_RG : OFF_MIX32)), g.N}; E(acc, u, wr, wc, fr, fq); } break;
    case 4: { EpiGlu E{(const bh*)(ws + OFF_YS), P_IN(28) + L * 512, (bh*)(ws + OFF_YCAT)}; E(acc, u, wr, wc, fr, fq); } break;
    case 5: { EpiUp<0> E{(const bh*)(ws + OFF_ZG), (float*)(ws + OFF_MIX32), (bh*)(ws + OFF_ABF)}; E(acc, u, wr, wc, fr, fq); } break;
    case 6: { EpiUp<1> E{(const bh*)(ws + OFF_ZG) + 2048, (float*)(ws + OFF_MIX32), (bh*)(ws + OFF_ABF)}; E(acc, u, wr, wc, fr, fq); } break;
    case 7: { EpiUp<2> E{(const bh*)(ws + OFF_ZG) + 4096, (float*)(ws + OFF_MIX32), (bh*)(ws + OFF_ABF)}; E(acc, u, wr, wc, fr, fq); } break;
    case 8: { EpiRes E{P_OUT}; E(acc, u, wr, wc, fr, fq); } break;
    case 9: { EpiFfn E{(bh*)(ws + OFF_ACT)}; E(acc, u, wr, wc, fr, fq); } break;
    case 11: { EpiUpF E{(const bh*)(ws + OFF_ZG) + 4096, (bh*)(ws + OFF_ABF)}; E(acc, u, wr, wc, fr, fq); } break;
    default: { EpiPle E{P_OUT, (const float*)(ws + OFF_MIX32)}; E(acc, u, wr, wc, fr, fq); } break;
    }
}
}

__device__ __forceinline__ bool make_gemm(const Params& p, int L, int q, int i, pg8::Gemm& g) {
    unsigned char* ws = P_WS;
    g.M = T; g.perm = 0; g.L = L;
    switch (q) {
    case 1: if (i > 0) return false;
        g.A = (const bh*)(ws + OFF_ABF); g.lda = D; g.Bt = (const bh*)(ws + OFF_WIN); g.ldb = D; g.N = NINP; g.K = D; g.epi = 0; return true;
    case 3: if (i > 2) return false;
        g.lda = 256; g.ldb = 256; g.N = 512; g.K = 256;
        if (i == 0) { g.A = (const bh*)(ws + OFF_LAW); g.Bt = (const bh*)(ws + OFF_WW2); g.epi = 1; }
        else if (i == 1) { g.A = (const bh*)(ws + OFF_LAA); g.Bt = (const bh*)(ws + OFF_WA2); g.epi = 2; }
        else { g.A = (const bh*)(ws + OFF_LAG); g.Bt = (const bh*)(ws + OFF_WG2); g.epi = 3; }
        return true;
    case 5: if (i > 0) return false;
        g.A = (const bh*)(ws + OFF_YS); g.lda = 512; g.Bt = (const bh*)(ws + OFF_WGLU); g.ldb = 512; g.N = 512; g.K = 512; g.epi = 4; return true;
    case 6: if (i > 0) return false;
        g.A = (const bh*)(ws + OFF_YCAT); g.lda = D; g.Bt = (const bh*)(ws + OFF_WUP); g.ldb = D; g.N = D; g.K = D; g.epi = 11; return true;
    case 7: if (i > 0) return false;
        g.A = (const bh*)(ws + OFF_ABF); g.lda = D; g.Bt = (const bh*)(ws + OFF_WO); g.ldb = D; g.N = D; g.K = D; g.epi = 8; return true;
    case 9: if (i > 0) return false;
        g.A = (const bh*)(ws + OFF_ABF); g.lda = D; g.Bt = (const bh*)(ws + OFF_WGU); g.ldb = D; g.N = 2 * FH; g.K = D; g.epi = 9; g.perm = 1; return true;
    case 10: if (i > 0) return false;
        g.A = (const bh*)(ws + OFF_ACT); g.lda = FH; g.Bt = (const bh*)(ws + OFF_WD); g.ldb = FH; g.N = D; g.K = FH; g.epi = 8; return true;
    case 12: if (i > 1) return false;
        if (i == 0) { g.A = (const bh*)(ws + OFF_PBF) + (size_t)L * T * 256; g.lda = 256; g.Bt = (const bh*)(ws + OFF_WPP); g.ldb = 256; g.N = D; g.K = 256; g.epi = 3; }
        else { g.A = (const bh*)(ws + OFF_ABF); g.lda = D; g.Bt = (const bh*)(ws + OFF_WPG); g.ldb = D; g.N = D; g.K = D; g.epi = 10; }
        return true;
    default: return false;
    }
}

struct CJ { const float* src; int in_idx, src_ld, kv, n0, nv; long lstride; size_t dst; int dst_ld, r0, c0, npad, kpad, seg, segstride; };
constexpr int BIGSEG = 1 << 30;
__constant__ int JT_I[15][12] = {
    {3, NIN, 2048, NF, NGATE, D, 0, 0, NGATE, 2048, BIGSEG, 0},
    {3, NIN, 2048, 0, NF, D, NGATE, 0, 6656, 2048, BIGSEG, 0},
    {29, D, 1024, 0, D, D, 0, 0, D, 1024, BIGSEG, 0},
    {30, D, 512, 0, D, D, 0, 1024, D, 512, BIGSEG, 0},
    {31, D, 512, 0, D, D, 0, 1536, D, 512, BIGSEG, 0},
    {32, D, 2048, 0, D, D, 0, 0, D, 2048, BIGSEG, 0},
    {34, FH, 2048, 0, FH, D, 0, 0, FH, 2048, 128, 256},
    {35, FH, 2048, 0, FH, D, 128, 0, FH, 2048, 128, 256},
    {36, D, FH, 0, D, FH, 0, 0, D, FH, BIGSEG, 0},
    {38, D, 2048, 0, D, D, 0, 0, D, 2048, BIGSEG, 0},
    {39, D, 256, 0, D, 256, 0, 0, D, 256, BIGSEG, 0},
    {27, 512, 512, 0, 512, 512, 0, 0, 512, 512, BIGSEG, 0},
    {10, 512, 96, 0, 512, 256, 0, 0, 512, 256, BIGSEG, 0},
    {12, 512, 96, 0, 512, 256, 0, 0, 512, 256, BIGSEG, 0},
    {13, 512, 256, 0, 512, 256, 0, 0, 512, 256, BIGSEG, 0}};
__constant__ long JT_L[15][2] = {
    {(long)D * NIN, (long)OFF_WIN}, {(long)D * NIN, (long)OFF_WIN}, {(long)1024 * D, (long)OFF_WUP}, {(long)512 * D, (long)OFF_WUP}, {(long)512 * D, (long)OFF_WUP},
    {(long)D * D, (long)OFF_WO}, {(long)D * FH, (long)OFF_WGU}, {(long)D * FH, (long)OFF_WGU}, {(long)FH * D, (long)OFF_WD}, {(long)D * D, (long)OFF_WPG},
    {(long)256 * D, (long)OFF_WPP}, {(long)512 * 512, (long)OFF_WGLU}, {(long)96 * 512, (long)OFF_WW2}, {(long)96 * 512, (long)OFF_WA2}, {(long)256 * 512, (long)OFF_WG2}};
__device__ __forceinline__ void get_job(int j, CJ& J) {
    J.in_idx = JT_I[j][0]; J.src_ld = JT_I[j][1]; J.kv = JT_I[j][2]; J.n0 = JT_I[j][3]; J.nv = JT_I[j][4]; J.dst_ld = JT_I[j][5]; J.r0 = JT_I[j][6]; J.c0 = JT_I[j][7];
    J.npad = JT_I[j][8]; J.kpad = JT_I[j][9]; J.seg = JT_I[j][10]; J.segstride = JT_I[j][11]; J.lstride = JT_L[j][0]; J.dst = (size_t)JT_L[j][1];
}
__device__ __forceinline__ const float* in_by_idx(const Params& p, int i) { return P_IN(i); }
constexpr int NJOBS = 15;

__device__ __forceinline__ void conv_tile(int L, const CJ& J, int tile, int lane, bh* dstbase) {
    const int nkt = J.kpad / 64; const int tn = tile / nkt, tk = tile % nkt;
    const float* src = J.src + (size_t)L * J.lstride;
    const int cq = lane & 15, r = lane >> 4;
    const int nl = tn * 64 + cq * 4; const bool nok = nl < J.nv;
    const int k0 = tk * 64 + 16 * r;
    f32x4 v[16];
    const float* sp = src + (size_t)k0 * J.src_ld + J.n0 + nl;
    const float zc = OZ();
#pragma unroll
    for (int i = 0; i < 16; ++i) { v[i] = (f32x4){zc, zc, zc, zc}; if (nok && (k0 + i) < J.kv) v[i] = *(const f32x4*)(sp + (size_t)i * J.src_ld); }
#pragma unroll
    for (int j = 0; j < 4; ++j) { const int n = nl + j; const int drow = J.r0 + (n / J.seg) * J.segstride + (n % J.seg);
        u32x4 w0, w1;
        w0.x = cvt_pk_bf16(v[0][j], v[1][j]); w0.y = cvt_pk_bf16(v[2][j], v[3][j]); w0.z = cvt_pk_bf16(v[4][j], v[5][j]); w0.w = cvt_pk_bf16(v[6][j], v[7][j]);
        w1.x = cvt_pk_bf16(v[8][j], v[9][j]); w1.y = cvt_pk_bf16(v[10][j], v[11][j]); w1.z = cvt_pk_bf16(v[12][j], v[13][j]); w1.w = cvt_pk_bf16(v[14][j], v[15][j]);
        bh* d = dstbase + (size_t)drow * J.dst_ld + J.c0 + k0;
        *(u32x4*)d = w0; *(u32x4*)(d + 8) = w1; }
}

__device__ __forceinline__ void rms_row_bf16(const float* x, const float* g, bh* o, int lane) {
    f32x4 v[8]; float s = 0.f;
#pragma unroll
    for (int j = 0; j < 8; ++j) { v[j] = *(const f32x4*)(x + j * 256 + lane * 4); s += (v[j][0] * v[j][0] + v[j][1] * v[j][1]) + (v[j][2] * v[j][2] + v[j][3] * v[j][3]); }
    const float rstd = rsqrtf(wave_sum(s) * (1.0f / D) + 1e-6f);
#pragma unroll
    for (int j = 0; j < 8; ++j) { const f32x4 gg = *(const f32x4*)(g + j * 256 + lane * 4); u32x2 w; w.x = pk2(v[j][0] * rstd * gg[0], v[j][1] * rstd * gg[1]); w.y = pk2(v[j][2] * rstd * gg[2], v[j][3] * rstd * gg[3]);
        *(u32x2*)(o + j * 256 + lane * 4) = w; }
}
__device__ __forceinline__ void phase_rmsnorm(const Params& p, const float* g) {
    const int gw = BIDX() * 8 + (TIDX() >> 6), NGW = GDIM() * 8, lane = TIDX() & 63;
    bh* abf = (bh*)(P_WS + OFF_ABF);
    for (int r = gw; r < T; r += NGW) rms_row_bf16(P_OUT + (size_t)r * D, g, abf + (size_t)r * D, lane);
}

__device__ __forceinline__ void phase_conv(const Params& p, int L, LAS unsigned char* lds) {
    const int tid = TIDX();
    {   const int gw0 = BIDX() * 8 + (tid >> 6), NGW0 = GDIM() * 8, ln = tid & 63;
        int base = 0;
        for (int j = 0; j < NJOBS; ++j) { CJ J; get_job(j, J); J.src = in_by_idx(p, J.in_idx); const int ntile = (J.npad / 64) * (J.kpad / 64);
            int first = gw0 - (base % NGW0); if (first < 0) first += NGW0;
            bh* dstbase = (bh*)(P_WS + J.dst);
            for (int t = first; t < ntile; t += NGW0) conv_tile(L, J, t, ln, dstbase);
            base += ntile; } }
    const int gw = BIDX() * 8 + (tid >> 6), NGW = GDIM() * 8, lane = tid & 63;
    bh* abf = (bh*)(P_WS + OFF_ABF);
    if (L == 0) {
        const float* ps = P_IN(1); bh* pb = (bh*)(P_WS + OFF_PBF);
        for (size_t i = (size_t)BIDX() * 512 + tid; i < (size_t)2 * T * 256 / 4; i += (size_t)GDIM() * 512) { const f32x4 v = ((const f32x4*)ps)[i]; u32x2 w; w.x = pk2(v[0], v[1]); w.y = pk2(v[2], v[3]); ((u32x2*)pb)[i] = w; }
        const float* x = P_IN(0);
        for (int r = gw; r < T; r += NGW) {
#pragma unroll
            for (int j = 0; j < 8; ++j) *(f32x4*)(P_OUT + (size_t)r * D + j * 256 + lane * 4) = *(const f32x4*)(x + (size_t)r * D + j * 256 + lane * 4);
            rms_row_bf16(x + (size_t)r * D, P_IN(2), abf + (size_t)r * D, lane);
        }
    } else {
        for (int r = gw; r < T; r += NGW) rms_row_bf16(P_OUT + (size_t)r * D, P_IN(2) + (size_t)L * D, abf + (size_t)r * D, lane);
    }
}

struct S5C { float ar, ai; float br[16], bi[16]; };
__device__ __forceinline__ void s5_setup(const Params& p, int L, int g, int n, S5C& c) {
    const int gi = L * 32 + g;
    const float dt = __expf(P_IN(21)[gi]);
    const float are = P_IN(19)[gi * 64 + n], aim = P_IN(20)[gi * 64 + n];
    const float mag = __expf(are * dt), ang = aim * dt;
    float sn, cs;
    {
        const double a = (double)ang; const double k = rint(a * 0.15915494309189535); const float r = (float)(a - k * 6.283185307179586);
        sn = sinf(r); cs = cosf(r);
    }
    c.ar = mag * cs; c.ai = mag * sn;
    const float den = are * are + aim * aim, nr = c.ar - 1.0f, ni = c.ai;
    const float cr = (nr * are + ni * aim) / den, ci = (ni * are - nr * aim) / den;
    const float* bre = P_IN(22) + ((size_t)gi * 64 + n) * 16; const float* bim = P_IN(23) + ((size_t)gi * 64 + n) * 16;
#pragma unroll
    for (int q = 0; q < 4; ++q) { const f32x4 r4 = *(const f32x4*)(bre + q * 4), i4 = *(const f32x4*)(bim + q * 4);
#pragma unroll
        for (int j = 0; j < 4; ++j) { c.br[q * 4 + j] = cr * r4[j] - ci * i4[j]; c.bi[q * 4 + j] = cr * i4[j] + ci * r4[j]; } }
}
__device__ __forceinline__ void s5_step(const S5C& c, const LAS float* urow, float& sr, float& si) {
    float xr = 0.f, xi = 0.f;
#pragma unroll
    for (int q = 0; q < 4; ++q) { const f32x4 u4 = *(const LAS f32x4*)(urow + q * 4);
#pragma unroll
        for (int j = 0; j < 4; ++j) { xr = fmaf(u4[j], c.br[q * 4 + j], xr); xi = fmaf(u4[j], c.bi[q * 4 + j], xi); } }
    const float nr = c.ar * sr - c.ai * si + xr, ni = c.ar * si + c.ai * sr + xi;
    sr = nr; si = ni;
}
__device__ __forceinline__ void s5_stage_u(const float* zfc, LAS float* ul, int lane) {
    const float* src = zfc + (size_t)lane * ZF_LD;
    const f32x4 a = *(const f32x4*)src, b = *(const f32x4*)(src + 4), c = *(const f32x4*)(src + 8), d = *(const f32x4*)(src + 12);
    *(LAS f32x4*)(ul + lane * 16) = a; *(LAS f32x4*)(ul + lane * 16 + 4) = b; *(LAS f32x4*)(ul + lane * 16 + 8) = c; *(LAS f32x4*)(ul + lane * 16 + 12) = d;
    asm volatile("s_waitcnt lgkmcnt(0)" ::: "memory"); __builtin_amdgcn_wave_barrier();
}

__device__ __forceinline__ size_t fq_base(int h, int c, int mt, int ks8) { return ((((size_t)(h * NCH + c) * 4 + mt) * 8 + ks8) * 64) * 8; }
__device__ __forceinline__ size_t fq_off(int h, int t, int d) { const int s = t & 63; return fq_base(h, t >> 6, s >> 4, d >> 5) + ((s & 15) + 16 * ((d >> 3) & 3)) * 8 + (d & 7); }
__device__ __forceinline__ int ft_off(int row, int s8) { return ((((row >> 5) * 4 + (s8 >> 1)) * 64) + (row & 31) + 32 * (s8 & 1)) * 8; }

__device__ __forceinline__ void mlstm_prep(const Params& p, int L, int h, int c, LAS unsigned char* lds) {
    const int tid = TIDX(), t0 = c * 64;
    const float* zf = (const float*)(P_WS + OFF_ZF);
    LAS float* s_ws = (LAS float*)lds;
    if (tid < 64) {
        const int t = t0 + tid;
        float ig = zf[(size_t)t * ZF_LD + 4096 + h] + P_IN(5)[L * 4 + h];
        float fg = zf[(size_t)t * ZF_LD + 4100 + h] + P_IN(6)[L * 4 + h];
        ig = 15.0f * tanhf(ig * (1.0f / 15.0f)); fg = 15.0f * tanhf(fg * (1.0f / 15.0f));
        const float lf = fminf(fg, 0.f) - log1pf(__expf(-fabsf(fg)));
        float b = lf;
#pragma unroll
        for (int o = 1; o < 64; o <<= 1) { const float nb = bperm_f((tid - o) & 63, b); if (tid >= o) b += nb; }
        const float bend = bperm_f(63, b);
        const float wlog = bend - b + ig;
        const float mloc = wave_max(wlog);
        s_ws[tid] = __expf(wlog - mloc);
        ((float*)(P_WS + OFF_MI))[h * T + t] = ig; ((float*)(P_WS + OFF_MBB))[h * T + t] = b;
        if (tid == 0) { ((float*)(P_WS + OFF_MBEND))[h * NCH + c] = bend; ((float*)(P_WS + OFF_MLOC))[h * NCH + c] = mloc; }
    }
    __syncthreads();
    const int d = tid & 255, isk = tid >> 8;
    const int col = isk * 1024 + h * 256 + d;
    const float* cw = P_IN(4) + (size_t)L * 4 * 2048;
    const float w0 = cw[col], w1 = cw[2048 + col], w2 = cw[4096 + col], w3 = cw[6144 + col];
    float x1 = (t0 >= 1) ? zf[(size_t)(t0 - 1) * ZF_LD + col] : 0.f, x2 = (t0 >= 2) ? zf[(size_t)(t0 - 2) * ZF_LD + col] : 0.f, x3 = (t0 >= 3) ? zf[(size_t)(t0 - 3) * ZF_LD + col] : 0.f;
    bh* MQ = (bh*)(P_WS + OFF_MQ); bh* MK = (bh*)(P_WS + OFF_MK);
    bh* MT = (bh*)(P_WS + (isk ? OFF_MKT : OFF_MVT)) + (size_t)(h * NCH + c) * 16384;
    LAS bh* sQK = (LAS bh*)(lds + 1024);
    float dnacc = 0.f;
    for (int s8 = 0; s8 < 8; ++s8) {
        unsigned pk[4];
#pragma unroll
        for (int j = 0; j < 8; ++j) { const int s = s8 * 8 + j, t = t0 + s;
            const float x0 = zf[(size_t)t * ZF_LD + col]; float y = w0 * x0 + w1 * x1 + w2 * x2 + w3 * x3; x3 = x2; x2 = x1; x1 = x0;
            y = y * sigmoidf_(y);
            unsigned short e;
            if (!isk) { sQK[s * 264 + d] = f2bf(y * 0.0625f); e = f2bf(zf[(size_t)t * ZF_LD + 2048 + h * 256 + d]); }
            else { sQK[64 * 264 + s * 264 + d] = f2bf(y); const float wk = y * s_ws[s]; e = f2bf(wk); dnacc += wk; }
            if (j & 1) pk[j >> 1] |= ((unsigned)e << 16); else pk[j >> 1] = e; }
        u32x4 w; w.x = pk[0]; w.y = pk[1]; w.z = pk[2]; w.w = pk[3];
        *(u32x4*)(MT + ft_off(d, s8)) = w;
    }
    if (isk) ((float*)(P_WS + OFF_DN))[(size_t)(h * NCH + c) * 256 + d] = dnacc;
    __syncthreads();
#pragma unroll
    for (int i = 0; i < 8; ++i) { const int pid = i * 512 + tid, tens = pid >> 11, rem = pid & 2047, mt = rem >> 9, ks8 = (rem >> 6) & 7, lp = rem & 63;
        const u32x4 w = *(const LAS u32x4*)(sQK + tens * (64 * 264) + (mt * 16 + (lp & 15)) * 264 + ks8 * 32 + (lp >> 4) * 8);
        *(u32x4*)((tens ? MK : MQ) + fq_base(h, c, mt, ks8) + lp * 8) = w; }
    __syncthreads();
}

__device__ __forceinline__ void rwkv_prep_token(const Params& p, int L, int t, int lane) {
    const float* zf = (const float*)(P_WS + OFF_ZF);
    const float* z = zf + (size_t)t * ZF_LD + ZR0; const float* zp = z - ZF_LD; const bool hp = t > 0;
    const float* mu = P_IN(8) + (size_t)L * 1984;
    float* RR = (float*)(P_WS + OFF_RR); float* RK = (float*)(P_WS + OFF_RK); float* RV = (float*)(P_WS + OFF_RV); float* RKK = (float*)(P_WS + OFF_RKK);
    const float* kkw = P_IN(14) + L * 512;
#pragma unroll
    for (int i = 0; i < 8; ++i) { const int c = i * 64 + lane;
        { const float a = z[c], b = hp ? zp[c] : 0.f; RR[(size_t)t * 512 + c] = a + (b - a) * mu[c]; }
        { const float a = z[1024 + c], b = hp ? zp[1024 + c] : 0.f; RV[(size_t)t * 512 + c] = a + (b - a) * mu[1024 + c]; }
        { const float a = z[512 + c], b = hp ? zp[512 + c] : 0.f; const float k = a + (b - a) * mu[512 + c]; RK[(size_t)t * 512 + c] = k;
          const float kkv = k * kkw[c]; const float ss = wave_sum(kkv * kkv); RKK[(size_t)t * 512 + c] = kkv / fmaxf(sqrtf(ss), 1e-12f); } }
    bh* LAW = (bh*)(P_WS + OFF_LAW) + (size_t)t * 256; bh* LAA = (bh*)(P_WS + OFF_LAA) + (size_t)t * 256; bh* LAG = (bh*)(P_WS + OFF_LAG) + (size_t)t * 256;
#pragma unroll
    for (int i = 0; i < 4; ++i) { const int j = i * 64 + lane;
        float vw = 0.f, va = 0.f;
        if (j < 96) { { const int c = 1536 + j; const float a = z[c], b = hp ? zp[c] : 0.f; vw = tanhf(a + (b - a) * mu[c]); }
                      { const int c = 1632 + j; const float a = z[c], b = hp ? zp[c] : 0.f; va = a + (b - a) * mu[c]; } }
        LAW[j] = f2bf(vw); LAA[j] = f2bf(va);
        { const int c = 1728 + j; const float a = z[c], b = hp ? zp[c] : 0.f; LAG[j] = f2bf(sigmoidf_(a + (b - a) * mu[c])); } }
}

__device__ __forceinline__ void s5_pass_a(const Params& p, int L, int g, int c, int lane, LAS float* ul) {
    const float* zf = (const float*)(P_WS + OFF_ZF) + (size_t)(c * 64) * ZF_LD + ZS0 + g * 16;
    s5_stage_u(zf, ul, lane);
    S5C k; s5_setup(p, L, g, lane, k);
    float sr = 0.f, si = 0.f;
#pragma unroll 8
    for (int s = 0; s < 64; ++s) s5_step(k, ul + s * 16, sr, si);
    asm volatile("s_waitcnt lgkmcnt(0)" ::: "memory"); __builtin_amdgcn_wave_barrier();
    float* se = (float*)(P_WS + OFF_SEND) + ((size_t)(g * NCH + c) * 64 + lane) * 2;
    se[0] = sr; se[1] = si;
}

__device__ __forceinline__ void phase_prep(const Params& p, int L, LAS unsigned char* lds) {
    const int wid = TIDX() >> 6, lane = TIDX() & 63;
    for (int it = BIDX(); it < 2048; it += GDIM()) {
        if (it < 512) mlstm_prep(p, L, it >> 7, it & 127, lds);
        else if (it < 1536) rwkv_prep_token(p, L, (it - 512) * 8 + wid, lane);
        else { const int w = (it - 1536) * 8 + wid; s5_pass_a(p, L, w >> 7, w & 127, lane, (LAS float*)lds + wid * 1024); }
    }
}

constexpr int RW_NS = 4, RW_LS = T / RW_NS, RW_NB = RW_LS / 16, RW_RING = 4, RW_SLOT = 16 * 384;
constexpr int RW_YOFF = RW_RING * RW_SLOT;
__device__ __forceinline__ void rwkv_scan(const Params& p, int b, LAS unsigned char* lds) {
    const int tid = TIDX(), wid = __builtin_amdgcn_readfirstlane(tid >> 6), lane = tid & 63;
    int j, h, rg;
    if (b < 32) { j = 0; h = b >> 2; rg = b & 3; } else { const int u = b - 32; j = 1 + (u >> 6); h = (u & 63) >> 3; rg = u & 7; }
    LAS float* ring = (LAS float*)lds;
    LAS float* ybuf = ring + RW_YOFF;
    const int tbase = j * RW_LS;
    const bool isP = rg >= 4;
    if (wid >= 4) {
        const int lw = wid - 4, lt = tid - 256;
        const float* gp[6]; unsigned lo[6];
#pragma unroll
        for (int i = 0; i < 6; ++i) { const int ii = lw * 6 + i, rowidx = ii * 4 + (lane >> 4), step = rowidx / 6, a = rowidx % 6, q = lane & 15;
            const int ai = (0x205314 >> (4 * a)) & 0xf;
            gp[i] = (const float*)(P_WS + OFF_RR + (size_t)ai * SZ_R) + (size_t)(tbase + step) * 512 + h * 64 + q * 4;
            lo[i] = (unsigned)ii * 256u; }
        float* OUT = (float*)(P_WS + (isP ? OFF_RZ : OFF_RY)) + (size_t)(tbase + (lt >> 4)) * 512 + h * 64 + (rg & 3) * 16 + (lt & 15);
#define RW_ISSUE(bi, sl) do { _Pragma("unroll") for (int _i = 0; _i < 6; ++_i) \
        __builtin_amdgcn_global_load_lds((const unsigned*)(gp[_i] + (size_t)(bi) * 16 * 512), (LAS unsigned*)(ring + (sl) * RW_SLOT + lo[_i]), 16, 0, 0); } while (0)
        RW_ISSUE(0, 0); RW_ISSUE(1, 1); RW_ISSUE(2, 2);
        asm volatile("s_waitcnt vmcnt(12)" ::: "memory"); __builtin_amdgcn_s_barrier();
        int sl = 3;
        for (int ib = 0; ib < RW_NB; ++ib) {
            if (ib + 3 < RW_NB) RW_ISSUE(ib + 3, sl);
            sl = (sl == RW_RING - 1) ? 0 : sl + 1;
            if (ib > 0) {
                const LAS float* yb = ybuf + ((ib - 1) & 1) * 4096 + lt * 16;
                const f32x4 a0 = *(const LAS f32x4*)yb, a1 = *(const LAS f32x4*)(yb + 4), a2 = *(const LAS f32x4*)(yb + 8), a3 = *(const LAS f32x4*)(yb + 12);
                const f32x4 sm = (a0 + a1) + (a2 + a3);
                OUT[(size_t)(ib - 1) * 16 * 512] = (sm[0] + sm[1]) + (sm[2] + sm[3]);
            }
            if (ib + 3 < RW_NB) asm volatile("s_waitcnt vmcnt(13)" ::: "memory");
            else asm volatile("s_waitcnt vmcnt(0)" ::: "memory");
            __builtin_amdgcn_s_barrier();
        }
        {   const LAS float* yb = ybuf + ((RW_NB - 1) & 1) * 4096 + lt * 16;
            const f32x4 a0 = *(const LAS f32x4*)yb, a1 = *(const LAS f32x4*)(yb + 4), a2 = *(const LAS f32x4*)(yb + 8), a3 = *(const LAS f32x4*)(yb + 12);
            const f32x4 sm = (a0 + a1) + (a2 + a3);
            OUT[(size_t)(RW_NB - 1) * 16 * 512] = (sm[0] + sm[1]) + (sm[2] + sm[3]); }
#undef RW_ISSUE
    } else {
        const int r16 = wid * 4 + (lane >> 4), kq = lane & 15, row = (rg & 3) * 16 + r16;
        f32x4 S;
#pragma unroll
        for (int e = 0; e < 4; ++e) S[e] = (isP && (kq * 4 + e == row)) ? 1.f : 0.f;
        const float vmask = isP ? 0.f : 1.f;
        __builtin_amdgcn_s_barrier();
        int sl = 0;
        for (int ib = 0; ib < RW_NB; ++ib) {
            const LAS float* bb = ring + sl * RW_SLOT;
            LAS float* yw = ybuf + (ib & 1) * 4096 + r16 * 16 + kq;
            f32x4 w4 = *(const LAS f32x4*)(bb + kq * 4), k4 = *(const LAS f32x4*)(bb + 64 + kq * 4), kk4 = *(const LAS f32x4*)(bb + 128 + kq * 4),
                  b4 = *(const LAS f32x4*)(bb + 192 + kq * 4), r4 = *(const LAS f32x4*)(bb + 256 + kq * 4);
            float vv = bb[320 + row];
#pragma unroll
            for (int s = 0; s < 16; ++s) {
                f32x4 w4n, k4n, kk4n, b4n, r4n; float vvn;
                if (s < 15) { const LAS float* q = bb + (s + 1) * 384;
                    w4n = *(const LAS f32x4*)(q + kq * 4); k4n = *(const LAS f32x4*)(q + 64 + kq * 4); kk4n = *(const LAS f32x4*)(q + 128 + kq * 4);
                    b4n = *(const LAS f32x4*)(q + 192 + kq * 4); r4n = *(const LAS f32x4*)(q + 256 + kq * 4); vvn = q[320 + row]; }
                __builtin_amdgcn_sched_barrier(0);
                float pd = fmaf(S[0], kk4[0], fmaf(S[1], kk4[1], fmaf(S[2], kk4[2], S[3] * kk4[3])));
                const f32x4 pre = S * w4 + (vv * vmask) * k4;
                pd = allreduce16(pd);
                S = pre + pd * b4;
                yw[s * 256] = fmaf(S[0], r4[0], fmaf(S[1], r4[1], fmaf(S[2], r4[2], S[3] * r4[3])));
                if (s < 15) { w4 = w4n; k4 = k4n; kk4 = kk4n; b4 = b4n; r4 = r4n; vv = vvn; }
            }
            sl = (sl == RW_RING - 1) ? 0 : sl + 1;
            asm volatile("s_waitcnt lgkmcnt(0)" ::: "memory");
            __builtin_amdgcn_s_barrier();
        }
        float* EN = (float*)(P_WS + (isP ? OFF_RPEND : OFF_RSEND)) + ((size_t)(h * 4 + j) * 64 + row) * 64 + kq * 4;
        *(f32x4*)EN = S;
    }
    __syncthreads();
}

struct MStage { bf16x8 q[4], k[4], v[4]; float bend, mloc; };
__device__ __forceinline__ void mstage_load(MStage& st, const bh* qp, const bh* kp, const bh* vp, const float* MBEND, const float* MLOC, int h, int c) {
#pragma unroll
    for (int ks = 0; ks < 4; ++ks) { st.q[ks] = *(const bf16x8*)(qp + (size_t)c * 16384 + ks * 512); st.k[ks] = *(const bf16x8*)(kp + (size_t)c * 16384 + ks * 512); st.v[ks] = *(const bf16x8*)(vp + (size_t)c * 16384 + ks * 512); }
    st.bend = MBEND[h * NCH + c]; st.mloc = MLOC[h * NCH + c];
}
__device__ __forceinline__ void mlstm_seq(const Params& p, int mb, LAS unsigned char* lds) {
    const int tid = TIDX(), wid = tid >> 6, lane = tid & 63;
    const int h = mb >> 3, jv = mb & 7;
    LAS bh* Cbf = (LAS bh*)lds;
    constexpr int CS = 264;
    for (int i = tid; i < 2 * 32 * CS / 2; i += 512) ((LAS unsigned*)Cbf)[i] = 0u;
    __syncthreads();
    const bh* MQ = (const bh*)(P_WS + OFF_MQ); const bh* MKT = (const bh*)(P_WS + OFF_MKT); const bh* MVT = (const bh*)(P_WS + OFF_MVT);
    const float* MBEND = (const float*)(P_WS + OFF_MBEND); const float* MLOC = (const float*)(P_WS + OFF_MLOC);
    f32x16 ct;
    { const float z = OZ();
#pragma unroll
    for (int i = 0; i < 16; ++i) ct[i] = z; }
    float m = 0.f;
    const int mt = wid >> 1, kh = wid & 1;
    float* MINTER = (float*)(P_WS + OFF_ABF);
    LAS float* It = (LAS float*)(lds + 2 * 32 * 264 * 2);
    const bh* qp = MQ + fq_base(h, 0, mt, kh * 4) + lane * 8;
    const bh* kp = MKT + (size_t)(h * NCH) * 16384 + (wid * 4 * 64 + lane) * 8;
    const bh* vp = MVT + (size_t)(h * NCH) * 16384 + (jv * 4 * 64 + lane) * 8;
    MStage s0, s1, s2;
    mstage_load(s0, qp, kp, vp, MBEND, MLOC, h, 0);
    mstage_load(s1, qp, kp, vp, MBEND, MLOC, h, 1);
#define MSTEP(SC, SL, CIDX) do { const int c = (CIDX); const int t0 = c * 64, cur = c & 1; \
        mstage_load(SL, qp, kp, vp, MBEND, MLOC, h, (c + 2 < NCH) ? c + 2 : NCH - 1); \
        const float mnew = fmaxf(SC.bend + m, SC.mloc), decay = __expf(SC.bend + m - mnew), scale = __expf(SC.mloc - mnew); \
        f32x4 r0 = {0.f, 0.f, 0.f, 0.f}, r1 = {0.f, 0.f, 0.f, 0.f}; \
        const LAS bh* cb = Cbf + cur * 32 * CS + (lane & 15) * CS + kh * 128 + (lane >> 4) * 8; \
        _Pragma("unroll") for (int ks = 0; ks < 4; ++ks) { const bf16x8 b0 = *(const LAS bf16x8*)(cb + ks * 32), b1 = *(const LAS bf16x8*)(cb + 16 * CS + ks * 32); r0 = MFMA16(SC.q[ks], b0, r0); r1 = MFMA16(SC.q[ks], b1, r1); } \
        {     \
            if (c > 0) { const LAS float* ip = It + ((c - 1) & 1) * (2 * 64 * 36) + (tid >> 3) * 36 + (tid & 7) * 4; \
                const f32x4 sv = *(const LAS f32x4*)ip + *(const LAS f32x4*)(ip + 64 * 36); \
                float* o = MINTER + (size_t)(t0 - 64 + (tid >> 3)) * 1024 + h * 256 + jv * 32 + (tid & 7) * 4; \
                asm volatile("global_store_dwordx4 %0, %1, off\n\ts_nop 1" :: "v"(o), "v"(sv) : "memory"); } \
            LAS float* iw = It + cur * (2 * 64 * 36) + kh * (64 * 36) + (mt * 16 + (lane >> 4) * 4) * 36 + (lane & 15); \
            _Pragma("unroll") for (int r = 0; r < 4; ++r) { iw[r * 36] = r0[r]; iw[r * 36 + 16] = r1[r]; } } \
        f32x16 d0; { const float z = OZ(); _Pragma("unroll") for (int i = 0; i < 16; ++i) d0[i] = z; } \
        _Pragma("unroll") for (int ks = 0; ks < 4; ++ks) d0 = MFMA32(SC.k[ks], SC.v[ks], d0); \
        _Pragma("unroll") for (int i = 0; i < 16; ++i) ct[i] = decay * ct[i] + scale * d0[i]; \
        m = mnew; \
        {   LAS bh* o0 = Cbf + (cur ^ 1) * 32 * CS + (lane & 31) * CS + wid * 32 + 4 * (lane >> 5); \
            _Pragma("unroll") for (int g = 0; g < 4; ++g) { u32x2 w0; w0.x = cvt_pk_bf16(ct[4 * g], ct[4 * g + 1]); w0.y = cvt_pk_bf16(ct[4 * g + 2], ct[4 * g + 3]); *(LAS u32x2*)(o0 + 8 * g) = w0; } } \
        asm volatile("s_waitcnt lgkmcnt(0)" ::: "memory"); __builtin_amdgcn_s_barrier(); asm volatile("" ::: "memory"); } while (0)
    for (int c3 = 0; c3 < 126; c3 += 6) { MSTEP(s0, s2, c3); MSTEP(s1, s0, c3 + 1); MSTEP(s2, s1, c3 + 2); MSTEP(s0, s2, c3 + 3); MSTEP(s1, s0, c3 + 4); MSTEP(s2, s1, c3 + 5); }
    MSTEP(s0, s2, 126); MSTEP(s1, s0, 127);
#undef MSTEP
    {   const LAS float* ip = It + (127 & 1) * (2 * 64 * 36) + (tid >> 3) * 36 + (tid & 7) * 4;
        const f32x4 sv = *(const LAS f32x4*)ip + *(const LAS f32x4*)(ip + 64 * 36);
        *(f32x4*)(MINTER + (size_t)(127 * 64 + (tid >> 3)) * 1024 + h * 256 + jv * 32 + (tid & 7) * 4) = sv; }
    asm volatile("s_waitcnt vmcnt(0)" ::: "memory");
    __syncthreads();
}

__device__ __forceinline__ void mlstm_nscan(const Params& p) {
    const float* MBEND = (const float*)(P_WS + OFF_MBEND); const float* MLOC = (const float*)(P_WS + OFF_MLOC);
    const float* DN = (const float*)(P_WS + OFF_DN); float* NST = (float*)(P_WS + OFF_NST); float* MSTART = (float*)(P_WS + OFF_MSTART);
    for (int idx = TIDX(); idx < 1024; idx += 512) { const int h = idx >> 8, d = idx & 255; float m = 0.f, n = 0.f;
#pragma unroll 8
        for (int c = 0; c < NCH; ++c) { if (d == 0) MSTART[h * NCH + c] = m; NST[(size_t)(h * NCH + c) * 256 + d] = n;
            const float bend = MBEND[h * NCH + c], mloc = MLOC[h * NCH + c]; const float mnew = fmaxf(bend + m, mloc);
            n = __expf(bend + m - mnew) * n + __expf(mloc - mnew) * DN[(size_t)(h * NCH + c) * 256 + d]; m = mnew; } }
}

__device__ __forceinline__ float gelu_tanh(float x) { const float u = 0.7978845608028654f * (x + 0.044715f * x * x * x); return 0.5f * x * (1.0f + tanhf(u)); }

__device__ __forceinline__ void s5_pass_c(const Params& p, int L, int g, int c, int lane, LAS bh* img, LAS float* ul) {
    const float* zf = (const float*)(P_WS + OFF_ZF) + (size_t)(c * 64) * ZF_LD + ZS0 + g * 16;
    s5_stage_u(zf, ul, lane);
    S5C k; s5_setup(p, L, g, lane, k);
    float sr = 0.f, si = 0.f;
    {   float pr = k.ar, pi = k.ai;
#pragma unroll
        for (int i = 0; i < 6; ++i) { const float nr = pr * pr - pi * pi, ni = 2.f * pr * pi; pr = nr; pi = ni; }
        const float* se = (const float*)(P_WS + OFF_SEND) + ((size_t)(g * NCH) * 64 + lane) * 2;
        int cc = 0;
        for (; cc + 8 <= c; cc += 8) { float er[8], ei[8];
#pragma unroll
            for (int j = 0; j < 8; ++j) { er[j] = se[(size_t)(cc + j) * 128]; ei[j] = se[(size_t)(cc + j) * 128 + 1]; }
#pragma unroll
            for (int j = 0; j < 8; ++j) { const float nr = pr * sr - pi * si + er[j], ni = pr * si + pi * sr + ei[j]; sr = nr; si = ni; } }
        for (; cc < c; ++cc) { const float er = se[(size_t)cc * 128], ei = se[(size_t)cc * 128 + 1];
            const float nr = pr * sr - pi * si + er, ni = pr * si + pi * sr + ei; sr = nr; si = ni; } }
    const int gi = L * 32 + g;
    bf16x8 bfr[4];
    {   const int pp = lane & 15; const float* cre = P_IN(24) + ((size_t)gi * 16 + pp) * 64; const float* cim = P_IN(25) + ((size_t)gi * 16 + pp) * 64;
#pragma unroll
        for (int ks = 0; ks < 4; ++ks)
#pragma unroll
            for (int j = 0; j < 8; ++j) { const int n2 = ks * 32 + (lane >> 4) * 8 + j; const float v = (n2 < 64) ? cre[n2] : -cim[n2 - 64]; bfr[ks][j] = (short)f2bf(v); } }
    const float dco = P_IN(26)[L * 512 + g * 16 + (lane & 15)];
    bh* YS = (bh*)(P_WS + OFF_YS);
    for (int half = 0; half < 2; ++half) {
#pragma unroll 8
        for (int s = 0; s < 32; ++s) { s5_step(k, ul + (half * 32 + s) * 16, sr, si); img[s * 136 + lane] = f2bf(sr); img[s * 136 + 64 + lane] = f2bf(si); }
        asm volatile("s_waitcnt lgkmcnt(0)" ::: "memory"); __builtin_amdgcn_wave_barrier();
#pragma unroll
        for (int mt = 0; mt < 2; ++mt) { f32x4 acc = {0.f, 0.f, 0.f, 0.f};
#pragma unroll
            for (int ks = 0; ks < 4; ++ks) { const bf16x8 a = *(const LAS bf16x8*)(img + (mt * 16 + (lane & 15)) * 136 + ks * 32 + (lane >> 4) * 8); acc = MFMA16(a, bfr[ks], acc); }
#pragma unroll
            for (int r = 0; r < 4; ++r) { const int tt = half * 32 + mt * 16 + (lane >> 4) * 4 + r; const float uv = ul[tt * 16 + (lane & 15)];
                YS[(size_t)(c * 64 + tt) * 512 + g * 16 + (lane & 15)] = f2bf(gelu_tanh(acc[r] + dco * uv)); } }
        asm volatile("s_waitcnt lgkmcnt(0)" ::: "memory"); __builtin_amdgcn_wave_barrier();
    }
}

__device__ __forceinline__ void phase_scan(const Params& p, int L, LAS unsigned char* lds) {
    const int b = BIDX();
    if (b < 224) { for (int rr = 0; rr < PROBE_RW; ++rr) rwkv_scan(p, b, lds); }
    else { for (int rr = 0; rr < PROBE_ML; ++rr) mlstm_seq(p, b - 224, lds); }
}
__device__ __forceinline__ void phase_s5c(const Params& p, int L, LAS unsigned char* lds) {
    const int b = BIDX(), wid = TIDX() >> 6, lane = TIDX() & 63;
    if (b == GDIM() - 1) mlstm_nscan(p);
    const int nw = GDIM() * 8;
    for (int w = b * 8 + wid; w < 32 * NCH; w += nw) s5_pass_c(p, L, w >> 7, w & 127, lane, (LAS bh*)lds + wid * (32 * 136), (LAS float*)(lds + 69632) + wid * 1024);
    __syncthreads();
}

__device__ __forceinline__ void mlstm_out(const Params& p, int L, int h, int c, LAS unsigned char* lds) {
    const int tid = TIDX(), wid = tid >> 6, lane = tid & 63, t0 = c * 64;
    LAS bh* Pl = (LAS bh*)lds;
    LAS float* s_b = (LAS float*)(lds + 9216); LAS float* s_a = s_b + 64; LAS float* s_mt = s_a + 64; LAS float* s_iw = s_mt + 64; LAS float* s_den = s_iw + 64; LAS float* s_qn = s_den + 64; LAS float* s_part = s_qn + 64;
    const bh* MQ = (const bh*)(P_WS + OFF_MQ); const bh* MK = (const bh*)(P_WS + OFF_MK); const bh* MVT = (const bh*)(P_WS + OFF_MVT);
    const float* MINTER = (const float*)(P_WS + OFF_ABF);
    const float m0 = ((const float*)(P_WS + OFF_MSTART))[h * NCH + c];
    if (tid < 64) { const float ig = ((const float*)(P_WS + OFF_MI))[h * T + t0 + tid], b = ((const float*)(P_WS + OFF_MBB))[h * T + t0 + tid];
        const float a = ig - b; float cm = a;
#pragma unroll
        for (int o = 1; o < 64; o <<= 1) { const float nb = bperm_f((tid - o) & 63, cm); if (tid >= o) cm = fmaxf(cm, nb); }
        const float mt = b + fmaxf(m0, cm);
        s_b[tid] = b; s_a[tid] = a; s_mt[tid] = mt; s_iw[tid] = __expf(b + m0 - mt); }
    __syncthreads();
    {
        const int mt = wid >> 1, nt0 = (wid & 1) * 2;
        f32x4 r0 = {0.f, 0.f, 0.f, 0.f}, r1 = {0.f, 0.f, 0.f, 0.f};
        const bh* qp = MQ + fq_base(h, c, mt, 0) + lane * 8;
        const bh* kp = MK + fq_base(h, c, nt0, 0) + lane * 8;
#pragma unroll
        for (int ks = 0; ks < 8; ++ks) { const bf16x8 a = *(const bf16x8*)(qp + ks * 512); const bf16x8 b0 = *(const bf16x8*)(kp + ks * 512), b1 = *(const bf16x8*)(kp + 8 * 512 + ks * 512);
            r0 = MFMA16(a, b0, r0); r1 = MFMA16(a, b1, r1); }
#pragma unroll
        for (int r = 0; r < 4; ++r) { const int t = mt * 16 + (lane >> 4) * 4 + r; const float bt = s_b[t] - s_mt[t];
            { const int s = nt0 * 16 + (lane & 15); const float pv = (s <= t) ? r0[r] * __expf(bt + s_a[s]) : 0.f; Pl[t * 72 + s] = f2bf(pv); }
            { const int s = nt0 * 16 + 16 + (lane & 15); const float pv = (s <= t) ? r1[r] * __expf(bt + s_a[s]) : 0.f; Pl[t * 72 + s] = f2bf(pv); } }
    }
    __syncthreads();
    if (tid < 64) { float s = 0.f;
#pragma unroll
        for (int q = 0; q < 8; ++q) { const u32x4 w = *(const LAS u32x4*)(Pl + tid * 72 + q * 8);
            s += __uint_as_float(w.x << 16) + __uint_as_float(w.x & 0xffff0000u) + __uint_as_float(w.y << 16) + __uint_as_float(w.y & 0xffff0000u)
               + __uint_as_float(w.z << 16) + __uint_as_float(w.z & 0xffff0000u) + __uint_as_float(w.w << 16) + __uint_as_float(w.w & 0xffff0000u); }
        s_den[tid] = s; }
    {
        const float* nst = (const float*)(P_WS + OFF_NST) + (size_t)(h * NCH + c) * 256 + lane * 4; const f32x4 nv = *(const f32x4*)nst;
#pragma unroll
        for (int i = 0; i < 8; ++i) { const int t = wid * 8 + i; const u32x2 q2 = *(const u32x2*)(MQ + fq_off(h, t0 + t, lane * 4));
            float s = __uint_as_float(q2.x << 16) * nv[0] + __uint_as_float(q2.x & 0xffff0000u) * nv[1] + __uint_as_float(q2.y << 16) * nv[2] + __uint_as_float(q2.y & 0xffff0000u) * nv[3];
            s = wave_sum(s); if (lane == 0) s_qn[t] = s; } }
    f32x4 acc[4][2];
#pragma unroll
    for (int a = 0; a < 4; ++a) { const float z = OZ(); acc[a][0] = (f32x4){z, z, z, z}; acc[a][1] = (f32x4){z, z, z, z}; }
    {   const bh* vp = MVT + (size_t)(h * NCH + c) * 16384;
#pragma unroll
        for (int ks = 0; ks < 2; ++ks) { const bf16x8 b0 = *(const bf16x8*)(vp + ft_off(wid * 32 + (lane & 15), ks * 4 + (lane >> 4))), b1 = *(const bf16x8*)(vp + ft_off(wid * 32 + 16 + (lane & 15), ks * 4 + (lane >> 4)));
#pragma unroll
            for (int a = 0; a < 4; ++a) { const bf16x8 av = *(const LAS bf16x8*)(Pl + (a * 16 + (lane & 15)) * 72 + ks * 32 + (lane >> 4) * 8);
                acc[a][0] = MFMA16(av, b0, acc[a][0]); acc[a][1] = MFMA16(av, b1, acc[a][1]); } } }
    __syncthreads();
#pragma unroll
    for (int a = 0; a < 4; ++a)
#pragma unroll
        for (int r = 0; r < 4; ++r) { const int t = a * 16 + (lane >> 4) * 4 + r; const float iw = s_iw[t];
            const float den = s_den[t] + iw * s_qn[t]; const float dd = 1.0f / fmaxf(fabsf(den), __expf(-s_mt[t]));
            const float* mi = MINTER + (size_t)(t0 + t) * 1024 + h * 256 + wid * 32 + (lane & 15);
            const float h0 = (acc[a][0][r] + iw * mi[0]) * dd, h1 = (acc[a][1][r] + iw * mi[16]) * dd;
            acc[a][0][r] = h0; acc[a][1][r] = h1;
            float ss = h0 * h0 + h1 * h1;
            ss = allreduce16(ss);
            if ((lane & 15) == 0) s_part[wid * 64 + t] = ss; }
    __syncthreads();
    {   const float* zf = (const float*)(P_WS + OFF_ZF); const float* ng = P_IN(7) + L * 1024 + h * 256; bh* YC = (bh*)(P_WS + OFF_YCAT);
#pragma unroll
        for (int a = 0; a < 4; ++a)
#pragma unroll
            for (int r = 0; r < 4; ++r) { const int t = a * 16 + (lane >> 4) * 4 + r;
                float tot = 0.f;
#pragma unroll
                for (int w = 0; w < 8; ++w) tot += s_part[w * 64 + t];
                const float rstd = rsqrtf(tot * (1.0f / 256.0f) + 1e-6f);
                const int v0 = wid * 32 + (lane & 15);
                const float* op = zf + (size_t)(t0 + t) * ZF_LD + 3072 + h * 256 + v0;
                bh* yo = YC + (size_t)(t0 + t) * D + h * 256 + v0;
                yo[0] = f2bf(sigmoidf_(op[0]) * acc[a][0][r] * rstd * ng[v0]);
                yo[16] = f2bf(sigmoidf_(op[16]) * acc[a][1][r] * rstd * ng[v0 + 16]); } }
    __syncthreads();
}

__device__ __forceinline__ void rwkv_post(const Params& p, int L, int it, LAS unsigned char* lds) {
    const int tid = TIDX(), wid = tid >> 6, lane = tid & 63;
    const int h = it & 7, blk = it >> 3, j = blk >> 3;
    LAS float* bufA = (LAS float*)lds;
    LAS float* bufB = bufA + 64 * 65;
    LAS float* bufP = bufB + 64 * 65;
    const float* SE = (const float*)(P_WS + OFF_RSEND) + (size_t)(h * 4) * 4096; const float* PE = (const float*)(P_WS + OFF_RPEND) + (size_t)(h * 4) * 4096;
    LAS float* sst = bufA;
    if (j >= 1) {
        const int v = tid >> 3, k8 = (tid & 7) * 8;
        { const f32x4 a0 = *(const f32x4*)(SE + v * 64 + k8), a1 = *(const f32x4*)(SE + v * 64 + k8 + 4);
#pragma unroll
          for (int e = 0; e < 4; ++e) { bufA[v * 65 + k8 + e] = a0[e]; bufA[v * 65 + k8 + 4 + e] = a1[e]; } }
        for (int jj = 1; jj < j; ++jj) {
            { const f32x4 p0 = *(const f32x4*)(PE + (size_t)jj * 4096 + v * 64 + k8), p1 = *(const f32x4*)(PE + (size_t)jj * 4096 + v * 64 + k8 + 4);
              *(LAS f32x4*)(bufP + v * 64 + k8) = p0; *(LAS f32x4*)(bufP + v * 64 + k8 + 4) = p1; }
            __syncthreads();
            LAS float* src = (jj & 1) ? bufA : bufB; LAS float* dst = (jj & 1) ? bufB : bufA;
            f32x4 c0 = *(const f32x4*)(SE + (size_t)jj * 4096 + v * 64 + k8), c1 = *(const f32x4*)(SE + (size_t)jj * 4096 + v * 64 + k8 + 4);
#pragma unroll 8
            for (int i = 0; i < 64; ++i) { const float a = src[v * 65 + i]; const f32x4 p0 = *(const LAS f32x4*)(bufP + i * 64 + k8), p1 = *(const LAS f32x4*)(bufP + i * 64 + k8 + 4); c0 += a * p0; c1 += a * p1; }
#pragma unroll
            for (int e = 0; e < 4; ++e) { dst[v * 65 + k8 + e] = c0[e]; dst[v * 65 + k8 + 4 + e] = c1[e]; }
            __syncthreads();
            sst = dst;
        }
        __syncthreads();
    }
    float srow[64];
    if (j >= 1) {
#pragma unroll
        for (int i = 0; i < 64; ++i) srow[i] = sst[lane * 65 + i];
    } else {
#pragma unroll
        for (int i = 0; i < 64; ++i) srow[i] = 0.f;
    }
    const int c = h * 64 + lane;
    const float rkw = P_IN(16)[L * 512 + c], lg = P_IN(17)[L * 512 + c], lb = P_IN(18)[L * 512 + c];
    const float* RY = (const float*)(P_WS + OFF_RY); const float* RZ = (const float*)(P_WS + OFF_RZ); const float* RR = (const float*)(P_WS + OFF_RR); const float* RK = (const float*)(P_WS + OFF_RK);
    const float* RV = (const float*)(P_WS + OFF_RV); const float* RG = (const float*)(P_WS + OFF_RG); bh* YC = (bh*)(P_WS + OFF_YCAT);
    for (int i = 0; i < 32; ++i) { const int t = blk * 256 + wid * 32 + i; const size_t o = (size_t)t * 512 + c;
        float y = RY[o];
        if (j >= 1) { const float z = RZ[o]; float y2 = 0.f;
#pragma unroll
            for (int q = 0; q < 64; q += 2) { y = fmaf(srow[q], __builtin_bit_cast(float, __builtin_amdgcn_readlane(__builtin_bit_cast(int, z), q)), y);
                                              y2 = fmaf(srow[q + 1], __builtin_bit_cast(float, __builtin_amdgcn_readlane(__builtin_bit_cast(int, z), q + 1)), y2); }
            y += y2; }
        const float mu = wave_sum(y) * (1.0f / 64.0f); const float dlt = y - mu; const float var = wave_sum(dlt * dlt) * (1.0f / 64.0f);
        const float yn = dlt * rsqrtf(var + 64e-5f) * lg + lb;
        const float bon = wave_sum(RR[o] * RK[o] * rkw) * RV[o];
        YC[(size_t)t * D + 1024 + c] = f2bf((yn + bon) * RG[o]); }
    __syncthreads();
}

__device__ __forceinline__ void phase_post(const Params& p, int L, LAS unsigned char* lds) {
    for (int it = BIDX(); it < 768; it += GDIM()) {
        if (it < 512) mlstm_out(p, L, it >> 7, it & 127, lds);
        else rwkv_post(p, L, it - 512, lds);
    }
    __syncthreads();
}

#define XB_TMO      128
#define XB_XCNT(j)  (256  + 64 * (j))
#define XB_XSUB(j)  (1280 + 64 * (j))
#define XB_XGEN(j)  (2304 + 64 * (j))
#define XB_TOP      3328
#define XB_TOPGEN   3392
#define XCD_BAR_WORDS 3456
#define XB_SPIN_CAP (1u << 18)

__device__ __forceinline__ unsigned xb_ld(unsigned* p)              { return __hip_atomic_load(p, __ATOMIC_RELAXED, __HIP_MEMORY_SCOPE_AGENT); }
__device__ __forceinline__ unsigned xb_add(unsigned* p, unsigned v) { return __hip_atomic_fetch_add(p, v, __ATOMIC_RELAXED, __HIP_MEMORY_SCOPE_AGENT); }
__device__ __forceinline__ unsigned xb_xcc_id() { return (unsigned)__builtin_amdgcn_s_getreg((3 << 11) | 20) & 0xFu; }
#define XB_SPIN(cond, bar) do { unsigned _sp = 0; while (cond) { __builtin_amdgcn_s_sleep(1); \
    if ((++_sp & 255u) == 0u) { if (xb_ld(&(bar)[XB_TMO])) break; if (_sp > XB_SPIN_CAP) { atomicAdd(&(bar)[XB_TMO], 1u); break; } } } } while (0)

struct XcdBarrier {
    unsigned* bar; unsigned x;
    volatile LAS unsigned* st;
};

__device__ __forceinline__ XcdBarrier xcd_barrier_post(unsigned* bar, volatile LAS unsigned* st) {
    XcdBarrier b; b.bar = bar; b.x = xb_xcc_id(); b.st = st;
    if (threadIdx.x == 0) (void)xb_add(&bar[XB_XCNT(b.x)], 1u);
    return b;
}
__device__ __forceinline__ void xcd_barrier_complete(unsigned* bar, unsigned x, unsigned& nloc, unsigned& nx) {
    const unsigned G = gridDim.x * gridDim.y * gridDim.z;
    unsigned sum, cnt, mine, sp = 0u;
    for (;;) {
        sum = 0u; cnt = 0u; mine = 0u;
#pragma unroll
        for (unsigned j = 0; j < 16; ++j) { const unsigned c = xb_ld(&bar[XB_XCNT(j)]); sum += c; cnt += (c > 0u) ? 1u : 0u; mine = (j == x) ? c : mine; }
        if (sum == G) break;
        __builtin_amdgcn_s_sleep(1);
        if ((++sp & 255u) == 0u) { if (xb_ld(&bar[XB_TMO])) break; if (sp > XB_SPIN_CAP) { atomicAdd(&bar[XB_TMO], 1u); break; } }
    }
    nloc = mine > 0u ? mine : 1u; nx = cnt > 0u ? cnt : 1u;
}

__device__ __forceinline__ void xcd_barrier(const XcdBarrier& b) {
    asm volatile("s_waitcnt vmcnt(0)" ::: "memory");
    __syncthreads();
    if (threadIdx.x == 0) {
        unsigned* bar = b.bar;
        __builtin_amdgcn_s_waitcnt(0);
        unsigned nloc = b.st[0], nx = b.st[1];
        if (nloc == 0u) { xcd_barrier_complete(bar, b.x, nloc, nx); b.st[0] = nloc; b.st[1] = nx; }
        const unsigned old = xb_add(&bar[XB_XSUB(b.x)], 1u);
        const unsigned gen = old / nloc;
        if (old + 1u == (gen + 1u) * nloc) {
            __builtin_amdgcn_fence(__ATOMIC_RELEASE, "agent");
            asm volatile("s_waitcnt vmcnt(0)" ::: "memory");
            const unsigned og = xb_add(&bar[XB_TOP], 1u);
            const unsigned tg = og / nx;
            if (og + 1u == (tg + 1u) * nx) xb_add(&bar[XB_TOPGEN], 1u);
            else XB_SPIN(xb_ld(&bar[XB_TOPGEN]) == tg, bar);
            __builtin_amdgcn_fence(__ATOMIC_ACQUIRE, "agent");
            xb_add(&bar[XB_XGEN(b.x)], 1u);
            asm volatile("s_waitcnt vmcnt(0)" ::: "memory");
        } else {
            XB_SPIN(xb_ld(&bar[XB_XGEN(b.x)]) == gen, bar);
            __builtin_amdgcn_fence(__ATOMIC_ACQUIRE, "agent");
            asm volatile("s_waitcnt vmcnt(0)" ::: "memory");
        }
    }
    __syncthreads();
}


constexpr int NPHASE = 27;
__global__ void __launch_bounds__(512, 2) hybrid_fwd(Params p, int ph_lo, int ph_hi, int rep_q) {
    extern __shared__ __attribute__((aligned(16))) unsigned char smem_raw[];
    LAS unsigned char* lds = (LAS unsigned char*)smem_raw;
    cg::grid_group grid = cg::this_grid();
    volatile LAS unsigned* xst = (volatile LAS unsigned*)(lds + 131072);
    if (threadIdx.x < 2) xst[threadIdx.x] = 0u;
    __syncthreads();
    { XcdBarrier b0 = xcd_barrier_post((unsigned*)(P_WS + OFF_BAR), xst); (void)b0; }
    for (int ph = ph_lo; ph < ph_hi; ++ph) {
        if (ph == ph_lo + 1) grid.sync();
        else if (ph > ph_lo) { XcdBarrier xb; xb.bar = (unsigned*)(P_WS + OFF_BAR); xb.x = xb_xcc_id(); xb.st = xst; xcd_barrier(xb); }
        if (ph == 26) {
            const int gw = BIDX() * 8 + (TIDX() >> 6), NGW = GDIM() * 8, lane = TIDX() & 63;
            for (int r = gw; r < T; r += NGW) { float* x = P_OUT + (size_t)r * D; f32x4 v[8]; float s = 0.f;
#pragma unroll
                for (int j = 0; j < 8; ++j) { v[j] = *(const f32x4*)(x + j * 256 + lane * 4); s += (v[j][0] * v[j][0] + v[j][1] * v[j][1]) + (v[j][2] * v[j][2] + v[j][3] * v[j][3]); }
                const float rstd = rsqrtf(wave_sum(s) * (1.0f / D) + 1e-6f);
#pragma unroll
                for (int j = 0; j < 8; ++j) { const f32x4 gg = *(const f32x4*)(P_IN(40) + j * 256 + lane * 4); *(f32x4*)(x + j * 256 + lane * 4) = v[j] * rstd * gg; } }
            continue;
        }
        const int L = ph / 13, q = ph % 13;
#ifdef ONLY_Q
        if (q != ONLY_Q) continue;
#endif
        const int nrep = (q == rep_q) ? 2 : 1;
        for (int rep = 0; rep < nrep; ++rep) {
        if (rep) grid.sync();
        switch (q) {
        case 0: phase_conv(p, L, lds); break;
        case 2: phase_prep(p, L, lds); break;
        case 4: phase_scan(p, L, lds); break;
        case 5: phase_post(p, L, lds); break;
        case 8: phase_rmsnorm(p, P_IN(33) + (size_t)L * D); break;
        case 11: phase_rmsnorm(p, P_IN(37) + (size_t)L * D); break;
        default: break;
        }
        for (int i = 0; i < 3; ++i) {
            pg8::Gemm g;
            if (!make_gemm(p, L, q, i, g)) break;
            pg8::StaticOrder S; S.init(T, g.N, GDIM(), (q == 3) ? BIDX() - 64 * i : BIDX());
            pg8::gemm_phase(lds, g, S);
        }
        if (q == 3) phase_s5c(p, L, lds);
        }
    }
}

extern "C" void kernel_launch(void* const* d_in, const int* in_sizes, int n_in, void* d_out, int out_size, void* d_ws, size_t ws_size, hipStream_t stream) {
    constexpr size_t kDynLds = 131072 + 64;
    static int grid_blocks = 0;
    if (!grid_blocks) {
        int dev = 0, cus = 0, per_cu = 0;
        (void)hipGetDevice(&dev);
        (void)hipDeviceGetAttribute(&cus, hipDeviceAttributeMultiprocessorCount, dev);
        (void)hipFuncSetAttribute((const void*)hybrid_fwd, hipFuncAttributeMaxDynamicSharedMemorySize, (int)kDynLds);
        (void)hipOccupancyMaxActiveBlocksPerMultiprocessor(&per_cu, hybrid_fwd, 512, kDynLds);
        if (per_cu > 1) per_cu = 1;
        grid_blocks = cus * per_cu;
        if (ws_size < WS_TOTAL) fprintf(stderr, "workspace too small: %zu < %zu\n", ws_size, (size_t)WS_TOTAL);
    }
    Params p{};
    for (int i = 0; i < 41; ++i) p.in[i] = (const float*)d_in[i];
    p.out = (float*)d_out; p.ws = (unsigned char*)d_ws;
    (void)hipMemsetAsync((char*)d_ws + OFF_BAR, 0, XCD_BAR_WORDS * 4, stream);
#if SINGLE_LAUNCH
    int lo = 0, hi = NPHASE, rq = PROBE_REP_Q;
    void* args[] = {&p, &lo, &hi, &rq};
    hipError_t e = hipLaunchCooperativeKernel((const void*)hybrid_fwd, dim3(grid_blocks), dim3(512), args, kDynLds, stream);
    if (e != hipSuccess) fprintf(stderr, "cooperative launch failed: %s (grid %d)\n", hipGetErrorString(e), grid_blocks);
#else
    for (int ph = 0; ph < NPHASE; ++ph) {
        int lo = ph, hi = ph + 1, rq = -1;
        void* args[] = {&p, &lo, &hi, &rq};
        hipError_t e = hipLaunchCooperativeKernel((const void*)hybrid_fwd, dim3(grid_blocks), dim3(512), args, kDynLds, stream);
        if (e != hipSuccess) fprintf(stderr, "cooperative launch failed: %s (grid %d)\n", hipGetErrorString(e), grid_blocks);
    }
#endif
}
```

```cpp
#include <hip/hip_runtime.h>
#include <hip/hip_cooperative_groups.h>
#include <cstdio>
#include <cstdint>
namespace cg = cooperative_groups;

#define LAS __attribute__((address_space(3)))
typedef unsigned short bh;
typedef short bf16x8 __attribute__((ext_vector_type(8)));
typedef float f32x4 __attribute__((ext_vector_type(4)));
typedef float f32x16 __attribute__((ext_vector_type(16)));
typedef unsigned u32x4 __attribute__((ext_vector_type(4)));
typedef unsigned u32x2 __attribute__((ext_vector_type(2)));

#ifndef PROBE_RW
#define PROBE_RW 1
#define PROBE_ML 1
#endif
#ifndef PROBE_REP_Q
#define PROBE_REP_Q (-1)
#endif
#ifndef SINGLE_LAUNCH
#define SINGLE_LAUNCH 1
#endif

constexpr int T = 8192, D = 2048, FH = 5632;
constexpr int NIN = 12744, NGATE = 6144, NF = 6600, ZF_LD = 6656, NINP = 12800;
constexpr int ZR0 = 4104, ZS0 = 6088;
constexpr int NCH = 128;

constexpr size_t AL(size_t x) { return (x + 255) & ~(size_t)255; }
constexpr size_t SZ_WIN = (size_t)NINP * D * 2, SZ_SQ = (size_t)D * D * 2, SZ_WGU = (size_t)2 * FH * D * 2, SZ_WD = (size_t)D * FH * 2;
constexpr size_t OFF_WIN = 0;
constexpr size_t OFF_WUP = OFF_WIN + SZ_WIN;
constexpr size_t OFF_WO = OFF_WUP + SZ_SQ;
constexpr size_t OFF_WGU = OFF_WO + SZ_SQ;
constexpr size_t OFF_WD = OFF_WGU + SZ_WGU;
constexpr size_t OFF_WPG = OFF_WD + SZ_WD;
constexpr size_t OFF_WPP = OFF_WPG + SZ_SQ;
constexpr size_t OFF_WGLU = OFF_WPP + (size_t)D * 256 * 2;
constexpr size_t OFF_WW2 = OFF_WGLU + (size_t)512 * 512 * 2;
constexpr size_t OFF_WA2 = OFF_WW2 + (size_t)512 * 256 * 2;
constexpr size_t OFF_WG2 = OFF_WA2 + (size_t)512 * 256 * 2;
constexpr size_t OFF_PBF = OFF_WG2 + (size_t)512 * 256 * 2;
constexpr size_t OFF_ABF = OFF_PBF + (size_t)2 * T * 256 * 2;
constexpr size_t OFF_YCAT = OFF_ABF + (size_t)T * D * 2;
constexpr size_t OFF_ZF = OFF_YCAT + (size_t)T * D * 2;
constexpr size_t OFF_ACT = OFF_ZF;
constexpr size_t OFF_MIX32 = OFF_ZF + (size_t)100663296;
constexpr size_t OFF_ZG = OFF_ZF + (size_t)T * ZF_LD * 4;
constexpr size_t SZ_R = (size_t)T * 512 * 4;
constexpr size_t OFF_RR = OFF_ZG + (size_t)T * NGATE * 2;
constexpr size_t OFF_RK = OFF_RR + SZ_R, OFF_RV = OFF_RK + SZ_R, OFF_RKK = OFF_RV + SZ_R, OFF_RW = OFF_RKK + SZ_R, OFF_RB = OFF_RW + SZ_R, OFF_RG = OFF_RB + SZ_R, OFF_RY = OFF_RG + SZ_R;
constexpr size_t OFF_LAW = OFF_RY + SZ_R;
constexpr size_t OFF_LAA = OFF_LAW + (size_t)T * 256 * 2, OFF_LAG = OFF_LAA + (size_t)T * 256 * 2;
constexpr size_t SZ_MB = (size_t)T * 1024 * 2;
constexpr size_t OFF_MQ = OFF_LAG + (size_t)T * 256 * 2, OFF_MK = OFF_MQ + SZ_MB, OFF_MKT = OFF_MK + SZ_MB, OFF_MVT = OFF_MKT + SZ_MB;
constexpr size_t OFF_MI = OFF_MVT + SZ_MB;
constexpr size_t OFF_MBB = OFF_MI + (size_t)4 * T * 4;
constexpr size_t OFF_MBEND = OFF_MBB + (size_t)4 * T * 4;
constexpr size_t OFF_MLOC = OFF_MBEND + 2048, OFF_MSTART = OFF_MLOC + 2048;
constexpr size_t OFF_DN = OFF_MSTART + 2048;
constexpr size_t OFF_NST = OFF_DN + (size_t)4 * NCH * 256 * 4;
constexpr size_t OFF_SEND = OFF_NST + (size_t)4 * NCH * 256 * 4;
constexpr size_t OFF_YS = OFF_SEND + (size_t)32 * NCH * 64 * 8;
constexpr size_t OFF_RZ = OFF_YS + (size_t)T * 512 * 2;
constexpr size_t OFF_RSEND = OFF_RZ + SZ_R;
constexpr size_t OFF_RPEND = OFF_RSEND + (size_t)8 * 4 * 4096 * 4;
constexpr size_t OFF_MINTER2 = OFF_RPEND + (size_t)8 * 4 * 4096 * 4;
constexpr size_t OFF_BAR = OFF_MINTER2;
constexpr size_t WS_TOTAL = OFF_MINTER2 + (size_t)T * 1024 * 4;

struct Params { const float* in[41]; float* out; unsigned char* ws; };
#define KARG4 __attribute__((address_space(4)))
__device__ __forceinline__ const float* karg_in(int i) { const KARG4 char* ka = (const KARG4 char*)__builtin_amdgcn_kernarg_segment_ptr(); return *(const float* const volatile KARG4*)(ka + (size_t)i * 8); }
#define P_IN(i) karg_in(i)
#define P_OUT ((float*)karg_in(41))
#define P_WS ((unsigned char*)karg_in(42))

__device__ __forceinline__ int TIDX() { int t = threadIdx.x; asm volatile("" : "+v"(t)); return t; }
__device__ __forceinline__ int BIDX() { int t = blockIdx.x; asm volatile("" : "+s"(t)); return t; }
__device__ __forceinline__ int GDIM() { int t = gridDim.x; asm volatile("" : "+s"(t)); return t; }
__device__ __forceinline__ bh f2bf(float f) { unsigned u = __float_as_uint(f); u += 0x7fffu + ((u >> 16) & 1u); return (bh)(u >> 16); }
__device__ __forceinline__ float bf2f(bh h) { return __uint_as_float(((unsigned)h) << 16); }
__device__ __forceinline__ unsigned pk2(float lo, float hi) { return (unsigned)f2bf(lo) | ((unsigned)f2bf(hi) << 16); }
__device__ __forceinline__ float sigmoidf_(float x) { return 1.0f / (1.0f + __expf(-x)); }
__device__ __forceinline__ float bperm_f(int srclane, float v) { return __builtin_bit_cast(float, __builtin_amdgcn_ds_bpermute(srclane << 2, __builtin_bit_cast(int, v))); }
template <int CTRL> __device__ __forceinline__ float dpp_f(float x) {
    return __builtin_bit_cast(float, __builtin_amdgcn_update_dpp(0, __builtin_bit_cast(int, x), CTRL, 0xf, 0xf, true));
}
__device__ __forceinline__ float allreduce16(float x) {
    x += dpp_f<0xB1>(x); x += dpp_f<0x4E>(x); x += dpp_f<0x141>(x); x += dpp_f<0x140>(x);
    return x;
}
__device__ __forceinline__ float rl_f(float v, int l) { return __builtin_bit_cast(float, __builtin_amdgcn_readlane(__builtin_bit_cast(int, v), l)); }
__device__ __forceinline__ float wave_sum(float v) {
    v = allreduce16(v);
    return (rl_f(v, 0) + rl_f(v, 16)) + (rl_f(v, 32) + rl_f(v, 48));
}
__device__ __forceinline__ float wave_max(float v) {
    v = fmaxf(v, dpp_f<0xB1>(v)); v = fmaxf(v, dpp_f<0x4E>(v)); v = fmaxf(v, dpp_f<0x141>(v)); v = fmaxf(v, dpp_f<0x140>(v));
    return fmaxf(fmaxf(rl_f(v, 0), rl_f(v, 16)), fmaxf(rl_f(v, 32), rl_f(v, 48)));
}
__device__ __forceinline__ float OZ() { float z = 0.f; asm volatile("" : "+v"(z)); return z; }
#define MFMA16(a, b, c) __builtin_amdgcn_mfma_f32_16x16x32_bf16(a, b, c, 0, 0, 0)
#define MFMA32(a, b, c) __builtin_amdgcn_mfma_f32_32x32x16_bf16(a, b, c, 0, 0, 0)

namespace pg8 {
constexpr int BM = 256, BK = 64, HALF = 128, HTB = HALF * BK * 2, STAGE_BYTES = 8 * HTB, NXCD = 8, WGM = 8;
__device__ __forceinline__ int lds_byte(int r, int c) { const int st = (r >> 4) * 2 + (c >> 5), rr = r & 15, cc = c & 31, ob = rr * 64 + cc * 2; return st * 1024 + (ob ^ (((ob >> 9) & 1) << 5)); }
__device__ __forceinline__ void stage_rc(int b, int& R, int& C) { const int st = b / 1024, sb = b % 1024, swz = sb ^ (((sb >> 9) & 1) << 5); R = (st >> 1) * 16 + swz / 64; C = (st & 1) * 32 + (swz % 64) / 2; }
__device__ __forceinline__ int perm32(int rho) { const int n = rho >> 4, i = rho & 15; return 8 * (i >> 2) + 4 * n + (i & 3); }
struct Unit { int pm, pn; };
struct Gemm { const bh* A; const bh* Bt; int M, N, K, lda, ldb, epi, perm, L; };
struct StaticOrder {
    int nM, nN, nwg, G, c;
    __device__ void init(int M, int N, int G_, int c_) { nM = M / BM; nN = N / BM; nwg = nM * nN; G = G_; c = c_; }
    __device__ bool next(int i, Unit& u) const {
        const long L = (long)i * G + c; if (c < 0 || L >= nwg) return false;
        int wgid = (int)L; { const int q = nwg / NXCD, r = nwg % NXCD, xcd = wgid % NXCD, off = wgid / NXCD; wgid = (xcd < r ? xcd * (q + 1) : r * (q + 1) + (xcd - r) * q) + off; }
        const int nig = WGM * nN, gid = wgid / nig, fm = gid * WGM, gsz = (nM - fm) < WGM ? (nM - fm) : WGM;
        u.pm = fm + ((wgid % nig) % gsz); u.pn = (wgid % nig) / gsz; return true;
    }
};
__device__ __forceinline__ unsigned cvt_pk_bf16(float lo, float hi) { unsigned r; asm volatile("v_cvt_pk_bf16_f32 %0, %1, %2" : "=v"(r) : "v"(lo), "v"(hi)); return r; }

__device__ __forceinline__ void epi_run(const Gemm& g, const f32x4 (&acc)[2][2][4][2], const Unit& u, int wr, int wc, int fr, int fq);
__device__ __forceinline__ void up_rescale(f32x4 (&acc)[2][2][4][2], const Unit& u, int wr, int wc, int fr, int fq, int goff) {
    const bh* zg = (const bh*)(P_WS + OFF_ZG) + goff;
    asm volatile("" : "+v"(fr), "+v"(fq));
    const bh* zrow0 = zg + (size_t)(u.pm * 256 + wr * 64 + fr) * NGATE + u.pn * 256 + wc * 32 + 4 * fq;
#pragma unroll
    for (int ai = 0; ai < 2; ++ai)
#pragma unroll
        for (int mp = 0; mp < 2; ++mp) {
            u32x2 gp[8], gn[8];
#pragma unroll
            for (int mm = 0; mm < 2; ++mm) { const bh* zr = zrow0 + (size_t)(ai * 128 + (mp * 2 + mm) * 16) * NGATE;
#pragma unroll
                for (int bj = 0; bj < 2; ++bj)
#pragma unroll
                    for (int n = 0; n < 2; ++n) { gp[mm * 4 + bj * 2 + n] = *(const u32x2*)(zr + bj * 128 + n * 16); gn[mm * 4 + bj * 2 + n] = *(const u32x2*)(zr + 2048 + bj * 128 + n * 16); } }
            __builtin_amdgcn_sched_barrier(0);
#pragma unroll
            for (int mm = 0; mm < 2; ++mm)
#pragma unroll
                for (int bj = 0; bj < 2; ++bj)
#pragma unroll
                    for (int n = 0; n < 2; ++n) { const u32x2 p = gp[mm * 4 + bj * 2 + n], q = gn[mm * 4 + bj * 2 + n];
                        f32x4 r;
                        r[0] = __uint_as_float(p.x << 16) * __builtin_amdgcn_rcpf(__uint_as_float(q.x << 16)); r[1] = __uint_as_float(p.x & 0xffff0000u) * __builtin_amdgcn_rcpf(__uint_as_float(q.x & 0xffff0000u));
                        r[2] = __uint_as_float(p.y << 16) * __builtin_amdgcn_rcpf(__uint_as_float(q.y << 16)); r[3] = __uint_as_float(p.y & 0xffff0000u) * __builtin_amdgcn_rcpf(__uint_as_float(q.y & 0xffff0000u));
                        acc[ai][bj][mp * 2 + mm][n] *= r; }
            __builtin_amdgcn_sched_barrier(0); }
}
__device__ __forceinline__ void gemm_phase(LAS unsigned char* lds, const Gemm& g, const StaticOrder& S) {
    const int tid = TIDX(), wid = __builtin_amdgcn_readfirstlane(tid >> 6), lane = tid & 63, wr = wid >> 2, wc = wid & 3, fr = lane & 15, fq = lane >> 4;
    const int K = g.K, nt = K / BK;
    unsigned voffA[2], voffB[2];
#pragma unroll
    for (int i = 0; i < 2; ++i) { int R, C; stage_rc(tid * 16 + i * 8192, R, C); const int Rb = g.perm ? ((R & ~31) + perm32(R & 31)) : R;
        voffA[i] = (unsigned)(R * g.lda + C) * 2u; voffB[i] = (unsigned)(Rb * g.ldb + C) * 2u; }
    const size_t kstep = (size_t)(BK * 2);
    const size_t hstepA = (size_t)HALF * g.lda * 2, hstepB = (size_t)HALF * g.ldb * 2;
    const size_t tstepA = 2 * hstepA, tstepB = 2 * hstepB;
    const unsigned ldsw = (unsigned)wid * 1024u;
    const int aoff = lds_byte(wr * 64 + fr, fq * 8), boff = lds_byte(wc * 32 + fr, fq * 8);
#define PG8_SA(b, h) (((b) * 2 + (h)) * HTB)
#define PG8_SB(b, h) ((4 + (b) * 2 + (h)) * HTB)
#define PG8_STAGE(bufoff, gbase, voff) do { _Pragma("unroll") for (int _i = 0; _i < 2; ++_i) \
        __builtin_amdgcn_global_load_lds((const unsigned*)((const char*)(gbase) + (voff)[_i]), (LAS unsigned*)(lds + (bufoff) + ldsw + _i * 8192), 16, 0, 0); } while (0)
#define PG8_LDA(dst, b, h) do { _Pragma("unroll") for (int m = 0; m < 4; ++m) _Pragma("unroll") for (int k = 0; k < 2; ++k) dst[m][k] = *(const LAS bf16x8*)(lds + PG8_SA(b, h) + aoff + m * 2048 + k * 1024); } while (0)
#define PG8_LDB(dst, b, h) do { _Pragma("unroll") for (int n = 0; n < 2; ++n) _Pragma("unroll") for (int k = 0; k < 2; ++k) dst[n][k] = *(const LAS bf16x8*)(lds + PG8_SB(b, h) + boff + n * 2048 + k * 1024); } while (0)
#define PG8_MMA(ai, bj, At, Bt) do { __builtin_amdgcn_s_setprio(1); _Pragma("unroll") for (int m = 0; m < 4; ++m) _Pragma("unroll") for (int n = 0; n < 2; ++n) _Pragma("unroll") for (int k = 0; k < 2; ++k) \
        acc[ai][bj][m][n] = __builtin_amdgcn_mfma_f32_16x16x32_bf16(Bt[n][k], At[m][k], acc[ai][bj][m][n], 0, 0, 0); __builtin_amdgcn_s_setprio(0); } while (0)
#define PG8_WAIT_V(n) asm volatile("s_waitcnt vmcnt(" #n ")" ::: "memory")
#define PG8_WAIT_L(n) asm volatile("s_waitcnt lgkmcnt(" #n ")" ::: "memory")
#define PG8_BAR __builtin_amdgcn_s_barrier()
#define PG8_SCHED __builtin_amdgcn_sched_barrier(0)
    Unit cur, nxt; int ui = 0;
    if (!S.next(0, cur)) return;
    f32x4 acc[2][2][4][2];
    { const float z = OZ();
#pragma unroll
    for (int a = 0; a < 2; ++a)
#pragma unroll
        for (int b = 0; b < 2; ++b)
#pragma unroll
            for (int m = 0; m < 4; ++m)
#pragma unroll
                for (int n = 0; n < 2; ++n) acc[a][b][m][n] = (f32x4){z, z, z, z}; }
    bf16x8 At[4][2], B0[2][2], B1[2][2];
    const char* cA = (const char*)g.A + (size_t)cur.pm * tstepA; const char* cB = (const char*)g.Bt + (size_t)cur.pn * tstepB;
    PG8_STAGE(PG8_SB(0, 0), cB, voffB); PG8_STAGE(PG8_SA(0, 0), cA, voffA); PG8_STAGE(PG8_SB(0, 1), cB + hstepB, voffB); PG8_STAGE(PG8_SA(0, 1), cA + hstepA, voffA);
    if (wr == 1) PG8_BAR;
    PG8_WAIT_V(4); PG8_BAR;
    PG8_STAGE(PG8_SB(1, 0), cB + kstep, voffB); PG8_STAGE(PG8_SA(1, 0), cA + kstep, voffA); PG8_STAGE(PG8_SB(1, 1), cB + hstepB + kstep, voffB);
    PG8_WAIT_V(6); PG8_BAR;
    for (;;) {
        const bool has_next = S.next(ui + 1, nxt);
        const char* nA = has_next ? (const char*)g.A + (size_t)nxt.pm * tstepA : cA; const char* nB = has_next ? (const char*)g.Bt + (size_t)nxt.pn * tstepB : cB;
        for (int t = 0; t < nt; t += 2) {
            if (g.epi == 11 && (t == 16 || t == 24)) up_rescale(acc, cur, wr, wc, fr, fq, t == 16 ? 0 : 2048);
            const bool last = (t == nt - 2);
            const char* a1 = cA + (size_t)(t + 1) * kstep;
            const char* a2 = last ? nA : cA + (size_t)(t + 2) * kstep; const char* b2 = last ? nB : cB + (size_t)(t + 2) * kstep;
            const char* a3 = a2 + kstep; const char* b3 = b2 + kstep;
            PG8_LDB(B0, 0, 0); PG8_SCHED; PG8_LDA(At, 0, 0); PG8_STAGE(PG8_SA(1, 1), a1 + hstepA, voffA);
            PG8_WAIT_L(8); PG8_BAR; PG8_WAIT_L(0); PG8_MMA(0, 0, At, B0); PG8_BAR; PG8_SCHED;
            PG8_LDB(B1, 0, 1); PG8_STAGE(PG8_SB(0, 0), b2, voffB);
            PG8_BAR; PG8_WAIT_L(0); PG8_MMA(0, 1, At, B1); PG8_BAR;
            PG8_LDA(At, 0, 1); PG8_STAGE(PG8_SA(0, 0), a2, voffA);
            PG8_BAR; PG8_WAIT_L(0); PG8_MMA(1, 0, At, B0); PG8_BAR; PG8_SCHED;
            PG8_STAGE(PG8_SB(0, 1), b2 + hstepB, voffB);
            PG8_WAIT_V(6); PG8_BAR; PG8_MMA(1, 1, At, B1); PG8_BAR;
            PG8_LDB(B0, 1, 0); PG8_SCHED; PG8_LDA(At, 1, 0); PG8_STAGE(PG8_SA(0, 1), a2 + hstepA, voffA);
            PG8_WAIT_L(8); PG8_BAR; PG8_WAIT_L(0); PG8_MMA(0, 0, At, B0); PG8_BAR; PG8_SCHED;
            PG8_LDB(B1, 1, 1); PG8_STAGE(PG8_SB(1, 0), b3, voffB);
            PG8_BAR; PG8_WAIT_L(0); PG8_MMA(0, 1, At, B1); PG8_BAR;
            PG8_LDA(At, 1, 1); PG8_STAGE(PG8_SA(1, 0), a3, voffA);
            PG8_BAR; PG8_WAIT_L(0); PG8_MMA(1, 0, At, B0); PG8_BAR; PG8_SCHED;
            PG8_STAGE(PG8_SB(1, 1), b3 + hstepB, voffB);
            PG8_WAIT_V(6); PG8_BAR; PG8_MMA(1, 1, At, B1); PG8_BAR;
        }
        epi_run(g, acc, cur, wr, wc, fr, fq);
        if (!has_next) break;
        { const float z = OZ();
#pragma unroll
        for (int a = 0; a < 2; ++a)
#pragma unroll
            for (int b = 0; b < 2; ++b)
#pragma unroll
                for (int m = 0; m < 4; ++m)
#pragma unroll
                    for (int n = 0; n < 2; ++n) acc[a][b][m][n] = (f32x4){z, z, z, z}; }
        cur = nxt; cA = nA; cB = nB; ++ui;
    }
    PG8_WAIT_V(0);
    if (wr == 0) PG8_BAR;
    PG8_BAR;
#undef PG8_SA
#undef PG8_SB
#undef PG8_STAGE
#undef PG8_LDA
#undef PG8_LDB
#undef PG8_MMA
#undef PG8_WAIT_V
#undef PG8_WAIT_L
#undef PG8_BAR
#undef PG8_SCHED
}
}
using pg8::Unit;
using pg8::cvt_pk_bf16;

#define EPI_FOR_NP(...) \
    _Pragma("unroll") for (int ai = 0; ai < 2; ++ai) _Pragma("unroll") for (int m = 0; m < 4; ++m) { const int row = u.pm * 256 + ai * 128 + wr * 64 + m * 16 + fr; \
    _Pragma("unroll") for (int bj = 0; bj < 2; ++bj) _Pragma("unroll") for (int n = 0; n < 2; ++n) { const int col = u.pn * 256 + bj * 128 + wc * 32 + n * 16 + 4 * fq; const f32x4 v = acc[ai][bj][m][n]; __VA_ARGS__ } }

typedef const f32x4 (&AccRef)[2][2][4][2];
#define EPI_GRP8(...) \
    _Pragma("unroll") for (int mm = 0; mm < 2; ++mm) _Pragma("unroll") for (int bj = 0; bj < 2; ++bj) _Pragma("unroll") for (int n = 0; n < 2; ++n) { \
        const int idx = mm * 4 + bj * 2 + n; const int row = u.pm * 256 + ai * 128 + wr * 64 + (mp * 2 + mm) * 16 + fr; const int col = u.pn * 256 + bj * 128 + wc * 32 + n * 16 + 4 * fq; \
        const f32x4 v = acc[ai][bj][mp * 2 + mm][n]; (void)idx; (void)row; (void)col; (void)v; __VA_ARGS__ }
#define EPI_GROUPS _Pragma("unroll") for (int ai = 0; ai < 2; ++ai) _Pragma("unroll") for (int mp = 0; mp < 2; ++mp)

struct EpiWin {
    static constexpr bool PERM = false;
    bh* zg; float* zf;
    __device__ __forceinline__ void operator()(AccRef acc, const Unit& u, int wr, int wc, int fr, int fq) const {
        if (u.pn < 24) {
            EPI_FOR_NP({ u32x2 w; w.x = cvt_pk_bf16(fmaxf(sigmoidf_(v[0]), 1e-6f), fmaxf(sigmoidf_(v[1]), 1e-6f)); w.y = cvt_pk_bf16(fmaxf(sigmoidf_(v[2]), 1e-6f), fmaxf(sigmoidf_(v[3]), 1e-6f)); *(u32x2*)(zg + (size_t)row * NGATE + col) = w; })
        } else {
            EPI_FOR_NP({ *(f32x4*)(zf + (size_t)row * ZF_LD + (col - NGATE)) = v; })
        }
    }
};
struct EpiLoraW {
    static constexpr bool PERM = false;
    const float* w0; float* rw;
    __device__ __forceinline__ void operator()(AccRef acc, const Unit& u, int wr, int wc, int fr, int fq) const {
        f32x4 bb[2][2];
#pragma unroll
        for (int bj = 0; bj < 2; ++bj)
#pragma unroll
            for (int n = 0; n < 2; ++n) bb[bj][n] = *(const f32x4*)(w0 + u.pn * 256 + bj * 128 + wc * 32 + n * 16 + 4 * fq);
        __builtin_amdgcn_sched_barrier(0);
        EPI_FOR_NP({ const f32x4 b = bb[bj][n]; f32x4 o;
            _Pragma("unroll") for (int j = 0; j < 4; ++j) { const float x = -(b[j] + v[j]); const float sp = fmaxf(x, 0.f) + log1pf(__expf(-fabsf(x))); o[j] = __expf(-__expf(-sp - 0.5f)); }
            *(f32x4*)(rw + (size_t)row * 512 + col) = o; })
    }
};
struct EpiLoraA {
    static constexpr bool PERM = false;
    const float* a0; const float* ka; const float* rkk; float* rb; float* rk;
    __device__ __forceinline__ void operator()(AccRef acc, const Unit& u, int wr, int wc, int fr, int fq) const {
        f32x4 b0s[2][2], kas[2][2];
#pragma unroll
        for (int bj = 0; bj < 2; ++bj)
#pragma unroll
            for (int n = 0; n < 2; ++n) { const int c0 = u.pn * 256 + bj * 128 + wc * 32 + n * 16 + 4 * fq; b0s[bj][n] = *(const f32x4*)(a0 + c0); kas[bj][n] = *(const f32x4*)(ka + c0); }
#pragma unroll
        for (int ai = 0; ai < 2; ++ai)
#pragma unroll
            for (int m = 0; m < 4; ++m) { const int row = u.pm * 256 + ai * 128 + wr * 64 + m * 16 + fr; f32x4 kkq[4], kq[4];
#pragma unroll
                for (int bj = 0; bj < 2; ++bj)
#pragma unroll
                    for (int n = 0; n < 2; ++n) { const size_t o = (size_t)row * 512 + u.pn * 256 + bj * 128 + wc * 32 + n * 16 + 4 * fq; kkq[bj * 2 + n] = *(const f32x4*)(rkk + o); kq[bj * 2 + n] = *(const f32x4*)(rk + o); }
                __builtin_amdgcn_sched_barrier(0);
#pragma unroll
                for (int bj = 0; bj < 2; ++bj)
#pragma unroll
                    for (int n = 0; n < 2; ++n) { const size_t o = (size_t)row * 512 + u.pn * 256 + bj * 128 + wc * 32 + n * 16 + 4 * fq;
                        const f32x4 v = acc[ai][bj][m][n]; const f32x4 b0 = b0s[bj][n]; const f32x4 kav = kas[bj][n]; const f32x4 kkv = kkq[bj * 2 + n]; f32x4 kv = kq[bj * 2 + n]; f32x4 bo;
                        _Pragma("unroll") for (int j = 0; j < 4; ++j) { const float a = sigmoidf_(b0[j] + v[j]); bo[j] = -(kkv[j] * a); kv[j] = kv[j] * (1.0f + (a - 1.0f) * kav[j]); }
                        *(f32x4*)(rb + o) = bo; *(f32x4*)(rk + o) = kv; }
                __builtin_amdgcn_sched_barrier(0); }
    }
};
struct EpiStoreF32 {
    static constexpr bool PERM = false;
    float* o; int ld;
    __device__ __forceinline__ void operator()(AccRef acc, const Unit& u, int wr, int wc, int fr, int fq) const {
        EPI_FOR_NP({ *(f32x4*)(o + (size_t)row * ld + col) = v; })
    }
};
struct EpiGlu {
    static constexpr bool PERM = false;
    const bh* ys; const float* gb; bh* ycat;
    __device__ __forceinline__ void operator()(AccRef acc, const Unit& u, int wr, int wc, int fr, int fq) const {
        f32x4 gbs[2][2];
#pragma unroll
        for (int bj = 0; bj < 2; ++bj)
#pragma unroll
            for (int n = 0; n < 2; ++n) gbs[bj][n] = *(const f32x4*)(gb + u.pn * 256 + bj * 128 + wc * 32 + n * 16 + 4 * fq);
        EPI_GROUPS { u32x2 yq[8];
            EPI_GRP8({ yq[idx] = *(const u32x2*)(ys + (size_t)row * 512 + col); })
            __builtin_amdgcn_sched_barrier(0);
            EPI_GRP8({ const f32x4 b = gbs[bj][n]; const u32x2 y2 = yq[idx];
                const float y0 = __uint_as_float(y2.x << 16), y1 = __uint_as_float(y2.x & 0xffff0000u), y2f = __uint_as_float(y2.y << 16), y3 = __uint_as_float(y2.y & 0xffff0000u);
                u32x2 w; w.x = cvt_pk_bf16(y0 * sigmoidf_(v[0] + b[0]), y1 * sigmoidf_(v[1] + b[1])); w.y = cvt_pk_bf16(y2f * sigmoidf_(v[2] + b[2]), y3 * sigmoidf_(v[3] + b[3]));
                *(u32x2*)(ycat + (size_t)row * D + 1536 + col) = w; })
            __builtin_amdgcn_sched_barrier(0); }
    }
};
template <int MODE> struct EpiUp {
    static constexpr bool PERM = false;
    const bh* zg; float* mix; bh* mixed;
    __device__ __forceinline__ void operator()(AccRef acc, const Unit& u, int wr, int wc, int fr, int fq) const {
        EPI_FOR_NP({ const u32x2 g2 = *(const u32x2*)(zg + (size_t)row * NGATE + col);
            f32x4 g; g[0] = __uint_as_float(g2.x << 16); g[1] = __uint_as_float(g2.x & 0xffff0000u); g[2] = __uint_as_float(g2.y << 16); g[3] = __uint_as_float(g2.y & 0xffff0000u);
            f32x4 r = g * v; float* mp = mix + (size_t)row * D + col;
            if (MODE >= 1) r += *(const f32x4*)mp;
            if (MODE <= 1) *(f32x4*)mp = r;
            else { u32x2 w; w.x = cvt_pk_bf16(r[0], r[1]); w.y = cvt_pk_bf16(r[2], r[3]); *(u32x2*)(mixed + (size_t)row * D + col) = w; } })
    }
};
struct EpiUpF {
    static constexpr bool PERM = false;
    const bh* zg; bh* mixed;
    __device__ __forceinline__ void operator()(AccRef acc, const Unit& u, int wr, int wc, int fr, int fq) const {
#pragma unroll
        for (int ai = 0; ai < 2; ++ai) { u32x2 gg[16];
#pragma unroll
            for (int m = 0; m < 4; ++m)
#pragma unroll
                for (int bj = 0; bj < 2; ++bj)
#pragma unroll
                    for (int n = 0; n < 2; ++n) gg[m * 4 + bj * 2 + n] = *(const u32x2*)(zg + (size_t)(u.pm * 256 + ai * 128 + wr * 64 + m * 16 + fr) * NGATE + u.pn * 256 + bj * 128 + wc * 32 + n * 16 + 4 * fq);
            __builtin_amdgcn_sched_barrier(0);
#pragma unroll
            for (int m = 0; m < 4; ++m)
#pragma unroll
                for (int bj = 0; bj < 2; ++bj)
#pragma unroll
                    for (int n = 0; n < 2; ++n) { const u32x2 g2 = gg[m * 4 + bj * 2 + n]; const f32x4 v = acc[ai][bj][m][n];
                        u32x2 w; w.x = cvt_pk_bf16(__uint_as_float(g2.x << 16) * v[0], __uint_as_float(g2.x & 0xffff0000u) * v[1]); w.y = cvt_pk_bf16(__uint_as_float(g2.y << 16) * v[2], __uint_as_float(g2.y & 0xffff0000u) * v[3]);
                        *(u32x2*)(mixed + (size_t)(u.pm * 256 + ai * 128 + wr * 64 + m * 16 + fr) * D + u.pn * 256 + bj * 128 + wc * 32 + n * 16 + 4 * fq) = w; }
            __builtin_amdgcn_sched_barrier(0); }
    }
};
struct EpiRes {
    static constexpr bool PERM = false;
    float* h;
    __device__ __forceinline__ void operator()(AccRef acc, const Unit& u, int wr, int wc, int fr, int fq) const {
#pragma unroll
        for (int ai = 0; ai < 2; ++ai)
#pragma unroll
            for (int mp = 0; mp < 2; ++mp) { f32x4 hv[8];
#pragma unroll
                for (int mm = 0; mm < 2; ++mm)
#pragma unroll
                    for (int bj = 0; bj < 2; ++bj)
#pragma unroll
                        for (int n = 0; n < 2; ++n) hv[mm * 4 + bj * 2 + n] = *(const f32x4*)(h + (size_t)(u.pm * 256 + ai * 128 + wr * 64 + (mp * 2 + mm) * 16 + fr) * D + u.pn * 256 + bj * 128 + wc * 32 + n * 16 + 4 * fq);
                __builtin_amdgcn_sched_barrier(0);
#pragma unroll
                for (int mm = 0; mm < 2; ++mm)
#pragma unroll
                    for (int bj = 0; bj < 2; ++bj)
#pragma unroll
                        for (int n = 0; n < 2; ++n) *(f32x4*)(h + (size_t)(u.pm * 256 + ai * 128 + wr * 64 + (mp * 2 + mm) * 16 + fr) * D + u.pn * 256 + bj * 128 + wc * 32 + n * 16 + 4 * fq) = hv[mm * 4 + bj * 2 + n] + acc[ai][bj][mp * 2 + mm][n];
                __builtin_amdgcn_sched_barrier(0); }
    }
};
struct EpiFfn {
    static constexpr bool PERM = true;
    bh* act;
    __device__ __forceinline__ void operator()(AccRef acc, const Unit& u, int wr, int wc, int fr, int fq) const {
#pragma unroll
        for (int ai = 0; ai < 2; ++ai)
#pragma unroll
            for (int m = 0; m < 4; ++m) { const int row = u.pm * 256 + ai * 128 + wr * 64 + m * 16 + fr; const int col = u.pn * 128 + wc * 32 + 8 * fq;
                float o[8];
#pragma unroll
                for (int n = 0; n < 2; ++n)
#pragma unroll
                    for (int j = 0; j < 4; ++j) { const float gte = acc[ai][0][m][n][j], up = acc[ai][1][m][n][j]; o[n * 4 + j] = gte * sigmoidf_(gte) * up; }
                u32x4 w; w.x = cvt_pk_bf16(o[0], o[1]); w.y = cvt_pk_bf16(o[2], o[3]); w.z = cvt_pk_bf16(o[4], o[5]); w.w = cvt_pk_bf16(o[6], o[7]);
                *(u32x4*)(act + (size_t)row * FH + col) = w; }
    }
};
struct EpiPle {
    static constexpr bool PERM = false;
    float* h; const float* tmp;
    __device__ __forceinline__ void operator()(AccRef acc, const Unit& u, int wr, int wc, int fr, int fq) const {
#pragma unroll
        for (int ai = 0; ai < 2; ++ai)
#pragma unroll
            for (int mp = 0; mp < 2; ++mp) { f32x4 hv[8], tv[8];
#pragma unroll
                for (int mm = 0; mm < 2; ++mm)
#pragma unroll
                    for (int bj = 0; bj < 2; ++bj)
#pragma unroll
                        for (int n = 0; n < 2; ++n) { const size_t o = (size_t)(u.pm * 256 + ai * 128 + wr * 64 + (mp * 2 + mm) * 16 + fr) * D + u.pn * 256 + bj * 128 + wc * 32 + n * 16 + 4 * fq;
                            hv[mm * 4 + bj * 2 + n] = *(const f32x4*)(h + o); tv[mm * 4 + bj * 2 + n] = *(const f32x4*)(tmp + o); }
                __builtin_amdgcn_sched_barrier(0);
#pragma unroll
                for (int mm = 0; mm < 2; ++mm)
#pragma unroll
                    for (int bj = 0; bj < 2; ++bj)
#pragma unroll
                        for (int n = 0; n < 2; ++n) { const size_t o = (size_t)(u.pm * 256 + ai * 128 + wr * 64 + (mp * 2 + mm) * 16 + fr) * D + u.pn * 256 + bj * 128 + wc * 32 + n * 16 + 4 * fq;
                            f32x4 r = hv[mm * 4 + bj * 2 + n]; const f32x4 v = acc[ai][bj][mp * 2 + mm][n]; const f32x4 t4 = tv[mm * 4 + bj * 2 + n];
                            _Pragma("unroll") for (int j = 0; j < 4; ++j) r[j] += t4[j] * sigmoidf_(v[j]);
                            *(f32x4*)(h + o) = r; }
                __builtin_amdgcn_sched_barrier(0); }
    }
};

namespace pg8 {
__device__ __forceinline__ void epi_run(const Gemm& g, const f32x4 (&acc)[2][2][4][2], const Unit& u, int wr, int wc, int fr, int fq) {
    unsigned char* ws = P_WS; const int L = g.L;
    switch (g.epi) {
    case 0: { EpiWin E{(bh*)(ws + OFF_ZG), (float*)(ws + OFF_ZF)}; E(acc, u, wr, wc, fr, fq); } break;
    case 1: { EpiLoraW E{P_IN(9) + L * 512, (float*)(ws + OFF_RW)}; E(acc, u, wr, wc, fr, fq); } break;
    case 2: { EpiLoraA E{P_IN(11) + L * 512, P_IN(15) + L * 512, (const float*)(ws + OFF_RKK), (float*)(ws + OFF_RB), (float*)(ws + OFF_RK)}; E(acc, u, wr, wc, fr, fq); } break;
    case 3: { EpiStoreF32 E{(float*)(ws + (g.N == 512 ? OFF_RG : OFF_MIX32)), g.N}; E(acc, u, wr, wc, fr, fq); } break;
    case 4: { EpiGlu E{(const bh*)(ws + OFF_YS), P_IN(28) + L * 512, (bh*)(ws + OFF_YCAT)}; E(acc, u, wr, wc, fr, fq); } break;
    case 5: { EpiUp<0> E{(const bh*)(ws + OFF_ZG), (float*)(ws + OFF_MIX32), (bh*)(ws + OFF_ABF)}; E(acc, u, wr, wc, fr, fq); } break;
    case 6: { EpiUp<1> E{(const bh*)(ws + OFF_ZG) + 2048, (float*)(ws + OFF_MIX32), (bh*)(ws + OFF_ABF)}; E(acc, u, wr, wc, fr, fq); } break;
    case 7: { EpiUp<2> E{(const bh*)(ws + OFF_ZG) + 4096, (float*)(ws + OFF_MIX32), (bh*)(ws + OFF_ABF)}; E(acc, u, wr, wc, fr, fq); } break;
    case 8: { EpiRes E{P_OUT}; E(acc, u, wr, wc, fr, fq); } break;
    case 9: { EpiFfn E{(bh*)(ws + OFF_ACT)}; E(acc, u, wr, wc, fr, fq); } break;
    case 11: { EpiUpF E{(const bh*)(ws + OFF_ZG) + 4096, (bh*)(ws + OFF_ABF)}; E(acc, u, wr, wc, fr, fq); } break;
    default: { EpiPle E{P_OUT, (const float*)(ws + OFF_MIX32)}; E(acc, u, wr, wc, fr, fq); } break;
    }
}
}

__device__ __forceinline__ bool make_gemm(const Params& p, int L, int q, int i, pg8::Gemm& g) {
    unsigned char* ws = P_WS;
    g.M = T; g.perm = 0; g.L = L;
    switch (q) {
    case 1: if (i > 0) return false;
        g.A = (const bh*)(ws + OFF_ABF); g.lda = D; g.Bt = (const bh*)(ws + OFF_WIN); g.ldb = D; g.N = NINP; g.K = D; g.epi = 0; return true;
    case 3: if (i > 2) return false;
        g.lda = 256; g.ldb = 256; g.N = 512; g.K = 256;
        if (i == 0) { g.A = (const bh*)(ws + OFF_LAW); g.Bt = (const bh*)(ws + OFF_WW2); g.epi = 1; }
        else if (i == 1) { g.A = (const bh*)(ws + OFF_LAA); g.Bt = (const bh*)(ws + OFF_WA2); g.epi = 2; }
        else { g.A = (const bh*)(ws + OFF_LAG); g.Bt = (const bh*)(ws + OFF_WG2); g.epi = 3; }
        return true;
    case 5: if (i > 0) return false;
        g.A = (const bh*)(ws + OFF_YS); g.lda = 512; g.Bt = (const bh*)(ws + OFF_WGLU); g.ldb = 512; g.N = 512; g.K = 512; g.epi = 4; return true;
    case 6: if (i > 0) return false;
        g.A = (const bh*)(ws + OFF_YCAT); g.lda = D; g.Bt = (const bh*)(ws + OFF_WUP); g.ldb = D; g.N = D; g.K = D; g.epi = 11; return true;
    case 7: if (i > 0) return false;
        g.A = (const bh*)(ws + OFF_ABF); g.lda = D; g.Bt = (const bh*)(ws + OFF_WO); g.ldb = D; g.N = D; g.K = D; g.epi = 8; return true;
    case 9: if (i > 0) return false;
        g.A = (const bh*)(ws + OFF_ABF); g.lda = D; g.Bt = (const bh*)(ws + OFF_WGU); g.ldb = D; g.N = 2 * FH; g.K = D; g.epi = 9; g.perm = 1; return true;
    case 10: if (i > 0) return false;
        g.A = (const bh*)(ws + OFF_ACT); g.lda = FH; g.Bt = (const bh*)(ws + OFF_WD); g.ldb = FH; g.N = D; g.K = FH; g.epi = 8; return true;
    case 12: if (i > 1) return false;
        if (i == 0) { g.A = (const bh*)(ws + OFF_PBF) + (size_t)L * T * 256; g.lda = 256; g.Bt = (const bh*)(ws + OFF_WPP); g.ldb = 256; g.N = D; g.K = 256; g.epi = 3; }
        else { g.A = (const bh*)(ws + OFF_ABF); g.lda = D; g.Bt = (const bh*)(ws + OFF_WPG); g.ldb = D; g.N = D; g.K = D; g.epi = 10; }
        return true;
    default: return false;
    }
}

struct CJ { const float* src; int in_idx, src_ld, kv, n0, nv; long lstride; size_t dst; int dst_ld, r0, c0, npad, kpad, seg, segstride; };
constexpr int BIGSEG = 1 << 30;
__constant__ int JT_I[15][12] = {
    {3, NIN, 2048, NF, NGATE, D, 0, 0, NGATE, 2048, BIGSEG, 0},
    {3, NIN, 2048, 0, NF, D, NGATE, 0, 6656, 2048, BIGSEG, 0},
    {29, D, 1024, 0, D, D, 0, 0, D, 1024, BIGSEG, 0},
    {30, D, 512, 0, D, D, 0, 1024, D, 512, BIGSEG, 0},
    {31, D, 512, 0, D, D, 0, 1536, D, 512, BIGSEG, 0},
    {32, D, 2048, 0, D, D, 0, 0, D, 2048, BIGSEG, 0},
    {34, FH, 2048, 0, FH, D, 0, 0, FH, 2048, 128, 256},
    {35, FH, 2048, 0, FH, D, 128, 0, FH, 2048, 128, 256},
    {36, D, FH, 0, D, FH, 0, 0, D, FH, BIGSEG, 0},
    {38, D, 2048, 0, D, D, 0, 0, D, 2048, BIGSEG, 0},
    {39, D, 256, 0, D, 256, 0, 0, D, 256, BIGSEG, 0},
    {27, 512, 512, 0, 512, 512, 0, 0, 512, 512, BIGSEG, 0},
    {10, 512, 96, 0, 512, 256, 0, 0, 512, 256, BIGSEG, 0},
    {12, 512, 96, 0, 512, 256, 0, 0, 512, 256, BIGSEG, 0},
    {13, 512, 256, 0, 512, 256, 0, 0, 512, 256, BIGSEG, 0}};
__constant__ long JT_L[15][2] = {
    {(long)D * NIN, (long)OFF_WIN}, {(long)D * NIN, (long)OFF_WIN}, {(long)1024 * D, (long)OFF_WUP}, {(long)512 * D, (long)OFF_WUP}, {(long)512 * D, (long)OFF_WUP},
    {(long)D * D, (long)OFF_WO}, {(long)D * FH, (long)OFF_WGU}, {(long)D * FH, (long)OFF_WGU}, {(long)FH * D, (long)OFF_WD}, {(long)D * D, (long)OFF_WPG},
    {(long)256 * D, (long)OFF_WPP}, {(long)512 * 512, (long)OFF_WGLU}, {(long)96 * 512, (long)OFF_WW2}, {(long)96 * 512, (long)OFF_WA2}, {(long)256 * 512, (long)OFF_WG2}};
__device__ __forceinline__ void get_job(int j, CJ& J) {
    J.in_idx = JT_I[j][0]; J.src_ld = JT_I[j][1]; J.kv = JT_I[j][2]; J.n0 = JT_I[j][3]; J.nv = JT_I[j][4]; J.dst_ld = JT_I[j][5]; J.r0 = JT_I[j][6]; J.c0 = JT_I[j][7];
    J.npad = JT_I[j][8]; J.kpad = JT_I[j][9]; J.seg = JT_I[j][10]; J.segstride = JT_I[j][11]; J.lstride = JT_L[j][0]; J.dst = (size_t)JT_L[j][1];
}
__device__ __forceinline__ const float* in_by_idx(const Params& p, int i) { return P_IN(i); }
constexpr int NJOBS = 15;

__device__ __forceinline__ void conv_tile(int L, const CJ& J, int tile, int lane, bh* dstbase) {
    const int nkt = J.kpad / 64; const int tn = tile / nkt, tk = tile % nkt;
    const float* src = J.src + (size_t)L * J.lstride;
    const int cq = lane & 15, r = lane >> 4;
    const int nl = tn * 64 + cq * 4; const bool nok = nl < J.nv;
    const int k0 = tk * 64 + 16 * r;
    f32x4 v[16];
    const float* sp = src + (size_t)k0 * J.src_ld + J.n0 + nl;
    const float zc = OZ();
#pragma unroll
    for (int i = 0; i < 16; ++i) { v[i] = (f32x4){zc, zc, zc, zc}; if (nok && (k0 + i) < J.kv) v[i] = *(const f32x4*)(sp + (size_t)i * J.src_ld); }
#pragma unroll
    for (int j = 0; j < 4; ++j) { const int n = nl + j; const int drow = J.r0 + (n / J.seg) * J.segstride + (n % J.seg);
        u32x4 w0, w1;
        w0.x = cvt_pk_bf16(v[0][j], v[1][j]); w0.y = cvt_pk_bf16(v[2][j], v[3][j]); w0.z = cvt_pk_bf16(v[4][j], v[5][j]); w0.w = cvt_pk_bf16(v[6][j], v[7][j]);
        w1.x = cvt_pk_bf16(v[8][j], v[9][j]); w1.y = cvt_pk_bf16(v[10][j], v[11][j]); w1.z = cvt_pk_bf16(v[12][j], v[13][j]); w1.w = cvt_pk_bf16(v[14][j], v[15][j]);
        bh* d = dstbase + (size_t)drow * J.dst_ld + J.c0 + k0;
        *(u32x4*)d = w0; *(u32x4*)(d + 8) = w1; }
}

__device__ __forceinline__ void rms_row_bf16(const float* x, const float* g, bh* o, int lane) {
    f32x4 v[8]; float s = 0.f;
#pragma unroll
    for (int j = 0; j < 8; ++j) { v[j] = *(const f32x4*)(x + j * 256 + lane * 4); s += (v[j][0] * v[j][0] + v[j][1] * v[j][1]) + (v[j][2] * v[j][2] + v[j][3] * v[j][3]); }
    const float rstd = rsqrtf(wave_sum(s) * (1.0f / D) + 1e-6f);
#pragma unroll
    for (int j = 0; j < 8; ++j) { const f32x4 gg = *(const f32x4*)(g + j * 256 + lane * 4); u32x2 w; w.x = pk2(v[j][0] * rstd * gg[0], v[j][1] * rstd * gg[1]); w.y = pk2(v[j][2] * rstd * gg[2], v[j][3] * rstd * gg[3]);
        *(u32x2*)(o + j * 256 + lane * 4) = w; }
}
__device__ __forceinline__ void phase_rmsnorm(const Params& p, const float* g) {
    const int gw = BIDX() * 8 + (TIDX() >> 6), NGW = GDIM() * 8, lane = TIDX() & 63;
    bh* abf = (bh*)(P_WS + OFF_ABF);
    for (int r = gw; r < T; r += NGW) rms_row_bf16(P_OUT + (size_t)r * D, g, abf + (size_t)r * D, lane);
}

__device__ __forceinline__ void phase_conv(const Params& p, int L, LAS unsigned char* lds) {
    const int tid = TIDX();
    {   const int gw0 = BIDX() * 8 + (tid >> 6), NGW0 = GDIM() * 8, ln = tid & 63;
        int base = 0;
        for (int j = 0; j < NJOBS; ++j) { CJ J; get_job(j, J); J.src = in_by_idx(p, J.in_idx); const int ntile = (J.npad / 64) * (J.kpad / 64);
            int first = gw0 - (base % NGW0); if (first < 0) first += NGW0;
            bh* dstbase = (bh*)(P_WS + J.dst);
            for (int t = first; t < ntile; t += NGW0) conv_tile(L, J, t, ln, dstbase);
            base += ntile; } }
    const int gw = BIDX() * 8 + (tid >> 6), NGW = GDIM() * 8, lane = tid & 63;
    bh* abf = (bh*)(P_WS + OFF_ABF);
    if (L == 0) {
        const float* ps = P_IN(1); bh* pb = (bh*)(P_WS + OFF_PBF);
        for (size_t i = (size_t)BIDX() * 512 + tid; i < (size_t)2 * T * 256 / 4; i += (size_t)GDIM() * 512) { const f32x4 v = ((const f32x4*)ps)[i]; u32x2 w; w.x = pk2(v[0], v[1]); w.y = pk2(v[2], v[3]); ((u32x2*)pb)[i] = w; }
        const float* x = P_IN(0);
        for (int r = gw; r < T; r += NGW) {
#pragma unroll
            for (int j = 0; j < 8; ++j) *(f32x4*)(P_OUT + (size_t)r * D + j * 256 + lane * 4) = *(const f32x4*)(x + (size_t)r * D + j * 256 + lane * 4);
            rms_row_bf16(x + (size_t)r * D, P_IN(2), abf + (size_t)r * D, lane);
        }
    } else {
        for (int r = gw; r < T; r += NGW) rms_row_bf16(P_OUT + (size_t)r * D, P_IN(2) + (size_t)L * D, abf + (size_t)r * D, lane);
    }
}

struct S5C { float ar, ai; float br[16], bi[16]; };
__device__ __forceinline__ void s5_setup(const Params& p, int L, int g, int n, S5C& c) {
    const int gi = L * 32 + g;
    const float dt = __expf(P_IN(21)[gi]);
    const float are = P_IN(19)[gi * 64 + n], aim = P_IN(20)[gi * 64 + n];
    const float mag = __expf(are * dt), ang = aim * dt;
    float sn, cs;
    {
        const double a = (double)ang; const double k = rint(a * 0.15915494309189535); const float r = (float)(a - k * 6.283185307179586);
        sn = sinf(r); cs = cosf(r);
    }
    c.ar = mag * cs; c.ai = mag * sn;
    const float den = are * are + aim * aim, nr = c.ar - 1.0f, ni = c.ai;
    const float cr = (nr * are + ni * aim) / den, ci = (ni * are - nr * aim) / den;
    const float* bre = P_IN(22) + ((size_t)gi * 64 + n) * 16; const float* bim = P_IN(23) + ((size_t)gi * 64 + n) * 16;
#pragma unroll
    for (int q = 0; q < 4; ++q) { const f32x4 r4 = *(const f32x4*)(bre + q * 4), i4 = *(const f32x4*)(bim + q * 4);
#pragma unroll
        for (int j = 0; j < 4; ++j) { c.br[q * 4 + j] = cr * r4[j] - ci * i4[j]; c.bi[q * 4 + j] = cr * i4[j] + ci * r4[j]; } }
}
__device__ __forceinline__ void s5_step(const S5C& c, const LAS float* urow, float& sr, float& si) {
    float xr = 0.f, xi = 0.f;
#pragma unroll
    for (int q = 0; q < 4; ++q) { const f32x4 u4 = *(const LAS f32x4*)(urow + q * 4);
#pragma unroll
        for (int j = 0; j < 4; ++j) { xr = fmaf(u4[j], c.br[q * 4 + j], xr); xi = fmaf(u4[j], c.bi[q * 4 + j], xi); } }
    const float nr = c.ar * sr - c.ai * si + xr, ni = c.ar * si + c.ai * sr + xi;
    sr = nr; si = ni;
}
__device__ __forceinline__ void s5_stage_u(const float* zfc, LAS float* ul, int lane) {
    const float* src = zfc + (size_t)lane * ZF_LD;
    const f32x4 a = *(const f32x4*)src, b = *(const f32x4*)(src + 4), c = *(const f32x4*)(src + 8), d = *(const f32x4*)(src + 12);
    *(LAS f32x4*)(ul + lane * 16) = a; *(LAS f32x4*)(ul + lane * 16 + 4) = b; *(LAS f32x4*)(ul + lane * 16 + 8) = c; *(LAS f32x4*)(ul + lane * 16 + 12) = d;
    asm volatile("s_waitcnt lgkmcnt(0)" ::: "memory"); __builtin_amdgcn_wave_barrier();
}

__device__ __forceinline__ size_t fq_base(int h, int c, int mt, int ks8) { return ((((size_t)(h * NCH + c) * 4 + mt) * 8 + ks8) * 64) * 8; }
__device__ __forceinline__ size_t fq_off(int h, int t, int d) { const int s = t & 63; return fq_base(h, t >> 6, s >> 4, d >> 5) + ((s & 15) + 16 * ((d >> 3) & 3)) * 8 + (d & 7); }
__device__ __forceinline__ int ft_off(int row, int s8) { return ((((row >> 5) * 4 + (s8 >> 1)) * 64) + (row & 31) + 32 * (s8 & 1)) * 8; }

__device__ __forceinline__ void mlstm_prep(const Params& p, int L, int h, int c, LAS unsigned char* lds) {
    const int tid = TIDX(), t0 = c * 64;
    const float* zf = (const float*)(P_WS + OFF_ZF);
    LAS float* s_ws = (LAS float*)lds;
    if (tid < 64) {
        const int t = t0 + tid;
        float ig = zf[(size_t)t * ZF_LD + 4096 + h] + P_IN(5)[L * 4 + h];
        float fg = zf[(size_t)t * ZF_LD + 4100 + h] + P_IN(6)[L * 4 + h];
        ig = 15.0f * tanhf(ig * (1.0f / 15.0f)); fg = 15.0f * tanhf(fg * (1.0f / 15.0f));
        const float lf = fminf(fg, 0.f) - log1pf(__expf(-fabsf(fg)));
        float b = lf;
#pragma unroll
        for (int o = 1; o < 64; o <<= 1) { const float nb = bperm_f((tid - o) & 63, b); if (tid >= o) b += nb; }
        const float bend = bperm_f(63, b);
        const float wlog = bend - b + ig;
        const float mloc = wave_max(wlog);
        s_ws[tid] = __expf(wlog - mloc);
        ((float*)(P_WS + OFF_MI))[h * T + t] = ig; ((float*)(P_WS + OFF_MBB))[h * T + t] = b;
        if (tid == 0) { ((float*)(P_WS + OFF_MBEND))[h * NCH + c] = bend; ((float*)(P_WS + OFF_MLOC))[h * NCH + c] = mloc; }
    }
    __syncthreads();
    const int d = tid & 255, isk = tid >> 8;
    const int col = isk * 1024 + h * 256 + d;
    const float* cw = P_IN(4) + (size_t)L * 4 * 2048;
    const float w0 = cw[col], w1 = cw[2048 + col], w2 = cw[4096 + col], w3 = cw[6144 + col];
    float x1 = (t0 >= 1) ? zf[(size_t)(t0 - 1) * ZF_LD + col] : 0.f, x2 = (t0 >= 2) ? zf[(size_t)(t0 - 2) * ZF_LD + col] : 0.f, x3 = (t0 >= 3) ? zf[(size_t)(t0 - 3) * ZF_LD + col] : 0.f;
    bh* MQ = (bh*)(P_WS + OFF_MQ); bh* MK = (bh*)(P_WS + OFF_MK);
    bh* MT = (bh*)(P_WS + (isk ? OFF_MKT : OFF_MVT)) + (size_t)(h * NCH + c) * 16384;
    LAS bh* sQK = (LAS bh*)(lds + 1024);
    float dnacc = 0.f;
    for (int s8 = 0; s8 < 8; ++s8) {
        unsigned pk[4];
#pragma unroll
        for (int j = 0; j < 8; ++j) { const int s = s8 * 8 + j, t = t0 + s;
            const float x0 = zf[(size_t)t * ZF_LD + col]; float y = w0 * x0 + w1 * x1 + w2 * x2 + w3 * x3; x3 = x2; x2 = x1; x1 = x0;
            y = y * sigmoidf_(y);
            unsigned short e;
            if (!isk) { sQK[s * 264 + d] = f2bf(y * 0.0625f); e = f2bf(zf[(size_t)t * ZF_LD + 2048 + h * 256 + d]); }
            else { sQK[64 * 264 + s * 264 + d] = f2bf(y); const float wk = y * s_ws[s]; e = f2bf(wk); dnacc += wk; }
            if (j & 1) pk[j >> 1] |= ((unsigned)e << 16); else pk[j >> 1] = e; }
        u32x4 w; w.x = pk[0]; w.y = pk[1]; w.z = pk[2]; w.w = pk[3];
        *(u32x4*)(MT + ft_off(d, s8)) = w;
    }
    if (isk) ((float*)(P_WS + OFF_DN))[(size_t)(h * NCH + c) * 256 + d] = dnacc;
    __syncthreads();
#pragma unroll
    for (int i = 0; i < 8; ++i) { const int pid = i * 512 + tid, tens = pid >> 11, rem = pid & 2047, mt = rem >> 9, ks8 = (rem >> 6) & 7, lp = rem & 63;
        const u32x4 w = *(const LAS u32x4*)(sQK + tens * (64 * 264) + (mt * 16 + (lp & 15)) * 264 + ks8 * 32 + (lp >> 4) * 8);
        *(u32x4*)((tens ? MK : MQ) + fq_base(h, c, mt, ks8) + lp * 8) = w; }
    __syncthreads();
}

__device__ __forceinline__ void rwkv_prep_token(const Params& p, int L, int t, int lane) {
    const float* zf = (const float*)(P_WS + OFF_ZF);
    const float* z = zf + (size_t)t * ZF_LD + ZR0; const float* zp = z - ZF_LD; const bool hp = t > 0;
    const float* mu = P_IN(8) + (size_t)L * 1984;
    float* RR = (float*)(P_WS + OFF_RR); float* RK = (float*)(P_WS + OFF_RK); float* RV = (float*)(P_WS + OFF_RV); float* RKK = (float*)(P_WS + OFF_RKK);
    const float* kkw = P_IN(14) + L * 512;
    float sr[8], sk[8], sv[8], kw[8], lw[2], la[2], lg[4];
#pragma unroll
    for (int i = 0; i < 8; ++i) { const int c = i * 64 + lane;
        { const float a = z[c], b = hp ? zp[c] : 0.f; sr[i] = a + (b - a) * mu[c]; }
        { const float a = z[512 + c], b = hp ? zp[512 + c] : 0.f; sk[i] = a + (b - a) * mu[512 + c]; }
        { const float a = z[1024 + c], b = hp ? zp[1024 + c] : 0.f; sv[i] = a + (b - a) * mu[1024 + c]; }
        kw[i] = kkw[c]; }
#pragma unroll
    for (int i = 0; i < 2; ++i) { const int j = i * 64 + lane; lw[i] = 0.f; la[i] = 0.f;
        if (j < 96) { { const int c = 1536 + j; const float a = z[c], b = hp ? zp[c] : 0.f; lw[i] = a + (b - a) * mu[c]; }
                      { const int c = 1632 + j; const float a = z[c], b = hp ? zp[c] : 0.f; la[i] = a + (b - a) * mu[c]; } } }
#pragma unroll
    for (int i = 0; i < 4; ++i) { const int c = 1728 + i * 64 + lane; const float a = z[c], b = hp ? zp[c] : 0.f; lg[i] = a + (b - a) * mu[c]; }
    __builtin_amdgcn_sched_barrier(0);
#pragma unroll
    for (int i = 0; i < 8; ++i) { const int c = i * 64 + lane;
        RR[(size_t)t * 512 + c] = sr[i]; RV[(size_t)t * 512 + c] = sv[i]; RK[(size_t)t * 512 + c] = sk[i];
        const float kkv = sk[i] * kw[i]; const float ss = wave_sum(kkv * kkv); RKK[(size_t)t * 512 + c] = kkv / fmaxf(sqrtf(ss), 1e-12f); }
    bh* LAW = (bh*)(P_WS + OFF_LAW) + (size_t)t * 256; bh* LAA = (bh*)(P_WS + OFF_LAA) + (size_t)t * 256; bh* LAG = (bh*)(P_WS + OFF_LAG) + (size_t)t * 256;
#pragma unroll
    for (int i = 0; i < 4; ++i) { const int j = i * 64 + lane;
        float vw = 0.f, va = 0.f;
        if (i < 2 && j < 96) { vw = tanhf(lw[i < 2 ? i : 0]); va = la[i < 2 ? i : 0]; }
        LAW[j] = f2bf(vw); LAA[j] = f2bf(va); LAG[j] = f2bf(sigmoidf_(lg[i])); }
}

__device__ __forceinline__ void s5_pass_a(const Params& p, int L, int g, int c, int lane, LAS float* ul) {
    const float* zf = (const float*)(P_WS + OFF_ZF) + (size_t)(c * 64) * ZF_LD + ZS0 + g * 16;
    s5_stage_u(zf, ul, lane);
    S5C k; s5_setup(p, L, g, lane, k);
    float sr = 0.f, si = 0.f;
#pragma unroll 8
    for (int s = 0; s < 64; ++s) s5_step(k, ul + s * 16, sr, si);
    asm volatile("s_waitcnt lgkmcnt(0)" ::: "memory"); __builtin_amdgcn_wave_barrier();
    float* se = (float*)(P_WS + OFF_SEND) + ((size_t)(g * NCH + c) * 64 + lane) * 2;
    se[0] = sr; se[1] = si;
}

__device__ __forceinline__ void phase_prep(const Params& p, int L, LAS unsigned char* lds) {
    const int wid = TIDX() >> 6, lane = TIDX() & 63;
    for (int it = BIDX(); it < 2048; it += GDIM()) {
        if (it < 512) mlstm_prep(p, L, it >> 7, it & 127, lds);
        else if (it < 1536) rwkv_prep_token(p, L, (it - 512) * 8 + wid, lane);
        else { const int w = (it - 1536) * 8 + wid; s5_pass_a(p, L, w >> 7, w & 127, lane, (LAS float*)lds + wid * 1024); }
    }
}

constexpr int RW_NS = 4, RW_LS = T / RW_NS, RW_NB = RW_LS / 16, RW_RING = 4, RW_SLOT = 16 * 384;
constexpr int RW_YOFF = RW_RING * RW_SLOT;
__device__ __forceinline__ void rwkv_scan(const Params& p, int b, LAS unsigned char* lds) {
    const int tid = TIDX(), wid = __builtin_amdgcn_readfirstlane(tid >> 6), lane = tid & 63;
    int j, h, rg;
    if (b < 32) { j = 0; h = b >> 2; rg = b & 3; } else { const int u = b - 32; j = 1 + (u >> 6); h = (u & 63) >> 3; rg = u & 7; }
    LAS float* ring = (LAS float*)lds;
    LAS float* ybuf = ring + RW_YOFF;
    const int tbase = j * RW_LS;
    const bool isP = rg >= 4;
    if (wid >= 4) {
        const int lw = wid - 4, lt = tid - 256;
        const float* gp[6]; unsigned lo[6];
#pragma unroll
        for (int i = 0; i < 6; ++i) { const int ii = lw * 6 + i, rowidx = ii * 4 + (lane >> 4), step = rowidx / 6, a = rowidx % 6, q = lane & 15;
            const int ai = (0x205314 >> (4 * a)) & 0xf;
            gp[i] = (const float*)(P_WS + OFF_RR + (size_t)ai * SZ_R) + (size_t)(tbase + step) * 512 + h * 64 + q * 4;
            lo[i] = (unsigned)ii * 256u; }
        float* OUT = (float*)(P_WS + (isP ? OFF_RZ : OFF_RY)) + (size_t)(tbase + (lt >> 4)) * 512 + h * 64 + (rg & 3) * 16 + (lt & 15);
#define RW_ISSUE(bi, sl) do { _Pragma("unroll") for (int _i = 0; _i < 6; ++_i) \
        __builtin_amdgcn_global_load_lds((const unsigned*)(gp[_i] + (size_t)(bi) * 16 * 512), (LAS unsigned*)(ring + (sl) * RW_SLOT + lo[_i]), 16, 0, 0); } while (0)
        RW_ISSUE(0, 0); RW_ISSUE(1, 1); RW_ISSUE(2, 2);
        asm volatile("s_waitcnt vmcnt(12)" ::: "memory"); __builtin_amdgcn_s_barrier();
        int sl = 3;
        for (int ib = 0; ib < RW_NB; ++ib) {
            if (ib + 3 < RW_NB) RW_ISSUE(ib + 3, sl);
            sl = (sl == RW_RING - 1) ? 0 : sl + 1;
            if (ib > 0) {
                const LAS float* yb = ybuf + ((ib - 1) & 1) * 4096 + lt * 16;
                const f32x4 a0 = *(const LAS f32x4*)yb, a1 = *(const LAS f32x4*)(yb + 4), a2 = *(const LAS f32x4*)(yb + 8), a3 = *(const LAS f32x4*)(yb + 12);
                const f32x4 sm = (a0 + a1) + (a2 + a3);
                OUT[(size_t)(ib - 1) * 16 * 512] = (sm[0] + sm[1]) + (sm[2] + sm[3]);
            }
            if (ib + 3 < RW_NB) asm volatile("s_waitcnt vmcnt(13)" ::: "memory");
            else asm volatile("s_waitcnt vmcnt(0)" ::: "memory");
            __builtin_amdgcn_s_barrier();
        }
        {   const LAS float* yb = ybuf + ((RW_NB - 1) & 1) * 4096 + lt * 16;
            const f32x4 a0 = *(const LAS f32x4*)yb, a1 = *(const LAS f32x4*)(yb + 4), a2 = *(const LAS f32x4*)(yb + 8), a3 = *(const LAS f32x4*)(yb + 12);
            const f32x4 sm = (a0 + a1) + (a2 + a3);
            OUT[(size_t)(RW_NB - 1) * 16 * 512] = (sm[0] + sm[1]) + (sm[2] + sm[3]); }
#undef RW_ISSUE
    } else {
        const int r16 = wid * 4 + (lane >> 4), kq = lane & 15, row = (rg & 3) * 16 + r16;
        f32x4 S;
#pragma unroll
        for (int e = 0; e < 4; ++e) S[e] = (isP && (kq * 4 + e == row)) ? 1.f : 0.f;
        const float vmask = isP ? 0.f : 1.f;
        __builtin_amdgcn_s_barrier();
        int sl = 0;
        for (int ib = 0; ib < RW_NB; ++ib) {
            const LAS float* bb = ring + sl * RW_SLOT;
            LAS float* yw = ybuf + (ib & 1) * 4096 + r16 * 16 + kq;
            f32x4 w4 = *(const LAS f32x4*)(bb + kq * 4), k4 = *(const LAS f32x4*)(bb + 64 + kq * 4), kk4 = *(const LAS f32x4*)(bb + 128 + kq * 4),
                  b4 = *(const LAS f32x4*)(bb + 192 + kq * 4), r4 = *(const LAS f32x4*)(bb + 256 + kq * 4);
            float vv = bb[320 + row];
#pragma unroll
            for (int s = 0; s < 16; ++s) {
                f32x4 w4n, k4n, kk4n, b4n, r4n; float vvn;
                if (s < 15) { const LAS float* q = bb + (s + 1) * 384;
                    w4n = *(const LAS f32x4*)(q + kq * 4); k4n = *(const LAS f32x4*)(q + 64 + kq * 4); kk4n = *(const LAS f32x4*)(q + 128 + kq * 4);
                    b4n = *(const LAS f32x4*)(q + 192 + kq * 4); r4n = *(const LAS f32x4*)(q + 256 + kq * 4); vvn = q[320 + row]; }
                __builtin_amdgcn_sched_barrier(0);
                float pd = fmaf(S[0], kk4[0], fmaf(S[1], kk4[1], fmaf(S[2], kk4[2], S[3] * kk4[3])));
                const f32x4 pre = S * w4 + (vv * vmask) * k4;
                pd = allreduce16(pd);
                S = pre + pd * b4;
                yw[s * 256] = fmaf(S[0], r4[0], fmaf(S[1], r4[1], fmaf(S[2], r4[2], S[3] * r4[3])));
                if (s < 15) { w4 = w4n; k4 = k4n; kk4 = kk4n; b4 = b4n; r4 = r4n; vv = vvn; }
            }
            sl = (sl == RW_RING - 1) ? 0 : sl + 1;
            asm volatile("s_waitcnt lgkmcnt(0)" ::: "memory");
            __builtin_amdgcn_s_barrier();
        }
        float* EN = (float*)(P_WS + (isP ? OFF_RPEND : OFF_RSEND)) + ((size_t)(h * 4 + j) * 64 + row) * 64 + kq * 4;
        *(f32x4*)EN = S;
    }
    __syncthreads();
}

struct MStage { bf16x8 q[4], k[4], v[4]; float bend, mloc; };
__device__ __forceinline__ void mstage_load(MStage& st, const bh* qp, const bh* kp, const bh* vp, const float* MBEND, const float* MLOC, int h, int c) {
#pragma unroll
    for (int ks = 0; ks < 4; ++ks) { st.q[ks] = *(const bf16x8*)(qp + (size_t)c * 16384 + ks * 512); st.k[ks] = *(const bf16x8*)(kp + (size_t)c * 16384 + ks * 512); st.v[ks] = *(const bf16x8*)(vp + (size_t)c * 16384 + ks * 512); }
    st.bend = MBEND[h * NCH + c]; st.mloc = MLOC[h * NCH + c];
}
__device__ __forceinline__ void mlstm_seq(const Params& p, int mb, LAS unsigned char* lds) {
    const int tid = TIDX(), wid = tid >> 6, lane = tid & 63;
    const int h = mb >> 3, jv = mb & 7;
    LAS bh* Cbf = (LAS bh*)lds;
    constexpr int CS = 264;
    for (int i = tid; i < 2 * 32 * CS / 2; i += 512) ((LAS unsigned*)Cbf)[i] = 0u;
    __syncthreads();
    const bh* MQ = (const bh*)(P_WS + OFF_MQ); const bh* MKT = (const bh*)(P_WS + OFF_MKT); const bh* MVT = (const bh*)(P_WS + OFF_MVT);
    const float* MBEND = (const float*)(P_WS + OFF_MBEND); const float* MLOC = (const float*)(P_WS + OFF_MLOC);
    f32x16 ct;
    { const float z = OZ();
#pragma unroll
    for (int i = 0; i < 16; ++i) ct[i] = z; }
    float m = 0.f;
    const int mt = wid >> 1, kh = wid & 1;
    float* MINTER = (float*)(P_WS + OFF_ABF);
    LAS float* It = (LAS float*)(lds + 2 * 32 * 264 * 2);
    const bh* qp = MQ + fq_base(h, 0, mt, kh * 4) + lane * 8;
    const bh* kp = MKT + (size_t)(h * NCH) * 16384 + (wid * 4 * 64 + lane) * 8;
    const bh* vp = MVT + (size_t)(h * NCH) * 16384 + (jv * 4 * 64 + lane) * 8;
    MStage s0, s1, s2;
    mstage_load(s0, qp, kp, vp, MBEND, MLOC, h, 0);
    mstage_load(s1, qp, kp, vp, MBEND, MLOC, h, 1);
#define MSTEP(SC, SL, CIDX) do { const int c = (CIDX); const int t0 = c * 64, cur = c & 1; \
        mstage_load(SL, qp, kp, vp, MBEND, MLOC, h, (c + 2 < NCH) ? c + 2 : NCH - 1); \
        const float mnew = fmaxf(SC.bend + m, SC.mloc), decay = __expf(SC.bend + m - mnew), scale = __expf(SC.mloc - mnew); \
        f32x4 r0 = {0.f, 0.f, 0.f, 0.f}, r1 = {0.f, 0.f, 0.f, 0.f}; \
        const LAS bh* cb = Cbf + cur * 32 * CS + (lane & 15) * CS + kh * 128 + (lane >> 4) * 8; \
        _Pragma("unroll") for (int ks = 0; ks < 4; ++ks) { const bf16x8 b0 = *(const LAS bf16x8*)(cb + ks * 32), b1 = *(const LAS bf16x8*)(cb + 16 * CS + ks * 32); r0 = MFMA16(SC.q[ks], b0, r0); r1 = MFMA16(SC.q[ks], b1, r1); } \
        {     \
            if (c > 0) { const LAS float* ip = It + ((c - 1) & 1) * (2 * 64 * 36) + (tid >> 3) * 36 + (tid & 7) * 4; \
                const f32x4 sv = *(const LAS f32x4*)ip + *(const LAS f32x4*)(ip + 64 * 36); \
                float* o = MINTER + (size_t)(t0 - 64 + (tid >> 3)) * 1024 + h * 256 + jv * 32 + (tid & 7) * 4; \
                asm volatile("global_store_dwordx4 %0, %1, off\n\ts_nop 1" :: "v"(o), "v"(sv) : "memory"); } \
            LAS float* iw = It + cur * (2 * 64 * 36) + kh * (64 * 36) + (mt * 16 + (lane >> 4) * 4) * 36 + (lane & 15); \
            _Pragma("unroll") for (int r = 0; r < 4; ++r) { iw[r * 36] = r0[r]; iw[r * 36 + 16] = r1[r]; } } \
        f32x16 d0; { const float z = OZ(); _Pragma("unroll") for (int i = 0; i < 16; ++i) d0[i] = z; } \
        _Pragma("unroll") for (int ks = 0; ks < 4; ++ks) d0 = MFMA32(SC.k[ks], SC.v[ks], d0); \
        _Pragma("unroll") for (int i = 0; i < 16; ++i) ct[i] = decay * ct[i] + scale * d0[i]; \
        m = mnew; \
        {   LAS bh* o0 = Cbf + (cur ^ 1) * 32 * CS + (lane & 31) * CS + wid * 32 + 4 * (lane >> 5); \
            _Pragma("unroll") for (int g = 0; g < 4; ++g) { u32x2 w0; w0.x = cvt_pk_bf16(ct[4 * g], ct[4 * g + 1]); w0.y = cvt_pk_bf16(ct[4 * g + 2], ct[4 * g + 3]); *(LAS u32x2*)(o0 + 8 * g) = w0; } } \
        asm volatile("s_waitcnt lgkmcnt(0)" ::: "memory"); __builtin_amdgcn_s_barrier(); asm volatile("" ::: "memory"); } while (0)
    for (int c3 = 0; c3 < 126; c3 += 6) { MSTEP(s0, s2, c3); MSTEP(s1, s0, c3 + 1); MSTEP(s2, s1, c3 + 2); MSTEP(s0, s2, c3 + 3); MSTEP(s1, s0, c3 + 4); MSTEP(s2, s1, c3 + 5); }
    MSTEP(s0, s2, 126); MSTEP(s1, s0, 127);
#undef MSTEP
    {   const LAS float* ip = It + (127 & 1) * (2 * 64 * 36) + (tid >> 3) * 36 + (tid & 7) * 4;
        const f32x4 sv = *(const LAS f32x4*)ip + *(const LAS f32x4*)(ip + 64 * 36);
        *(f32x4*)(MINTER + (size_t)(127 * 64 + (tid >> 3)) * 1024 + h * 256 + jv * 32 + (tid & 7) * 4) = sv; }
    asm volatile("s_waitcnt vmcnt(0)" ::: "memory");
    __syncthreads();
}

__device__ __forceinline__ void mlstm_nscan(const Params& p) {
    const float* MBEND = (const float*)(P_WS + OFF_MBEND); const float* MLOC = (const float*)(P_WS + OFF_MLOC);
    const float* DN = (const float*)(P_WS + OFF_DN); float* NST = (float*)(P_WS + OFF_NST); float* MSTART = (float*)(P_WS + OFF_MSTART);
    for (int idx = TIDX(); idx < 1024; idx += 512) { const int h = idx >> 8, d = idx & 255; float m = 0.f, n = 0.f;
#pragma unroll 8
        for (int c = 0; c < NCH; ++c) { if (d == 0) MSTART[h * NCH + c] = m; NST[(size_t)(h * NCH + c) * 256 + d] = n;
            const float bend = MBEND[h * NCH + c], mloc = MLOC[h * NCH + c]; const float mnew = fmaxf(bend + m, mloc);
            n = __expf(bend + m - mnew) * n + __expf(mloc - mnew) * DN[(size_t)(h * NCH + c) * 256 + d]; m = mnew; } }
}

__device__ __forceinline__ float gelu_tanh(float x) { const float u = 0.7978845608028654f * (x + 0.044715f * x * x * x); return 0.5f * x * (1.0f + tanhf(u)); }

__device__ __forceinline__ void s5_pass_c(const Params& p, int L, int g, int c, int lane, LAS bh* img, LAS float* ul) {
    const float* zf = (const float*)(P_WS + OFF_ZF) + (size_t)(c * 64) * ZF_LD + ZS0 + g * 16;
    s5_stage_u(zf, ul, lane);
    S5C k; s5_setup(p, L, g, lane, k);
    float sr = 0.f, si = 0.f;
    {   float pr = k.ar, pi = k.ai;
#pragma unroll
        for (int i = 0; i < 6; ++i) { const float nr = pr * pr - pi * pi, ni = 2.f * pr * pi; pr = nr; pi = ni; }
        const float* se = (const float*)(P_WS + OFF_SEND) + ((size_t)(g * NCH) * 64 + lane) * 2;
        int cc = 0;
        for (; cc + 8 <= c; cc += 8) { float er[8], ei[8];
#pragma unroll
            for (int j = 0; j < 8; ++j) { er[j] = se[(size_t)(cc + j) * 128]; ei[j] = se[(size_t)(cc + j) * 128 + 1]; }
#pragma unroll
            for (int j = 0; j < 8; ++j) { const float nr = pr * sr - pi * si + er[j], ni = pr * si + pi * sr + ei[j]; sr = nr; si = ni; } }
        for (; cc < c; ++cc) { const float er = se[(size_t)cc * 128], ei = se[(size_t)cc * 128 + 1];
            const float nr = pr * sr - pi * si + er, ni = pr * si + pi * sr + ei; sr = nr; si = ni; } }
    const int gi = L * 32 + g;
    bf16x8 bfr[4];
    {   const int pp = lane & 15; const float* cre = P_IN(24) + ((size_t)gi * 16 + pp) * 64; const float* cim = P_IN(25) + ((size_t)gi * 16 + pp) * 64;
#pragma unroll
        for (int ks = 0; ks < 4; ++ks)
#pragma unroll
            for (int j = 0; j < 8; ++j) { const int n2 = ks * 32 + (lane >> 4) * 8 + j; const float v = (n2 < 64) ? cre[n2] : -cim[n2 - 64]; bfr[ks][j] = (short)f2bf(v); } }
    const float dco = P_IN(26)[L * 512 + g * 16 + (lane & 15)];
    bh* YS = (bh*)(P_WS + OFF_YS);
    for (int half = 0; half < 2; ++half) {
#pragma unroll 8
        for (int s = 0; s < 32; ++s) { s5_step(k, ul + (half * 32 + s) * 16, sr, si); img[s * 136 + lane] = f2bf(sr); img[s * 136 + 64 + lane] = f2bf(si); }
        asm volatile("s_waitcnt lgkmcnt(0)" ::: "memory"); __builtin_amdgcn_wave_barrier();
#pragma unroll
        for (int mt = 0; mt < 2; ++mt) { f32x4 acc = {0.f, 0.f, 0.f, 0.f};
#pragma unroll
            for (int ks = 0; ks < 4; ++ks) { const bf16x8 a = *(const LAS bf16x8*)(img + (mt * 16 + (lane & 15)) * 136 + ks * 32 + (lane >> 4) * 8); acc = MFMA16(a, bfr[ks], acc); }
#pragma unroll
            for (int r = 0; r < 4; ++r) { const int tt = half * 32 + mt * 16 + (lane >> 4) * 4 + r; const float uv = ul[tt * 16 + (lane & 15)];
                YS[(size_t)(c * 64 + tt) * 512 + g * 16 + (lane & 15)] = f2bf(gelu_tanh(acc[r] + dco * uv)); } }
        asm volatile("s_waitcnt lgkmcnt(0)" ::: "memory"); __builtin_amdgcn_wave_barrier();
    }
}

__device__ __forceinline__ void phase_scan(const Params& p, int L, LAS unsigned char* lds) {
    const int b = BIDX();
    if (b < 224) { for (int rr = 0; rr < PROBE_RW; ++rr) rwkv_scan(p, b, lds); }
    else { for (int rr = 0; rr < PROBE_ML; ++rr) mlstm_seq(p, b - 224, lds); }
}
__device__ __forceinline__ void phase_s5c(const Params& p, int L, LAS unsigned char* lds) {
    const int b = BIDX(), wid = TIDX() >> 6, lane = TIDX() & 63;
    if (b == GDIM() - 1) mlstm_nscan(p);
    const int nw = GDIM() * 8;
    for (int w = b * 8 + wid; w < 32 * NCH; w += nw) s5_pass_c(p, L, w >> 7, w & 127, lane, (LAS bh*)lds + wid * (32 * 136), (LAS float*)(lds + 69632) + wid * 1024);
    __syncthreads();
}

__device__ __forceinline__ void mlstm_out(const Params& p, int L, int h, int c, LAS unsigned char* lds) {
    const int tid = TIDX(), wid = tid >> 6, lane = tid & 63, t0 = c * 64;
    LAS bh* Pl = (LAS bh*)lds;
    LAS float* s_b = (LAS float*)(lds + 9216); LAS float* s_a = s_b + 64; LAS float* s_mt = s_a + 64; LAS float* s_iw = s_mt + 64; LAS float* s_den = s_iw + 64; LAS float* s_qn = s_den + 64; LAS float* s_part = s_qn + 64;
    const bh* MQ = (const bh*)(P_WS + OFF_MQ); const bh* MK = (const bh*)(P_WS + OFF_MK); const bh* MVT = (const bh*)(P_WS + OFF_MVT);
    const float* MINTER = (const float*)(P_WS + OFF_ABF);
    const float m0 = ((const float*)(P_WS + OFF_MSTART))[h * NCH + c];
    if (tid < 64) { const float ig = ((const float*)(P_WS + OFF_MI))[h * T + t0 + tid], b = ((const float*)(P_WS + OFF_MBB))[h * T + t0 + tid];
        const float a = ig - b; float cm = a;
#pragma unroll
        for (int o = 1; o < 64; o <<= 1) { const float nb = bperm_f((tid - o) & 63, cm); if (tid >= o) cm = fmaxf(cm, nb); }
        const float mt = b + fmaxf(m0, cm);
        s_b[tid] = b; s_a[tid] = a; s_mt[tid] = mt; s_iw[tid] = __expf(b + m0 - mt); }
    __syncthreads();
    {
        const int mt = wid >> 1, nt0 = (wid & 1) * 2;
        f32x4 r0 = {0.f, 0.f, 0.f, 0.f}, r1 = {0.f, 0.f, 0.f, 0.f};
        const bh* qp = MQ + fq_base(h, c, mt, 0) + lane * 8;
        const bh* kp = MK + fq_base(h, c, nt0, 0) + lane * 8;
#pragma unroll
        for (int ks = 0; ks < 8; ++ks) { const bf16x8 a = *(const bf16x8*)(qp + ks * 512); const bf16x8 b0 = *(const bf16x8*)(kp + ks * 512), b1 = *(const bf16x8*)(kp + 8 * 512 + ks * 512);
            r0 = MFMA16(a, b0, r0); r1 = MFMA16(a, b1, r1); }
#pragma unroll
        for (int r = 0; r < 4; ++r) { const int t = mt * 16 + (lane >> 4) * 4 + r; const float bt = s_b[t] - s_mt[t];
            { const int s = nt0 * 16 + (lane & 15); const float pv = (s <= t) ? r0[r] * __expf(bt + s_a[s]) : 0.f; Pl[t * 72 + s] = f2bf(pv); }
            { const int s = nt0 * 16 + 16 + (lane & 15); const float pv = (s <= t) ? r1[r] * __expf(bt + s_a[s]) : 0.f; Pl[t * 72 + s] = f2bf(pv); } }
    }
    __syncthreads();
    if (tid < 64) { float s = 0.f;
#pragma unroll
        for (int q = 0; q < 8; ++q) { const u32x4 w = *(const LAS u32x4*)(Pl + tid * 72 + q * 8);
            s += __uint_as_float(w.x << 16) + __uint_as_float(w.x & 0xffff0000u) + __uint_as_float(w.y << 16) + __uint_as_float(w.y & 0xffff0000u)
               + __uint_as_float(w.z << 16) + __uint_as_float(w.z & 0xffff0000u) + __uint_as_float(w.w << 16) + __uint_as_float(w.w & 0xffff0000u); }
        s_den[tid] = s; }
    {
        const float* nst = (const float*)(P_WS + OFF_NST) + (size_t)(h * NCH + c) * 256 + lane * 4; const f32x4 nv = *(const f32x4*)nst;
#pragma unroll
        for (int i = 0; i < 8; ++i) { const int t = wid * 8 + i; const u32x2 q2 = *(const u32x2*)(MQ + fq_off(h, t0 + t, lane * 4));
            float s = __uint_as_float(q2.x << 16) * nv[0] + __uint_as_float(q2.x & 0xffff0000u) * nv[1] + __uint_as_float(q2.y << 16) * nv[2] + __uint_as_float(q2.y & 0xffff0000u) * nv[3];
            s = wave_sum(s); if (lane == 0) s_qn[t] = s; } }
    f32x4 acc[4][2];
#pragma unroll
    for (int a = 0; a < 4; ++a) { const float z = OZ(); acc[a][0] = (f32x4){z, z, z, z}; acc[a][1] = (f32x4){z, z, z, z}; }
    {   const bh* vp = MVT + (size_t)(h * NCH + c) * 16384;
#pragma unroll
        for (int ks = 0; ks < 2; ++ks) { const bf16x8 b0 = *(const bf16x8*)(vp + ft_off(wid * 32 + (lane & 15), ks * 4 + (lane >> 4))), b1 = *(const bf16x8*)(vp + ft_off(wid * 32 + 16 + (lane & 15), ks * 4 + (lane >> 4)));
#pragma unroll
            for (int a = 0; a < 4; ++a) { const bf16x8 av = *(const LAS bf16x8*)(Pl + (a * 16 + (lane & 15)) * 72 + ks * 32 + (lane >> 4) * 8);
                acc[a][0] = MFMA16(av, b0, acc[a][0]); acc[a][1] = MFMA16(av, b1, acc[a][1]); } } }
    __syncthreads();
#pragma unroll
    for (int a = 0; a < 4; ++a)
#pragma unroll
        for (int r = 0; r < 4; ++r) { const int t = a * 16 + (lane >> 4) * 4 + r; const float iw = s_iw[t];
            const float den = s_den[t] + iw * s_qn[t]; const float dd = 1.0f / fmaxf(fabsf(den), __expf(-s_mt[t]));
            const float* mi = MINTER + (size_t)(t0 + t) * 1024 + h * 256 + wid * 32 + (lane & 15);
            const float h0 = (acc[a][0][r] + iw * mi[0]) * dd, h1 = (acc[a][1][r] + iw * mi[16]) * dd;
            acc[a][0][r] = h0; acc[a][1][r] = h1;
            float ss = h0 * h0 + h1 * h1;
            ss = allreduce16(ss);
            if ((lane & 15) == 0) s_part[wid * 64 + t] = ss; }
    __syncthreads();
    {   const float* zf = (const float*)(P_WS + OFF_ZF); const float* ng = P_IN(7) + L * 1024 + h * 256; bh* YC = (bh*)(P_WS + OFF_YCAT);
        float og[4][4][2]; const float ng0 = ng[wid * 32 + (lane & 15)], ng1 = ng[wid * 32 + 16 + (lane & 15)];
#pragma unroll
        for (int a = 0; a < 4; ++a)
#pragma unroll
            for (int r = 0; r < 4; ++r) { const float* op = zf + (size_t)(t0 + a * 16 + (lane >> 4) * 4 + r) * ZF_LD + 3072 + h * 256 + wid * 32 + (lane & 15); og[a][r][0] = op[0]; og[a][r][1] = op[16]; }
        __builtin_amdgcn_sched_barrier(0);
#pragma unroll
        for (int a = 0; a < 4; ++a)
#pragma unroll
            for (int r = 0; r < 4; ++r) { const int t = a * 16 + (lane >> 4) * 4 + r;
                float tot = 0.f;
#pragma unroll
                for (int w = 0; w < 8; ++w) tot += s_part[w * 64 + t];
                const float rstd = rsqrtf(tot * (1.0f / 256.0f) + 1e-6f);
                const int v0 = wid * 32 + (lane & 15);
                bh* yo = YC + (size_t)(t0 + t) * D + h * 256 + v0;
                yo[0] = f2bf(sigmoidf_(og[a][r][0]) * acc[a][0][r] * rstd * ng0);
                yo[16] = f2bf(sigmoidf_(og[a][r][1]) * acc[a][1][r] * rstd * ng1); } }
    __syncthreads();
}

__device__ __forceinline__ void rwkv_post(const Params& p, int L, int it, LAS unsigned char* lds) {
    const int tid = TIDX(), wid = tid >> 6, lane = tid & 63;
    const int h = it & 7, blk = it >> 3, j = blk >> 3;
    LAS float* bufA = (LAS float*)lds;
    LAS float* bufB = bufA + 64 * 65;
    LAS float* bufP = bufB + 64 * 65;
    const float* SE = (const float*)(P_WS + OFF_RSEND) + (size_t)(h * 4) * 4096; const float* PE = (const float*)(P_WS + OFF_RPEND) + (size_t)(h * 4) * 4096;
    LAS float* sst = bufA;
    if (j >= 1) {
        const int v = tid >> 3, k8 = (tid & 7) * 8;
        { const f32x4 a0 = *(const f32x4*)(SE + v * 64 + k8), a1 = *(const f32x4*)(SE + v * 64 + k8 + 4);
#pragma unroll
          for (int e = 0; e < 4; ++e) { bufA[v * 65 + k8 + e] = a0[e]; bufA[v * 65 + k8 + 4 + e] = a1[e]; } }
        for (int jj = 1; jj < j; ++jj) {
            { const f32x4 p0 = *(const f32x4*)(PE + (size_t)jj * 4096 + v * 64 + k8), p1 = *(const f32x4*)(PE + (size_t)jj * 4096 + v * 64 + k8 + 4);
              *(LAS f32x4*)(bufP + v * 64 + k8) = p0; *(LAS f32x4*)(bufP + v * 64 + k8 + 4) = p1; }
            __syncthreads();
            LAS float* src = (jj & 1) ? bufA : bufB; LAS float* dst = (jj & 1) ? bufB : bufA;
            f32x4 c0 = *(const f32x4*)(SE + (size_t)jj * 4096 + v * 64 + k8), c1 = *(const f32x4*)(SE + (size_t)jj * 4096 + v * 64 + k8 + 4);
#pragma unroll 8
            for (int i = 0; i < 64; ++i) { const float a = src[v * 65 + i]; const f32x4 p0 = *(const LAS f32x4*)(bufP + i * 64 + k8), p1 = *(const LAS f32x4*)(bufP + i * 64 + k8 + 4); c0 += a * p0; c1 += a * p1; }
#pragma unroll
            for (int e = 0; e < 4; ++e) { dst[v * 65 + k8 + e] = c0[e]; dst[v * 65 + k8 + 4 + e] = c1[e]; }
            __syncthreads();
            sst = dst;
        }
        __syncthreads();
    }
    float srow[64];
    if (j >= 1) {
#pragma unroll
        for (int i = 0; i < 64; ++i) srow[i] = sst[lane * 65 + i];
    } else {
#pragma unroll
        for (int i = 0; i < 64; ++i) srow[i] = 0.f;
    }
    const int c = h * 64 + lane;
    const float rkw = P_IN(16)[L * 512 + c], lg = P_IN(17)[L * 512 + c], lb = P_IN(18)[L * 512 + c];
    const float* RY = (const float*)(P_WS + OFF_RY); const float* RZ = (const float*)(P_WS + OFF_RZ); const float* RR = (const float*)(P_WS + OFF_RR); const float* RK = (const float*)(P_WS + OFF_RK);
    const float* RV = (const float*)(P_WS + OFF_RV); const float* RG = (const float*)(P_WS + OFF_RG); bh* YC = (bh*)(P_WS + OFF_YCAT);
    for (int i4 = 0; i4 < 32; i4 += 4) { float yv[4], zv[4], rrv[4], rkv[4], rvv[4], rgv[4];
#pragma unroll
        for (int q = 0; q < 4; ++q) { const size_t o = (size_t)(blk * 256 + wid * 32 + i4 + q) * 512 + c;
            yv[q] = RY[o]; zv[q] = (j >= 1) ? RZ[o] : 0.f; rrv[q] = RR[o]; rkv[q] = RK[o]; rvv[q] = RV[o]; rgv[q] = RG[o]; }
        __builtin_amdgcn_sched_barrier(0);
#pragma unroll
        for (int q4 = 0; q4 < 4; ++q4) { const int t = blk * 256 + wid * 32 + i4 + q4;
            float y = yv[q4];
            if (j >= 1) { const float z = zv[q4]; float y2 = 0.f;
#pragma unroll
                for (int q = 0; q < 64; q += 2) { y = fmaf(srow[q], __builtin_bit_cast(float, __builtin_amdgcn_readlane(__builtin_bit_cast(int, z), q)), y);
                                                  y2 = fmaf(srow[q + 1], __builtin_bit_cast(float, __builtin_amdgcn_readlane(__builtin_bit_cast(int, z), q + 1)), y2); }
                y += y2; }
            const float mu = wave_sum(y) * (1.0f / 64.0f); const float dlt = y - mu; const float var = wave_sum(dlt * dlt) * (1.0f / 64.0f);
            const float yn = dlt * rsqrtf(var + 64e-5f) * lg + lb;
            const float bon = wave_sum(rrv[q4] * rkv[q4] * rkw) * rvv[q4];
            YC[(size_t)t * D + 1024 + c] = f2bf((yn + bon) * rgv[q4]); } }
    __syncthreads();
}

__device__ __forceinline__ void phase_post(const Params& p, int L, LAS unsigned char* lds) {
    for (int it = BIDX(); it < 768; it += GDIM()) {
        if (it < 512) mlstm_out(p, L, it >> 7, it & 127, lds);
        else rwkv_post(p, L, it - 512, lds);
    }
    __syncthreads();
}

#define XB_TMO      128
#define XB_XCNT(j)  (256  + 64 * (j))
#define XB_XSUB(j)  (1280 + 64 * (j))
#define XB_XGEN(j)  (2304 + 64 * (j))
#define XB_TOP      3328
#define XB_TOPGEN   3392
#define XCD_BAR_WORDS 3456
#define XB_SPIN_CAP (1u << 18)

__device__ __forceinline__ unsigned xb_ld(unsigned* p)              { return __hip_atomic_load(p, __ATOMIC_RELAXED, __HIP_MEMORY_SCOPE_AGENT); }
__device__ __forceinline__ unsigned xb_add(unsigned* p, unsigned v) { return __hip_atomic_fetch_add(p, v, __ATOMIC_RELAXED, __HIP_MEMORY_SCOPE_AGENT); }
__device__ __forceinline__ unsigned xb_xcc_id() { return (unsigned)__builtin_amdgcn_s_getreg((3 << 11) | 20) & 0xFu; }
#define XB_SPIN(cond, bar) do { unsigned _sp = 0; while (cond) { __builtin_amdgcn_s_sleep(1); \
    if ((++_sp & 255u) == 0u) { if (xb_ld(&(bar)[XB_TMO])) break; if (_sp > XB_SPIN_CAP) { atomicAdd(&(bar)[XB_TMO], 1u); break; } } } } while (0)

struct XcdBarrier {
    unsigned* bar; unsigned x;
    volatile LAS unsigned* st;
};

__device__ __forceinline__ XcdBarrier xcd_barrier_post(unsigned* bar, volatile LAS unsigned* st) {
    XcdBarrier b; b.bar = bar; b.x = xb_xcc_id(); b.st = st;
    if (threadIdx.x == 0) (void)xb_add(&bar[XB_XCNT(b.x)], 1u);
    return b;
}
__device__ __forceinline__ void xcd_barrier_complete(unsigned* bar, unsigned x, unsigned& nloc, unsigned& nx) {
    const unsigned G = gridDim.x * gridDim.y * gridDim.z;
    unsigned sum, cnt, mine, sp = 0u;
    for (;;) {
        sum = 0u; cnt = 0u; mine = 0u;
#pragma unroll
        for (unsigned j = 0; j < 16; ++j) { const unsigned c = xb_ld(&bar[XB_XCNT(j)]); sum += c; cnt += (c > 0u) ? 1u : 0u; mine = (j == x) ? c : mine; }
        if (sum == G) break;
        __builtin_amdgcn_s_sleep(1);
        if ((++sp & 255u) == 0u) { if (xb_ld(&bar[XB_TMO])) break; if (sp > XB_SPIN_CAP) { atomicAdd(&bar[XB_TMO], 1u); break; } }
    }
    nloc = mine > 0u ? mine : 1u; nx = cnt > 0u ? cnt : 1u;
}

__device__ __forceinline__ void xcd_barrier(const XcdBarrier& b) {
    asm volatile("s_waitcnt vmcnt(0)" ::: "memory");
    __syncthreads();
    if (threadIdx.x == 0) {
        unsigned* bar = b.bar;
        __builtin_amdgcn_s_waitcnt(0);
        unsigned nloc = b.st[0], nx = b.st[1];
        if (nloc == 0u) { xcd_barrier_complete(bar, b.x, nloc, nx); b.st[0] = nloc; b.st[1] = nx; }
        const unsigned old = xb_add(&bar[XB_XSUB(b.x)], 1u);
        const unsigned gen = old / nloc;
        if (old + 1u == (gen + 1u) * nloc) {
            __builtin_amdgcn_fence(__ATOMIC_RELEASE, "agent");
            asm volatile("s_waitcnt vmcnt(0)" ::: "memory");
            const unsigned og = xb_add(&bar[XB_TOP], 1u);
            const unsigned tg = og / nx;
            if (og + 1u == (tg + 1u) * nx) xb_add(&bar[XB_TOPGEN], 1u);
            else XB_SPIN(xb_ld(&bar[XB_TOPGEN]) == tg, bar);
            __builtin_amdgcn_fence(__ATOMIC_ACQUIRE, "agent");
            xb_add(&bar[XB_XGEN(b.x)], 1u);
            asm volatile("s_waitcnt vmcnt(0)" ::: "memory");
        } else {
            XB_SPIN(xb_ld(&bar[XB_XGEN(b.x)]) == gen, bar);
            __builtin_amdgcn_fence(__ATOMIC_ACQUIRE, "agent");
            asm volatile("s_waitcnt vmcnt(0)" ::: "memory");
        }
    }
    __syncthreads();
}


constexpr int NPHASE = 27;
__global__ void __launch_bounds__(512, 2) hybrid_fwd(Params p, int ph_lo, int ph_hi, int rep_q) {
    extern __shared__ __attribute__((aligned(16))) unsigned char smem_raw[];
    LAS unsigned char* lds = (LAS unsigned char*)smem_raw;
    cg::grid_group grid = cg::this_grid();
    volatile LAS unsigned* xst = (volatile LAS unsigned*)(lds + 131072);
    if (threadIdx.x < 2) xst[threadIdx.x] = 0u;
    __syncthreads();
    { XcdBarrier b0 = xcd_barrier_post((unsigned*)(P_WS + OFF_BAR), xst); (void)b0; }
    for (int ph = ph_lo; ph < ph_hi; ++ph) {
        if (ph == ph_lo + 1) grid.sync();
        else if (ph > ph_lo) { XcdBarrier xb; xb.bar = (unsigned*)(P_WS + OFF_BAR); xb.x = xb_xcc_id(); xb.st = xst; xcd_barrier(xb); }
        if (ph == 26) {
            const int gw = BIDX() * 8 + (TIDX() >> 6), NGW = GDIM() * 8, lane = TIDX() & 63;
            for (int r = gw; r < T; r += NGW) { float* x = P_OUT + (size_t)r * D; f32x4 v[8]; float s = 0.f;
#pragma unroll
                for (int j = 0; j < 8; ++j) { v[j] = *(const f32x4*)(x + j * 256 + lane * 4); s += (v[j][0] * v[j][0] + v[j][1] * v[j][1]) + (v[j][2] * v[j][2] + v[j][3] * v[j][3]); }
                const float rstd = rsqrtf(wave_sum(s) * (1.0f / D) + 1e-6f);
#pragma unroll
                for (int j = 0; j < 8; ++j) { const f32x4 gg = *(const f32x4*)(P_IN(40) + j * 256 + lane * 4); *(f32x4*)(x + j * 256 + lane * 4) = v[j] * rstd * gg; } }
            continue;
        }
        const int L = ph / 13, q = ph % 13;
#ifdef ONLY_Q
        if (q != ONLY_Q) continue;
#endif
        const int nrep = (q == rep_q) ? 2 : 1;
        for (int rep = 0; rep < nrep; ++rep) {
        if (rep) grid.sync();
        switch (q) {
        case 0: phase_conv(p, L, lds); break;
        case 2: phase_prep(p, L, lds); break;
        case 4: phase_scan(p, L, lds); break;
        case 5: phase_post(p, L, lds); break;
        case 8: phase_rmsnorm(p, P_IN(33) + (size_t)L * D); break;
        case 11: phase_rmsnorm(p, P_IN(37) + (size_t)L * D); break;
        default: break;
        }
        for (int i = 0; i < 3; ++i) {
            pg8::Gemm g;
            if (!make_gemm(p, L, q, i, g)) break;
            pg8::StaticOrder S; S.init(T, g.N, GDIM(), (q == 3) ? BIDX() - 64 * i : BIDX());
            pg8::gemm_phase(lds, g, S);
        }
        if (q == 3) phase_s5c(p, L, lds);
        }
    }
}

extern "C" void kernel_launch(void* const* d_in, const int* in_sizes, int n_in, void* d_out, int out_size, void* d_ws, size_t ws_size, hipStream_t stream) {
    constexpr size_t kDynLds = 131072 + 64;
    static int grid_blocks = 0;
    if (!grid_blocks) {
        int dev = 0, cus = 0, per_cu = 0;
        (void)hipGetDevice(&dev);
        (void)hipDeviceGetAttribute(&cus, hipDeviceAttributeMultiprocessorCount, dev);
        (void)hipFuncSetAttribute((const void*)hybrid_fwd, hipFuncAttributeMaxDynamicSharedMemorySize, (int)kDynLds);
        (void)hipOccupancyMaxActiveBlocksPerMultiprocessor(&per_cu, hybrid_fwd, 512, kDynLds);
        if (per_cu > 1) per_cu = 1;
        grid_blocks = cus * per_cu;
        if (ws_size < WS_TOTAL) fprintf(stderr, "workspace too small: %zu < %zu\n", ws_size, (size_t)WS_TOTAL);
    }
    Params p{};
    for (int i = 0; i < 41; ++i) p.in[i] = (const float*)d_in[i];
    p.out = (float*)d_out; p.ws = (unsigned char*)d_ws;
    (void)hipMemsetAsync((char*)d_ws + OFF_BAR, 0, XCD_BAR_WORDS * 4, stream);
#if SINGLE_LAUNCH
    int lo = 0, hi = NPHASE, rq = PROBE_REP_Q;
    void* args[] = {&p, &lo, &hi, &rq};
    hipError_t e = hipLaunchCooperativeKernel((const void*)hybrid_fwd, dim3(grid_blocks), dim3(512), args, kDynLds, stream);
    if (e != hipSuccess) fprintf(stderr, "cooperative launch failed: %s (grid %d)\n", hipGetErrorString(e), grid_blocks);
#else
    for (int ph = 0; ph < NPHASE; ++ph) {
        int lo = ph, hi = ph + 1, rq = -1;
        void* args[] = {&p, &lo, &hi, &rq};
        hipError_t e = hipLaunchCooperativeKernel((const void*)hybrid_fwd, dim3(grid_blocks), dim3(512), args, kDynLds, stream);
        if (e != hipSuccess) fprintf(stderr, "cooperative launch failed: %s (grid %d)\n", hipGetErrorString(e), grid_blocks);
    }
#endif
}
```

```cpp
#include <hip/hip_runtime.h>
#include <hip/hip_cooperative_groups.h>
#include <cstdio>
#include <cstdint>
namespace cg = cooperative_groups;

#define LAS __attribute__((address_space(3)))
typedef unsigned short bh;
typedef short bf16x8 __attribute__((ext_vector_type(8)));
typedef float f32x4 __attribute__((ext_vector_type(4)));
typedef float f32x16 __attribute__((ext_vector_type(16)));
typedef unsigned u32x4 __attribute__((ext_vector_type(4)));
typedef unsigned u32x2 __attribute__((ext_vector_type(2)));

#ifndef PROBE_RW
#define PROBE_RW 1
#define PROBE_ML 1
#endif
#ifndef PROBE_REP_Q
#define PROBE_REP_Q (-1)
#endif
#ifndef SINGLE_LAUNCH
#define SINGLE_LAUNCH 1
#endif

constexpr int T = 8192, D = 2048, FH = 5632;
constexpr int NIN = 12744, NGATE = 6144, NF = 6600, ZF_LD = 6656, NINP = 12800;
constexpr int ZR0 = 4104, ZS0 = 6088;
constexpr int NCH = 128;

constexpr size_t AL(size_t x) { return (x + 255) & ~(size_t)255; }
constexpr size_t SZ_WIN = (size_t)NINP * D * 2, SZ_SQ = (size_t)D * D * 2, SZ_WGU = (size_t)2 * FH * D * 2, SZ_WD = (size_t)D * FH * 2;
constexpr size_t OFF_WIN = 0;
constexpr size_t OFF_WUP = OFF_WIN + SZ_WIN;
constexpr size_t OFF_WO = OFF_WUP + SZ_SQ;
constexpr size_t OFF_WGU = OFF_WO + SZ_SQ;
constexpr size_t OFF_WD = OFF_WGU + SZ_WGU;
constexpr size_t OFF_WPG = OFF_WD + SZ_WD;
constexpr size_t OFF_WPP = OFF_WPG + SZ_SQ;
constexpr size_t OFF_WGLU = OFF_WPP + (size_t)D * 256 * 2;
constexpr size_t OFF_WW2 = OFF_WGLU + (size_t)512 * 512 * 2;
constexpr size_t OFF_WA2 = OFF_WW2 + (size_t)512 * 256 * 2;
constexpr size_t OFF_WG2 = OFF_WA2 + (size_t)512 * 256 * 2;
constexpr size_t OFF_PBF = OFF_WG2 + (size_t)512 * 256 * 2;
constexpr size_t OFF_ABF = OFF_PBF + (size_t)2 * T * 256 * 2;
constexpr size_t OFF_YCAT = OFF_ABF + (size_t)T * D * 2;
constexpr size_t OFF_ZF = OFF_YCAT + (size_t)T * D * 2;
constexpr size_t OFF_ACT = OFF_ZF;
constexpr size_t OFF_MIX32 = OFF_ZF + (size_t)100663296;
constexpr size_t OFF_ZG = OFF_ZF + (size_t)T * ZF_LD * 4;
constexpr size_t SZ_R = (size_t)T * 512 * 4;
constexpr size_t OFF_RR = OFF_ZG + (size_t)T * NGATE * 2;
constexpr size_t OFF_RK = OFF_RR + SZ_R, OFF_RV = OFF_RK + SZ_R, OFF_RKK = OFF_RV + SZ_R, OFF_RW = OFF_RKK + SZ_R, OFF_RB = OFF_RW + SZ_R, OFF_RG = OFF_RB + SZ_R, OFF_RY = OFF_RG + SZ_R;
constexpr size_t OFF_LAW = OFF_RY + SZ_R;
constexpr size_t OFF_LAA = OFF_LAW + (size_t)T * 256 * 2, OFF_LAG = OFF_LAA + (size_t)T * 256 * 2;
constexpr size_t SZ_MB = (size_t)T * 1024 * 2;
constexpr size_t OFF_MQ = OFF_LAG + (size_t)T * 256 * 2, OFF_MK = OFF_MQ + SZ_MB, OFF_MKT = OFF_MK + SZ_MB, OFF_MVT = OFF_MKT + SZ_MB;
constexpr size_t OFF_MI = OFF_MVT + SZ_MB;
constexpr size_t OFF_MBB = OFF_MI + (size_t)4 * T * 4;
constexpr size_t OFF_MBEND = OFF_MBB + (size_t)4 * T * 4;
constexpr size_t OFF_MLOC = OFF_MBEND + 2048, OFF_MSTART = OFF_MLOC + 2048;
constexpr size_t OFF_DN = OFF_MSTART + 2048;
constexpr size_t OFF_NST = OFF_DN + (size_t)4 * NCH * 256 * 4;
constexpr size_t OFF_SEND = OFF_NST + (size_t)4 * NCH * 256 * 4;
constexpr size_t OFF_YS = OFF_SEND + (size_t)32 * NCH * 64 * 8;
constexpr size_t OFF_RZ = OFF_YS + (size_t)T * 512 * 2;
constexpr size_t OFF_RSEND = OFF_RZ + SZ_R;
constexpr size_t OFF_RPEND = OFF_RSEND + (size_t)8 * 4 * 4096 * 4;
constexpr size_t OFF_MINTER2 = OFF_RPEND + (size_t)8 * 4 * 4096 * 4;
constexpr size_t OFF_BAR = OFF_MINTER2;
constexpr size_t WS_TOTAL = OFF_MINTER2 + (size_t)T * 1024 * 4;

struct Params { const float* in[41]; float* out; unsigned char* ws; };
#define KARG4 __attribute__((address_space(4)))
__device__ __forceinline__ const float* karg_in(int i) { const KARG4 char* ka = (const KARG4 char*)__builtin_amdgcn_kernarg_segment_ptr(); return *(const float* const volatile KARG4*)(ka + (size_t)i * 8); }
#define P_IN(i) karg_in(i)
#define P_OUT ((float*)karg_in(41))
#define P_WS ((unsigned char*)karg_in(42))

__device__ __forceinline__ int TIDX() { int t = threadIdx.x; asm volatile("" : "+v"(t)); return t; }
__device__ __forceinline__ int BIDX() { int t = blockIdx.x; asm volatile("" : "+s"(t)); return t; }
__device__ __forceinline__ int GDIM() { int t = gridDim.x; asm volatile("" : "+s"(t)); return t; }
__device__ __forceinline__ bh f2bf(float f) { unsigned u = __float_as_uint(f); u += 0x7fffu + ((u >> 16) & 1u); return (bh)(u >> 16); }
__device__ __forceinline__ float bf2f(bh h) { return __uint_as_float(((unsigned)h) << 16); }
__device__ __forceinline__ unsigned pk2(float lo, float hi) { return (unsigned)f2bf(lo) | ((unsigned)f2bf(hi) << 16); }
__device__ __forceinline__ float sigmoidf_(float x) { return 1.0f / (1.0f + __expf(-x)); }
__device__ __forceinline__ float bperm_f(int srclane, float v) { return __builtin_bit_cast(float, __builtin_amdgcn_ds_bpermute(srclane << 2, __builtin_bit_cast(int, v))); }
template <int CTRL> __device__ __forceinline__ float dpp_f(float x) {
    return __builtin_bit_cast(float, __builtin_amdgcn_update_dpp(0, __builtin_bit_cast(int, x), CTRL, 0xf, 0xf, true));
}
__device__ __forceinline__ float allreduce16(float x) {
    x += dpp_f<0xB1>(x); x += dpp_f<0x4E>(x); x += dpp_f<0x141>(x); x += dpp_f<0x140>(x);
    return x;
}
__device__ __forceinline__ float rl_f(float v, int l) { return __builtin_bit_cast(float, __builtin_amdgcn_readlane(__builtin_bit_cast(int, v), l)); }
__device__ __forceinline__ float wave_sum(float v) {
    v = allreduce16(v);
    return (rl_f(v, 0) + rl_f(v, 16)) + (rl_f(v, 32) + rl_f(v, 48));
}
__device__ __forceinline__ float wave_max(float v) {
    v = fmaxf(v, dpp_f<0xB1>(v)); v = fmaxf(v, dpp_f<0x4E>(v)); v = fmaxf(v, dpp_f<0x141>(v)); v = fmaxf(v, dpp_f<0x140>(v));
    return fmaxf(fmaxf(rl_f(v, 0), rl_f(v, 16)), fmaxf(rl_f(v, 32), rl_f(v, 48)));
}
__device__ __forceinline__ float OZ() { float z = 0.f; asm volatile("" : "+v"(z)); return z; }
#define MFMA16(a, b, c) __builtin_amdgcn_mfma_f32_16x16x32_bf16(a, b, c, 0, 0, 0)
#define MFMA32(a, b, c) __builtin_amdgcn_mfma_f32_32x32x16_bf16(a, b, c, 0, 0, 0)

namespace pg8 {
constexpr int BM = 256, BK = 64, HALF = 128, HTB = HALF * BK * 2, STAGE_BYTES = 8 * HTB, NXCD = 8, WGM = 8;
__device__ __forceinline__ int lds_byte(int r, int c) { const int st = (r >> 4) * 2 + (c >> 5), rr = r & 15, cc = c & 31, ob = rr * 64 + cc * 2; return st * 1024 + (ob ^ (((ob >> 9) & 1) << 5)); }
__device__ __forceinline__ void stage_rc(int b, int& R, int& C) { const int st = b / 1024, sb = b % 1024, swz = sb ^ (((sb >> 9) & 1) << 5); R = (st >> 1) * 16 + swz / 64; C = (st & 1) * 32 + (swz % 64) / 2; }
__device__ __forceinline__ int perm32(int rho) { const int n = rho >> 4, i = rho & 15; return 8 * (i >> 2) + 4 * n + (i & 3); }
struct Unit { int pm, pn; };
struct Gemm { const bh* A; const bh* Bt; int M, N, K, lda, ldb, epi, perm, L; };
struct StaticOrder {
    int nM, nN, nwg, G, c;
    __device__ void init(int M, int N, int G_, int c_) { nM = M / BM; nN = N / BM; nwg = nM * nN; G = G_; c = c_; }
    __device__ bool next(int i, Unit& u) const {
        const long L = (long)i * G + c; if (c < 0 || L >= nwg) return false;
        int wgid = (int)L; { const int q = nwg / NXCD, r = nwg % NXCD, xcd = wgid % NXCD, off = wgid / NXCD; wgid = (xcd < r ? xcd * (q + 1) : r * (q + 1) + (xcd - r) * q) + off; }
        const int nig = WGM * nN, gid = wgid / nig, fm = gid * WGM, gsz = (nM - fm) < WGM ? (nM - fm) : WGM;
        u.pm = fm + ((wgid % nig) % gsz); u.pn = (wgid % nig) / gsz; return true;
    }
};
__device__ __forceinline__ unsigned cvt_pk_bf16(float lo, float hi) { unsigned r; asm volatile("v_cvt_pk_bf16_f32 %0, %1, %2" : "=v"(r) : "v"(lo), "v"(hi)); return r; }

__device__ __forceinline__ void epi_run(const Gemm& g, const f32x4 (&acc)[2][2][4][2], const Unit& u, int wr, int wc, int fr, int fq);
__device__ __forceinline__ void up_rescale(f32x4 (&acc)[2][2][4][2], const Unit& u, int wr, int wc, int fr, int fq, int goff) {
    const bh* zg = (const bh*)(P_WS + OFF_ZG) + goff;
    asm volatile("" : "+v"(fr), "+v"(fq));
    const bh* zrow0 = zg + (size_t)(u.pm * 256 + wr * 64 + fr) * NGATE + u.pn * 256 + wc * 32 + 4 * fq;
#pragma unroll
    for (int ai = 0; ai < 2; ++ai)
#pragma unroll
        for (int mp = 0; mp < 2; ++mp) {
            u32x2 gp[8], gn[8];
#pragma unroll
            for (int mm = 0; mm < 2; ++mm) { const bh* zr = zrow0 + (size_t)(ai * 128 + (mp * 2 + mm) * 16) * NGATE;
#pragma unroll
                for (int bj = 0; bj < 2; ++bj)
#pragma unroll
                    for (int n = 0; n < 2; ++n) { gp[mm * 4 + bj * 2 + n] = *(const u32x2*)(zr + bj * 128 + n * 16); gn[mm * 4 + bj * 2 + n] = *(const u32x2*)(zr + 2048 + bj * 128 + n * 16); } }
            __builtin_amdgcn_sched_barrier(0);
#pragma unroll
            for (int mm = 0; mm < 2; ++mm)
#pragma unroll
                for (int bj = 0; bj < 2; ++bj)
#pragma unroll
                    for (int n = 0; n < 2; ++n) { const u32x2 p = gp[mm * 4 + bj * 2 + n], q = gn[mm * 4 + bj * 2 + n];
                        f32x4 r;
                        r[0] = __uint_as_float(p.x << 16) * __builtin_amdgcn_rcpf(__uint_as_float(q.x << 16)); r[1] = __uint_as_float(p.x & 0xffff0000u) * __builtin_amdgcn_rcpf(__uint_as_float(q.x & 0xffff0000u));
                        r[2] = __uint_as_float(p.y << 16) * __builtin_amdgcn_rcpf(__uint_as_float(q.y << 16)); r[3] = __uint_as_float(p.y & 0xffff0000u) * __builtin_amdgcn_rcpf(__uint_as_float(q.y & 0xffff0000u));
                        acc[ai][bj][mp * 2 + mm][n] *= r; }
            __builtin_amdgcn_sched_barrier(0); }
}
__device__ __forceinline__ void gemm_phase(LAS unsigned char* lds, const Gemm& g, const StaticOrder& S) {
    const int tid = TIDX(), wid = __builtin_amdgcn_readfirstlane(tid >> 6), lane = tid & 63, wr = wid >> 2, wc = wid & 3, fr = lane & 15, fq = lane >> 4;
    const int K = g.K, nt = K / BK;
    unsigned voffA[2], voffB[2];
#pragma unroll
    for (int i = 0; i < 2; ++i) { int R, C; stage_rc(tid * 16 + i * 8192, R, C); const int Rb = g.perm ? ((R & ~31) + perm32(R & 31)) : R;
        voffA[i] = (unsigned)(R * g.lda + C) * 2u; voffB[i] = (unsigned)(Rb * g.ldb + C) * 2u; }
    const size_t kstep = (size_t)(BK * 2);
    const size_t hstepA = (size_t)HALF * g.lda * 2, hstepB = (size_t)HALF * g.ldb * 2;
    const size_t tstepA = 2 * hstepA, tstepB = 2 * hstepB;
    const unsigned ldsw = (unsigned)wid * 1024u;
    const int aoff = lds_byte(wr * 64 + fr, fq * 8), boff = lds_byte(wc * 32 + fr, fq * 8);
#define PG8_SA(b, h) (((b) * 2 + (h)) * HTB)
#define PG8_SB(b, h) ((4 + (b) * 2 + (h)) * HTB)
#define PG8_STAGE(bufoff, gbase, voff) do { _Pragma("unroll") for (int _i = 0; _i < 2; ++_i) \
        __builtin_amdgcn_global_load_lds((const unsigned*)((const char*)(gbase) + (voff)[_i]), (LAS unsigned*)(lds + (bufoff) + ldsw + _i * 8192), 16, 0, 0); } while (0)
#define PG8_LDA(dst, b, h) do { _Pragma("unroll") for (int m = 0; m < 4; ++m) _Pragma("unroll") for (int k = 0; k < 2; ++k) dst[m][k] = *(const LAS bf16x8*)(lds + PG8_SA(b, h) + aoff + m * 2048 + k * 1024); } while (0)
#define PG8_LDB(dst, b, h) do { _Pragma("unroll") for (int n = 0; n < 2; ++n) _Pragma("unroll") for (int k = 0; k < 2; ++k) dst[n][k] = *(const LAS bf16x8*)(lds + PG8_SB(b, h) + boff + n * 2048 + k * 1024); } while (0)
#define PG8_MMA(ai, bj, At, Bt) do { __builtin_amdgcn_s_setprio(1); _Pragma("unroll") for (int m = 0; m < 4; ++m) _Pragma("unroll") for (int n = 0; n < 2; ++n) _Pragma("unroll") for (int k = 0; k < 2; ++k) \
        acc[ai][bj][m][n] = __builtin_amdgcn_mfma_f32_16x16x32_bf16(Bt[n][k], At[m][k], acc[ai][bj][m][n], 0, 0, 0); __builtin_amdgcn_s_setprio(0); } while (0)
#define PG8_WAIT_V(n) asm volatile("s_waitcnt vmcnt(" #n ")" ::: "memory")
#define PG8_WAIT_L(n) asm volatile("s_waitcnt lgkmcnt(" #n ")" ::: "memory")
#define PG8_BAR __builtin_amdgcn_s_barrier()
#define PG8_SCHED __builtin_amdgcn_sched_barrier(0)
    Unit cur, nxt; int ui = 0;
    if (!S.next(0, cur)) return;
    f32x4 acc[2][2][4][2];
    { const float z = OZ();
#pragma unroll
    for (int a = 0; a < 2; ++a)
#pragma unroll
        for (int b = 0; b < 2; ++b)
#pragma unroll
            for (int m = 0; m < 4; ++m)
#pragma unroll
                for (int n = 0; n < 2; ++n) acc[a][b][m][n] = (f32x4){z, z, z, z}; }
    bf16x8 At[4][2], B0[2][2], B1[2][2];
    const char* cA = (const char*)g.A + (size_t)cur.pm * tstepA; const char* cB = (const char*)g.Bt + (size_t)cur.pn * tstepB;
    PG8_STAGE(PG8_SB(0, 0), cB, voffB); PG8_STAGE(PG8_SA(0, 0), cA, voffA); PG8_STAGE(PG8_SB(0, 1), cB + hstepB, voffB); PG8_STAGE(PG8_SA(0, 1), cA + hstepA, voffA);
    if (wr == 1) PG8_BAR;
    PG8_WAIT_V(4); PG8_BAR;
    PG8_STAGE(PG8_SB(1, 0), cB + kstep, voffB); PG8_STAGE(PG8_SA(1, 0), cA + kstep, voffA); PG8_STAGE(PG8_SB(1, 1), cB + hstepB + kstep, voffB);
    PG8_WAIT_V(6); PG8_BAR;
    for (;;) {
        const bool has_next = S.next(ui + 1, nxt);
        const char* nA = has_next ? (const char*)g.A + (size_t)nxt.pm * tstepA : cA; const char* nB = has_next ? (const char*)g.Bt + (size_t)nxt.pn * tstepB : cB;
        for (int t = 0; t < nt; t += 2) {
            if (g.epi == 11 && (t == 16 || t == 24)) up_rescale(acc, cur, wr, wc, fr, fq, t == 16 ? 0 : 2048);
            const bool last = (t == nt - 2);
            const char* a1 = cA + (size_t)(t + 1) * kstep;
            const char* a2 = last ? nA : cA + (size_t)(t + 2) * kstep; const char* b2 = last ? nB : cB + (size_t)(t + 2) * kstep;
            const char* a3 = a2 + kstep; const char* b3 = b2 + kstep;
            PG8_LDB(B0, 0, 0); PG8_SCHED; PG8_LDA(At, 0, 0); PG8_STAGE(PG8_SA(1, 1), a1 + hstepA, voffA);
            PG8_WAIT_L(8); PG8_BAR; PG8_WAIT_L(0); PG8_MMA(0, 0, At, B0); PG8_BAR; PG8_SCHED;
            PG8_LDB(B1, 0, 1); PG8_STAGE(PG8_SB(0, 0), b2, voffB);
            PG8_BAR; PG8_WAIT_L(0); PG8_MMA(0, 1, At, B1); PG8_BAR;
            PG8_LDA(At, 0, 1); PG8_STAGE(PG8_SA(0, 0), a2, voffA);
            PG8_BAR; PG8_WAIT_L(0); PG8_MMA(1, 0, At, B0); PG8_BAR; PG8_SCHED;
            PG8_STAGE(PG8_SB(0, 1), b2 + hstepB, voffB);
            PG8_WAIT_V(6); PG8_BAR; PG8_MMA(1, 1, At, B1); PG8_BAR;
            PG8_LDB(B0, 1, 0); PG8_SCHED; PG8_LDA(At, 1, 0); PG8_STAGE(PG8_SA(0, 1), a2 + hstepA, voffA);
            PG8_WAIT_L(8); PG8_BAR; PG8_WAIT_L(0); PG8_MMA(0, 0, At, B0); PG8_BAR; PG8_SCHED;
            PG8_LDB(B1, 1, 1); PG8_STAGE(PG8_SB(1, 0), b3, voffB);
            PG8_BAR; PG8_WAIT_L(0); PG8_MMA(0, 1, At, B1); PG8_BAR;
            PG8_LDA(At, 1, 1); PG8_STAGE(PG8_SA(1, 0), a3, voffA);
            PG8_BAR; PG8_WAIT_L(0); PG8_MMA(1, 0, At, B0); PG8_BAR; PG8_SCHED;
            PG8_STAGE(PG8_SB(1, 1), b3 + hstepB, voffB);
            PG8_WAIT_V(6); PG8_BAR; PG8_MMA(1, 1, At, B1); PG8_BAR;
        }
        epi_run(g, acc, cur, wr, wc, fr, fq);
        if (!has_next) break;
        { const float z = OZ();
#pragma unroll
        for (int a = 0; a < 2; ++a)
#pragma unroll
            for (int b = 0; b < 2; ++b)
#pragma unroll
                for (int m = 0; m < 4; ++m)
#pragma unroll
                    for (int n = 0; n < 2; ++n) acc[a][b][m][n] = (f32x4){z, z, z, z}; }
        cur = nxt; cA = nA; cB = nB; ++ui;
    }
    PG8_WAIT_V(0);
    if (wr == 0) PG8_BAR;
    PG8_BAR;
#undef PG8_SA
#undef PG8_SB
#undef PG8_STAGE
#undef PG8_LDA
#undef PG8_LDB
#undef PG8_MMA
#undef PG8_WAIT_V
#undef PG8_WAIT_L
#undef PG8_BAR
#undef PG8_SCHED
}
}
using pg8::Unit;
using pg8::cvt_pk_bf16;

#define EPI_FOR_NP(...) \
    _Pragma("unroll") for (int ai = 0; ai < 2; ++ai) _Pragma("unroll") for (int m = 0; m < 4; ++m) { const int row = u.pm * 256 + ai * 128 + wr * 64 + m * 16 + fr; \
    _Pragma("unroll") for (int bj = 0; bj < 2; ++bj) _Pragma("unroll") for (int n = 0; n < 2; ++n) { const int col = u.pn * 256 + bj * 128 + wc * 32 + n * 16 + 4 * fq; const f32x4 v = acc[ai][bj][m][n]; __VA_ARGS__ } }

typedef const f32x4 (&AccRef)[2][2][4][2];
#define EPI_GRP8(...) \
    _Pragma("unroll") for (int mm = 0; mm < 2; ++mm) _Pragma("unroll") for (int bj = 0; bj < 2; ++bj) _Pragma("unroll") for (int n = 0; n < 2; ++n) { \
        const int idx = mm * 4 + bj * 2 + n; const int row = u.pm * 256 + ai * 128 + wr * 64 + (mp * 2 + mm) * 16 + fr; const int col = u.pn * 256 + bj * 128 + wc * 32 + n * 16 + 4 * fq; \
        const f32x4 v = acc[ai][bj][mp * 2 + mm][n]; (void)idx; (void)row; (void)col; (void)v; __VA_ARGS__ }
#define EPI_GROUPS _Pragma("unroll") for (int ai = 0; ai < 2; ++ai) _Pragma("unroll") for (int mp = 0; mp < 2; ++mp)

struct EpiWin {
    static constexpr bool PERM = false;
    bh* zg; float* zf;
    __device__ __forceinline__ void operator()(AccRef acc, const Unit& u, int wr, int wc, int fr, int fq) const {
        if (u.pn < 24) {
            EPI_FOR_NP({ u32x2 w; w.x = cvt_pk_bf16(fmaxf(sigmoidf_(v[0]), 1e-6f), fmaxf(sigmoidf_(v[1]), 1e-6f)); w.y = cvt_pk_bf16(fmaxf(sigmoidf_(v[2]), 1e-6f), fmaxf(sigmoidf_(v[3]), 1e-6f)); *(u32x2*)(zg + (size_t)row * NGATE + col) = w; })
        } else {
            EPI_FOR_NP({ *(f32x4*)(zf + (size_t)row * ZF_LD + (col - NGATE)) = v; })
        }
    }
};
struct EpiLoraW {
    static constexpr bool PERM = false;
    const float* w0; float* rw;
    __device__ __forceinline__ void operator()(AccRef acc, const Unit& u, int wr, int wc, int fr, int fq) const {
        f32x4 bb[2][2];
#pragma unroll
        for (int bj = 0; bj < 2; ++bj)
#pragma unroll
            for (int n = 0; n < 2; ++n) bb[bj][n] = *(const f32x4*)(w0 + u.pn * 256 + bj * 128 + wc * 32 + n * 16 + 4 * fq);
        __builtin_amdgcn_sched_barrier(0);
        EPI_FOR_NP({ const f32x4 b = bb[bj][n]; f32x4 o;
            _Pragma("unroll") for (int j = 0; j < 4; ++j) { const float x = -(b[j] + v[j]); const float sp = fmaxf(x, 0.f) + log1pf(__expf(-fabsf(x))); o[j] = __expf(-__expf(-sp - 0.5f)); }
            *(f32x4*)(rw + (size_t)row * 512 + col) = o; })
    }
};
struct EpiLoraA {
    static constexpr bool PERM = false;
    const float* a0; const float* ka; const float* rkk; float* rb; float* rk;
    __device__ __forceinline__ void operator()(AccRef acc, const Unit& u, int wr, int wc, int fr, int fq) const {
        f32x4 b0s[2][2], kas[2][2];
#pragma unroll
        for (int bj = 0; bj < 2; ++bj)
#pragma unroll
            for (int n = 0; n < 2; ++n) { const int c0 = u.pn * 256 + bj * 128 + wc * 32 + n * 16 + 4 * fq; b0s[bj][n] = *(const f32x4*)(a0 + c0); kas[bj][n] = *(const f32x4*)(ka + c0); }
#pragma unroll
        for (int ai = 0; ai < 2; ++ai)
#pragma unroll
            for (int m = 0; m < 4; ++m) { const int row = u.pm * 256 + ai * 128 + wr * 64 + m * 16 + fr; f32x4 kkq[4], kq[4];
#pragma unroll
                for (int bj = 0; bj < 2; ++bj)
#pragma unroll
                    for (int n = 0; n < 2; ++n) { const size_t o = (size_t)row * 512 + u.pn * 256 + bj * 128 + wc * 32 + n * 16 + 4 * fq; kkq[bj * 2 + n] = *(const f32x4*)(rkk + o); kq[bj * 2 + n] = *(const f32x4*)(rk + o); }
                __builtin_amdgcn_sched_barrier(0);
#pragma unroll
                for (int bj = 0; bj < 2; ++bj)
#pragma unroll
                    for (int n = 0; n < 2; ++n) { const size_t o = (size_t)row * 512 + u.pn * 256 + bj * 128 + wc * 32 + n * 16 + 4 * fq;
                        const f32x4 v = acc[ai][bj][m][n]; const f32x4 b0 = b0s[bj][n]; const f32x4 kav = kas[bj][n]; const f32x4 kkv = kkq[bj * 2 + n]; f32x4 kv = kq[bj * 2 + n]; f32x4 bo;
                        _Pragma("unroll") for (int j = 0; j < 4; ++j) { const float a = sigmoidf_(b0[j] + v[j]); bo[j] = -(kkv[j] * a); kv[j] = kv[j] * (1.0f + (a - 1.0f) * kav[j]); }
                        *(f32x4*)(rb + o) = bo; *(f32x4*)(rk + o) = kv; }
                __builtin_amdgcn_sched_barrier(0); }
    }
};
struct EpiStoreF32 {
    static constexpr bool PERM = false;
    float* o; int ld;
    __device__ __forceinline__ void operator()(AccRef acc, const Unit& u, int wr, int wc, int fr, int fq) const {
        EPI_FOR_NP({ *(f32x4*)(o + (size_t)row * ld + col) = v; })
    }
};
struct EpiGlu {
    static constexpr bool PERM = false;
    const bh* ys; const float* gb; bh* ycat;
    __device__ __forceinline__ void operator()(AccRef acc, const Unit& u, int wr, int wc, int fr, int fq) const {
        f32x4 gbs[2][2];
#pragma unroll
        for (int bj = 0; bj < 2; ++bj)
#pragma unroll
            for (int n = 0; n < 2; ++n) gbs[bj][n] = *(const f32x4*)(gb + u.pn * 256 + bj * 128 + wc * 32 + n * 16 + 4 * fq);
        EPI_GROUPS { u32x2 yq[8];
            EPI_GRP8({ yq[idx] = *(const u32x2*)(ys + (size_t)row * 512 + col); })
            __builtin_amdgcn_sched_barrier(0);
            EPI_GRP8({ const f32x4 b = gbs[bj][n]; const u32x2 y2 = yq[idx];
                const float y0 = __uint_as_float(y2.x << 16), y1 = __uint_as_float(y2.x & 0xffff0000u), y2f = __uint_as_float(y2.y << 16), y3 = __uint_as_float(y2.y & 0xffff0000u);
                u32x2 w; w.x = cvt_pk_bf16(y0 * sigmoidf_(v[0] + b[0]), y1 * sigmoidf_(v[1] + b[1])); w.y = cvt_pk_bf16(y2f * sigmoidf_(v[2] + b[2]), y3 * sigmoidf_(v[3] + b[3]));
                *(u32x2*)(ycat + (size_t)row * D + 1536 + col) = w; })
            __builtin_amdgcn_sched_barrier(0); }
    }
};
template <int MODE> struct EpiUp {
    static constexpr bool PERM = false;
    const bh* zg; float* mix; bh* mixed;
    __device__ __forceinline__ void operator()(AccRef acc, const Unit& u, int wr, int wc, int fr, int fq) const {
        EPI_FOR_NP({ const u32x2 g2 = *(const u32x2*)(zg + (size_t)row * NGATE + col);
            f32x4 g; g[0] = __uint_as_float(g2.x << 16); g[1] = __uint_as_float(g2.x & 0xffff0000u); g[2] = __uint_as_float(g2.y << 16); g[3] = __uint_as_float(g2.y & 0xffff0000u);
            f32x4 r = g * v; float* mp = mix + (size_t)row * D + col;
            if (MODE >= 1) r += *(const f32x4*)mp;
            if (MODE <= 1) *(f32x4*)mp = r;
            else { u32x2 w; w.x = cvt_pk_bf16(r[0], r[1]); w.y = cvt_pk_bf16(r[2], r[3]); *(u32x2*)(mixed + (size_t)row * D + col) = w; } })
    }
};
struct EpiUpF {
    static constexpr bool PERM = false;
    const bh* zg; bh* mixed;
    __device__ __forceinline__ void operator()(AccRef acc, const Unit& u, int wr, int wc, int fr, int fq) const {
#pragma unroll
        for (int ai = 0; ai < 2; ++ai) { u32x2 gg[16];
#pragma unroll
            for (int m = 0; m < 4; ++m)
#pragma unroll
                for (int bj = 0; bj < 2; ++bj)
#pragma unroll
                    for (int n = 0; n < 2; ++n) gg[m * 4 + bj * 2 + n] = *(const u32x2*)(zg + (size_t)(u.pm * 256 + ai * 128 + wr * 64 + m * 16 + fr) * NGATE + u.pn * 256 + bj * 128 + wc * 32 + n * 16 + 4 * fq);
            __builtin_amdgcn_sched_barrier(0);
#pragma unroll
            for (int m = 0; m < 4; ++m)
#pragma unroll
                for (int bj = 0; bj < 2; ++bj)
#pragma unroll
                    for (int n = 0; n < 2; ++n) { const u32x2 g2 = gg[m * 4 + bj * 2 + n]; const f32x4 v = acc[ai][bj][m][n];
                        u32x2 w; w.x = cvt_pk_bf16(__uint_as_float(g2.x << 16) * v[0], __uint_as_float(g2.x & 0xffff0000u) * v[1]); w.y = cvt_pk_bf16(__uint_as_float(g2.y << 16) * v[2], __uint_as_float(g2.y & 0xffff0000u) * v[3]);
                        *(u32x2*)(mixed + (size_t)(u.pm * 256 + ai * 128 + wr * 64 + m * 16 + fr) * D + u.pn * 256 + bj * 128 + wc * 32 + n * 16 + 4 * fq) = w; }
            __builtin_amdgcn_sched_barrier(0); }
    }
};
struct EpiRes {
    static constexpr bool PERM = false;
    float* h;
    __device__ __forceinline__ void operator()(AccRef acc, const Unit& u, int wr, int wc, int fr, int fq) const {
#pragma unroll
        for (int ai = 0; ai < 2; ++ai)
#pragma unroll
            for (int mp = 0; mp < 2; ++mp) { f32x4 hv[8];
#pragma unroll
                for (int mm = 0; mm < 2; ++mm)
#pragma unroll
                    for (int bj = 0; bj < 2; ++bj)
#pragma unroll
                        for (int n = 0; n < 2; ++n) hv[mm * 4 + bj * 2 + n] = *(const f32x4*)(h + (size_t)(u.pm * 256 + ai * 128 + wr * 64 + (mp * 2 + mm) * 16 + fr) * D + u.pn * 256 + bj * 128 + wc * 32 + n * 16 + 4 * fq);
                __builtin_amdgcn_sched_barrier(0);
#pragma unroll
                for (int mm = 0; mm < 2; ++mm)
#pragma unroll
                    for (int bj = 0; bj < 2; ++bj)
#pragma unroll
                        for (int n = 0; n < 2; ++n) *(f32x4*)(h + (size_t)(u.pm * 256 + ai * 128 + wr * 64 + (mp * 2 + mm) * 16 + fr) * D + u.pn * 256 + bj * 128 + wc * 32 + n * 16 + 4 * fq) = hv[mm * 4 + bj * 2 + n] + acc[ai][bj][mp * 2 + mm][n];
                __builtin_amdgcn_sched_barrier(0); }
    }
};
struct EpiFfn {
    static constexpr bool PERM = true;
    bh* act;
    __device__ __forceinline__ void operator()(AccRef acc, const Unit& u, int wr, int wc, int fr, int fq) const {
#pragma unroll
        for (int ai = 0; ai < 2; ++ai)
#pragma unroll
            for (int m = 0; m < 4; ++m) { const int row = u.pm * 256 + ai * 128 + wr * 64 + m * 16 + fr; const int col = u.pn * 128 + wc * 32 + 8 * fq;
                float o[8];
#pragma unroll
                for (int n = 0; n < 2; ++n)
#pragma unroll
                    for (int j = 0; j < 4; ++j) { const float gte = acc[ai][0][m][n][j], up = acc[ai][1][m][n][j]; o[n * 4 + j] = gte * sigmoidf_(gte) * up; }
                u32x4 w; w.x = cvt_pk_bf16(o[0], o[1]); w.y = cvt_pk_bf16(o[2], o[3]); w.z = cvt_pk_bf16(o[4], o[5]); w.w = cvt_pk_bf16(o[6], o[7]);
                *(u32x4*)(act + (size_t)row * FH + col) = w; }
    }
};
struct EpiPle {
    static constexpr bool PERM = false;
    float* h; const float* tmp;
    __device__ __forceinline__ void operator()(AccRef acc, const Unit& u, int wr, int wc, int fr, int fq) const {
#pragma unroll
        for (int ai = 0; ai < 2; ++ai)
#pragma unroll
            for (int mp = 0; mp < 2; ++mp) { f32x4 hv[8], tv[8];
#pragma unroll
                for (int mm = 0; mm < 2; ++mm)
#pragma unroll
                    for (int bj = 0; bj < 2; ++bj)
#pragma unroll
                        for (int n = 0; n < 2; ++n) { const size_t o = (size_t)(u.pm * 256 + ai * 128 + wr * 64 + (mp * 2 + mm) * 16 + fr) * D + u.pn * 256 + bj * 128 + wc * 32 + n * 16 + 4 * fq;
                            hv[mm * 4 + bj * 2 + n] = *(const f32x4*)(h + o); tv[mm * 4 + bj * 2 + n] = *(const f32x4*)(tmp + o); }
                __builtin_amdgcn_sched_barrier(0);
#pragma unroll
                for (int mm = 0; mm < 2; ++mm)
#pragma unroll
                    for (int bj = 0; bj < 2; ++bj)
#pragma unroll
                        for (int n = 0; n < 2; ++n) { const size_t o = (size_t)(u.pm * 256 + ai * 128 + wr * 64 + (mp * 2 + mm) * 16 + fr) * D + u.pn * 256 + bj * 128 + wc * 32 + n * 16 + 4 * fq;
                            f32x4 r = hv[mm * 4 + bj * 2 + n]; const f32x4 v = acc[ai][bj][mp * 2 + mm][n]; const f32x4 t4 = tv[mm * 4 + bj * 2 + n];
                            _Pragma("unroll") for (int j = 0; j < 4; ++j) r[j] += t4[j] * sigmoidf_(v[j]);
                            *(f32x4*)(h + o) = r; }
                __builtin_amdgcn_sched_barrier(0); }
    }
};

namespace pg8 {
__device__ __forceinline__ void epi_run(const Gemm& g, const f32x4 (&acc)[2][2][4][2], const Unit& u, int wr, int wc, int fr, int fq) {
    unsigned char* ws = P_WS; const int L = g.L;
    switch (g.epi) {
    case 0: { EpiWin E{(bh*)(ws + OFF_ZG), (float*)(ws + OFF_ZF)}; E(acc, u, wr, wc, fr, fq); } break;
    case 1: { EpiLoraW E{P_IN(9) + L * 512, (float*)(ws + OFF_RW)}; E(acc, u, wr, wc, fr, fq); } break;
    case 2: { EpiLoraA E{P_IN(11) + L * 512, P_IN(15) + L * 512, (const float*)(ws + OFF_RKK), (float*)(ws + OFF_RB), (float*)(ws + OFF_RK)}; E(acc, u, wr, wc, fr, fq); } break;
    case 3: { EpiStoreF32 E{(float*)(ws + (g.N == 512 ? OFF_RG : OFF_MIX32)), g.N}; E(acc, u, wr, wc, fr, fq); } break;
    case 4: { EpiGlu E{(const bh*)(ws + OFF_YS), P_IN(28) + L * 512, (bh*)(ws + OFF_YCAT)}; E(acc, u, wr, wc, fr, fq); } break;
    case 5: { EpiUp<0> E{(const bh*)(ws + OFF_ZG), (float*)(ws + OFF_MIX32), (bh*)(ws + OFF_ABF)}; E(acc, u, wr, wc, fr, fq); } break;
    case 6: { EpiUp<1> E{(const bh*)(ws + OFF_ZG) + 2048, (float*)(ws + OFF_MIX32), (bh*)(ws + OFF_ABF)}; E(acc, u, wr, wc, fr, fq); } break;
    case 7: { EpiUp<2> E{(const bh*)(ws + OFF_ZG) + 4096, (float*)(ws + OFF_MIX32), (bh*)(ws + OFF_ABF)}; E(acc, u, wr, wc, fr, fq); } break;
    case 8: { EpiRes E{P_OUT}; E(acc, u, wr, wc, fr, fq); } break;
    case 9: { EpiFfn E{(bh*)(ws + OFF_ACT)}; E(acc, u, wr, wc, fr, fq); } break;
    case 11: { EpiUpF E{(const bh*)(ws + OFF_ZG) + 4096, (bh*)(ws + OFF_ABF)}; E(acc, u, wr, wc, fr, fq); } break;
    default: { EpiPle E{P_OUT, (const float*)(ws + OFF_MIX32)}; E(acc, u, wr, wc, fr, fq); } break;
    }
}
}

__device__ __forceinline__ bool make_gemm(const Params& p, int L, int q, int i, pg8::Gemm& g) {
    unsigned char* ws = P_WS;
    g.M = T; g.perm = 0; g.L = L;
    switch (q) {
    case 1: if (i > 0) return false;
        g.A = (const bh*)(ws + OFF_ABF); g.lda = D; g.Bt = (const bh*)(ws + OFF_WIN); g.ldb = D; g.N = NINP; g.K = D; g.epi = 0; return true;
    case 3: if (i > 2) return false;
        g.lda = 256; g.ldb = 256; g.N = 512; g.K = 256;
        if (i == 0) { g.A = (const bh*)(ws + OFF_LAW); g.Bt = (const bh*)(ws + OFF_WW2); g.epi = 1; }
        else if (i == 1) { g.A = (const bh*)(ws + OFF_LAA); g.Bt = (const bh*)(ws + OFF_WA2); g.epi = 2; }
        else { g.A = (const bh*)(ws + OFF_LAG); g.Bt = (const bh*)(ws + OFF_WG2); g.epi = 3; }
        return true;
    case 5: if (i > 0) return false;
        g.A = (const bh*)(ws + OFF_YS); g.lda = 512; g.Bt = (const bh*)(ws + OFF_WGLU); g.ldb = 512; g.N = 512; g.K = 512; g.epi = 4; return true;
    case 6: if (i > 0) return false;
        g.A = (const bh*)(ws + OFF_YCAT); g.lda = D; g.Bt = (const bh*)(ws + OFF_WUP); g.ldb = D; g.N = D; g.K = D; g.epi = 11; return true;
    case 7: if (i > 0) return false;
        g.A = (const bh*)(ws + OFF_ABF); g.lda = D; g.Bt = (const bh*)(ws + OFF_WO); g.ldb = D; g.N = D; g.K = D; g.epi = 8; return true;
    case 9: if (i > 0) return false;
        g.A = (const bh*)(ws + OFF_ABF); g.lda = D; g.Bt = (const bh*)(ws + OFF_WGU); g.ldb = D; g.N = 2 * FH; g.K = D; g.epi = 9; g.perm = 1; return true;
    case 10: if (i > 0) return false;
        g.A = (const bh*)(ws + OFF_ACT); g.lda = FH; g.Bt = (const bh*)(ws + OFF_WD); g.ldb = FH; g.N = D; g.K = FH; g.epi = 8; return true;
    case 12: if (i > 1) return false;
        if (i == 0) { g.A = (const bh*)(ws + OFF_PBF) + (size_t)L * T * 256; g.lda = 256; g.Bt = (const bh*)(ws + OFF_WPP); g.ldb = 256; g.N = D; g.K = 256; g.epi = 3; }
        else { g.A = (const bh*)(ws + OFF_ABF); g.lda = D; g.Bt = (const bh*)(ws + OFF_WPG); g.ldb = D; g.N = D; g.K = D; g.epi = 10; }
        return true;
    default: return false;
    }
}

struct CJ { const float* src; int in_idx, src_ld, kv, n0, nv; long lstride; size_t dst; int dst_ld, r0, c0, npad, kpad, seg, segstride; };
constexpr int BIGSEG = 1 << 30;
__constant__ int JT_I[15][12] = {
    {3, NIN, 2048, NF, NGATE, D, 0, 0, NGATE, 2048, BIGSEG, 0},
    {3, NIN, 2048, 0, NF, D, NGATE, 0, 6656, 2048, BIGSEG, 0},
    {29, D, 1024, 0, D, D, 0, 0, D, 1024, BIGSEG, 0},
    {30, D, 512, 0, D, D, 0, 1024, D, 512, BIGSEG, 0},
    {31, D, 512, 0, D, D, 0, 1536, D, 512, BIGSEG, 0},
    {32, D, 2048, 0, D, D, 0, 0, D, 2048, BIGSEG, 0},
    {34, FH, 2048, 0, FH, D, 0, 0, FH, 2048, 128, 256},
    {35, FH, 2048, 0, FH, D, 128, 0, FH, 2048, 128, 256},
    {36, D, FH, 0, D, FH, 0, 0, D, FH, BIGSEG, 0},
    {38, D, 2048, 0, D, D, 0, 0, D, 2048, BIGSEG, 0},
    {39, D, 256, 0, D, 256, 0, 0, D, 256, BIGSEG, 0},
    {27, 512, 512, 0, 512, 512, 0, 0, 512, 512, BIGSEG, 0},
    {10, 512, 96, 0, 512, 256, 0, 0, 512, 256, BIGSEG, 0},
    {12, 512, 96, 0, 512, 256, 0, 0, 512, 256, BIGSEG, 0},
    {13, 512, 256, 0, 512, 256, 0, 0, 512, 256, BIGSEG, 0}};
__constant__ long JT_L[15][2] = {
    {(long)D * NIN, (long)OFF_WIN}, {(long)D * NIN, (long)OFF_WIN}, {(long)1024 * D, (long)OFF_WUP}, {(long)512 * D, (long)OFF_WUP}, {(long)512 * D, (long)OFF_WUP},
    {(long)D * D, (long)OFF_WO}, {(long)D * FH, (long)OFF_WGU}, {(long)D * FH, (long)OFF_WGU}, {(long)FH * D, (long)OFF_WD}, {(long)D * D, (long)OFF_WPG},
    {(long)256 * D, (long)OFF_WPP}, {(long)512 * 512, (long)OFF_WGLU}, {(long)96 * 512, (long)OFF_WW2}, {(long)96 * 512, (long)OFF_WA2}, {(long)256 * 512, (long)OFF_WG2}};
__device__ __forceinline__ void get_job(int j, CJ& J) {
    J.in_idx = JT_I[j][0]; J.src_ld = JT_I[j][1]; J.kv = JT_I[j][2]; J.n0 = JT_I[j][3]; J.nv = JT_I[j][4]; J.dst_ld = JT_I[j][5]; J.r0 = JT_I[j][6]; J.c0 = JT_I[j][7];
    J.npad = JT_I[j][8]; J.kpad = JT_I[j][9]; J.seg = JT_I[j][10]; J.segstride = JT_I[j][11]; J.lstride = JT_L[j][0]; J.dst = (size_t)JT_L[j][1];
}
__device__ __forceinline__ const float* in_by_idx(const Params& p, int i) { return P_IN(i); }
constexpr int NJOBS = 15;

__device__ __forceinline__ void conv_load(int L, const CJ& J, int tile, int lane, f32x4 (&v)[16]) {
    const int nkt = J.kpad / 64; const int tn = tile / nkt, tk = tile % nkt;
    const float* src = J.src + (size_t)L * J.lstride;
    const int cq = lane & 15, r = lane >> 4;
    const int nl = tn * 64 + cq * 4; const bool nok = nl < J.nv;
    const int k0 = tk * 64 + 16 * r;
    const float* sp = src + (size_t)k0 * J.src_ld + J.n0 + nl;
    const float zc = OZ();
#pragma unroll
    for (int i = 0; i < 16; ++i) { v[i] = (f32x4){zc, zc, zc, zc}; if (nok && (k0 + i) < J.kv) v[i] = *(const f32x4*)(sp + (size_t)i * J.src_ld); }
}
__device__ __forceinline__ void conv_store(const CJ& J, int tile, int lane, const f32x4 (&v)[16], bh* dstbase) {
    const int nkt = J.kpad / 64; const int tn = tile / nkt, tk = tile % nkt;
    const int cq = lane & 15, r = lane >> 4;
    const int nl = tn * 64 + cq * 4; const int k0 = tk * 64 + 16 * r;
#pragma unroll
    for (int j = 0; j < 4; ++j) { const int n = nl + j; const int drow = J.r0 + (n / J.seg) * J.segstride + (n % J.seg);
        u32x4 w0, w1;
        w0.x = cvt_pk_bf16(v[0][j], v[1][j]); w0.y = cvt_pk_bf16(v[2][j], v[3][j]); w0.z = cvt_pk_bf16(v[4][j], v[5][j]); w0.w = cvt_pk_bf16(v[6][j], v[7][j]);
        w1.x = cvt_pk_bf16(v[8][j], v[9][j]); w1.y = cvt_pk_bf16(v[10][j], v[11][j]); w1.z = cvt_pk_bf16(v[12][j], v[13][j]); w1.w = cvt_pk_bf16(v[14][j], v[15][j]);
        bh* d = dstbase + (size_t)drow * J.dst_ld + J.c0 + k0;
        *(u32x4*)d = w0; *(u32x4*)(d + 8) = w1; }
}
__device__ __forceinline__ void conv_tiles(int L, const CJ& J, int first, int ntile, int stride, int lane, bh* dstbase) {
    for (int t = first; t < ntile; t += 2 * stride) {
        f32x4 va[16], vb[16]; const bool hasb = (t + stride) < ntile;
        conv_load(L, J, t, lane, va);
        if (hasb) conv_load(L, J, t + stride, lane, vb);
        __builtin_amdgcn_sched_barrier(0);
        conv_store(J, t, lane, va, dstbase);
        if (hasb) conv_store(J, t + stride, lane, vb, dstbase);
    }
}

__device__ __forceinline__ void rms_row_bf16(const float* x, const float* g, bh* o, int lane) {
    f32x4 v[8]; float s = 0.f;
#pragma unroll
    for (int j = 0; j < 8; ++j) { v[j] = *(const f32x4*)(x + j * 256 + lane * 4); s += (v[j][0] * v[j][0] + v[j][1] * v[j][1]) + (v[j][2] * v[j][2] + v[j][3] * v[j][3]); }
    const float rstd = rsqrtf(wave_sum(s) * (1.0f / D) + 1e-6f);
#pragma unroll
    for (int j = 0; j < 8; ++j) { const f32x4 gg = *(const f32x4*)(g + j * 256 + lane * 4); u32x2 w; w.x = pk2(v[j][0] * rstd * gg[0], v[j][1] * rstd * gg[1]); w.y = pk2(v[j][2] * rstd * gg[2], v[j][3] * rstd * gg[3]);
        *(u32x2*)(o + j * 256 + lane * 4) = w; }
}
__device__ __forceinline__ void phase_rmsnorm(const Params& p, const float* g) {
    const int gw = BIDX() * 8 + (TIDX() >> 6), NGW = GDIM() * 8, lane = TIDX() & 63;
    bh* abf = (bh*)(P_WS + OFF_ABF);
    for (int r = gw; r < T; r += NGW) rms_row_bf16(P_OUT + (size_t)r * D, g, abf + (size_t)r * D, lane);
}

__device__ __forceinline__ void phase_conv(const Params& p, int L, LAS unsigned char* lds) {
    const int tid = TIDX();
    {   const int gw0 = BIDX() * 8 + (tid >> 6), NGW0 = GDIM() * 8, ln = tid & 63;
        int base = 0;
        for (int j = 0; j < NJOBS; ++j) { CJ J; get_job(j, J); J.src = in_by_idx(p, J.in_idx); const int ntile = (J.npad / 64) * (J.kpad / 64);
            int first = gw0 - (base % NGW0); if (first < 0) first += NGW0;
            bh* dstbase = (bh*)(P_WS + J.dst);
            conv_tiles(L, J, first, ntile, NGW0, ln, dstbase);
            base += ntile; } }
    const int gw = BIDX() * 8 + (tid >> 6), NGW = GDIM() * 8, lane = tid & 63;
    bh* abf = (bh*)(P_WS + OFF_ABF);
    if (L == 0) {
        const float* ps = P_IN(1); bh* pb = (bh*)(P_WS + OFF_PBF);
        for (size_t i = (size_t)BIDX() * 512 + tid; i < (size_t)2 * T * 256 / 4; i += (size_t)GDIM() * 512) { const f32x4 v = ((const f32x4*)ps)[i]; u32x2 w; w.x = pk2(v[0], v[1]); w.y = pk2(v[2], v[3]); ((u32x2*)pb)[i] = w; }
        const float* x = P_IN(0);
        for (int r = gw; r < T; r += NGW) {
#pragma unroll
            for (int j = 0; j < 8; ++j) *(f32x4*)(P_OUT + (size_t)r * D + j * 256 + lane * 4) = *(const f32x4*)(x + (size_t)r * D + j * 256 + lane * 4);
            rms_row_bf16(x + (size_t)r * D, P_IN(2), abf + (size_t)r * D, lane);
        }
    } else {
        for (int r = gw; r < T; r += NGW) rms_row_bf16(P_OUT + (size_t)r * D, P_IN(2) + (size_t)L * D, abf + (size_t)r * D, lane);
    }
}

struct S5C { float ar, ai; float br[16], bi[16]; };
__device__ __forceinline__ void s5_setup(const Params& p, int L, int g, int n, S5C& c) {
    const int gi = L * 32 + g;
    const float dt = __expf(P_IN(21)[gi]);
    const float are = P_IN(19)[gi * 64 + n], aim = P_IN(20)[gi * 64 + n];
    const float mag = __expf(are * dt), ang = aim * dt;
    float sn, cs;
    {
        const double a = (double)ang; const double k = rint(a * 0.15915494309189535); const float r = (float)(a - k * 6.283185307179586);
        sn = sinf(r); cs = cosf(r);
    }
    c.ar = mag * cs; c.ai = mag * sn;
    const float den = are * are + aim * aim, nr = c.ar - 1.0f, ni = c.ai;
    const float cr = (nr * are + ni * aim) / den, ci = (ni * are - nr * aim) / den;
    const float* bre = P_IN(22) + ((size_t)gi * 64 + n) * 16; const float* bim = P_IN(23) + ((size_t)gi * 64 + n) * 16;
#pragma unroll
    for (int q = 0; q < 4; ++q) { const f32x4 r4 = *(const f32x4*)(bre + q * 4), i4 = *(const f32x4*)(bim + q * 4);
#pragma unroll
        for (int j = 0; j < 4; ++j) { c.br[q * 4 + j] = cr * r4[j] - ci * i4[j]; c.bi[q * 4 + j] = cr * i4[j] + ci * r4[j]; } }
}
__device__ __forceinline__ void s5_step(const S5C& c, const LAS float* urow, float& sr, float& si) {
    float xr = 0.f, xi = 0.f;
#pragma unroll
    for (int q = 0; q < 4; ++q) { const f32x4 u4 = *(const LAS f32x4*)(urow + q * 4);
#pragma unroll
        for (int j = 0; j < 4; ++j) { xr = fmaf(u4[j], c.br[q * 4 + j], xr); xi = fmaf(u4[j], c.bi[q * 4 + j], xi); } }
    const float nr = c.ar * sr - c.ai * si + xr, ni = c.ar * si + c.ai * sr + xi;
    sr = nr; si = ni;
}
__device__ __forceinline__ void s5_stage_u(const float* zfc, LAS float* ul, int lane) {
    const float* src = zfc + (size_t)lane * ZF_LD;
    const f32x4 a = *(const f32x4*)src, b = *(const f32x4*)(src + 4), c = *(const f32x4*)(src + 8), d = *(const f32x4*)(src + 12);
    *(LAS f32x4*)(ul + lane * 16) = a; *(LAS f32x4*)(ul + lane * 16 + 4) = b; *(LAS f32x4*)(ul + lane * 16 + 8) = c; *(LAS f32x4*)(ul + lane * 16 + 12) = d;
    asm volatile("s_waitcnt lgkmcnt(0)" ::: "memory"); __builtin_amdgcn_wave_barrier();
}

__device__ __forceinline__ size_t fq_base(int h, int c, int mt, int ks8) { return ((((size_t)(h * NCH + c) * 4 + mt) * 8 + ks8) * 64) * 8; }
__device__ __forceinline__ size_t fq_off(int h, int t, int d) { const int s = t & 63; return fq_base(h, t >> 6, s >> 4, d >> 5) + ((s & 15) + 16 * ((d >> 3) & 3)) * 8 + (d & 7); }
__device__ __forceinline__ int ft_off(int row, int s8) { return ((((row >> 5) * 4 + (s8 >> 1)) * 64) + (row & 31) + 32 * (s8 & 1)) * 8; }

__device__ __forceinline__ void mlstm_prep(const Params& p, int L, int h, int c, LAS unsigned char* lds) {
    const int tid = TIDX(), t0 = c * 64;
    const float* zf = (const float*)(P_WS + OFF_ZF);
    LAS float* s_ws = (LAS float*)lds;
    if (tid < 64) {
        const int t = t0 + tid;
        float ig = zf[(size_t)t * ZF_LD + 4096 + h] + P_IN(5)[L * 4 + h];
        float fg = zf[(size_t)t * ZF_LD + 4100 + h] + P_IN(6)[L * 4 + h];
        ig = 15.0f * tanhf(ig * (1.0f / 15.0f)); fg = 15.0f * tanhf(fg * (1.0f / 15.0f));
        const float lf = fminf(fg, 0.f) - log1pf(__expf(-fabsf(fg)));
        float b = lf;
#pragma unroll
        for (int o = 1; o < 64; o <<= 1) { const float nb = bperm_f((tid - o) & 63, b); if (tid >= o) b += nb; }
        const float bend = bperm_f(63, b);
        const float wlog = bend - b + ig;
        const float mloc = wave_max(wlog);
        s_ws[tid] = __expf(wlog - mloc);
        ((float*)(P_WS + OFF_MI))[h * T + t] = ig; ((float*)(P_WS + OFF_MBB))[h * T + t] = b;
        if (tid == 0) { ((float*)(P_WS + OFF_MBEND))[h * NCH + c] = bend; ((float*)(P_WS + OFF_MLOC))[h * NCH + c] = mloc; }
    }
    __syncthreads();
    const int d = tid & 255, isk = tid >> 8;
    const int col = isk * 1024 + h * 256 + d;
    const float* cw = P_IN(4) + (size_t)L * 4 * 2048;
    const float w0 = cw[col], w1 = cw[2048 + col], w2 = cw[4096 + col], w3 = cw[6144 + col];
    float x1 = (t0 >= 1) ? zf[(size_t)(t0 - 1) * ZF_LD + col] : 0.f, x2 = (t0 >= 2) ? zf[(size_t)(t0 - 2) * ZF_LD + col] : 0.f, x3 = (t0 >= 3) ? zf[(size_t)(t0 - 3) * ZF_LD + col] : 0.f;
    bh* MQ = (bh*)(P_WS + OFF_MQ); bh* MK = (bh*)(P_WS + OFF_MK);
    bh* MT = (bh*)(P_WS + (isk ? OFF_MKT : OFF_MVT)) + (size_t)(h * NCH + c) * 16384;
    LAS bh* sQK = (LAS bh*)(lds + 1024);
    float dnacc = 0.f;
    for (int hf = 0; hf < 2; ++hf) {
        float xs[32], vs[32];
#pragma unroll
        for (int j = 0; j < 32; ++j) { const int t = t0 + hf * 32 + j; xs[j] = zf[(size_t)t * ZF_LD + col]; vs[j] = isk ? 0.f : zf[(size_t)t * ZF_LD + 2048 + h * 256 + d]; }
        __builtin_amdgcn_sched_barrier(0);
#pragma unroll
        for (int s8l = 0; s8l < 4; ++s8l) { const int s8 = hf * 4 + s8l;
            unsigned pk[4];
#pragma unroll
            for (int j = 0; j < 8; ++j) { const int s = s8 * 8 + j;
                const float x0 = xs[s8l * 8 + j]; float y = w0 * x0 + w1 * x1 + w2 * x2 + w3 * x3; x3 = x2; x2 = x1; x1 = x0;
                y = y * sigmoidf_(y);
                unsigned short e;
                if (!isk) { sQK[s * 264 + d] = f2bf(y * 0.0625f); e = f2bf(vs[s8l * 8 + j]); }
                else { sQK[64 * 264 + s * 264 + d] = f2bf(y); const float wk = y * s_ws[s]; e = f2bf(wk); dnacc += wk; }
                if (j & 1) pk[j >> 1] |= ((unsigned)e << 16); else pk[j >> 1] = e; }
            u32x4 w; w.x = pk[0]; w.y = pk[1]; w.z = pk[2]; w.w = pk[3];
            *(u32x4*)(MT + ft_off(d, s8)) = w; }
    }
    if (isk) ((float*)(P_WS + OFF_DN))[(size_t)(h * NCH + c) * 256 + d] = dnacc;
    __syncthreads();
#pragma unroll
    for (int i = 0; i < 8; ++i) { const int pid = i * 512 + tid, tens = pid >> 11, rem = pid & 2047, mt = rem >> 9, ks8 = (rem >> 6) & 7, lp = rem & 63;
        const u32x4 w = *(const LAS u32x4*)(sQK + tens * (64 * 264) + (mt * 16 + (lp & 15)) * 264 + ks8 * 32 + (lp >> 4) * 8);
        *(u32x4*)((tens ? MK : MQ) + fq_base(h, c, mt, ks8) + lp * 8) = w; }
    __syncthreads();
}

__device__ __forceinline__ void rwkv_prep_token(const Params& p, int L, int t, int lane) {
    const float* zf = (const float*)(P_WS + OFF_ZF);
    const float* z = zf + (size_t)t * ZF_LD + ZR0; const float* zp = z - ZF_LD; const bool hp = t > 0;
    const float* mu = P_IN(8) + (size_t)L * 1984;
    float* RR = (float*)(P_WS + OFF_RR); float* RK = (float*)(P_WS + OFF_RK); float* RV = (float*)(P_WS + OFF_RV); float* RKK = (float*)(P_WS + OFF_RKK);
    const float* kkw = P_IN(14) + L * 512;
    float sr[8], sk[8], sv[8], kw[8], lw[2], la[2], lg[4];
#pragma unroll
    for (int i = 0; i < 8; ++i) { const int c = i * 64 + lane;
        { const float a = z[c], b = hp ? zp[c] : 0.f; sr[i] = a + (b - a) * mu[c]; }
        { const float a = z[512 + c], b = hp ? zp[512 + c] : 0.f; sk[i] = a + (b - a) * mu[512 + c]; }
        { const float a = z[1024 + c], b = hp ? zp[1024 + c] : 0.f; sv[i] = a + (b - a) * mu[1024 + c]; }
        kw[i] = kkw[c]; }
#pragma unroll
    for (int i = 0; i < 2; ++i) { const int j = i * 64 + lane; lw[i] = 0.f; la[i] = 0.f;
        if (j < 96) { { const int c = 1536 + j; const float a = z[c], b = hp ? zp[c] : 0.f; lw[i] = a + (b - a) * mu[c]; }
                      { const int c = 1632 + j; const float a = z[c], b = hp ? zp[c] : 0.f; la[i] = a + (b - a) * mu[c]; } } }
#pragma unroll
    for (int i = 0; i < 4; ++i) { const int c = 1728 + i * 64 + lane; const float a = z[c], b = hp ? zp[c] : 0.f; lg[i] = a + (b - a) * mu[c]; }
    __builtin_amdgcn_sched_barrier(0);
#pragma unroll
    for (int i = 0; i < 8; ++i) { const int c = i * 64 + lane;
        RR[(size_t)t * 512 + c] = sr[i]; RV[(size_t)t * 512 + c] = sv[i]; RK[(size_t)t * 512 + c] = sk[i];
        const float kkv = sk[i] * kw[i]; const float ss = wave_sum(kkv * kkv); RKK[(size_t)t * 512 + c] = kkv / fmaxf(sqrtf(ss), 1e-12f); }
    bh* LAW = (bh*)(P_WS + OFF_LAW) + (size_t)t * 256; bh* LAA = (bh*)(P_WS + OFF_LAA) + (size_t)t * 256; bh* LAG = (bh*)(P_WS + OFF_LAG) + (size_t)t * 256;
#pragma unroll
    for (int i = 0; i < 4; ++i) { const int j = i * 64 + lane;
        float vw = 0.f, va = 0.f;
        if (i < 2 && j < 96) { vw = tanhf(lw[i < 2 ? i : 0]); va = la[i < 2 ? i : 0]; }
        LAW[j] = f2bf(vw); LAA[j] = f2bf(va); LAG[j] = f2bf(sigmoidf_(lg[i])); }
}

__device__ __forceinline__ void s5_pass_a(const Params& p, int L, int g, int c, int lane, LAS float* ul) {
    const float* zf = (const float*)(P_WS + OFF_ZF) + (size_t)(c * 64) * ZF_LD + ZS0 + g * 16;
    s5_stage_u(zf, ul, lane);
    S5C k; s5_setup(p, L, g, lane, k);
    float sr = 0.f, si = 0.f;
#pragma unroll 8
    for (int s = 0; s < 64; ++s) s5_step(k, ul + s * 16, sr, si);
    asm volatile("s_waitcnt lgkmcnt(0)" ::: "memory"); __builtin_amdgcn_wave_barrier();
    float* se = (float*)(P_WS + OFF_SEND) + ((size_t)(g * NCH + c) * 64 + lane) * 2;
    se[0] = sr; se[1] = si;
}

__device__ __forceinline__ void phase_prep(const Params& p, int L, LAS unsigned char* lds) {
    const int wid = TIDX() >> 6, lane = TIDX() & 63;
    for (int it = BIDX(); it < 2048; it += GDIM()) {
        if (it < 512) mlstm_prep(p, L, it >> 7, it & 127, lds);
        else if (it < 1536) rwkv_prep_token(p, L, (it - 512) * 8 + wid, lane);
        else { const int w = (it - 1536) * 8 + wid; s5_pass_a(p, L, w >> 7, w & 127, lane, (LAS float*)lds + wid * 1024); }
    }
}

constexpr int RW_NS = 4, RW_LS = T / RW_NS, RW_NB = RW_LS / 16, RW_RING = 4, RW_SLOT = 16 * 384;
constexpr int RW_YOFF = RW_RING * RW_SLOT;
__device__ __forceinline__ void rwkv_scan(const Params& p, int b, LAS unsigned char* lds) {
    const int tid = TIDX(), wid = __builtin_amdgcn_readfirstlane(tid >> 6), lane = tid & 63;
    int j, h, rg;
    if (b < 32) { j = 0; h = b >> 2; rg = b & 3; } else { const int u = b - 32; j = 1 + (u >> 6); h = (u & 63) >> 3; rg = u & 7; }
    LAS float* ring = (LAS float*)lds;
    LAS float* ybuf = ring + RW_YOFF;
    const int tbase = j * RW_LS;
    const bool isP = rg >= 4;
    if (wid >= 4) {
        const int lw = wid - 4, lt = tid - 256;
        const float* gp[6]; unsigned lo[6];
#pragma unroll
        for (int i = 0; i < 6; ++i) { const int ii = lw * 6 + i, rowidx = ii * 4 + (lane >> 4), step = rowidx / 6, a = rowidx % 6, q = lane & 15;
            const int ai = (0x205314 >> (4 * a)) & 0xf;
            gp[i] = (const float*)(P_WS + OFF_RR + (size_t)ai * SZ_R) + (size_t)(tbase + step) * 512 + h * 64 + q * 4;
            lo[i] = (unsigned)ii * 256u; }
        float* OUT = (float*)(P_WS + (isP ? OFF_RZ : OFF_RY)) + (size_t)(tbase + (lt >> 4)) * 512 + h * 64 + (rg & 3) * 16 + (lt & 15);
#define RW_ISSUE(bi, sl) do { _Pragma("unroll") for (int _i = 0; _i < 6; ++_i) \
        __builtin_amdgcn_global_load_lds((const unsigned*)(gp[_i] + (size_t)(bi) * 16 * 512), (LAS unsigned*)(ring + (sl) * RW_SLOT + lo[_i]), 16, 0, 0); } while (0)
        RW_ISSUE(0, 0); RW_ISSUE(1, 1); RW_ISSUE(2, 2);
        asm volatile("s_waitcnt vmcnt(12)" ::: "memory"); __builtin_amdgcn_s_barrier();
        int sl = 3;
        for (int ib = 0; ib < RW_NB; ++ib) {
            if (ib + 3 < RW_NB) RW_ISSUE(ib + 3, sl);
            sl = (sl == RW_RING - 1) ? 0 : sl + 1;
            if (ib > 0) {
                const LAS float* yb = ybuf + ((ib - 1) & 1) * 4096 + lt * 16;
                const f32x4 a0 = *(const LAS f32x4*)yb, a1 = *(const LAS f32x4*)(yb + 4), a2 = *(const LAS f32x4*)(yb + 8), a3 = *(const LAS f32x4*)(yb + 12);
                const f32x4 sm = (a0 + a1) + (a2 + a3);
                OUT[(size_t)(ib - 1) * 16 * 512] = (sm[0] + sm[1]) + (sm[2] + sm[3]);
            }
            if (ib + 3 < RW_NB) asm volatile("s_waitcnt vmcnt(13)" ::: "memory");
            else asm volatile("s_waitcnt vmcnt(0)" ::: "memory");
            __builtin_amdgcn_s_barrier();
        }
        {   const LAS float* yb = ybuf + ((RW_NB - 1) & 1) * 4096 + lt * 16;
            const f32x4 a0 = *(const LAS f32x4*)yb, a1 = *(const LAS f32x4*)(yb + 4), a2 = *(const LAS f32x4*)(yb + 8), a3 = *(const LAS f32x4*)(yb + 12);
            const f32x4 sm = (a0 + a1) + (a2 + a3);
            OUT[(size_t)(RW_NB - 1) * 16 * 512] = (sm[0] + sm[1]) + (sm[2] + sm[3]); }
#undef RW_ISSUE
    } else {
        const int r16 = wid * 4 + (lane >> 4), kq = lane & 15, row = (rg & 3) * 16 + r16;
        f32x4 S;
#pragma unroll
        for (int e = 0; e < 4; ++e) S[e] = (isP && (kq * 4 + e == row)) ? 1.f : 0.f;
        const float vmask = isP ? 0.f : 1.f;
        __builtin_amdgcn_s_barrier();
        int sl = 0;
        for (int ib = 0; ib < RW_NB; ++ib) {
            const LAS float* bb = ring + sl * RW_SLOT;
            LAS float* yw = ybuf + (ib & 1) * 4096 + r16 * 16 + kq;
            f32x4 w4 = *(const LAS f32x4*)(bb + kq * 4), k4 = *(const LAS f32x4*)(bb + 64 + kq * 4), kk4 = *(const LAS f32x4*)(bb + 128 + kq * 4),
                  b4 = *(const LAS f32x4*)(bb + 192 + kq * 4), r4 = *(const LAS f32x4*)(bb + 256 + kq * 4);
            float vv = bb[320 + row];
#pragma unroll
            for (int s = 0; s < 16; ++s) {
                f32x4 w4n, k4n, kk4n, b4n, r4n; float vvn;
                if (s < 15) { const LAS float* q = bb + (s + 1) * 384;
                    w4n = *(const LAS f32x4*)(q + kq * 4); k4n = *(const LAS f32x4*)(q + 64 + kq * 4); kk4n = *(const LAS f32x4*)(q + 128 + kq * 4);
                    b4n = *(const LAS f32x4*)(q + 192 + kq * 4); r4n = *(const LAS f32x4*)(q + 256 + kq * 4); vvn = q[320 + row]; }
                __builtin_amdgcn_sched_barrier(0);
                float pd = fmaf(S[0], kk4[0], fmaf(S[1], kk4[1], fmaf(S[2], kk4[2], S[3] * kk4[3])));
                const f32x4 pre = S * w4 + (vv * vmask) * k4;
                pd = allreduce16(pd);
                S = pre + pd * b4;
                yw[s * 256] = fmaf(S[0], r4[0], fmaf(S[1], r4[1], fmaf(S[2], r4[2], S[3] * r4[3])));
                if (s < 15) { w4 = w4n; k4 = k4n; kk4 = kk4n; b4 = b4n; r4 = r4n; vv = vvn; }
            }
            sl = (sl == RW_RING - 1) ? 0 : sl + 1;
            asm volatile("s_waitcnt lgkmcnt(0)" ::: "memory");
            __builtin_amdgcn_s_barrier();
        }
        float* EN = (float*)(P_WS + (isP ? OFF_RPEND : OFF_RSEND)) + ((size_t)(h * 4 + j) * 64 + row) * 64 + kq * 4;
        *(f32x4*)EN = S;
    }
    __syncthreads();
}

struct MStage { bf16x8 q[4], k[4], v[4]; float bend, mloc; };
__device__ __forceinline__ void mstage_load(MStage& st, const bh* qp, const bh* kp, const bh* vp, const float* MBEND, const float* MLOC, int h, int c) {
#pragma unroll
    for (int ks = 0; ks < 4; ++ks) { st.q[ks] = *(const bf16x8*)(qp + (size_t)c * 16384 + ks * 512); st.k[ks] = *(const bf16x8*)(kp + (size_t)c * 16384 + ks * 512); st.v[ks] = *(const bf16x8*)(vp + (size_t)c * 16384 + ks * 512); }
    st.bend = MBEND[h * NCH + c]; st.mloc = MLOC[h * NCH + c];
}
__device__ __forceinline__ void mlstm_seq(const Params& p, int mb, LAS unsigned char* lds) {
    const int tid = TIDX(), wid = tid >> 6, lane = tid & 63;
    const int h = mb >> 3, jv = mb & 7;
    LAS bh* Cbf = (LAS bh*)lds;
    constexpr int CS = 264;
    for (int i = tid; i < 2 * 32 * CS / 2; i += 512) ((LAS unsigned*)Cbf)[i] = 0u;
    __syncthreads();
    const bh* MQ = (const bh*)(P_WS + OFF_MQ); const bh* MKT = (const bh*)(P_WS + OFF_MKT); const bh* MVT = (const bh*)(P_WS + OFF_MVT);
    const float* MBEND = (const float*)(P_WS + OFF_MBEND); const float* MLOC = (const float*)(P_WS + OFF_MLOC);
    f32x16 ct;
    { const float z = OZ();
#pragma unroll
    for (int i = 0; i < 16; ++i) ct[i] = z; }
    float m = 0.f;
    const int mt = wid >> 1, kh = wid & 1;
    float* MINTER = (float*)(P_WS + OFF_ABF);
    LAS float* It = (LAS float*)(lds + 2 * 32 * 264 * 2);
    const bh* qp = MQ + fq_base(h, 0, mt, kh * 4) + lane * 8;
    const bh* kp = MKT + (size_t)(h * NCH) * 16384 + (wid * 4 * 64 + lane) * 8;
    const bh* vp = MVT + (size_t)(h * NCH) * 16384 + (jv * 4 * 64 + lane) * 8;
    MStage s0, s1, s2;
    mstage_load(s0, qp, kp, vp, MBEND, MLOC, h, 0);
    mstage_load(s1, qp, kp, vp, MBEND, MLOC, h, 1);
#define MSTEP(SC, SL, CIDX) do { const int c = (CIDX); const int t0 = c * 64, cur = c & 1; \
        mstage_load(SL, qp, kp, vp, MBEND, MLOC, h, (c + 2 < NCH) ? c + 2 : NCH - 1); \
        const float mnew = fmaxf(SC.bend + m, SC.mloc), decay = __expf(SC.bend + m - mnew), scale = __expf(SC.mloc - mnew); \
        f32x4 r0 = {0.f, 0.f, 0.f, 0.f}, r1 = {0.f, 0.f, 0.f, 0.f}; \
        const LAS bh* cb = Cbf + cur * 32 * CS + (lane & 15) * CS + kh * 128 + (lane >> 4) * 8; \
        _Pragma("unroll") for (int ks = 0; ks < 4; ++ks) { const bf16x8 b0 = *(const LAS bf16x8*)(cb + ks * 32), b1 = *(const LAS bf16x8*)(cb + 16 * CS + ks * 32); r0 = MFMA16(SC.q[ks], b0, r0); r1 = MFMA16(SC.q[ks], b1, r1); } \
        {     \
            if (c > 0) { const LAS float* ip = It + ((c - 1) & 1) * (2 * 64 * 36) + (tid >> 3) * 36 + (tid & 7) * 4; \
                const f32x4 sv = *(const LAS f32x4*)ip + *(const LAS f32x4*)(ip + 64 * 36); \
                float* o = MINTER + (size_t)(t0 - 64 + (tid >> 3)) * 1024 + h * 256 + jv * 32 + (tid & 7) * 4; \
                asm volatile("global_store_dwordx4 %0, %1, off\n\ts_nop 1" :: "v"(o), "v"(sv) : "memory"); } \
            LAS float* iw = It + cur * (2 * 64 * 36) + kh * (64 * 36) + (mt * 16 + (lane >> 4) * 4) * 36 + (lane & 15); \
            _Pragma("unroll") for (int r = 0; r < 4; ++r) { iw[r * 36] = r0[r]; iw[r * 36 + 16] = r1[r]; } } \
        f32x16 d0; { const float z = OZ(); _Pragma("unroll") for (int i = 0; i < 16; ++i) d0[i] = z; } \
        _Pragma("unroll") for (int ks = 0; ks < 4; ++ks) d0 = MFMA32(SC.k[ks], SC.v[ks], d0); \
        _Pragma("unroll") for (int i = 0; i < 16; ++i) ct[i] = decay * ct[i] + scale * d0[i]; \
        m = mnew; \
        {   LAS bh* o0 = Cbf + (cur ^ 1) * 32 * CS + (lane & 31) * CS + wid * 32 + 4 * (lane >> 5); \
            _Pragma("unroll") for (int g = 0; g < 4; ++g) { u32x2 w0; w0.x = cvt_pk_bf16(ct[4 * g], ct[4 * g + 1]); w0.y = cvt_pk_bf16(ct[4 * g + 2], ct[4 * g + 3]); *(LAS u32x2*)(o0 + 8 * g) = w0; } } \
        asm volatile("s_waitcnt lgkmcnt(0)" ::: "memory"); __builtin_amdgcn_s_barrier(); asm volatile("" ::: "memory"); } while (0)
    for (int c3 = 0; c3 < 126; c3 += 6) { MSTEP(s0, s2, c3); MSTEP(s1, s0, c3 + 1); MSTEP(s2, s1, c3 + 2); MSTEP(s0, s2, c3 + 3); MSTEP(s1, s0, c3 + 4); MSTEP(s2, s1, c3 + 5); }
    MSTEP(s0, s2, 126); MSTEP(s1, s0, 127);
#undef MSTEP
    {   const LAS float* ip = It + (127 & 1) * (2 * 64 * 36) + (tid >> 3) * 36 + (tid & 7) * 4;
        const f32x4 sv = *(const LAS f32x4*)ip + *(const LAS f32x4*)(ip + 64 * 36);
        *(f32x4*)(MINTER + (size_t)(127 * 64 + (tid >> 3)) * 1024 + h * 256 + jv * 32 + (tid & 7) * 4) = sv; }
    asm volatile("s_waitcnt vmcnt(0)" ::: "memory");
    __syncthreads();
}

__device__ __forceinline__ void mlstm_nscan(const Params& p) {
    const float* MBEND = (const float*)(P_WS + OFF_MBEND); const float* MLOC = (const float*)(P_WS + OFF_MLOC);
    const float* DN = (const float*)(P_WS + OFF_DN); float* NST = (float*)(P_WS + OFF_NST); float* MSTART = (float*)(P_WS + OFF_MSTART);
    for (int idx = TIDX(); idx < 1024; idx += 512) { const int h = idx >> 8, d = idx & 255; float m = 0.f, n = 0.f;
        for (int c0 = 0; c0 < NCH; c0 += 16) {
            float be[16], ml[16], dn[16];
#pragma unroll
            for (int j = 0; j < 16; ++j) { be[j] = MBEND[h * NCH + c0 + j]; ml[j] = MLOC[h * NCH + c0 + j]; dn[j] = DN[(size_t)(h * NCH + c0 + j) * 256 + d]; }
            __builtin_amdgcn_sched_barrier(0);
#pragma unroll
            for (int j = 0; j < 16; ++j) { const int c = c0 + j; if (d == 0) MSTART[h * NCH + c] = m; NST[(size_t)(h * NCH + c) * 256 + d] = n;
                const float mnew = fmaxf(be[j] + m, ml[j]);
                n = __expf(be[j] + m - mnew) * n + __expf(ml[j] - mnew) * dn[j]; m = mnew; } } }
}

__device__ __forceinline__ float gelu_tanh(float x) { const float u = 0.7978845608028654f * (x + 0.044715f * x * x * x); return 0.5f * x * (1.0f + tanhf(u)); }

__device__ __forceinline__ void s5_pass_c(const Params& p, int L, int g, int c, int lane, LAS bh* img, LAS float* ul) {
    const float* zf = (const float*)(P_WS + OFF_ZF) + (size_t)(c * 64) * ZF_LD + ZS0 + g * 16;
    s5_stage_u(zf, ul, lane);
    S5C k; s5_setup(p, L, g, lane, k);
    float sr = 0.f, si = 0.f;
    {   float pr = k.ar, pi = k.ai;
#pragma unroll
        for (int i = 0; i < 6; ++i) { const float nr = pr * pr - pi * pi, ni = 2.f * pr * pi; pr = nr; pi = ni; }
        const float* se = (const float*)(P_WS + OFF_SEND) + ((size_t)(g * NCH) * 64 + lane) * 2;
        int cc = 0;
        for (; cc + 8 <= c; cc += 8) { float er[8], ei[8];
#pragma unroll
            for (int j = 0; j < 8; ++j) { er[j] = se[(size_t)(cc + j) * 128]; ei[j] = se[(size_t)(cc + j) * 128 + 1]; }
#pragma unroll
            for (int j = 0; j < 8; ++j) { const float nr = pr * sr - pi * si + er[j], ni = pr * si + pi * sr + ei[j]; sr = nr; si = ni; } }
        for (; cc < c; ++cc) { const float er = se[(size_t)cc * 128], ei = se[(size_t)cc * 128 + 1];
            const float nr = pr * sr - pi * si + er, ni = pr * si + pi * sr + ei; sr = nr; si = ni; } }
    const int gi = L * 32 + g;
    bf16x8 bfr[4];
    {   const int pp = lane & 15; const float* cre = P_IN(24) + ((size_t)gi * 16 + pp) * 64; const float* cim = P_IN(25) + ((size_t)gi * 16 + pp) * 64;
#pragma unroll
        for (int ks = 0; ks < 4; ++ks)
#pragma unroll
            for (int j = 0; j < 8; ++j) { const int n2 = ks * 32 + (lane >> 4) * 8 + j; const float v = (n2 < 64) ? cre[n2] : -cim[n2 - 64]; bfr[ks][j] = (short)f2bf(v); } }
    const float dco = P_IN(26)[L * 512 + g * 16 + (lane & 15)];
    bh* YS = (bh*)(P_WS + OFF_YS);
    for (int half = 0; half < 2; ++half) {
#pragma unroll 8
        for (int s = 0; s < 32; ++s) { s5_step(k, ul + (half * 32 + s) * 16, sr, si); img[s * 136 + lane] = f2bf(sr); img[s * 136 + 64 + lane] = f2bf(si); }
        asm volatile("s_waitcnt lgkmcnt(0)" ::: "memory"); __builtin_amdgcn_wave_barrier();
#pragma unroll
        for (int mt = 0; mt < 2; ++mt) { f32x4 acc = {0.f, 0.f, 0.f, 0.f};
#pragma unroll
            for (int ks = 0; ks < 4; ++ks) { const bf16x8 a = *(const LAS bf16x8*)(img + (mt * 16 + (lane & 15)) * 136 + ks * 32 + (lane >> 4) * 8); acc = MFMA16(a, bfr[ks], acc); }
#pragma unroll
            for (int r = 0; r < 4; ++r) { const int tt = half * 32 + mt * 16 + (lane >> 4) * 4 + r; const float uv = ul[tt * 16 + (lane & 15)];
                YS[(size_t)(c * 64 + tt) * 512 + g * 16 + (lane & 15)] = f2bf(gelu_tanh(acc[r] + dco * uv)); } }
        asm volatile("s_waitcnt lgkmcnt(0)" ::: "memory"); __builtin_amdgcn_wave_barrier();
    }
}

__device__ __forceinline__ void phase_scan(const Params& p, int L, LAS unsigned char* lds) {
    const int b = BIDX();
    if (b < 224) { for (int rr = 0; rr < PROBE_RW; ++rr) rwkv_scan(p, b, lds); }
    else { for (int rr = 0; rr < PROBE_ML; ++rr) mlstm_seq(p, b - 224, lds); }
}
__device__ __forceinline__ void phase_s5c(const Params& p, int L, LAS unsigned char* lds) {
    const int b = BIDX(), wid = TIDX() >> 6, lane = TIDX() & 63;
    if (b == GDIM() - 1) mlstm_nscan(p);
    const int nw = GDIM() * 8;
    for (int w = b * 8 + wid; w < 32 * NCH; w += nw) s5_pass_c(p, L, w >> 7, w & 127, lane, (LAS bh*)lds + wid * (32 * 136), (LAS float*)(lds + 69632) + wid * 1024);
    __syncthreads();
}

__device__ __forceinline__ void mlstm_out(const Params& p, int L, int h, int c, LAS unsigned char* lds) {
    const int tid = TIDX(), wid = tid >> 6, lane = tid & 63, t0 = c * 64;
    LAS bh* Pl = (LAS bh*)lds;
    LAS float* s_b = (LAS float*)(lds + 9216); LAS float* s_a = s_b + 64; LAS float* s_mt = s_a + 64; LAS float* s_iw = s_mt + 64; LAS float* s_den = s_iw + 64; LAS float* s_qn = s_den + 64; LAS float* s_part = s_qn + 64;
    const bh* MQ = (const bh*)(P_WS + OFF_MQ); const bh* MK = (const bh*)(P_WS + OFF_MK); const bh* MVT = (const bh*)(P_WS + OFF_MVT);
    const float* MINTER = (const float*)(P_WS + OFF_ABF);
    const float m0 = ((const float*)(P_WS + OFF_MSTART))[h * NCH + c];
    if (tid < 64) { const float ig = ((const float*)(P_WS + OFF_MI))[h * T + t0 + tid], b = ((const float*)(P_WS + OFF_MBB))[h * T + t0 + tid];
        const float a = ig - b; float cm = a;
#pragma unroll
        for (int o = 1; o < 64; o <<= 1) { const float nb = bperm_f((tid - o) & 63, cm); if (tid >= o) cm = fmaxf(cm, nb); }
        const float mt = b + fmaxf(m0, cm);
        s_b[tid] = b; s_a[tid] = a; s_mt[tid] = mt; s_iw[tid] = __expf(b + m0 - mt); }
    __syncthreads();
    {
        const int mt = wid >> 1, nt0 = (wid & 1) * 2;
        f32x4 r0 = {0.f, 0.f, 0.f, 0.f}, r1 = {0.f, 0.f, 0.f, 0.f};
        const bh* qp = MQ + fq_base(h, c, mt, 0) + lane * 8;
        const bh* kp = MK + fq_base(h, c, nt0, 0) + lane * 8;
#pragma unroll
        for (int ks = 0; ks < 8; ++ks) { const bf16x8 a = *(const bf16x8*)(qp + ks * 512); const bf16x8 b0 = *(const bf16x8*)(kp + ks * 512), b1 = *(const bf16x8*)(kp + 8 * 512 + ks * 512);
            r0 = MFMA16(a, b0, r0); r1 = MFMA16(a, b1, r1); }
#pragma unroll
        for (int r = 0; r < 4; ++r) { const int t = mt * 16 + (lane >> 4) * 4 + r; const float bt = s_b[t] - s_mt[t];
            { const int s = nt0 * 16 + (lane & 15); const float pv = (s <= t) ? r0[r] * __expf(bt + s_a[s]) : 0.f; Pl[t * 72 + s] = f2bf(pv); }
            { const int s = nt0 * 16 + 16 + (lane & 15); const float pv = (s <= t) ? r1[r] * __expf(bt + s_a[s]) : 0.f; Pl[t * 72 + s] = f2bf(pv); } }
    }
    __syncthreads();
    if (tid < 64) { float s = 0.f;
#pragma unroll
        for (int q = 0; q < 8; ++q) { const u32x4 w = *(const LAS u32x4*)(Pl + tid * 72 + q * 8);
            s += __uint_as_float(w.x << 16) + __uint_as_float(w.x & 0xffff0000u) + __uint_as_float(w.y << 16) + __uint_as_float(w.y & 0xffff0000u)
               + __uint_as_float(w.z << 16) + __uint_as_float(w.z & 0xffff0000u) + __uint_as_float(w.w << 16) + __uint_as_float(w.w & 0xffff0000u); }
        s_den[tid] = s; }
    {
        const float* nst = (const float*)(P_WS + OFF_NST) + (size_t)(h * NCH + c) * 256 + lane * 4; const f32x4 nv = *(const f32x4*)nst;
#pragma unroll
        for (int i = 0; i < 8; ++i) { const int t = wid * 8 + i; const u32x2 q2 = *(const u32x2*)(MQ + fq_off(h, t0 + t, lane * 4));
            float s = __uint_as_float(q2.x << 16) * nv[0] + __uint_as_float(q2.x & 0xffff0000u) * nv[1] + __uint_as_float(q2.y << 16) * nv[2] + __uint_as_float(q2.y & 0xffff0000u) * nv[3];
            s = wave_sum(s); if (lane == 0) s_qn[t] = s; } }
    f32x4 acc[4][2];
#pragma unroll
    for (int a = 0; a < 4; ++a) { const float z = OZ(); acc[a][0] = (f32x4){z, z, z, z}; acc[a][1] = (f32x4){z, z, z, z}; }
    {   const bh* vp = MVT + (size_t)(h * NCH + c) * 16384;
#pragma unroll
        for (int ks = 0; ks < 2; ++ks) { const bf16x8 b0 = *(const bf16x8*)(vp + ft_off(wid * 32 + (lane & 15), ks * 4 + (lane >> 4))), b1 = *(const bf16x8*)(vp + ft_off(wid * 32 + 16 + (lane & 15), ks * 4 + (lane >> 4)));
#pragma unroll
            for (int a = 0; a < 4; ++a) { const bf16x8 av = *(const LAS bf16x8*)(Pl + (a * 16 + (lane & 15)) * 72 + ks * 32 + (lane >> 4) * 8);
                acc[a][0] = MFMA16(av, b0, acc[a][0]); acc[a][1] = MFMA16(av, b1, acc[a][1]); } } }
    __syncthreads();
#pragma unroll
    for (int a = 0; a < 4; ++a)
#pragma unroll
        for (int r = 0; r < 4; ++r) { const int t = a * 16 + (lane >> 4) * 4 + r; const float iw = s_iw[t];
            const float den = s_den[t] + iw * s_qn[t]; const float dd = 1.0f / fmaxf(fabsf(den), __expf(-s_mt[t]));
            const float* mi = MINTER + (size_t)(t0 + t) * 1024 + h * 256 + wid * 32 + (lane & 15);
            const float h0 = (acc[a][0][r] + iw * mi[0]) * dd, h1 = (acc[a][1][r] + iw * mi[16]) * dd;
            acc[a][0][r] = h0; acc[a][1][r] = h1;
            float ss = h0 * h0 + h1 * h1;
            ss = allreduce16(ss);
            if ((lane & 15) == 0) s_part[wid * 64 + t] = ss; }
    __syncthreads();
    {   const float* zf = (const float*)(P_WS + OFF_ZF); const float* ng = P_IN(7) + L * 1024 + h * 256; bh* YC = (bh*)(P_WS + OFF_YCAT);
        float og[4][4][2]; const float ng0 = ng[wid * 32 + (lane & 15)], ng1 = ng[wid * 32 + 16 + (lane & 15)];
#pragma unroll
        for (int a = 0; a < 4; ++a)
#pragma unroll
            for (int r = 0; r < 4; ++r) { const float* op = zf + (size_t)(t0 + a * 16 + (lane >> 4) * 4 + r) * ZF_LD + 3072 + h * 256 + wid * 32 + (lane & 15); og[a][r][0] = op[0]; og[a][r][1] = op[16]; }
        __builtin_amdgcn_sched_barrier(0);
#pragma unroll
        for (int a = 0; a < 4; ++a)
#pragma unroll
            for (int r = 0; r < 4; ++r) { const int t = a * 16 + (lane >> 4) * 4 + r;
                float tot = 0.f;
#pragma unroll
                for (int w = 0; w < 8; ++w) tot += s_part[w * 64 + t];
                const float rstd = rsqrtf(tot * (1.0f / 256.0f) + 1e-6f);
                const int v0 = wid * 32 + (lane & 15);
                bh* yo = YC + (size_t)(t0 + t) * D + h * 256 + v0;
                yo[0] = f2bf(sigmoidf_(og[a][r][0]) * acc[a][0][r] * rstd * ng0);
                yo[16] = f2bf(sigmoidf_(og[a][r][1]) * acc[a][1][r] * rstd * ng1); } }
    __syncthreads();
}

__device__ __forceinline__ void rwkv_post(const Params& p, int L, int it, LAS unsigned char* lds) {
    const int tid = TIDX(), wid = tid >> 6, lane = tid & 63;
    const int h = it & 7, blk = it >> 3, j = blk >> 3;
    LAS float* bufA = (LAS float*)lds;
    LAS float* bufB = bufA + 64 * 65;
    LAS float* bufP = bufB + 64 * 65;
    const float* SE = (const float*)(P_WS + OFF_RSEND) + (size_t)(h * 4) * 4096; const float* PE = (const float*)(P_WS + OFF_RPEND) + (size_t)(h * 4) * 4096;
    LAS float* sst = bufA;
    if (j >= 1) {
        const int v = tid >> 3, k8 = (tid & 7) * 8;
        { const f32x4 a0 = *(const f32x4*)(SE + v * 64 + k8), a1 = *(const f32x4*)(SE + v * 64 + k8 + 4);
#pragma unroll
          for (int e = 0; e < 4; ++e) { bufA[v * 65 + k8 + e] = a0[e]; bufA[v * 65 + k8 + 4 + e] = a1[e]; } }
        for (int jj = 1; jj < j; ++jj) {
            { const f32x4 p0 = *(const f32x4*)(PE + (size_t)jj * 4096 + v * 64 + k8), p1 = *(const f32x4*)(PE + (size_t)jj * 4096 + v * 64 + k8 + 4);
              *(LAS f32x4*)(bufP + v * 64 + k8) = p0; *(LAS f32x4*)(bufP + v * 64 + k8 + 4) = p1; }
            __syncthreads();
            LAS float* src = (jj & 1) ? bufA : bufB; LAS float* dst = (jj & 1) ? bufB : bufA;
            f32x4 c0 = *(const f32x4*)(SE + (size_t)jj * 4096 + v * 64 + k8), c1 = *(const f32x4*)(SE + (size_t)jj * 4096 + v * 64 + k8 + 4);
#pragma unroll 8
            for (int i = 0; i < 64; ++i) { const float a = src[v * 65 + i]; const f32x4 p0 = *(const LAS f32x4*)(bufP + i * 64 + k8), p1 = *(const LAS f32x4*)(bufP + i * 64 + k8 + 4); c0 += a * p0; c1 += a * p1; }
#pragma unroll
            for (int e = 0; e < 4; ++e) { dst[v * 65 + k8 + e] = c0[e]; dst[v * 65 + k8 + 4 + e] = c1[e]; }
            __syncthreads();
            sst = dst;
        }
        __syncthreads();
    }
    float srow[64];
    if (j >= 1) {
#pragma unroll
        for (int i = 0; i < 64; ++i) srow[i] = sst[lane * 65 + i];
    } else {
#pragma unroll
        for (int i = 0; i < 64; ++i) srow[i] = 0.f;
    }
    const int c = h * 64 + lane;
    const float rkw = P_IN(16)[L * 512 + c], lg = P_IN(17)[L * 512 + c], lb = P_IN(18)[L * 512 + c];
    const float* RY = (const float*)(P_WS + OFF_RY); const float* RZ = (const float*)(P_WS + OFF_RZ); const float* RR = (const float*)(P_WS + OFF_RR); const float* RK = (const float*)(P_WS + OFF_RK);
    const float* RV = (const float*)(P_WS + OFF_RV); const float* RG = (const float*)(P_WS + OFF_RG); bh* YC = (bh*)(P_WS + OFF_YCAT);
    for (int i4 = 0; i4 < 32; i4 += 4) { float yv[4], zv[4], rrv[4], rkv[4], rvv[4], rgv[4];
#pragma unroll
        for (int q = 0; q < 4; ++q) { const size_t o = (size_t)(blk * 256 + wid * 32 + i4 + q) * 512 + c;
            yv[q] = RY[o]; zv[q] = (j >= 1) ? RZ[o] : 0.f; rrv[q] = RR[o]; rkv[q] = RK[o]; rvv[q] = RV[o]; rgv[q] = RG[o]; }
        __builtin_amdgcn_sched_barrier(0);
#pragma unroll
        for (int q4 = 0; q4 < 4; ++q4) { const int t = blk * 256 + wid * 32 + i4 + q4;
            float y = yv[q4];
            if (j >= 1) { const float z = zv[q4]; float y2 = 0.f;
#pragma unroll
                for (int q = 0; q < 64; q += 2) { y = fmaf(srow[q], __builtin_bit_cast(float, __builtin_amdgcn_readlane(__builtin_bit_cast(int, z), q)), y);
                                                  y2 = fmaf(srow[q + 1], __builtin_bit_cast(float, __builtin_amdgcn_readlane(__builtin_bit_cast(int, z), q + 1)), y2); }
                y += y2; }
            const float mu = wave_sum(y) * (1.0f / 64.0f); const float dlt = y - mu; const float var = wave_sum(dlt * dlt) * (1.0f / 64.0f);
            const float yn = dlt * rsqrtf(var + 64e-5f) * lg + lb;
            const float bon = wave_sum(rrv[q4] * rkv[q4] * rkw) * rvv[q4];
            YC[(size_t)t * D + 1024 + c] = f2bf((yn + bon) * rgv[q4]); } }
    __syncthreads();
}

__device__ __forceinline__ void phase_post(const Params& p, int L, LAS unsigned char* lds) {
    for (int it = BIDX(); it < 768; it += GDIM()) {
        if (it < 512) mlstm_out(p, L, it >> 7, it & 127, lds);
        else rwkv_post(p, L, it - 512, lds);
    }
    __syncthreads();
}

#define XB_TMO      128
#define XB_XCNT(j)  (256  + 64 * (j))
#define XB_XSUB(j)  (1280 + 64 * (j))
#define XB_XGEN(j)  (2304 + 64 * (j))
#define XB_TOP      3328
#define XB_TOPGEN   3392
#define XCD_BAR_WORDS 3456
#define XB_SPIN_CAP (1u << 18)

__device__ __forceinline__ unsigned xb_ld(unsigned* p)              { return __hip_atomic_load(p, __ATOMIC_RELAXED, __HIP_MEMORY_SCOPE_AGENT); }
__device__ __forceinline__ unsigned xb_add(unsigned* p, unsigned v) { return __hip_atomic_fetch_add(p, v, __ATOMIC_RELAXED, __HIP_MEMORY_SCOPE_AGENT); }
__device__ __forceinline__ unsigned xb_xcc_id() { return (unsigned)__builtin_amdgcn_s_getreg((3 << 11) | 20) & 0xFu; }
#define XB_SPIN(cond, bar) do { unsigned _sp = 0; while (cond) { __builtin_amdgcn_s_sleep(1); \
    if ((++_sp & 255u) == 0u) { if (xb_ld(&(bar)[XB_TMO])) break; if (_sp > XB_SPIN_CAP) { atomicAdd(&(bar)[XB_TMO], 1u); break; } } } } while (0)

struct XcdBarrier {
    unsigned* bar; unsigned x;
    volatile LAS unsigned* st;
};

__device__ __forceinline__ XcdBarrier xcd_barrier_post(unsigned* bar, volatile LAS unsigned* st) {
    XcdBarrier b; b.bar = bar; b.x = xb_xcc_id(); b.st = st;
    if (threadIdx.x == 0) (void)xb_add(&bar[XB_XCNT(b.x)], 1u);
    return b;
}
__device__ __forceinline__ void xcd_barrier_complete(unsigned* bar, unsigned x, unsigned& nloc, unsigned& nx) {
    const unsigned G = gridDim.x * gridDim.y * gridDim.z;
    unsigned sum, cnt, mine, sp = 0u;
    for (;;) {
        sum = 0u; cnt = 0u; mine = 0u;
#pragma unroll
        for (unsigned j = 0; j < 16; ++j) { const unsigned c = xb_ld(&bar[XB_XCNT(j)]); sum += c; cnt += (c > 0u) ? 1u : 0u; mine = (j == x) ? c : mine; }
        if (sum == G) break;
        __builtin_amdgcn_s_sleep(1);
        if ((++sp & 255u) == 0u) { if (xb_ld(&bar[XB_TMO])) break; if (sp > XB_SPIN_CAP) { atomicAdd(&bar[XB_TMO], 1u); break; } }
    }
    nloc = mine > 0u ? mine : 1u; nx = cnt > 0u ? cnt : 1u;
}

__device__ __forceinline__ void xcd_barrier(const XcdBarrier& b) {
    asm volatile("s_waitcnt vmcnt(0)" ::: "memory");
    __syncthreads();
    if (threadIdx.x == 0) {
        unsigned* bar = b.bar;
        __builtin_amdgcn_s_waitcnt(0);
        unsigned nloc = b.st[0], nx = b.st[1];
        if (nloc == 0u) { xcd_barrier_complete(bar, b.x, nloc, nx); b.st[0] = nloc; b.st[1] = nx; }
        const unsigned old = xb_add(&bar[XB_XSUB(b.x)], 1u);
        const unsigned gen = old / nloc;
        if (old + 1u == (gen + 1u) * nloc) {
            __builtin_amdgcn_fence(__ATOMIC_RELEASE, "agent");
            asm volatile("s_waitcnt vmcnt(0)" ::: "memory");
            const unsigned og = xb_add(&bar[XB_TOP], 1u);
            const unsigned tg = og / nx;
            if (og + 1u == (tg + 1u) * nx) xb_add(&bar[XB_TOPGEN], 1u);
            else XB_SPIN(xb_ld(&bar[XB_TOPGEN]) == tg, bar);
            __builtin_amdgcn_fence(__ATOMIC_ACQUIRE, "agent");
            xb_add(&bar[XB_XGEN(b.x)], 1u);
            asm volatile("s_waitcnt vmcnt(0)" ::: "memory");
        } else {
            XB_SPIN(xb_ld(&bar[XB_XGEN(b.x)]) == gen, bar);
            __builtin_amdgcn_fence(__ATOMIC_ACQUIRE, "agent");
            asm volatile("s_waitcnt vmcnt(0)" ::: "memory");
        }
    }
    __syncthreads();
}


constexpr int NPHASE = 27;
__global__ void __launch_bounds__(512, 2) hybrid_fwd(Params p, int ph_lo, int ph_hi, int rep_q) {
    extern __shared__ __attribute__((aligned(16))) unsigned char smem_raw[];
    LAS unsigned char* lds = (LAS unsigned char*)smem_raw;
    cg::grid_group grid = cg::this_grid();
    volatile LAS unsigned* xst = (volatile LAS unsigned*)(lds + 131072);
    if (threadIdx.x < 2) xst[threadIdx.x] = 0u;
    __syncthreads();
    { XcdBarrier b0 = xcd_barrier_post((unsigned*)(P_WS + OFF_BAR), xst); (void)b0; }
    for (int ph = ph_lo; ph < ph_hi; ++ph) {
        if (ph == ph_lo + 1) grid.sync();
        else if (ph > ph_lo) { XcdBarrier xb; xb.bar = (unsigned*)(P_WS + OFF_BAR); xb.x = xb_xcc_id(); xb.st = xst; xcd_barrier(xb); }
        if (ph == 26) {
            const int gw = BIDX() * 8 + (TIDX() >> 6), NGW = GDIM() * 8, lane = TIDX() & 63;
            for (int r = gw; r < T; r += NGW) { float* x = P_OUT + (size_t)r * D; f32x4 v[8]; float s = 0.f;
#pragma unroll
                for (int j = 0; j < 8; ++j) { v[j] = *(const f32x4*)(x + j * 256 + lane * 4); s += (v[j][0] * v[j][0] + v[j][1] * v[j][1]) + (v[j][2] * v[j][2] + v[j][3] * v[j][3]); }
                const float rstd = rsqrtf(wave_sum(s) * (1.0f / D) + 1e-6f);
#pragma unroll
                for (int j = 0; j < 8; ++j) { const f32x4 gg = *(const f32x4*)(P_IN(40) + j * 256 + lane * 4); *(f32x4*)(x + j * 256 + lane * 4) = v[j] * rstd * gg; } }
            continue;
        }
        const int L = ph / 13, q = ph % 13;
#ifdef ONLY_Q
        if (q != ONLY_Q) continue;
#endif
        const int nrep = (q == rep_q) ? 2 : 1;
        for (int rep = 0; rep < nrep; ++rep) {
        if (rep) grid.sync();
        switch (q) {
        case 0: phase_conv(p, L, lds); break;
        case 2: phase_prep(p, L, lds); break;
        case 4: phase_scan(p, L, lds); break;
        case 5: phase_post(p, L, lds); break;
        case 8: phase_rmsnorm(p, P_IN(33) + (size_t)L * D); break;
        case 11: phase_rmsnorm(p, P_IN(37) + (size_t)L * D); break;
        default: break;
        }
        for (int i = 0; i < 3; ++i) {
            pg8::Gemm g;
            if (!make_gemm(p, L, q, i, g)) break;
            pg8::StaticOrder S; S.init(T, g.N, GDIM(), (q == 3) ? BIDX() - 64 * i : BIDX());
            pg8::gemm_phase(lds, g, S);
        }
        if (q == 3) phase_s5c(p, L, lds);
        }
    }
}

extern "C" void kernel_launch(void* const* d_in, const int* in_sizes, int n_in, void* d_out, int out_size, void* d_ws, size_t ws_size, hipStream_t stream) {
    constexpr size_t kDynLds = 131072 + 64;
    static int grid_blocks = 0;
    if (!grid_blocks) {
        int dev = 0, cus = 0, per_cu = 0;
        (void)hipGetDevice(&dev);
        (void)hipDeviceGetAttribute(&cus, hipDeviceAttributeMultiprocessorCount, dev);
        (void)hipFuncSetAttribute((const void*)hybrid_fwd, hipFuncAttributeMaxDynamicSharedMemorySize, (int)kDynLds);
        (void)hipOccupancyMaxActiveBlocksPerMultiprocessor(&per_cu, hybrid_fwd, 512, kDynLds);
        if (per_cu > 1) per_cu = 1;
        grid_blocks = cus * per_cu;
        if (ws_size < WS_TOTAL) fprintf(stderr, "workspace too small: %zu < %zu\n", ws_size, (size_t)WS_TOTAL);
    }
    Params p{};
    for (int i = 0; i < 41; ++i) p.in[i] = (const float*)d_in[i];
    p.out = (float*)d_out; p.ws = (unsigned char*)d_ws;
    (void)hipMemsetAsync((char*)d_ws + OFF_BAR, 0, XCD_BAR_WORDS * 4, stream);
#if SINGLE_LAUNCH
    int lo = 0, hi = NPHASE, rq = PROBE_REP_Q;
    void* args[] = {&p, &lo, &hi, &rq};
    hipError_t e = hipLaunchCooperativeKernel((const void*)hybrid_fwd, dim3(grid_blocks), dim3(512), args, kDynLds, stream);
    if (e != hipSuccess) fprintf(stderr, "cooperative launch failed: %s (grid %d)\n", hipGetErrorString(e), grid_blocks);
#else
    for (int ph = 0; ph < NPHASE; ++ph) {
        int lo = ph, hi = ph + 1, rq = -1;
        void* args[] = {&p, &lo, &hi, &rq};
        hipError_t e = hipLaunchCooperativeKernel((const void*)hybrid_fwd, dim3(grid_blocks), dim3(512), args, kDynLds, stream);
        if (e != hipSuccess) fprintf(stderr, "cooperative launch failed: %s (grid %d)\n", hipGetErrorString(e), grid_blocks);
    }
#endif
}
```

```cpp
#include <hip/hip_runtime.h>
#include <hip/hip_cooperative_groups.h>
#include <cstdio>
#include <cstdint>
namespace cg = cooperative_groups;

#define LAS __attribute__((address_space(3)))
typedef unsigned short bh;
typedef short bf16x8 __attribute__((ext_vector_type(8)));
typedef float f32x4 __attribute__((ext_vector_type(4)));
typedef float f32x16 __attribute__((ext_vector_type(16)));
typedef unsigned u32x4 __attribute__((ext_vector_type(4)));
typedef unsigned u32x2 __attribute__((ext_vector_type(2)));

#ifndef PROBE_RW
#define PROBE_RW 1
#define PROBE_ML 1
#endif
#ifndef PROBE_REP_Q
#define PROBE_REP_Q (-1)
#endif
#ifndef SINGLE_LAUNCH
#define SINGLE_LAUNCH 1
#endif

constexpr int T = 8192, D = 2048, FH = 5632;
constexpr int NIN = 12744, NGATE = 6144, NF = 6600, ZF_LD = 6656, NINP = 12800;
constexpr int ZR0 = 4104, ZS0 = 6088;
constexpr int NCH = 128;

constexpr size_t AL(size_t x) { return (x + 255) & ~(size_t)255; }
constexpr size_t SZ_WIN = (size_t)NINP * D * 2, SZ_SQ = (size_t)D * D * 2, SZ_WGU = (size_t)2 * FH * D * 2, SZ_WD = (size_t)D * FH * 2;
constexpr size_t OFF_WIN = 0;
constexpr size_t OFF_WUP = OFF_WIN + SZ_WIN;
constexpr size_t OFF_WO = OFF_WUP + SZ_SQ;
constexpr size_t OFF_WGU = OFF_WO + SZ_SQ;
constexpr size_t OFF_WD = OFF_WGU + SZ_WGU;
constexpr size_t OFF_WPG = OFF_WD + SZ_WD;
constexpr size_t OFF_WPP = OFF_WPG + SZ_SQ;
constexpr size_t OFF_WGLU = OFF_WPP + (size_t)D * 256 * 2;
constexpr size_t OFF_WW2 = OFF_WGLU + (size_t)512 * 512 * 2;
constexpr size_t OFF_WA2 = OFF_WW2 + (size_t)512 * 256 * 2;
constexpr size_t OFF_WG2 = OFF_WA2 + (size_t)512 * 256 * 2;
constexpr size_t OFF_PBF = OFF_WG2 + (size_t)512 * 256 * 2;
constexpr size_t OFF_ABF = OFF_PBF + (size_t)2 * T * 256 * 2;
constexpr size_t OFF_YCAT = OFF_ABF + (size_t)T * D * 2;
constexpr size_t OFF_ZF = OFF_YCAT + (size_t)T * D * 2;
constexpr size_t OFF_ACT = OFF_ZF;
constexpr size_t OFF_MIX32 = OFF_ZF + (size_t)100663296;
constexpr size_t OFF_ZG = OFF_ZF + (size_t)T * ZF_LD * 4;
constexpr size_t SZ_R = (size_t)T * 512 * 4;
constexpr size_t OFF_RR = OFF_ZG + (size_t)T * NGATE * 2;
constexpr size_t OFF_RK = OFF_RR + SZ_R, OFF_RV = OFF_RK + SZ_R, OFF_RKK = OFF_RV + SZ_R, OFF_RW = OFF_RKK + SZ_R, OFF_RB = OFF_RW + SZ_R, OFF_RG = OFF_RB + SZ_R, OFF_RY = OFF_RG + SZ_R;
constexpr size_t OFF_LAW = OFF_RY + SZ_R;
constexpr size_t OFF_LAA = OFF_LAW + (size_t)T * 256 * 2, OFF_LAG = OFF_LAA + (size_t)T * 256 * 2;
constexpr size_t SZ_MB = (size_t)T * 1024 * 2;
constexpr size_t OFF_MQ = OFF_LAG + (size_t)T * 256 * 2, OFF_MK = OFF_MQ + SZ_MB, OFF_MKT = OFF_MK + SZ_MB, OFF_MVT = OFF_MKT + SZ_MB;
constexpr size_t OFF_MI = OFF_MVT + SZ_MB;
constexpr size_t OFF_MBB = OFF_MI + (size_t)4 * T * 4;
constexpr size_t OFF_MBEND = OFF_MBB + (size_t)4 * T * 4;
constexpr size_t OFF_MLOC = OFF_MBEND + 2048, OFF_MSTART = OFF_MLOC + 2048;
constexpr size_t OFF_DN = OFF_MSTART + 2048;
constexpr size_t OFF_NST = OFF_DN + (size_t)4 * NCH * 256 * 4;
constexpr size_t OFF_SEND = OFF_NST + (size_t)4 * NCH * 256 * 4;
constexpr size_t OFF_YS = OFF_SEND + (size_t)32 * NCH * 64 * 8;
constexpr size_t OFF_RZ = OFF_YS + (size_t)T * 512 * 2;
constexpr size_t OFF_RSEND = OFF_RZ + SZ_R;
constexpr size_t OFF_RPEND = OFF_RSEND + (size_t)8 * 4 * 4096 * 4;
constexpr size_t OFF_MINTER2 = OFF_RPEND + (size_t)8 * 4 * 4096 * 4;
constexpr size_t OFF_BAR = OFF_MINTER2;
constexpr size_t WS_TOTAL = OFF_MINTER2 + (size_t)T * 1024 * 4;

struct Params { const float* in[41]; float* out; unsigned char* ws; };
#define KARG4 __attribute__((address_space(4)))
__device__ __forceinline__ const float* karg_in(int i) { const KARG4 char* ka = (const KARG4 char*)__builtin_amdgcn_kernarg_segment_ptr(); return *(const float* const volatile KARG4*)(ka + (size_t)i * 8); }
#define P_IN(i) karg_in(i)
#define P_OUT ((float*)karg_in(41))
#define P_WS ((unsigned char*)karg_in(42))

__device__ __forceinline__ int TIDX() { int t = threadIdx.x; asm volatile("" : "+v"(t)); return t; }
__device__ __forceinline__ int BIDX() { int t = blockIdx.x; asm volatile("" : "+s"(t)); return t; }
__device__ __forceinline__ int GDIM() { int t = gridDim.x; asm volatile("" : "+s"(t)); return t; }
__device__ __forceinline__ bh f2bf(float f) { unsigned u = __float_as_uint(f); u += 0x7fffu + ((u >> 16) & 1u); return (bh)(u >> 16); }
__device__ __forceinline__ float bf2f(bh h) { return __uint_as_float(((unsigned)h) << 16); }
__device__ __forceinline__ unsigned pk2(float lo, float hi) { return (unsigned)f2bf(lo) | ((unsigned)f2bf(hi) << 16); }
__device__ __forceinline__ float sigmoidf_(float x) { return __builtin_amdgcn_rcpf(1.0f + __expf(-x)); }
__device__ __forceinline__ float bperm_f(int srclane, float v) { return __builtin_bit_cast(float, __builtin_amdgcn_ds_bpermute(srclane << 2, __builtin_bit_cast(int, v))); }
template <int CTRL> __device__ __forceinline__ float dpp_f(float x) {
    return __builtin_bit_cast(float, __builtin_amdgcn_update_dpp(0, __builtin_bit_cast(int, x), CTRL, 0xf, 0xf, true));
}
__device__ __forceinline__ float allreduce16(float x) {
    x += dpp_f<0xB1>(x); x += dpp_f<0x4E>(x); x += dpp_f<0x141>(x); x += dpp_f<0x140>(x);
    return x;
}
__device__ __forceinline__ float rl_f(float v, int l) { return __builtin_bit_cast(float, __builtin_amdgcn_readlane(__builtin_bit_cast(int, v), l)); }
__device__ __forceinline__ float wave_sum(float v) {
    v = allreduce16(v);
    return (rl_f(v, 0) + rl_f(v, 16)) + (rl_f(v, 32) + rl_f(v, 48));
}
__device__ __forceinline__ float wave_max(float v) {
    v = fmaxf(v, dpp_f<0xB1>(v)); v = fmaxf(v, dpp_f<0x4E>(v)); v = fmaxf(v, dpp_f<0x141>(v)); v = fmaxf(v, dpp_f<0x140>(v));
    return fmaxf(fmaxf(rl_f(v, 0), rl_f(v, 16)), fmaxf(rl_f(v, 32), rl_f(v, 48)));
}
__device__ __forceinline__ float OZ() { float z = 0.f; asm volatile("" : "+v"(z)); return z; }
#define MFMA16(a, b, c) __builtin_amdgcn_mfma_f32_16x16x32_bf16(a, b, c, 0, 0, 0)
#define MFMA32(a, b, c) __builtin_amdgcn_mfma_f32_32x32x16_bf16(a, b, c, 0, 0, 0)

namespace pg8 {
constexpr int BM = 256, BK = 64, HALF = 128, HTB = HALF * BK * 2, STAGE_BYTES = 8 * HTB, NXCD = 8, WGM = 8;
__device__ __forceinline__ int lds_byte(int r, int c) { const int st = (r >> 4) * 2 + (c >> 5), rr = r & 15, cc = c & 31, ob = rr * 64 + cc * 2; return st * 1024 + (ob ^ (((ob >> 9) & 1) << 5)); }
__device__ __forceinline__ void stage_rc(int b, int& R, int& C) { const int st = b / 1024, sb = b % 1024, swz = sb ^ (((sb >> 9) & 1) << 5); R = (st >> 1) * 16 + swz / 64; C = (st & 1) * 32 + (swz % 64) / 2; }
__device__ __forceinline__ int perm32(int rho) { const int n = rho >> 4, i = rho & 15; return 8 * (i >> 2) + 4 * n + (i & 3); }
struct Unit { int pm, pn; };
struct Gemm { const bh* A; const bh* Bt; int M, N, K, lda, ldb, epi, perm, L; };
struct StaticOrder {
    int nM, nN, nwg, G, c;
    __device__ void init(int M, int N, int G_, int c_) { nM = M / BM; nN = N / BM; nwg = nM * nN; G = G_; c = c_; }
    __device__ bool next(int i, Unit& u) const {
        const long L = (long)i * G + c; if (c < 0 || L >= nwg) return false;
        int wgid = (int)L; { const int q = nwg / NXCD, r = nwg % NXCD, xcd = wgid % NXCD, off = wgid / NXCD; wgid = (xcd < r ? xcd * (q + 1) : r * (q + 1) + (xcd - r) * q) + off; }
        const int nig = WGM * nN, gid = wgid / nig, fm = gid * WGM, gsz = (nM - fm) < WGM ? (nM - fm) : WGM;
        u.pm = fm + ((wgid % nig) % gsz); u.pn = (wgid % nig) / gsz; return true;
    }
};
__device__ __forceinline__ unsigned cvt_pk_bf16(float lo, float hi) { unsigned r; asm volatile("v_cvt_pk_bf16_f32 %0, %1, %2" : "=v"(r) : "v"(lo), "v"(hi)); return r; }

__device__ __forceinline__ void epi_run(const Gemm& g, const f32x4 (&acc)[2][2][4][2], const Unit& u, int wr, int wc, int fr, int fq);
__device__ __forceinline__ void up_rescale(f32x4 (&acc)[2][2][4][2], const Unit& u, int wr, int wc, int fr, int fq, int goff) {
    const bh* zg = (const bh*)(P_WS + OFF_ZG) + goff;
    asm volatile("" : "+v"(fr), "+v"(fq));
    const bh* zrow0 = zg + (size_t)(u.pm * 256 + wr * 64 + fr) * NGATE + u.pn * 256 + wc * 32 + 4 * fq;
#pragma unroll
    for (int ai = 0; ai < 2; ++ai)
#pragma unroll
        for (int mp = 0; mp < 2; ++mp) {
            u32x2 gp[8], gn[8];
#pragma unroll
            for (int mm = 0; mm < 2; ++mm) { const bh* zr = zrow0 + (size_t)(ai * 128 + (mp * 2 + mm) * 16) * NGATE;
#pragma unroll
                for (int bj = 0; bj < 2; ++bj)
#pragma unroll
                    for (int n = 0; n < 2; ++n) { gp[mm * 4 + bj * 2 + n] = *(const u32x2*)(zr + bj * 128 + n * 16); gn[mm * 4 + bj * 2 + n] = *(const u32x2*)(zr + 2048 + bj * 128 + n * 16); } }
            __builtin_amdgcn_sched_barrier(0);
#pragma unroll
            for (int mm = 0; mm < 2; ++mm)
#pragma unroll
                for (int bj = 0; bj < 2; ++bj)
#pragma unroll
                    for (int n = 0; n < 2; ++n) { const u32x2 p = gp[mm * 4 + bj * 2 + n], q = gn[mm * 4 + bj * 2 + n];
                        f32x4 r;
                        r[0] = __uint_as_float(p.x << 16) * __builtin_amdgcn_rcpf(__uint_as_float(q.x << 16)); r[1] = __uint_as_float(p.x & 0xffff0000u) * __builtin_amdgcn_rcpf(__uint_as_float(q.x & 0xffff0000u));
                        r[2] = __uint_as_float(p.y << 16) * __builtin_amdgcn_rcpf(__uint_as_float(q.y << 16)); r[3] = __uint_as_float(p.y & 0xffff0000u) * __builtin_amdgcn_rcpf(__uint_as_float(q.y & 0xffff0000u));
                        acc[ai][bj][mp * 2 + mm][n] *= r; }
            __builtin_amdgcn_sched_barrier(0); }
}
__device__ __forceinline__ void gemm_phase(LAS unsigned char* lds, const Gemm& g, const StaticOrder& S) {
    const int tid = TIDX(), wid = __builtin_amdgcn_readfirstlane(tid >> 6), lane = tid & 63, wr = wid >> 2, wc = wid & 3, fr = lane & 15, fq = lane >> 4;
    const int K = g.K, nt = K / BK;
    unsigned voffA[2], voffB[2];
#pragma unroll
    for (int i = 0; i < 2; ++i) { int R, C; stage_rc(tid * 16 + i * 8192, R, C); const int Rb = g.perm ? ((R & ~31) + perm32(R & 31)) : R;
        voffA[i] = (unsigned)(R * g.lda + C) * 2u; voffB[i] = (unsigned)(Rb * g.ldb + C) * 2u; }
    const size_t kstep = (size_t)(BK * 2);
    const size_t hstepA = (size_t)HALF * g.lda * 2, hstepB = (size_t)HALF * g.ldb * 2;
    const size_t tstepA = 2 * hstepA, tstepB = 2 * hstepB;
    const unsigned ldsw = (unsigned)wid * 1024u;
    const int aoff = lds_byte(wr * 64 + fr, fq * 8), boff = lds_byte(wc * 32 + fr, fq * 8);
#define PG8_SA(b, h) (((b) * 2 + (h)) * HTB)
#define PG8_SB(b, h) ((4 + (b) * 2 + (h)) * HTB)
#define PG8_STAGE(bufoff, gbase, voff) do { _Pragma("unroll") for (int _i = 0; _i < 2; ++_i) \
        __builtin_amdgcn_global_load_lds((const unsigned*)((const char*)(gbase) + (voff)[_i]), (LAS unsigned*)(lds + (bufoff) + ldsw + _i * 8192), 16, 0, 0); } while (0)
#define PG8_LDA(dst, b, h) do { _Pragma("unroll") for (int m = 0; m < 4; ++m) _Pragma("unroll") for (int k = 0; k < 2; ++k) dst[m][k] = *(const LAS bf16x8*)(lds + PG8_SA(b, h) + aoff + m * 2048 + k * 1024); } while (0)
#define PG8_LDB(dst, b, h) do { _Pragma("unroll") for (int n = 0; n < 2; ++n) _Pragma("unroll") for (int k = 0; k < 2; ++k) dst[n][k] = *(const LAS bf16x8*)(lds + PG8_SB(b, h) + boff + n * 2048 + k * 1024); } while (0)
#define PG8_MMA(ai, bj, At, Bt) do { __builtin_amdgcn_s_setprio(1); _Pragma("unroll") for (int m = 0; m < 4; ++m) _Pragma("unroll") for (int n = 0; n < 2; ++n) _Pragma("unroll") for (int k = 0; k < 2; ++k) \
        acc[ai][bj][m][n] = __builtin_amdgcn_mfma_f32_16x16x32_bf16(Bt[n][k], At[m][k], acc[ai][bj][m][n], 0, 0, 0); __builtin_amdgcn_s_setprio(0); } while (0)
#define PG8_WAIT_V(n) asm volatile("s_waitcnt vmcnt(" #n ")" ::: "memory")
#define PG8_WAIT_L(n) asm volatile("s_waitcnt lgkmcnt(" #n ")" ::: "memory")
#define PG8_BAR __builtin_amdgcn_s_barrier()
#define PG8_SCHED __builtin_amdgcn_sched_barrier(0)
    Unit cur, nxt; int ui = 0;
    if (!S.next(0, cur)) return;
    f32x4 acc[2][2][4][2];
    { const float z = OZ();
#pragma unroll
    for (int a = 0; a < 2; ++a)
#pragma unroll
        for (int b = 0; b < 2; ++b)
#pragma unroll
            for (int m = 0; m < 4; ++m)
#pragma unroll
                for (int n = 0; n < 2; ++n) acc[a][b][m][n] = (f32x4){z, z, z, z}; }
    bf16x8 At[4][2], B0[2][2], B1[2][2];
    const char* cA = (const char*)g.A + (size_t)cur.pm * tstepA; const char* cB = (const char*)g.Bt + (size_t)cur.pn * tstepB;
    PG8_STAGE(PG8_SB(0, 0), cB, voffB); PG8_STAGE(PG8_SA(0, 0), cA, voffA); PG8_STAGE(PG8_SB(0, 1), cB + hstepB, voffB); PG8_STAGE(PG8_SA(0, 1), cA + hstepA, voffA);
    if (wr == 1) PG8_BAR;
    PG8_WAIT_V(4); PG8_BAR;
    PG8_STAGE(PG8_SB(1, 0), cB + kstep, voffB); PG8_STAGE(PG8_SA(1, 0), cA + kstep, voffA); PG8_STAGE(PG8_SB(1, 1), cB + hstepB + kstep, voffB);
    PG8_WAIT_V(6); PG8_BAR;
    for (;;) {
        const bool has_next = S.next(ui + 1, nxt);
        const char* nA = has_next ? (const char*)g.A + (size_t)nxt.pm * tstepA : cA; const char* nB = has_next ? (const char*)g.Bt + (size_t)nxt.pn * tstepB : cB;
        for (int t = 0; t < nt; t += 2) {
            if (g.epi == 11 && (t == 16 || t == 24)) up_rescale(acc, cur, wr, wc, fr, fq, t == 16 ? 0 : 2048);
            const bool last = (t == nt - 2);
            const char* a1 = cA + (size_t)(t + 1) * kstep;
            const char* a2 = last ? nA : cA + (size_t)(t + 2) * kstep; const char* b2 = last ? nB : cB + (size_t)(t + 2) * kstep;
            const char* a3 = a2 + kstep; const char* b3 = b2 + kstep;
            PG8_LDB(B0, 0, 0); PG8_SCHED; PG8_LDA(At, 0, 0); PG8_STAGE(PG8_SA(1, 1), a1 + hstepA, voffA);
            PG8_WAIT_L(8); PG8_BAR; PG8_WAIT_L(0); PG8_MMA(0, 0, At, B0); PG8_BAR; PG8_SCHED;
            PG8_LDB(B1, 0, 1); PG8_STAGE(PG8_SB(0, 0), b2, voffB);
            PG8_BAR; PG8_WAIT_L(0); PG8_MMA(0, 1, At, B1); PG8_BAR;
            PG8_LDA(At, 0, 1); PG8_STAGE(PG8_SA(0, 0), a2, voffA);
            PG8_BAR; PG8_WAIT_L(0); PG8_MMA(1, 0, At, B0); PG8_BAR; PG8_SCHED;
            PG8_STAGE(PG8_SB(0, 1), b2 + hstepB, voffB);
            PG8_WAIT_V(6); PG8_BAR; PG8_MMA(1, 1, At, B1); PG8_BAR;
            PG8_LDB(B0, 1, 0); PG8_SCHED; PG8_LDA(At, 1, 0); PG8_STAGE(PG8_SA(0, 1), a2 + hstepA, voffA);
            PG8_WAIT_L(8); PG8_BAR; PG8_WAIT_L(0); PG8_MMA(0, 0, At, B0); PG8_BAR; PG8_SCHED;
            PG8_LDB(B1, 1, 1); PG8_STAGE(PG8_SB(1, 0), b3, voffB);
            PG8_BAR; PG8_WAIT_L(0); PG8_MMA(0, 1, At, B1); PG8_BAR;
            PG8_LDA(At, 1, 1); PG8_STAGE(PG8_SA(1, 0), a3, voffA);
            PG8_BAR; PG8_WAIT_L(0); PG8_MMA(1, 0, At, B0); PG8_BAR; PG8_SCHED;
            PG8_STAGE(PG8_SB(1, 1), b3 + hstepB, voffB);
            PG8_WAIT_V(6); PG8_BAR; PG8_MMA(1, 1, At, B1); PG8_BAR;
        }
        epi_run(g, acc, cur, wr, wc, fr, fq);
        if (!has_next) break;
        { const float z = OZ();
#pragma unroll
        for (int a = 0; a < 2; ++a)
#pragma unroll
            for (int b = 0; b < 2; ++b)
#pragma unroll
                for (int m = 0; m < 4; ++m)
#pragma unroll
                    for (int n = 0; n < 2; ++n) acc[a][b][m][n] = (f32x4){z, z, z, z}; }
        cur = nxt; cA = nA; cB = nB; ++ui;
    }
    PG8_WAIT_V(0);
    if (wr == 0) PG8_BAR;
    PG8_BAR;
#undef PG8_SA
#undef PG8_SB
#undef PG8_STAGE
#undef PG8_LDA
#undef PG8_LDB
#undef PG8_MMA
#undef PG8_WAIT_V
#undef PG8_WAIT_L
#undef PG8_BAR
#undef PG8_SCHED
}
}
using pg8::Unit;
using pg8::cvt_pk_bf16;

#define EPI_FOR_NP(...) \
    _Pragma("unroll") for (int ai = 0; ai < 2; ++ai) _Pragma("unroll") for (int m = 0; m < 4; ++m) { const int row = u.pm * 256 + ai * 128 + wr * 64 + m * 16 + fr; \
    _Pragma("unroll") for (int bj = 0; bj < 2; ++bj) _Pragma("unroll") for (int n = 0; n < 2; ++n) { const int col = u.pn * 256 + bj * 128 + wc * 32 + n * 16 + 4 * fq; const f32x4 v = acc[ai][bj][m][n]; __VA_ARGS__ } }

typedef const f32x4 (&AccRef)[2][2][4][2];
#define EPI_GRP8(...) \
    _Pragma("unroll") for (int mm = 0; mm < 2; ++mm) _Pragma("unroll") for (int bj = 0; bj < 2; ++bj) _Pragma("unroll") for (int n = 0; n < 2; ++n) { \
        const int idx = mm * 4 + bj * 2 + n; const int row = u.pm * 256 + ai * 128 + wr * 64 + (mp * 2 + mm) * 16 + fr; const int col = u.pn * 256 + bj * 128 + wc * 32 + n * 16 + 4 * fq; \
        const f32x4 v = acc[ai][bj][mp * 2 + mm][n]; (void)idx; (void)row; (void)col; (void)v; __VA_ARGS__ }
#define EPI_GROUPS _Pragma("unroll") for (int ai = 0; ai < 2; ++ai) _Pragma("unroll") for (int mp = 0; mp < 2; ++mp)

struct EpiWin {
    static constexpr bool PERM = false;
    bh* zg; float* zf;
    __device__ __forceinline__ void operator()(AccRef acc, const Unit& u, int wr, int wc, int fr, int fq) const {
        if (u.pn < 24) {
            EPI_FOR_NP({ u32x2 w; w.x = cvt_pk_bf16(fmaxf(sigmoidf_(v[0]), 1e-6f), fmaxf(sigmoidf_(v[1]), 1e-6f)); w.y = cvt_pk_bf16(fmaxf(sigmoidf_(v[2]), 1e-6f), fmaxf(sigmoidf_(v[3]), 1e-6f)); *(u32x2*)(zg + (size_t)row * NGATE + col) = w; })
        } else {
            EPI_FOR_NP({ *(f32x4*)(zf + (size_t)row * ZF_LD + (col - NGATE)) = v; })
        }
    }
};
struct EpiLoraW {
    static constexpr bool PERM = false;
    const float* w0; float* rw;
    __device__ __forceinline__ void operator()(AccRef acc, const Unit& u, int wr, int wc, int fr, int fq) const {
        f32x4 bb[2][2];
#pragma unroll
        for (int bj = 0; bj < 2; ++bj)
#pragma unroll
            for (int n = 0; n < 2; ++n) bb[bj][n] = *(const f32x4*)(w0 + u.pn * 256 + bj * 128 + wc * 32 + n * 16 + 4 * fq);
        __builtin_amdgcn_sched_barrier(0);
        EPI_FOR_NP({ const f32x4 b = bb[bj][n]; f32x4 o;
            _Pragma("unroll") for (int j = 0; j < 4; ++j) { const float x = -(b[j] + v[j]); const float sp = fmaxf(x, 0.f) + log1pf(__expf(-fabsf(x))); o[j] = __expf(-__expf(-sp - 0.5f)); }
            *(f32x4*)(rw + (size_t)row * 512 + col) = o; })
    }
};
struct EpiLoraA {
    static constexpr bool PERM = false;
    const float* a0; const float* ka; const float* rkk; float* rb; float* rk;
    __device__ __forceinline__ void operator()(AccRef acc, const Unit& u, int wr, int wc, int fr, int fq) const {
        f32x4 b0s[2][2], kas[2][2];
#pragma unroll
        for (int bj = 0; bj < 2; ++bj)
#pragma unroll
            for (int n = 0; n < 2; ++n) { const int c0 = u.pn * 256 + bj * 128 + wc * 32 + n * 16 + 4 * fq; b0s[bj][n] = *(const f32x4*)(a0 + c0); kas[bj][n] = *(const f32x4*)(ka + c0); }
#pragma unroll
        for (int ai = 0; ai < 2; ++ai)
#pragma unroll
            for (int m = 0; m < 4; ++m) { const int row = u.pm * 256 + ai * 128 + wr * 64 + m * 16 + fr; f32x4 kkq[4], kq[4];
#pragma unroll
                for (int bj = 0; bj < 2; ++bj)
#pragma unroll
                    for (int n = 0; n < 2; ++n) { const size_t o = (size_t)row * 512 + u.pn * 256 + bj * 128 + wc * 32 + n * 16 + 4 * fq; kkq[bj * 2 + n] = *(const f32x4*)(rkk + o); kq[bj * 2 + n] = *(const f32x4*)(rk + o); }
                __builtin_amdgcn_sched_barrier(0);
#pragma unroll
                for (int bj = 0; bj < 2; ++bj)
#pragma unroll
                    for (int n = 0; n < 2; ++n) { const size_t o = (size_t)row * 512 + u.pn * 256 + bj * 128 + wc * 32 + n * 16 + 4 * fq;
                        const f32x4 v = acc[ai][bj][m][n]; const f32x4 b0 = b0s[bj][n]; const f32x4 kav = kas[bj][n]; const f32x4 kkv = kkq[bj * 2 + n]; f32x4 kv = kq[bj * 2 + n]; f32x4 bo;
                        _Pragma("unroll") for (int j = 0; j < 4; ++j) { const float a = sigmoidf_(b0[j] + v[j]); bo[j] = -(kkv[j] * a); kv[j] = kv[j] * (1.0f + (a - 1.0f) * kav[j]); }
                        *(f32x4*)(rb + o) = bo; *(f32x4*)(rk + o) = kv; }
                __builtin_amdgcn_sched_barrier(0); }
    }
};
struct EpiStoreF32 {
    static constexpr bool PERM = false;
    float* o; int ld;
    __device__ __forceinline__ void operator()(AccRef acc, const Unit& u, int wr, int wc, int fr, int fq) const {
        EPI_FOR_NP({ *(f32x4*)(o + (size_t)row * ld + col) = v; })
    }
};
struct EpiGlu {
    static constexpr bool PERM = false;
    const bh* ys; const float* gb; bh* ycat;
    __device__ __forceinline__ void operator()(AccRef acc, const Unit& u, int wr, int wc, int fr, int fq) const {
        f32x4 gbs[2][2];
#pragma unroll
        for (int bj = 0; bj < 2; ++bj)
#pragma unroll
            for (int n = 0; n < 2; ++n) gbs[bj][n] = *(const f32x4*)(gb + u.pn * 256 + bj * 128 + wc * 32 + n * 16 + 4 * fq);
        EPI_GROUPS { u32x2 yq[8];
            EPI_GRP8({ yq[idx] = *(const u32x2*)(ys + (size_t)row * 512 + col); })
            __builtin_amdgcn_sched_barrier(0);
            EPI_GRP8({ const f32x4 b = gbs[bj][n]; const u32x2 y2 = yq[idx];
                const float y0 = __uint_as_float(y2.x << 16), y1 = __uint_as_float(y2.x & 0xffff0000u), y2f = __uint_as_float(y2.y << 16), y3 = __uint_as_float(y2.y & 0xffff0000u);
                u32x2 w; w.x = cvt_pk_bf16(y0 * sigmoidf_(v[0] + b[0]), y1 * sigmoidf_(v[1] + b[1])); w.y = cvt_pk_bf16(y2f * sigmoidf_(v[2] + b[2]), y3 * sigmoidf_(v[3] + b[3]));
                *(u32x2*)(ycat + (size_t)row * D + 1536 + col) = w; })
            __builtin_amdgcn_sched_barrier(0); }
    }
};
template <int MODE> struct EpiUp {
    static constexpr bool PERM = false;
    const bh* zg; float* mix; bh* mixed;
    __device__ __forceinline__ void operator()(AccRef acc, const Unit& u, int wr, int wc, int fr, int fq) const {
        EPI_FOR_NP({ const u32x2 g2 = *(const u32x2*)(zg + (size_t)row * NGATE + col);
            f32x4 g; g[0] = __uint_as_float(g2.x << 16); g[1] = __uint_as_float(g2.x & 0xffff0000u); g[2] = __uint_as_float(g2.y << 16); g[3] = __uint_as_float(g2.y & 0xffff0000u);
            f32x4 r = g * v; float* mp = mix + (size_t)row * D + col;
            if (MODE >= 1) r += *(const f32x4*)mp;
            if (MODE <= 1) *(f32x4*)mp = r;
            else { u32x2 w; w.x = cvt_pk_bf16(r[0], r[1]); w.y = cvt_pk_bf16(r[2], r[3]); *(u32x2*)(mixed + (size_t)row * D + col) = w; } })
    }
};
struct EpiUpF {
    static constexpr bool PERM = false;
    const bh* zg; bh* mixed;
    __device__ __forceinline__ void operator()(AccRef acc, const Unit& u, int wr, int wc, int fr, int fq) const {
#pragma unroll
        for (int ai = 0; ai < 2; ++ai) { u32x2 gg[16];
#pragma unroll
            for (int m = 0; m < 4; ++m)
#pragma unroll
                for (int bj = 0; bj < 2; ++bj)
#pragma unroll
                    for (int n = 0; n < 2; ++n) gg[m * 4 + bj * 2 + n] = *(const u32x2*)(zg + (size_t)(u.pm * 256 + ai * 128 + wr * 64 + m * 16 + fr) * NGATE + u.pn * 256 + bj * 128 + wc * 32 + n * 16 + 4 * fq);
            __builtin_amdgcn_sched_barrier(0);
#pragma unroll
            for (int m = 0; m < 4; ++m)
#pragma unroll
                for (int bj = 0; bj < 2; ++bj)
#pragma unroll
                    for (int n = 0; n < 2; ++n) { const u32x2 g2 = gg[m * 4 + bj * 2 + n]; const f32x4 v = acc[ai][bj][m][n];
                        u32x2 w; w.x = cvt_pk_bf16(__uint_as_float(g2.x << 16) * v[0], __uint_as_float(g2.x & 0xffff0000u) * v[1]); w.y = cvt_pk_bf16(__uint_as_float(g2.y << 16) * v[2], __uint_as_float(g2.y & 0xffff0000u) * v[3]);
                        *(u32x2*)(mixed + (size_t)(u.pm * 256 + ai * 128 + wr * 64 + m * 16 + fr) * D + u.pn * 256 + bj * 128 + wc * 32 + n * 16 + 4 * fq) = w; }
            __builtin_amdgcn_sched_barrier(0); }
    }
};
struct EpiRes {
    static constexpr bool PERM = false;
    float* h;
    __device__ __forceinline__ void operator()(AccRef acc, const Unit& u, int wr, int wc, int fr, int fq) const {
#pragma unroll
        for (int ai = 0; ai < 2; ++ai)
#pragma unroll
            for (int mp = 0; mp < 2; ++mp) { f32x4 hv[8];
#pragma unroll
                for (int mm = 0; mm < 2; ++mm)
#pragma unroll
                    for (int bj = 0; bj < 2; ++bj)
#pragma unroll
                        for (int n = 0; n < 2; ++n) hv[mm * 4 + bj * 2 + n] = *(const f32x4*)(h + (size_t)(u.pm * 256 + ai * 128 + wr * 64 + (mp * 2 + mm) * 16 + fr) * D + u.pn * 256 + bj * 128 + wc * 32 + n * 16 + 4 * fq);
                __builtin_amdgcn_sched_barrier(0);
#pragma unroll
                for (int mm = 0; mm < 2; ++mm)
#pragma unroll
                    for (int bj = 0; bj < 2; ++bj)
#pragma unroll
                        for (int n = 0; n < 2; ++n) *(f32x4*)(h + (size_t)(u.pm * 256 + ai * 128 + wr * 64 + (mp * 2 + mm) * 16 + fr) * D + u.pn * 256 + bj * 128 + wc * 32 + n * 16 + 4 * fq) = hv[mm * 4 + bj * 2 + n] + acc[ai][bj][mp * 2 + mm][n];
                __builtin_amdgcn_sched_barrier(0); }
    }
};
struct EpiFfn {
    static constexpr bool PERM = true;
    bh* act;
    __device__ __forceinline__ void operator()(AccRef acc, const Unit& u, int wr, int wc, int fr, int fq) const {
#pragma unroll
        for (int ai = 0; ai < 2; ++ai)
#pragma unroll
            for (int m = 0; m < 4; ++m) { const int row = u.pm * 256 + ai * 128 + wr * 64 + m * 16 + fr; const int col = u.pn * 128 + wc * 32 + 8 * fq;
                float o[8];
#pragma unroll
                for (int n = 0; n < 2; ++n)
#pragma unroll
                    for (int j = 0; j < 4; ++j) { const float gte = acc[ai][0][m][n][j], up = acc[ai][1][m][n][j]; o[n * 4 + j] = gte * sigmoidf_(gte) * up; }
                u32x4 w; w.x = cvt_pk_bf16(o[0], o[1]); w.y = cvt_pk_bf16(o[2], o[3]); w.z = cvt_pk_bf16(o[4], o[5]); w.w = cvt_pk_bf16(o[6], o[7]);
                *(u32x4*)(act + (size_t)row * FH + col) = w; }
    }
};
struct EpiPle {
    static constexpr bool PERM = false;
    float* h; const float* tmp;
    __device__ __forceinline__ void operator()(AccRef acc, const Unit& u, int wr, int wc, int fr, int fq) const {
#pragma unroll
        for (int ai = 0; ai < 2; ++ai)
#pragma unroll
            for (int mp = 0; mp < 2; ++mp) { f32x4 hv[8], tv[8];
#pragma unroll
                for (int mm = 0; mm < 2; ++mm)
#pragma unroll
                    for (int bj = 0; bj < 2; ++bj)
#pragma unroll
                        for (int n = 0; n < 2; ++n) { const size_t o = (size_t)(u.pm * 256 + ai * 128 + wr * 64 + (mp * 2 + mm) * 16 + fr) * D + u.pn * 256 + bj * 128 + wc * 32 + n * 16 + 4 * fq;
                            hv[mm * 4 + bj * 2 + n] = *(const f32x4*)(h + o); tv[mm * 4 + bj * 2 + n] = *(const f32x4*)(tmp + o); }
                __builtin_amdgcn_sched_barrier(0);
#pragma unroll
                for (int mm = 0; mm < 2; ++mm)
#pragma unroll
                    for (int bj = 0; bj < 2; ++bj)
#pragma unroll
                        for (int n = 0; n < 2; ++n) { const size_t o = (size_t)(u.pm * 256 + ai * 128 + wr * 64 + (mp * 2 + mm) * 16 + fr) * D + u.pn * 256 + bj * 128 + wc * 32 + n * 16 + 4 * fq;
                            f32x4 r = hv[mm * 4 + bj * 2 + n]; const f32x4 v = acc[ai][bj][mp * 2 + mm][n]; const f32x4 t4 = tv[mm * 4 + bj * 2 + n];
                            _Pragma("unroll") for (int j = 0; j < 4; ++j) r[j] += t4[j] * sigmoidf_(v[j]);
                            *(f32x4*)(h + o) = r; }
                __builtin_amdgcn_sched_barrier(0); }
    }
};

namespace pg8 {
__device__ __forceinline__ void epi_run(const Gemm& g, const f32x4 (&acc)[2][2][4][2], const Unit& u, int wr, int wc, int fr, int fq) {
    unsigned char* ws = P_WS; const int L = g.L;
    switch (g.epi) {
    case 0: { EpiWin E{(bh*)(ws + OFF_ZG), (float*)(ws + OFF_ZF)}; E(acc, u, wr, wc, fr, fq); } break;
    case 1: { EpiLoraW E{P_IN(9) + L * 512, (float*)(ws + OFF_RW)}; E(acc, u, wr, wc, fr, fq); } break;
    case 2: { EpiLoraA E{P_IN(11) + L * 512, P_IN(15) + L * 512, (const float*)(ws + OFF_RKK), (float*)(ws + OFF_RB), (float*)(ws + OFF_RK)}; E(acc, u, wr, wc, fr, fq); } break;
    case 3: { EpiStoreF32 E{(float*)(ws + (g.N == 512 ? OFF_RG : OFF_MIX32)), g.N}; E(acc, u, wr, wc, fr, fq); } break;
    case 4: { EpiGlu E{(const bh*)(ws + OFF_YS), P_IN(28) + L * 512, (bh*)(ws + OFF_YCAT)}; E(acc, u, wr, wc, fr, fq); } break;
    case 5: { EpiUp<0> E{(const bh*)(ws + OFF_ZG), (float*)(ws + OFF_MIX32), (bh*)(ws + OFF_ABF)}; E(acc, u, wr, wc, fr, fq); } break;
    case 6: { EpiUp<1> E{(const bh*)(ws + OFF_ZG) + 2048, (float*)(ws + OFF_MIX32), (bh*)(ws + OFF_ABF)}; E(acc, u, wr, wc, fr, fq); } break;
    case 7: { EpiUp<2> E{(const bh*)(ws + OFF_ZG) + 4096, (float*)(ws + OFF_MIX32), (bh*)(ws + OFF_ABF)}; E(acc, u, wr, wc, fr, fq); } break;
    case 8: { EpiRes E{P_OUT}; E(acc, u, wr, wc, fr, fq); } break;
    case 9: { EpiFfn E{(bh*)(ws + OFF_ACT)}; E(acc, u, wr, wc, fr, fq); } break;
    case 11: { EpiUpF E{(const bh*)(ws + OFF_ZG) + 4096, (bh*)(ws + OFF_ABF)}; E(acc, u, wr, wc, fr, fq); } break;
    default: { EpiPle E{P_OUT, (const float*)(ws + OFF_MIX32)}; E(acc, u, wr, wc, fr, fq); } break;
    }
}
}

__device__ __forceinline__ bool make_gemm(const Params& p, int L, int q, int i, pg8::Gemm& g) {
    unsigned char* ws = P_WS;
    g.M = T; g.perm = 0; g.L = L;
    switch (q) {
    case 1: if (i > 0) return false;
        g.A = (const bh*)(ws + OFF_ABF); g.lda = D; g.Bt = (const bh*)(ws + OFF_WIN); g.ldb = D; g.N = NINP; g.K = D; g.epi = 0; return true;
    case 3: if (i > 2) return false;
        g.lda = 256; g.ldb = 256; g.N = 512; g.K = 256;
        if (i == 0) { g.A = (const bh*)(ws + OFF_LAW); g.Bt = (const bh*)(ws + OFF_WW2); g.epi = 1; }
        else if (i == 1) { g.A = (const bh*)(ws + OFF_LAA); g.Bt = (const bh*)(ws + OFF_WA2); g.epi = 2; }
        else { g.A = (const bh*)(ws + OFF_LAG); g.Bt = (const bh*)(ws + OFF_WG2); g.epi = 3; }
        return true;
    case 5: if (i > 0) return false;
        g.A = (const bh*)(ws + OFF_YS); g.lda = 512; g.Bt = (const bh*)(ws + OFF_WGLU); g.ldb = 512; g.N = 512; g.K = 512; g.epi = 4; return true;
    case 6: if (i > 0) return false;
        g.A = (const bh*)(ws + OFF_YCAT); g.lda = D; g.Bt = (const bh*)(ws + OFF_WUP); g.ldb = D; g.N = D; g.K = D; g.epi = 11; return true;
    case 7: if (i > 0) return false;
        g.A = (const bh*)(ws + OFF_ABF); g.lda = D; g.Bt = (const bh*)(ws + OFF_WO); g.ldb = D; g.N = D; g.K = D; g.epi = 8; return true;
    case 9: if (i > 0) return false;
        g.A = (const bh*)(ws + OFF_ABF); g.lda = D; g.Bt = (const bh*)(ws + OFF_WGU); g.ldb = D; g.N = 2 * FH; g.K = D; g.epi = 9; g.perm = 1; return true;
    case 10: if (i > 0) return false;
        g.A = (const bh*)(ws + OFF_ACT); g.lda = FH; g.Bt = (const bh*)(ws + OFF_WD); g.ldb = FH; g.N = D; g.K = FH; g.epi = 8; return true;
    case 12: if (i > 1) return false;
        if (i == 0) { g.A = (const bh*)(ws + OFF_PBF) + (size_t)L * T * 256; g.lda = 256; g.Bt = (const bh*)(ws + OFF_WPP); g.ldb = 256; g.N = D; g.K = 256; g.epi = 3; }
        else { g.A = (const bh*)(ws + OFF_ABF); g.lda = D; g.Bt = (const bh*)(ws + OFF_WPG); g.ldb = D; g.N = D; g.K = D; g.epi = 10; }
        return true;
    default: return false;
    }
}

struct CJ { const float* src; int in_idx, src_ld, kv, n0, nv; long lstride; size_t dst; int dst_ld, r0, c0, npad, kpad, seg, segstride; };
constexpr int BIGSEG = 1 << 30;
__constant__ int JT_I[15][12] = {
    {3, NIN, 2048, NF, NGATE, D, 0, 0, NGATE, 2048, BIGSEG, 0},
    {3, NIN, 2048, 0, NF, D, NGATE, 0, 6656, 2048, BIGSEG, 0},
    {29, D, 1024, 0, D, D, 0, 0, D, 1024, BIGSEG, 0},
    {30, D, 512, 0, D, D, 0, 1024, D, 512, BIGSEG, 0},
    {31, D, 512, 0, D, D, 0, 1536, D, 512, BIGSEG, 0},
    {32, D, 2048, 0, D, D, 0, 0, D, 2048, BIGSEG, 0},
    {34, FH, 2048, 0, FH, D, 0, 0, FH, 2048, 128, 256},
    {35, FH, 2048, 0, FH, D, 128, 0, FH, 2048, 128, 256},
    {36, D, FH, 0, D, FH, 0, 0, D, FH, BIGSEG, 0},
    {38, D, 2048, 0, D, D, 0, 0, D, 2048, BIGSEG, 0},
    {39, D, 256, 0, D, 256, 0, 0, D, 256, BIGSEG, 0},
    {27, 512, 512, 0, 512, 512, 0, 0, 512, 512, BIGSEG, 0},
    {10, 512, 96, 0, 512, 256, 0, 0, 512, 256, BIGSEG, 0},
    {12, 512, 96, 0, 512, 256, 0, 0, 512, 256, BIGSEG, 0},
    {13, 512, 256, 0, 512, 256, 0, 0, 512, 256, BIGSEG, 0}};
__constant__ long JT_L[15][2] = {
    {(long)D * NIN, (long)OFF_WIN}, {(long)D * NIN, (long)OFF_WIN}, {(long)1024 * D, (long)OFF_WUP}, {(long)512 * D, (long)OFF_WUP}, {(long)512 * D, (long)OFF_WUP},
    {(long)D * D, (long)OFF_WO}, {(long)D * FH, (long)OFF_WGU}, {(long)D * FH, (long)OFF_WGU}, {(long)FH * D, (long)OFF_WD}, {(long)D * D, (long)OFF_WPG},
    {(long)256 * D, (long)OFF_WPP}, {(long)512 * 512, (long)OFF_WGLU}, {(long)96 * 512, (long)OFF_WW2}, {(long)96 * 512, (long)OFF_WA2}, {(long)256 * 512, (long)OFF_WG2}};
__device__ __forceinline__ void get_job(int j, CJ& J) {
    J.in_idx = JT_I[j][0]; J.src_ld = JT_I[j][1]; J.kv = JT_I[j][2]; J.n0 = JT_I[j][3]; J.nv = JT_I[j][4]; J.dst_ld = JT_I[j][5]; J.r0 = JT_I[j][6]; J.c0 = JT_I[j][7];
    J.npad = JT_I[j][8]; J.kpad = JT_I[j][9]; J.seg = JT_I[j][10]; J.segstride = JT_I[j][11]; J.lstride = JT_L[j][0]; J.dst = (size_t)JT_L[j][1];
}
__device__ __forceinline__ const float* in_by_idx(const Params& p, int i) { return P_IN(i); }
constexpr int NJOBS = 15;

__device__ __forceinline__ void conv_load(int L, const CJ& J, int tile, int lane, f32x4 (&v)[16]) {
    const int nkt = J.kpad / 64; const int tn = tile / nkt, tk = tile % nkt;
    const float* src = J.src + (size_t)L * J.lstride;
    const int cq = lane & 15, r = lane >> 4;
    const int nl = tn * 64 + cq * 4; const bool nok = nl < J.nv;
    const int k0 = tk * 64 + 16 * r;
    const float* sp = src + (size_t)k0 * J.src_ld + J.n0 + nl;
    const float zc = OZ();
#pragma unroll
    for (int i = 0; i < 16; ++i) { v[i] = (f32x4){zc, zc, zc, zc}; if (nok && (k0 + i) < J.kv) v[i] = *(const f32x4*)(sp + (size_t)i * J.src_ld); }
}
__device__ __forceinline__ void conv_store(const CJ& J, int tile, int lane, const f32x4 (&v)[16], bh* dstbase) {
    const int nkt = J.kpad / 64; const int tn = tile / nkt, tk = tile % nkt;
    const int cq = lane & 15, r = lane >> 4;
    const int nl = tn * 64 + cq * 4; const int k0 = tk * 64 + 16 * r;
#pragma unroll
    for (int j = 0; j < 4; ++j) { const int n = nl + j; const int drow = J.r0 + (n / J.seg) * J.segstride + (n % J.seg);
        u32x4 w0, w1;
        w0.x = cvt_pk_bf16(v[0][j], v[1][j]); w0.y = cvt_pk_bf16(v[2][j], v[3][j]); w0.z = cvt_pk_bf16(v[4][j], v[5][j]); w0.w = cvt_pk_bf16(v[6][j], v[7][j]);
        w1.x = cvt_pk_bf16(v[8][j], v[9][j]); w1.y = cvt_pk_bf16(v[10][j], v[11][j]); w1.z = cvt_pk_bf16(v[12][j], v[13][j]); w1.w = cvt_pk_bf16(v[14][j], v[15][j]);
        bh* d = dstbase + (size_t)drow * J.dst_ld + J.c0 + k0;
        *(u32x4*)d = w0; *(u32x4*)(d + 8) = w1; }
}
__device__ __forceinline__ void conv_tiles(int L, const CJ& J, int first, int ntile, int stride, int lane, bh* dstbase) {
    for (int t = first; t < ntile; t += 2 * stride) {
        f32x4 va[16], vb[16]; const bool hasb = (t + stride) < ntile;
        conv_load(L, J, t, lane, va);
        if (hasb) conv_load(L, J, t + stride, lane, vb);
        __builtin_amdgcn_sched_barrier(0);
        conv_store(J, t, lane, va, dstbase);
        if (hasb) conv_store(J, t + stride, lane, vb, dstbase);
    }
}

__device__ __forceinline__ void rms_row_bf16(const float* x, const float* g, bh* o, int lane) {
    f32x4 v[8]; float s = 0.f;
#pragma unroll
    for (int j = 0; j < 8; ++j) { v[j] = *(const f32x4*)(x + j * 256 + lane * 4); s += (v[j][0] * v[j][0] + v[j][1] * v[j][1]) + (v[j][2] * v[j][2] + v[j][3] * v[j][3]); }
    const float rstd = rsqrtf(wave_sum(s) * (1.0f / D) + 1e-6f);
#pragma unroll
    for (int j = 0; j < 8; ++j) { const f32x4 gg = *(const f32x4*)(g + j * 256 + lane * 4); u32x2 w; w.x = pk2(v[j][0] * rstd * gg[0], v[j][1] * rstd * gg[1]); w.y = pk2(v[j][2] * rstd * gg[2], v[j][3] * rstd * gg[3]);
        *(u32x2*)(o + j * 256 + lane * 4) = w; }
}
__device__ __forceinline__ void phase_rmsnorm(const Params& p, const float* g) {
    const int gw = BIDX() * 8 + (TIDX() >> 6), NGW = GDIM() * 8, lane = TIDX() & 63;
    bh* abf = (bh*)(P_WS + OFF_ABF);
    f32x4 gg[8];
#pragma unroll
    for (int j = 0; j < 8; ++j) gg[j] = *(const f32x4*)(g + j * 256 + lane * 4);
    for (int r = gw; r < T; r += 2 * NGW) {
        const int r2 = r + NGW; const bool has2 = r2 < T;
        f32x4 va[8], vb[8]; float sa = 0.f, sb = 0.f;
#pragma unroll
        for (int j = 0; j < 8; ++j) { va[j] = *(const f32x4*)(P_OUT + (size_t)r * D + j * 256 + lane * 4); vb[j] = has2 ? *(const f32x4*)(P_OUT + (size_t)r2 * D + j * 256 + lane * 4) : va[j]; }
        __builtin_amdgcn_sched_barrier(0);
#pragma unroll
        for (int j = 0; j < 8; ++j) { sa += (va[j][0] * va[j][0] + va[j][1] * va[j][1]) + (va[j][2] * va[j][2] + va[j][3] * va[j][3]); sb += (vb[j][0] * vb[j][0] + vb[j][1] * vb[j][1]) + (vb[j][2] * vb[j][2] + vb[j][3] * vb[j][3]); }
        const float ra = rsqrtf(wave_sum(sa) * (1.0f / D) + 1e-6f), rb = rsqrtf(wave_sum(sb) * (1.0f / D) + 1e-6f);
#pragma unroll
        for (int j = 0; j < 8; ++j) { u32x2 w; w.x = pk2(va[j][0] * ra * gg[j][0], va[j][1] * ra * gg[j][1]); w.y = pk2(va[j][2] * ra * gg[j][2], va[j][3] * ra * gg[j][3]);
            *(u32x2*)(abf + (size_t)r * D + j * 256 + lane * 4) = w; }
        if (has2) {
#pragma unroll
            for (int j = 0; j < 8; ++j) { u32x2 w; w.x = pk2(vb[j][0] * rb * gg[j][0], vb[j][1] * rb * gg[j][1]); w.y = pk2(vb[j][2] * rb * gg[j][2], vb[j][3] * rb * gg[j][3]);
                *(u32x2*)(abf + (size_t)r2 * D + j * 256 + lane * 4) = w; } }
    }
}

__device__ __forceinline__ void phase_conv(const Params& p, int L, LAS unsigned char* lds) {
    const int tid = TIDX();
    {   const int gw0 = BIDX() * 8 + (tid >> 6), NGW0 = GDIM() * 8, ln = tid & 63;
        int base = 0;
        for (int j = 0; j < NJOBS; ++j) { CJ J; get_job(j, J); J.src = in_by_idx(p, J.in_idx); const int ntile = (J.npad / 64) * (J.kpad / 64);
            int first = gw0 - (base % NGW0); if (first < 0) first += NGW0;
            bh* dstbase = (bh*)(P_WS + J.dst);
            conv_tiles(L, J, first, ntile, NGW0, ln, dstbase);
            base += ntile; } }
    const int gw = BIDX() * 8 + (tid >> 6), NGW = GDIM() * 8, lane = tid & 63;
    bh* abf = (bh*)(P_WS + OFF_ABF);
    if (L == 0) {
        const float* ps = P_IN(1); bh* pb = (bh*)(P_WS + OFF_PBF);
        for (size_t i = (size_t)BIDX() * 512 + tid; i < (size_t)2 * T * 256 / 4; i += (size_t)GDIM() * 512) { const f32x4 v = ((const f32x4*)ps)[i]; u32x2 w; w.x = pk2(v[0], v[1]); w.y = pk2(v[2], v[3]); ((u32x2*)pb)[i] = w; }
        const float* x = P_IN(0);
        for (int r = gw; r < T; r += NGW) {
#pragma unroll
            for (int j = 0; j < 8; ++j) *(f32x4*)(P_OUT + (size_t)r * D + j * 256 + lane * 4) = *(const f32x4*)(x + (size_t)r * D + j * 256 + lane * 4);
            rms_row_bf16(x + (size_t)r * D, P_IN(2), abf + (size_t)r * D, lane);
        }
    } else {
        for (int r = gw; r < T; r += NGW) rms_row_bf16(P_OUT + (size_t)r * D, P_IN(2) + (size_t)L * D, abf + (size_t)r * D, lane);
    }
}

struct S5C { float ar, ai; float br[16], bi[16]; };
__device__ __forceinline__ void s5_setup(const Params& p, int L, int g, int n, S5C& c) {
    const int gi = L * 32 + g;
    const float dt = __expf(P_IN(21)[gi]);
    const float are = P_IN(19)[gi * 64 + n], aim = P_IN(20)[gi * 64 + n];
    const float mag = __expf(are * dt), ang = aim * dt;
    float sn, cs;
    {
        const double a = (double)ang; const double k = rint(a * 0.15915494309189535); const float r = (float)(a - k * 6.283185307179586);
        sn = sinf(r); cs = cosf(r);
    }
    c.ar = mag * cs; c.ai = mag * sn;
    const float den = are * are + aim * aim, nr = c.ar - 1.0f, ni = c.ai;
    const float cr = (nr * are + ni * aim) / den, ci = (ni * are - nr * aim) / den;
    const float* bre = P_IN(22) + ((size_t)gi * 64 + n) * 16; const float* bim = P_IN(23) + ((size_t)gi * 64 + n) * 16;
#pragma unroll
    for (int q = 0; q < 4; ++q) { const f32x4 r4 = *(const f32x4*)(bre + q * 4), i4 = *(const f32x4*)(bim + q * 4);
#pragma unroll
        for (int j = 0; j < 4; ++j) { c.br[q * 4 + j] = cr * r4[j] - ci * i4[j]; c.bi[q * 4 + j] = cr * i4[j] + ci * r4[j]; } }
}
__device__ __forceinline__ void s5_step(const S5C& c, const LAS float* urow, float& sr, float& si) {
    float xr = 0.f, xi = 0.f;
#pragma unroll
    for (int q = 0; q < 4; ++q) { const f32x4 u4 = *(const LAS f32x4*)(urow + q * 4);
#pragma unroll
        for (int j = 0; j < 4; ++j) { xr = fmaf(u4[j], c.br[q * 4 + j], xr); xi = fmaf(u4[j], c.bi[q * 4 + j], xi); } }
    const float nr = c.ar * sr - c.ai * si + xr, ni = c.ar * si + c.ai * sr + xi;
    sr = nr; si = ni;
}
__device__ __forceinline__ void s5_stage_u(const float* zfc, LAS float* ul, int lane) {
    const float* src = zfc + (size_t)lane * ZF_LD;
    const f32x4 a = *(const f32x4*)src, b = *(const f32x4*)(src + 4), c = *(const f32x4*)(src + 8), d = *(const f32x4*)(src + 12);
    *(LAS f32x4*)(ul + lane * 16) = a; *(LAS f32x4*)(ul + lane * 16 + 4) = b; *(LAS f32x4*)(ul + lane * 16 + 8) = c; *(LAS f32x4*)(ul + lane * 16 + 12) = d;
    asm volatile("s_waitcnt lgkmcnt(0)" ::: "memory"); __builtin_amdgcn_wave_barrier();
}

__device__ __forceinline__ size_t fq_base(int h, int c, int mt, int ks8) { return ((((size_t)(h * NCH + c) * 4 + mt) * 8 + ks8) * 64) * 8; }
__device__ __forceinline__ size_t fq_off(int h, int t, int d) { const int s = t & 63; return fq_base(h, t >> 6, s >> 4, d >> 5) + ((s & 15) + 16 * ((d >> 3) & 3)) * 8 + (d & 7); }
__device__ __forceinline__ int ft_off(int row, int s8) { return ((((row >> 5) * 4 + (s8 >> 1)) * 64) + (row & 31) + 32 * (s8 & 1)) * 8; }

__device__ __forceinline__ void mlstm_prep(const Params& p, int L, int h, int c, LAS unsigned char* lds) {
    const int tid = TIDX(), t0 = c * 64;
    const float* zf = (const float*)(P_WS + OFF_ZF);
    LAS float* s_ws = (LAS float*)lds;
    if (tid < 64) {
        const int t = t0 + tid;
        float ig = zf[(size_t)t * ZF_LD + 4096 + h] + P_IN(5)[L * 4 + h];
        float fg = zf[(size_t)t * ZF_LD + 4100 + h] + P_IN(6)[L * 4 + h];
        ig = 15.0f * tanhf(ig * (1.0f / 15.0f)); fg = 15.0f * tanhf(fg * (1.0f / 15.0f));
        const float lf = fminf(fg, 0.f) - log1pf(__expf(-fabsf(fg)));
        float b = lf;
#pragma unroll
        for (int o = 1; o < 64; o <<= 1) { const float nb = bperm_f((tid - o) & 63, b); if (tid >= o) b += nb; }
        const float bend = bperm_f(63, b);
        const float wlog = bend - b + ig;
        const float mloc = wave_max(wlog);
        s_ws[tid] = __expf(wlog - mloc);
        ((float*)(P_WS + OFF_MI))[h * T + t] = ig; ((float*)(P_WS + OFF_MBB))[h * T + t] = b;
        if (tid == 0) { ((float*)(P_WS + OFF_MBEND))[h * NCH + c] = bend; ((float*)(P_WS + OFF_MLOC))[h * NCH + c] = mloc; }
    }
    __syncthreads();
    const int d = tid & 255, isk = tid >> 8;
    const int col = isk * 1024 + h * 256 + d;
    const float* cw = P_IN(4) + (size_t)L * 4 * 2048;
    const float w0 = cw[col], w1 = cw[2048 + col], w2 = cw[4096 + col], w3 = cw[6144 + col];
    float x1 = (t0 >= 1) ? zf[(size_t)(t0 - 1) * ZF_LD + col] : 0.f, x2 = (t0 >= 2) ? zf[(size_t)(t0 - 2) * ZF_LD + col] : 0.f, x3 = (t0 >= 3) ? zf[(size_t)(t0 - 3) * ZF_LD + col] : 0.f;
    bh* MQ = (bh*)(P_WS + OFF_MQ); bh* MK = (bh*)(P_WS + OFF_MK);
    bh* MT = (bh*)(P_WS + (isk ? OFF_MKT : OFF_MVT)) + (size_t)(h * NCH + c) * 16384;
    LAS bh* sQK = (LAS bh*)(lds + 1024);
    float dnacc = 0.f;
    for (int hf = 0; hf < 2; ++hf) {
        float xs[32], vs[32];
#pragma unroll
        for (int j = 0; j < 32; ++j) { const int t = t0 + hf * 32 + j; xs[j] = zf[(size_t)t * ZF_LD + col]; vs[j] = isk ? 0.f : zf[(size_t)t * ZF_LD + 2048 + h * 256 + d]; }
        __builtin_amdgcn_sched_barrier(0);
#pragma unroll
        for (int s8l = 0; s8l < 4; ++s8l) { const int s8 = hf * 4 + s8l;
            unsigned pk[4];
#pragma unroll
            for (int j = 0; j < 8; ++j) { const int s = s8 * 8 + j;
                const float x0 = xs[s8l * 8 + j]; float y = w0 * x0 + w1 * x1 + w2 * x2 + w3 * x3; x3 = x2; x2 = x1; x1 = x0;
                y = y * sigmoidf_(y);
                unsigned short e;
                if (!isk) { sQK[s * 264 + d] = f2bf(y * 0.0625f); e = f2bf(vs[s8l * 8 + j]); }
                else { sQK[64 * 264 + s * 264 + d] = f2bf(y); const float wk = y * s_ws[s]; e = f2bf(wk); dnacc += wk; }
                if (j & 1) pk[j >> 1] |= ((unsigned)e << 16); else pk[j >> 1] = e; }
            u32x4 w; w.x = pk[0]; w.y = pk[1]; w.z = pk[2]; w.w = pk[3];
            *(u32x4*)(MT + ft_off(d, s8)) = w; }
    }
    if (isk) ((float*)(P_WS + OFF_DN))[(size_t)(h * NCH + c) * 256 + d] = dnacc;
    __syncthreads();
#pragma unroll
    for (int i = 0; i < 8; ++i) { const int pid = i * 512 + tid, tens = pid >> 11, rem = pid & 2047, mt = rem >> 9, ks8 = (rem >> 6) & 7, lp = rem & 63;
        const u32x4 w = *(const LAS u32x4*)(sQK + tens * (64 * 264) + (mt * 16 + (lp & 15)) * 264 + ks8 * 32 + (lp >> 4) * 8);
        *(u32x4*)((tens ? MK : MQ) + fq_base(h, c, mt, ks8) + lp * 8) = w; }
    __syncthreads();
}

__device__ __forceinline__ void rwkv_prep_token(const Params& p, int L, int t, int lane) {
    const float* zf = (const float*)(P_WS + OFF_ZF);
    const float* z = zf + (size_t)t * ZF_LD + ZR0; const float* zp = z - ZF_LD; const bool hp = t > 0;
    const float* mu = P_IN(8) + (size_t)L * 1984;
    float* RR = (float*)(P_WS + OFF_RR); float* RK = (float*)(P_WS + OFF_RK); float* RV = (float*)(P_WS + OFF_RV); float* RKK = (float*)(P_WS + OFF_RKK);
    const float* kkw = P_IN(14) + L * 512;
    float sr[8], sk[8], sv[8], kw[8], lw[2], la[2], lg[4];
#pragma unroll
    for (int i = 0; i < 8; ++i) { const int c = i * 64 + lane;
        { const float a = z[c], b = hp ? zp[c] : 0.f; sr[i] = a + (b - a) * mu[c]; }
        { const float a = z[512 + c], b = hp ? zp[512 + c] : 0.f; sk[i] = a + (b - a) * mu[512 + c]; }
        { const float a = z[1024 + c], b = hp ? zp[1024 + c] : 0.f; sv[i] = a + (b - a) * mu[1024 + c]; }
        kw[i] = kkw[c]; }
#pragma unroll
    for (int i = 0; i < 2; ++i) { const int j = i * 64 + lane; lw[i] = 0.f; la[i] = 0.f;
        if (j < 96) { { const int c = 1536 + j; const float a = z[c], b = hp ? zp[c] : 0.f; lw[i] = a + (b - a) * mu[c]; }
                      { const int c = 1632 + j; const float a = z[c], b = hp ? zp[c] : 0.f; la[i] = a + (b - a) * mu[c]; } } }
#pragma unroll
    for (int i = 0; i < 4; ++i) { const int c = 1728 + i * 64 + lane; const float a = z[c], b = hp ? zp[c] : 0.f; lg[i] = a + (b - a) * mu[c]; }
    __builtin_amdgcn_sched_barrier(0);
#pragma unroll
    for (int i = 0; i < 8; ++i) { const int c = i * 64 + lane;
        RR[(size_t)t * 512 + c] = sr[i]; RV[(size_t)t * 512 + c] = sv[i]; RK[(size_t)t * 512 + c] = sk[i];
        const float kkv = sk[i] * kw[i]; const float ss = wave_sum(kkv * kkv); RKK[(size_t)t * 512 + c] = kkv / fmaxf(sqrtf(ss), 1e-12f); }
    bh* LAW = (bh*)(P_WS + OFF_LAW) + (size_t)t * 256; bh* LAA = (bh*)(P_WS + OFF_LAA) + (size_t)t * 256; bh* LAG = (bh*)(P_WS + OFF_LAG) + (size_t)t * 256;
#pragma unroll
    for (int i = 0; i < 4; ++i) { const int j = i * 64 + lane;
        float vw = 0.f, va = 0.f;
        if (i < 2 && j < 96) { vw = tanhf(lw[i < 2 ? i : 0]); va = la[i < 2 ? i : 0]; }
        LAW[j] = f2bf(vw); LAA[j] = f2bf(va); LAG[j] = f2bf(sigmoidf_(lg[i])); }
}

__device__ __forceinline__ void s5_pass_a(const Params& p, int L, int g, int c, int lane, LAS float* ul) {
    const float* zf = (const float*)(P_WS + OFF_ZF) + (size_t)(c * 64) * ZF_LD + ZS0 + g * 16;
    s5_stage_u(zf, ul, lane);
    S5C k; s5_setup(p, L, g, lane, k);
    float sr = 0.f, si = 0.f;
#pragma unroll 8
    for (int s = 0; s < 64; ++s) s5_step(k, ul + s * 16, sr, si);
    asm volatile("s_waitcnt lgkmcnt(0)" ::: "memory"); __builtin_amdgcn_wave_barrier();
    float* se = (float*)(P_WS + OFF_SEND) + ((size_t)(g * NCH + c) * 64 + lane) * 2;
    se[0] = sr; se[1] = si;
}

__device__ __forceinline__ void phase_prep(const Params& p, int L, LAS unsigned char* lds) {
    const int wid = TIDX() >> 6, lane = TIDX() & 63;
    for (int it = BIDX(); it < 2048; it += GDIM()) {
        if (it < 512) mlstm_prep(p, L, it >> 7, it & 127, lds);
        else if (it < 1536) rwkv_prep_token(p, L, (it - 512) * 8 + wid, lane);
        else { const int w = (it - 1536) * 8 + wid; s5_pass_a(p, L, w >> 7, w & 127, lane, (LAS float*)lds + wid * 1024); }
    }
}

constexpr int RW_NS = 4, RW_LS = T / RW_NS, RW_NB = RW_LS / 16, RW_RING = 4, RW_SLOT = 16 * 384;
constexpr int RW_YOFF = RW_RING * RW_SLOT;
__device__ __forceinline__ void rwkv_scan(const Params& p, int b, LAS unsigned char* lds) {
    const int tid = TIDX(), wid = __builtin_amdgcn_readfirstlane(tid >> 6), lane = tid & 63;
    int j, h, rg;
    if (b < 32) { j = 0; h = b >> 2; rg = b & 3; } else { const int u = b - 32; j = 1 + (u >> 6); h = (u & 63) >> 3; rg = u & 7; }
    LAS float* ring = (LAS float*)lds;
    LAS float* ybuf = ring + RW_YOFF;
    const int tbase = j * RW_LS;
    const bool isP = rg >= 4;
    if (wid >= 4) {
        const int lw = wid - 4, lt = tid - 256;
        const float* gp[6]; unsigned lo[6];
#pragma unroll
        for (int i = 0; i < 6; ++i) { const int ii = lw * 6 + i, rowidx = ii * 4 + (lane >> 4), step = rowidx / 6, a = rowidx % 6, q = lane & 15;
            const int ai = (0x205314 >> (4 * a)) & 0xf;
            gp[i] = (const float*)(P_WS + OFF_RR + (size_t)ai * SZ_R) + (size_t)(tbase + step) * 512 + h * 64 + q * 4;
            lo[i] = (unsigned)ii * 256u; }
        float* OUT = (float*)(P_WS + (isP ? OFF_RZ : OFF_RY)) + (size_t)(tbase + (lt >> 4)) * 512 + h * 64 + (rg & 3) * 16 + (lt & 15);
#define RW_ISSUE(bi, sl) do { _Pragma("unroll") for (int _i = 0; _i < 6; ++_i) \
        __builtin_amdgcn_global_load_lds((const unsigned*)(gp[_i] + (size_t)(bi) * 16 * 512), (LAS unsigned*)(ring + (sl) * RW_SLOT + lo[_i]), 16, 0, 0); } while (0)
        RW_ISSUE(0, 0); RW_ISSUE(1, 1); RW_ISSUE(2, 2);
        asm volatile("s_waitcnt vmcnt(12)" ::: "memory"); __builtin_amdgcn_s_barrier();
        int sl = 3;
        for (int ib = 0; ib < RW_NB; ++ib) {
            if (ib + 3 < RW_NB) RW_ISSUE(ib + 3, sl);
            sl = (sl == RW_RING - 1) ? 0 : sl + 1;
            if (ib > 0) {
                const LAS float* yb = ybuf + ((ib - 1) & 1) * 4096 + lt * 16;
                const f32x4 a0 = *(const LAS f32x4*)yb, a1 = *(const LAS f32x4*)(yb + 4), a2 = *(const LAS f32x4*)(yb + 8), a3 = *(const LAS f32x4*)(yb + 12);
                const f32x4 sm = (a0 + a1) + (a2 + a3);
                OUT[(size_t)(ib - 1) * 16 * 512] = (sm[0] + sm[1]) + (sm[2] + sm[3]);
            }
            if (ib + 3 < RW_NB) asm volatile("s_waitcnt vmcnt(13)" ::: "memory");
            else asm volatile("s_waitcnt vmcnt(0)" ::: "memory");
            __builtin_amdgcn_s_barrier();
        }
        {   const LAS float* yb = ybuf + ((RW_NB - 1) & 1) * 4096 + lt * 16;
            const f32x4 a0 = *(const LAS f32x4*)yb, a1 = *(const LAS f32x4*)(yb + 4), a2 = *(const LAS f32x4*)(yb + 8), a3 = *(const LAS f32x4*)(yb + 12);
            const f32x4 sm = (a0 + a1) + (a2 + a3);
            OUT[(size_t)(RW_NB - 1) * 16 * 512] = (sm[0] + sm[1]) + (sm[2] + sm[3]); }
#undef RW_ISSUE
    } else {
        const int r16 = wid * 4 + (lane >> 4), kq = lane & 15, row = (rg & 3) * 16 + r16;
        f32x4 S;
#pragma unroll
        for (int e = 0; e < 4; ++e) S[e] = (isP && (kq * 4 + e == row)) ? 1.f : 0.f;
        const float vmask = isP ? 0.f : 1.f;
        __builtin_amdgcn_s_barrier();
        int sl = 0;
        for (int ib = 0; ib < RW_NB; ++ib) {
            const LAS float* bb = ring + sl * RW_SLOT;
            LAS float* yw = ybuf + (ib & 1) * 4096 + r16 * 16 + kq;
            f32x4 w4 = *(const LAS f32x4*)(bb + kq * 4), k4 = *(const LAS f32x4*)(bb + 64 + kq * 4), kk4 = *(const LAS f32x4*)(bb + 128 + kq * 4),
                  b4 = *(const LAS f32x4*)(bb + 192 + kq * 4), r4 = *(const LAS f32x4*)(bb + 256 + kq * 4);
            float vv = bb[320 + row];
#pragma unroll
            for (int s = 0; s < 16; ++s) {
                f32x4 w4n, k4n, kk4n, b4n, r4n; float vvn;
                if (s < 15) { const LAS float* q = bb + (s + 1) * 384;
                    w4n = *(const LAS f32x4*)(q + kq * 4); k4n = *(const LAS f32x4*)(q + 64 + kq * 4); kk4n = *(const LAS f32x4*)(q + 128 + kq * 4);
                    b4n = *(const LAS f32x4*)(q + 192 + kq * 4); r4n = *(const LAS f32x4*)(q + 256 + kq * 4); vvn = q[320 + row]; }
                __builtin_amdgcn_sched_barrier(0);
                float pd = fmaf(S[0], kk4[0], fmaf(S[1], kk4[1], fmaf(S[2], kk4[2], S[3] * kk4[3])));
                const f32x4 pre = S * w4 + (vv * vmask) * k4;
                pd = allreduce16(pd);
                S = pre + pd * b4;
                yw[s * 256] = fmaf(S[0], r4[0], fmaf(S[1], r4[1], fmaf(S[2], r4[2], S[3] * r4[3])));
                if (s < 15) { w4 = w4n; k4 = k4n; kk4 = kk4n; b4 = b4n; r4 = r4n; vv = vvn; }
            }
            sl = (sl == RW_RING - 1) ? 0 : sl + 1;
            asm volatile("s_waitcnt lgkmcnt(0)" ::: "memory");
            __builtin_amdgcn_s_barrier();
        }
        float* EN = (float*)(P_WS + (isP ? OFF_RPEND : OFF_RSEND)) + ((size_t)(h * 4 + j) * 64 + row) * 64 + kq * 4;
        *(f32x4*)EN = S;
    }
    __syncthreads();
}

struct MStage { bf16x8 q[4], k[4], v[4]; float bend, mloc; };
__device__ __forceinline__ void mstage_load(MStage& st, const bh* qp, const bh* kp, const bh* vp, const float* MBEND, const float* MLOC, int h, int c) {
#pragma unroll
    for (int ks = 0; ks < 4; ++ks) { st.q[ks] = *(const bf16x8*)(qp + (size_t)c * 16384 + ks * 512); st.k[ks] = *(const bf16x8*)(kp + (size_t)c * 16384 + ks * 512); st.v[ks] = *(const bf16x8*)(vp + (size_t)c * 16384 + ks * 512); }
    st.bend = MBEND[h * NCH + c]; st.mloc = MLOC[h * NCH + c];
}
__device__ __forceinline__ void mlstm_seq(const Params& p, int mb, LAS unsigned char* lds) {
    const int tid = TIDX(), wid = tid >> 6, lane = tid & 63;
    const int h = mb >> 3, jv = mb & 7;
    LAS bh* Cbf = (LAS bh*)lds;
    constexpr int CS = 264;
    for (int i = tid; i < 2 * 32 * CS / 2; i += 512) ((LAS unsigned*)Cbf)[i] = 0u;
    __syncthreads();
    const bh* MQ = (const bh*)(P_WS + OFF_MQ); const bh* MKT = (const bh*)(P_WS + OFF_MKT); const bh* MVT = (const bh*)(P_WS + OFF_MVT);
    const float* MBEND = (const float*)(P_WS + OFF_MBEND); const float* MLOC = (const float*)(P_WS + OFF_MLOC);
    f32x16 ct;
    { const float z = OZ();
#pragma unroll
    for (int i = 0; i < 16; ++i) ct[i] = z; }
    float m = 0.f;
    const int mt = wid >> 1, kh = wid & 1;
    float* MINTER = (float*)(P_WS + OFF_ABF);
    LAS float* It = (LAS float*)(lds + 2 * 32 * 264 * 2);
    const bh* qp = MQ + fq_base(h, 0, mt, kh * 4) + lane * 8;
    const bh* kp = MKT + (size_t)(h * NCH) * 16384 + (wid * 4 * 64 + lane) * 8;
    const bh* vp = MVT + (size_t)(h * NCH) * 16384 + (jv * 4 * 64 + lane) * 8;
    MStage s0, s1, s2;
    mstage_load(s0, qp, kp, vp, MBEND, MLOC, h, 0);
    mstage_load(s1, qp, kp, vp, MBEND, MLOC, h, 1);
#define MSTEP(SC, SL, CIDX) do { const int c = (CIDX); const int t0 = c * 64, cur = c & 1; \
        mstage_load(SL, qp, kp, vp, MBEND, MLOC, h, (c + 2 < NCH) ? c + 2 : NCH - 1); \
        const float mnew = fmaxf(SC.bend + m, SC.mloc), decay = __expf(SC.bend + m - mnew), scale = __expf(SC.mloc - mnew); \
        f32x4 r0 = {0.f, 0.f, 0.f, 0.f}, r1 = {0.f, 0.f, 0.f, 0.f}; \
        const LAS bh* cb = Cbf + cur * 32 * CS + (lane & 15) * CS + kh * 128 + (lane >> 4) * 8; \
        _Pragma("unroll") for (int ks = 0; ks < 4; ++ks) { const bf16x8 b0 = *(const LAS bf16x8*)(cb + ks * 32), b1 = *(const LAS bf16x8*)(cb + 16 * CS + ks * 32); r0 = MFMA16(SC.q[ks], b0, r0); r1 = MFMA16(SC.q[ks], b1, r1); } \
        {     \
            if (c > 0) { const LAS float* ip = It + ((c - 1) & 1) * (2 * 64 * 36) + (tid >> 3) * 36 + (tid & 7) * 4; \
                const f32x4 sv = *(const LAS f32x4*)ip + *(const LAS f32x4*)(ip + 64 * 36); \
                float* o = MINTER + (size_t)(t0 - 64 + (tid >> 3)) * 1024 + h * 256 + jv * 32 + (tid & 7) * 4; \
                asm volatile("global_store_dwordx4 %0, %1, off\n\ts_nop 1" :: "v"(o), "v"(sv) : "memory"); } \
            LAS float* iw = It + cur * (2 * 64 * 36) + kh * (64 * 36) + (mt * 16 + (lane >> 4) * 4) * 36 + (lane & 15); \
            _Pragma("unroll") for (int r = 0; r < 4; ++r) { iw[r * 36] = r0[r]; iw[r * 36 + 16] = r1[r]; } } \
        f32x16 d0; { const float z = OZ(); _Pragma("unroll") for (int i = 0; i < 16; ++i) d0[i] = z; } \
        _Pragma("unroll") for (int ks = 0; ks < 4; ++ks) d0 = MFMA32(SC.k[ks], SC.v[ks], d0); \
        _Pragma("unroll") for (int i = 0; i < 16; ++i) ct[i] = decay * ct[i] + scale * d0[i]; \
        m = mnew; \
        {   LAS bh* o0 = Cbf + (cur ^ 1) * 32 * CS + (lane & 31) * CS + wid * 32 + 4 * (lane >> 5); \
            _Pragma("unroll") for (int g = 0; g < 4; ++g) { u32x2 w0; w0.x = cvt_pk_bf16(ct[4 * g], ct[4 * g + 1]); w0.y = cvt_pk_bf16(ct[4 * g + 2], ct[4 * g + 3]); *(LAS u32x2*)(o0 + 8 * g) = w0; } } \
        asm volatile("s_waitcnt lgkmcnt(0)" ::: "memory"); __builtin_amdgcn_s_barrier(); asm volatile("" ::: "memory"); } while (0)
    for (int c3 = 0; c3 < 126; c3 += 6) { MSTEP(s0, s2, c3); MSTEP(s1, s0, c3 + 1); MSTEP(s2, s1, c3 + 2); MSTEP(s0, s2, c3 + 3); MSTEP(s1, s0, c3 + 4); MSTEP(s2, s1, c3 + 5); }
    MSTEP(s0, s2, 126); MSTEP(s1, s0, 127);
#undef MSTEP
    {   const LAS float* ip = It + (127 & 1) * (2 * 64 * 36) + (tid >> 3) * 36 + (tid & 7) * 4;
        const f32x4 sv = *(const LAS f32x4*)ip + *(const LAS f32x4*)(ip + 64 * 36);
        *(f32x4*)(MINTER + (size_t)(127 * 64 + (tid >> 3)) * 1024 + h * 256 + jv * 32 + (tid & 7) * 4) = sv; }
    asm volatile("s_waitcnt vmcnt(0)" ::: "memory");
    __syncthreads();
}

__device__ __forceinline__ void mlstm_nscan(const Params& p) {
    const float* MBEND = (const float*)(P_WS + OFF_MBEND); const float* MLOC = (const float*)(P_WS + OFF_MLOC);
    const float* DN = (const float*)(P_WS + OFF_DN); float* NST = (float*)(P_WS + OFF_NST); float* MSTART = (float*)(P_WS + OFF_MSTART);
    for (int idx = TIDX(); idx < 1024; idx += 512) { const int h = idx >> 8, d = idx & 255; float m = 0.f, n = 0.f;
        for (int c0 = 0; c0 < NCH; c0 += 16) {
            float be[16], ml[16], dn[16];
#pragma unroll
            for (int j = 0; j < 16; ++j) { be[j] = MBEND[h * NCH + c0 + j]; ml[j] = MLOC[h * NCH + c0 + j]; dn[j] = DN[(size_t)(h * NCH + c0 + j) * 256 + d]; }
            __builtin_amdgcn_sched_barrier(0);
#pragma unroll
            for (int j = 0; j < 16; ++j) { const int c = c0 + j; if (d == 0) MSTART[h * NCH + c] = m; NST[(size_t)(h * NCH + c) * 256 + d] = n;
                const float mnew = fmaxf(be[j] + m, ml[j]);
                n = __expf(be[j] + m - mnew) * n + __expf(ml[j] - mnew) * dn[j]; m = mnew; } } }
}

__device__ __forceinline__ float gelu_tanh(float x) { const float u = 0.7978845608028654f * (x + 0.044715f * x * x * x); return 0.5f * x * (1.0f + tanhf(u)); }

__device__ __forceinline__ void s5_pass_c(const Params& p, int L, int g, int c, int lane, LAS bh* img, LAS float* ul) {
    const float* zf = (const float*)(P_WS + OFF_ZF) + (size_t)(c * 64) * ZF_LD + ZS0 + g * 16;
    s5_stage_u(zf, ul, lane);
    S5C k; s5_setup(p, L, g, lane, k);
    float sr = 0.f, si = 0.f;
    {   float pr = k.ar, pi = k.ai;
#pragma unroll
        for (int i = 0; i < 6; ++i) { const float nr = pr * pr - pi * pi, ni = 2.f * pr * pi; pr = nr; pi = ni; }
        const float* se = (const float*)(P_WS + OFF_SEND) + ((size_t)(g * NCH) * 64 + lane) * 2;
        int cc = 0;
        for (; cc + 32 <= c; cc += 32) { float er[32], ei[32];
#pragma unroll
            for (int j = 0; j < 32; ++j) { er[j] = se[(size_t)(cc + j) * 128]; ei[j] = se[(size_t)(cc + j) * 128 + 1]; }
#pragma unroll
            for (int j = 0; j < 32; ++j) { const float nr = pr * sr - pi * si + er[j], ni = pr * si + pi * sr + ei[j]; sr = nr; si = ni; } }
        for (; cc + 8 <= c; cc += 8) { float er[8], ei[8];
#pragma unroll
            for (int j = 0; j < 8; ++j) { er[j] = se[(size_t)(cc + j) * 128]; ei[j] = se[(size_t)(cc + j) * 128 + 1]; }
#pragma unroll
            for (int j = 0; j < 8; ++j) { const float nr = pr * sr - pi * si + er[j], ni = pr * si + pi * sr + ei[j]; sr = nr; si = ni; } }
        for (; cc < c; ++cc) { const float er = se[(size_t)cc * 128], ei = se[(size_t)cc * 128 + 1];
            const float nr = pr * sr - pi * si + er, ni = pr * si + pi * sr + ei; sr = nr; si = ni; } }
    const int gi = L * 32 + g;
    bf16x8 bfr[4];
    {   const int pp = lane & 15; const float* cre = P_IN(24) + ((size_t)gi * 16 + pp) * 64; const float* cim = P_IN(25) + ((size_t)gi * 16 + pp) * 64;
#pragma unroll
        for (int ks = 0; ks < 4; ++ks)
#pragma unroll
            for (int j = 0; j < 8; ++j) { const int n2 = ks * 32 + (lane >> 4) * 8 + j; const float v = (n2 < 64) ? cre[n2] : -cim[n2 - 64]; bfr[ks][j] = (short)f2bf(v); } }
    const float dco = P_IN(26)[L * 512 + g * 16 + (lane & 15)];
    bh* YS = (bh*)(P_WS + OFF_YS);
    for (int half = 0; half < 2; ++half) {
#pragma unroll 8
        for (int s = 0; s < 32; ++s) { s5_step(k, ul + (half * 32 + s) * 16, sr, si); img[s * 136 + lane] = f2bf(sr); img[s * 136 + 64 + lane] = f2bf(si); }
        asm volatile("s_waitcnt lgkmcnt(0)" ::: "memory"); __builtin_amdgcn_wave_barrier();
#pragma unroll
        for (int mt = 0; mt < 2; ++mt) { f32x4 acc = {0.f, 0.f, 0.f, 0.f};
#pragma unroll
            for (int ks = 0; ks < 4; ++ks) { const bf16x8 a = *(const LAS bf16x8*)(img + (mt * 16 + (lane & 15)) * 136 + ks * 32 + (lane >> 4) * 8); acc = MFMA16(a, bfr[ks], acc); }
#pragma unroll
            for (int r = 0; r < 4; ++r) { const int tt = half * 32 + mt * 16 + (lane >> 4) * 4 + r; const float uv = ul[tt * 16 + (lane & 15)];
                YS[(size_t)(c * 64 + tt) * 512 + g * 16 + (lane & 15)] = f2bf(gelu_tanh(acc[r] + dco * uv)); } }
        asm volatile("s_waitcnt lgkmcnt(0)" ::: "memory"); __builtin_amdgcn_wave_barrier();
    }
}

__device__ __forceinline__ void phase_scan(const Params& p, int L, LAS unsigned char* lds) {
    const int b = BIDX();
    if (b < 224) { for (int rr = 0; rr < PROBE_RW; ++rr) rwkv_scan(p, b, lds); }
    else { for (int rr = 0; rr < PROBE_ML; ++rr) mlstm_seq(p, b - 224, lds); }
}
__device__ __forceinline__ void phase_s5c(const Params& p, int L, LAS unsigned char* lds) {
    const int b = BIDX(), wid = TIDX() >> 6, lane = TIDX() & 63;
    if (b == GDIM() - 1) mlstm_nscan(p);
    const int nw = GDIM() * 8;
    for (int w = b * 8 + wid; w < 32 * NCH; w += nw) s5_pass_c(p, L, w >> 7, w & 127, lane, (LAS bh*)lds + wid * (32 * 136), (LAS float*)(lds + 69632) + wid * 1024);
    __syncthreads();
}

__device__ __forceinline__ void mlstm_out(const Params& p, int L, int h, int c, LAS unsigned char* lds) {
    const int tid = TIDX(), wid = tid >> 6, lane = tid & 63, t0 = c * 64;
    LAS bh* Pl = (LAS bh*)lds;
    LAS float* s_b = (LAS float*)(lds + 9216); LAS float* s_a = s_b + 64; LAS float* s_mt = s_a + 64; LAS float* s_iw = s_mt + 64; LAS float* s_den = s_iw + 64; LAS float* s_qn = s_den + 64; LAS float* s_part = s_qn + 64;
    const bh* MQ = (const bh*)(P_WS + OFF_MQ); const bh* MK = (const bh*)(P_WS + OFF_MK); const bh* MVT = (const bh*)(P_WS + OFF_MVT);
    const float* MINTER = (const float*)(P_WS + OFF_ABF);
    const float m0 = ((const float*)(P_WS + OFF_MSTART))[h * NCH + c];
    if (tid < 64) { const float ig = ((const float*)(P_WS + OFF_MI))[h * T + t0 + tid], b = ((const float*)(P_WS + OFF_MBB))[h * T + t0 + tid];
        const float a = ig - b; float cm = a;
#pragma unroll
        for (int o = 1; o < 64; o <<= 1) { const float nb = bperm_f((tid - o) & 63, cm); if (tid >= o) cm = fmaxf(cm, nb); }
        const float mt = b + fmaxf(m0, cm);
        s_b[tid] = b; s_a[tid] = a; s_mt[tid] = mt; s_iw[tid] = __expf(b + m0 - mt); }
    __syncthreads();
    {
        const int mt = wid >> 1, nt0 = (wid & 1) * 2;
        f32x4 r0 = {0.f, 0.f, 0.f, 0.f}, r1 = {0.f, 0.f, 0.f, 0.f};
        const bh* qp = MQ + fq_base(h, c, mt, 0) + lane * 8;
        const bh* kp = MK + fq_base(h, c, nt0, 0) + lane * 8;
#pragma unroll
        for (int ks = 0; ks < 8; ++ks) { const bf16x8 a = *(const bf16x8*)(qp + ks * 512); const bf16x8 b0 = *(const bf16x8*)(kp + ks * 512), b1 = *(const bf16x8*)(kp + 8 * 512 + ks * 512);
            r0 = MFMA16(a, b0, r0); r1 = MFMA16(a, b1, r1); }
#pragma unroll
        for (int r = 0; r < 4; ++r) { const int t = mt * 16 + (lane >> 4) * 4 + r; const float bt = s_b[t] - s_mt[t];
            { const int s = nt0 * 16 + (lane & 15); const float pv = (s <= t) ? r0[r] * __expf(bt + s_a[s]) : 0.f; Pl[t * 72 + s] = f2bf(pv); }
            { const int s = nt0 * 16 + 16 + (lane & 15); const float pv = (s <= t) ? r1[r] * __expf(bt + s_a[s]) : 0.f; Pl[t * 72 + s] = f2bf(pv); } }
    }
    __syncthreads();
    if (tid < 64) { float s = 0.f;
#pragma unroll
        for (int q = 0; q < 8; ++q) { const u32x4 w = *(const LAS u32x4*)(Pl + tid * 72 + q * 8);
            s += __uint_as_float(w.x << 16) + __uint_as_float(w.x & 0xffff0000u) + __uint_as_float(w.y << 16) + __uint_as_float(w.y & 0xffff0000u)
               + __uint_as_float(w.z << 16) + __uint_as_float(w.z & 0xffff0000u) + __uint_as_float(w.w << 16) + __uint_as_float(w.w & 0xffff0000u); }
        s_den[tid] = s; }
    {
        const float* nst = (const float*)(P_WS + OFF_NST) + (size_t)(h * NCH + c) * 256 + lane * 4; const f32x4 nv = *(const f32x4*)nst;
#pragma unroll
        for (int i = 0; i < 8; ++i) { const int t = wid * 8 + i; const u32x2 q2 = *(const u32x2*)(MQ + fq_off(h, t0 + t, lane * 4));
            float s = __uint_as_float(q2.x << 16) * nv[0] + __uint_as_float(q2.x & 0xffff0000u) * nv[1] + __uint_as_float(q2.y << 16) * nv[2] + __uint_as_float(q2.y & 0xffff0000u) * nv[3];
            s = wave_sum(s); if (lane == 0) s_qn[t] = s; } }
    f32x4 acc[4][2];
#pragma unroll
    for (int a = 0; a < 4; ++a) { const float z = OZ(); acc[a][0] = (f32x4){z, z, z, z}; acc[a][1] = (f32x4){z, z, z, z}; }
    {   const bh* vp = MVT + (size_t)(h * NCH + c) * 16384;
#pragma unroll
        for (int ks = 0; ks < 2; ++ks) { const bf16x8 b0 = *(const bf16x8*)(vp + ft_off(wid * 32 + (lane & 15), ks * 4 + (lane >> 4))), b1 = *(const bf16x8*)(vp + ft_off(wid * 32 + 16 + (lane & 15), ks * 4 + (lane >> 4)));
#pragma unroll
            for (int a = 0; a < 4; ++a) { const bf16x8 av = *(const LAS bf16x8*)(Pl + (a * 16 + (lane & 15)) * 72 + ks * 32 + (lane >> 4) * 8);
                acc[a][0] = MFMA16(av, b0, acc[a][0]); acc[a][1] = MFMA16(av, b1, acc[a][1]); } } }
    __syncthreads();
#pragma unroll
    for (int a = 0; a < 4; ++a)
#pragma unroll
        for (int r = 0; r < 4; ++r) { const int t = a * 16 + (lane >> 4) * 4 + r; const float iw = s_iw[t];
            const float den = s_den[t] + iw * s_qn[t]; const float dd = 1.0f / fmaxf(fabsf(den), __expf(-s_mt[t]));
            const float* mi = MINTER + (size_t)(t0 + t) * 1024 + h * 256 + wid * 32 + (lane & 15);
            const float h0 = (acc[a][0][r] + iw * mi[0]) * dd, h1 = (acc[a][1][r] + iw * mi[16]) * dd;
            acc[a][0][r] = h0; acc[a][1][r] = h1;
            float ss = h0 * h0 + h1 * h1;
            ss = allreduce16(ss);
            if ((lane & 15) == 0) s_part[wid * 64 + t] = ss; }
    __syncthreads();
    {   const float* zf = (const float*)(P_WS + OFF_ZF); const float* ng = P_IN(7) + L * 1024 + h * 256; bh* YC = (bh*)(P_WS + OFF_YCAT);
        float og[4][4][2]; const float ng0 = ng[wid * 32 + (lane & 15)], ng1 = ng[wid * 32 + 16 + (lane & 15)];
#pragma unroll
        for (int a = 0; a < 4; ++a)
#pragma unroll
            for (int r = 0; r < 4; ++r) { const float* op = zf + (size_t)(t0 + a * 16 + (lane >> 4) * 4 + r) * ZF_LD + 3072 + h * 256 + wid * 32 + (lane & 15); og[a][r][0] = op[0]; og[a][r][1] = op[16]; }
        __builtin_amdgcn_sched_barrier(0);
#pragma unroll
        for (int a = 0; a < 4; ++a)
#pragma unroll
            for (int r = 0; r < 4; ++r) { const int t = a * 16 + (lane >> 4) * 4 + r;
                float tot = 0.f;
#pragma unroll
                for (int w = 0; w < 8; ++w) tot += s_part[w * 64 + t];
                const float rstd = rsqrtf(tot * (1.0f / 256.0f) + 1e-6f);
                const int v0 = wid * 32 + (lane & 15);
                bh* yo = YC + (size_t)(t0 + t) * D + h * 256 + v0;
                yo[0] = f2bf(sigmoidf_(og[a][r][0]) * acc[a][0][r] * rstd * ng0);
                yo[16] = f2bf(sigmoidf_(og[a][r][1]) * acc[a][1][r] * rstd * ng1); } }
    __syncthreads();
}

__device__ __forceinline__ void rwkv_post(const Params& p, int L, int it, LAS unsigned char* lds) {
    const int tid = TIDX(), wid = tid >> 6, lane = tid & 63;
    const int h = it & 7, blk = it >> 3, j = blk >> 3;
    LAS float* bufA = (LAS float*)lds;
    LAS float* bufB = bufA + 64 * 65;
    LAS float* bufP = bufB + 64 * 65;
    const float* SE = (const float*)(P_WS + OFF_RSEND) + (size_t)(h * 4) * 4096; const float* PE = (const float*)(P_WS + OFF_RPEND) + (size_t)(h * 4) * 4096;
    LAS float* sst = bufA;
    if (j >= 1) {
        const int v = tid >> 3, k8 = (tid & 7) * 8;
        { const f32x4 a0 = *(const f32x4*)(SE + v * 64 + k8), a1 = *(const f32x4*)(SE + v * 64 + k8 + 4);
#pragma unroll
          for (int e = 0; e < 4; ++e) { bufA[v * 65 + k8 + e] = a0[e]; bufA[v * 65 + k8 + 4 + e] = a1[e]; } }
        for (int jj = 1; jj < j; ++jj) {
            { const f32x4 p0 = *(const f32x4*)(PE + (size_t)jj * 4096 + v * 64 + k8), p1 = *(const f32x4*)(PE + (size_t)jj * 4096 + v * 64 + k8 + 4);
              *(LAS f32x4*)(bufP + v * 64 + k8) = p0; *(LAS f32x4*)(bufP + v * 64 + k8 + 4) = p1; }
            __syncthreads();
            LAS float* src = (jj & 1) ? bufA : bufB; LAS float* dst = (jj & 1) ? bufB : bufA;
            f32x4 c0 = *(const f32x4*)(SE + (size_t)jj * 4096 + v * 64 + k8), c1 = *(const f32x4*)(SE + (size_t)jj * 4096 + v * 64 + k8 + 4);
#pragma unroll 8
            for (int i = 0; i < 64; ++i) { const float a = src[v * 65 + i]; const f32x4 p0 = *(const LAS f32x4*)(bufP + i * 64 + k8), p1 = *(const LAS f32x4*)(bufP + i * 64 + k8 + 4); c0 += a * p0; c1 += a * p1; }
#pragma unroll
            for (int e = 0; e < 4; ++e) { dst[v * 65 + k8 + e] = c0[e]; dst[v * 65 + k8 + 4 + e] = c1[e]; }
            __syncthreads();
            sst = dst;
        }
        __syncthreads();
    }
    float srow[64];
    if (j >= 1) {
#pragma unroll
        for (int i = 0; i < 64; ++i) srow[i] = sst[lane * 65 + i];
    } else {
#pragma unroll
        for (int i = 0; i < 64; ++i) srow[i] = 0.f;
    }
    const int c = h * 64 + lane;
    const float rkw = P_IN(16)[L * 512 + c], lg = P_IN(17)[L * 512 + c], lb = P_IN(18)[L * 512 + c];
    const float* RY = (const float*)(P_WS + OFF_RY); const float* RZ = (const float*)(P_WS + OFF_RZ); const float* RR = (const float*)(P_WS + OFF_RR); const float* RK = (const float*)(P_WS + OFF_RK);
    const float* RV = (const float*)(P_WS + OFF_RV); const float* RG = (const float*)(P_WS + OFF_RG); bh* YC = (bh*)(P_WS + OFF_YCAT);
    for (int i4 = 0; i4 < 32; i4 += 4) { float yv[4], zv[4], rrv[4], rkv[4], rvv[4], rgv[4];
#pragma unroll
        for (int q = 0; q < 4; ++q) { const size_t o = (size_t)(blk * 256 + wid * 32 + i4 + q) * 512 + c;
            yv[q] = RY[o]; zv[q] = (j >= 1) ? RZ[o] : 0.f; rrv[q] = RR[o]; rkv[q] = RK[o]; rvv[q] = RV[o]; rgv[q] = RG[o]; }
        __builtin_amdgcn_sched_barrier(0);
#pragma unroll
        for (int q4 = 0; q4 < 4; ++q4) { const int t = blk * 256 + wid * 32 + i4 + q4;
            float y = yv[q4];
            if (j >= 1) { const float z = zv[q4]; float y2 = 0.f;
#pragma unroll
                for (int q = 0; q < 64; q += 2) { y = fmaf(srow[q], __builtin_bit_cast(float, __builtin_amdgcn_readlane(__builtin_bit_cast(int, z), q)), y);
                                                  y2 = fmaf(srow[q + 1], __builtin_bit_cast(float, __builtin_amdgcn_readlane(__builtin_bit_cast(int, z), q + 1)), y2); }
                y += y2; }
            const float mu = wave_sum(y) * (1.0f / 64.0f); const float dlt = y - mu; const float var = wave_sum(dlt * dlt) * (1.0f / 64.0f);
            const float yn = dlt * rsqrtf(var + 64e-5f) * lg + lb;
            const float bon = wave_sum(rrv[q4] * rkv[q4] * rkw) * rvv[q4];
            YC[(size_t)t * D + 1024 + c] = f2bf((yn + bon) * rgv[q4]); } }
    __syncthreads();
}

__device__ __forceinline__ void phase_post(const Params& p, int L, LAS unsigned char* lds) {
    for (int it = BIDX(); it < 768; it += GDIM()) {
        if (it < 512) mlstm_out(p, L, it >> 7, it & 127, lds);
        else rwkv_post(p, L, it - 512, lds);
    }
    __syncthreads();
}

#define XB_TMO      128
#define XB_XCNT(j)  (256  + 64 * (j))
#define XB_XSUB(j)  (1280 + 64 * (j))
#define XB_XGEN(j)  (2304 + 64 * (j))
#define XB_TOP      3328
#define XB_TOPGEN   3392
#define XCD_BAR_WORDS 3456
#define XB_SPIN_CAP (1u << 18)

__device__ __forceinline__ unsigned xb_ld(unsigned* p)              { return __hip_atomic_load(p, __ATOMIC_RELAXED, __HIP_MEMORY_SCOPE_AGENT); }
__device__ __forceinline__ unsigned xb_add(unsigned* p, unsigned v) { return __hip_atomic_fetch_add(p, v, __ATOMIC_RELAXED, __HIP_MEMORY_SCOPE_AGENT); }
__device__ __forceinline__ unsigned xb_xcc_id() { return (unsigned)__builtin_amdgcn_s_getreg((3 << 11) | 20) & 0xFu; }
#define XB_SPIN(cond, bar) do { unsigned _sp = 0; while (cond) { __builtin_amdgcn_s_sleep(1); \
    if ((++_sp & 255u) == 0u) { if (xb_ld(&(bar)[XB_TMO])) break; if (_sp > XB_SPIN_CAP) { atomicAdd(&(bar)[XB_TMO], 1u); break; } } } } while (0)

struct XcdBarrier {
    unsigned* bar; unsigned x;
    volatile LAS unsigned* st;
};

__device__ __forceinline__ XcdBarrier xcd_barrier_post(unsigned* bar, volatile LAS unsigned* st) {
    XcdBarrier b; b.bar = bar; b.x = xb_xcc_id(); b.st = st;
    if (threadIdx.x == 0) (void)xb_add(&bar[XB_XCNT(b.x)], 1u);
    return b;
}
__device__ __forceinline__ void xcd_barrier_complete(unsigned* bar, unsigned x, unsigned& nloc, unsigned& nx) {
    const unsigned G = gridDim.x * gridDim.y * gridDim.z;
    unsigned sum, cnt, mine, sp = 0u;
    for (;;) {
        sum = 0u; cnt = 0u; mine = 0u;
#pragma unroll
        for (unsigned j = 0; j < 16; ++j) { const unsigned c = xb_ld(&bar[XB_XCNT(j)]); sum += c; cnt += (c > 0u) ? 1u : 0u; mine = (j == x) ? c : mine; }
        if (sum == G) break;
        __builtin_amdgcn_s_sleep(1);
        if ((++sp & 255u) == 0u) { if (xb_ld(&bar[XB_TMO])) break; if (sp > XB_SPIN_CAP) { atomicAdd(&bar[XB_TMO], 1u); break; } }
    }
    nloc = mine > 0u ? mine : 1u; nx = cnt > 0u ? cnt : 1u;
}

__device__ __forceinline__ void xcd_barrier(const XcdBarrier& b) {
    asm volatile("s_waitcnt vmcnt(0)" ::: "memory");
    __syncthreads();
    if (threadIdx.x == 0) {
        unsigned* bar = b.bar;
        __builtin_amdgcn_s_waitcnt(0);
        unsigned nloc = b.st[0], nx = b.st[1];
        if (nloc == 0u) { xcd_barrier_complete(bar, b.x, nloc, nx); b.st[0] = nloc; b.st[1] = nx; }
        const unsigned old = xb_add(&bar[XB_XSUB(b.x)], 1u);
        const unsigned gen = old / nloc;
        if (old + 1u == (gen + 1u) * nloc) {
            __builtin_amdgcn_fence(__ATOMIC_RELEASE, "agent");
            asm volatile("s_waitcnt vmcnt(0)" ::: "memory");
            const unsigned og = xb_add(&bar[XB_TOP], 1u);
            const unsigned tg = og / nx;
            if (og + 1u == (tg + 1u) * nx) xb_add(&bar[XB_TOPGEN], 1u);
            else XB_SPIN(xb_ld(&bar[XB_TOPGEN]) == tg, bar);
            __builtin_amdgcn_fence(__ATOMIC_ACQUIRE, "agent");
            xb_add(&bar[XB_XGEN(b.x)], 1u);
            asm volatile("s_waitcnt vmcnt(0)" ::: "memory");
        } else {
            XB_SPIN(xb_ld(&bar[XB_XGEN(b.x)]) == gen, bar);
            __builtin_amdgcn_fence(__ATOMIC_ACQUIRE, "agent");
            asm volatile("s_waitcnt vmcnt(0)" ::: "memory");
        }
    }
    __syncthreads();
}


constexpr int NPHASE = 27;
__global__ void __launch_bounds__(512, 2) hybrid_fwd(Params p, int ph_lo, int ph_hi, int rep_q) {
    extern __shared__ __attribute__((aligned(16))) unsigned char smem_raw[];
    LAS unsigned char* lds = (LAS unsigned char*)smem_raw;
    cg::grid_group grid = cg::this_grid();
    volatile LAS unsigned* xst = (volatile LAS unsigned*)(lds + 131072);
    if (threadIdx.x < 2) xst[threadIdx.x] = 0u;
    __syncthreads();
    { XcdBarrier b0 = xcd_barrier_post((unsigned*)(P_WS + OFF_BAR), xst); (void)b0; }
    for (int ph = ph_lo; ph < ph_hi; ++ph) {
        if (ph == ph_lo + 1) grid.sync();
        else if (ph > ph_lo) { XcdBarrier xb; xb.bar = (unsigned*)(P_WS + OFF_BAR); xb.x = xb_xcc_id(); xb.st = xst; xcd_barrier(xb); }
        if (ph == 26) {
            const int gw = BIDX() * 8 + (TIDX() >> 6), NGW = GDIM() * 8, lane = TIDX() & 63;
            for (int r = gw; r < T; r += NGW) { float* x = P_OUT + (size_t)r * D; f32x4 v[8]; float s = 0.f;
#pragma unroll
                for (int j = 0; j < 8; ++j) { v[j] = *(const f32x4*)(x + j * 256 + lane * 4); s += (v[j][0] * v[j][0] + v[j][1] * v[j][1]) + (v[j][2] * v[j][2] + v[j][3] * v[j][3]); }
                const float rstd = rsqrtf(wave_sum(s) * (1.0f / D) + 1e-6f);
#pragma unroll
                for (int j = 0; j < 8; ++j) { const f32x4 gg = *(const f32x4*)(P_IN(40) + j * 256 + lane * 4); *(f32x4*)(x + j * 256 + lane * 4) = v[j] * rstd * gg; } }
            continue;
        }
        const int L = ph / 13, q = ph % 13;
#ifdef ONLY_Q
        if (q != ONLY_Q) continue;
#endif
        const int nrep = (q == rep_q) ? 2 : 1;
        for (int rep = 0; rep < nrep; ++rep) {
        if (rep) grid.sync();
        switch (q) {
        case 0: phase_conv(p, L, lds); break;
        case 2: phase_prep(p, L, lds); break;
        case 4: phase_scan(p, L, lds); break;
        case 5: phase_post(p, L, lds); break;
        case 8: phase_rmsnorm(p, P_IN(33) + (size_t)L * D); break;
        case 11: phase_rmsnorm(p, P_IN(37) + (size_t)L * D); break;
        default: break;
        }
        for (int i = 0; i < 3; ++i) {
            pg8::Gemm g;
            if (!make_gemm(p, L, q, i, g)) break;
            pg8::StaticOrder S; S.init(T, g.N, GDIM(), (q == 3) ? BIDX() - 64 * i : BIDX());
            pg8::gemm_phase(lds, g, S);
        }
        if (q == 3) phase_s5c(p, L, lds);
        }
    }
}

extern "C" void kernel_launch(void* const* d_in, const int* in_sizes, int n_in, void* d_out, int out_size, void* d_ws, size_t ws_size, hipStream_t stream) {
    constexpr size_t kDynLds = 131072 + 64;
    static int grid_blocks = 0;
    if (!grid_blocks) {
        int dev = 0, cus = 0, per_cu = 0;
        (void)hipGetDevice(&dev);
        (void)hipDeviceGetAttribute(&cus, hipDeviceAttributeMultiprocessorCount, dev);
        (void)hipFuncSetAttribute((const void*)hybrid_fwd, hipFuncAttributeMaxDynamicSharedMemorySize, (int)kDynLds);
        (void)hipOccupancyMaxActiveBlocksPerMultiprocessor(&per_cu, hybrid_fwd, 512, kDynLds);
        if (per_cu > 1) per_cu = 1;
        grid_blocks = cus * per_cu;
        if (ws_size < WS_TOTAL) fprintf(stderr, "workspace too small: %zu < %zu\n", ws_size, (size_t)WS_TOTAL);
    }
    Params p{};
    for (int i = 0; i < 41; ++i) p.in[i] = (const float*)d_in[i];
    p.out = (float*)d_out; p.ws = (unsigned char*)d_ws;
    (void)hipMemsetAsync((char*)d_ws + OFF_BAR, 0, XCD_BAR_WORDS * 4, stream);
#if SINGLE_LAUNCH
    int lo = 0, hi = NPHASE, rq = PROBE_REP_Q;
    void* args[] = {&p, &lo, &hi, &rq};
    hipError_t e = hipLaunchCooperativeKernel((const void*)hybrid_fwd, dim3(grid_blocks), dim3(512), args, kDynLds, stream);
    if (e != hipSuccess) fprintf(stderr, "cooperative launch failed: %s (grid %d)\n", hipGetErrorString(e), grid_blocks);
#else
    for (int ph = 0; ph < NPHASE; ++ph) {
        int lo = ph, hi = ph + 1, rq = -1;
        void* args[] = {&p, &lo, &hi, &rq};
        hipError_t e = hipLaunchCooperativeKernel((const void*)hybrid_fwd, dim3(grid_blocks), dim3(512), args, kDynLds, stream);
        if (e != hipSuccess) fprintf(stderr, "cooperative launch failed: %s (grid %d)\n", hipGetErrorString(e), grid_blocks);
    }
#endif
}
```

```cpp
#include <hip/hip_runtime.h>
#include <hip/hip_cooperative_groups.h>
#include <cstdio>
#include <cstdint>
namespace cg = cooperative_groups;

#define LAS __attribute__((address_space(3)))
typedef unsigned short bh;
typedef short bf16x8 __attribute__((ext_vector_type(8)));
typedef float f32x4 __attribute__((ext_vector_type(4)));
typedef float f32x16 __attribute__((ext_vector_type(16)));
typedef unsigned u32x4 __attribute__((ext_vector_type(4)));
typedef unsigned u32x2 __attribute__((ext_vector_type(2)));

#ifndef PROBE_RW
#define PROBE_RW 1
#define PROBE_ML 1
#endif
#ifndef PROBE_REP_Q
#define PROBE_REP_Q (-1)
#endif
#ifndef SINGLE_LAUNCH
#define SINGLE_LAUNCH 1
#endif

constexpr int T = 8192, D = 2048, FH = 5632;
constexpr int NIN = 12744, NGATE = 6144, NF = 6600, ZF_LD = 6656, NINP = 12800;
constexpr int ZR0 = 4104, ZS0 = 6088;
constexpr int NCH = 128;

constexpr size_t AL(size_t x) { return (x + 255) & ~(size_t)255; }
constexpr size_t SZ_WIN = (size_t)NINP * D * 2, SZ_SQ = (size_t)D * D * 2, SZ_WGU = (size_t)2 * FH * D * 2, SZ_WD = (size_t)D * FH * 2;
constexpr size_t OFF_WIN = 0;
constexpr size_t OFF_WUP = OFF_WIN + SZ_WIN;
constexpr size_t OFF_WO = OFF_WUP + SZ_SQ;
constexpr size_t OFF_WGU = OFF_WO + SZ_SQ;
constexpr size_t OFF_WD = OFF_WGU + SZ_WGU;
constexpr size_t OFF_WPG = OFF_WD + SZ_WD;
constexpr size_t OFF_WPP = OFF_WPG + SZ_SQ;
constexpr size_t OFF_WGLU = OFF_WPP + (size_t)D * 256 * 2;
constexpr size_t OFF_WW2 = OFF_WGLU + (size_t)512 * 512 * 2;
constexpr size_t OFF_WA2 = OFF_WW2 + (size_t)512 * 256 * 2;
constexpr size_t OFF_WG2 = OFF_WA2 + (size_t)512 * 256 * 2;
constexpr size_t OFF_PBF = OFF_WG2 + (size_t)512 * 256 * 2;
constexpr size_t OFF_ABF = OFF_PBF + (size_t)2 * T * 256 * 2;
constexpr size_t OFF_YCAT = OFF_ABF + (size_t)T * D * 2;
constexpr size_t OFF_ZF = OFF_YCAT + (size_t)T * D * 2;
constexpr size_t OFF_ACT = OFF_ZF;
constexpr size_t OFF_MIX32 = OFF_ZF + (size_t)100663296;
constexpr size_t OFF_ZG = OFF_ZF + (size_t)T * ZF_LD * 4;
constexpr size_t SZ_R = (size_t)T * 512 * 4;
constexpr size_t OFF_RR = OFF_ZG + (size_t)T * NGATE * 2;
constexpr size_t OFF_RK = OFF_RR + SZ_R, OFF_RV = OFF_RK + SZ_R, OFF_RKK = OFF_RV + SZ_R, OFF_RW = OFF_RKK + SZ_R, OFF_RB = OFF_RW + SZ_R, OFF_RG = OFF_RB + SZ_R, OFF_RY = OFF_RG + SZ_R;
constexpr size_t OFF_LAW = OFF_RY + SZ_R;
constexpr size_t OFF_LAA = OFF_LAW + (size_t)T * 256 * 2, OFF_LAG = OFF_LAA + (size_t)T * 256 * 2;
constexpr size_t SZ_MB = (size_t)T * 1024 * 2;
constexpr size_t OFF_MQ = OFF_LAG + (size_t)T * 256 * 2, OFF_MK = OFF_MQ + SZ_MB, OFF_MKT = OFF_MK + SZ_MB, OFF_MVT = OFF_MKT + SZ_MB;
constexpr size_t OFF_MI = OFF_MVT + SZ_MB;
constexpr size_t OFF_MBB = OFF_MI + (size_t)4 * T * 4;
constexpr size_t OFF_MBEND = OFF_MBB + (size_t)4 * T * 4;
constexpr size_t OFF_MLOC = OFF_MBEND + 2048, OFF_MSTART = OFF_MLOC + 2048;
constexpr size_t OFF_DN = OFF_MSTART + 2048;
constexpr size_t OFF_NST = OFF_DN + (size_t)4 * NCH * 256 * 4;
constexpr size_t OFF_SEND = OFF_NST + (size_t)4 * NCH * 256 * 4;
constexpr size_t OFF_YS = OFF_SEND + (size_t)32 * NCH * 64 * 8;
constexpr size_t OFF_RZ = OFF_YS + (size_t)T * 512 * 2;
constexpr size_t OFF_RSEND = OFF_RZ + SZ_R;
constexpr size_t OFF_RPEND = OFF_RSEND + (size_t)8 * 4 * 4096 * 4;
constexpr size_t OFF_MINTER2 = OFF_RPEND + (size_t)8 * 4 * 4096 * 4;
constexpr size_t OFF_BAR = OFF_MINTER2;
constexpr size_t WS_TOTAL = OFF_MINTER2 + (size_t)T * 1024 * 4;

struct Params { const float* in[41]; float* out; unsigned char* ws; };
#define KARG4 __attribute__((address_space(4)))
__device__ __forceinline__ const float* karg_in(int i) { const KARG4 char* ka = (const KARG4 char*)__builtin_amdgcn_kernarg_segment_ptr(); return *(const float* const volatile KARG4*)(ka + (size_t)i * 8); }
#define P_IN(i) karg_in(i)
#define P_OUT ((float*)karg_in(41))
#define P_WS ((unsigned char*)karg_in(42))

__device__ __forceinline__ int TIDX() { int t = threadIdx.x; asm volatile("" : "+v"(t)); return t; }
__device__ __forceinline__ int BIDX() { int t = blockIdx.x; asm volatile("" : "+s"(t)); return t; }
__device__ __forceinline__ int GDIM() { int t = gridDim.x; asm volatile("" : "+s"(t)); return t; }
__device__ __forceinline__ bh f2bf(float f) { unsigned u = __float_as_uint(f); u += 0x7fffu + ((u >> 16) & 1u); return (bh)(u >> 16); }
__device__ __forceinline__ float bf2f(bh h) { return __uint_as_float(((unsigned)h) << 16); }
__device__ __forceinline__ unsigned pk2(float lo, float hi) { return (unsigned)f2bf(lo) | ((unsigned)f2bf(hi) << 16); }
__device__ __forceinline__ float tanhf_(float x) { return 1.0f - 2.0f * __builtin_amdgcn_rcpf(1.0f + __expf(2.0f * x)); }
__device__ __forceinline__ float sigmoidf_(float x) { return __builtin_amdgcn_rcpf(1.0f + __expf(-x)); }
__device__ __forceinline__ float bperm_f(int srclane, float v) { return __builtin_bit_cast(float, __builtin_amdgcn_ds_bpermute(srclane << 2, __builtin_bit_cast(int, v))); }
template <int CTRL> __device__ __forceinline__ float dpp_f(float x) {
    return __builtin_bit_cast(float, __builtin_amdgcn_update_dpp(0, __builtin_bit_cast(int, x), CTRL, 0xf, 0xf, true));
}
__device__ __forceinline__ float allreduce16(float x) {
    x += dpp_f<0xB1>(x); x += dpp_f<0x4E>(x); x += dpp_f<0x141>(x); x += dpp_f<0x140>(x);
    return x;
}
__device__ __forceinline__ float rl_f(float v, int l) { return __builtin_bit_cast(float, __builtin_amdgcn_readlane(__builtin_bit_cast(int, v), l)); }
__device__ __forceinline__ float wave_sum(float v) {
    v = allreduce16(v);
    return (rl_f(v, 0) + rl_f(v, 16)) + (rl_f(v, 32) + rl_f(v, 48));
}
__device__ __forceinline__ float wave_max(float v) {
    v = fmaxf(v, dpp_f<0xB1>(v)); v = fmaxf(v, dpp_f<0x4E>(v)); v = fmaxf(v, dpp_f<0x141>(v)); v = fmaxf(v, dpp_f<0x140>(v));
    return fmaxf(fmaxf(rl_f(v, 0), rl_f(v, 16)), fmaxf(rl_f(v, 32), rl_f(v, 48)));
}
__device__ __forceinline__ float OZ() { float z = 0.f; asm volatile("" : "+v"(z)); return z; }
#define MFMA16(a, b, c) __builtin_amdgcn_mfma_f32_16x16x32_bf16(a, b, c, 0, 0, 0)
#define MFMA32(a, b, c) __builtin_amdgcn_mfma_f32_32x32x16_bf16(a, b, c, 0, 0, 0)

namespace pg8 {
constexpr int BM = 256, BK = 64, HALF = 128, HTB = HALF * BK * 2, STAGE_BYTES = 8 * HTB, NXCD = 8, WGM = 8;
__device__ __forceinline__ int lds_byte(int r, int c) { const int st = (r >> 4) * 2 + (c >> 5), rr = r & 15, cc = c & 31, ob = rr * 64 + cc * 2; return st * 1024 + (ob ^ (((ob >> 9) & 1) << 5)); }
__device__ __forceinline__ void stage_rc(int b, int& R, int& C) { const int st = b / 1024, sb = b % 1024, swz = sb ^ (((sb >> 9) & 1) << 5); R = (st >> 1) * 16 + swz / 64; C = (st & 1) * 32 + (swz % 64) / 2; }
__device__ __forceinline__ int perm32(int rho) { const int n = rho >> 4, i = rho & 15; return 8 * (i >> 2) + 4 * n + (i & 3); }
struct Unit { int pm, pn; };
struct Gemm { const bh* A; const bh* Bt; int M, N, K, lda, ldb, epi, perm, L; };
struct StaticOrder {
    int nM, nN, nwg, G, c;
    __device__ void init(int M, int N, int G_, int c_) { nM = M / BM; nN = N / BM; nwg = nM * nN; G = G_; c = c_; }
    __device__ bool next(int i, Unit& u) const {
        const long L = (long)i * G + c; if (c < 0 || L >= nwg) return false;
        int wgid = (int)L; { const int q = nwg / NXCD, r = nwg % NXCD, xcd = wgid % NXCD, off = wgid / NXCD; wgid = (xcd < r ? xcd * (q + 1) : r * (q + 1) + (xcd - r) * q) + off; }
        const int nig = WGM * nN, gid = wgid / nig, fm = gid * WGM, gsz = (nM - fm) < WGM ? (nM - fm) : WGM;
        u.pm = fm + ((wgid % nig) % gsz); u.pn = (wgid % nig) / gsz; return true;
    }
};
__device__ __forceinline__ unsigned cvt_pk_bf16(float lo, float hi) { unsigned r; asm volatile("v_cvt_pk_bf16_f32 %0, %1, %2" : "=v"(r) : "v"(lo), "v"(hi)); return r; }

__device__ __forceinline__ void epi_run(const Gemm& g, const f32x4 (&acc)[2][2][4][2], const Unit& u, int wr, int wc, int fr, int fq);
__device__ __forceinline__ void up_rescale(f32x4 (&acc)[2][2][4][2], const Unit& u, int wr, int wc, int fr, int fq, int goff) {
    const bh* zg = (const bh*)(P_WS + OFF_ZG) + goff;
    asm volatile("" : "+v"(fr), "+v"(fq));
    const bh* zrow0 = zg + (size_t)(u.pm * 256 + wr * 64 + fr) * NGATE + u.pn * 256 + wc * 32 + 4 * fq;
#pragma unroll
    for (int ai = 0; ai < 2; ++ai)
#pragma unroll
        for (int mp = 0; mp < 2; ++mp) {
            u32x2 gp[8], gn[8];
#pragma unroll
            for (int mm = 0; mm < 2; ++mm) { const bh* zr = zrow0 + (size_t)(ai * 128 + (mp * 2 + mm) * 16) * NGATE;
#pragma unroll
                for (int bj = 0; bj < 2; ++bj)
#pragma unroll
                    for (int n = 0; n < 2; ++n) { gp[mm * 4 + bj * 2 + n] = *(const u32x2*)(zr + bj * 128 + n * 16); gn[mm * 4 + bj * 2 + n] = *(const u32x2*)(zr + 2048 + bj * 128 + n * 16); } }
            __builtin_amdgcn_sched_barrier(0);
#pragma unroll
            for (int mm = 0; mm < 2; ++mm)
#pragma unroll
                for (int bj = 0; bj < 2; ++bj)
#pragma unroll
                    for (int n = 0; n < 2; ++n) { const u32x2 p = gp[mm * 4 + bj * 2 + n], q = gn[mm * 4 + bj * 2 + n];
                        f32x4 r;
                        r[0] = __uint_as_float(p.x << 16) * __builtin_amdgcn_rcpf(__uint_as_float(q.x << 16)); r[1] = __uint_as_float(p.x & 0xffff0000u) * __builtin_amdgcn_rcpf(__uint_as_float(q.x & 0xffff0000u));
                        r[2] = __uint_as_float(p.y << 16) * __builtin_amdgcn_rcpf(__uint_as_float(q.y << 16)); r[3] = __uint_as_float(p.y & 0xffff0000u) * __builtin_amdgcn_rcpf(__uint_as_float(q.y & 0xffff0000u));
                        acc[ai][bj][mp * 2 + mm][n] *= r; }
            __builtin_amdgcn_sched_barrier(0); }
}
__device__ __forceinline__ void gemm_phase(LAS unsigned char* lds, const Gemm& g, const StaticOrder& S) {
    const int tid = TIDX(), wid = __builtin_amdgcn_readfirstlane(tid >> 6), lane = tid & 63, wr = wid >> 2, wc = wid & 3, fr = lane & 15, fq = lane >> 4;
    const int K = g.K, nt = K / BK;
    unsigned voffA[2], voffB[2];
#pragma unroll
    for (int i = 0; i < 2; ++i) { int R, C; stage_rc(tid * 16 + i * 8192, R, C); const int Rb = g.perm ? ((R & ~31) + perm32(R & 31)) : R;
        voffA[i] = (unsigned)(R * g.lda + C) * 2u; voffB[i] = (unsigned)(Rb * g.ldb + C) * 2u; }
    const size_t kstep = (size_t)(BK * 2);
    const size_t hstepA = (size_t)HALF * g.lda * 2, hstepB = (size_t)HALF * g.ldb * 2;
    const size_t tstepA = 2 * hstepA, tstepB = 2 * hstepB;
    const unsigned ldsw = (unsigned)wid * 1024u;
    const int aoff = lds_byte(wr * 64 + fr, fq * 8), boff = lds_byte(wc * 32 + fr, fq * 8);
#define PG8_SA(b, h) (((b) * 2 + (h)) * HTB)
#define PG8_SB(b, h) ((4 + (b) * 2 + (h)) * HTB)
#define PG8_STAGE(bufoff, gbase, voff) do { _Pragma("unroll") for (int _i = 0; _i < 2; ++_i) \
        __builtin_amdgcn_global_load_lds((const unsigned*)((const char*)(gbase) + (voff)[_i]), (LAS unsigned*)(lds + (bufoff) + ldsw + _i * 8192), 16, 0, 0); } while (0)
#define PG8_LDA(dst, b, h) do { _Pragma("unroll") for (int m = 0; m < 4; ++m) _Pragma("unroll") for (int k = 0; k < 2; ++k) dst[m][k] = *(const LAS bf16x8*)(lds + PG8_SA(b, h) + aoff + m * 2048 + k * 1024); } while (0)
#define PG8_LDB(dst, b, h) do { _Pragma("unroll") for (int n = 0; n < 2; ++n) _Pragma("unroll") for (int k = 0; k < 2; ++k) dst[n][k] = *(const LAS bf16x8*)(lds + PG8_SB(b, h) + boff + n * 2048 + k * 1024); } while (0)
#define PG8_MMA(ai, bj, At, Bt) do { __builtin_amdgcn_s_setprio(1); _Pragma("unroll") for (int m = 0; m < 4; ++m) _Pragma("unroll") for (int n = 0; n < 2; ++n) _Pragma("unroll") for (int k = 0; k < 2; ++k) \
        acc[ai][bj][m][n] = __builtin_amdgcn_mfma_f32_16x16x32_bf16(Bt[n][k], At[m][k], acc[ai][bj][m][n], 0, 0, 0); __builtin_amdgcn_s_setprio(0); } while (0)
#define PG8_WAIT_V(n) asm volatile("s_waitcnt vmcnt(" #n ")" ::: "memory")
#define PG8_WAIT_L(n) asm volatile("s_waitcnt lgkmcnt(" #n ")" ::: "memory")
#define PG8_BAR __builtin_amdgcn_s_barrier()
#define PG8_SCHED __builtin_amdgcn_sched_barrier(0)
    Unit cur, nxt; int ui = 0;
    if (!S.next(0, cur)) return;
    f32x4 acc[2][2][4][2];
    { const float z = OZ();
#pragma unroll
    for (int a = 0; a < 2; ++a)
#pragma unroll
        for (int b = 0; b < 2; ++b)
#pragma unroll
            for (int m = 0; m < 4; ++m)
#pragma unroll
                for (int n = 0; n < 2; ++n) acc[a][b][m][n] = (f32x4){z, z, z, z}; }
    bf16x8 At[4][2], B0[2][2], B1[2][2];
    const char* cA = (const char*)g.A + (size_t)cur.pm * tstepA; const char* cB = (const char*)g.Bt + (size_t)cur.pn * tstepB;
    PG8_STAGE(PG8_SB(0, 0), cB, voffB); PG8_STAGE(PG8_SA(0, 0), cA, voffA); PG8_STAGE(PG8_SB(0, 1), cB + hstepB, voffB); PG8_STAGE(PG8_SA(0, 1), cA + hstepA, voffA);
    if (wr == 1) PG8_BAR;
    PG8_WAIT_V(4); PG8_BAR;
    PG8_STAGE(PG8_SB(1, 0), cB + kstep, voffB); PG8_STAGE(PG8_SA(1, 0), cA + kstep, voffA); PG8_STAGE(PG8_SB(1, 1), cB + hstepB + kstep, voffB);
    PG8_WAIT_V(6); PG8_BAR;
    for (;;) {
        const bool has_next = S.next(ui + 1, nxt);
        const char* nA = has_next ? (const char*)g.A + (size_t)nxt.pm * tstepA : cA; const char* nB = has_next ? (const char*)g.Bt + (size_t)nxt.pn * tstepB : cB;
        for (int t = 0; t < nt; t += 2) {
            if (g.epi == 11 && (t == 16 || t == 24)) up_rescale(acc, cur, wr, wc, fr, fq, t == 16 ? 0 : 2048);
            const bool last = (t == nt - 2);
            const char* a1 = cA + (size_t)(t + 1) * kstep;
            const char* a2 = last ? nA : cA + (size_t)(t + 2) * kstep; const char* b2 = last ? nB : cB + (size_t)(t + 2) * kstep;
            const char* a3 = a2 + kstep; const char* b3 = b2 + kstep;
            PG8_LDB(B0, 0, 0); PG8_SCHED; PG8_LDA(At, 0, 0); PG8_STAGE(PG8_SA(1, 1), a1 + hstepA, voffA);
            PG8_WAIT_L(8); PG8_BAR; PG8_WAIT_L(0); PG8_MMA(0, 0, At, B0); PG8_BAR; PG8_SCHED;
            PG8_LDB(B1, 0, 1); PG8_STAGE(PG8_SB(0, 0), b2, voffB);
            PG8_BAR; PG8_WAIT_L(0); PG8_MMA(0, 1, At, B1); PG8_BAR;
            PG8_LDA(At, 0, 1); PG8_STAGE(PG8_SA(0, 0), a2, voffA);
            PG8_BAR; PG8_WAIT_L(0); PG8_MMA(1, 0, At, B0); PG8_BAR; PG8_SCHED;
            PG8_STAGE(PG8_SB(0, 1), b2 + hstepB, voffB);
            PG8_WAIT_V(6); PG8_BAR; PG8_MMA(1, 1, At, B1); PG8_BAR;
            PG8_LDB(B0, 1, 0); PG8_SCHED; PG8_LDA(At, 1, 0); PG8_STAGE(PG8_SA(0, 1), a2 + hstepA, voffA);
            PG8_WAIT_L(8); PG8_BAR; PG8_WAIT_L(0); PG8_MMA(0, 0, At, B0); PG8_BAR; PG8_SCHED;
            PG8_LDB(B1, 1, 1); PG8_STAGE(PG8_SB(1, 0), b3, voffB);
            PG8_BAR; PG8_WAIT_L(0); PG8_MMA(0, 1, At, B1); PG8_BAR;
            PG8_LDA(At, 1, 1); PG8_STAGE(PG8_SA(1, 0), a3, voffA);
            PG8_BAR; PG8_WAIT_L(0); PG8_MMA(1, 0, At, B0); PG8_BAR; PG8_SCHED;
            PG8_STAGE(PG8_SB(1, 1), b3 + hstepB, voffB);
            PG8_WAIT_V(6); PG8_BAR; PG8_MMA(1, 1, At, B1); PG8_BAR;
        }
        epi_run(g, acc, cur, wr, wc, fr, fq);
        if (!has_next) break;
        { const float z = OZ();
#pragma unroll
        for (int a = 0; a < 2; ++a)
#pragma unroll
            for (int b = 0; b < 2; ++b)
#pragma unroll
                for (int m = 0; m < 4; ++m)
#pragma unroll
                    for (int n = 0; n < 2; ++n) acc[a][b][m][n] = (f32x4){z, z, z, z}; }
        cur = nxt; cA = nA; cB = nB; ++ui;
    }
    PG8_WAIT_V(0);
    if (wr == 0) PG8_BAR;
    PG8_BAR;
#undef PG8_SA
#undef PG8_SB
#undef PG8_STAGE
#undef PG8_LDA
#undef PG8_LDB
#undef PG8_MMA
#undef PG8_WAIT_V
#undef PG8_WAIT_L
#undef PG8_BAR
#undef PG8_SCHED
}
}
using pg8::Unit;
using pg8::cvt_pk_bf16;

#define EPI_FOR_NP(...) \
    _Pragma("unroll") for (int ai = 0; ai < 2; ++ai) _Pragma("unroll") for (int m = 0; m < 4; ++m) { const int row = u.pm * 256 + ai * 128 + wr * 64 + m * 16 + fr; \
    _Pragma("unroll") for (int bj = 0; bj < 2; ++bj) _Pragma("unroll") for (int n = 0; n < 2; ++n) { const int col = u.pn * 256 + bj * 128 + wc * 32 + n * 16 + 4 * fq; const f32x4 v = acc[ai][bj][m][n]; __VA_ARGS__ } }

typedef const f32x4 (&AccRef)[2][2][4][2];
#define EPI_GRP8(...) \
    _Pragma("unroll") for (int mm = 0; mm < 2; ++mm) _Pragma("unroll") for (int bj = 0; bj < 2; ++bj) _Pragma("unroll") for (int n = 0; n < 2; ++n) { \
        const int idx = mm * 4 + bj * 2 + n; const int row = u.pm * 256 + ai * 128 + wr * 64 + (mp * 2 + mm) * 16 + fr; const int col = u.pn * 256 + bj * 128 + wc * 32 + n * 16 + 4 * fq; \
        const f32x4 v = acc[ai][bj][mp * 2 + mm][n]; (void)idx; (void)row; (void)col; (void)v; __VA_ARGS__ }
#define EPI_GROUPS _Pragma("unroll") for (int ai = 0; ai < 2; ++ai) _Pragma("unroll") for (int mp = 0; mp < 2; ++mp)

struct EpiWin {
    static constexpr bool PERM = false;
    bh* zg; float* zf;
    __device__ __forceinline__ void operator()(AccRef acc, const Unit& u, int wr, int wc, int fr, int fq) const {
        if (u.pn < 24) {
            EPI_FOR_NP({ u32x2 w; w.x = cvt_pk_bf16(fmaxf(sigmoidf_(v[0]), 1e-6f), fmaxf(sigmoidf_(v[1]), 1e-6f)); w.y = cvt_pk_bf16(fmaxf(sigmoidf_(v[2]), 1e-6f), fmaxf(sigmoidf_(v[3]), 1e-6f)); *(u32x2*)(zg + (size_t)row * NGATE + col) = w; })
        } else {
            EPI_FOR_NP({ *(f32x4*)(zf + (size_t)row * ZF_LD + (col - NGATE)) = v; })
        }
    }
};
struct EpiLoraW {
    static constexpr bool PERM = false;
    const float* w0; float* rw;
    __device__ __forceinline__ void operator()(AccRef acc, const Unit& u, int wr, int wc, int fr, int fq) const {
        f32x4 bb[2][2];
#pragma unroll
        for (int bj = 0; bj < 2; ++bj)
#pragma unroll
            for (int n = 0; n < 2; ++n) bb[bj][n] = *(const f32x4*)(w0 + u.pn * 256 + bj * 128 + wc * 32 + n * 16 + 4 * fq);
        __builtin_amdgcn_sched_barrier(0);
        EPI_FOR_NP({ const f32x4 b = bb[bj][n]; f32x4 o;
            _Pragma("unroll") for (int j = 0; j < 4; ++j) { const float x = -(b[j] + v[j]); const float sp = fmaxf(x, 0.f) + __logf(1.0f + __expf(-fabsf(x))); o[j] = __expf(-__expf(-sp - 0.5f)); }
            *(f32x4*)(rw + (size_t)row * 512 + col) = o; })
    }
};
struct EpiLoraA {
    static constexpr bool PERM = false;
    const float* a0; const float* ka; const float* rkk; float* rb; float* rk;
    __device__ __forceinline__ void operator()(AccRef acc, const Unit& u, int wr, int wc, int fr, int fq) const {
        f32x4 b0s[2][2], kas[2][2];
#pragma unroll
        for (int bj = 0; bj < 2; ++bj)
#pragma unroll
            for (int n = 0; n < 2; ++n) { const int c0 = u.pn * 256 + bj * 128 + wc * 32 + n * 16 + 4 * fq; b0s[bj][n] = *(const f32x4*)(a0 + c0); kas[bj][n] = *(const f32x4*)(ka + c0); }
#pragma unroll
        for (int ai = 0; ai < 2; ++ai)
#pragma unroll
            for (int m = 0; m < 4; ++m) { const int row = u.pm * 256 + ai * 128 + wr * 64 + m * 16 + fr; f32x4 kkq[4], kq[4];
#pragma unroll
                for (int bj = 0; bj < 2; ++bj)
#pragma unroll
                    for (int n = 0; n < 2; ++n) { const size_t o = (size_t)row * 512 + u.pn * 256 + bj * 128 + wc * 32 + n * 16 + 4 * fq; kkq[bj * 2 + n] = *(const f32x4*)(rkk + o); kq[bj * 2 + n] = *(const f32x4*)(rk + o); }
                __builtin_amdgcn_sched_barrier(0);
#pragma unroll
                for (int bj = 0; bj < 2; ++bj)
#pragma unroll
                    for (int n = 0; n < 2; ++n) { const size_t o = (size_t)row * 512 + u.pn * 256 + bj * 128 + wc * 32 + n * 16 + 4 * fq;
                        const f32x4 v = acc[ai][bj][m][n]; const f32x4 b0 = b0s[bj][n]; const f32x4 kav = kas[bj][n]; const f32x4 kkv = kkq[bj * 2 + n]; f32x4 kv = kq[bj * 2 + n]; f32x4 bo;
                        _Pragma("unroll") for (int j = 0; j < 4; ++j) { const float a = sigmoidf_(b0[j] + v[j]); bo[j] = -(kkv[j] * a); kv[j] = kv[j] * (1.0f + (a - 1.0f) * kav[j]); }
                        *(f32x4*)(rb + o) = bo; *(f32x4*)(rk + o) = kv; }
                __builtin_amdgcn_sched_barrier(0); }
    }
};
struct EpiStoreF32 {
    static constexpr bool PERM = false;
    float* o; int ld;
    __device__ __forceinline__ void operator()(AccRef acc, const Unit& u, int wr, int wc, int fr, int fq) const {
        EPI_FOR_NP({ *(f32x4*)(o + (size_t)row * ld + col) = v; })
    }
};
struct EpiGlu {
    static constexpr bool PERM = false;
    const bh* ys; const float* gb; bh* ycat;
    __device__ __forceinline__ void operator()(AccRef acc, const Unit& u, int wr, int wc, int fr, int fq) const {
        f32x4 gbs[2][2];
#pragma unroll
        for (int bj = 0; bj < 2; ++bj)
#pragma unroll
            for (int n = 0; n < 2; ++n) gbs[bj][n] = *(const f32x4*)(gb + u.pn * 256 + bj * 128 + wc * 32 + n * 16 + 4 * fq);
        EPI_GROUPS { u32x2 yq[8];
            EPI_GRP8({ yq[idx] = *(const u32x2*)(ys + (size_t)row * 512 + col); })
            __builtin_amdgcn_sched_barrier(0);
            EPI_GRP8({ const f32x4 b = gbs[bj][n]; const u32x2 y2 = yq[idx];
                const float y0 = __uint_as_float(y2.x << 16), y1 = __uint_as_float(y2.x & 0xffff0000u), y2f = __uint_as_float(y2.y << 16), y3 = __uint_as_float(y2.y & 0xffff0000u);
                u32x2 w; w.x = cvt_pk_bf16(y0 * sigmoidf_(v[0] + b[0]), y1 * sigmoidf_(v[1] + b[1])); w.y = cvt_pk_bf16(y2f * sigmoidf_(v[2] + b[2]), y3 * sigmoidf_(v[3] + b[3]));
                *(u32x2*)(ycat + (size_t)row * D + 1536 + col) = w; })
            __builtin_amdgcn_sched_barrier(0); }
    }
};
template <int MODE> struct EpiUp {
    static constexpr bool PERM = false;
    const bh* zg; float* mix; bh* mixed;
    __device__ __forceinline__ void operator()(AccRef acc, const Unit& u, int wr, int wc, int fr, int fq) const {
        EPI_FOR_NP({ const u32x2 g2 = *(const u32x2*)(zg + (size_t)row * NGATE + col);
            f32x4 g; g[0] = __uint_as_float(g2.x << 16); g[1] = __uint_as_float(g2.x & 0xffff0000u); g[2] = __uint_as_float(g2.y << 16); g[3] = __uint_as_float(g2.y & 0xffff0000u);
            f32x4 r = g * v; float* mp = mix + (size_t)row * D + col;
            if (MODE >= 1) r += *(const f32x4*)mp;
            if (MODE <= 1) *(f32x4*)mp = r;
            else { u32x2 w; w.x = cvt_pk_bf16(r[0], r[1]); w.y = cvt_pk_bf16(r[2], r[3]); *(u32x2*)(mixed + (size_t)row * D + col) = w; } })
    }
};
struct EpiUpF {
    static constexpr bool PERM = false;
    const bh* zg; bh* mixed;
    __device__ __forceinline__ void operator()(AccRef acc, const Unit& u, int wr, int wc, int fr, int fq) const {
#pragma unroll
        for (int ai = 0; ai < 2; ++ai) { u32x2 gg[16];
#pragma unroll
            for (int m = 0; m < 4; ++m)
#pragma unroll
                for (int bj = 0; bj < 2; ++bj)
#pragma unroll
                    for (int n = 0; n < 2; ++n) gg[m * 4 + bj * 2 + n] = *(const u32x2*)(zg + (size_t)(u.pm * 256 + ai * 128 + wr * 64 + m * 16 + fr) * NGATE + u.pn * 256 + bj * 128 + wc * 32 + n * 16 + 4 * fq);
            __builtin_amdgcn_sched_barrier(0);
#pragma unroll
            for (int m = 0; m < 4; ++m)
#pragma unroll
                for (int bj = 0; bj < 2; ++bj)
#pragma unroll
                    for (int n = 0; n < 2; ++n) { const u32x2 g2 = gg[m * 4 + bj * 2 + n]; const f32x4 v = acc[ai][bj][m][n];
                        u32x2 w; w.x = cvt_pk_bf16(__uint_as_float(g2.x << 16) * v[0], __uint_as_float(g2.x & 0xffff0000u) * v[1]); w.y = cvt_pk_bf16(__uint_as_float(g2.y << 16) * v[2], __uint_as_float(g2.y & 0xffff0000u) * v[3]);
                        *(u32x2*)(mixed + (size_t)(u.pm * 256 + ai * 128 + wr * 64 + m * 16 + fr) * D + u.pn * 256 + bj * 128 + wc * 32 + n * 16 + 4 * fq) = w; }
            __builtin_amdgcn_sched_barrier(0); }
    }
};
struct EpiRes {
    static constexpr bool PERM = false;
    float* h;
    __device__ __forceinline__ void operator()(AccRef acc, const Unit& u, int wr, int wc, int fr, int fq) const {
#pragma unroll
        for (int ai = 0; ai < 2; ++ai)
#pragma unroll
            for (int mp = 0; mp < 2; ++mp) { f32x4 hv[8];
#pragma unroll
                for (int mm = 0; mm < 2; ++mm)
#pragma unroll
                    for (int bj = 0; bj < 2; ++bj)
#pragma unroll
                        for (int n = 0; n < 2; ++n) hv[mm * 4 + bj * 2 + n] = *(const f32x4*)(h + (size_t)(u.pm * 256 + ai * 128 + wr * 64 + (mp * 2 + mm) * 16 + fr) * D + u.pn * 256 + bj * 128 + wc * 32 + n * 16 + 4 * fq);
                __builtin_amdgcn_sched_barrier(0);
#pragma unroll
                for (int mm = 0; mm < 2; ++mm)
#pragma unroll
                    for (int bj = 0; bj < 2; ++bj)
#pragma unroll
                        for (int n = 0; n < 2; ++n) *(f32x4*)(h + (size_t)(u.pm * 256 + ai * 128 + wr * 64 + (mp * 2 + mm) * 16 + fr) * D + u.pn * 256 + bj * 128 + wc * 32 + n * 16 + 4 * fq) = hv[mm * 4 + bj * 2 + n] + acc[ai][bj][mp * 2 + mm][n];
                __builtin_amdgcn_sched_barrier(0); }
    }
};
struct EpiFfn {
    static constexpr bool PERM = true;
    bh* act;
    __device__ __forceinline__ void operator()(AccRef acc, const Unit& u, int wr, int wc, int fr, int fq) const {
#pragma unroll
        for (int ai = 0; ai < 2; ++ai)
#pragma unroll
            for (int m = 0; m < 4; ++m) { const int row = u.pm * 256 + ai * 128 + wr * 64 + m * 16 + fr; const int col = u.pn * 128 + wc * 32 + 8 * fq;
                float o[8];
#pragma unroll
                for (int n = 0; n < 2; ++n)
#pragma unroll
                    for (int j = 0; j < 4; ++j) { const float gte = acc[ai][0][m][n][j], up = acc[ai][1][m][n][j]; o[n * 4 + j] = gte * sigmoidf_(gte) * up; }
                u32x4 w; w.x = cvt_pk_bf16(o[0], o[1]); w.y = cvt_pk_bf16(o[2], o[3]); w.z = cvt_pk_bf16(o[4], o[5]); w.w = cvt_pk_bf16(o[6], o[7]);
                *(u32x4*)(act + (size_t)row * FH + col) = w; }
    }
};
struct EpiPle {
    static constexpr bool PERM = false;
    float* h; const float* tmp;
    __device__ __forceinline__ void operator()(AccRef acc, const Unit& u, int wr, int wc, int fr, int fq) const {
#pragma unroll
        for (int ai = 0; ai < 2; ++ai)
#pragma unroll
            for (int mp = 0; mp < 2; ++mp) { f32x4 hv[8], tv[8];
#pragma unroll
                for (int mm = 0; mm < 2; ++mm)
#pragma unroll
                    for (int bj = 0; bj < 2; ++bj)
#pragma unroll
                        for (int n = 0; n < 2; ++n) { const size_t o = (size_t)(u.pm * 256 + ai * 128 + wr * 64 + (mp * 2 + mm) * 16 + fr) * D + u.pn * 256 + bj * 128 + wc * 32 + n * 16 + 4 * fq;
                            hv[mm * 4 + bj * 2 + n] = *(const f32x4*)(h + o); tv[mm * 4 + bj * 2 + n] = *(const f32x4*)(tmp + o); }
                __builtin_amdgcn_sched_barrier(0);
#pragma unroll
                for (int mm = 0; mm < 2; ++mm)
#pragma unroll
                    for (int bj = 0; bj < 2; ++bj)
#pragma unroll
                        for (int n = 0; n < 2; ++n) { const size_t o = (size_t)(u.pm * 256 + ai * 128 + wr * 64 + (mp * 2 + mm) * 16 + fr) * D + u.pn * 256 + bj * 128 + wc * 32 + n * 16 + 4 * fq;
                            f32x4 r = hv[mm * 4 + bj * 2 + n]; const f32x4 v = acc[ai][bj][mp * 2 + mm][n]; const f32x4 t4 = tv[mm * 4 + bj * 2 + n];
                            _Pragma("unroll") for (int j = 0; j < 4; ++j) r[j] += t4[j] * sigmoidf_(v[j]);
                            *(f32x4*)(h + o) = r; }
                __builtin_amdgcn_sched_barrier(0); }
    }
};

namespace pg8 {
__device__ __forceinline__ void epi_run(const Gemm& g, const f32x4 (&acc)[2][2][4][2], const Unit& u, int wr, int wc, int fr, int fq) {
    unsigned char* ws = P_WS; const int L = g.L;
    switch (g.epi) {
    case 0: { EpiWin E{(bh*)(ws + OFF_ZG), (float*)(ws + OFF_ZF)}; E(acc, u, wr, wc, fr, fq); } break;
    case 1: { EpiLoraW E{P_IN(9) + L * 512, (float*)(ws + OFF_RW)}; E(acc, u, wr, wc, fr, fq); } break;
    case 2: { EpiLoraA E{P_IN(11) + L * 512, P_IN(15) + L * 512, (const float*)(ws + OFF_RKK), (float*)(ws + OFF_RB), (float*)(ws + OFF_RK)}; E(acc, u, wr, wc, fr, fq); } break;
    case 3: { EpiStoreF32 E{(float*)(ws + (g.N == 512 ? OFF_RG : OFF_MIX32)), g.N}; E(acc, u, wr, wc, fr, fq); } break;
    case 4: { EpiGlu E{(const bh*)(ws + OFF_YS), P_IN(28) + L * 512, (bh*)(ws + OFF_YCAT)}; E(acc, u, wr, wc, fr, fq); } break;
    case 5: { EpiUp<0> E{(const bh*)(ws + OFF_ZG), (float*)(ws + OFF_MIX32), (bh*)(ws + OFF_ABF)}; E(acc, u, wr, wc, fr, fq); } break;
    case 6: { EpiUp<1> E{(const bh*)(ws + OFF_ZG) + 2048, (float*)(ws + OFF_MIX32), (bh*)(ws + OFF_ABF)}; E(acc, u, wr, wc, fr, fq); } break;
    case 7: { EpiUp<2> E{(const bh*)(ws + OFF_ZG) + 4096, (float*)(ws + OFF_MIX32), (bh*)(ws + OFF_ABF)}; E(acc, u, wr, wc, fr, fq); } break;
    case 8: { EpiRes E{P_OUT}; E(acc, u, wr, wc, fr, fq); } break;
    case 9: { EpiFfn E{(bh*)(ws + OFF_ACT)}; E(acc, u, wr, wc, fr, fq); } break;
    case 11: { EpiUpF E{(const bh*)(ws + OFF_ZG) + 4096, (bh*)(ws + OFF_ABF)}; E(acc, u, wr, wc, fr, fq); } break;
    default: { EpiPle E{P_OUT, (const float*)(ws + OFF_MIX32)}; E(acc, u, wr, wc, fr, fq); } break;
    }
}
}

__device__ __forceinline__ bool make_gemm(const Params& p, int L, int q, int i, pg8::Gemm& g) {
    unsigned char* ws = P_WS;
    g.M = T; g.perm = 0; g.L = L;
    switch (q) {
    case 1: if (i > 0) return false;
        g.A = (const bh*)(ws + OFF_ABF); g.lda = D; g.Bt = (const bh*)(ws + OFF_WIN); g.ldb = D; g.N = NINP; g.K = D; g.epi = 0; return true;
    case 3: if (i > 2) return false;
        g.lda = 256; g.ldb = 256; g.N = 512; g.K = 256;
        if (i == 0) { g.A = (const bh*)(ws + OFF_LAW); g.Bt = (const bh*)(ws + OFF_WW2); g.epi = 1; }
        else if (i == 1) { g.A = (const bh*)(ws + OFF_LAA); g.Bt = (const bh*)(ws + OFF_WA2); g.epi = 2; }
        else { g.A = (const bh*)(ws + OFF_LAG); g.Bt = (const bh*)(ws + OFF_WG2); g.epi = 3; }
        return true;
    case 5: if (i > 0) return false;
        g.A = (const bh*)(ws + OFF_YS); g.lda = 512; g.Bt = (const bh*)(ws + OFF_WGLU); g.ldb = 512; g.N = 512; g.K = 512; g.epi = 4; return true;
    case 6: if (i > 0) return false;
        g.A = (const bh*)(ws + OFF_YCAT); g.lda = D; g.Bt = (const bh*)(ws + OFF_WUP); g.ldb = D; g.N = D; g.K = D; g.epi = 11; return true;
    case 7: if (i > 0) return false;
        g.A = (const bh*)(ws + OFF_ABF); g.lda = D; g.Bt = (const bh*)(ws + OFF_WO); g.ldb = D; g.N = D; g.K = D; g.epi = 8; return true;
    case 9: if (i > 0) return false;
        g.A = (const bh*)(ws + OFF_ABF); g.lda = D; g.Bt = (const bh*)(ws + OFF_WGU); g.ldb = D; g.N = 2 * FH; g.K = D; g.epi = 9; g.perm = 1; return true;
    case 10: if (i > 0) return false;
        g.A = (const bh*)(ws + OFF_ACT); g.lda = FH; g.Bt = (const bh*)(ws + OFF_WD); g.ldb = FH; g.N = D; g.K = FH; g.epi = 8; return true;
    case 12: if (i > 1) return false;
        if (i == 0) { g.A = (const bh*)(ws + OFF_PBF) + (size_t)L * T * 256; g.lda = 256; g.Bt = (const bh*)(ws + OFF_WPP); g.ldb = 256; g.N = D; g.K = 256; g.epi = 3; }
        else { g.A = (const bh*)(ws + OFF_ABF); g.lda = D; g.Bt = (const bh*)(ws + OFF_WPG); g.ldb = D; g.N = D; g.K = D; g.epi = 10; }
        return true;
    default: return false;
    }
}

struct CJ { const float* src; int in_idx, src_ld, kv, n0, nv; long lstride; size_t dst; int dst_ld, r0, c0, npad, kpad, seg, segstride; };
constexpr int BIGSEG = 1 << 30;
__constant__ int JT_I[15][12] = {
    {3, NIN, 2048, NF, NGATE, D, 0, 0, NGATE, 2048, BIGSEG, 0},
    {3, NIN, 2048, 0, NF, D, NGATE, 0, 6656, 2048, BIGSEG, 0},
    {29, D, 1024, 0, D, D, 0, 0, D, 1024, BIGSEG, 0},
    {30, D, 512, 0, D, D, 0, 1024, D, 512, BIGSEG, 0},
    {31, D, 512, 0, D, D, 0, 1536, D, 512, BIGSEG, 0},
    {32, D, 2048, 0, D, D, 0, 0, D, 2048, BIGSEG, 0},
    {34, FH, 2048, 0, FH, D, 0, 0, FH, 2048, 128, 256},
    {35, FH, 2048, 0, FH, D, 128, 0, FH, 2048, 128, 256},
    {36, D, FH, 0, D, FH, 0, 0, D, FH, BIGSEG, 0},
    {38, D, 2048, 0, D, D, 0, 0, D, 2048, BIGSEG, 0},
    {39, D, 256, 0, D, 256, 0, 0, D, 256, BIGSEG, 0},
    {27, 512, 512, 0, 512, 512, 0, 0, 512, 512, BIGSEG, 0},
    {10, 512, 96, 0, 512, 256, 0, 0, 512, 256, BIGSEG, 0},
    {12, 512, 96, 0, 512, 256, 0, 0, 512, 256, BIGSEG, 0},
    {13, 512, 256, 0, 512, 256, 0, 0, 512, 256, BIGSEG, 0}};
__constant__ long JT_L[15][2] = {
    {(long)D * NIN, (long)OFF_WIN}, {(long)D * NIN, (long)OFF_WIN}, {(long)1024 * D, (long)OFF_WUP}, {(long)512 * D, (long)OFF_WUP}, {(long)512 * D, (long)OFF_WUP},
    {(long)D * D, (long)OFF_WO}, {(long)D * FH, (long)OFF_WGU}, {(long)D * FH, (long)OFF_WGU}, {(long)FH * D, (long)OFF_WD}, {(long)D * D, (long)OFF_WPG},
    {(long)256 * D, (long)OFF_WPP}, {(long)512 * 512, (long)OFF_WGLU}, {(long)96 * 512, (long)OFF_WW2}, {(long)96 * 512, (long)OFF_WA2}, {(long)256 * 512, (long)OFF_WG2}};
__device__ __forceinline__ void get_job(int j, CJ& J) {
    J.in_idx = JT_I[j][0]; J.src_ld = JT_I[j][1]; J.kv = JT_I[j][2]; J.n0 = JT_I[j][3]; J.nv = JT_I[j][4]; J.dst_ld = JT_I[j][5]; J.r0 = JT_I[j][6]; J.c0 = JT_I[j][7];
    J.npad = JT_I[j][8]; J.kpad = JT_I[j][9]; J.seg = JT_I[j][10]; J.segstride = JT_I[j][11]; J.lstride = JT_L[j][0]; J.dst = (size_t)JT_L[j][1];
}
__device__ __forceinline__ const float* in_by_idx(const Params& p, int i) { return P_IN(i); }
constexpr int NJOBS = 15;

__device__ __forceinline__ void conv_load(int L, const CJ& J, int tile, int lane, f32x4 (&v)[16]) {
    const int nkt = J.kpad / 64; const int tn = tile / nkt, tk = tile % nkt;
    const float* src = J.src + (size_t)L * J.lstride;
    const int cq = lane & 15, r = lane >> 4;
    const int nl = tn * 64 + cq * 4; const bool nok = nl < J.nv;
    const int k0 = tk * 64 + 16 * r;
    const float* sp = src + (size_t)k0 * J.src_ld + J.n0 + nl;
    const float zc = OZ();
#pragma unroll
    for (int i = 0; i < 16; ++i) { v[i] = (f32x4){zc, zc, zc, zc}; if (nok && (k0 + i) < J.kv) v[i] = *(const f32x4*)(sp + (size_t)i * J.src_ld); }
}
__device__ __forceinline__ void conv_store(const CJ& J, int tile, int lane, const f32x4 (&v)[16], bh* dstbase) {
    const int nkt = J.kpad / 64; const int tn = tile / nkt, tk = tile % nkt;
    const int cq = lane & 15, r = lane >> 4;
    const int nl = tn * 64 + cq * 4; const int k0 = tk * 64 + 16 * r;
#pragma unroll
    for (int j = 0; j < 4; ++j) { const int n = nl + j; const int drow = J.r0 + (n / J.seg) * J.segstride + (n % J.seg);
        u32x4 w0, w1;
        w0.x = cvt_pk_bf16(v[0][j], v[1][j]); w0.y = cvt_pk_bf16(v[2][j], v[3][j]); w0.z = cvt_pk_bf16(v[4][j], v[5][j]); w0.w = cvt_pk_bf16(v[6][j], v[7][j]);
        w1.x = cvt_pk_bf16(v[8][j], v[9][j]); w1.y = cvt_pk_bf16(v[10][j], v[11][j]); w1.z = cvt_pk_bf16(v[12][j], v[13][j]); w1.w = cvt_pk_bf16(v[14][j], v[15][j]);
        bh* d = dstbase + (size_t)drow * J.dst_ld + J.c0 + k0;
        *(u32x4*)d = w0; *(u32x4*)(d + 8) = w1; }
}
__device__ __forceinline__ void conv_tiles(int L, const CJ& J, int first, int ntile, int stride, int lane, bh* dstbase) {
    for (int t = first; t < ntile; t += 2 * stride) {
        f32x4 va[16], vb[16]; const bool hasb = (t + stride) < ntile;
        conv_load(L, J, t, lane, va);
        if (hasb) conv_load(L, J, t + stride, lane, vb);
        __builtin_amdgcn_sched_barrier(0);
        conv_store(J, t, lane, va, dstbase);
        if (hasb) conv_store(J, t + stride, lane, vb, dstbase);
    }
}

__device__ __forceinline__ void rms_row_bf16(const float* x, const float* g, bh* o, int lane) {
    f32x4 v[8]; float s = 0.f;
#pragma unroll
    for (int j = 0; j < 8; ++j) { v[j] = *(const f32x4*)(x + j * 256 + lane * 4); s += (v[j][0] * v[j][0] + v[j][1] * v[j][1]) + (v[j][2] * v[j][2] + v[j][3] * v[j][3]); }
    const float rstd = rsqrtf(wave_sum(s) * (1.0f / D) + 1e-6f);
#pragma unroll
    for (int j = 0; j < 8; ++j) { const f32x4 gg = *(const f32x4*)(g + j * 256 + lane * 4); u32x2 w; w.x = pk2(v[j][0] * rstd * gg[0], v[j][1] * rstd * gg[1]); w.y = pk2(v[j][2] * rstd * gg[2], v[j][3] * rstd * gg[3]);
        *(u32x2*)(o + j * 256 + lane * 4) = w; }
}
__device__ __forceinline__ void phase_rmsnorm(const Params& p, const float* g) {
    const int gw = BIDX() * 8 + (TIDX() >> 6), NGW = GDIM() * 8, lane = TIDX() & 63;
    bh* abf = (bh*)(P_WS + OFF_ABF);
    f32x4 gg[8];
#pragma unroll
    for (int j = 0; j < 8; ++j) gg[j] = *(const f32x4*)(g + j * 256 + lane * 4);
    for (int r = gw; r < T; r += 2 * NGW) {
        const int r2 = r + NGW; const bool has2 = r2 < T;
        f32x4 va[8], vb[8]; float sa = 0.f, sb = 0.f;
#pragma unroll
        for (int j = 0; j < 8; ++j) { va[j] = *(const f32x4*)(P_OUT + (size_t)r * D + j * 256 + lane * 4); vb[j] = has2 ? *(const f32x4*)(P_OUT + (size_t)r2 * D + j * 256 + lane * 4) : va[j]; }
        __builtin_amdgcn_sched_barrier(0);
#pragma unroll
        for (int j = 0; j < 8; ++j) { sa += (va[j][0] * va[j][0] + va[j][1] * va[j][1]) + (va[j][2] * va[j][2] + va[j][3] * va[j][3]); sb += (vb[j][0] * vb[j][0] + vb[j][1] * vb[j][1]) + (vb[j][2] * vb[j][2] + vb[j][3] * vb[j][3]); }
        const float ra = rsqrtf(wave_sum(sa) * (1.0f / D) + 1e-6f), rb = rsqrtf(wave_sum(sb) * (1.0f / D) + 1e-6f);
#pragma unroll
        for (int j = 0; j < 8; ++j) { u32x2 w; w.x = pk2(va[j][0] * ra * gg[j][0], va[j][1] * ra * gg[j][1]); w.y = pk2(va[j][2] * ra * gg[j][2], va[j][3] * ra * gg[j][3]);
            *(u32x2*)(abf + (size_t)r * D + j * 256 + lane * 4) = w; }
        if (has2) {
#pragma unroll
            for (int j = 0; j < 8; ++j) { u32x2 w; w.x = pk2(vb[j][0] * rb * gg[j][0], vb[j][1] * rb * gg[j][1]); w.y = pk2(vb[j][2] * rb * gg[j][2], vb[j][3] * rb * gg[j][3]);
                *(u32x2*)(abf + (size_t)r2 * D + j * 256 + lane * 4) = w; } }
    }
}

__device__ __forceinline__ void phase_conv(const Params& p, int L, LAS unsigned char* lds) {
    const int tid = TIDX();
    {   const int gw0 = BIDX() * 8 + (tid >> 6), NGW0 = GDIM() * 8, ln = tid & 63;
        int base = 0;
        for (int j = 0; j < NJOBS; ++j) { CJ J; get_job(j, J); J.src = in_by_idx(p, J.in_idx); const int ntile = (J.npad / 64) * (J.kpad / 64);
            int first = gw0 - (base % NGW0); if (first < 0) first += NGW0;
            bh* dstbase = (bh*)(P_WS + J.dst);
            conv_tiles(L, J, first, ntile, NGW0, ln, dstbase);
            base += ntile; } }
    const int gw = BIDX() * 8 + (tid >> 6), NGW = GDIM() * 8, lane = tid & 63;
    bh* abf = (bh*)(P_WS + OFF_ABF);
    if (L == 0) {
        const float* ps = P_IN(1); bh* pb = (bh*)(P_WS + OFF_PBF);
        for (size_t i = (size_t)BIDX() * 512 + tid; i < (size_t)2 * T * 256 / 4; i += (size_t)GDIM() * 512) { const f32x4 v = ((const f32x4*)ps)[i]; u32x2 w; w.x = pk2(v[0], v[1]); w.y = pk2(v[2], v[3]); ((u32x2*)pb)[i] = w; }
        const float* x = P_IN(0);
        for (int r = gw; r < T; r += NGW) {
#pragma unroll
            for (int j = 0; j < 8; ++j) *(f32x4*)(P_OUT + (size_t)r * D + j * 256 + lane * 4) = *(const f32x4*)(x + (size_t)r * D + j * 256 + lane * 4);
            rms_row_bf16(x + (size_t)r * D, P_IN(2), abf + (size_t)r * D, lane);
        }
    } else {
        for (int r = gw; r < T; r += NGW) rms_row_bf16(P_OUT + (size_t)r * D, P_IN(2) + (size_t)L * D, abf + (size_t)r * D, lane);
    }
}

struct S5C { float ar, ai; float br[16], bi[16]; };
__device__ __forceinline__ void s5_setup(const Params& p, int L, int g, int n, S5C& c) {
    const int gi = L * 32 + g;
    const float dt = __expf(P_IN(21)[gi]);
    const float are = P_IN(19)[gi * 64 + n], aim = P_IN(20)[gi * 64 + n];
    const float mag = __expf(are * dt), ang = aim * dt;
    float sn, cs;
    {
        const double a = (double)ang; const double k = rint(a * 0.15915494309189535); const float r = (float)(a - k * 6.283185307179586);
        sn = sinf(r); cs = cosf(r);
    }
    c.ar = mag * cs; c.ai = mag * sn;
    const float den = are * are + aim * aim, nr = c.ar - 1.0f, ni = c.ai;
    const float cr = (nr * are + ni * aim) / den, ci = (ni * are - nr * aim) / den;
    const float* bre = P_IN(22) + ((size_t)gi * 64 + n) * 16; const float* bim = P_IN(23) + ((size_t)gi * 64 + n) * 16;
#pragma unroll
    for (int q = 0; q < 4; ++q) { const f32x4 r4 = *(const f32x4*)(bre + q * 4), i4 = *(const f32x4*)(bim + q * 4);
#pragma unroll
        for (int j = 0; j < 4; ++j) { c.br[q * 4 + j] = cr * r4[j] - ci * i4[j]; c.bi[q * 4 + j] = cr * i4[j] + ci * r4[j]; } }
}
__device__ __forceinline__ void s5_step(const S5C& c, const LAS float* urow, float& sr, float& si) {
    float xr = 0.f, xi = 0.f;
#pragma unroll
    for (int q = 0; q < 4; ++q) { const f32x4 u4 = *(const LAS f32x4*)(urow + q * 4);
#pragma unroll
        for (int j = 0; j < 4; ++j) { xr = fmaf(u4[j], c.br[q * 4 + j], xr); xi = fmaf(u4[j], c.bi[q * 4 + j], xi); } }
    const float nr = c.ar * sr - c.ai * si + xr, ni = c.ar * si + c.ai * sr + xi;
    sr = nr; si = ni;
}
__device__ __forceinline__ void s5_stage_u(const float* zfc, LAS float* ul, int lane) {
    const float* src = zfc + (size_t)lane * ZF_LD;
    const f32x4 a = *(const f32x4*)src, b = *(const f32x4*)(src + 4), c = *(const f32x4*)(src + 8), d = *(const f32x4*)(src + 12);
    *(LAS f32x4*)(ul + lane * 16) = a; *(LAS f32x4*)(ul + lane * 16 + 4) = b; *(LAS f32x4*)(ul + lane * 16 + 8) = c; *(LAS f32x4*)(ul + lane * 16 + 12) = d;
    asm volatile("s_waitcnt lgkmcnt(0)" ::: "memory"); __builtin_amdgcn_wave_barrier();
}

__device__ __forceinline__ size_t fq_base(int h, int c, int mt, int ks8) { return ((((size_t)(h * NCH + c) * 4 + mt) * 8 + ks8) * 64) * 8; }
__device__ __forceinline__ size_t fq_off(int h, int t, int d) { const int s = t & 63; return fq_base(h, t >> 6, s >> 4, d >> 5) + ((s & 15) + 16 * ((d >> 3) & 3)) * 8 + (d & 7); }
__device__ __forceinline__ int ft_off(int row, int s8) { return ((((row >> 5) * 4 + (s8 >> 1)) * 64) + (row & 31) + 32 * (s8 & 1)) * 8; }

__device__ __forceinline__ void mlstm_prep(const Params& p, int L, int h, int c, LAS unsigned char* lds) {
    const int tid = TIDX(), t0 = c * 64;
    const float* zf = (const float*)(P_WS + OFF_ZF);
    LAS float* s_ws = (LAS float*)lds;
    if (tid < 64) {
        const int t = t0 + tid;
        float ig = zf[(size_t)t * ZF_LD + 4096 + h] + P_IN(5)[L * 4 + h];
        float fg = zf[(size_t)t * ZF_LD + 4100 + h] + P_IN(6)[L * 4 + h];
        ig = 15.0f * tanhf_(ig * (1.0f / 15.0f)); fg = 15.0f * tanhf_(fg * (1.0f / 15.0f));
        const float lf = fminf(fg, 0.f) - __logf(1.0f + __expf(-fabsf(fg)));
        float b = lf;
#pragma unroll
        for (int o = 1; o < 64; o <<= 1) { const float nb = bperm_f((tid - o) & 63, b); if (tid >= o) b += nb; }
        const float bend = bperm_f(63, b);
        const float wlog = bend - b + ig;
        const float mloc = wave_max(wlog);
        s_ws[tid] = __expf(wlog - mloc);
        ((float*)(P_WS + OFF_MI))[h * T + t] = ig; ((float*)(P_WS + OFF_MBB))[h * T + t] = b;
        if (tid == 0) { ((float*)(P_WS + OFF_MBEND))[h * NCH + c] = bend; ((float*)(P_WS + OFF_MLOC))[h * NCH + c] = mloc; }
    }
    __syncthreads();
    const int d = tid & 255, isk = tid >> 8;
    const int col = isk * 1024 + h * 256 + d;
    const float* cw = P_IN(4) + (size_t)L * 4 * 2048;
    const float w0 = cw[col], w1 = cw[2048 + col], w2 = cw[4096 + col], w3 = cw[6144 + col];
    float x1 = (t0 >= 1) ? zf[(size_t)(t0 - 1) * ZF_LD + col] : 0.f, x2 = (t0 >= 2) ? zf[(size_t)(t0 - 2) * ZF_LD + col] : 0.f, x3 = (t0 >= 3) ? zf[(size_t)(t0 - 3) * ZF_LD + col] : 0.f;
    bh* MQ = (bh*)(P_WS + OFF_MQ); bh* MK = (bh*)(P_WS + OFF_MK);
    bh* MT = (bh*)(P_WS + (isk ? OFF_MKT : OFF_MVT)) + (size_t)(h * NCH + c) * 16384;
    LAS bh* sQK = (LAS bh*)(lds + 1024);
    float dnacc = 0.f;
    for (int hf = 0; hf < 2; ++hf) {
        float xs[32], vs[32];
#pragma unroll
        for (int j = 0; j < 32; ++j) { const int t = t0 + hf * 32 + j; xs[j] = zf[(size_t)t * ZF_LD + col]; vs[j] = isk ? 0.f : zf[(size_t)t * ZF_LD + 2048 + h * 256 + d]; }
        __builtin_amdgcn_sched_barrier(0);
#pragma unroll
        for (int s8l = 0; s8l < 4; ++s8l) { const int s8 = hf * 4 + s8l;
            unsigned pk[4];
#pragma unroll
            for (int j = 0; j < 8; ++j) { const int s = s8 * 8 + j;
                const float x0 = xs[s8l * 8 + j]; float y = w0 * x0 + w1 * x1 + w2 * x2 + w3 * x3; x3 = x2; x2 = x1; x1 = x0;
                y = y * sigmoidf_(y);
                unsigned short e;
                if (!isk) { sQK[s * 264 + d] = f2bf(y * 0.0625f); e = f2bf(vs[s8l * 8 + j]); }
                else { sQK[64 * 264 + s * 264 + d] = f2bf(y); const float wk = y * s_ws[s]; e = f2bf(wk); dnacc += wk; }
                if (j & 1) pk[j >> 1] |= ((unsigned)e << 16); else pk[j >> 1] = e; }
            u32x4 w; w.x = pk[0]; w.y = pk[1]; w.z = pk[2]; w.w = pk[3];
            *(u32x4*)(MT + ft_off(d, s8)) = w; }
    }
    if (isk) ((float*)(P_WS + OFF_DN))[(size_t)(h * NCH + c) * 256 + d] = dnacc;
    __syncthreads();
#pragma unroll
    for (int i = 0; i < 8; ++i) { const int pid = i * 512 + tid, tens = pid >> 11, rem = pid & 2047, mt = rem >> 9, ks8 = (rem >> 6) & 7, lp = rem & 63;
        const u32x4 w = *(const LAS u32x4*)(sQK + tens * (64 * 264) + (mt * 16 + (lp & 15)) * 264 + ks8 * 32 + (lp >> 4) * 8);
        *(u32x4*)((tens ? MK : MQ) + fq_base(h, c, mt, ks8) + lp * 8) = w; }
    __syncthreads();
}

__device__ __forceinline__ void rwkv_prep_token(const Params& p, int L, int t, int lane) {
    const float* zf = (const float*)(P_WS + OFF_ZF);
    const float* z = zf + (size_t)t * ZF_LD + ZR0; const float* zp = z - ZF_LD; const bool hp = t > 0;
    const float* mu = P_IN(8) + (size_t)L * 1984;
    float* RR = (float*)(P_WS + OFF_RR); float* RK = (float*)(P_WS + OFF_RK); float* RV = (float*)(P_WS + OFF_RV); float* RKK = (float*)(P_WS + OFF_RKK);
    const float* kkw = P_IN(14) + L * 512;
    float sr[8], sk[8], sv[8], kw[8], lw[2], la[2], lg[4];
#pragma unroll
    for (int i = 0; i < 8; ++i) { const int c = i * 64 + lane;
        { const float a = z[c], b = hp ? zp[c] : 0.f; sr[i] = a + (b - a) * mu[c]; }
        { const float a = z[512 + c], b = hp ? zp[512 + c] : 0.f; sk[i] = a + (b - a) * mu[512 + c]; }
        { const float a = z[1024 + c], b = hp ? zp[1024 + c] : 0.f; sv[i] = a + (b - a) * mu[1024 + c]; }
        kw[i] = kkw[c]; }
#pragma unroll
    for (int i = 0; i < 2; ++i) { const int j = i * 64 + lane; lw[i] = 0.f; la[i] = 0.f;
        if (j < 96) { { const int c = 1536 + j; const float a = z[c], b = hp ? zp[c] : 0.f; lw[i] = a + (b - a) * mu[c]; }
                      { const int c = 1632 + j; const float a = z[c], b = hp ? zp[c] : 0.f; la[i] = a + (b - a) * mu[c]; } } }
#pragma unroll
    for (int i = 0; i < 4; ++i) { const int c = 1728 + i * 64 + lane; const float a = z[c], b = hp ? zp[c] : 0.f; lg[i] = a + (b - a) * mu[c]; }
    __builtin_amdgcn_sched_barrier(0);
#pragma unroll
    for (int i = 0; i < 8; ++i) { const int c = i * 64 + lane;
        RR[(size_t)t * 512 + c] = sr[i]; RV[(size_t)t * 512 + c] = sv[i]; RK[(size_t)t * 512 + c] = sk[i];
        const float kkv = sk[i] * kw[i]; const float ss = wave_sum(kkv * kkv); RKK[(size_t)t * 512 + c] = kkv * rsqrtf(fmaxf(ss, 1e-24f)); }
    bh* LAW = (bh*)(P_WS + OFF_LAW) + (size_t)t * 256; bh* LAA = (bh*)(P_WS + OFF_LAA) + (size_t)t * 256; bh* LAG = (bh*)(P_WS + OFF_LAG) + (size_t)t * 256;
#pragma unroll
    for (int i = 0; i < 4; ++i) { const int j = i * 64 + lane;
        float vw = 0.f, va = 0.f;
        if (i < 2 && j < 96) { vw = tanhf_(lw[i < 2 ? i : 0]); va = la[i < 2 ? i : 0]; }
        LAW[j] = f2bf(vw); LAA[j] = f2bf(va); LAG[j] = f2bf(sigmoidf_(lg[i])); }
}

__device__ __forceinline__ void s5_pass_a(const Params& p, int L, int g, int c, int lane, LAS float* ul) {
    const float* zf = (const float*)(P_WS + OFF_ZF) + (size_t)(c * 64) * ZF_LD + ZS0 + g * 16;
    s5_stage_u(zf, ul, lane);
    S5C k; s5_setup(p, L, g, lane, k);
    float sr = 0.f, si = 0.f;
#pragma unroll 8
    for (int s = 0; s < 64; ++s) s5_step(k, ul + s * 16, sr, si);
    asm volatile("s_waitcnt lgkmcnt(0)" ::: "memory"); __builtin_amdgcn_wave_barrier();
    float* se = (float*)(P_WS + OFF_SEND) + ((size_t)(g * NCH + c) * 64 + lane) * 2;
    se[0] = sr; se[1] = si;
}

__device__ __forceinline__ void phase_prep(const Params& p, int L, LAS unsigned char* lds) {
    const int wid = TIDX() >> 6, lane = TIDX() & 63;
    for (int it = BIDX(); it < 2048; it += GDIM()) {
        if (it < 512) mlstm_prep(p, L, it >> 7, it & 127, lds);
        else if (it < 1536) rwkv_prep_token(p, L, (it - 512) * 8 + wid, lane);
        else { const int w = (it - 1536) * 8 + wid; s5_pass_a(p, L, w >> 7, w & 127, lane, (LAS float*)lds + wid * 1024); }
    }
}

constexpr int RW_NS = 4, RW_LS = T / RW_NS, RW_NB = RW_LS / 16, RW_RING = 4, RW_SLOT = 16 * 384;
constexpr int RW_YOFF = RW_RING * RW_SLOT;
__device__ __forceinline__ void rwkv_scan(const Params& p, int b, LAS unsigned char* lds) {
    const int tid = TIDX(), wid = __builtin_amdgcn_readfirstlane(tid >> 6), lane = tid & 63;
    int j, h, rg;
    if (b < 32) { j = 0; h = b >> 2; rg = b & 3; } else { const int u = b - 32; j = 1 + (u >> 6); h = (u & 63) >> 3; rg = u & 7; }
    LAS float* ring = (LAS float*)lds;
    LAS float* ybuf = ring + RW_YOFF;
    const int tbase = j * RW_LS;
    const bool isP = rg >= 4;
    if (wid >= 4) {
        const int lw = wid - 4, lt = tid - 256;
        const float* gp[6]; unsigned lo[6];
#pragma unroll
        for (int i = 0; i < 6; ++i) { const int ii = lw * 6 + i, rowidx = ii * 4 + (lane >> 4), step = rowidx / 6, a = rowidx % 6, q = lane & 15;
            const int ai = (0x205314 >> (4 * a)) & 0xf;
            gp[i] = (const float*)(P_WS + OFF_RR + (size_t)ai * SZ_R) + (size_t)(tbase + step) * 512 + h * 64 + q * 4;
            lo[i] = (unsigned)ii * 256u; }
        float* OUT = (float*)(P_WS + (isP ? OFF_RZ : OFF_RY)) + (size_t)(tbase + (lt >> 4)) * 512 + h * 64 + (rg & 3) * 16 + (lt & 15);
#define RW_ISSUE(bi, sl) do { _Pragma("unroll") for (int _i = 0; _i < 6; ++_i) \
        __builtin_amdgcn_global_load_lds((const unsigned*)(gp[_i] + (size_t)(bi) * 16 * 512), (LAS unsigned*)(ring + (sl) * RW_SLOT + lo[_i]), 16, 0, 0); } while (0)
        RW_ISSUE(0, 0); RW_ISSUE(1, 1); RW_ISSUE(2, 2);
        asm volatile("s_waitcnt vmcnt(12)" ::: "memory"); __builtin_amdgcn_s_barrier();
        int sl = 3;
        for (int ib = 0; ib < RW_NB; ++ib) {
            if (ib + 3 < RW_NB) RW_ISSUE(ib + 3, sl);
            sl = (sl == RW_RING - 1) ? 0 : sl + 1;
            if (ib > 0) {
                const LAS float* yb = ybuf + ((ib - 1) & 1) * 4096 + lt * 16;
                const f32x4 a0 = *(const LAS f32x4*)yb, a1 = *(const LAS f32x4*)(yb + 4), a2 = *(const LAS f32x4*)(yb + 8), a3 = *(const LAS f32x4*)(yb + 12);
                const f32x4 sm = (a0 + a1) + (a2 + a3);
                OUT[(size_t)(ib - 1) * 16 * 512] = (sm[0] + sm[1]) + (sm[2] + sm[3]);
            }
            if (ib + 3 < RW_NB) asm volatile("s_waitcnt vmcnt(13)" ::: "memory");
            else asm volatile("s_waitcnt vmcnt(0)" ::: "memory");
            __builtin_amdgcn_s_barrier();
        }
        {   const LAS float* yb = ybuf + ((RW_NB - 1) & 1) * 4096 + lt * 16;
            const f32x4 a0 = *(const LAS f32x4*)yb, a1 = *(const LAS f32x4*)(yb + 4), a2 = *(const LAS f32x4*)(yb + 8), a3 = *(const LAS f32x4*)(yb + 12);
            const f32x4 sm = (a0 + a1) + (a2 + a3);
            OUT[(size_t)(RW_NB - 1) * 16 * 512] = (sm[0] + sm[1]) + (sm[2] + sm[3]); }
#undef RW_ISSUE
    } else {
        const int r16 = wid * 4 + (lane >> 4), kq = lane & 15, row = (rg & 3) * 16 + r16;
        f32x4 S;
#pragma unroll
        for (int e = 0; e < 4; ++e) S[e] = (isP && (kq * 4 + e == row)) ? 1.f : 0.f;
        const float vmask = isP ? 0.f : 1.f;
        __builtin_amdgcn_s_barrier();
        int sl = 0;
        for (int ib = 0; ib < RW_NB; ++ib) {
            const LAS float* bb = ring + sl * RW_SLOT;
            LAS float* yw = ybuf + (ib & 1) * 4096 + r16 * 16 + kq;
            f32x4 w4 = *(const LAS f32x4*)(bb + kq * 4), k4 = *(const LAS f32x4*)(bb + 64 + kq * 4), kk4 = *(const LAS f32x4*)(bb + 128 + kq * 4),
                  b4 = *(const LAS f32x4*)(bb + 192 + kq * 4), r4 = *(const LAS f32x4*)(bb + 256 + kq * 4);
            float vv = bb[320 + row];
#pragma unroll
            for (int s = 0; s < 16; ++s) {
                f32x4 w4n, k4n, kk4n, b4n, r4n; float vvn;
                if (s < 15) { const LAS float* q = bb + (s + 1) * 384;
                    w4n = *(const LAS f32x4*)(q + kq * 4); k4n = *(const LAS f32x4*)(q + 64 + kq * 4); kk4n = *(const LAS f32x4*)(q + 128 + kq * 4);
                    b4n = *(const LAS f32x4*)(q + 192 + kq * 4); r4n = *(const LAS f32x4*)(q + 256 + kq * 4); vvn = q[320 + row]; }
                __builtin_amdgcn_sched_barrier(0);
                float pd = fmaf(S[0], kk4[0], fmaf(S[1], kk4[1], fmaf(S[2], kk4[2], S[3] * kk4[3])));
                const f32x4 pre = S * w4 + (vv * vmask) * k4;
                pd = allreduce16(pd);
                S = pre + pd * b4;
                yw[s * 256] = fmaf(S[0], r4[0], fmaf(S[1], r4[1], fmaf(S[2], r4[2], S[3] * r4[3])));
                if (s < 15) { w4 = w4n; k4 = k4n; kk4 = kk4n; b4 = b4n; r4 = r4n; vv = vvn; }
            }
            sl = (sl == RW_RING - 1) ? 0 : sl + 1;
            asm volatile("s_waitcnt lgkmcnt(0)" ::: "memory");
            __builtin_amdgcn_s_barrier();
        }
        float* EN = (float*)(P_WS + (isP ? OFF_RPEND : OFF_RSEND)) + ((size_t)(h * 4 + j) * 64 + row) * 64 + kq * 4;
        *(f32x4*)EN = S;
    }
    __syncthreads();
}

struct MStage { bf16x8 q[4], k[4], v[4]; float bend, mloc; };
__device__ __forceinline__ void mstage_load(MStage& st, const bh* qp, const bh* kp, const bh* vp, const float* MBEND, const float* MLOC, int h, int c) {
#pragma unroll
    for (int ks = 0; ks < 4; ++ks) { st.q[ks] = *(const bf16x8*)(qp + (size_t)c * 16384 + ks * 512); st.k[ks] = *(const bf16x8*)(kp + (size_t)c * 16384 + ks * 512); st.v[ks] = *(const bf16x8*)(vp + (size_t)c * 16384 + ks * 512); }
    st.bend = MBEND[h * NCH + c]; st.mloc = MLOC[h * NCH + c];
}
__device__ __forceinline__ void mlstm_seq(const Params& p, int mb, LAS unsigned char* lds) {
    const int tid = TIDX(), wid = tid >> 6, lane = tid & 63;
    const int h = mb >> 3, jv = mb & 7;
    LAS bh* Cbf = (LAS bh*)lds;
    constexpr int CS = 264;
    for (int i = tid; i < 2 * 32 * CS / 2; i += 512) ((LAS unsigned*)Cbf)[i] = 0u;
    __syncthreads();
    const bh* MQ = (const bh*)(P_WS + OFF_MQ); const bh* MKT = (const bh*)(P_WS + OFF_MKT); const bh* MVT = (const bh*)(P_WS + OFF_MVT);
    const float* MBEND = (const float*)(P_WS + OFF_MBEND); const float* MLOC = (const float*)(P_WS + OFF_MLOC);
    f32x16 ct;
    { const float z = OZ();
#pragma unroll
    for (int i = 0; i < 16; ++i) ct[i] = z; }
    float m = 0.f;
    const int mt = wid >> 1, kh = wid & 1;
    float* MINTER = (float*)(P_WS + OFF_ABF);
    LAS float* It = (LAS float*)(lds + 2 * 32 * 264 * 2);
    const bh* qp = MQ + fq_base(h, 0, mt, kh * 4) + lane * 8;
    const bh* kp = MKT + (size_t)(h * NCH) * 16384 + (wid * 4 * 64 + lane) * 8;
    const bh* vp = MVT + (size_t)(h * NCH) * 16384 + (jv * 4 * 64 + lane) * 8;
    MStage s0, s1, s2;
    mstage_load(s0, qp, kp, vp, MBEND, MLOC, h, 0);
    mstage_load(s1, qp, kp, vp, MBEND, MLOC, h, 1);
#define MSTEP(SC, SL, CIDX) do { const int c = (CIDX); const int t0 = c * 64, cur = c & 1; \
        mstage_load(SL, qp, kp, vp, MBEND, MLOC, h, (c + 2 < NCH) ? c + 2 : NCH - 1); \
        const float mnew = fmaxf(SC.bend + m, SC.mloc), decay = __expf(SC.bend + m - mnew), scale = __expf(SC.mloc - mnew); \
        f32x4 r0 = {0.f, 0.f, 0.f, 0.f}, r1 = {0.f, 0.f, 0.f, 0.f}; \
        const LAS bh* cb = Cbf + cur * 32 * CS + (lane & 15) * CS + kh * 128 + (lane >> 4) * 8; \
        _Pragma("unroll") for (int ks = 0; ks < 4; ++ks) { const bf16x8 b0 = *(const LAS bf16x8*)(cb + ks * 32), b1 = *(const LAS bf16x8*)(cb + 16 * CS + ks * 32); r0 = MFMA16(SC.q[ks], b0, r0); r1 = MFMA16(SC.q[ks], b1, r1); } \
        {     \
            if (c > 0) { const LAS float* ip = It + ((c - 1) & 1) * (2 * 64 * 36) + (tid >> 3) * 36 + (tid & 7) * 4; \
                const f32x4 sv = *(const LAS f32x4*)ip + *(const LAS f32x4*)(ip + 64 * 36); \
                float* o = MINTER + (size_t)(t0 - 64 + (tid >> 3)) * 1024 + h * 256 + jv * 32 + (tid & 7) * 4; \
                asm volatile("global_store_dwordx4 %0, %1, off\n\ts_nop 1" :: "v"(o), "v"(sv) : "memory"); } \
            LAS float* iw = It + cur * (2 * 64 * 36) + kh * (64 * 36) + (mt * 16 + (lane >> 4) * 4) * 36 + (lane & 15); \
            _Pragma("unroll") for (int r = 0; r < 4; ++r) { iw[r * 36] = r0[r]; iw[r * 36 + 16] = r1[r]; } } \
        f32x16 d0; { const float z = OZ(); _Pragma("unroll") for (int i = 0; i < 16; ++i) d0[i] = z; } \
        _Pragma("unroll") for (int ks = 0; ks < 4; ++ks) d0 = MFMA32(SC.k[ks], SC.v[ks], d0); \
        _Pragma("unroll") for (int i = 0; i < 16; ++i) ct[i] = decay * ct[i] + scale * d0[i]; \
        m = mnew; \
        {   LAS bh* o0 = Cbf + (cur ^ 1) * 32 * CS + (lane & 31) * CS + wid * 32 + 4 * (lane >> 5); \
            _Pragma("unroll") for (int g = 0; g < 4; ++g) { u32x2 w0; w0.x = cvt_pk_bf16(ct[4 * g], ct[4 * g + 1]); w0.y = cvt_pk_bf16(ct[4 * g + 2], ct[4 * g + 3]); *(LAS u32x2*)(o0 + 8 * g) = w0; } } \
        asm volatile("s_waitcnt lgkmcnt(0)" ::: "memory"); __builtin_amdgcn_s_barrier(); asm volatile("" ::: "memory"); } while (0)
    for (int c3 = 0; c3 < 126; c3 += 6) { MSTEP(s0, s2, c3); MSTEP(s1, s0, c3 + 1); MSTEP(s2, s1, c3 + 2); MSTEP(s0, s2, c3 + 3); MSTEP(s1, s0, c3 + 4); MSTEP(s2, s1, c3 + 5); }
    MSTEP(s0, s2, 126); MSTEP(s1, s0, 127);
#undef MSTEP
    {   const LAS float* ip = It + (127 & 1) * (2 * 64 * 36) + (tid >> 3) * 36 + (tid & 7) * 4;
        const f32x4 sv = *(const LAS f32x4*)ip + *(const LAS f32x4*)(ip + 64 * 36);
        *(f32x4*)(MINTER + (size_t)(127 * 64 + (tid >> 3)) * 1024 + h * 256 + jv * 32 + (tid & 7) * 4) = sv; }
    asm volatile("s_waitcnt vmcnt(0)" ::: "memory");
    __syncthreads();
}

__device__ __forceinline__ void mlstm_nscan(const Params& p) {
    const float* MBEND = (const float*)(P_WS + OFF_MBEND); const float* MLOC = (const float*)(P_WS + OFF_MLOC);
    const float* DN = (const float*)(P_WS + OFF_DN); float* NST = (float*)(P_WS + OFF_NST); float* MSTART = (float*)(P_WS + OFF_MSTART);
    for (int idx = TIDX(); idx < 1024; idx += 512) { const int h = idx >> 8, d = idx & 255; float m = 0.f, n = 0.f;
        for (int c0 = 0; c0 < NCH; c0 += 16) {
            float be[16], ml[16], dn[16];
#pragma unroll
            for (int j = 0; j < 16; ++j) { be[j] = MBEND[h * NCH + c0 + j]; ml[j] = MLOC[h * NCH + c0 + j]; dn[j] = DN[(size_t)(h * NCH + c0 + j) * 256 + d]; }
            __builtin_amdgcn_sched_barrier(0);
#pragma unroll
            for (int j = 0; j < 16; ++j) { const int c = c0 + j; if (d == 0) MSTART[h * NCH + c] = m; NST[(size_t)(h * NCH + c) * 256 + d] = n;
                const float mnew = fmaxf(be[j] + m, ml[j]);
                n = __expf(be[j] + m - mnew) * n + __expf(ml[j] - mnew) * dn[j]; m = mnew; } } }
}

__device__ __forceinline__ float gelu_tanh(float x) { const float u = 0.7978845608028654f * (x + 0.044715f * x * x * x); return 0.5f * x * (1.0f + tanhf_(u)); }

__device__ __forceinline__ void s5_pass_c(const Params& p, int L, int g, int c, int lane, LAS bh* img, LAS float* ul) {
    const float* zf = (const float*)(P_WS + OFF_ZF) + (size_t)(c * 64) * ZF_LD + ZS0 + g * 16;
    s5_stage_u(zf, ul, lane);
    S5C k; s5_setup(p, L, g, lane, k);
    float sr = 0.f, si = 0.f;
    {   float pr = k.ar, pi = k.ai;
#pragma unroll
        for (int i = 0; i < 6; ++i) { const float nr = pr * pr - pi * pi, ni = 2.f * pr * pi; pr = nr; pi = ni; }
        const float* se = (const float*)(P_WS + OFF_SEND) + ((size_t)(g * NCH) * 64 + lane) * 2;
        int cc = 0;
        for (; cc + 32 <= c; cc += 32) { float er[32], ei[32];
#pragma unroll
            for (int j = 0; j < 32; ++j) { er[j] = se[(size_t)(cc + j) * 128]; ei[j] = se[(size_t)(cc + j) * 128 + 1]; }
#pragma unroll
            for (int j = 0; j < 32; ++j) { const float nr = pr * sr - pi * si + er[j], ni = pr * si + pi * sr + ei[j]; sr = nr; si = ni; } }
        for (; cc + 8 <= c; cc += 8) { float er[8], ei[8];
#pragma unroll
            for (int j = 0; j < 8; ++j) { er[j] = se[(size_t)(cc + j) * 128]; ei[j] = se[(size_t)(cc + j) * 128 + 1]; }
#pragma unroll
            for (int j = 0; j < 8; ++j) { const float nr = pr * sr - pi * si + er[j], ni = pr * si + pi * sr + ei[j]; sr = nr; si = ni; } }
        for (; cc < c; ++cc) { const float er = se[(size_t)cc * 128], ei = se[(size_t)cc * 128 + 1];
            const float nr = pr * sr - pi * si + er, ni = pr * si + pi * sr + ei; sr = nr; si = ni; } }
    const int gi = L * 32 + g;
    bf16x8 bfr[4];
    {   const int pp = lane & 15; const float* cre = P_IN(24) + ((size_t)gi * 16 + pp) * 64; const float* cim = P_IN(25) + ((size_t)gi * 16 + pp) * 64;
#pragma unroll
        for (int ks = 0; ks < 4; ++ks)
#pragma unroll
            for (int j = 0; j < 8; ++j) { const int n2 = ks * 32 + (lane >> 4) * 8 + j; const float v = (n2 < 64) ? cre[n2] : -cim[n2 - 64]; bfr[ks][j] = (short)f2bf(v); } }
    const float dco = P_IN(26)[L * 512 + g * 16 + (lane & 15)];
    bh* YS = (bh*)(P_WS + OFF_YS);
    for (int half = 0; half < 2; ++half) {
#pragma unroll 8
        for (int s = 0; s < 32; ++s) { s5_step(k, ul + (half * 32 + s) * 16, sr, si); img[s * 136 + lane] = f2bf(sr); img[s * 136 + 64 + lane] = f2bf(si); }
        asm volatile("s_waitcnt lgkmcnt(0)" ::: "memory"); __builtin_amdgcn_wave_barrier();
#pragma unroll
        for (int mt = 0; mt < 2; ++mt) { f32x4 acc = {0.f, 0.f, 0.f, 0.f};
#pragma unroll
            for (int ks = 0; ks < 4; ++ks) { const bf16x8 a = *(const LAS bf16x8*)(img + (mt * 16 + (lane & 15)) * 136 + ks * 32 + (lane >> 4) * 8); acc = MFMA16(a, bfr[ks], acc); }
#pragma unroll
            for (int r = 0; r < 4; ++r) { const int tt = half * 32 + mt * 16 + (lane >> 4) * 4 + r; const float uv = ul[tt * 16 + (lane & 15)];
                YS[(size_t)(c * 64 + tt) * 512 + g * 16 + (lane & 15)] = f2bf(gelu_tanh(acc[r] + dco * uv)); } }
        asm volatile("s_waitcnt lgkmcnt(0)" ::: "memory"); __builtin_amdgcn_wave_barrier();
    }
}

__device__ __forceinline__ void phase_scan(const Params& p, int L, LAS unsigned char* lds) {
    const int b = BIDX();
    if (b < 224) { for (int rr = 0; rr < PROBE_RW; ++rr) rwkv_scan(p, b, lds); }
    else { for (int rr = 0; rr < PROBE_ML; ++rr) mlstm_seq(p, b - 224, lds); }
}
__device__ __forceinline__ void phase_s5c(const Params& p, int L, LAS unsigned char* lds) {
    const int b = BIDX(), wid = TIDX() >> 6, lane = TIDX() & 63;
    if (b == GDIM() - 1) mlstm_nscan(p);
    const int nw = GDIM() * 8;
    for (int w = b * 8 + wid; w < 32 * NCH; w += nw) s5_pass_c(p, L, w >> 7, w & 127, lane, (LAS bh*)lds + wid * (32 * 136), (LAS float*)(lds + 69632) + wid * 1024);
    __syncthreads();
}

__device__ __forceinline__ void mlstm_out(const Params& p, int L, int h, int c, LAS unsigned char* lds) {
    const int tid = TIDX(), wid = tid >> 6, lane = tid & 63, t0 = c * 64;
    LAS bh* Pl = (LAS bh*)lds;
    LAS float* s_b = (LAS float*)(lds + 9216); LAS float* s_a = s_b + 64; LAS float* s_mt = s_a + 64; LAS float* s_iw = s_mt + 64; LAS float* s_den = s_iw + 64; LAS float* s_qn = s_den + 64; LAS float* s_part = s_qn + 64;
    const bh* MQ = (const bh*)(P_WS + OFF_MQ); const bh* MK = (const bh*)(P_WS + OFF_MK); const bh* MVT = (const bh*)(P_WS + OFF_MVT);
    const float* MINTER = (const float*)(P_WS + OFF_ABF);
    const float m0 = ((const float*)(P_WS + OFF_MSTART))[h * NCH + c];
    if (tid < 64) { const float ig = ((const float*)(P_WS + OFF_MI))[h * T + t0 + tid], b = ((const float*)(P_WS + OFF_MBB))[h * T + t0 + tid];
        const float a = ig - b; float cm = a;
#pragma unroll
        for (int o = 1; o < 64; o <<= 1) { const float nb = bperm_f((tid - o) & 63, cm); if (tid >= o) cm = fmaxf(cm, nb); }
        const float mt = b + fmaxf(m0, cm);
        s_b[tid] = b; s_a[tid] = a; s_mt[tid] = mt; s_iw[tid] = __expf(b + m0 - mt); }
    __syncthreads();
    {
        const int mt = wid >> 1, nt0 = (wid & 1) * 2;
        f32x4 r0 = {0.f, 0.f, 0.f, 0.f}, r1 = {0.f, 0.f, 0.f, 0.f};
        const bh* qp = MQ + fq_base(h, c, mt, 0) + lane * 8;
        const bh* kp = MK + fq_base(h, c, nt0, 0) + lane * 8;
#pragma unroll
        for (int ks = 0; ks < 8; ++ks) { const bf16x8 a = *(const bf16x8*)(qp + ks * 512); const bf16x8 b0 = *(const bf16x8*)(kp + ks * 512), b1 = *(const bf16x8*)(kp + 8 * 512 + ks * 512);
            r0 = MFMA16(a, b0, r0); r1 = MFMA16(a, b1, r1); }
#pragma unroll
        for (int r = 0; r < 4; ++r) { const int t = mt * 16 + (lane >> 4) * 4 + r; const float bt = s_b[t] - s_mt[t];
            { const int s = nt0 * 16 + (lane & 15); const float pv = (s <= t) ? r0[r] * __expf(bt + s_a[s]) : 0.f; Pl[t * 72 + s] = f2bf(pv); }
            { const int s = nt0 * 16 + 16 + (lane & 15); const float pv = (s <= t) ? r1[r] * __expf(bt + s_a[s]) : 0.f; Pl[t * 72 + s] = f2bf(pv); } }
    }
    __syncthreads();
    if (tid < 64) { float s = 0.f;
#pragma unroll
        for (int q = 0; q < 8; ++q) { const u32x4 w = *(const LAS u32x4*)(Pl + tid * 72 + q * 8);
            s += __uint_as_float(w.x << 16) + __uint_as_float(w.x & 0xffff0000u) + __uint_as_float(w.y << 16) + __uint_as_float(w.y & 0xffff0000u)
               + __uint_as_float(w.z << 16) + __uint_as_float(w.z & 0xffff0000u) + __uint_as_float(w.w << 16) + __uint_as_float(w.w & 0xffff0000u); }
        s_den[tid] = s; }
    {
        const float* nst = (const float*)(P_WS + OFF_NST) + (size_t)(h * NCH + c) * 256 + lane * 4; const f32x4 nv = *(const f32x4*)nst;
#pragma unroll
        for (int i = 0; i < 8; ++i) { const int t = wid * 8 + i; const u32x2 q2 = *(const u32x2*)(MQ + fq_off(h, t0 + t, lane * 4));
            float s = __uint_as_float(q2.x << 16) * nv[0] + __uint_as_float(q2.x & 0xffff0000u) * nv[1] + __uint_as_float(q2.y << 16) * nv[2] + __uint_as_float(q2.y & 0xffff0000u) * nv[3];
            s = wave_sum(s); if (lane == 0) s_qn[t] = s; } }
    f32x4 acc[4][2];
#pragma unroll
    for (int a = 0; a < 4; ++a) { const float z = OZ(); acc[a][0] = (f32x4){z, z, z, z}; acc[a][1] = (f32x4){z, z, z, z}; }
    {   const bh* vp = MVT + (size_t)(h * NCH + c) * 16384;
#pragma unroll
        for (int ks = 0; ks < 2; ++ks) { const bf16x8 b0 = *(const bf16x8*)(vp + ft_off(wid * 32 + (lane & 15), ks * 4 + (lane >> 4))), b1 = *(const bf16x8*)(vp + ft_off(wid * 32 + 16 + (lane & 15), ks * 4 + (lane >> 4)));
#pragma unroll
            for (int a = 0; a < 4; ++a) { const bf16x8 av = *(const LAS bf16x8*)(Pl + (a * 16 + (lane & 15)) * 72 + ks * 32 + (lane >> 4) * 8);
                acc[a][0] = MFMA16(av, b0, acc[a][0]); acc[a][1] = MFMA16(av, b1, acc[a][1]); } } }
    __syncthreads();
#pragma unroll
    for (int a = 0; a < 4; ++a)
#pragma unroll
        for (int r = 0; r < 4; ++r) { const int t = a * 16 + (lane >> 4) * 4 + r; const float iw = s_iw[t];
            const float den = s_den[t] + iw * s_qn[t]; const float dd = __builtin_amdgcn_rcpf(fmaxf(fabsf(den), __expf(-s_mt[t])));
            const float* mi = MINTER + (size_t)(t0 + t) * 1024 + h * 256 + wid * 32 + (lane & 15);
            const float h0 = (acc[a][0][r] + iw * mi[0]) * dd, h1 = (acc[a][1][r] + iw * mi[16]) * dd;
            acc[a][0][r] = h0; acc[a][1][r] = h1;
            float ss = h0 * h0 + h1 * h1;
            ss = allreduce16(ss);
            if ((lane & 15) == 0) s_part[wid * 64 + t] = ss; }
    __syncthreads();
    {   const float* zf = (const float*)(P_WS + OFF_ZF); const float* ng = P_IN(7) + L * 1024 + h * 256; bh* YC = (bh*)(P_WS + OFF_YCAT);
        float og[4][4][2]; const float ng0 = ng[wid * 32 + (lane & 15)], ng1 = ng[wid * 32 + 16 + (lane & 15)];
#pragma unroll
        for (int a = 0; a < 4; ++a)
#pragma unroll
            for (int r = 0; r < 4; ++r) { const float* op = zf + (size_t)(t0 + a * 16 + (lane >> 4) * 4 + r) * ZF_LD + 3072 + h * 256 + wid * 32 + (lane & 15); og[a][r][0] = op[0]; og[a][r][1] = op[16]; }
        __builtin_amdgcn_sched_barrier(0);
#pragma unroll
        for (int a = 0; a < 4; ++a)
#pragma unroll
            for (int r = 0; r < 4; ++r) { const int t = a * 16 + (lane >> 4) * 4 + r;
                float tot = 0.f;
#pragma unroll
                for (int w = 0; w < 8; ++w) tot += s_part[w * 64 + t];
                const float rstd = rsqrtf(tot * (1.0f / 256.0f) + 1e-6f);
                const int v0 = wid * 32 + (lane & 15);
                bh* yo = YC + (size_t)(t0 + t) * D + h * 256 + v0;
                yo[0] = f2bf(sigmoidf_(og[a][r][0]) * acc[a][0][r] * rstd * ng0);
                yo[16] = f2bf(sigmoidf_(og[a][r][1]) * acc[a][1][r] * rstd * ng1); } }
    __syncthreads();
}

__device__ __forceinline__ void rwkv_post(const Params& p, int L, int it, LAS unsigned char* lds) {
    const int tid = TIDX(), wid = tid >> 6, lane = tid & 63;
    const int h = it & 7, blk = it >> 3, j = blk >> 3;
    LAS float* bufA = (LAS float*)lds;
    LAS float* bufB = bufA + 64 * 65;
    LAS float* bufP = bufB + 64 * 65;
    const float* SE = (const float*)(P_WS + OFF_RSEND) + (size_t)(h * 4) * 4096; const float* PE = (const float*)(P_WS + OFF_RPEND) + (size_t)(h * 4) * 4096;
    LAS float* sst = bufA;
    if (j >= 1) {
        const int v = tid >> 3, k8 = (tid & 7) * 8;
        { const f32x4 a0 = *(const f32x4*)(SE + v * 64 + k8), a1 = *(const f32x4*)(SE + v * 64 + k8 + 4);
#pragma unroll
          for (int e = 0; e < 4; ++e) { bufA[v * 65 + k8 + e] = a0[e]; bufA[v * 65 + k8 + 4 + e] = a1[e]; } }
        for (int jj = 1; jj < j; ++jj) {
            { const f32x4 p0 = *(const f32x4*)(PE + (size_t)jj * 4096 + v * 64 + k8), p1 = *(const f32x4*)(PE + (size_t)jj * 4096 + v * 64 + k8 + 4);
              *(LAS f32x4*)(bufP + v * 64 + k8) = p0; *(LAS f32x4*)(bufP + v * 64 + k8 + 4) = p1; }
            __syncthreads();
            LAS float* src = (jj & 1) ? bufA : bufB; LAS float* dst = (jj & 1) ? bufB : bufA;
            f32x4 c0 = *(const f32x4*)(SE + (size_t)jj * 4096 + v * 64 + k8), c1 = *(const f32x4*)(SE + (size_t)jj * 4096 + v * 64 + k8 + 4);
#pragma unroll 8
            for (int i = 0; i < 64; ++i) { const float a = src[v * 65 + i]; const f32x4 p0 = *(const LAS f32x4*)(bufP + i * 64 + k8), p1 = *(const LAS f32x4*)(bufP + i * 64 + k8 + 4); c0 += a * p0; c1 += a * p1; }
#pragma unroll
            for (int e = 0; e < 4; ++e) { dst[v * 65 + k8 + e] = c0[e]; dst[v * 65 + k8 + 4 + e] = c1[e]; }
            __syncthreads();
            sst = dst;
        }
        __syncthreads();
    }
    float srow[64];
    if (j >= 1) {
#pragma unroll
        for (int i = 0; i < 64; ++i) srow[i] = sst[lane * 65 + i];
    } else {
#pragma unroll
        for (int i = 0; i < 64; ++i) srow[i] = 0.f;
    }
    const int c = h * 64 + lane;
    const float rkw = P_IN(16)[L * 512 + c], lg = P_IN(17)[L * 512 + c], lb = P_IN(18)[L * 512 + c];
    const float* RY = (const float*)(P_WS + OFF_RY); const float* RZ = (const float*)(P_WS + OFF_RZ); const float* RR = (const float*)(P_WS + OFF_RR); const float* RK = (const float*)(P_WS + OFF_RK);
    const float* RV = (const float*)(P_WS + OFF_RV); const float* RG = (const float*)(P_WS + OFF_RG); bh* YC = (bh*)(P_WS + OFF_YCAT);
    for (int i4 = 0; i4 < 32; i4 += 4) { float yv[4], zv[4], rrv[4], rkv[4], rvv[4], rgv[4];
#pragma unroll
        for (int q = 0; q < 4; ++q) { const size_t o = (size_t)(blk * 256 + wid * 32 + i4 + q) * 512 + c;
            yv[q] = RY[o]; zv[q] = (j >= 1) ? RZ[o] : 0.f; rrv[q] = RR[o]; rkv[q] = RK[o]; rvv[q] = RV[o]; rgv[q] = RG[o]; }
        __builtin_amdgcn_sched_barrier(0);
#pragma unroll
        for (int q4 = 0; q4 < 4; ++q4) { const int t = blk * 256 + wid * 32 + i4 + q4;
            float y = yv[q4];
            if (j >= 1) { const float z = zv[q4]; float y2 = 0.f;
#pragma unroll
                for (int q = 0; q < 64; q += 2) { y = fmaf(srow[q], __builtin_bit_cast(float, __builtin_amdgcn_readlane(__builtin_bit_cast(int, z), q)), y);
                                                  y2 = fmaf(srow[q + 1], __builtin_bit_cast(float, __builtin_amdgcn_readlane(__builtin_bit_cast(int, z), q + 1)), y2); }
                y += y2; }
            const float mu = wave_sum(y) * (1.0f / 64.0f); const float dlt = y - mu; const float var = wave_sum(dlt * dlt) * (1.0f / 64.0f);
            const float yn = dlt * rsqrtf(var + 64e-5f) * lg + lb;
            const float bon = wave_sum(rrv[q4] * rkv[q4] * rkw) * rvv[q4];
            YC[(size_t)t * D + 1024 + c] = f2bf((yn + bon) * rgv[q4]); } }
    __syncthreads();
}

__device__ __forceinline__ void phase_post(const Params& p, int L, LAS unsigned char* lds) {
    for (int it = BIDX(); it < 768; it += GDIM()) {
        if (it < 512) mlstm_out(p, L, it >> 7, it & 127, lds);
        else rwkv_post(p, L, it - 512, lds);
    }
    __syncthreads();
}

#define XB_TMO      128
#define XB_XCNT(j)  (256  + 64 * (j))
#define XB_XSUB(j)  (1280 + 64 * (j))
#define XB_XGEN(j)  (2304 + 64 * (j))
#define XB_TOP      3328
#define XB_TOPGEN   3392
#define XCD_BAR_WORDS 3456
#define XB_SPIN_CAP (1u << 18)

__device__ __forceinline__ unsigned xb_ld(unsigned* p)              { return __hip_atomic_load(p, __ATOMIC_RELAXED, __HIP_MEMORY_SCOPE_AGENT); }
__device__ __forceinline__ unsigned xb_add(unsigned* p, unsigned v) { return __hip_atomic_fetch_add(p, v, __ATOMIC_RELAXED, __HIP_MEMORY_SCOPE_AGENT); }
__device__ __forceinline__ unsigned xb_xcc_id() { return (unsigned)__builtin_amdgcn_s_getreg((3 << 11) | 20) & 0xFu; }
#define XB_SPIN(cond, bar) do { unsigned _sp = 0; while (cond) { __builtin_amdgcn_s_sleep(1); \
    if ((++_sp & 255u) == 0u) { if (xb_ld(&(bar)[XB_TMO])) break; if (_sp > XB_SPIN_CAP) { atomicAdd(&(bar)[XB_TMO], 1u); break; } } } } while (0)

struct XcdBarrier {
    unsigned* bar; unsigned x;
    volatile LAS unsigned* st;
};

__device__ __forceinline__ XcdBarrier xcd_barrier_post(unsigned* bar, volatile LAS unsigned* st) {
    XcdBarrier b; b.bar = bar; b.x = xb_xcc_id(); b.st = st;
    if (threadIdx.x == 0) (void)xb_add(&bar[XB_XCNT(b.x)], 1u);
    return b;
}
__device__ __forceinline__ void xcd_barrier_complete(unsigned* bar, unsigned x, unsigned& nloc, unsigned& nx) {
    const unsigned G = gridDim.x * gridDim.y * gridDim.z;
    unsigned sum, cnt, mine, sp = 0u;
    for (;;) {
        sum = 0u; cnt = 0u; mine = 0u;
#pragma unroll
        for (unsigned j = 0; j < 16; ++j) { const unsigned c = xb_ld(&bar[XB_XCNT(j)]); sum += c; cnt += (c > 0u) ? 1u : 0u; mine = (j == x) ? c : mine; }
        if (sum == G) break;
        __builtin_amdgcn_s_sleep(1);
        if ((++sp & 255u) == 0u) { if (xb_ld(&bar[XB_TMO])) break; if (sp > XB_SPIN_CAP) { atomicAdd(&bar[XB_TMO], 1u); break; } }
    }
    nloc = mine > 0u ? mine : 1u; nx = cnt > 0u ? cnt : 1u;
}

__device__ __forceinline__ void xcd_barrier(const XcdBarrier& b) {
    asm volatile("s_waitcnt vmcnt(0)" ::: "memory");
    __syncthreads();
    if (threadIdx.x == 0) {
        unsigned* bar = b.bar;
        __builtin_amdgcn_s_waitcnt(0);
        unsigned nloc = b.st[0], nx = b.st[1];
        if (nloc == 0u) { xcd_barrier_complete(bar, b.x, nloc, nx); b.st[0] = nloc; b.st[1] = nx; }
        const unsigned old = xb_add(&bar[XB_XSUB(b.x)], 1u);
        const unsigned gen = old / nloc;
        if (old + 1u == (gen + 1u) * nloc) {
            __builtin_amdgcn_fence(__ATOMIC_RELEASE, "agent");
            asm volatile("s_waitcnt vmcnt(0)" ::: "memory");
            const unsigned og = xb_add(&bar[XB_TOP], 1u);
            const unsigned tg = og / nx;
            if (og + 1u == (tg + 1u) * nx) xb_add(&bar[XB_TOPGEN], 1u);
            else XB_SPIN(xb_ld(&bar[XB_TOPGEN]) == tg, bar);
            __builtin_amdgcn_fence(__ATOMIC_ACQUIRE, "agent");
            xb_add(&bar[XB_XGEN(b.x)], 1u);
            asm volatile("s_waitcnt vmcnt(0)" ::: "memory");
        } else {
            XB_SPIN(xb_ld(&bar[XB_XGEN(b.x)]) == gen, bar);
            __builtin_amdgcn_fence(__ATOMIC_ACQUIRE, "agent");
            asm volatile("s_waitcnt vmcnt(0)" ::: "memory");
        }
    }
    __syncthreads();
}


constexpr int NPHASE = 27;
__global__ void __launch_bounds__(512, 2) hybrid_fwd(Params p, int ph_lo, int ph_hi, int rep_q) {
    extern __shared__ __attribute__((aligned(16))) unsigned char smem_raw[];
    LAS unsigned char* lds = (LAS unsigned char*)smem_raw;
    cg::grid_group grid = cg::this_grid();
    volatile LAS unsigned* xst = (volatile LAS unsigned*)(lds + 131072);
    if (threadIdx.x < 2) xst[threadIdx.x] = 0u;
    __syncthreads();
    { XcdBarrier b0 = xcd_barrier_post((unsigned*)(P_WS + OFF_BAR), xst); (void)b0; }
    for (int ph = ph_lo; ph < ph_hi; ++ph) {
        if (ph == ph_lo + 1) grid.sync();
        else if (ph > ph_lo) { XcdBarrier xb; xb.bar = (unsigned*)(P_WS + OFF_BAR); xb.x = xb_xcc_id(); xb.st = xst; xcd_barrier(xb); }
        if (ph == 26) {
            const int gw = BIDX() * 8 + (TIDX() >> 6), NGW = GDIM() * 8, lane = TIDX() & 63;
            for (int r = gw; r < T; r += NGW) { float* x = P_OUT + (size_t)r * D; f32x4 v[8]; float s = 0.f;
#pragma unroll
                for (int j = 0; j < 8; ++j) { v[j] = *(const f32x4*)(x + j * 256 + lane * 4); s += (v[j][0] * v[j][0] + v[j][1] * v[j][1]) + (v[j][2] * v[j][2] + v[j][3] * v[j][3]); }
                const float rstd = rsqrtf(wave_sum(s) * (1.0f / D) + 1e-6f);
#pragma unroll
                for (int j = 0; j < 8; ++j) { const f32x4 gg = *(const f32x4*)(P_IN(40) + j * 256 + lane * 4); *(f32x4*)(x + j * 256 + lane * 4) = v[j] * rstd * gg; } }
            continue;
        }
        const int L = ph / 13, q = ph % 13;
#ifdef ONLY_Q
        if (q != ONLY_Q) continue;
#endif
        const int nrep = (q == rep_q) ? 2 : 1;
        for (int rep = 0; rep < nrep; ++rep) {
        if (rep) grid.sync();
        switch (q) {
        case 0: phase_conv(p, L, lds); break;
        case 2: phase_prep(p, L, lds); break;
        case 4: phase_scan(p, L, lds); break;
        case 5: phase_post(p, L, lds); break;
        case 8: phase_rmsnorm(p, P_IN(33) + (size_t)L * D); break;
        case 11: phase_rmsnorm(p, P_IN(37) + (size_t)L * D); break;
        default: break;
        }
        for (int i = 0; i < 3; ++i) {
            pg8::Gemm g;
            if (!make_gemm(p, L, q, i, g)) break;
            pg8::StaticOrder S; S.init(T, g.N, GDIM(), (q == 3) ? BIDX() - 64 * i : BIDX());
            pg8::gemm_phase(lds, g, S);
        }
        if (q == 3) phase_s5c(p, L, lds);
        }
    }
}

extern "C" void kernel_launch(void* const* d_in, const int* in_sizes, int n_in, void* d_out, int out_size, void* d_ws, size_t ws_size, hipStream_t stream) {
    constexpr size_t kDynLds = 131072 + 64;
    static int grid_blocks = 0;
    if (!grid_blocks) {
        int dev = 0, cus = 0, per_cu = 0;
        (void)hipGetDevice(&dev);
        (void)hipDeviceGetAttribute(&cus, hipDeviceAttributeMultiprocessorCount, dev);
        (void)hipFuncSetAttribute((const void*)hybrid_fwd, hipFuncAttributeMaxDynamicSharedMemorySize, (int)kDynLds);
        (void)hipOccupancyMaxActiveBlocksPerMultiprocessor(&per_cu, hybrid_fwd, 512, kDynLds);
        if (per_cu > 1) per_cu = 1;
        grid_blocks = cus * per_cu;
        if (ws_size < WS_TOTAL) fprintf(stderr, "workspace too small: %zu < %zu\n", ws_size, (size_t)WS_TOTAL);
    }
    Params p{};
    for (int i = 0; i < 41; ++i) p.in[i] = (const float*)d_in[i];
    p.out = (float*)d_out; p.ws = (unsigned char*)d_ws;
    (void)hipMemsetAsync((char*)d_ws + OFF_BAR, 0, XCD_BAR_WORDS * 4, stream);
#if SINGLE_LAUNCH
    int lo = 0, hi = NPHASE, rq = PROBE_REP_Q;
    void* args[] = {&p, &lo, &hi, &rq};
    hipError_t e = hipLaunchCooperativeKernel((const void*)hybrid_fwd, dim3(grid_blocks), dim3(512), args, kDynLds, stream);
    if (e != hipSuccess) fprintf(stderr, "cooperative launch failed: %s (grid %d)\n", hipGetErrorString(e), grid_blocks);
#else
    for (int ph = 0; ph < NPHASE; ++ph) {
        int lo = ph, hi = ph + 1, rq = -1;
        void* args[] = {&p, &lo, &hi, &rq};
        hipError_t e = hipLaunchCooperativeKernel((const void*)hybrid_fwd, dim3(grid_blocks), dim3(512), args, kDynLds, stream);
        if (e != hipSuccess) fprintf(stderr, "cooperative launch failed: %s (grid %d)\n", hipGetErrorString(e), grid_blocks);
    }
#endif
}
```
